# Optimizing an MI355X kernel written in HIP

```python
import math
import jax, jax.numpy as jnp
from jax import lax
import numpy as np

D_MODEL = 1024
BATCH = 8
SEQ = 4096
DEPTH = 2

GRID_W = 64
CTX_LEN = 256
EPS = 1e-6
ROPE_THETA = 10000.0
F32 = jnp.float32

A_HEADS = 4
A_QK_DIM = 64
A_V_DIM = 2 * A_QK_DIM
A_WIDTH = A_HEADS * A_V_DIM
A_PROJ = 2 * (A_HEADS * 2 * A_QK_DIM) + A_WIDTH
Q_BLOCK = 128

B_HEADS = 8
B_HEAD = 64
B_WIDTH = B_HEADS * B_HEAD
B_DECAY_LORA = 64
B_AAA_LORA = 64
B_GATE_LORA = 128
B_GN_EPS = 64e-5
B_PROJ = 3 * B_WIDTH + B_DECAY_LORA + B_AAA_LORA + B_GATE_LORA

C_HEADS = 8
C_HEAD = 64
C_WIDTH = C_HEADS * C_HEAD
C_GROUPS = 2
C_REP = C_HEADS // C_GROUPS
C_STATE = 128
C_CONV = 5
C_CHUNK = 128
C_CONV_DIM = C_WIDTH + 2 * C_GROUPS * C_STATE
C_PROJ = C_WIDTH + C_CONV_DIM + 2 * C_HEADS

D_HEADS = 4
D_KEY = 64
D_VAL = 128
D_WIDTH = D_HEADS * D_VAL
D_GATE_LORA = 16
D_GATE_TAU = 16.0
D_CHUNK = 64
D_PROJ = 2 * D_HEADS * D_KEY + 2 * D_WIDTH + D_GATE_LORA

MLP_HIDDEN = 4 * D_MODEL
EVEN_IN = A_PROJ + B_PROJ
ODD_IN = C_PROJ + D_PROJ
MIX_WIDTH = A_WIDTH + B_WIDTH

kernel_name = 'hybrid_diffattn_rwkv7_ssd_gla_dit'


def rmsnorm(x, g, eps=EPS):
    xf = x.astype(F32)
    y = xf * lax.rsqrt(jnp.mean(xf * xf, axis=-1, keepdims=True) + eps)
    return (y * g.astype(F32)).astype(x.dtype)


def _split(t, sizes):
    idx = [int(s) for s in np.cumsum(sizes)[:-1]]
    return jnp.split(t, idx, axis=-1)


def _flip_seq(*ts):
    return tuple(jnp.flip(t, axis=1) for t in ts)


def axial_rope_tables(n, dim):
    rows = n // GRID_W
    t = jnp.arange(rows * GRID_W)
    row = (t // GRID_W).astype(F32)
    col = (t % GRID_W).astype(F32)
    nf = dim // 4
    inv = ROPE_THETA ** (-jnp.arange(nf, dtype=F32) / nf)
    ar = row[:, None] * inv[None, :]
    ac = col[:, None] * inv[None, :]
    return jnp.cos(ar), jnp.sin(ar), jnp.cos(ac), jnp.sin(ac)


def _rot_half(x, cos, sin):
    x1, x2 = jnp.split(x, 2, axis=-1)
    return jnp.concatenate([x1 * cos - x2 * sin, x2 * cos + x1 * sin], axis=-1)


def apply_axial_rope(x, tabs):
    cr, sr, cc, sc = tabs
    xr, xc = jnp.split(x.astype(F32), 2, axis=-1)
    return jnp.concatenate([_rot_half(xr, cr, sr), _rot_half(xc, cc, sc)], axis=-1)


def _diff_softmax_mix(q, k, v, lam):
    s = jnp.einsum('bhmqd,bhmkd->bhmqk', q.astype(F32), k.astype(F32)) * (A_QK_DIM ** -0.5)
    p = jax.nn.softmax(s, axis=-1)
    w = p[:, :, 0] - lam * p[:, :, 1]
    return jnp.einsum('bhqk,bhkd->bhqd', w, v.astype(F32))


def diff_attention(t_lat, t_ctx, lam_q1, lam_k1, lam_q2, lam_k2, subln, layer_idx, need_ctx):
    bsz, n = t_lat.shape[0], t_lat.shape[1]
    lam_init = 0.8 - 0.6 * math.exp(-0.3 * layer_idx)
    lam = (jnp.exp(jnp.sum(lam_q1.astype(F32) * lam_k1.astype(F32)))
           - jnp.exp(jnp.sum(lam_q2.astype(F32) * lam_k2.astype(F32))) + lam_init)

    def heads(t):
        m = t.shape[1]
        q, k, v = _split(t, [A_HEADS * 2 * A_QK_DIM, A_HEADS * 2 * A_QK_DIM, A_WIDTH])
        q = q.reshape(bsz, m, A_HEADS, 2, A_QK_DIM).transpose(0, 2, 3, 1, 4)
        k = k.reshape(bsz, m, A_HEADS, 2, A_QK_DIM).transpose(0, 2, 3, 1, 4)
        v = v.reshape(bsz, m, A_HEADS, A_V_DIM).transpose(0, 2, 1, 3)
        return q, k, v

    q_l, k_l, v_l = heads(t_lat)
    q_c, k_c, v_c = heads(t_ctx)
    tabs = axial_rope_tables(n, A_QK_DIM)
    q_l = apply_axial_rope(q_l, tabs)
    k_l = apply_axial_rope(k_l, tabs)
    k_all = jnp.concatenate([k_c.astype(F32), k_l], axis=3)
    v_all = jnp.concatenate([v_c, v_l], axis=2)
    nb = n // Q_BLOCK
    qb = jnp.moveaxis(q_l.reshape(bsz, A_HEADS, 2, nb, Q_BLOCK, A_QK_DIM), 3, 0)
    ob = lax.map(lambda qq: _diff_softmax_mix(qq, k_all, v_all, lam), qb)
    o_l = jnp.moveaxis(ob, 0, 2).reshape(bsz, A_HEADS, n, A_V_DIM)

    def post(o):
        o = rmsnorm(o, subln, eps=1e-5) * (1.0 - lam_init)
        return o.transpose(0, 2, 1, 3).reshape(bsz, o.shape[2], A_WIDTH)

    out_l = post(o_l)
    out_c = post(_diff_softmax_mix(q_c, k_c, v_c, lam)) if need_ctx else None
    return out_l, out_c


def _token_shift_mix(f, mu):
    prev = jnp.pad(f[:, :-1], ((0, 0), (1, 0), (0, 0)))
    nxt = jnp.pad(f[:, 1:], ((0, 0), (0, 1), (0, 0)))
    return f + (0.5 * (prev + nxt) - f) * mu


def _rwkv7_scan(S0, r, w, k, v, kk, a):
    def step(S, inp):
        r_t, w_t, k_t, v_t, kk_t, a_t = inp
        sa = jnp.einsum('bhvk,bhk->bhv', S, kk_t)
        S = (S * w_t[:, :, None, :] - sa[..., None] * (kk_t * a_t)[:, :, None, :]
             + v_t[..., None] * k_t[:, :, None, :])
        return S, jnp.einsum('bhvk,bhk->bhv', S, r_t)
    xs = tuple(jnp.swapaxes(t, 0, 1) for t in (r, w, k, v, kk, a))
    S, ys = lax.scan(step, S0, xs)
    return jnp.swapaxes(ys, 0, 1), S


def rwkv7_mix(t_lat, t_ctx, mu, w0_f, w2_f, w0_b, w2_b, a0, a2, g2, k_k, k_a, r_k, lnx_w, lnx_b, need_ctx):
    def prep(t):
        bsz, n = t.shape[0], t.shape[1]
        f = _token_shift_mix(t, mu).astype(F32)
        r, k, v, wd, ad, gd = _split(f, [B_WIDTH, B_WIDTH, B_WIDTH, B_DECAY_LORA, B_AAA_LORA, B_GATE_LORA])
        hd = lambda u: u.reshape(bsz, n, B_HEADS, B_HEAD)
        a = jax.nn.sigmoid(a0 + ad @ a2)
        tw = jnp.tanh(wd)
        def decay(w0, w2):
            wl = -jax.nn.softplus(-(w0 + tw @ w2)) - 0.5
            return hd(jnp.exp(-jnp.exp(wl)))
        kk = hd(k * k_k)
        kk = kk / jnp.maximum(jnp.sqrt(jnp.sum(kk * kk, axis=-1, keepdims=True)), 1e-12)
        k = k * (1.0 + (a - 1.0) * k_a)
        g = jax.nn.sigmoid(gd) @ g2
        return (hd(r), hd(k), hd(v), kk, hd(a), decay(w0_f, w2_f), decay(w0_b, w2_b), g)

    r_c, k_c, v_c, kk_c, a_c, wf_c, wb_c, g_c = prep(t_ctx)
    r_l, k_l, v_l, kk_l, a_l, wf_l, wb_l, g_l = prep(t_lat)
    S0 = jnp.zeros((t_lat.shape[0], B_HEADS, B_HEAD, B_HEAD), F32)
    yf_c, Sf_c = _rwkv7_scan(S0, r_c, wf_c, k_c, v_c, kk_c, a_c)
    yb_c, Sb_c = _rwkv7_scan(S0, *_flip_seq(r_c, wb_c, k_c, v_c, kk_c, a_c))
    yf_l, _ = _rwkv7_scan(Sf_c, r_l, wf_l, k_l, v_l, kk_l, a_l)
    yb_l, _ = _rwkv7_scan(Sb_c, *_flip_seq(r_l, wb_l, k_l, v_l, kk_l, a_l))

    def post(r, k, v, g, yf, yb):
        bsz, n = r.shape[0], r.shape[1]
        y = yf + jnp.flip(yb, axis=1)
        mean = jnp.mean(y, axis=-1, keepdims=True)
        var = jnp.mean(jnp.square(y - mean), axis=-1, keepdims=True)
        y = ((y - mean) * lax.rsqrt(var + B_GN_EPS)).reshape(bsz, n, B_WIDTH) * lnx_w + lnx_b
        bonus = jnp.sum(r * k * r_k.reshape(B_HEADS, B_HEAD), axis=-1, keepdims=True) * v
        return (y + bonus.reshape(bsz, n, B_WIDTH)) * g

    out_l = post(r_l, k_l, v_l, g_l, yf_l, yb_l)
    out_c = post(r_c, k_c, v_c, g_c, yf_c, yb_c) if need_ctx else None
    return out_l, out_c


def _dwconv_centred(t, w, b):
    y = lax.conv_general_dilated(t, w[:, None, :].astype(t.dtype), window_strides=(1,),
                                 padding=[(C_CONV // 2, C_CONV // 2)],
                                 dimension_numbers=('NWC', 'WIO', 'NWC'),
                                 feature_group_count=t.shape[-1])
    return y + b


def _ssd_chunk_scan(h0, x, dt, la, bm, cm):
    bsz, n = x.shape[0], x.shape[1]
    nc = n // C_CHUNK
    chunks = lambda t: jnp.swapaxes(t.reshape((bsz, nc, C_CHUNK) + t.shape[2:]), 0, 1)
    idx = jnp.arange(C_CHUNK)
    lower = (idx[:, None] >= idx[None, :])[None, :, :, None, None]

    def step(h, inp):
        xc, dtc, lac, bc, cc = inp
        cum = jnp.cumsum(lac, axis=1)
        lmat = jnp.exp(jnp.where(lower, cum[:, :, None] - cum[:, None, :], -jnp.inf))
        cb = jnp.einsum('bign,bjgn->bijg', cc, bc)
        xdt = xc * dtc[..., None]
        y = jnp.einsum('bijgr,bjgrp->bigrp', cb[..., None] * lmat, xdt)
        y = y + jnp.einsum('bign,bgrpn->bigrp', cc, h) * jnp.exp(cum)[..., None]
        w_end = jnp.exp(cum[:, -1:] - cum)
        h = h * jnp.exp(cum[:, -1])[..., None, None] + jnp.einsum('bjgn,bjgrp->bgrpn', bc, xdt * w_end[..., None])
        return h, y

    h, ys = lax.scan(step, h0, tuple(chunks(t) for t in (x, dt, la, bm, cm)))
    return jnp.swapaxes(ys, 0, 1).reshape(x.shape), h


def ssd_mix(t_lat, t_ctx, conv_w, conv_b, dt_bias_f, a_log_f, dt_bias_b, a_log_b, d_skip, norm_g, need_ctx):
    def prep(t):
        bsz, n = t.shape[0], t.shape[1]
        z, xbc, dt_f, dt_b = _split(t, [C_WIDTH, C_CONV_DIM, C_HEADS, C_HEADS])
        xbc = jax.nn.silu(_dwconv_centred(xbc, conv_w, conv_b).astype(F32))
        xs, bm, cm = _split(xbc, [C_WIDTH, C_GROUPS * C_STATE, C_GROUPS * C_STATE])
        xs = xs.reshape(bsz, n, C_GROUPS, C_REP, C_HEAD)
        bm = bm.reshape(bsz, n, C_GROUPS, C_STATE)
        cm = cm.reshape(bsz, n, C_GROUPS, C_STATE)
        def direction(dt_raw, dt_bias, a_log):
            dt = jax.nn.softplus(dt_raw.astype(F32) + dt_bias).reshape(bsz, n, C_GROUPS, C_REP)
            return dt, dt * (-jnp.exp(a_log.astype(F32))).reshape(C_GROUPS, C_REP)
        return z, xs, bm, cm, direction(dt_f, dt_bias_f, a_log_f), direction(dt_b, dt_bias_b, a_log_b)

    z_c, x_c, b_c, c_c, (dtf_c, laf_c), (dtb_c, lab_c) = prep(t_ctx)
    z_l, x_l, b_l, c_l, (dtf_l, laf_l), (dtb_l, lab_l) = prep(t_lat)
    h0 = jnp.zeros((t_lat.shape[0], C_GROUPS, C_REP, C_HEAD, C_STATE), F32)
    yf_c, hf_c = _ssd_chunk_scan(h0, x_c, dtf_c, laf_c, b_c, c_c)
    yb_c, hb_c = _ssd_chunk_scan(h0, *_flip_seq(x_c, dtb_c, lab_c, b_c, c_c))
    yf_l, _ = _ssd_chunk_scan(hf_c, x_l, dtf_l, laf_l, b_l, c_l)
    yb_l, _ = _ssd_chunk_scan(hb_c, *_flip_seq(x_l, dtb_l, lab_l, b_l, c_l))

    def post(z, xs, yf, yb):
        bsz, n = xs.shape[0], xs.shape[1]
        y = yf + jnp.flip(yb, axis=1) + xs * d_skip.astype(F32).reshape(C_GROUPS, C_REP, 1)
        y = y.reshape(bsz, n, C_WIDTH) * jax.nn.silu(z.astype(F32))
        y = rmsnorm(y.reshape(bsz, n, C_GROUPS, C_WIDTH // C_GROUPS), norm_g.reshape(C_GROUPS, C_WIDTH // C_GROUPS))
        return y.reshape(bsz, n, C_WIDTH)

    out_l = post(z_l, x_l, yf_l, yb_l)
    out_c = post(z_c, x_c, yf_c, yb_c) if need_ctx else None
    return out_l, out_c


def _gla_chunk_scan(S0, q, k, v, lg):
    bsz, n = q.shape[0], q.shape[1]
    nc = n // D_CHUNK
    chunks = lambda t: jnp.swapaxes(t.reshape((bsz, nc, D_CHUNK) + t.shape[2:]), 0, 1)
    idx = jnp.arange(D_CHUNK)
    lower = (idx[:, None] >= idx[None, :])[None, :, :, None, None]

    def step(S, inp):
        qc, kc, vc, gc = inp
        cum = jnp.cumsum(gc, axis=1)
        dec = jnp.exp(jnp.where(lower, cum[:, :, None] - cum[:, None, :], -jnp.inf))
        att = jnp.einsum('bihk,bjhk,bijhk->bhij', qc, kc, dec)
        y = jnp.einsum('bhij,bjhv->bihv', att, vc) + jnp.einsum('bihk,bhkv->bihv', qc * jnp.exp(cum), S)
        S = S * jnp.exp(cum[:, -1])[..., None] + jnp.einsum('bjhk,bjhv->bhkv', kc * jnp.exp(cum[:, -1:] - cum), vc)
        return S, y

    S, ys = lax.scan(step, S0, tuple(chunks(t) for t in (q, k, v, lg)))
    return jnp.swapaxes(ys, 0, 1).reshape(v.shape), S


def gla_mix(t_lat, t_ctx, gk_up_f, gk_b_f, gk_up_b, gk_b_b, norm_g, need_ctx):
    def prep(t):
        bsz, n = t.shape[0], t.shape[1]
        q, k, v, g, gd = _split(t.astype(F32), [D_HEADS * D_KEY, D_HEADS * D_KEY, D_WIDTH, D_WIDTH, D_GATE_LORA])
        hk = lambda u: u.reshape(bsz, n, D_HEADS, D_KEY)
        def log_gate(up, b):
            return hk(jax.nn.log_sigmoid(gd @ up + b) / D_GATE_TAU)
        return (hk(q) * (D_KEY ** -0.5), hk(k), v.reshape(bsz, n, D_HEADS, D_VAL), g,
                log_gate(gk_up_f, gk_b_f), log_gate(gk_up_b, gk_b_b))

    q_c, k_c, v_c, g_c, gf_c, gb_c = prep(t_ctx)
    q_l, k_l, v_l, g_l, gf_l, gb_l = prep(t_lat)
    S0 = jnp.zeros((t_lat.shape[0], D_HEADS, D_KEY, D_VAL), F32)
    yf_c, Sf_c = _gla_chunk_scan(S0, q_c, k_c, v_c, gf_c)
    yb_c, Sb_c = _gla_chunk_scan(S0, *_flip_seq(q_c, k_c, v_c, gb_c))
    yf_l, _ = _gla_chunk_scan(Sf_c, q_l, k_l, v_l, gf_l)
    yb_l, _ = _gla_chunk_scan(Sb_c, *_flip_seq(q_l, k_l, v_l, gb_l))

    def post(g, yf, yb):
        bsz, n = g.shape[0], g.shape[1]
        y = rmsnorm(yf + jnp.flip(yb, axis=1), norm_g)
        return y.reshape(bsz, n, D_WIDTH) * jax.nn.silu(g)

    out_l = post(g_l, yf_l, yb_l)
    out_c = post(g_c, yf_c, yb_c) if need_ctx else None
    return out_l, out_c


def even_mixer(p_lat, p_ctx, lam_q1, lam_k1, lam_q2, lam_k2, subln, mu, w0_f, w2_f, w0_b, w2_b,
               a0, a2, g2, k_k, k_a, r_k, lnx_w, lnx_b, layer_idx, need_ctx):
    oa_l, oa_c = diff_attention(p_lat[..., :A_PROJ], p_ctx[..., :A_PROJ],
                                lam_q1, lam_k1, lam_q2, lam_k2, subln, layer_idx, need_ctx)
    ob_l, ob_c = rwkv7_mix(p_lat[..., A_PROJ:], p_ctx[..., A_PROJ:], mu, w0_f, w2_f, w0_b, w2_b,
                           a0, a2, g2, k_k, k_a, r_k, lnx_w, lnx_b, need_ctx)
    o_l = jnp.concatenate([oa_l, ob_l], axis=-1)
    o_c = jnp.concatenate([oa_c, ob_c], axis=-1) if need_ctx else None
    return o_l, o_c


def odd_mixer(p_lat, p_ctx, conv_w, conv_b, dt_bias_f, a_log_f, dt_bias_b, a_log_b, d_skip, ssm_norm,
              gk_up_f, gk_b_f, gk_up_b, gk_b_b, gla_norm, need_ctx):
    oc_l, oc_c = ssd_mix(p_lat[..., :C_PROJ], p_ctx[..., :C_PROJ], conv_w, conv_b, dt_bias_f, a_log_f,
                         dt_bias_b, a_log_b, d_skip, ssm_norm, need_ctx)
    od_l, od_c = gla_mix(p_lat[..., C_PROJ:], p_ctx[..., C_PROJ:], gk_up_f, gk_b_f, gk_up_b, gk_b_b,
                         gla_norm, need_ctx)
    o_l = jnp.concatenate([oc_l, od_l], axis=-1)
    o_c = jnp.concatenate([oc_c, od_c], axis=-1) if need_ctx else None
    return o_l, o_c


def _ada(x, g, shift, scale):
    return rmsnorm(x, g) * (1.0 + scale) + shift


def _sq_relu_mlp(h, w1, w2):
    return jnp.square(jax.nn.relu(h @ w1)) @ w2


def setup_inputs(seed: int = 0) -> dict:
    key = jax.random.key(seed)
    keys = iter(jax.random.split(key, 64))
    D = D_MODEL
    def nrm(shape, scale):
        return jax.random.normal(next(keys), shape, F32) * scale
    def gain(n):
        return 1.0 + 0.05 * jax.random.normal(next(keys), (n,), F32)
    def unif(shape, lo, hi):
        return jax.random.uniform(next(keys), shape, F32, lo, hi)
    def dt_bias(n):
        dt = jnp.exp(unif((n,), math.log(1e-3), math.log(1e-1)))
        return dt + jnp.log(-jnp.expm1(-dt))
    inp = {}
    inp['x'] = nrm((BATCH, SEQ, D), 1.0)
    inp['c'] = nrm((BATCH, D), 1.0)
    inp['ctx'] = nrm((BATCH, CTX_LEN, D), 1.0)
    inp['c_ctx'] = nrm((D,), 1.0)
    inp['l0_mod_w'] = nrm((D, 6 * D), 0.5 * D ** -0.5)
    inp['l0_mod_b'] = nrm((6 * D,), 0.02)
    inp['l0_norm1'] = gain(D)
    inp['l0_norm2'] = gain(D)
    inp['l0_w_in'] = nrm((D, EVEN_IN), D ** -0.5)
    inp['l0_w_out'] = nrm((MIX_WIDTH, D), MIX_WIDTH ** -0.5)
    inp['l0_mlp_w1'] = nrm((D, MLP_HIDDEN), D ** -0.5)
    inp['l0_mlp_w2'] = nrm((MLP_HIDDEN, D), MLP_HIDDEN ** -0.5)
    inp['l0_lam_q1'] = nrm((A_QK_DIM,), 0.1)
    inp['l0_lam_k1'] = nrm((A_QK_DIM,), 0.1)
    inp['l0_lam_q2'] = nrm((A_QK_DIM,), 0.1)
    inp['l0_lam_k2'] = nrm((A_QK_DIM,), 0.1)
    inp['l0_subln'] = gain(A_V_DIM)
    inp['l0_mu'] = unif((B_PROJ,), 0.0, 1.0)
    inp['l0_w0_f'] = unif((B_WIDTH,), -6.0, -1.0)
    inp['l0_w2_f'] = nrm((B_DECAY_LORA, B_WIDTH), 0.1 * B_DECAY_LORA ** -0.5)
    inp['l0_w0_b'] = unif((B_WIDTH,), -6.0, -1.0)
    inp['l0_w2_b'] = nrm((B_DECAY_LORA, B_WIDTH), 0.1 * B_DECAY_LORA ** -0.5)
    inp['l0_a0'] = nrm((B_WIDTH,), 0.1)
    inp['l0_a2'] = nrm((B_AAA_LORA, B_WIDTH), B_AAA_LORA ** -0.5)
    inp['l0_g2'] = nrm((B_GATE_LORA, B_WIDTH), B_GATE_LORA ** -0.5)
    inp['l0_k_k'] = 0.85 + nrm((B_WIDTH,), 0.05)
    inp['l0_k_a'] = gain(B_WIDTH)
    inp['l0_r_k'] = nrm((B_WIDTH,), 0.1)
    inp['l0_lnx_w'] = gain(B_WIDTH)
    inp['l0_lnx_b'] = nrm((B_WIDTH,), 0.02)
    inp['l1_mod_w'] = nrm((D, 6 * D), 0.5 * D ** -0.5)
    inp['l1_mod_b'] = nrm((6 * D,), 0.02)
    inp['l1_norm1'] = gain(D)
    inp['l1_norm2'] = gain(D)
    inp['l1_w_in'] = nrm((D, ODD_IN), D ** -0.5)
    inp['l1_w_out'] = nrm((MIX_WIDTH, D), MIX_WIDTH ** -0.5)
    inp['l1_mlp_w1'] = nrm((D, MLP_HIDDEN), D ** -0.5)
    inp['l1_mlp_w2'] = nrm((MLP_HIDDEN, D), MLP_HIDDEN ** -0.5)
    inp['l1_conv_w'] = nrm((C_CONV, C_CONV_DIM), C_CONV ** -0.5)
    inp['l1_conv_b'] = nrm((C_CONV_DIM,), 0.02)
    inp['l1_dt_bias_f'] = dt_bias(C_HEADS)
    inp['l1_a_log_f'] = jnp.log(unif((C_HEADS,), 1.0, 16.0))
    inp['l1_dt_bias_b'] = dt_bias(C_HEADS)
    inp['l1_a_log_b'] = jnp.log(unif((C_HEADS,), 1.0, 16.0))
    inp['l1_d_skip'] = gain(C_HEADS)
    inp['l1_ssm_norm'] = gain(C_WIDTH)
    inp['l1_gk_up_f'] = nrm((D_GATE_LORA, D_HEADS * D_KEY), D_GATE_LORA ** -0.5)
    inp['l1_gk_b_f'] = nrm((D_HEADS * D_KEY,), 0.1)
    inp['l1_gk_up_b'] = nrm((D_GATE_LORA, D_HEADS * D_KEY), D_GATE_LORA ** -0.5)
    inp['l1_gk_b_b'] = nrm((D_HEADS * D_KEY,), 0.1)
    inp['l1_gla_norm'] = gain(D_VAL)
    inp['final_norm'] = gain(D)
    return inp


def reference(x, c, ctx, c_ctx,
              l0_mod_w, l0_mod_b, l0_norm1, l0_norm2, l0_w_in, l0_w_out, l0_mlp_w1, l0_mlp_w2,
              l0_lam_q1, l0_lam_k1, l0_lam_q2, l0_lam_k2, l0_subln,
              l0_mu, l0_w0_f, l0_w2_f, l0_w0_b, l0_w2_b, l0_a0, l0_a2, l0_g2, l0_k_k, l0_k_a, l0_r_k,
              l0_lnx_w, l0_lnx_b,
              l1_mod_w, l1_mod_b, l1_norm1, l1_norm2, l1_w_in, l1_w_out, l1_mlp_w1, l1_mlp_w2,
              l1_conv_w, l1_conv_b, l1_dt_bias_f, l1_a_log_f, l1_dt_bias_b, l1_a_log_b, l1_d_skip, l1_ssm_norm,
              l1_gk_up_f, l1_gk_b_f, l1_gk_up_b, l1_gk_b_b, l1_gla_norm,
              final_norm):
    shared = [
        (l0_mod_w, l0_mod_b, l0_norm1, l0_norm2, l0_w_in, l0_w_out, l0_mlp_w1, l0_mlp_w2),
        (l1_mod_w, l1_mod_b, l1_norm1, l1_norm2, l1_w_in, l1_w_out, l1_mlp_w1, l1_mlp_w2),
    ]
    for i in range(DEPTH):
        mod_w, mod_b, norm1, norm2, w_in, w_out, mlp_w1, mlp_w2 = shared[i]
        need_ctx = i < DEPTH - 1
        m_l = (jax.nn.silu(c) @ mod_w + mod_b)[:, None, :]
        m_c = jax.nn.silu(c_ctx) @ mod_w + mod_b
        sh1_l, sc1_l, g1_l, sh2_l, sc2_l, g2_l = jnp.split(m_l, 6, axis=-1)
        sh1_c, sc1_c, g1_c, sh2_c, sc2_c, g2_c = jnp.split(m_c, 6, axis=-1)
        p_lat = _ada(x, norm1, sh1_l, sc1_l) @ w_in
        p_ctx = _ada(ctx, norm1, sh1_c, sc1_c) @ w_in
        if i % 2 == 0:
            o_l, o_c = even_mixer(p_lat, p_ctx, l0_lam_q1, l0_lam_k1, l0_lam_q2, l0_lam_k2, l0_subln,
                                  l0_mu, l0_w0_f, l0_w2_f, l0_w0_b, l0_w2_b, l0_a0, l0_a2, l0_g2,
                                  l0_k_k, l0_k_a, l0_r_k, l0_lnx_w, l0_lnx_b, i, need_ctx)
        else:
            o_l, o_c = odd_mixer(p_lat, p_ctx, l1_conv_w, l1_conv_b, l1_dt_bias_f, l1_a_log_f,
                                 l1_dt_bias_b, l1_a_log_b, l1_d_skip, l1_ssm_norm,
                                 l1_gk_up_f, l1_gk_b_f, l1_gk_up_b, l1_gk_b_b, l1_gla_norm, need_ctx)
        x = x + g1_l * (o_l.astype(x.dtype) @ w_out)
        x = x + g2_l * _sq_relu_mlp(_ada(x, norm2, sh2_l, sc2_l), mlp_w1, mlp_w2)
        if need_ctx:
            ctx = ctx + g1_c * (o_c.astype(ctx.dtype) @ w_out)
            ctx = ctx + g2_c * _sq_relu_mlp(_ada(ctx, norm2, sh2_c, sc2_c), mlp_w1, mlp_w2)
    return rmsnorm(x, final_norm)
```

```cpp
#include <hip/hip_runtime.h>
#include <hip/hip_cooperative_groups.h>
#include <cstdio>
namespace cg = cooperative_groups;

#ifndef MODE_COOP
#define MODE_COOP 0
#endif

typedef unsigned short bf;
typedef __attribute__((ext_vector_type(8))) short bf16x8;
typedef __attribute__((ext_vector_type(4))) float f32x4;
typedef __attribute__((ext_vector_type(4))) int i32x4;

constexpr int NT = 512;
constexpr int Dm = 1024, NBAT = 8, SEQ = 4096, CTX = 256, TA = 4352, RT = NBAT * TA;

constexpr size_t OFF_MOD = 0;
constexpr size_t OFF_CNT = 450000;
constexpr size_t OFF_WT = 524288;
constexpr size_t WT_IN = 0, WT_OUT = (size_t)3328 * 1024, WT_W1 = WT_OUT + (size_t)1024 * 1024, WT_W2 = WT_W1 + (size_t)4096 * 1024;
constexpr size_t OFF_CTXX = OFF_WT + (size_t)12544 * 1024 * 2;
constexpr size_t OFF_HO = OFF_CTXX + (size_t)2048 * 1024 * 4;
constexpr size_t OFF_BIG = OFF_HO + (size_t)RT * 1024 * 2;
constexpr size_t SZ512 = (size_t)RT * 512 * 2;
constexpr size_t OFF_QKV = OFF_BIG;
constexpr size_t OFF_PREP = OFF_QKV + (size_t)RT * 1536 * 2;
constexpr size_t OFF_G = OFF_PREP + 7 * SZ512;
constexpr size_t OFF_BONUS = OFF_G + SZ512;
constexpr size_t OFF_HID = OFF_BIG;
constexpr size_t OFF_P1C = OFF_BIG;
constexpr size_t OFF_XRAW = OFF_P1C + (size_t)RT * 2080 * 2;
constexpr size_t OFF_DTRAW = OFF_XRAW + (size_t)RT * 1024 * 2;
constexpr size_t OFF_XBC = OFF_DTRAW + (size_t)RT * 16 * 4;
constexpr size_t OFF_GY = OFF_XBC + (size_t)RT * 1024 * 2;

struct P {
  const float* in[52];
  float* out;
  char* ws;
};

__device__ __forceinline__ bf f2bf(float f) {
  unsigned u = __float_as_uint(f);
  u += 0x7fffu + ((u >> 16) & 1u);
  return (bf)(u >> 16);
}
__device__ __forceinline__ float bf2f(bf h) { return __uint_as_float(((unsigned)h) << 16); }
__device__ __forceinline__ float bflo(unsigned u) { return __uint_as_float(u << 16); }
__device__ __forceinline__ float bfhi(unsigned u) { return __uint_as_float(u & 0xffff0000u); }
__device__ __forceinline__ unsigned pack2(float a, float b) { return (unsigned)f2bf(a) | ((unsigned)f2bf(b) << 16); }
__device__ __forceinline__ float sigmoidf_(float x) { return 1.f / (1.f + expf(-x)); }
__device__ __forceinline__ float softplusf_(float x) { return x > 20.f ? x : log1pf(expf(x)); }
__device__ __forceinline__ float siluf_(float x) { return x / (1.f + expf(-x)); }
__device__ __forceinline__ float wave_sum(float v) {
#pragma unroll
  for (int o = 32; o >= 1; o >>= 1) v += __shfl_xor(v, o);
  return v;
}
template <int C>
__device__ __forceinline__ float dppf(float x) {
  return __builtin_bit_cast(float, __builtin_amdgcn_update_dpp(0, __builtin_bit_cast(int, x), C, 0xF, 0xF, false));
}
__device__ __forceinline__ float red16(float x) {
  x += dppf<0xB1>(x);
  x += dppf<0x4E>(x);
  x += dppf<0x141>(x);
  x += dppf<0x128>(x);
  return x;
}
__device__ __forceinline__ float* xrow(const P& p, int R) {
  int b = R / TA, a = R - b * TA;
  if (a < CTX) return (float*)(p.ws + OFF_CTXX) + (size_t)(b * CTX + a) * Dm;
  return p.out + (size_t)(b * SEQ + a - CTX) * Dm;
}
__device__ __forceinline__ const float* inrow(const P& p, int R) {
  int b = R / TA, a = R - b * TA;
  if (a < CTX) return p.in[2] + (size_t)(b * CTX + a) * Dm;
  return p.in[0] + (size_t)(b * SEQ + a - CTX) * Dm;
}
__device__ __forceinline__ int mrow(int R) {
  int b = R / TA, a = R - b * TA;
  return a < CTX ? 8 : b;
}

__device__ __forceinline__ void ph_mod(const P& p, char* smem) {
  float* sc = (float*)smem;
  float* red = sc + 9 * 1024;
  const int tid = threadIdx.x;
  bool loaded = false;
  for (int unit = blockIdx.x; unit < 2 * 192; unit += gridDim.x) {
    int layer = unit / 192, cch = unit - layer * 192;
    const float* W = p.in[layer ? 30 : 4];
    const float* bias = p.in[layer ? 31 : 5];
    __syncthreads();
    if (!loaded) {
      for (int i = tid; i < 9 * 1024; i += NT) {
        int r = i >> 10, k = i & 1023;
        float v = (r < 8) ? p.in[1][r * 1024 + k] : p.in[3][k];
        sc[i] = siluf_(v);
      }
      loaded = true;
      __syncthreads();
    }
    int cl = tid & 31, kg = tid >> 5;
    int col = cch * 32 + cl;
    float acc[9];
#pragma unroll
    for (int r = 0; r < 9; ++r) acc[r] = 0.f;
    for (int k = kg * 64; k < kg * 64 + 64; ++k) {
      float w = W[(size_t)k * 6144 + col];
#pragma unroll
      for (int r = 0; r < 9; ++r) acc[r] += sc[r * 1024 + k] * w;
    }
#pragma unroll
    for (int r = 0; r < 9; ++r) red[(kg * 9 + r) * 32 + cl] = acc[r];
    __syncthreads();
    if (tid < 288) {
      int r = tid >> 5, c = tid & 31;
      float s = 0.f;
#pragma unroll
      for (int g = 0; g < 16; ++g) s += red[(g * 9 + r) * 32 + c];
      ((float*)(p.ws + OFF_MOD))[(size_t)(layer * 9 + r) * 6144 + cch * 32 + c] = s + bias[cch * 32 + c];
    }
  }
}

__device__ __forceinline__ void transpose_one(const float* W, bf* Wt, int K, int N, int Npad, int vb, int nvb, char* smem) {
  float* tile = (float*)smem;
  const int tid = threadIdx.x;
  int ntn = Npad / 64, ntk = K / 64;
  for (int t = vb; t < ntn * ntk; t += nvb) {
    int tn = t / ntk, tk = t - tn * ntk;
    int n0 = tn * 64, k0 = tk * 64;
    __syncthreads();
#pragma unroll
    for (int i = 0; i < 8; ++i) {
      int kk = (tid >> 6) + 8 * i, nn = tid & 63;
      float v = (n0 + nn < N) ? W[(size_t)(k0 + kk) * N + n0 + nn] : 0.f;
      tile[kk * 65 + nn] = v;
    }
    __syncthreads();
#pragma unroll
    for (int i = 0; i < 8; ++i) {
      int nn = (tid >> 6) + 8 * i, kk = tid & 63;
      Wt[(size_t)(n0 + nn) * K + k0 + kk] = f2bf(tile[kk * 65 + nn]);
    }
  }
}
__device__ __forceinline__ void ph_wt(const P& p, int layer, char* smem) {
  bf* WT = (bf*)(p.ws + OFF_WT);
  int base = layer ? 34 : 8;
  int nin = layer ? 3104 : 3328, ninp = layer ? 3200 : 3328;
  int nb = gridDim.x, b = blockIdx.x;
  for (int mtx = 0; mtx < 4; ++mtx) {
    const float* W = p.in[base + mtx];
    bf* dst = WT + (mtx == 0 ? WT_IN : mtx == 1 ? WT_OUT : mtx == 2 ? WT_W1 : WT_W2);
    int K = mtx == 3 ? 4096 : 1024;
    int N = mtx == 0 ? nin : mtx == 2 ? 4096 : 1024;
    int Np = mtx == 0 ? ninp : N;
    transpose_one(W, dst, K, N, Np, (b + 64 * mtx) % nb, nb, smem);
  }
}

__device__ __forceinline__ void ph_ada(const P& p, int layer, int which, int useInput, int latonly) {
  const int lane = threadIdx.x & 63, wave = threadIdx.x >> 6;
  const float* ng = p.in[(layer ? 32 : 6) + which];
  const float* mod = (const float*)(p.ws + OFF_MOD);
  bf* H = (bf*)(p.ws + OFF_HO);
  for (int R = blockIdx.x * 8 + wave; R < RT; R += gridDim.x * 8) {
    int b = R / TA, a = R - b * TA;
    if (latonly && a < CTX) continue;
    const float* src = useInput ? inrow(p, R) : xrow(p, R);
    float4 v[4];
    float ss = 0.f;
#pragma unroll
    for (int i = 0; i < 4; ++i) {
      v[i] = *(const float4*)(src + i * 256 + lane * 4);
      ss += v[i].x * v[i].x + v[i].y * v[i].y + v[i].z * v[i].z + v[i].w * v[i].w;
    }
    ss = wave_sum(ss);
    float rs = rsqrtf(ss * (1.f / 1024.f) + 1e-6f);
    int mr = a < CTX ? 8 : b;
    const float* sh = mod + (size_t)(layer * 9 + mr) * 6144 + (which * 3 + 0) * 1024;
    const float* scl = mod + (size_t)(layer * 9 + mr) * 6144 + (which * 3 + 1) * 1024;
#pragma unroll
    for (int i = 0; i < 4; ++i) {
      int k = i * 256 + lane * 4;
      float4 g = *(const float4*)(ng + k);
      float4 s4 = *(const float4*)(sh + k);
      float4 c4 = *(const float4*)(scl + k);
      float o0 = v[i].x * rs * g.x * (1.f + c4.x) + s4.x;
      float o1 = v[i].y * rs * g.y * (1.f + c4.y) + s4.y;
      float o2 = v[i].z * rs * g.z * (1.f + c4.z) + s4.z;
      float o3 = v[i].w * rs * g.w * (1.f + c4.w) + s4.w;
      uint2 o;
      o.x = pack2(o0, o1);
      o.y = pack2(o2, o3);
      *(uint2*)(H + (size_t)R * 1024 + k) = o;
    }
  }
}

struct GArgs {
  const bf* A;
  int lda;
  const bf* Bt;
  int K;
  int ntn;
  int epi;
  int layer;
  int latonly;
};

__device__ __forceinline__ void gemm_store(const P& p, const GArgs& g, int m, int n, float v) {
  switch (g.epi) {
    case 0: {
      if (n < 1536) ((bf*)(p.ws + OFF_QKV))[(size_t)m * 1536 + n] = f2bf(v);
      else ((bf*)p.out)[(size_t)m * 1792 + (n - 1536)] = f2bf(v);
    } break;
    case 1: {
      if (n < 512) ((bf*)(p.ws + OFF_P1C))[(size_t)m * 2080 + n] = f2bf(v);
      else if (n < 1536) ((bf*)(p.ws + OFF_XRAW))[(size_t)m * 1024 + (n - 512)] = f2bf(v);
      else if (n < 1552) ((float*)(p.ws + OFF_DTRAW))[(size_t)m * 16 + (n - 1536)] = v;
      else if (n < 3104) ((bf*)(p.ws + OFF_P1C))[(size_t)m * 2080 + (n - 1024)] = f2bf(v);
    } break;
    case 2: {
      const float* mod = (const float*)(p.ws + OFF_MOD);
      float gate = mod[(size_t)(g.layer * 9 + mrow(m)) * 6144 + 2 * 1024 + n];
      float* dst = xrow(p, m) + n;
      float base = g.layer == 0 ? inrow(p, m)[n] : *dst;
      *dst = base + gate * v;
    } break;
    case 3: {
      float r = v > 0.f ? v : 0.f;
      ((bf*)(p.ws + OFF_HID))[(size_t)m * 4096 + n] = f2bf(r * r);
    } break;
    default: {
      const float* mod = (const float*)(p.ws + OFF_MOD);
      float gate = mod[(size_t)(g.layer * 9 + mrow(m)) * 6144 + 5 * 1024 + n];
      float* dst = xrow(p, m) + n;
      *dst = *dst + gate * v;
    } break;
  }
}

__device__ __forceinline__ void ph_gemm(const P& p, const GArgs& g, char* smem) {
  bf* As = (bf*)smem;
  bf* Bs = As + 256 * 72;
  const int tid = threadIdx.x, lane = tid & 63, wave = tid >> 6;
  const int wm = wave >> 1, wn = wave & 1;
  const int l15 = lane & 15, lg = lane >> 4;
  const int nmt = g.latonly ? 128 : 136;
  const int ntiles = nmt * g.ntn;
  const int nk = g.K / 64;
  for (int t = blockIdx.x; t < ntiles; t += gridDim.x) {
    int mt = t / g.ntn, nt = t - mt * g.ntn;
    if (g.latonly) mt = (mt >> 4) * 17 + 1 + (mt & 15);
    const int m0 = mt * 256, n0 = nt * 128;
    f32x4 acc[4][4];
#pragma unroll
    for (int i = 0; i < 4; ++i)
#pragma unroll
      for (int j = 0; j < 4; ++j) acc[i][j] = (f32x4){0.f, 0.f, 0.f, 0.f};
    const int srow = tid >> 3, skc = (tid & 7) * 8;
    const bf* ap = g.A + (size_t)(m0 + srow) * g.lda + skc;
    const bf* bp = g.Bt + (size_t)(n0 + srow) * g.K + skc;
    const size_t astep = (size_t)64 * g.lda, bstep = (size_t)64 * g.K;
    uint4 ra0 = *(const uint4*)(ap), ra1 = *(const uint4*)(ap + astep), ra2 = *(const uint4*)(ap + 2 * astep), ra3 = *(const uint4*)(ap + 3 * astep);
    uint4 rb0 = *(const uint4*)(bp), rb1 = *(const uint4*)(bp + bstep);
    for (int kt = 0; kt < nk; ++kt) {
      __syncthreads();
      *(uint4*)(As + (srow)*72 + skc) = ra0;
      *(uint4*)(As + (srow + 64) * 72 + skc) = ra1;
      *(uint4*)(As + (srow + 128) * 72 + skc) = ra2;
      *(uint4*)(As + (srow + 192) * 72 + skc) = ra3;
      *(uint4*)(Bs + (srow)*72 + skc) = rb0;
      *(uint4*)(Bs + (srow + 64) * 72 + skc) = rb1;
      __syncthreads();
      if (kt + 1 < nk) {
        const bf* ap2 = ap + (kt + 1) * 64;
        const bf* bp2 = bp + (kt + 1) * 64;
        ra0 = *(const uint4*)(ap2); ra1 = *(const uint4*)(ap2 + astep); ra2 = *(const uint4*)(ap2 + 2 * astep); ra3 = *(const uint4*)(ap2 + 3 * astep);
        rb0 = *(const uint4*)(bp2); rb1 = *(const uint4*)(bp2 + bstep);
      }
#pragma unroll
      for (int ks = 0; ks < 2; ++ks) {
        bf16x8 af[4], bfr[4];
#pragma unroll
        for (int i = 0; i < 4; ++i) af[i] = *(const bf16x8*)(As + (wm * 64 + i * 16 + l15) * 72 + ks * 32 + lg * 8);
#pragma unroll
        for (int j = 0; j < 4; ++j) bfr[j] = *(const bf16x8*)(Bs + (wn * 64 + j * 16 + l15) * 72 + ks * 32 + lg * 8);
#pragma unroll
        for (int i = 0; i < 4; ++i)
#pragma unroll
          for (int j = 0; j < 4; ++j) acc[i][j] = __builtin_amdgcn_mfma_f32_16x16x32_bf16(af[i], bfr[j], acc[i][j], 0, 0, 0);
      }
    }
#pragma unroll
    for (int i = 0; i < 4; ++i)
#pragma unroll
      for (int r = 0; r < 4; ++r) {
        int m = m0 + wm * 64 + i * 16 + lg * 4 + r;
#pragma unroll
        for (int j = 0; j < 4; ++j) {
          int n = n0 + wn * 64 + j * 16 + l15;
          gemm_store(p, g, m, n, acc[i][j][r]);
        }
      }
  }
}

__device__ __forceinline__ void ph_rope(const P& p, char* smem) {
  float* tcos = (float*)smem;
  float* tsin = tcos + 1024;
  const int tid = threadIdx.x;
  __syncthreads();
  for (int i = tid; i < 1024; i += NT) {
    int c = i >> 4, f = i & 15;
    float inv = powf(10000.f, -(float)f / 16.f);
    float ang = (float)c * inv;
    float sn, cs;
    sincosf(ang, &sn, &cs);
    tcos[i] = cs;
    tsin[i] = sn;
  }
  __syncthreads();
  bf* QKV = (bf*)(p.ws + OFF_QKV);
  for (size_t it = (size_t)blockIdx.x * NT + tid; it < (size_t)RT * 512; it += (size_t)gridDim.x * NT) {
    int R = (int)(it >> 9);
    int w = (int)(it & 511);
    int vec = w >> 5, half = (w >> 4) & 1, f = w & 15;
    int b = R / TA, a = R - b * TA;
    bool isq = vec < 8;
    size_t off = (size_t)R * 1536 + (size_t)vec * 64 + half * 32 + f;
    float x1 = bf2f(QKV[off]), x2 = bf2f(QKV[off + 16]);
    if (a >= CTX) {
      int pos = a - CTX;
      int cidx = half == 0 ? (pos >> 6) : (pos & 63);
      float cs = tcos[cidx * 16 + f], sn = tsin[cidx * 16 + f];
      float y1 = x1 * cs - x2 * sn, y2 = x2 * cs + x1 * sn;
      x1 = y1;
      x2 = y2;
    }
    if (isq) {
      x1 *= 0.125f;
      x2 *= 0.125f;
    }
    if (isq || a >= CTX) {
      QKV[off] = f2bf(x1);
      QKV[off + 16] = f2bf(x2);
    }
  }
}

__device__ __forceinline__ float shiftmix(const bf* PB, const float* mu, int R, int a, int col) {
  int lo = a < CTX ? 0 : CTX, hi = a < CTX ? CTX : TA;
  float t = bf2f(PB[(size_t)R * 1792 + col]);
  float pv = a > lo ? bf2f(PB[(size_t)(R - 1) * 1792 + col]) : 0.f;
  float nx = a + 1 < hi ? bf2f(PB[(size_t)(R + 1) * 1792 + col]) : 0.f;
  return t + (0.5f * (pv + nx) - t) * mu[col];
}
__device__ __forceinline__ void ph_rwkv_prep(const P& p, char* smem) {
  float* lin = (float*)smem;
  const int tid = threadIdx.x, lane = tid & 63, wave = tid >> 6;
  const bf* PB = (const bf*)p.out;
  const float* mu = p.in[17];
  const float *w0f = p.in[18], *w2f = p.in[19], *w0b = p.in[20], *w2b = p.in[21], *a0 = p.in[22], *a2 = p.in[23], *g2 = p.in[24];
  const float *k_k = p.in[25], *k_a = p.in[26], *r_k = p.in[27];
  bf* PR = (bf*)(p.ws + OFF_PREP);
  bf* PK = PR + (size_t)RT * 512;
  bf* PV = PK + (size_t)RT * 512;
  bf* PKK = PV + (size_t)RT * 512;
  bf* PKA = PKK + (size_t)RT * 512;
  bf* PLF = PKA + (size_t)RT * 512;
  bf* PLB = PLF + (size_t)RT * 512;
  bf* G = (bf*)(p.ws + OFF_G);
  float* BON = (float*)(p.ws + OFF_BONUS);
  const int c = tid;
  for (int unit = blockIdx.x; unit < RT / 16; unit += gridDim.x) {
    int R0 = unit * 16;
    int b = R0 / TA, a00 = R0 - b * TA;
    __syncthreads();
#pragma unroll
    for (int i = 0; i < 8; ++i) {
      int idx = tid + NT * i;
      int tok = idx >> 8, j = idx & 255;
      float f = shiftmix(PB, mu, R0 + tok, a00 + tok, 1536 + j);
      float val = j < 64 ? tanhf(f) : (j < 128 ? f : sigmoidf_(f));
      lin[j * 16 + tok] = val;
    }
    __syncthreads();
    float aa[16], wf[16], wb[16], gg[16];
#pragma unroll
    for (int t = 0; t < 16; ++t) { aa[t] = 0.f; wf[t] = 0.f; wb[t] = 0.f; gg[t] = 0.f; }
    for (int j = 0; j < 64; ++j) {
      float x2f = w2f[j * 512 + c], x2b = w2b[j * 512 + c];
      const float4* lp = (const float4*)(lin + j * 16);
#pragma unroll
      for (int q = 0; q < 4; ++q) {
        float4 t4 = lp[q];
        wf[q * 4 + 0] += t4.x * x2f; wf[q * 4 + 1] += t4.y * x2f; wf[q * 4 + 2] += t4.z * x2f; wf[q * 4 + 3] += t4.w * x2f;
        wb[q * 4 + 0] += t4.x * x2b; wb[q * 4 + 1] += t4.y * x2b; wb[q * 4 + 2] += t4.z * x2b; wb[q * 4 + 3] += t4.w * x2b;
      }
    }
    for (int j = 0; j < 64; ++j) {
      float xa = a2[j * 512 + c];
      const float4* lp = (const float4*)(lin + (64 + j) * 16);
#pragma unroll
      for (int q = 0; q < 4; ++q) {
        float4 t4 = lp[q];
        aa[q * 4 + 0] += t4.x * xa; aa[q * 4 + 1] += t4.y * xa; aa[q * 4 + 2] += t4.z * xa; aa[q * 4 + 3] += t4.w * xa;
      }
    }
    for (int j = 0; j < 128; ++j) {
      float xg = g2[j * 512 + c];
      const float4* lp = (const float4*)(lin + (128 + j) * 16);
#pragma unroll
      for (int q = 0; q < 4; ++q) {
        float4 t4 = lp[q];
        gg[q * 4 + 0] += t4.x * xg; gg[q * 4 + 1] += t4.y * xg; gg[q * 4 + 2] += t4.z * xg; gg[q * 4 + 3] += t4.w * xg;
      }
    }
    const float vw0f = w0f[c], vw0b = w0b[c], va0 = a0[c], vkk = k_k[c], vka = k_a[c], vrk = r_k[c];
#pragma unroll
    for (int t = 0; t < 16; ++t) {
      int R = R0 + t, a = a00 + t;
      float fr = shiftmix(PB, mu, R, a, c);
      float fk = shiftmix(PB, mu, R, a, 512 + c);
      float fv = shiftmix(PB, mu, R, a, 1024 + c);
      float av = sigmoidf_(va0 + aa[t]);
      float lwf = -expf(-softplusf_(-(vw0f + wf[t])) - 0.5f);
      float lwb = -expf(-softplusf_(-(vw0b + wb[t])) - 0.5f);
      float kk = fk * vkk;
      float n2 = wave_sum(kk * kk);
      kk = kk / fmaxf(sqrtf(n2), 1e-12f);
      float kmod = fk * (1.f + (av - 1.f) * vka);
      float bon = wave_sum(fr * kmod * vrk);
      size_t o = (size_t)R * 512 + c;
      PR[o] = f2bf(fr);
      PK[o] = f2bf(kmod);
      PV[o] = f2bf(fv);
      PKK[o] = f2bf(kk);
      PKA[o] = f2bf(kk * av);
      PLF[o] = f2bf(lwf);
      PLB[o] = f2bf(lwb);
      G[o] = f2bf(gg[t]);
      if (lane == 0) BON[(size_t)R * 8 + wave] = bon;
    }
  }
}

__device__ __forceinline__ int scan_row(int b, int dir, int s) {
  int a = dir ? (s < CTX ? CTX - 1 - s : TA + CTX - 1 - s) : s;
  return b * TA + a;
}

__device__ __forceinline__ void rwkv_chain(const P& p, int chain, char* smem) {
  const int dir = chain & 1, h = (chain >> 1) & 7, b = chain >> 4;
  float* cR = (float*)smem;
  float* cW = cR + 2048;
  float* cK = cW + 2048;
  float* cKK = cK + 2048;
  float* cKA = cKK + 2048;
  float* cV = cKA + 2048;
  float* yb = cV + 2048;
  const int tid = threadIdx.x, lane = tid & 63, wave = tid >> 6;
  const int l15 = lane & 15, lg = lane >> 4;
  const bf* PR = (const bf*)(p.ws + OFF_PREP);
  const bf* PK = PR + (size_t)RT * 512;
  const bf* PV = PK + (size_t)RT * 512;
  const bf* PKK = PV + (size_t)RT * 512;
  const bf* PKA = PKK + (size_t)RT * 512;
  const bf* PLW = PKA + (size_t)RT * 512 + (size_t)dir * RT * 512;
  bf* Y = (bf*)p.out + (size_t)dir * RT * 512;
  const int st = tid >> 4, c4 = (tid & 15) * 4;
  const int r0 = wave * 8 + lg * 2;
  float s0[4], s1[4];
#pragma unroll
  for (int j = 0; j < 4; ++j) { s0[j] = 0.f; s1[j] = 0.f; }
  uint2 gR, gW, gK, gV, gKK, gKA;
  {
    size_t o = (size_t)scan_row(b, dir, st) * 512 + h * 64 + c4;
    gR = *(const uint2*)(PR + o); gW = *(const uint2*)(PLW + o); gK = *(const uint2*)(PK + o);
    gV = *(const uint2*)(PV + o); gKK = *(const uint2*)(PKK + o); gKA = *(const uint2*)(PKA + o);
  }
  const int NCH = TA / 32;
  for (int ch = 0; ch <= NCH; ++ch) {
    __syncthreads();
    if (ch > 0) {
      float4 y4 = *(const float4*)(yb + st * 64 + c4);
      uint2 o2;
      o2.x = pack2(y4.x, y4.y);
      o2.y = pack2(y4.z, y4.w);
      *(uint2*)(Y + (size_t)scan_row(b, dir, (ch - 1) * 32 + st) * 512 + h * 64 + c4) = o2;
    }
    if (ch == NCH) break;
    {
      int o = st * 64 + c4;
      *(float4*)(cR + o) = make_float4(bflo(gR.x), bfhi(gR.x), bflo(gR.y), bfhi(gR.y));
      *(float4*)(cW + o) = make_float4(expf(bflo(gW.x)), expf(bfhi(gW.x)), expf(bflo(gW.y)), expf(bfhi(gW.y)));
      *(float4*)(cK + o) = make_float4(bflo(gK.x), bfhi(gK.x), bflo(gK.y), bfhi(gK.y));
      *(float4*)(cV + o) = make_float4(bflo(gV.x), bfhi(gV.x), bflo(gV.y), bfhi(gV.y));
      *(float4*)(cKK + o) = make_float4(bflo(gKK.x), bfhi(gKK.x), bflo(gKK.y), bfhi(gKK.y));
      *(float4*)(cKA + o) = make_float4(bflo(gKA.x), bfhi(gKA.x), bflo(gKA.y), bfhi(gKA.y));
    }
    __syncthreads();
    if (ch + 1 < NCH) {
      size_t o = (size_t)scan_row(b, dir, (ch + 1) * 32 + st) * 512 + h * 64 + c4;
      gR = *(const uint2*)(PR + o); gW = *(const uint2*)(PLW + o); gK = *(const uint2*)(PK + o);
      gV = *(const uint2*)(PV + o); gKK = *(const uint2*)(PKK + o); gKA = *(const uint2*)(PKA + o);
    }
#pragma unroll 4
    for (int t = 0; t < 32; ++t) {
      float4 kk4 = *(const float4*)(cKK + t * 64 + l15 * 4);
      float4 w4 = *(const float4*)(cW + t * 64 + l15 * 4);
      float4 k4 = *(const float4*)(cK + t * 64 + l15 * 4);
      float4 ka4 = *(const float4*)(cKA + t * 64 + l15 * 4);
      float4 r4 = *(const float4*)(cR + t * 64 + l15 * 4);
      float2 v2 = *(const float2*)(cV + t * 64 + r0);
      float sa0 = s0[0] * kk4.x + s0[1] * kk4.y + s0[2] * kk4.z + s0[3] * kk4.w;
      float sa1 = s1[0] * kk4.x + s1[1] * kk4.y + s1[2] * kk4.z + s1[3] * kk4.w;
      sa0 = red16(sa0);
      sa1 = red16(sa1);
      s0[0] = s0[0] * w4.x + (v2.x * k4.x - sa0 * ka4.x);
      s0[1] = s0[1] * w4.y + (v2.x * k4.y - sa0 * ka4.y);
      s0[2] = s0[2] * w4.z + (v2.x * k4.z - sa0 * ka4.z);
      s0[3] = s0[3] * w4.w + (v2.x * k4.w - sa0 * ka4.w);
      s1[0] = s1[0] * w4.x + (v2.y * k4.x - sa1 * ka4.x);
      s1[1] = s1[1] * w4.y + (v2.y * k4.y - sa1 * ka4.y);
      s1[2] = s1[2] * w4.z + (v2.y * k4.z - sa1 * ka4.z);
      s1[3] = s1[3] * w4.w + (v2.y * k4.w - sa1 * ka4.w);
      float y0 = s0[0] * r4.x + s0[1] * r4.y + s0[2] * r4.z + s0[3] * r4.w;
      float y1 = s1[0] * r4.x + s1[1] * r4.y + s1[2] * r4.z + s1[3] * r4.w;
      y0 = red16(y0);
      y1 = red16(y1);
      if (l15 == 0) *(float2*)(yb + t * 64 + r0) = make_float2(y0, y1);
    }
  }
}

__device__ __forceinline__ void attn_unit(const P& p, int u, char* smem, float lam) {
  bf* Ks = (bf*)smem;
  bf* Vt = Ks + 64 * 136;
  int b, h, nkeys, qa0;
  if (u < 1024) { b = u >> 7; h = (u >> 5) & 3; nkeys = TA; qa0 = CTX + (u & 31) * 128; }
  else { int v = u - 1024; b = v >> 3; h = (v >> 1) & 3; nkeys = CTX; qa0 = (v & 1) * 128; }
  const bf* QKV = (const bf*)(p.ws + OFF_QKV);
  const int tid = threadIdx.x, lane = tid & 63, wave = tid >> 6;
  const int l15 = lane & 15, lg = lane >> 4;
  const size_t rowbase = (size_t)b * TA;
  bf16x8 qf[2][2];
  {
    size_t Rq = rowbase + qa0 + wave * 16 + l15;
#pragma unroll
    for (int m = 0; m < 2; ++m)
#pragma unroll
      for (int ks = 0; ks < 2; ++ks) qf[m][ks] = *(const bf16x8*)(QKV + Rq * 1536 + h * 128 + m * 64 + ks * 32 + lg * 8);
  }
  f32x4 oacc[2][8];
#pragma unroll
  for (int m = 0; m < 2; ++m)
#pragma unroll
    for (int n = 0; n < 8; ++n) oacc[m][n] = (f32x4){0.f, 0.f, 0.f, 0.f};
  float mrun[2] = {-INFINITY, -INFINITY}, lrun[2] = {0.f, 0.f};
  for (int k0 = 0; k0 < nkeys; k0 += 64) {
    __syncthreads();
#pragma unroll
    for (int i = 0; i < 2; ++i) {
      int c = tid + NT * i, r = c >> 4, cc = c & 15;
      const bf* src = QKV + (rowbase + k0 + r) * 1536 + h * 128 + cc * 8;
      uint4 kv = *(const uint4*)(src + 512);
      *(uint4*)(Ks + r * 136 + cc * 8) = kv;
      uint4 vv = *(const uint4*)(src + 1024);
      bf* vd = Vt + (cc * 8) * 72 + r;
      vd[0 * 72] = (bf)(vv.x & 0xffff); vd[1 * 72] = (bf)(vv.x >> 16);
      vd[2 * 72] = (bf)(vv.y & 0xffff); vd[3 * 72] = (bf)(vv.y >> 16);
      vd[4 * 72] = (bf)(vv.z & 0xffff); vd[5 * 72] = (bf)(vv.z >> 16);
      vd[6 * 72] = (bf)(vv.w & 0xffff); vd[7 * 72] = (bf)(vv.w >> 16);
    }
    __syncthreads();
#pragma unroll
    for (int m = 0; m < 2; ++m) {
      f32x4 s[4];
#pragma unroll
      for (int kt = 0; kt < 4; ++kt) s[kt] = (f32x4){0.f, 0.f, 0.f, 0.f};
#pragma unroll
      for (int ks = 0; ks < 2; ++ks)
#pragma unroll
        for (int kt = 0; kt < 4; ++kt) {
          bf16x8 a = *(const bf16x8*)(Ks + (kt * 16 + l15) * 136 + m * 64 + ks * 32 + lg * 8);
          s[kt] = __builtin_amdgcn_mfma_f32_16x16x32_bf16(a, qf[m][ks], s[kt], 0, 0, 0);
        }
      float mx = s[0][0];
#pragma unroll
      for (int kt = 0; kt < 4; ++kt)
#pragma unroll
        for (int r = 0; r < 4; ++r) mx = fmaxf(mx, s[kt][r]);
      mx = fmaxf(mx, __shfl_xor(mx, 16));
      mx = fmaxf(mx, __shfl_xor(mx, 32));
      float mnew = fmaxf(mrun[m], mx);
      float alpha = __expf(mrun[m] - mnew);
      mrun[m] = mnew;
      float ps = 0.f;
#pragma unroll
      for (int kt = 0; kt < 4; ++kt)
#pragma unroll
        for (int r = 0; r < 4; ++r) {
          float e = __expf(s[kt][r] - mnew);
          s[kt][r] = e;
          ps += e;
        }
      lrun[m] = lrun[m] * alpha + ps;
      bf16x8 pf[2];
#pragma unroll
      for (int si = 0; si < 2; ++si) {
        i32x4 t;
        t[0] = (int)pack2(s[2 * si][0], s[2 * si][1]);
        t[1] = (int)pack2(s[2 * si][2], s[2 * si][3]);
        t[2] = (int)pack2(s[2 * si + 1][0], s[2 * si + 1][1]);
        t[3] = (int)pack2(s[2 * si + 1][2], s[2 * si + 1][3]);
        pf[si] = __builtin_bit_cast(bf16x8, t);
      }
      float al[4];
#pragma unroll
      for (int r = 0; r < 4; ++r) al[r] = __shfl(alpha, lg * 4 + r);
#pragma unroll
      for (int n = 0; n < 8; ++n)
#pragma unroll
        for (int r = 0; r < 4; ++r) oacc[m][n][r] *= al[r];
#pragma unroll
      for (int si = 0; si < 2; ++si)
#pragma unroll
        for (int n = 0; n < 8; ++n) {
          const bf* vp = Vt + (n * 16 + l15) * 72 + si * 32 + lg * 4;
          uint2 v0 = *(const uint2*)vp;
          uint2 v1 = *(const uint2*)(vp + 16);
          i32x4 t;
          t[0] = (int)v0.x; t[1] = (int)v0.y; t[2] = (int)v1.x; t[3] = (int)v1.y;
          oacc[m][n] = __builtin_amdgcn_mfma_f32_16x16x32_bf16(pf[si], __builtin_bit_cast(bf16x8, t), oacc[m][n], 0, 0, 0);
        }
    }
  }
  float inv[2];
#pragma unroll
  for (int m = 0; m < 2; ++m) {
    float l = lrun[m];
    l += __shfl_xor(l, 16);
    l += __shfl_xor(l, 32);
    inv[m] = 1.f / l;
  }
  float i1[4], i2[4];
#pragma unroll
  for (int r = 0; r < 4; ++r) { i1[r] = __shfl(inv[0], lg * 4 + r); i2[r] = __shfl(inv[1], lg * 4 + r); }
  float ss[4] = {0.f, 0.f, 0.f, 0.f};
#pragma unroll
  for (int n = 0; n < 8; ++n)
#pragma unroll
    for (int r = 0; r < 4; ++r) {
      float o = oacc[0][n][r] * i1[r] - lam * (oacc[1][n][r] * i2[r]);
      oacc[0][n][r] = o;
      ss[r] += o * o;
    }
  const float* subln = p.in[16];
  bf* O = (bf*)(p.ws + OFF_HO);
#pragma unroll
  for (int r = 0; r < 4; ++r) {
    float t = red16(ss[r]);
    float scl = rsqrtf(t * (1.f / 128.f) + 1e-5f) * 0.8f;
    size_t Ro = rowbase + qa0 + wave * 16 + lg * 4 + r;
#pragma unroll
    for (int n = 0; n < 8; ++n) O[Ro * 1024 + h * 128 + n * 16 + l15] = f2bf(oacc[0][n][r] * scl * subln[n * 16 + l15]);
  }
}

__device__ __forceinline__ void ph_mix0(const P& p, char* smem) {
  __shared__ int s_unit;
  for (int chain = blockIdx.x; chain < 128; chain += gridDim.x) rwkv_chain(p, chain, smem);
  float d1 = 0.f, d2 = 0.f;
  for (int i = 0; i < 64; ++i) { d1 += p.in[12][i] * p.in[13][i]; d2 += p.in[14][i] * p.in[15][i]; }
  float lam = expf(d1) - expf(d2) + 0.2f;
  int* cnt = (int*)(p.ws + OFF_CNT);
  while (true) {
    __syncthreads();
    if (threadIdx.x == 0) s_unit = atomicAdd(cnt, 1);
    __syncthreads();
    int u = s_unit;
    if (u >= 1088) break;
    attn_unit(p, u, smem, lam);
  }
}

__device__ __forceinline__ void ph_rwkv_post(const P& p) {
  const int tid = threadIdx.x, wave = tid >> 6;
  const bf* YF = (const bf*)p.out;
  const bf* YB = YF + (size_t)RT * 512;
  const bf* PV = (const bf*)(p.ws + OFF_PREP) + (size_t)2 * RT * 512;
  const bf* G = (const bf*)(p.ws + OFF_G);
  const float* BON = (const float*)(p.ws + OFF_BONUS);
  bf* O = (bf*)(p.ws + OFF_HO);
  const float lw = p.in[28][tid], lb = p.in[29][tid];
  for (int R = blockIdx.x; R < RT; R += gridDim.x) {
    size_t o = (size_t)R * 512 + tid;
    float y = bf2f(YF[o]) + bf2f(YB[o]);
    float mean = wave_sum(y) * (1.f / 64.f);
    float d = y - mean;
    float var = wave_sum(d * d) * (1.f / 64.f);
    float yn = d * rsqrtf(var + 64e-5f) * lw + lb;
    float outv = (yn + BON[(size_t)R * 8 + wave] * bf2f(PV[o])) * bf2f(G[o]);
    O[(size_t)R * 1024 + 512 + tid] = f2bf(outv);
  }
}

__device__ __forceinline__ void ph_conv(const P& p) {
  const bf* XR = (const bf*)(p.ws + OFF_XRAW);
  bf* XO = (bf*)(p.ws + OFF_XBC);
  const float* cw = p.in[38];
  const float* cb = p.in[39];
  for (size_t it = (size_t)blockIdx.x * NT + threadIdx.x; it < (size_t)RT * 128; it += (size_t)gridDim.x * NT) {
    int R = (int)(it >> 7), c8 = (int)(it & 127) * 8;
    int b = R / TA, a = R - b * TA;
    int lo = a < CTX ? 0 : CTX, hi = a < CTX ? CTX : TA;
    float acc[8];
#pragma unroll
    for (int e = 0; e < 8; ++e) acc[e] = cb[c8 + e];
#pragma unroll
    for (int j = 0; j < 5; ++j) {
      int aj = a + j - 2;
      if (aj >= lo && aj < hi) {
        uint4 v = *(const uint4*)(XR + (size_t)(R + j - 2) * 1024 + c8);
        const float* w = cw + j * 1024 + c8;
        acc[0] += w[0] * bflo(v.x); acc[1] += w[1] * bfhi(v.x);
        acc[2] += w[2] * bflo(v.y); acc[3] += w[3] * bfhi(v.y);
        acc[4] += w[4] * bflo(v.z); acc[5] += w[5] * bfhi(v.z);
        acc[6] += w[6] * bflo(v.w); acc[7] += w[7] * bfhi(v.w);
      }
    }
    uint4 o;
    o.x = pack2(siluf_(acc[0]), siluf_(acc[1]));
    o.y = pack2(siluf_(acc[2]), siluf_(acc[3]));
    o.z = pack2(siluf_(acc[4]), siluf_(acc[5]));
    o.w = pack2(siluf_(acc[6]), siluf_(acc[7]));
    *(uint4*)(XO + (size_t)R * 1024 + c8) = o;
  }
}

__device__ __forceinline__ void ssd_chain(const P& p, int chain, char* smem) {
  const int dir = chain & 1, hh = (chain >> 1) & 7, b = chain >> 4;
  const int grp = hh >> 2;
  float* cB = (float*)smem;
  float* cC = cB + 4096;
  float* cX = cC + 4096;
  float* cDA = cX + 2048;
  float* yb = cDA + 32;
  const int tid = threadIdx.x, lane = tid & 63, wave = tid >> 6;
  const int l15 = lane & 15, lg = lane >> 4;
  const bf* XBC = (const bf*)(p.ws + OFF_XBC);
  const float* DTR = (const float*)(p.ws + OFF_DTRAW);
  bf* Y = (bf*)(p.ws + OFF_XRAW) + (size_t)dir * RT * 512;
  const float dtb = p.in[dir ? 42 : 40][hh];
  const float Aneg = -expf(p.in[dir ? 43 : 41][hh]);
  const int st = tid >> 4, q = tid & 15;
  const int r0 = wave * 8 + lg * 2;
  float s0[8], s1[8];
#pragma unroll
  for (int j = 0; j < 8; ++j) { s0[j] = 0.f; s1[j] = 0.f; }
  uint4 gB, gC;
  uint2 gX;
  float gD;
  {
    size_t R = (size_t)scan_row(b, dir, st);
    gB = *(const uint4*)(XBC + R * 1024 + 512 + grp * 128 + q * 8);
    gC = *(const uint4*)(XBC + R * 1024 + 768 + grp * 128 + q * 8);
    gX = *(const uint2*)(XBC + R * 1024 + hh * 64 + q * 4);
    gD = DTR[R * 16 + dir * 8 + hh];
  }
  const int NCH = TA / 32;
  for (int ch = 0; ch <= NCH; ++ch) {
    __syncthreads();
    if (ch > 0) {
      float4 y4 = *(const float4*)(yb + st * 64 + q * 4);
      uint2 o2;
      o2.x = pack2(y4.x, y4.y);
      o2.y = pack2(y4.z, y4.w);
      *(uint2*)(Y + (size_t)scan_row(b, dir, (ch - 1) * 32 + st) * 512 + hh * 64 + q * 4) = o2;
    }
    if (ch == NCH) break;
    {
      float dt = softplusf_(gD + dtb);
      float dA = expf(dt * Aneg);
      float* d = cB + st * 128 + q * 8;
      *(float4*)d = make_float4(bflo(gB.x), bfhi(gB.x), bflo(gB.y), bfhi(gB.y));
      *(float4*)(d + 4) = make_float4(bflo(gB.z), bfhi(gB.z), bflo(gB.w), bfhi(gB.w));
      d = cC + st * 128 + q * 8;
      *(float4*)d = make_float4(bflo(gC.x), bfhi(gC.x), bflo(gC.y), bfhi(gC.y));
      *(float4*)(d + 4) = make_float4(bflo(gC.z), bfhi(gC.z), bflo(gC.w), bfhi(gC.w));
      *(float4*)(cX + st * 64 + q * 4) = make_float4(bflo(gX.x) * dt, bfhi(gX.x) * dt, bflo(gX.y) * dt, bfhi(gX.y) * dt);
      if (q == 0) cDA[st] = dA;
    }
    __syncthreads();
    if (ch + 1 < NCH) {
      size_t R = (size_t)scan_row(b, dir, (ch + 1) * 32 + st);
      gB = *(const uint4*)(XBC + R * 1024 + 512 + grp * 128 + q * 8);
      gC = *(const uint4*)(XBC + R * 1024 + 768 + grp * 128 + q * 8);
      gX = *(const uint2*)(XBC + R * 1024 + hh * 64 + q * 4);
      gD = DTR[R * 16 + dir * 8 + hh];
    }
#pragma unroll 4
    for (int t = 0; t < 32; ++t) {
      float4 b0 = *(const float4*)(cB + t * 128 + l15 * 8);
      float4 b1 = *(const float4*)(cB + t * 128 + l15 * 8 + 4);
      float4 c0 = *(const float4*)(cC + t * 128 + l15 * 8);
      float4 c1 = *(const float4*)(cC + t * 128 + l15 * 8 + 4);
      float2 x2 = *(const float2*)(cX + t * 64 + r0);
      float dA = cDA[t];
      s0[0] = s0[0] * dA + x2.x * b0.x; s0[1] = s0[1] * dA + x2.x * b0.y; s0[2] = s0[2] * dA + x2.x * b0.z; s0[3] = s0[3] * dA + x2.x * b0.w;
      s0[4] = s0[4] * dA + x2.x * b1.x; s0[5] = s0[5] * dA + x2.x * b1.y; s0[6] = s0[6] * dA + x2.x * b1.z; s0[7] = s0[7] * dA + x2.x * b1.w;
      s1[0] = s1[0] * dA + x2.y * b0.x; s1[1] = s1[1] * dA + x2.y * b0.y; s1[2] = s1[2] * dA + x2.y * b0.z; s1[3] = s1[3] * dA + x2.y * b0.w;
      s1[4] = s1[4] * dA + x2.y * b1.x; s1[5] = s1[5] * dA + x2.y * b1.y; s1[6] = s1[6] * dA + x2.y * b1.z; s1[7] = s1[7] * dA + x2.y * b1.w;
      float y0 = s0[0] * c0.x + s0[1] * c0.y + s0[2] * c0.z + s0[3] * c0.w + s0[4] * c1.x + s0[5] * c1.y + s0[6] * c1.z + s0[7] * c1.w;
      float y1 = s1[0] * c0.x + s1[1] * c0.y + s1[2] * c0.z + s1[3] * c0.w + s1[4] * c1.x + s1[5] * c1.y + s1[6] * c1.z + s1[7] * c1.w;
      y0 = red16(y0);
      y1 = red16(y1);
      if (l15 == 0) *(float2*)(yb + t * 64 + r0) = make_float2(y0, y1);
    }
  }
}

__device__ __forceinline__ void gla_chain(const P& p, int chain, char* smem) {
  const int dir = chain & 1, h = (chain >> 1) & 3, b = chain >> 3;
  float* cQ = (float*)smem;
  float* cK = cQ + 2048;
  float* cD = cK + 2048;
  float* cV = cD + 2048;
  float* yb = cV + 4096;
  float* up = yb + 4096;
  float* gbias = up + 1024;
  const int tid = threadIdx.x, lane = tid & 63, wave = tid >> 6;
  const int l15 = lane & 15, lg = lane >> 4;
  const bf* P1 = (const bf*)(p.ws + OFF_P1C);
  bf* Y = (bf*)(p.ws + OFF_GY) + (size_t)dir * RT * 512;
  const float* gup = p.in[dir ? 48 : 46];
  const float* gb = p.in[dir ? 49 : 47];
  __syncthreads();
  for (int i = tid; i < 1024; i += NT) up[i] = gup[(i >> 6) * 256 + h * 64 + (i & 63)];
  if (tid < 64) gbias[tid] = gb[h * 64 + tid];
  const int st = tid >> 4, q = tid & 15;
  const int r0 = wave * 16 + lg * 4;
  float s[4][4];
#pragma unroll
  for (int r = 0; r < 4; ++r)
#pragma unroll
    for (int j = 0; j < 4; ++j) s[r][j] = 0.f;
  uint2 gQ, gK;
  uint4 gV, gG0, gG1;
  {
    const bf* row = P1 + (size_t)scan_row(b, dir, st) * 2080;
    gQ = *(const uint2*)(row + 528 + h * 64 + q * 4);
    gK = *(const uint2*)(row + 784 + h * 64 + q * 4);
    gV = *(const uint4*)(row + 1040 + h * 128 + q * 8);
    gG0 = *(const uint4*)(row + 2064);
    gG1 = *(const uint4*)(row + 2072);
  }
  const int NCH = TA / 32;
  for (int ch = 0; ch <= NCH; ++ch) {
    __syncthreads();
    if (ch > 0) {
      float4 ya = *(const float4*)(yb + st * 128 + q * 8);
      float4 yc = *(const float4*)(yb + st * 128 + q * 8 + 4);
      uint4 o4;
      o4.x = pack2(ya.x, ya.y); o4.y = pack2(ya.z, ya.w); o4.z = pack2(yc.x, yc.y); o4.w = pack2(yc.z, yc.w);
      *(uint4*)(Y + (size_t)scan_row(b, dir, (ch - 1) * 32 + st) * 512 + h * 128 + q * 8) = o4;
    }
    if (ch == NCH) break;
    {
      float gd[16];
      gd[0] = bflo(gG0.x); gd[1] = bfhi(gG0.x); gd[2] = bflo(gG0.y); gd[3] = bfhi(gG0.y);
      gd[4] = bflo(gG0.z); gd[5] = bfhi(gG0.z); gd[6] = bflo(gG0.w); gd[7] = bfhi(gG0.w);
      gd[8] = bflo(gG1.x); gd[9] = bfhi(gG1.x); gd[10] = bflo(gG1.y); gd[11] = bfhi(gG1.y);
      gd[12] = bflo(gG1.z); gd[13] = bfhi(gG1.z); gd[14] = bflo(gG1.w); gd[15] = bfhi(gG1.w);
      float4 z = *(const float4*)(gbias + q * 4);
#pragma unroll
      for (int i = 0; i < 16; ++i) {
        float4 u4 = *(const float4*)(up + i * 64 + q * 4);
        z.x += gd[i] * u4.x; z.y += gd[i] * u4.y; z.z += gd[i] * u4.z; z.w += gd[i] * u4.w;
      }
      float4 dd;
      dd.x = expf(-softplusf_(-z.x) * (1.f / 16.f));
      dd.y = expf(-softplusf_(-z.y) * (1.f / 16.f));
      dd.z = expf(-softplusf_(-z.z) * (1.f / 16.f));
      dd.w = expf(-softplusf_(-z.w) * (1.f / 16.f));
      *(float4*)(cD + st * 64 + q * 4) = dd;
      *(float4*)(cQ + st * 64 + q * 4) = make_float4(bflo(gQ.x) * 0.125f, bfhi(gQ.x) * 0.125f, bflo(gQ.y) * 0.125f, bfhi(gQ.y) * 0.125f);
      *(float4*)(cK + st * 64 + q * 4) = make_float4(bflo(gK.x), bfhi(gK.x), bflo(gK.y), bfhi(gK.y));
      float* d = cV + st * 128 + q * 8;
      *(float4*)d = make_float4(bflo(gV.x), bfhi(gV.x), bflo(gV.y), bfhi(gV.y));
      *(float4*)(d + 4) = make_float4(bflo(gV.z), bfhi(gV.z), bflo(gV.w), bfhi(gV.w));
    }
    __syncthreads();
    if (ch + 1 < NCH) {
      const bf* row = P1 + (size_t)scan_row(b, dir, (ch + 1) * 32 + st) * 2080;
      gQ = *(const uint2*)(row + 528 + h * 64 + q * 4);
      gK = *(const uint2*)(row + 784 + h * 64 + q * 4);
      gV = *(const uint4*)(row + 1040 + h * 128 + q * 8);
      gG0 = *(const uint4*)(row + 2064);
      gG1 = *(const uint4*)(row + 2072);
    }
#pragma unroll 4
    for (int t = 0; t < 32; ++t) {
      float4 q4 = *(const float4*)(cQ + t * 64 + l15 * 4);
      float4 k4 = *(const float4*)(cK + t * 64 + l15 * 4);
      float4 d4 = *(const float4*)(cD + t * 64 + l15 * 4);
      float4 v4 = *(const float4*)(cV + t * 128 + r0);
      float vv[4] = {v4.x, v4.y, v4.z, v4.w};
      float yy[4];
#pragma unroll
      for (int r = 0; r < 4; ++r) {
        s[r][0] = s[r][0] * d4.x + k4.x * vv[r];
        s[r][1] = s[r][1] * d4.y + k4.y * vv[r];
        s[r][2] = s[r][2] * d4.z + k4.z * vv[r];
        s[r][3] = s[r][3] * d4.w + k4.w * vv[r];
        yy[r] = red16(s[r][0] * q4.x + s[r][1] * q4.y + s[r][2] * q4.z + s[r][3] * q4.w);
      }
      if (l15 == 0) *(float4*)(yb + t * 128 + r0) = make_float4(yy[0], yy[1], yy[2], yy[3]);
    }
  }
}

__device__ __forceinline__ void ph_mix1(const P& p, char* smem) {
  for (int u = blockIdx.x; u < 192; u += gridDim.x) {
    if (u < 128) ssd_chain(p, u, smem);
    else gla_chain(p, u - 128, smem);
  }
}

__device__ __forceinline__ void ph_post1(const P& p, char* smem) {
  float* ws1 = (float*)smem;
  float* ws2 = ws1 + 8;
  const int tid = threadIdx.x, lane = tid & 63, wave = tid >> 6;
  const bf* SYF = (const bf*)(p.ws + OFF_XRAW);
  const bf* SYB = SYF + (size_t)RT * 512;
  const bf* GYF = (const bf*)(p.ws + OFF_GY);
  const bf* GYB = GYF + (size_t)RT * 512;
  const bf* XBC = (const bf*)(p.ws + OFF_XBC);
  const bf* P1 = (const bf*)(p.ws + OFF_P1C);
  bf* O = (bf*)(p.ws + OFF_HO);
  const float dsk = p.in[44][tid >> 6];
  const float sn = p.in[45][tid];
  const float gn = p.in[50][tid & 127];
  for (int rr = blockIdx.x; rr < NBAT * SEQ; rr += gridDim.x) {
    int b = rr >> 12;
    int R = b * TA + CTX + (rr & 4095);
    size_t o = (size_t)R * 512 + tid;
    float y = bf2f(SYF[o]) + bf2f(SYB[o]) + bf2f(XBC[(size_t)R * 1024 + tid]) * dsk;
    y *= siluf_(bf2f(P1[(size_t)R * 2080 + tid]));
    float s1 = wave_sum(y * y);
    float y2 = bf2f(GYF[o]) + bf2f(GYB[o]);
    float s2 = wave_sum(y2 * y2);
    __syncthreads();
    if (lane == 0) { ws1[wave] = s1; ws2[wave] = s2; }
    __syncthreads();
    int g4 = (wave >> 2) * 4;
    float t1 = ws1[g4] + ws1[g4 + 1] + ws1[g4 + 2] + ws1[g4 + 3];
    int g2 = (wave >> 1) * 2;
    float t2 = ws2[g2] + ws2[g2 + 1];
    float o1 = y * rsqrtf(t1 * (1.f / 256.f) + 1e-6f) * sn;
    float o2 = y2 * rsqrtf(t2 * (1.f / 128.f) + 1e-6f) * gn * siluf_(bf2f(P1[(size_t)R * 2080 + 1552 + tid]));
    O[(size_t)R * 1024 + tid] = f2bf(o1);
    O[(size_t)R * 1024 + 512 + tid] = f2bf(o2);
  }
}

__device__ __forceinline__ void ph_final(const P& p) {
  const int lane = threadIdx.x & 63, wave = threadIdx.x >> 6;
  const float* g = p.in[51];
  for (int r = blockIdx.x * 8 + wave; r < NBAT * SEQ; r += gridDim.x * 8) {
    float* row = p.out + (size_t)r * 1024;
    float4 v[4];
    float ss = 0.f;
#pragma unroll
    for (int i = 0; i < 4; ++i) {
      v[i] = *(const float4*)(row + i * 256 + lane * 4);
      ss += v[i].x * v[i].x + v[i].y * v[i].y + v[i].z * v[i].z + v[i].w * v[i].w;
    }
    ss = wave_sum(ss);
    float rs = rsqrtf(ss * (1.f / 1024.f) + 1e-6f);
#pragma unroll
    for (int i = 0; i < 4; ++i) {
      float4 gg = *(const float4*)(g + i * 256 + lane * 4);
      float4 o = make_float4(v[i].x * rs * gg.x, v[i].y * rs * gg.y, v[i].z * rs * gg.z, v[i].w * rs * gg.w);
      *(float4*)(row + i * 256 + lane * 4) = o;
    }
  }
}

constexpr int NPH = 20;
__device__ __forceinline__ void run_phase(const P& p, int ph, char* smem) {
  const bf* WT = (const bf*)(p.ws + OFF_WT);
  const bf* HO = (const bf*)(p.ws + OFF_HO);
  const bf* HID = (const bf*)(p.ws + OFF_HID);
  GArgs g{HO, 1024, WT, 1024, 8, 0, 0, 0};
  bool isg = false, isada = false, iswt = false;
  int al = 0, aw = 0, ai = 0, alat = 0, wl = 0;
  switch (ph) {
    case 0:
      if (blockIdx.x == 0 && threadIdx.x == 0) *(int*)(p.ws + OFF_CNT) = 0;
      ph_mod(p, smem);
      iswt = true; wl = 0;
      break;
    case 1: isada = true; al = 0; aw = 0; ai = 1; alat = 0; break;
    case 2: g = GArgs{HO, 1024, WT + WT_IN, 1024, 26, 0, 0, 0}; isg = true; break;
    case 3: ph_rope(p, smem); ph_rwkv_prep(p, smem); break;
    case 4: ph_mix0(p, smem); break;
    case 5: ph_rwkv_post(p); break;
    case 6: g = GArgs{HO, 1024, WT + WT_OUT, 1024, 8, 2, 0, 0}; isg = true; break;
    case 7: isada = true; al = 0; aw = 1; ai = 0; alat = 0; break;
    case 8: g = GArgs{HO, 1024, WT + WT_W1, 1024, 32, 3, 0, 0}; isg = true; break;
    case 9: g = GArgs{HID, 4096, WT + WT_W2, 4096, 8, 4, 0, 0}; isg = true; break;
    case 10: isada = true; al = 1; aw = 0; ai = 0; alat = 0; iswt = true; wl = 1; break;
    case 11: g = GArgs{HO, 1024, WT + WT_IN, 1024, 25, 1, 1, 0}; isg = true; break;
    case 12: ph_conv(p); break;
    case 13: ph_mix1(p, smem); break;
    case 14: ph_post1(p, smem); break;
    case 15: g = GArgs{HO, 1024, WT + WT_OUT, 1024, 8, 2, 1, 1}; isg = true; break;
    case 16: isada = true; al = 1; aw = 1; ai = 0; alat = 1; break;
    case 17: g = GArgs{HO, 1024, WT + WT_W1, 1024, 32, 3, 1, 1}; isg = true; break;
    case 18: g = GArgs{HID, 4096, WT + WT_W2, 4096, 8, 4, 1, 1}; isg = true; break;
    default: ph_final(p); break;
  }
  if (isada) ph_ada(p, al, aw, ai, alat);
  if (iswt) ph_wt(p, wl, smem);
  if (isg) ph_gemm(p, g, smem);
}

#if MODE_COOP
template <int PH>
__device__ __forceinline__ void run_all(const P& p, char* smem) {
  run_phase(p, PH, smem);
  if constexpr (PH + 1 < NPH) {
    cg::this_grid().sync();
    run_all<PH + 1>(p, smem);
  }
}
__global__ void __launch_bounds__(NT) mega(P p) {
  __shared__ __attribute__((aligned(16))) char smem[63488];
  run_all<0>(p, smem);
}
#endif

template <int PH>
__global__ void __launch_bounds__(NT) phk(P p) {
  __shared__ __attribute__((aligned(16))) char smem[63488];
  run_phase(p, PH, smem);
}
template <int PH>
static void launch_all(const P& p, int grid, hipStream_t stream) {
  phk<PH><<<grid, NT, 0, stream>>>(p);
  if constexpr (PH + 1 < NPH) launch_all<PH + 1>(p, grid, stream);
}

extern "C" void kernel_launch(void* const* d_in, const int* in_sizes, int n_in, void* d_out, int out_size, void* d_ws,
                              size_t ws_size, hipStream_t stream) {
  P p{};
  for (int i = 0; i < 52; ++i) p.in[i] = (const float*)d_in[i];
  p.out = (float*)d_out;
  p.ws = (char*)d_ws;
  static int grid_blocks = 0;
  if (!grid_blocks) {
    int dev = 0, cus = 0, per_cu = 0;
    (void)hipGetDevice(&dev);
    (void)hipDeviceGetAttribute(&cus, hipDeviceAttributeMultiprocessorCount, dev);
    #if MODE_COOP
    (void)hipOccupancyMaxActiveBlocksPerMultiprocessor(&per_cu, mega, NT, 0);
#else
    per_cu = 1;
#endif
    if (per_cu < 1) per_cu = 1;
    if (per_cu > 1) per_cu = 1;
    grid_blocks = cus * per_cu;
  }
#if MODE_COOP
  void* args[] = {&p};
  hipError_t e = hipLaunchCooperativeKernel((void*)mega, dim3(grid_blocks), dim3(NT), args, 0, stream);
  if (e != hipSuccess) fprintf(stderr, "cooperative launch failed: %s (grid %d)\n", hipGetErrorString(e), grid_blocks);
#else
  launch_all<0>(p, grid_blocks, stream);
#endif
}
```

```cpp
#include <hip/hip_runtime.h>
#include <hip/hip_cooperative_groups.h>
#include <cstdio>
namespace cg = cooperative_groups;

#ifndef MODE_COOP
#define MODE_COOP 1
#endif

typedef unsigned short bf;
typedef __attribute__((ext_vector_type(8))) short bf16x8;
typedef __attribute__((ext_vector_type(4))) float f32x4;
typedef __attribute__((ext_vector_type(4))) int i32x4;

constexpr int NT = 512;
constexpr int Dm = 1024, NBAT = 8, SEQ = 4096, CTX = 256, TA = 4352, RT = NBAT * TA;

constexpr size_t OFF_MOD = 0;
constexpr size_t OFF_CNT = 450000;
constexpr size_t OFF_WT = 524288;
constexpr size_t WT_IN = 0, WT_OUT = (size_t)3328 * 1024, WT_W1 = WT_OUT + (size_t)1024 * 1024, WT_W2 = WT_W1 + (size_t)4096 * 1024;
constexpr size_t OFF_CTXX = OFF_WT + (size_t)12544 * 1024 * 2;
constexpr size_t OFF_HO = OFF_CTXX + (size_t)2048 * 1024 * 4;
constexpr size_t OFF_BIG = OFF_HO + (size_t)RT * 1024 * 2;
constexpr size_t SZ512 = (size_t)RT * 512 * 2;
constexpr size_t OFF_QKV = OFF_BIG;
constexpr size_t OFF_PREP = OFF_QKV + (size_t)RT * 1536 * 2;
constexpr size_t OFF_G = OFF_PREP + 7 * SZ512;
constexpr size_t OFF_BONUS = OFF_G + SZ512;
constexpr size_t OFF_HID = OFF_BIG;
constexpr size_t OFF_P1C = OFF_BIG;
constexpr size_t OFF_XRAW = OFF_P1C + (size_t)RT * 2080 * 2;
constexpr size_t OFF_DTRAW = OFF_XRAW + (size_t)RT * 1024 * 2;
constexpr size_t OFF_XBC = OFF_DTRAW + (size_t)RT * 16 * 4;
constexpr size_t OFF_GY = OFF_XBC + (size_t)RT * 1024 * 2;

struct P {
  const float* in[52];
  float* out;
  char* ws;
};

__device__ __forceinline__ bf f2bf(float f) {
  unsigned u = __float_as_uint(f);
  u += 0x7fffu + ((u >> 16) & 1u);
  return (bf)(u >> 16);
}
__device__ __forceinline__ float bf2f(bf h) { return __uint_as_float(((unsigned)h) << 16); }
__device__ __forceinline__ float bflo(unsigned u) { return __uint_as_float(u << 16); }
__device__ __forceinline__ float bfhi(unsigned u) { return __uint_as_float(u & 0xffff0000u); }
__device__ __forceinline__ unsigned pack2(float a, float b) { return (unsigned)f2bf(a) | ((unsigned)f2bf(b) << 16); }
__device__ __forceinline__ float sigmoidf_(float x) { return 1.f / (1.f + expf(-x)); }
__device__ __forceinline__ float softplusf_(float x) { return x > 20.f ? x : log1pf(expf(x)); }
__device__ __forceinline__ float siluf_(float x) { return x / (1.f + expf(-x)); }
__device__ __forceinline__ float wave_sum(float v) {
#pragma unroll
  for (int o = 32; o >= 1; o >>= 1) v += __shfl_xor(v, o);
  return v;
}
template <int C>
__device__ __forceinline__ float dppf(float x) {
  return __builtin_bit_cast(float, __builtin_amdgcn_update_dpp(0, __builtin_bit_cast(int, x), C, 0xF, 0xF, false));
}
__device__ __forceinline__ float red16(float x) {
  x += dppf<0xB1>(x);
  x += dppf<0x4E>(x);
  x += dppf<0x141>(x);
  x += dppf<0x128>(x);
  return x;
}
__device__ __forceinline__ float* xrow(const P& p, int R) {
  int b = R / TA, a = R - b * TA;
  if (a < CTX) return (float*)(p.ws + OFF_CTXX) + (size_t)(b * CTX + a) * Dm;
  return p.out + (size_t)(b * SEQ + a - CTX) * Dm;
}
__device__ __forceinline__ const float* inrow(const P& p, int R) {
  int b = R / TA, a = R - b * TA;
  if (a < CTX) return p.in[2] + (size_t)(b * CTX + a) * Dm;
  return p.in[0] + (size_t)(b * SEQ + a - CTX) * Dm;
}
__device__ __forceinline__ int mrow(int R) {
  int b = R / TA, a = R - b * TA;
  return a < CTX ? 8 : b;
}

__device__ __forceinline__ void ph_mod(const P& p, char* smem) {
  float* sc = (float*)smem;
  float* red = sc + 9 * 1024;
  const int tid = threadIdx.x;
  bool loaded = false;
  for (int unit = blockIdx.x; unit < 2 * 192; unit += gridDim.x) {
    int layer = unit / 192, cch = unit - layer * 192;
    const float* W = p.in[layer ? 30 : 4];
    const float* bias = p.in[layer ? 31 : 5];
    __syncthreads();
    if (!loaded) {
      for (int i = tid; i < 9 * 1024; i += NT) {
        int r = i >> 10, k = i & 1023;
        float v = (r < 8) ? p.in[1][r * 1024 + k] : p.in[3][k];
        sc[i] = siluf_(v);
      }
      loaded = true;
      __syncthreads();
    }
    int cl = tid & 31, kg = tid >> 5;
    int col = cch * 32 + cl;
    float acc[9];
#pragma unroll
    for (int r = 0; r < 9; ++r) acc[r] = 0.f;
    for (int k = kg * 64; k < kg * 64 + 64; ++k) {
      float w = W[(size_t)k * 6144 + col];
#pragma unroll
      for (int r = 0; r < 9; ++r) acc[r] += sc[r * 1024 + k] * w;
    }
#pragma unroll
    for (int r = 0; r < 9; ++r) red[(kg * 9 + r) * 32 + cl] = acc[r];
    __syncthreads();
    if (tid < 288) {
      int r = tid >> 5, c = tid & 31;
      float s = 0.f;
#pragma unroll
      for (int g = 0; g < 16; ++g) s += red[(g * 9 + r) * 32 + c];
      ((float*)(p.ws + OFF_MOD))[(size_t)(layer * 9 + r) * 6144 + cch * 32 + c] = s + bias[cch * 32 + c];
    }
  }
}

__device__ __forceinline__ void transpose_one(const float* W, bf* Wt, int K, int N, int Npad, int vb, int nvb, char* smem) {
  float* tile = (float*)smem;
  const int tid = threadIdx.x;
  int ntn = Npad / 64, ntk = K / 64;
  for (int t = vb; t < ntn * ntk; t += nvb) {
    int tn = t / ntk, tk = t - tn * ntk;
    int n0 = tn * 64, k0 = tk * 64;
    __syncthreads();
#pragma unroll
    for (int i = 0; i < 8; ++i) {
      int kk = (tid >> 6) + 8 * i, nn = tid & 63;
      float v = (n0 + nn < N) ? W[(size_t)(k0 + kk) * N + n0 + nn] : 0.f;
      tile[kk * 65 + nn] = v;
    }
    __syncthreads();
#pragma unroll
    for (int i = 0; i < 8; ++i) {
      int nn = (tid >> 6) + 8 * i, kk = tid & 63;
      Wt[(size_t)(n0 + nn) * K + k0 + kk] = f2bf(tile[kk * 65 + nn]);
    }
  }
}
__device__ __forceinline__ void ph_wt(const P& p, int layer, char* smem) {
  bf* WT = (bf*)(p.ws + OFF_WT);
  int base = layer ? 34 : 8;
  int nin = layer ? 3104 : 3328, ninp = layer ? 3200 : 3328;
  int nb = gridDim.x, b = blockIdx.x;
  for (int mtx = 0; mtx < 4; ++mtx) {
    const float* W = p.in[base + mtx];
    bf* dst = WT + (mtx == 0 ? WT_IN : mtx == 1 ? WT_OUT : mtx == 2 ? WT_W1 : WT_W2);
    int K = mtx == 3 ? 4096 : 1024;
    int N = mtx == 0 ? nin : mtx == 2 ? 4096 : 1024;
    int Np = mtx == 0 ? ninp : N;
    transpose_one(W, dst, K, N, Np, (b + 64 * mtx) % nb, nb, smem);
  }
}

__device__ __forceinline__ void ph_ada(const P& p, int layer, int which, int useInput, int latonly) {
  const int lane = threadIdx.x & 63, wave = threadIdx.x >> 6;
  const float* ng = p.in[(layer ? 32 : 6) + which];
  const float* mod = (const float*)(p.ws + OFF_MOD);
  bf* H = (bf*)(p.ws + OFF_HO);
  for (int R = blockIdx.x * 8 + wave; R < RT; R += gridDim.x * 8) {
    int b = R / TA, a = R - b * TA;
    if (latonly && a < CTX) continue;
    const float* src = useInput ? inrow(p, R) : xrow(p, R);
    float4 v[4];
    float ss = 0.f;
#pragma unroll
    for (int i = 0; i < 4; ++i) {
      v[i] = *(const float4*)(src + i * 256 + lane * 4);
      ss += v[i].x * v[i].x + v[i].y * v[i].y + v[i].z * v[i].z + v[i].w * v[i].w;
    }
    ss = wave_sum(ss);
    float rs = rsqrtf(ss * (1.f / 1024.f) + 1e-6f);
    int mr = a < CTX ? 8 : b;
    const float* sh = mod + (size_t)(layer * 9 + mr) * 6144 + (which * 3 + 0) * 1024;
    const float* scl = mod + (size_t)(layer * 9 + mr) * 6144 + (which * 3 + 1) * 1024;
#pragma unroll
    for (int i = 0; i < 4; ++i) {
      int k = i * 256 + lane * 4;
      float4 g = *(const float4*)(ng + k);
      float4 s4 = *(const float4*)(sh + k);
      float4 c4 = *(const float4*)(scl + k);
      float o0 = v[i].x * rs * g.x * (1.f + c4.x) + s4.x;
      float o1 = v[i].y * rs * g.y * (1.f + c4.y) + s4.y;
      float o2 = v[i].z * rs * g.z * (1.f + c4.z) + s4.z;
      float o3 = v[i].w * rs * g.w * (1.f + c4.w) + s4.w;
      uint2 o;
      o.x = pack2(o0, o1);
      o.y = pack2(o2, o3);
      *(uint2*)(H + (size_t)R * 1024 + k) = o;
    }
  }
}

struct GArgs {
  const bf* A;
  int lda;
  const bf* Bt;
  int K;
  int ntn;
  int epi;
  int layer;
  int latonly;
};

__device__ __forceinline__ void gemm_store(const P& p, const GArgs& g, int m, int n, float v) {
  switch (g.epi) {
    case 0: {
      if (n < 1536) ((bf*)(p.ws + OFF_QKV))[(size_t)m * 1536 + n] = f2bf(v);
      else ((bf*)p.out)[(size_t)m * 1792 + (n - 1536)] = f2bf(v);
    } break;
    case 1: {
      if (n < 512) ((bf*)(p.ws + OFF_P1C))[(size_t)m * 2080 + n] = f2bf(v);
      else if (n < 1536) ((bf*)(p.ws + OFF_XRAW))[(size_t)m * 1024 + (n - 512)] = f2bf(v);
      else if (n < 1552) ((float*)(p.ws + OFF_DTRAW))[(size_t)m * 16 + (n - 1536)] = v;
      else if (n < 3104) ((bf*)(p.ws + OFF_P1C))[(size_t)m * 2080 + (n - 1024)] = f2bf(v);
    } break;
    case 2: {
      const float* mod = (const float*)(p.ws + OFF_MOD);
      float gate = mod[(size_t)(g.layer * 9 + mrow(m)) * 6144 + 2 * 1024 + n];
      float* dst = xrow(p, m) + n;
      float base = g.layer == 0 ? inrow(p, m)[n] : *dst;
      *dst = base + gate * v;
    } break;
    case 3: {
      float r = v > 0.f ? v : 0.f;
      ((bf*)(p.ws + OFF_HID))[(size_t)m * 4096 + n] = f2bf(r * r);
    } break;
    default: {
      const float* mod = (const float*)(p.ws + OFF_MOD);
      float gate = mod[(size_t)(g.layer * 9 + mrow(m)) * 6144 + 5 * 1024 + n];
      float* dst = xrow(p, m) + n;
      *dst = *dst + gate * v;
    } break;
  }
}

__device__ __forceinline__ void ph_gemm(const P& p, const GArgs& g, char* smem) {
  bf* As = (bf*)smem;
  bf* Bs = As + 256 * 72;
  const int tid = threadIdx.x, lane = tid & 63, wave = tid >> 6;
  const int wm = wave >> 1, wn = wave & 1;
  const int l15 = lane & 15, lg = lane >> 4;
  const int nmt = g.latonly ? 128 : 136;
  const int ntiles = nmt * g.ntn;
  const int nk = g.K / 64;
  for (int t = blockIdx.x; t < ntiles; t += gridDim.x) {
    int mt = t / g.ntn, nt = t - mt * g.ntn;
    if (g.latonly) mt = (mt >> 4) * 17 + 1 + (mt & 15);
    const int m0 = mt * 256, n0 = nt * 128;
    f32x4 acc[4][4];
#pragma unroll
    for (int i = 0; i < 4; ++i)
#pragma unroll
      for (int j = 0; j < 4; ++j) acc[i][j] = (f32x4){0.f, 0.f, 0.f, 0.f};
    const int srow = tid >> 3, skc = (tid & 7) * 8;
    const bf* ap = g.A + (size_t)(m0 + srow) * g.lda + skc;
    const bf* bp = g.Bt + (size_t)(n0 + srow) * g.K + skc;
    const size_t astep = (size_t)64 * g.lda, bstep = (size_t)64 * g.K;
    uint4 ra0 = *(const uint4*)(ap), ra1 = *(const uint4*)(ap + astep), ra2 = *(const uint4*)(ap + 2 * astep), ra3 = *(const uint4*)(ap + 3 * astep);
    uint4 rb0 = *(const uint4*)(bp), rb1 = *(const uint4*)(bp + bstep);
    for (int kt = 0; kt < nk; ++kt) {
      __syncthreads();
      *(uint4*)(As + (srow)*72 + skc) = ra0;
      *(uint4*)(As + (srow + 64) * 72 + skc) = ra1;
      *(uint4*)(As + (srow + 128) * 72 + skc) = ra2;
      *(uint4*)(As + (srow + 192) * 72 + skc) = ra3;
      *(uint4*)(Bs + (srow)*72 + skc) = rb0;
      *(uint4*)(Bs + (srow + 64) * 72 + skc) = rb1;
      __syncthreads();
      if (kt + 1 < nk) {
        const bf* ap2 = ap + (kt + 1) * 64;
        const bf* bp2 = bp + (kt + 1) * 64;
        ra0 = *(const uint4*)(ap2); ra1 = *(const uint4*)(ap2 + astep); ra2 = *(const uint4*)(ap2 + 2 * astep); ra3 = *(const uint4*)(ap2 + 3 * astep);
        rb0 = *(const uint4*)(bp2); rb1 = *(const uint4*)(bp2 + bstep);
      }
#pragma unroll
      for (int ks = 0; ks < 2; ++ks) {
        bf16x8 af[4], bfr[4];
#pragma unroll
        for (int i = 0; i < 4; ++i) af[i] = *(const bf16x8*)(As + (wm * 64 + i * 16 + l15) * 72 + ks * 32 + lg * 8);
#pragma unroll
        for (int j = 0; j < 4; ++j) bfr[j] = *(const bf16x8*)(Bs + (wn * 64 + j * 16 + l15) * 72 + ks * 32 + lg * 8);
#pragma unroll
        for (int i = 0; i < 4; ++i)
#pragma unroll
          for (int j = 0; j < 4; ++j) acc[i][j] = __builtin_amdgcn_mfma_f32_16x16x32_bf16(af[i], bfr[j], acc[i][j], 0, 0, 0);
      }
    }
#pragma unroll
    for (int i = 0; i < 4; ++i)
#pragma unroll
      for (int r = 0; r < 4; ++r) {
        int m = m0 + wm * 64 + i * 16 + lg * 4 + r;
#pragma unroll
        for (int j = 0; j < 4; ++j) {
          int n = n0 + wn * 64 + j * 16 + l15;
          gemm_store(p, g, m, n, acc[i][j][r]);
        }
      }
  }
}

__device__ __forceinline__ void ph_rope(const P& p, char* smem) {
  float* tcos = (float*)smem;
  float* tsin = tcos + 1024;
  const int tid = threadIdx.x;
  __syncthreads();
  for (int i = tid; i < 1024; i += NT) {
    int c = i >> 4, f = i & 15;
    float inv = powf(10000.f, -(float)f / 16.f);
    float ang = (float)c * inv;
    float sn, cs;
    sincosf(ang, &sn, &cs);
    tcos[i] = cs;
    tsin[i] = sn;
  }
  __syncthreads();
  bf* QKV = (bf*)(p.ws + OFF_QKV);
  for (size_t it = (size_t)blockIdx.x * NT + tid; it < (size_t)RT * 512; it += (size_t)gridDim.x * NT) {
    int R = (int)(it >> 9);
    int w = (int)(it & 511);
    int vec = w >> 5, half = (w >> 4) & 1, f = w & 15;
    int b = R / TA, a = R - b * TA;
    bool isq = vec < 8;
    size_t off = (size_t)R * 1536 + (size_t)vec * 64 + half * 32 + f;
    float x1 = bf2f(QKV[off]), x2 = bf2f(QKV[off + 16]);
    if (a >= CTX) {
      int pos = a - CTX;
      int cidx = half == 0 ? (pos >> 6) : (pos & 63);
      float cs = tcos[cidx * 16 + f], sn = tsin[cidx * 16 + f];
      float y1 = x1 * cs - x2 * sn, y2 = x2 * cs + x1 * sn;
      x1 = y1;
      x2 = y2;
    }
    if (isq) {
      x1 *= 0.125f;
      x2 *= 0.125f;
    }
    if (isq || a >= CTX) {
      QKV[off] = f2bf(x1);
      QKV[off + 16] = f2bf(x2);
    }
  }
}

__device__ __forceinline__ float shiftmix(const bf* PB, const float* mu, int R, int a, int col) {
  int lo = a < CTX ? 0 : CTX, hi = a < CTX ? CTX : TA;
  float t = bf2f(PB[(size_t)R * 1792 + col]);
  float pv = a > lo ? bf2f(PB[(size_t)(R - 1) * 1792 + col]) : 0.f;
  float nx = a + 1 < hi ? bf2f(PB[(size_t)(R + 1) * 1792 + col]) : 0.f;
  return t + (0.5f * (pv + nx) - t) * mu[col];
}
__device__ __forceinline__ void ph_rwkv_prep(const P& p, char* smem) {
  float* lin = (float*)smem;
  const int tid = threadIdx.x, lane = tid & 63, wave = tid >> 6;
  const bf* PB = (const bf*)p.out;
  const float* mu = p.in[17];
  const float *w0f = p.in[18], *w2f = p.in[19], *w0b = p.in[20], *w2b = p.in[21], *a0 = p.in[22], *a2 = p.in[23], *g2 = p.in[24];
  const float *k_k = p.in[25], *k_a = p.in[26], *r_k = p.in[27];
  bf* PR = (bf*)(p.ws + OFF_PREP);
  bf* PK = PR + (size_t)RT * 512;
  bf* PV = PK + (size_t)RT * 512;
  bf* PKK = PV + (size_t)RT * 512;
  bf* PKA = PKK + (size_t)RT * 512;
  bf* PLF = PKA + (size_t)RT * 512;
  bf* PLB = PLF + (size_t)RT * 512;
  bf* G = (bf*)(p.ws + OFF_G);
  float* BON = (float*)(p.ws + OFF_BONUS);
  const int c = tid;
  for (int unit = blockIdx.x; unit < RT / 16; unit += gridDim.x) {
    int R0 = unit * 16;
    int b = R0 / TA, a00 = R0 - b * TA;
    __syncthreads();
#pragma unroll
    for (int i = 0; i < 8; ++i) {
      int idx = tid + NT * i;
      int tok = idx >> 8, j = idx & 255;
      float f = shiftmix(PB, mu, R0 + tok, a00 + tok, 1536 + j);
      float val = j < 64 ? tanhf(f) : (j < 128 ? f : sigmoidf_(f));
      lin[j * 16 + tok] = val;
    }
    __syncthreads();
    float aa[16], wf[16], wb[16], gg[16];
#pragma unroll
    for (int t = 0; t < 16; ++t) { aa[t] = 0.f; wf[t] = 0.f; wb[t] = 0.f; gg[t] = 0.f; }
    for (int j = 0; j < 64; ++j) {
      float x2f = w2f[j * 512 + c], x2b = w2b[j * 512 + c];
      const float4* lp = (const float4*)(lin + j * 16);
#pragma unroll
      for (int q = 0; q < 4; ++q) {
        float4 t4 = lp[q];
        wf[q * 4 + 0] += t4.x * x2f; wf[q * 4 + 1] += t4.y * x2f; wf[q * 4 + 2] += t4.z * x2f; wf[q * 4 + 3] += t4.w * x2f;
        wb[q * 4 + 0] += t4.x * x2b; wb[q * 4 + 1] += t4.y * x2b; wb[q * 4 + 2] += t4.z * x2b; wb[q * 4 + 3] += t4.w * x2b;
      }
    }
    for (int j = 0; j < 64; ++j) {
      float xa = a2[j * 512 + c];
      const float4* lp = (const float4*)(lin + (64 + j) * 16);
#pragma unroll
      for (int q = 0; q < 4; ++q) {
        float4 t4 = lp[q];
        aa[q * 4 + 0] += t4.x * xa; aa[q * 4 + 1] += t4.y * xa; aa[q * 4 + 2] += t4.z * xa; aa[q * 4 + 3] += t4.w * xa;
      }
    }
    for (int j = 0; j < 128; ++j) {
      float xg = g2[j * 512 + c];
      const float4* lp = (const float4*)(lin + (128 + j) * 16);
#pragma unroll
      for (int q = 0; q < 4; ++q) {
        float4 t4 = lp[q];
        gg[q * 4 + 0] += t4.x * xg; gg[q * 4 + 1] += t4.y * xg; gg[q * 4 + 2] += t4.z * xg; gg[q * 4 + 3] += t4.w * xg;
      }
    }
    const float vw0f = w0f[c], vw0b = w0b[c], va0 = a0[c], vkk = k_k[c], vka = k_a[c], vrk = r_k[c];
#pragma unroll
    for (int t = 0; t < 16; ++t) {
      int R = R0 + t, a = a00 + t;
      float fr = shiftmix(PB, mu, R, a, c);
      float fk = shiftmix(PB, mu, R, a, 512 + c);
      float fv = shiftmix(PB, mu, R, a, 1024 + c);
      float av = sigmoidf_(va0 + aa[t]);
      float lwf = -expf(-softplusf_(-(vw0f + wf[t])) - 0.5f);
      float lwb = -expf(-softplusf_(-(vw0b + wb[t])) - 0.5f);
      float kk = fk * vkk;
      float n2 = wave_sum(kk * kk);
      kk = kk / fmaxf(sqrtf(n2), 1e-12f);
      float kmod = fk * (1.f + (av - 1.f) * vka);
      float bon = wave_sum(fr * kmod * vrk);
      size_t o = (size_t)R * 512 + c;
      PR[o] = f2bf(fr);
      PK[o] = f2bf(kmod);
      PV[o] = f2bf(fv);
      PKK[o] = f2bf(kk);
      PKA[o] = f2bf(kk * av);
      PLF[o] = f2bf(lwf);
      PLB[o] = f2bf(lwb);
      G[o] = f2bf(gg[t]);
      if (lane == 0) BON[(size_t)R * 8 + wave] = bon;
    }
  }
}

__device__ __forceinline__ int scan_row(int b, int dir, int s) {
  int a = dir ? (s < CTX ? CTX - 1 - s : TA + CTX - 1 - s) : s;
  return b * TA + a;
}

__device__ __forceinline__ void rwkv_chain(const P& p, int chain, char* smem) {
  const int dir = chain & 1, h = (chain >> 1) & 7, b = chain >> 4;
  float* cR = (float*)smem;
  float* cW = cR + 2048;
  float* cK = cW + 2048;
  float* cKK = cK + 2048;
  float* cKA = cKK + 2048;
  float* cV = cKA + 2048;
  float* yb = cV + 2048;
  const int tid = threadIdx.x, lane = tid & 63, wave = tid >> 6;
  const int l15 = lane & 15, lg = lane >> 4;
  const bf* PR = (const bf*)(p.ws + OFF_PREP);
  const bf* PK = PR + (size_t)RT * 512;
  const bf* PV = PK + (size_t)RT * 512;
  const bf* PKK = PV + (size_t)RT * 512;
  const bf* PKA = PKK + (size_t)RT * 512;
  const bf* PLW = PKA + (size_t)RT * 512 + (size_t)dir * RT * 512;
  bf* Y = (bf*)p.out + (size_t)dir * RT * 512;
  const int st = tid >> 4, c4 = (tid & 15) * 4;
  const int r0 = wave * 8 + lg * 2;
  float s0[4], s1[4];
#pragma unroll
  for (int j = 0; j < 4; ++j) { s0[j] = 0.f; s1[j] = 0.f; }
  uint2 gR, gW, gK, gV, gKK, gKA;
  {
    size_t o = (size_t)scan_row(b, dir, st) * 512 + h * 64 + c4;
    gR = *(const uint2*)(PR + o); gW = *(const uint2*)(PLW + o); gK = *(const uint2*)(PK + o);
    gV = *(const uint2*)(PV + o); gKK = *(const uint2*)(PKK + o); gKA = *(const uint2*)(PKA + o);
  }
  const int NCH = TA / 32;
  for (int ch = 0; ch <= NCH; ++ch) {
    __syncthreads();
    if (ch > 0) {
      float4 y4 = *(const float4*)(yb + st * 64 + c4);
      uint2 o2;
      o2.x = pack2(y4.x, y4.y);
      o2.y = pack2(y4.z, y4.w);
      *(uint2*)(Y + (size_t)scan_row(b, dir, (ch - 1) * 32 + st) * 512 + h * 64 + c4) = o2;
    }
    if (ch == NCH) break;
    {
      int o = st * 64 + c4;
      *(float4*)(cR + o) = make_float4(bflo(gR.x), bfhi(gR.x), bflo(gR.y), bfhi(gR.y));
      *(float4*)(cW + o) = make_float4(expf(bflo(gW.x)), expf(bfhi(gW.x)), expf(bflo(gW.y)), expf(bfhi(gW.y)));
      *(float4*)(cK + o) = make_float4(bflo(gK.x), bfhi(gK.x), bflo(gK.y), bfhi(gK.y));
      *(float4*)(cV + o) = make_float4(bflo(gV.x), bfhi(gV.x), bflo(gV.y), bfhi(gV.y));
      *(float4*)(cKK + o) = make_float4(bflo(gKK.x), bfhi(gKK.x), bflo(gKK.y), bfhi(gKK.y));
      *(float4*)(cKA + o) = make_float4(bflo(gKA.x), bfhi(gKA.x), bflo(gKA.y), bfhi(gKA.y));
    }
    __syncthreads();
    if (ch + 1 < NCH) {
      size_t o = (size_t)scan_row(b, dir, (ch + 1) * 32 + st) * 512 + h * 64 + c4;
      gR = *(const uint2*)(PR + o); gW = *(const uint2*)(PLW + o); gK = *(const uint2*)(PK + o);
      gV = *(const uint2*)(PV + o); gKK = *(const uint2*)(PKK + o); gKA = *(const uint2*)(PKA + o);
    }
#pragma unroll 4
    for (int t = 0; t < 32; ++t) {
      float4 kk4 = *(const float4*)(cKK + t * 64 + l15 * 4);
      float4 w4 = *(const float4*)(cW + t * 64 + l15 * 4);
      float4 k4 = *(const float4*)(cK + t * 64 + l15 * 4);
      float4 ka4 = *(const float4*)(cKA + t * 64 + l15 * 4);
      float4 r4 = *(const float4*)(cR + t * 64 + l15 * 4);
      float2 v2 = *(const float2*)(cV + t * 64 + r0);
      float sa0 = s0[0] * kk4.x + s0[1] * kk4.y + s0[2] * kk4.z + s0[3] * kk4.w;
      float sa1 = s1[0] * kk4.x + s1[1] * kk4.y + s1[2] * kk4.z + s1[3] * kk4.w;
      sa0 = red16(sa0);
      sa1 = red16(sa1);
      s0[0] = s0[0] * w4.x + (v2.x * k4.x - sa0 * ka4.x);
      s0[1] = s0[1] * w4.y + (v2.x * k4.y - sa0 * ka4.y);
      s0[2] = s0[2] * w4.z + (v2.x * k4.z - sa0 * ka4.z);
      s0[3] = s0[3] * w4.w + (v2.x * k4.w - sa0 * ka4.w);
      s1[0] = s1[0] * w4.x + (v2.y * k4.x - sa1 * ka4.x);
      s1[1] = s1[1] * w4.y + (v2.y * k4.y - sa1 * ka4.y);
      s1[2] = s1[2] * w4.z + (v2.y * k4.z - sa1 * ka4.z);
      s1[3] = s1[3] * w4.w + (v2.y * k4.w - sa1 * ka4.w);
      float y0 = s0[0] * r4.x + s0[1] * r4.y + s0[2] * r4.z + s0[3] * r4.w;
      float y1 = s1[0] * r4.x + s1[1] * r4.y + s1[2] * r4.z + s1[3] * r4.w;
      y0 = red16(y0);
      y1 = red16(y1);
      if (l15 == 0) *(float2*)(yb + t * 64 + r0) = make_float2(y0, y1);
    }
  }
}

__device__ __forceinline__ void attn_unit(const P& p, int u, char* smem, float lam) {
  bf* Ks = (bf*)smem;
  bf* Vt = Ks + 64 * 136;
  int b, h, nkeys, qa0;
  if (u < 1024) { b = u >> 7; h = (u >> 5) & 3; nkeys = TA; qa0 = CTX + (u & 31) * 128; }
  else { int v = u - 1024; b = v >> 3; h = (v >> 1) & 3; nkeys = CTX; qa0 = (v & 1) * 128; }
  const bf* QKV = (const bf*)(p.ws + OFF_QKV);
  const int tid = threadIdx.x, lane = tid & 63, wave = tid >> 6;
  const int l15 = lane & 15, lg = lane >> 4;
  const size_t rowbase = (size_t)b * TA;
  bf16x8 qf[2][2];
  {
    size_t Rq = rowbase + qa0 + wave * 16 + l15;
#pragma unroll
    for (int m = 0; m < 2; ++m)
#pragma unroll
      for (int ks = 0; ks < 2; ++ks) qf[m][ks] = *(const bf16x8*)(QKV + Rq * 1536 + h * 128 + m * 64 + ks * 32 + lg * 8);
  }
  f32x4 oacc[2][8];
#pragma unroll
  for (int m = 0; m < 2; ++m)
#pragma unroll
    for (int n = 0; n < 8; ++n) oacc[m][n] = (f32x4){0.f, 0.f, 0.f, 0.f};
  float mrun[2] = {-INFINITY, -INFINITY}, lrun[2] = {0.f, 0.f};
  for (int k0 = 0; k0 < nkeys; k0 += 64) {
    __syncthreads();
#pragma unroll
    for (int i = 0; i < 2; ++i) {
      int c = tid + NT * i, r = c >> 4, cc = c & 15;
      const bf* src = QKV + (rowbase + k0 + r) * 1536 + h * 128 + cc * 8;
      uint4 kv = *(const uint4*)(src + 512);
      *(uint4*)(Ks + r * 136 + cc * 8) = kv;
      uint4 vv = *(const uint4*)(src + 1024);
      bf* vd = Vt + (cc * 8) * 72 + r;
      vd[0 * 72] = (bf)(vv.x & 0xffff); vd[1 * 72] = (bf)(vv.x >> 16);
      vd[2 * 72] = (bf)(vv.y & 0xffff); vd[3 * 72] = (bf)(vv.y >> 16);
      vd[4 * 72] = (bf)(vv.z & 0xffff); vd[5 * 72] = (bf)(vv.z >> 16);
      vd[6 * 72] = (bf)(vv.w & 0xffff); vd[7 * 72] = (bf)(vv.w >> 16);
    }
    __syncthreads();
#pragma unroll
    for (int m = 0; m < 2; ++m) {
      f32x4 s[4];
#pragma unroll
      for (int kt = 0; kt < 4; ++kt) s[kt] = (f32x4){0.f, 0.f, 0.f, 0.f};
#pragma unroll
      for (int ks = 0; ks < 2; ++ks)
#pragma unroll
        for (int kt = 0; kt < 4; ++kt) {
          bf16x8 a = *(const bf16x8*)(Ks + (kt * 16 + l15) * 136 + m * 64 + ks * 32 + lg * 8);
          s[kt] = __builtin_amdgcn_mfma_f32_16x16x32_bf16(a, qf[m][ks], s[kt], 0, 0, 0);
        }
      float mx = s[0][0];
#pragma unroll
      for (int kt = 0; kt < 4; ++kt)
#pragma unroll
        for (int r = 0; r < 4; ++r) mx = fmaxf(mx, s[kt][r]);
      mx = fmaxf(mx, __shfl_xor(mx, 16));
      mx = fmaxf(mx, __shfl_xor(mx, 32));
      float mnew = fmaxf(mrun[m], mx);
      float alpha = __expf(mrun[m] - mnew);
      mrun[m] = mnew;
      float ps = 0.f;
#pragma unroll
      for (int kt = 0; kt < 4; ++kt)
#pragma unroll
        for (int r = 0; r < 4; ++r) {
          float e = __expf(s[kt][r] - mnew);
          s[kt][r] = e;
          ps += e;
        }
      lrun[m] = lrun[m] * alpha + ps;
      bf16x8 pf[2];
#pragma unroll
      for (int si = 0; si < 2; ++si) {
        i32x4 t;
        t[0] = (int)pack2(s[2 * si][0], s[2 * si][1]);
        t[1] = (int)pack2(s[2 * si][2], s[2 * si][3]);
        t[2] = (int)pack2(s[2 * si + 1][0], s[2 * si + 1][1]);
        t[3] = (int)pack2(s[2 * si + 1][2], s[2 * si + 1][3]);
        pf[si] = __builtin_bit_cast(bf16x8, t);
      }
      float al[4];
#pragma unroll
      for (int r = 0; r < 4; ++r) al[r] = __shfl(alpha, lg * 4 + r);
#pragma unroll
      for (int n = 0; n < 8; ++n)
#pragma unroll
        for (int r = 0; r < 4; ++r) oacc[m][n][r] *= al[r];
#pragma unroll
      for (int si = 0; si < 2; ++si)
#pragma unroll
        for (int n = 0; n < 8; ++n) {
          const bf* vp = Vt + (n * 16 + l15) * 72 + si * 32 + lg * 4;
          uint2 v0 = *(const uint2*)vp;
          uint2 v1 = *(const uint2*)(vp + 16);
          i32x4 t;
          t[0] = (int)v0.x; t[1] = (int)v0.y; t[2] = (int)v1.x; t[3] = (int)v1.y;
          oacc[m][n] = __builtin_amdgcn_mfma_f32_16x16x32_bf16(pf[si], __builtin_bit_cast(bf16x8, t), oacc[m][n], 0, 0, 0);
        }
    }
  }
  float inv[2];
#pragma unroll
  for (int m = 0; m < 2; ++m) {
    float l = lrun[m];
    l += __shfl_xor(l, 16);
    l += __shfl_xor(l, 32);
    inv[m] = 1.f / l;
  }
  float i1[4], i2[4];
#pragma unroll
  for (int r = 0; r < 4; ++r) { i1[r] = __shfl(inv[0], lg * 4 + r); i2[r] = __shfl(inv[1], lg * 4 + r); }
  float ss[4] = {0.f, 0.f, 0.f, 0.f};
#pragma unroll
  for (int n = 0; n < 8; ++n)
#pragma unroll
    for (int r = 0; r < 4; ++r) {
      float o = oacc[0][n][r] * i1[r] - lam * (oacc[1][n][r] * i2[r]);
      oacc[0][n][r] = o;
      ss[r] += o * o;
    }
  const float* subln = p.in[16];
  bf* O = (bf*)(p.ws + OFF_HO);
#pragma unroll
  for (int r = 0; r < 4; ++r) {
    float t = red16(ss[r]);
    float scl = rsqrtf(t * (1.f / 128.f) + 1e-5f) * 0.8f;
    size_t Ro = rowbase + qa0 + wave * 16 + lg * 4 + r;
#pragma unroll
    for (int n = 0; n < 8; ++n) O[Ro * 1024 + h * 128 + n * 16 + l15] = f2bf(oacc[0][n][r] * scl * subln[n * 16 + l15]);
  }
}

__device__ __forceinline__ void ph_mix0(const P& p, char* smem) {
  __shared__ int s_unit;
  for (int chain = blockIdx.x; chain < 128; chain += gridDim.x) rwkv_chain(p, chain, smem);
  float d1 = 0.f, d2 = 0.f;
  for (int i = 0; i < 64; ++i) { d1 += p.in[12][i] * p.in[13][i]; d2 += p.in[14][i] * p.in[15][i]; }
  float lam = expf(d1) - expf(d2) + 0.2f;
  int* cnt = (int*)(p.ws + OFF_CNT);
  while (true) {
    __syncthreads();
    if (threadIdx.x == 0) s_unit = atomicAdd(cnt, 1);
    __syncthreads();
    int u = s_unit;
    if (u >= 1088) break;
    attn_unit(p, u, smem, lam);
  }
}

__device__ __forceinline__ void ph_rwkv_post(const P& p) {
  const int tid = threadIdx.x, wave = tid >> 6;
  const bf* YF = (const bf*)p.out;
  const bf* YB = YF + (size_t)RT * 512;
  const bf* PV = (const bf*)(p.ws + OFF_PREP) + (size_t)2 * RT * 512;
  const bf* G = (const bf*)(p.ws + OFF_G);
  const float* BON = (const float*)(p.ws + OFF_BONUS);
  bf* O = (bf*)(p.ws + OFF_HO);
  const float lw = p.in[28][tid], lb = p.in[29][tid];
  for (int R = blockIdx.x; R < RT; R += gridDim.x) {
    size_t o = (size_t)R * 512 + tid;
    float y = bf2f(YF[o]) + bf2f(YB[o]);
    float mean = wave_sum(y) * (1.f / 64.f);
    float d = y - mean;
    float var = wave_sum(d * d) * (1.f / 64.f);
    float yn = d * rsqrtf(var + 64e-5f) * lw + lb;
    float outv = (yn + BON[(size_t)R * 8 + wave] * bf2f(PV[o])) * bf2f(G[o]);
    O[(size_t)R * 1024 + 512 + tid] = f2bf(outv);
  }
}

__device__ __forceinline__ void ph_conv(const P& p) {
  const bf* XR = (const bf*)(p.ws + OFF_XRAW);
  bf* XO = (bf*)(p.ws + OFF_XBC);
  const float* cw = p.in[38];
  const float* cb = p.in[39];
  for (size_t it = (size_t)blockIdx.x * NT + threadIdx.x; it < (size_t)RT * 128; it += (size_t)gridDim.x * NT) {
    int R = (int)(it >> 7), c8 = (int)(it & 127) * 8;
    int b = R / TA, a = R - b * TA;
    int lo = a < CTX ? 0 : CTX, hi = a < CTX ? CTX : TA;
    float acc[8];
#pragma unroll
    for (int e = 0; e < 8; ++e) acc[e] = cb[c8 + e];
#pragma unroll
    for (int j = 0; j < 5; ++j) {
      int aj = a + j - 2;
      if (aj >= lo && aj < hi) {
        uint4 v = *(const uint4*)(XR + (size_t)(R + j - 2) * 1024 + c8);
        const float* w = cw + j * 1024 + c8;
        acc[0] += w[0] * bflo(v.x); acc[1] += w[1] * bfhi(v.x);
        acc[2] += w[2] * bflo(v.y); acc[3] += w[3] * bfhi(v.y);
        acc[4] += w[4] * bflo(v.z); acc[5] += w[5] * bfhi(v.z);
        acc[6] += w[6] * bflo(v.w); acc[7] += w[7] * bfhi(v.w);
      }
    }
    uint4 o;
    o.x = pack2(siluf_(acc[0]), siluf_(acc[1]));
    o.y = pack2(siluf_(acc[2]), siluf_(acc[3]));
    o.z = pack2(siluf_(acc[4]), siluf_(acc[5]));
    o.w = pack2(siluf_(acc[6]), siluf_(acc[7]));
    *(uint4*)(XO + (size_t)R * 1024 + c8) = o;
  }
}

__device__ __forceinline__ void ssd_chain(const P& p, int chain, char* smem) {
  const int dir = chain & 1, hh = (chain >> 1) & 7, b = chain >> 4;
  const int grp = hh >> 2;
  float* cB = (float*)smem;
  float* cC = cB + 4096;
  float* cX = cC + 4096;
  float* cDA = cX + 2048;
  float* yb = cDA + 32;
  const int tid = threadIdx.x, lane = tid & 63, wave = tid >> 6;
  const int l15 = lane & 15, lg = lane >> 4;
  const bf* XBC = (const bf*)(p.ws + OFF_XBC);
  const float* DTR = (const float*)(p.ws + OFF_DTRAW);
  bf* Y = (bf*)(p.ws + OFF_XRAW) + (size_t)dir * RT * 512;
  const float dtb = p.in[dir ? 42 : 40][hh];
  const float Aneg = -expf(p.in[dir ? 43 : 41][hh]);
  const int st = tid >> 4, q = tid & 15;
  const int r0 = wave * 8 + lg * 2;
  float s0[8], s1[8];
#pragma unroll
  for (int j = 0; j < 8; ++j) { s0[j] = 0.f; s1[j] = 0.f; }
  uint4 gB, gC;
  uint2 gX;
  float gD;
  {
    size_t R = (size_t)scan_row(b, dir, st);
    gB = *(const uint4*)(XBC + R * 1024 + 512 + grp * 128 + q * 8);
    gC = *(const uint4*)(XBC + R * 1024 + 768 + grp * 128 + q * 8);
    gX = *(const uint2*)(XBC + R * 1024 + hh * 64 + q * 4);
    gD = DTR[R * 16 + dir * 8 + hh];
  }
  const int NCH = TA / 32;
  for (int ch = 0; ch <= NCH; ++ch) {
    __syncthreads();
    if (ch > 0) {
      float4 y4 = *(const float4*)(yb + st * 64 + q * 4);
      uint2 o2;
      o2.x = pack2(y4.x, y4.y);
      o2.y = pack2(y4.z, y4.w);
      *(uint2*)(Y + (size_t)scan_row(b, dir, (ch - 1) * 32 + st) * 512 + hh * 64 + q * 4) = o2;
    }
    if (ch == NCH) break;
    {
      float dt = softplusf_(gD + dtb);
      float dA = expf(dt * Aneg);
      float* d = cB + st * 128 + q * 8;
      *(float4*)d = make_float4(bflo(gB.x), bfhi(gB.x), bflo(gB.y), bfhi(gB.y));
      *(float4*)(d + 4) = make_float4(bflo(gB.z), bfhi(gB.z), bflo(gB.w), bfhi(gB.w));
      d = cC + st * 128 + q * 8;
      *(float4*)d = make_float4(bflo(gC.x), bfhi(gC.x), bflo(gC.y), bfhi(gC.y));
      *(float4*)(d + 4) = make_float4(bflo(gC.z), bfhi(gC.z), bflo(gC.w), bfhi(gC.w));
      *(float4*)(cX + st * 64 + q * 4) = make_float4(bflo(gX.x) * dt, bfhi(gX.x) * dt, bflo(gX.y) * dt, bfhi(gX.y) * dt);
      if (q == 0) cDA[st] = dA;
    }
    __syncthreads();
    if (ch + 1 < NCH) {
      size_t R = (size_t)scan_row(b, dir, (ch + 1) * 32 + st);
      gB = *(const uint4*)(XBC + R * 1024 + 512 + grp * 128 + q * 8);
      gC = *(const uint4*)(XBC + R * 1024 + 768 + grp * 128 + q * 8);
      gX = *(const uint2*)(XBC + R * 1024 + hh * 64 + q * 4);
      gD = DTR[R * 16 + dir * 8 + hh];
    }
#pragma unroll 4
    for (int t = 0; t < 32; ++t) {
      float4 b0 = *(const float4*)(cB + t * 128 + l15 * 8);
      float4 b1 = *(const float4*)(cB + t * 128 + l15 * 8 + 4);
      float4 c0 = *(const float4*)(cC + t * 128 + l15 * 8);
      float4 c1 = *(const float4*)(cC + t * 128 + l15 * 8 + 4);
      float2 x2 = *(const float2*)(cX + t * 64 + r0);
      float dA = cDA[t];
      s0[0] = s0[0] * dA + x2.x * b0.x; s0[1] = s0[1] * dA + x2.x * b0.y; s0[2] = s0[2] * dA + x2.x * b0.z; s0[3] = s0[3] * dA + x2.x * b0.w;
      s0[4] = s0[4] * dA + x2.x * b1.x; s0[5] = s0[5] * dA + x2.x * b1.y; s0[6] = s0[6] * dA + x2.x * b1.z; s0[7] = s0[7] * dA + x2.x * b1.w;
      s1[0] = s1[0] * dA + x2.y * b0.x; s1[1] = s1[1] * dA + x2.y * b0.y; s1[2] = s1[2] * dA + x2.y * b0.z; s1[3] = s1[3] * dA + x2.y * b0.w;
      s1[4] = s1[4] * dA + x2.y * b1.x; s1[5] = s1[5] * dA + x2.y * b1.y; s1[6] = s1[6] * dA + x2.y * b1.z; s1[7] = s1[7] * dA + x2.y * b1.w;
      float y0 = s0[0] * c0.x + s0[1] * c0.y + s0[2] * c0.z + s0[3] * c0.w + s0[4] * c1.x + s0[5] * c1.y + s0[6] * c1.z + s0[7] * c1.w;
      float y1 = s1[0] * c0.x + s1[1] * c0.y + s1[2] * c0.z + s1[3] * c0.w + s1[4] * c1.x + s1[5] * c1.y + s1[6] * c1.z + s1[7] * c1.w;
      y0 = red16(y0);
      y1 = red16(y1);
      if (l15 == 0) *(float2*)(yb + t * 64 + r0) = make_float2(y0, y1);
    }
  }
}

__device__ __forceinline__ void gla_chain(const P& p, int chain, char* smem) {
  const int dir = chain & 1, h = (chain >> 1) & 3, b = chain >> 3;
  float* cQ = (float*)smem;
  float* cK = cQ + 2048;
  float* cD = cK + 2048;
  float* cV = cD + 2048;
  float* yb = cV + 4096;
  float* up = yb + 4096;
  float* gbias = up + 1024;
  const int tid = threadIdx.x, lane = tid & 63, wave = tid >> 6;
  const int l15 = lane & 15, lg = lane >> 4;
  const bf* P1 = (const bf*)(p.ws + OFF_P1C);
  bf* Y = (bf*)(p.ws + OFF_GY) + (size_t)dir * RT * 512;
  const float* gup = p.in[dir ? 48 : 46];
  const float* gb = p.in[dir ? 49 : 47];
  __syncthreads();
  for (int i = tid; i < 1024; i += NT) up[i] = gup[(i >> 6) * 256 + h * 64 + (i & 63)];
  if (tid < 64) gbias[tid] = gb[h * 64 + tid];
  const int st = tid >> 4, q = tid & 15;
  const int r0 = wave * 16 + lg * 4;
  float s[4][4];
#pragma unroll
  for (int r = 0; r < 4; ++r)
#pragma unroll
    for (int j = 0; j < 4; ++j) s[r][j] = 0.f;
  uint2 gQ, gK;
  uint4 gV, gG0, gG1;
  {
    const bf* row = P1 + (size_t)scan_row(b, dir, st) * 2080;
    gQ = *(const uint2*)(row + 528 + h * 64 + q * 4);
    gK = *(const uint2*)(row + 784 + h * 64 + q * 4);
    gV = *(const uint4*)(row + 1040 + h * 128 + q * 8);
    gG0 = *(const uint4*)(row + 2064);
    gG1 = *(const uint4*)(row + 2072);
  }
  const int NCH = TA / 32;
  for (int ch = 0; ch <= NCH; ++ch) {
    __syncthreads();
    if (ch > 0) {
      float4 ya = *(const float4*)(yb + st * 128 + q * 8);
      float4 yc = *(const float4*)(yb + st * 128 + q * 8 + 4);
      uint4 o4;
      o4.x = pack2(ya.x, ya.y); o4.y = pack2(ya.z, ya.w); o4.z = pack2(yc.x, yc.y); o4.w = pack2(yc.z, yc.w);
      *(uint4*)(Y + (size_t)scan_row(b, dir, (ch - 1) * 32 + st) * 512 + h * 128 + q * 8) = o4;
    }
    if (ch == NCH) break;
    {
      float gd[16];
      gd[0] = bflo(gG0.x); gd[1] = bfhi(gG0.x); gd[2] = bflo(gG0.y); gd[3] = bfhi(gG0.y);
      gd[4] = bflo(gG0.z); gd[5] = bfhi(gG0.z); gd[6] = bflo(gG0.w); gd[7] = bfhi(gG0.w);
      gd[8] = bflo(gG1.x); gd[9] = bfhi(gG1.x); gd[10] = bflo(gG1.y); gd[11] = bfhi(gG1.y);
      gd[12] = bflo(gG1.z); gd[13] = bfhi(gG1.z); gd[14] = bflo(gG1.w); gd[15] = bfhi(gG1.w);
      float4 z = *(const float4*)(gbias + q * 4);
#pragma unroll
      for (int i = 0; i < 16; ++i) {
        float4 u4 = *(const float4*)(up + i * 64 + q * 4);
        z.x += gd[i] * u4.x; z.y += gd[i] * u4.y; z.z += gd[i] * u4.z; z.w += gd[i] * u4.w;
      }
      float4 dd;
      dd.x = expf(-softplusf_(-z.x) * (1.f / 16.f));
      dd.y = expf(-softplusf_(-z.y) * (1.f / 16.f));
      dd.z = expf(-softplusf_(-z.z) * (1.f / 16.f));
      dd.w = expf(-softplusf_(-z.w) * (1.f / 16.f));
      *(float4*)(cD + st * 64 + q * 4) = dd;
      *(float4*)(cQ + st * 64 + q * 4) = make_float4(bflo(gQ.x) * 0.125f, bfhi(gQ.x) * 0.125f, bflo(gQ.y) * 0.125f, bfhi(gQ.y) * 0.125f);
      *(float4*)(cK + st * 64 + q * 4) = make_float4(bflo(gK.x), bfhi(gK.x), bflo(gK.y), bfhi(gK.y));
      float* d = cV + st * 128 + q * 8;
      *(float4*)d = make_float4(bflo(gV.x), bfhi(gV.x), bflo(gV.y), bfhi(gV.y));
      *(float4*)(d + 4) = make_float4(bflo(gV.z), bfhi(gV.z), bflo(gV.w), bfhi(gV.w));
    }
    __syncthreads();
    if (ch + 1 < NCH) {
      const bf* row = P1 + (size_t)scan_row(b, dir, (ch + 1) * 32 + st) * 2080;
      gQ = *(const uint2*)(row + 528 + h * 64 + q * 4);
      gK = *(const uint2*)(row + 784 + h * 64 + q * 4);
      gV = *(const uint4*)(row + 1040 + h * 128 + q * 8);
      gG0 = *(const uint4*)(row + 2064);
      gG1 = *(const uint4*)(row + 2072);
    }
#pragma unroll 4
    for (int t = 0; t < 32; ++t) {
      float4 q4 = *(const float4*)(cQ + t * 64 + l15 * 4);
      float4 k4 = *(const float4*)(cK + t * 64 + l15 * 4);
      float4 d4 = *(const float4*)(cD + t * 64 + l15 * 4);
      float4 v4 = *(const float4*)(cV + t * 128 + r0);
      float vv[4] = {v4.x, v4.y, v4.z, v4.w};
      float yy[4];
#pragma unroll
      for (int r = 0; r < 4; ++r) {
        s[r][0] = s[r][0] * d4.x + k4.x * vv[r];
        s[r][1] = s[r][1] * d4.y + k4.y * vv[r];
        s[r][2] = s[r][2] * d4.z + k4.z * vv[r];
        s[r][3] = s[r][3] * d4.w + k4.w * vv[r];
        yy[r] = red16(s[r][0] * q4.x + s[r][1] * q4.y + s[r][2] * q4.z + s[r][3] * q4.w);
      }
      if (l15 == 0) *(float4*)(yb + t * 128 + r0) = make_float4(yy[0], yy[1], yy[2], yy[3]);
    }
  }
}

__device__ __forceinline__ void ph_mix1(const P& p, char* smem) {
  for (int u = blockIdx.x; u < 192; u += gridDim.x) {
    if (u < 128) ssd_chain(p, u, smem);
    else gla_chain(p, u - 128, smem);
  }
}

__device__ __forceinline__ void ph_post1(const P& p, char* smem) {
  float* ws1 = (float*)smem;
  float* ws2 = ws1 + 8;
  const int tid = threadIdx.x, lane = tid & 63, wave = tid >> 6;
  const bf* SYF = (const bf*)(p.ws + OFF_XRAW);
  const bf* SYB = SYF + (size_t)RT * 512;
  const bf* GYF = (const bf*)(p.ws + OFF_GY);
  const bf* GYB = GYF + (size_t)RT * 512;
  const bf* XBC = (const bf*)(p.ws + OFF_XBC);
  const bf* P1 = (const bf*)(p.ws + OFF_P1C);
  bf* O = (bf*)(p.ws + OFF_HO);
  const float dsk = p.in[44][tid >> 6];
  const float sn = p.in[45][tid];
  const float gn = p.in[50][tid & 127];
  for (int rr = blockIdx.x; rr < NBAT * SEQ; rr += gridDim.x) {
    int b = rr >> 12;
    int R = b * TA + CTX + (rr & 4095);
    size_t o = (size_t)R * 512 + tid;
    float y = bf2f(SYF[o]) + bf2f(SYB[o]) + bf2f(XBC[(size_t)R * 1024 + tid]) * dsk;
    y *= siluf_(bf2f(P1[(size_t)R * 2080 + tid]));
    float s1 = wave_sum(y * y);
    float y2 = bf2f(GYF[o]) + bf2f(GYB[o]);
    float s2 = wave_sum(y2 * y2);
    __syncthreads();
    if (lane == 0) { ws1[wave] = s1; ws2[wave] = s2; }
    __syncthreads();
    int g4 = (wave >> 2) * 4;
    float t1 = ws1[g4] + ws1[g4 + 1] + ws1[g4 + 2] + ws1[g4 + 3];
    int g2 = (wave >> 1) * 2;
    float t2 = ws2[g2] + ws2[g2 + 1];
    float o1 = y * rsqrtf(t1 * (1.f / 256.f) + 1e-6f) * sn;
    float o2 = y2 * rsqrtf(t2 * (1.f / 128.f) + 1e-6f) * gn * siluf_(bf2f(P1[(size_t)R * 2080 + 1552 + tid]));
    O[(size_t)R * 1024 + tid] = f2bf(o1);
    O[(size_t)R * 1024 + 512 + tid] = f2bf(o2);
  }
}

__device__ __forceinline__ void ph_final(const P& p) {
  const int lane = threadIdx.x & 63, wave = threadIdx.x >> 6;
  const float* g = p.in[51];
  for (int r = blockIdx.x * 8 + wave; r < NBAT * SEQ; r += gridDim.x * 8) {
    float* row = p.out + (size_t)r * 1024;
    float4 v[4];
    float ss = 0.f;
#pragma unroll
    for (int i = 0; i < 4; ++i) {
      v[i] = *(const float4*)(row + i * 256 + lane * 4);
      ss += v[i].x * v[i].x + v[i].y * v[i].y + v[i].z * v[i].z + v[i].w * v[i].w;
    }
    ss = wave_sum(ss);
    float rs = rsqrtf(ss * (1.f / 1024.f) + 1e-6f);
#pragma unroll
    for (int i = 0; i < 4; ++i) {
      float4 gg = *(const float4*)(g + i * 256 + lane * 4);
      float4 o = make_float4(v[i].x * rs * gg.x, v[i].y * rs * gg.y, v[i].z * rs * gg.z, v[i].w * rs * gg.w);
      *(float4*)(row + i * 256 + lane * 4) = o;
    }
  }
}

constexpr int NPH = 20;
__device__ __forceinline__ void run_phase(const P& p, int ph, char* smem) {
  const bf* WT = (const bf*)(p.ws + OFF_WT);
  const bf* HO = (const bf*)(p.ws + OFF_HO);
  const bf* HID = (const bf*)(p.ws + OFF_HID);
  GArgs g{HO, 1024, WT, 1024, 8, 0, 0, 0};
  bool isg = false, isada = false, iswt = false;
  int al = 0, aw = 0, ai = 0, alat = 0, wl = 0;
  switch (ph) {
    case 0:
      if (blockIdx.x == 0 && threadIdx.x == 0) *(int*)(p.ws + OFF_CNT) = 0;
      ph_mod(p, smem);
      iswt = true; wl = 0;
      break;
    case 1: isada = true; al = 0; aw = 0; ai = 1; alat = 0; break;
    case 2: g = GArgs{HO, 1024, WT + WT_IN, 1024, 26, 0, 0, 0}; isg = true; break;
    case 3: ph_rope(p, smem); ph_rwkv_prep(p, smem); break;
    case 4: ph_mix0(p, smem); break;
    case 5: ph_rwkv_post(p); break;
    case 6: g = GArgs{HO, 1024, WT + WT_OUT, 1024, 8, 2, 0, 0}; isg = true; break;
    case 7: isada = true; al = 0; aw = 1; ai = 0; alat = 0; break;
    case 8: g = GArgs{HO, 1024, WT + WT_W1, 1024, 32, 3, 0, 0}; isg = true; break;
    case 9: g = GArgs{HID, 4096, WT + WT_W2, 4096, 8, 4, 0, 0}; isg = true; break;
    case 10: isada = true; al = 1; aw = 0; ai = 0; alat = 0; iswt = true; wl = 1; break;
    case 11: g = GArgs{HO, 1024, WT + WT_IN, 1024, 25, 1, 1, 0}; isg = true; break;
    case 12: ph_conv(p); break;
    case 13: ph_mix1(p, smem); break;
    case 14: ph_post1(p, smem); break;
    case 15: g = GArgs{HO, 1024, WT + WT_OUT, 1024, 8, 2, 1, 1}; isg = true; break;
    case 16: isada = true; al = 1; aw = 1; ai = 0; alat = 1; break;
    case 17: g = GArgs{HO, 1024, WT + WT_W1, 1024, 32, 3, 1, 1}; isg = true; break;
    case 18: g = GArgs{HID, 4096, WT + WT_W2, 4096, 8, 4, 1, 1}; isg = true; break;
    default: ph_final(p); break;
  }
  if (isada) ph_ada(p, al, aw, ai, alat);
  if (iswt) ph_wt(p, wl, smem);
  if (isg) ph_gemm(p, g, smem);
}

#if MODE_COOP
template <int PH>
__device__ __forceinline__ void run_all(const P& p, char* smem) {
  run_phase(p, PH, smem);
  if constexpr (PH + 1 < NPH) {
    cg::this_grid().sync();
    run_all<PH + 1>(p, smem);
  }
}
__global__ void __launch_bounds__(NT) mega(P p) {
  __shared__ __attribute__((aligned(16))) char smem[63488];
  run_all<0>(p, smem);
}
#endif

template <int PH>
__global__ void __launch_bounds__(NT) phk(P p) {
  __shared__ __attribute__((aligned(16))) char smem[63488];
  run_phase(p, PH, smem);
}
template <int PH>
static void launch_all(const P& p, int grid, hipStream_t stream) {
  phk<PH><<<grid, NT, 0, stream>>>(p);
  if constexpr (PH + 1 < NPH) launch_all<PH + 1>(p, grid, stream);
}

extern "C" void kernel_launch(void* const* d_in, const int* in_sizes, int n_in, void* d_out, int out_size, void* d_ws,
                              size_t ws_size, hipStream_t stream) {
  P p{};
  for (int i = 0; i < 52; ++i) p.in[i] = (const float*)d_in[i];
  p.out = (float*)d_out;
  p.ws = (char*)d_ws;
  static int grid_blocks = 0;
  if (!grid_blocks) {
    int dev = 0, cus = 0, per_cu = 0;
    (void)hipGetDevice(&dev);
    (void)hipDeviceGetAttribute(&cus, hipDeviceAttributeMultiprocessorCount, dev);
    #if MODE_COOP
    (void)hipOccupancyMaxActiveBlocksPerMultiprocessor(&per_cu, mega, NT, 0);
#else
    per_cu = 1;
#endif
    if (per_cu < 1) per_cu = 1;
    if (per_cu > 1) per_cu = 1;
    grid_blocks = cus * per_cu;
  }
#if MODE_COOP
  void* args[] = {&p};
  hipError_t e = hipLaunchCooperativeKernel((void*)mega, dim3(grid_blocks), dim3(NT), args, 0, stream);
  if (e != hipSuccess) fprintf(stderr, "cooperative launch failed: %s (grid %d)\n", hipGetErrorString(e), grid_blocks);
#else
  launch_all<0>(p, grid_blocks, stream);
#endif
}
```

```cpp
#include <hip/hip_runtime.h>
#include <hip/hip_cooperative_groups.h>
#include <cstdio>
namespace cg = cooperative_groups;

#ifndef MODE_COOP
#define MODE_COOP 1
#endif

typedef unsigned short bf;
typedef __attribute__((ext_vector_type(8))) short bf16x8;
typedef __attribute__((ext_vector_type(4))) float f32x4;
typedef __attribute__((ext_vector_type(4))) int i32x4;

constexpr int NT = 512;
constexpr int Dm = 1024, NBAT = 8, SEQ = 4096, CTX = 256, TA = 4352, RT = NBAT * TA;

constexpr size_t OFF_MOD = 0;
constexpr size_t OFF_CNT = 450000;
constexpr size_t OFF_WT = 524288;
constexpr size_t WT_IN = 0, WT_OUT = (size_t)3328 * 1024, WT_W1 = WT_OUT + (size_t)1024 * 1024, WT_W2 = WT_W1 + (size_t)4096 * 1024;
constexpr size_t OFF_CTXX = OFF_WT + (size_t)12544 * 1024 * 2;
constexpr size_t OFF_HO = OFF_CTXX + (size_t)2048 * 1024 * 4;
constexpr size_t OFF_BIG = OFF_HO + (size_t)RT * 1024 * 2;
constexpr size_t SZ512 = (size_t)RT * 512 * 2;
constexpr size_t OFF_QKV = OFF_BIG;
constexpr size_t OFF_PREP = OFF_QKV + (size_t)RT * 1536 * 2;
constexpr size_t OFF_G = OFF_PREP + 7 * SZ512;
constexpr size_t OFF_BONUS = OFF_G + SZ512;
constexpr size_t OFF_HID = OFF_BIG;
constexpr size_t OFF_P1C = OFF_BIG;
constexpr size_t OFF_XRAW = OFF_P1C + (size_t)RT * 2080 * 2;
constexpr size_t OFF_DTRAW = OFF_XRAW + (size_t)RT * 1024 * 2;
constexpr size_t OFF_XBC = OFF_DTRAW + (size_t)RT * 16 * 4;
constexpr size_t OFF_GY = OFF_XBC + (size_t)RT * 1024 * 2;

struct P {
  const float* in[52];
  float* out;
  char* ws;
};

__device__ __forceinline__ int tidx() { int t = threadIdx.x; asm volatile("" : "+v"(t)); return t; }
__device__ __forceinline__ bf f2bf(float f) {
  unsigned u = __float_as_uint(f);
  u += 0x7fffu + ((u >> 16) & 1u);
  return (bf)(u >> 16);
}
__device__ __forceinline__ float bf2f(bf h) { return __uint_as_float(((unsigned)h) << 16); }
__device__ __forceinline__ float bflo(unsigned u) { return __uint_as_float(u << 16); }
__device__ __forceinline__ float bfhi(unsigned u) { return __uint_as_float(u & 0xffff0000u); }
__device__ __forceinline__ unsigned pack2(float a, float b) { return (unsigned)f2bf(a) | ((unsigned)f2bf(b) << 16); }
__device__ __forceinline__ float sigmoidf_(float x) { return __builtin_amdgcn_rcpf(1.f + __expf(-x)); }
__device__ __forceinline__ float softplusf_(float x) { return x > 15.f ? x : __logf(1.f + __expf(x)); }
__device__ __forceinline__ float siluf_(float x) { return x * __builtin_amdgcn_rcpf(1.f + __expf(-x)); }
__device__ __forceinline__ float wave_sum(float v) {
#pragma unroll
  for (int o = 32; o >= 1; o >>= 1) v += __shfl_xor(v, o);
  return v;
}
template <int C>
__device__ __forceinline__ float dppf(float x) {
  return __builtin_bit_cast(float, __builtin_amdgcn_update_dpp(0, __builtin_bit_cast(int, x), C, 0xF, 0xF, false));
}
__device__ __forceinline__ float red16(float x) {
  x += dppf<0xB1>(x);
  x += dppf<0x4E>(x);
  x += dppf<0x141>(x);
  x += dppf<0x128>(x);
  return x;
}
__device__ __forceinline__ float* xrow(const P& p, int R) {
  int b = R / TA, a = R - b * TA;
  if (a < CTX) return (float*)(p.ws + OFF_CTXX) + (size_t)(b * CTX + a) * Dm;
  return p.out + (size_t)(b * SEQ + a - CTX) * Dm;
}
__device__ __forceinline__ const float* inrow(const P& p, int R) {
  int b = R / TA, a = R - b * TA;
  if (a < CTX) return p.in[2] + (size_t)(b * CTX + a) * Dm;
  return p.in[0] + (size_t)(b * SEQ + a - CTX) * Dm;
}
__device__ __forceinline__ int mrow(int R) {
  int b = R / TA, a = R - b * TA;
  return a < CTX ? 8 : b;
}

__device__ __forceinline__ void ph_mod(const P& p, char* smem) {
  float* sc = (float*)smem;
  float* red = sc + 9 * 1024;
  const int tid = tidx();
  bool loaded = false;
  for (int unit = blockIdx.x; unit < 2 * 192; unit += gridDim.x) {
    int layer = unit / 192, cch = unit - layer * 192;
    const float* W = p.in[layer ? 30 : 4];
    const float* bias = p.in[layer ? 31 : 5];
    __syncthreads();
    if (!loaded) {
      for (int i = tid; i < 9 * 1024; i += NT) {
        int r = i >> 10, k = i & 1023;
        float v = (r < 8) ? p.in[1][r * 1024 + k] : p.in[3][k];
        sc[i] = siluf_(v);
      }
      loaded = true;
      __syncthreads();
    }
    int cl = tid & 31, kg = tid >> 5;
    int col = cch * 32 + cl;
    float acc[9];
#pragma unroll
    for (int r = 0; r < 9; ++r) acc[r] = 0.f;
    for (int k = kg * 64; k < kg * 64 + 64; ++k) {
      float w = W[(size_t)k * 6144 + col];
#pragma unroll
      for (int r = 0; r < 9; ++r) acc[r] += sc[r * 1024 + k] * w;
    }
#pragma unroll
    for (int r = 0; r < 9; ++r) red[(kg * 9 + r) * 32 + cl] = acc[r];
    __syncthreads();
    if (tid < 288) {
      int r = tid >> 5, c = tid & 31;
      float s = 0.f;
#pragma unroll
      for (int g = 0; g < 16; ++g) s += red[(g * 9 + r) * 32 + c];
      ((float*)(p.ws + OFF_MOD))[(size_t)(layer * 9 + r) * 6144 + cch * 32 + c] = s + bias[cch * 32 + c];
    }
  }
}

__device__ __forceinline__ void transpose_one(const float* W, bf* Wt, int K, int N, int Npad, int vb, int nvb, char* smem) {
  float* tile = (float*)smem;
  const int tid = tidx();
  int ntn = Npad / 64, ntk = K / 64;
  for (int t = vb; t < ntn * ntk; t += nvb) {
    int tn = t / ntk, tk = t - tn * ntk;
    int n0 = tn * 64, k0 = tk * 64;
    __syncthreads();
#pragma unroll
    for (int i = 0; i < 8; ++i) {
      int kk = (tid >> 6) + 8 * i, nn = tid & 63;
      float v = (n0 + nn < N) ? W[(size_t)(k0 + kk) * N + n0 + nn] : 0.f;
      tile[kk * 65 + nn] = v;
    }
    __syncthreads();
#pragma unroll
    for (int i = 0; i < 8; ++i) {
      int nn = (tid >> 6) + 8 * i, kk = tid & 63;
      Wt[(size_t)(n0 + nn) * K + k0 + kk] = f2bf(tile[kk * 65 + nn]);
    }
  }
}
__device__ __forceinline__ void ph_wt(const P& p, int layer, char* smem) {
  bf* WT = (bf*)(p.ws + OFF_WT);
  int base = layer ? 34 : 8;
  int nin = layer ? 3104 : 3328, ninp = 3328;
  int nb = gridDim.x, b = blockIdx.x;
  for (int mtx = 0; mtx < 4; ++mtx) {
    const float* W = p.in[base + mtx];
    bf* dst = WT + (mtx == 0 ? WT_IN : mtx == 1 ? WT_OUT : mtx == 2 ? WT_W1 : WT_W2);
    int K = mtx == 3 ? 4096 : 1024;
    int N = mtx == 0 ? nin : mtx == 2 ? 4096 : 1024;
    int Np = mtx == 0 ? ninp : N;
    transpose_one(W, dst, K, N, Np, (b + 64 * mtx) % nb, nb, smem);
  }
}

__device__ __forceinline__ void ph_ada(const P& p, int layer, int which, int useInput, int latonly) {
  const int lane = tidx() & 63, wave = tidx() >> 6;
  const float* ng = p.in[(layer ? 32 : 6) + which];
  const float* mod = (const float*)(p.ws + OFF_MOD);
  bf* H = (bf*)(p.ws + OFF_HO);
  for (int R = blockIdx.x * 8 + wave; R < RT; R += gridDim.x * 8) {
    int b = R / TA, a = R - b * TA;
    if (latonly && a < CTX) continue;
    const float* src = useInput ? inrow(p, R) : xrow(p, R);
    float4 v[4];
    float ss = 0.f;
#pragma unroll
    for (int i = 0; i < 4; ++i) {
      v[i] = *(const float4*)(src + i * 256 + lane * 4);
      ss += v[i].x * v[i].x + v[i].y * v[i].y + v[i].z * v[i].z + v[i].w * v[i].w;
    }
    ss = wave_sum(ss);
    float rs = rsqrtf(ss * (1.f / 1024.f) + 1e-6f);
    int mr = a < CTX ? 8 : b;
    const float* sh = mod + (size_t)(layer * 9 + mr) * 6144 + (which * 3 + 0) * 1024;
    const float* scl = mod + (size_t)(layer * 9 + mr) * 6144 + (which * 3 + 1) * 1024;
#pragma unroll
    for (int i = 0; i < 4; ++i) {
      int k = i * 256 + lane * 4;
      float4 g = *(const float4*)(ng + k);
      float4 s4 = *(const float4*)(sh + k);
      float4 c4 = *(const float4*)(scl + k);
      float o0 = v[i].x * rs * g.x * (1.f + c4.x) + s4.x;
      float o1 = v[i].y * rs * g.y * (1.f + c4.y) + s4.y;
      float o2 = v[i].z * rs * g.z * (1.f + c4.z) + s4.z;
      float o3 = v[i].w * rs * g.w * (1.f + c4.w) + s4.w;
      uint2 o;
      o.x = pack2(o0, o1);
      o.y = pack2(o2, o3);
      *(uint2*)(H + (size_t)R * 1024 + k) = o;
    }
  }
}

namespace pg8 {
#define PG8_LAS __attribute__((address_space(3)))
typedef float f32x2 __attribute__((ext_vector_type(2)));
typedef unsigned u32x4 __attribute__((ext_vector_type(4)));
constexpr int BM = 256, BK = 64, HALF = 128, HTB = HALF * BK * 2, STAGE_BYTES = 8 * HTB, NXCD = 8, WGM = 8;
__device__ __forceinline__ int lds_byte(int r, int c) { const int st = (r >> 4) * 2 + (c >> 5), rr = r & 15, cc = c & 31, ob = rr * 64 + cc * 2; return st * 1024 + (ob ^ (((ob >> 9) & 1) << 5)); }
__device__ __forceinline__ void stage_rc(int b, int& R, int& C) { const int st = b / 1024, sb = b % 1024, swz = sb ^ (((sb >> 9) & 1) << 5); R = (st >> 1) * 16 + swz / 64; C = (st & 1) * 32 + (swz % 64) / 2; }
__device__ __forceinline__ int perm32(int rho) { const int n = rho >> 4, i = rho & 15; return 8 * (i >> 2) + 4 * n + (i & 3); }
struct Unit { int pm, pn; };
struct Gemm { const bf* A; const bf* Bt; int K; };
struct Order {
  int nM, nN, nwg, G, c, latonly;
  __device__ void init(int nM_, int nN_, int G_, int c_, int lat) { nM = nM_; nN = nN_; nwg = nM * nN; G = G_; c = c_; latonly = lat; }
  __device__ bool next(int i, Unit& u) const {
    const long L = (long)i * G + c;
    if (L >= nwg) return false;
    int wgid = (int)L;
    { const int q = nwg / NXCD, r = nwg % NXCD, xcd = wgid % NXCD, off = wgid / NXCD; wgid = (xcd < r ? xcd * (q + 1) : r * (q + 1) + (xcd - r) * q) + off; }
    const int nig = WGM * nN, gid = wgid / nig, fm = gid * WGM, gsz = (nM - fm) < WGM ? (nM - fm) : WGM;
    int pm = fm + ((wgid % nig) % gsz);
    u.pn = (wgid % nig) / gsz;
    u.pm = latonly ? ((pm >> 4) * 17 + 1 + (pm & 15)) : pm;
    return true;
  }
};
__device__ __forceinline__ unsigned cvt_pk_bf16(float lo, float hi) { unsigned r; asm volatile("v_cvt_pk_bf16_f32 %0, %1, %2" : "=v"(r) : "v"(lo), "v"(hi)); return r; }

template <int EPI>
struct Epi {
  static constexpr bool PERM = (EPI == 0 || EPI == 1 || EPI == 3);
  P p;
  int layer;
  __device__ __forceinline__ void operator()(const f32x4 (&acc)[2][2][4][2], const Unit& u, int wr, int wc, int fr, int fq) const {
#pragma unroll
    for (int ai = 0; ai < 2; ++ai)
#pragma unroll
      for (int m = 0; m < 4; ++m) {
        const int row = u.pm * BM + ai * HALF + wr * 64 + m * 16 + fr;
        if constexpr (PERM) {
#pragma unroll
          for (int bj = 0; bj < 2; ++bj) {
            const int c0 = u.pn * BM + bj * HALF + wc * 32 + 8 * fq;
            f32x4 v0 = acc[ai][bj][m][0], v1 = acc[ai][bj][m][1];
            if constexpr (EPI == 3) {
#pragma unroll
              for (int j = 0; j < 4; ++j) { float a = v0[j] > 0.f ? v0[j] : 0.f; v0[j] = a * a; float b2 = v1[j] > 0.f ? v1[j] : 0.f; v1[j] = b2 * b2; }
            }
            u32x4 w;
            w.x = cvt_pk_bf16(v0[0], v0[1]); w.y = cvt_pk_bf16(v0[2], v0[3]); w.z = cvt_pk_bf16(v1[0], v1[1]); w.w = cvt_pk_bf16(v1[2], v1[3]);
            if constexpr (EPI == 0) {
              bf* dst = c0 < 1536 ? (bf*)(p.ws + OFF_QKV) + (size_t)row * 1536 + c0 : (bf*)p.out + (size_t)row * 1792 + (c0 - 1536);
              *(u32x4*)dst = w;
            } else if constexpr (EPI == 1) {
              if (c0 < 512) *(u32x4*)((bf*)(p.ws + OFF_P1C) + (size_t)row * 2080 + c0) = w;
              else if (c0 < 1536) *(u32x4*)((bf*)(p.ws + OFF_XRAW) + (size_t)row * 1024 + (c0 - 512)) = w;
              else if (c0 < 1552) { float* d = (float*)(p.ws + OFF_DTRAW) + (size_t)row * 16 + (c0 - 1536); *(f32x4*)d = v0; *(f32x4*)(d + 4) = v1; }
              else if (c0 < 3104) *(u32x4*)((bf*)(p.ws + OFF_P1C) + (size_t)row * 2080 + (c0 - 1024)) = w;
            } else {
              *(u32x4*)((bf*)(p.ws + OFF_HID) + (size_t)row * 4096 + c0) = w;
            }
          }
        } else {
          const float* gate = (const float*)(p.ws + OFF_MOD) + (size_t)(layer * 9 + mrow(row)) * 6144 + (EPI == 2 ? 2 : 5) * 1024;
          float* xr = xrow(p, row);
          const float* br = (EPI == 2 && layer == 0) ? inrow(p, row) : xr;
#pragma unroll
          for (int bj = 0; bj < 2; ++bj)
#pragma unroll
            for (int n = 0; n < 2; ++n) {
              const int c = u.pn * BM + bj * HALF + wc * 32 + 16 * n + 4 * fq;
              f32x4 gt = *(const f32x4*)(gate + c);
              f32x4 bs = *(const f32x4*)(br + c);
              *(f32x4*)(xr + c) = bs + gt * acc[ai][bj][m][n];
            }
        }
      }
  }
};

template <class EpiT>
__device__ __forceinline__ void gemm_phase(PG8_LAS unsigned char* lds, const Gemm g, const Order& S, const EpiT& E) {
  const int tid = tidx(), wid = __builtin_amdgcn_readfirstlane(tid >> 6), lane = tid & 63, wr = wid >> 2, wc = wid & 3, fr = lane & 15, fq = lane >> 4;
  const int K = g.K, nt = K / BK;
  unsigned voffA[2], voffB[2];
#pragma unroll
  for (int i = 0; i < 2; ++i) { int R, C; stage_rc(tid * 16 + i * 8192, R, C); const int Rb = EpiT::PERM ? ((R & ~31) + perm32(R & 31)) : R;
    voffA[i] = (unsigned)(R * K + C) * 2u; voffB[i] = (unsigned)(Rb * K + C) * 2u; }
  const size_t kstep = (size_t)(BK * 2);
  const size_t hstep = (size_t)HALF * K * 2;
  const size_t tstep = 2 * hstep;
  const unsigned ldsw = (unsigned)wid * 1024u;
  const int aoff = lds_byte(wr * 64 + fr, fq * 8), boff = lds_byte(wc * 32 + fr, fq * 8);
#define PG8_SA(b, h) (((b) * 2 + (h)) * HTB)
#define PG8_SB(b, h) ((4 + (b) * 2 + (h)) * HTB)
#define PG8_STAGE(bufoff, gbase, voff) do { _Pragma("unroll") for (int _i = 0; _i < 2; ++_i) \
        __builtin_amdgcn_global_load_lds((const unsigned*)((const char*)(gbase) + (voff)[_i]), (PG8_LAS unsigned*)(lds + (bufoff) + ldsw + _i * 8192), 16, 0, 0); } while (0)
#define PG8_LDA(dst, b, h) do { _Pragma("unroll") for (int m = 0; m < 4; ++m) _Pragma("unroll") for (int k = 0; k < 2; ++k) dst[m][k] = *(const PG8_LAS bf16x8*)(lds + PG8_SA(b, h) + aoff + m * 2048 + k * 1024); } while (0)
#define PG8_LDB(dst, b, h) do { _Pragma("unroll") for (int n = 0; n < 2; ++n) _Pragma("unroll") for (int k = 0; k < 2; ++k) dst[n][k] = *(const PG8_LAS bf16x8*)(lds + PG8_SB(b, h) + boff + n * 2048 + k * 1024); } while (0)
#define PG8_MMA(ai, bj, At, Bt) do { __builtin_amdgcn_s_setprio(1); _Pragma("unroll") for (int m = 0; m < 4; ++m) _Pragma("unroll") for (int n = 0; n < 2; ++n) _Pragma("unroll") for (int k = 0; k < 2; ++k) \
        acc[ai][bj][m][n] = __builtin_amdgcn_mfma_f32_16x16x32_bf16(Bt[n][k], At[m][k], acc[ai][bj][m][n], 0, 0, 0); __builtin_amdgcn_s_setprio(0); } while (0)
#define PG8_WAIT_V(n) asm volatile("s_waitcnt vmcnt(" #n ")" ::: "memory")
#define PG8_WAIT_L(n) asm volatile("s_waitcnt lgkmcnt(" #n ")" ::: "memory")
#define PG8_BAR __builtin_amdgcn_s_barrier()
#define PG8_SCHED __builtin_amdgcn_sched_barrier(0)
  Unit cur, nxt; int ui = 0;
  if (!S.next(0, cur)) return;
  f32x4 acc[2][2][4][2];
#pragma unroll
  for (int a = 0; a < 2; ++a)
#pragma unroll
    for (int b = 0; b < 2; ++b)
#pragma unroll
      for (int m = 0; m < 4; ++m)
#pragma unroll
        for (int n = 0; n < 2; ++n) acc[a][b][m][n] = (f32x4){0.f, 0.f, 0.f, 0.f};
  bf16x8 At[4][2], B0[2][2], B1[2][2];
  const char* cA = (const char*)g.A + (size_t)cur.pm * tstep; const char* cB = (const char*)g.Bt + (size_t)cur.pn * tstep;
  PG8_STAGE(PG8_SB(0, 0), cB, voffB); PG8_STAGE(PG8_SA(0, 0), cA, voffA); PG8_STAGE(PG8_SB(0, 1), cB + hstep, voffB); PG8_STAGE(PG8_SA(0, 1), cA + hstep, voffA);
  if (wr == 1) PG8_BAR;
  PG8_WAIT_V(4); PG8_BAR;
  PG8_STAGE(PG8_SB(1, 0), cB + kstep, voffB); PG8_STAGE(PG8_SA(1, 0), cA + kstep, voffA); PG8_STAGE(PG8_SB(1, 1), cB + hstep + kstep, voffB);
  PG8_WAIT_V(6); PG8_BAR;
  for (;;) {
    const bool has_next = S.next(ui + 1, nxt);
    const char* nA = has_next ? (const char*)g.A + (size_t)nxt.pm * tstep : cA; const char* nB = has_next ? (const char*)g.Bt + (size_t)nxt.pn * tstep : cB;
    for (int t = 0; t < nt; t += 2) {
      const bool last = (t == nt - 2);
      const char* a1 = cA + (size_t)(t + 1) * kstep;
      const char* a2 = last ? nA : cA + (size_t)(t + 2) * kstep; const char* b2 = last ? nB : cB + (size_t)(t + 2) * kstep;
      const char* a3 = a2 + kstep; const char* b3 = b2 + kstep;
      PG8_LDB(B0, 0, 0); PG8_SCHED; PG8_LDA(At, 0, 0); PG8_STAGE(PG8_SA(1, 1), a1 + hstep, voffA);
      PG8_WAIT_L(8); PG8_BAR; PG8_WAIT_L(0); PG8_MMA(0, 0, At, B0); PG8_BAR; PG8_SCHED;
      PG8_LDB(B1, 0, 1); PG8_STAGE(PG8_SB(0, 0), b2, voffB);
      PG8_BAR; PG8_WAIT_L(0); PG8_MMA(0, 1, At, B1); PG8_BAR;
      PG8_LDA(At, 0, 1); PG8_STAGE(PG8_SA(0, 0), a2, voffA);
      PG8_BAR; PG8_WAIT_L(0); PG8_MMA(1, 0, At, B0); PG8_BAR; PG8_SCHED;
      PG8_STAGE(PG8_SB(0, 1), b2 + hstep, voffB);
      PG8_WAIT_V(6); PG8_BAR; PG8_MMA(1, 1, At, B1); PG8_BAR;
      PG8_LDB(B0, 1, 0); PG8_SCHED; PG8_LDA(At, 1, 0); PG8_STAGE(PG8_SA(0, 1), a2 + hstep, voffA);
      PG8_WAIT_L(8); PG8_BAR; PG8_WAIT_L(0); PG8_MMA(0, 0, At, B0); PG8_BAR; PG8_SCHED;
      PG8_LDB(B1, 1, 1); PG8_STAGE(PG8_SB(1, 0), b3, voffB);
      PG8_BAR; PG8_WAIT_L(0); PG8_MMA(0, 1, At, B1); PG8_BAR;
      PG8_LDA(At, 1, 1); PG8_STAGE(PG8_SA(1, 0), a3, voffA);
      PG8_BAR; PG8_WAIT_L(0); PG8_MMA(1, 0, At, B0); PG8_BAR; PG8_SCHED;
      PG8_STAGE(PG8_SB(1, 1), b3 + hstep, voffB);
      PG8_WAIT_V(6); PG8_BAR; PG8_MMA(1, 1, At, B1); PG8_BAR;
    }
    E(acc, cur, wr, wc, fr, fq);
    if (!has_next) break;
#pragma unroll
    for (int a = 0; a < 2; ++a)
#pragma unroll
      for (int b = 0; b < 2; ++b)
#pragma unroll
        for (int m = 0; m < 4; ++m)
#pragma unroll
          for (int n = 0; n < 2; ++n) acc[a][b][m][n] = (f32x4){0.f, 0.f, 0.f, 0.f};
    cur = nxt; cA = nA; cB = nB; ++ui;
  }
  PG8_WAIT_V(0);
  if (wr == 0) PG8_BAR;
  PG8_BAR;
#undef PG8_SA
#undef PG8_SB
#undef PG8_STAGE
#undef PG8_LDA
#undef PG8_LDB
#undef PG8_MMA
#undef PG8_WAIT_V
#undef PG8_WAIT_L
#undef PG8_BAR
#undef PG8_SCHED
}
}

template <int EPI>
__device__ __forceinline__ void ph_gemm(const P& p, const bf* A, const bf* Bt, int K, int nN, int layer, int latonly, char* smem) {
  pg8::Order S;
  S.init(latonly ? 128 : 136, nN, gridDim.x, blockIdx.x, latonly);
  pg8::Epi<EPI> E{p, layer};
  pg8::Gemm g{A, Bt, K};
  __syncthreads();
  pg8::gemm_phase(( __attribute__((address_space(3))) unsigned char*)smem, g, S, E);
  __syncthreads();
}

__device__ __forceinline__ void ph_rope(const P& p, char* smem) {
  float* tcos = (float*)smem;
  float* tsin = tcos + 1024;
  const int tid = tidx();
  __syncthreads();
  for (int i = tid; i < 1024; i += NT) {
    int c = i >> 4, f = i & 15;
    float inv = powf(10000.f, -(float)f / 16.f);
    float ang = (float)c * inv;
    float sn, cs;
    sincosf(ang, &sn, &cs);
    tcos[i] = cs;
    tsin[i] = sn;
  }
  __syncthreads();
  bf* QKV = (bf*)(p.ws + OFF_QKV);
  for (int it = blockIdx.x * NT + tid; it < RT * 32; it += gridDim.x * NT) {
    int R = it >> 5;
    int vec = (it >> 1) & 15, half = it & 1;
    int b = R / TA, a = R - b * TA;
    bool isq = vec < 8;
    if (!isq && a < CTX) continue;
    bf* ptr = QKV + (size_t)R * 1536 + vec * 64 + half * 32;
    uint4 a0 = *(const uint4*)ptr, a1 = *(const uint4*)(ptr + 8), b0 = *(const uint4*)(ptr + 16), b1 = *(const uint4*)(ptr + 24);
    float x1[16], x2[16];
    x1[0] = bflo(a0.x); x1[1] = bfhi(a0.x); x1[2] = bflo(a0.y); x1[3] = bfhi(a0.y); x1[4] = bflo(a0.z); x1[5] = bfhi(a0.z); x1[6] = bflo(a0.w); x1[7] = bfhi(a0.w);
    x1[8] = bflo(a1.x); x1[9] = bfhi(a1.x); x1[10] = bflo(a1.y); x1[11] = bfhi(a1.y); x1[12] = bflo(a1.z); x1[13] = bfhi(a1.z); x1[14] = bflo(a1.w); x1[15] = bfhi(a1.w);
    x2[0] = bflo(b0.x); x2[1] = bfhi(b0.x); x2[2] = bflo(b0.y); x2[3] = bfhi(b0.y); x2[4] = bflo(b0.z); x2[5] = bfhi(b0.z); x2[6] = bflo(b0.w); x2[7] = bfhi(b0.w);
    x2[8] = bflo(b1.x); x2[9] = bfhi(b1.x); x2[10] = bflo(b1.y); x2[11] = bfhi(b1.y); x2[12] = bflo(b1.z); x2[13] = bfhi(b1.z); x2[14] = bflo(b1.w); x2[15] = bfhi(b1.w);
    const float qs = isq ? 0.125f : 1.f;
    if (a >= CTX) {
      int pos = a - CTX;
      int cidx = half == 0 ? (pos >> 6) : (pos & 63);
#pragma unroll
      for (int f = 0; f < 16; ++f) {
        float cs = tcos[cidx * 16 + f], sn = tsin[cidx * 16 + f];
        float y1 = x1[f] * cs - x2[f] * sn, y2 = x2[f] * cs + x1[f] * sn;
        x1[f] = y1 * qs;
        x2[f] = y2 * qs;
      }
    } else {
#pragma unroll
      for (int f = 0; f < 16; ++f) { x1[f] *= qs; x2[f] *= qs; }
    }
    uint4 o;
    o.x = pack2(x1[0], x1[1]); o.y = pack2(x1[2], x1[3]); o.z = pack2(x1[4], x1[5]); o.w = pack2(x1[6], x1[7]); *(uint4*)ptr = o;
    o.x = pack2(x1[8], x1[9]); o.y = pack2(x1[10], x1[11]); o.z = pack2(x1[12], x1[13]); o.w = pack2(x1[14], x1[15]); *(uint4*)(ptr + 8) = o;
    o.x = pack2(x2[0], x2[1]); o.y = pack2(x2[2], x2[3]); o.z = pack2(x2[4], x2[5]); o.w = pack2(x2[6], x2[7]); *(uint4*)(ptr + 16) = o;
    o.x = pack2(x2[8], x2[9]); o.y = pack2(x2[10], x2[11]); o.z = pack2(x2[12], x2[13]); o.w = pack2(x2[14], x2[15]); *(uint4*)(ptr + 24) = o;
  }
}

__device__ __forceinline__ float shiftmix(const bf* PB, const float* mu, int R, int a, int col) {
  int lo = a < CTX ? 0 : CTX, hi = a < CTX ? CTX : TA;
  float t = bf2f(PB[(size_t)R * 1792 + col]);
  float pv = a > lo ? bf2f(PB[(size_t)(R - 1) * 1792 + col]) : 0.f;
  float nx = a + 1 < hi ? bf2f(PB[(size_t)(R + 1) * 1792 + col]) : 0.f;
  return t + (0.5f * (pv + nx) - t) * mu[col];
}
__device__ __forceinline__ void ph_rwkv_prep(const P& p, char* smem) {
  float* lin = (float*)smem;
  const int tid = tidx(), lane = tid & 63, wave = tid >> 6;
  const bf* PB = (const bf*)p.out;
  const float* mu = p.in[17];
  const float *w0f = p.in[18], *w2f = p.in[19], *w0b = p.in[20], *w2b = p.in[21], *a0 = p.in[22], *a2 = p.in[23], *g2 = p.in[24];
  const float *k_k = p.in[25], *k_a = p.in[26], *r_k = p.in[27];
  bf* PR = (bf*)(p.ws + OFF_PREP);
  bf* PK = PR + (size_t)RT * 512;
  bf* PV = PK + (size_t)RT * 512;
  bf* PKK = PV + (size_t)RT * 512;
  bf* PKA = PKK + (size_t)RT * 512;
  bf* PLF = PKA + (size_t)RT * 512;
  bf* PLB = PLF + (size_t)RT * 512;
  bf* G = (bf*)(p.ws + OFF_G);
  float* BON = (float*)(p.ws + OFF_BONUS);
  const int c = tid;
  for (int unit = blockIdx.x; unit < RT / 16; unit += gridDim.x) {
    int R0 = unit * 16;
    int b = R0 / TA, a00 = R0 - b * TA;
    __syncthreads();
#pragma unroll
    for (int i = 0; i < 8; ++i) {
      int idx = tid + NT * i;
      int tok = idx >> 8, j = idx & 255;
      float f = shiftmix(PB, mu, R0 + tok, a00 + tok, 1536 + j);
      float val = j < 64 ? tanhf(f) : (j < 128 ? f : sigmoidf_(f));
      lin[j * 16 + tok] = val;
    }
    __syncthreads();
    float aa[16], wf[16], wb[16], gg[16];
#pragma unroll
    for (int t = 0; t < 16; ++t) { aa[t] = 0.f; wf[t] = 0.f; wb[t] = 0.f; gg[t] = 0.f; }
    for (int j = 0; j < 64; ++j) {
      float x2f = w2f[j * 512 + c], x2b = w2b[j * 512 + c];
      const float4* lp = (const float4*)(lin + j * 16);
#pragma unroll
      for (int q = 0; q < 4; ++q) {
        float4 t4 = lp[q];
        wf[q * 4 + 0] += t4.x * x2f; wf[q * 4 + 1] += t4.y * x2f; wf[q * 4 + 2] += t4.z * x2f; wf[q * 4 + 3] += t4.w * x2f;
        wb[q * 4 + 0] += t4.x * x2b; wb[q * 4 + 1] += t4.y * x2b; wb[q * 4 + 2] += t4.z * x2b; wb[q * 4 + 3] += t4.w * x2b;
      }
    }
    for (int j = 0; j < 64; ++j) {
      float xa = a2[j * 512 + c];
      const float4* lp = (const float4*)(lin + (64 + j) * 16);
#pragma unroll
      for (int q = 0; q < 4; ++q) {
        float4 t4 = lp[q];
        aa[q * 4 + 0] += t4.x * xa; aa[q * 4 + 1] += t4.y * xa; aa[q * 4 + 2] += t4.z * xa; aa[q * 4 + 3] += t4.w * xa;
      }
    }
    for (int j = 0; j < 128; ++j) {
      float xg = g2[j * 512 + c];
      const float4* lp = (const float4*)(lin + (128 + j) * 16);
#pragma unroll
      for (int q = 0; q < 4; ++q) {
        float4 t4 = lp[q];
        gg[q * 4 + 0] += t4.x * xg; gg[q * 4 + 1] += t4.y * xg; gg[q * 4 + 2] += t4.z * xg; gg[q * 4 + 3] += t4.w * xg;
      }
    }
    const float vw0f = w0f[c], vw0b = w0b[c], va0 = a0[c], vkk = k_k[c], vka = k_a[c], vrk = r_k[c];
#pragma unroll
    for (int t = 0; t < 16; ++t) {
      int R = R0 + t, a = a00 + t;
      float fr = shiftmix(PB, mu, R, a, c);
      float fk = shiftmix(PB, mu, R, a, 512 + c);
      float fv = shiftmix(PB, mu, R, a, 1024 + c);
      float av = sigmoidf_(va0 + aa[t]);
      float lwf = -__expf(-softplusf_(-(vw0f + wf[t])) - 0.5f);
      float lwb = -__expf(-softplusf_(-(vw0b + wb[t])) - 0.5f);
      float kk = fk * vkk;
      float n2 = wave_sum(kk * kk);
      kk = kk / fmaxf(sqrtf(n2), 1e-12f);
      float kmod = fk * (1.f + (av - 1.f) * vka);
      float bon = wave_sum(fr * kmod * vrk);
      size_t o = (size_t)R * 512 + c;
      PR[o] = f2bf(fr);
      PK[o] = f2bf(kmod);
      PV[o] = f2bf(fv);
      PKK[o] = f2bf(kk);
      PKA[o] = f2bf(kk * av);
      PLF[o] = f2bf(lwf);
      PLB[o] = f2bf(lwb);
      G[o] = f2bf(gg[t]);
      if (lane == 0) BON[(size_t)R * 8 + wave] = bon;
    }
  }
}

__device__ __forceinline__ int scan_row(int b, int dir, int s) {
  int a = dir ? (s < CTX ? CTX - 1 - s : TA + CTX - 1 - s) : s;
  return b * TA + a;
}

__device__ __forceinline__ void rwkv_chain(const P& p, int chain, char* smem) {
  const int dir = chain & 1, h = (chain >> 1) & 7, b = chain >> 4;
  float* cR = (float*)smem;
  float* cW = cR + 2048;
  float* cK = cW + 2048;
  float* cKK = cK + 2048;
  float* cKA = cKK + 2048;
  float* cV = cKA + 2048;
  float* yb = cV + 2048;
  const int tid = tidx(), lane = tid & 63, wave = tid >> 6;
  const int l15 = lane & 15, lg = lane >> 4;
  const bf* PR = (const bf*)(p.ws + OFF_PREP);
  const bf* PK = PR + (size_t)RT * 512;
  const bf* PV = PK + (size_t)RT * 512;
  const bf* PKK = PV + (size_t)RT * 512;
  const bf* PKA = PKK + (size_t)RT * 512;
  const bf* PLW = PKA + (size_t)RT * 512 + (size_t)dir * RT * 512;
  bf* Y = (bf*)p.out + (size_t)dir * RT * 512;
  const int st = tid >> 4, c4 = (tid & 15) * 4;
  const int r0 = wave * 8 + lg * 2;
  float s0[4], s1[4];
#pragma unroll
  for (int j = 0; j < 4; ++j) { s0[j] = 0.f; s1[j] = 0.f; }
  uint2 gR, gW, gK, gV, gKK, gKA;
  {
    size_t o = (size_t)scan_row(b, dir, st) * 512 + h * 64 + c4;
    gR = *(const uint2*)(PR + o); gW = *(const uint2*)(PLW + o); gK = *(const uint2*)(PK + o);
    gV = *(const uint2*)(PV + o); gKK = *(const uint2*)(PKK + o); gKA = *(const uint2*)(PKA + o);
  }
  const int NCH = TA / 32;
  for (int ch = 0; ch <= NCH; ++ch) {
    __syncthreads();
    if (ch > 0) {
      float4 y4 = *(const float4*)(yb + st * 64 + c4);
      uint2 o2;
      o2.x = pack2(y4.x, y4.y);
      o2.y = pack2(y4.z, y4.w);
      *(uint2*)(Y + (size_t)scan_row(b, dir, (ch - 1) * 32 + st) * 512 + h * 64 + c4) = o2;
    }
    if (ch == NCH) break;
    {
      int o = st * 64 + c4;
      *(float4*)(cR + o) = make_float4(bflo(gR.x), bfhi(gR.x), bflo(gR.y), bfhi(gR.y));
      *(float4*)(cW + o) = make_float4(__expf(bflo(gW.x)), __expf(bfhi(gW.x)), __expf(bflo(gW.y)), __expf(bfhi(gW.y)));
      *(float4*)(cK + o) = make_float4(bflo(gK.x), bfhi(gK.x), bflo(gK.y), bfhi(gK.y));
      *(float4*)(cV + o) = make_float4(bflo(gV.x), bfhi(gV.x), bflo(gV.y), bfhi(gV.y));
      *(float4*)(cKK + o) = make_float4(bflo(gKK.x), bfhi(gKK.x), bflo(gKK.y), bfhi(gKK.y));
      *(float4*)(cKA + o) = make_float4(bflo(gKA.x), bfhi(gKA.x), bflo(gKA.y), bfhi(gKA.y));
    }
    __syncthreads();
    if (ch + 1 < NCH) {
      size_t o = (size_t)scan_row(b, dir, (ch + 1) * 32 + st) * 512 + h * 64 + c4;
      gR = *(const uint2*)(PR + o); gW = *(const uint2*)(PLW + o); gK = *(const uint2*)(PK + o);
      gV = *(const uint2*)(PV + o); gKK = *(const uint2*)(PKK + o); gKA = *(const uint2*)(PKA + o);
    }
#pragma unroll 4
    for (int t = 0; t < 32; ++t) {
      float4 kk4 = *(const float4*)(cKK + t * 64 + l15 * 4);
      float4 w4 = *(const float4*)(cW + t * 64 + l15 * 4);
      float4 k4 = *(const float4*)(cK + t * 64 + l15 * 4);
      float4 ka4 = *(const float4*)(cKA + t * 64 + l15 * 4);
      float4 r4 = *(const float4*)(cR + t * 64 + l15 * 4);
      float2 v2 = *(const float2*)(cV + t * 64 + r0);
      float sa0 = s0[0] * kk4.x + s0[1] * kk4.y + s0[2] * kk4.z + s0[3] * kk4.w;
      float sa1 = s1[0] * kk4.x + s1[1] * kk4.y + s1[2] * kk4.z + s1[3] * kk4.w;
      sa0 = red16(sa0);
      sa1 = red16(sa1);
      s0[0] = s0[0] * w4.x + (v2.x * k4.x - sa0 * ka4.x);
      s0[1] = s0[1] * w4.y + (v2.x * k4.y - sa0 * ka4.y);
      s0[2] = s0[2] * w4.z + (v2.x * k4.z - sa0 * ka4.z);
      s0[3] = s0[3] * w4.w + (v2.x * k4.w - sa0 * ka4.w);
      s1[0] = s1[0] * w4.x + (v2.y * k4.x - sa1 * ka4.x);
      s1[1] = s1[1] * w4.y + (v2.y * k4.y - sa1 * ka4.y);
      s1[2] = s1[2] * w4.z + (v2.y * k4.z - sa1 * ka4.z);
      s1[3] = s1[3] * w4.w + (v2.y * k4.w - sa1 * ka4.w);
      float y0 = s0[0] * r4.x + s0[1] * r4.y + s0[2] * r4.z + s0[3] * r4.w;
      float y1 = s1[0] * r4.x + s1[1] * r4.y + s1[2] * r4.z + s1[3] * r4.w;
      y0 = red16(y0);
      y1 = red16(y1);
      if (l15 == 0) *(float2*)(yb + t * 64 + r0) = make_float2(y0, y1);
    }
  }
}

typedef short s16x4 __attribute__((ext_vector_type(4)));
__device__ __forceinline__ void attn_unit(const P& p, int u, char* smem, float lam) {
  bf* Ks = (bf*)smem;
  bf* Vs = Ks + 64 * 136;
  int b, h, nkeys, qa0;
  if (u < 1024) { b = u >> 7; h = (u >> 5) & 3; nkeys = TA; qa0 = CTX + (u & 31) * 128; }
  else { int v = u - 1024; b = v >> 3; h = (v >> 1) & 3; nkeys = CTX; qa0 = (v & 1) * 128; }
  const bf* QKV = (const bf*)(p.ws + OFF_QKV);
  const int tid = tidx(), lane = tid & 63, wave = tid >> 6;
  const int l15 = lane & 15, lg = lane >> 4;
  const size_t rowbase = (size_t)b * TA;
  bf16x8 qf[2][2];
  {
    size_t Rq = rowbase + qa0 + wave * 16 + l15;
#pragma unroll
    for (int m = 0; m < 2; ++m)
#pragma unroll
      for (int ks = 0; ks < 2; ++ks) qf[m][ks] = *(const bf16x8*)(QKV + Rq * 1536 + h * 128 + m * 64 + ks * 32 + lg * 8);
  }
  f32x4 oacc[2][8];
#pragma unroll
  for (int m = 0; m < 2; ++m)
#pragma unroll
    for (int n = 0; n < 8; ++n) oacc[m][n] = (f32x4){0.f, 0.f, 0.f, 0.f};
  float mrun[2] = {-INFINITY, -INFINITY}, lrun[2] = {0.f, 0.f};
  const int sr = tid >> 4, scc = tid & 15;
  const bf* gsrc = QKV + (rowbase + sr) * 1536 + h * 128 + scc * 8;
  uint4 pk0 = *(const uint4*)(gsrc + 512), pv0 = *(const uint4*)(gsrc + 1024);
  uint4 pk1 = *(const uint4*)(gsrc + (size_t)32 * 1536 + 512), pv1 = *(const uint4*)(gsrc + (size_t)32 * 1536 + 1024);
  const int vrow = lg * 4 + (l15 >> 2), vcol = (lane & 3) * 4;
  for (int k0 = 0; k0 < nkeys; k0 += 64) {
    __syncthreads();
    *(uint4*)(Ks + sr * 136 + scc * 8) = pk0;
    *(uint4*)(Ks + (sr + 32) * 136 + scc * 8) = pk1;
    *(uint4*)(Vs + sr * 144 + scc * 8) = pv0;
    *(uint4*)(Vs + (sr + 32) * 144 + scc * 8) = pv1;
    __syncthreads();
    if (k0 + 64 < nkeys) {
      const bf* g2 = gsrc + (size_t)(k0 + 64) * 1536;
      pk0 = *(const uint4*)(g2 + 512); pv0 = *(const uint4*)(g2 + 1024);
      pk1 = *(const uint4*)(g2 + (size_t)32 * 1536 + 512); pv1 = *(const uint4*)(g2 + (size_t)32 * 1536 + 1024);
    }
    bf16x8 pf[2][2];
#pragma unroll
    for (int m = 0; m < 2; ++m) {
      f32x4 s[4];
#pragma unroll
      for (int kt = 0; kt < 4; ++kt) s[kt] = (f32x4){0.f, 0.f, 0.f, 0.f};
#pragma unroll
      for (int ks = 0; ks < 2; ++ks)
#pragma unroll
        for (int kt = 0; kt < 4; ++kt) {
          bf16x8 a = *(const bf16x8*)(Ks + (kt * 16 + l15) * 136 + m * 64 + ks * 32 + lg * 8);
          s[kt] = __builtin_amdgcn_mfma_f32_16x16x32_bf16(a, qf[m][ks], s[kt], 0, 0, 0);
        }
      float mx = s[0][0];
#pragma unroll
      for (int kt = 0; kt < 4; ++kt)
#pragma unroll
        for (int r = 0; r < 4; ++r) mx = fmaxf(mx, s[kt][r]);
      mx = fmaxf(mx, __shfl_xor(mx, 16));
      mx = fmaxf(mx, __shfl_xor(mx, 32));
      float mnew = fmaxf(mrun[m], mx);
      float alpha = __expf(mrun[m] - mnew);
      mrun[m] = mnew;
      float ps = 0.f;
#pragma unroll
      for (int kt = 0; kt < 4; ++kt)
#pragma unroll
        for (int r = 0; r < 4; ++r) {
          float e = __expf(s[kt][r] - mnew);
          s[kt][r] = e;
          ps += e;
        }
      lrun[m] = lrun[m] * alpha + ps;
#pragma unroll
      for (int si = 0; si < 2; ++si) {
        i32x4 t;
        t[0] = (int)pack2(s[2 * si][0], s[2 * si][1]);
        t[1] = (int)pack2(s[2 * si][2], s[2 * si][3]);
        t[2] = (int)pack2(s[2 * si + 1][0], s[2 * si + 1][1]);
        t[3] = (int)pack2(s[2 * si + 1][2], s[2 * si + 1][3]);
        pf[m][si] = __builtin_bit_cast(bf16x8, t);
      }
      if (__any(alpha != 1.f)) {
        float al[4];
#pragma unroll
        for (int r = 0; r < 4; ++r) al[r] = __shfl(alpha, lg * 4 + r);
#pragma unroll
        for (int n = 0; n < 8; ++n)
#pragma unroll
          for (int r = 0; r < 4; ++r) oacc[m][n][r] *= al[r];
      }
    }
#pragma unroll
    for (int si = 0; si < 2; ++si)
#pragma unroll
      for (int n = 0; n < 8; ++n) {
        const bf* vp = Vs + (si * 32 + vrow) * 144 + n * 16 + vcol;
        s16x4 v0 = __builtin_amdgcn_ds_read_tr16_b64_v4i16((__attribute__((address_space(3))) s16x4*)vp);
        s16x4 v1 = __builtin_amdgcn_ds_read_tr16_b64_v4i16((__attribute__((address_space(3))) s16x4*)(vp + 16 * 144));
        bf16x8 bv = __builtin_shufflevector(v0, v1, 0, 1, 2, 3, 4, 5, 6, 7);
        oacc[0][n] = __builtin_amdgcn_mfma_f32_16x16x32_bf16(pf[0][si], bv, oacc[0][n], 0, 0, 0);
        oacc[1][n] = __builtin_amdgcn_mfma_f32_16x16x32_bf16(pf[1][si], bv, oacc[1][n], 0, 0, 0);
      }
  }
  float inv[2];
#pragma unroll
  for (int m = 0; m < 2; ++m) {
    float l = lrun[m];
    l += __shfl_xor(l, 16);
    l += __shfl_xor(l, 32);
    inv[m] = 1.f / l;
  }
  float i1[4], i2[4];
#pragma unroll
  for (int r = 0; r < 4; ++r) { i1[r] = __shfl(inv[0], lg * 4 + r); i2[r] = __shfl(inv[1], lg * 4 + r); }
  float ss[4] = {0.f, 0.f, 0.f, 0.f};
#pragma unroll
  for (int n = 0; n < 8; ++n)
#pragma unroll
    for (int r = 0; r < 4; ++r) {
      float o = oacc[0][n][r] * i1[r] - lam * (oacc[1][n][r] * i2[r]);
      oacc[0][n][r] = o;
      ss[r] += o * o;
    }
  const float* subln = p.in[16];
  bf* O = (bf*)(p.ws + OFF_HO);
#pragma unroll
  for (int r = 0; r < 4; ++r) {
    float t = red16(ss[r]);
    float scl = rsqrtf(t * (1.f / 128.f) + 1e-5f) * 0.8f;
    size_t Ro = rowbase + qa0 + wave * 16 + lg * 4 + r;
#pragma unroll
    for (int n = 0; n < 8; ++n) O[Ro * 1024 + h * 128 + n * 16 + l15] = f2bf(oacc[0][n][r] * scl * subln[n * 16 + l15]);
  }
}

__device__ __forceinline__ void ph_mix0(const P& p, char* smem) {
  volatile int* s_unitp = (volatile int*)(smem + 131072);
  for (int chain = blockIdx.x; chain < 128; chain += gridDim.x) rwkv_chain(p, chain, smem);
  float d1 = 0.f, d2 = 0.f;
  for (int i = 0; i < 64; ++i) { d1 += p.in[12][i] * p.in[13][i]; d2 += p.in[14][i] * p.in[15][i]; }
  float lam = expf(d1) - expf(d2) + 0.2f;
  int* cnt = (int*)(p.ws + OFF_CNT);
  while (true) {
    __syncthreads();
    if (tidx() == 0) *s_unitp = atomicAdd(cnt, 1);
    __syncthreads();
    int u = *s_unitp;
    if (u >= 1088) break;
    attn_unit(p, u, smem, lam);
  }
}

__device__ __forceinline__ void ph_rwkv_post(const P& p) {
  const int tid = tidx(), wave = tid >> 6;
  const bf* YF = (const bf*)p.out;
  const bf* YB = YF + (size_t)RT * 512;
  const bf* PV = (const bf*)(p.ws + OFF_PREP) + (size_t)2 * RT * 512;
  const bf* G = (const bf*)(p.ws + OFF_G);
  const float* BON = (const float*)(p.ws + OFF_BONUS);
  bf* O = (bf*)(p.ws + OFF_HO);
  const float lw = p.in[28][tid], lb = p.in[29][tid];
  for (int R0 = blockIdx.x * 4; R0 < RT; R0 += gridDim.x * 4) {
    float yf[4], yb4[4], pv[4], gg[4], bn[4];
#pragma unroll
    for (int i = 0; i < 4; ++i) {
      size_t o = (size_t)(R0 + i) * 512 + tid;
      yf[i] = bf2f(YF[o]); yb4[i] = bf2f(YB[o]); pv[i] = bf2f(PV[o]); gg[i] = bf2f(G[o]); bn[i] = BON[(size_t)(R0 + i) * 8 + wave];
    }
#pragma unroll
    for (int i = 0; i < 4; ++i) {
      float y = yf[i] + yb4[i];
      float mean = wave_sum(y) * (1.f / 64.f);
      float d = y - mean;
      float var = wave_sum(d * d) * (1.f / 64.f);
      float yn = d * rsqrtf(var + 64e-5f) * lw + lb;
      float outv = (yn + bn[i] * pv[i]) * gg[i];
      O[(size_t)(R0 + i) * 1024 + 512 + tid] = f2bf(outv);
    }
  }
}

__device__ __forceinline__ void ph_conv(const P& p) {
  const bf* XR = (const bf*)(p.ws + OFF_XRAW);
  bf* XO = (bf*)(p.ws + OFF_XBC);
  const float* cw = p.in[38];
  const float* cb = p.in[39];
  for (size_t it = (size_t)blockIdx.x * NT + tidx(); it < (size_t)RT * 128; it += (size_t)gridDim.x * NT) {
    int R = (int)(it >> 7), c8 = (int)(it & 127) * 8;
    int b = R / TA, a = R - b * TA;
    int lo = a < CTX ? 0 : CTX, hi = a < CTX ? CTX : TA;
    float acc[8];
#pragma unroll
    for (int e = 0; e < 8; ++e) acc[e] = cb[c8 + e];
#pragma unroll
    for (int j = 0; j < 5; ++j) {
      int aj = a + j - 2;
      if (aj >= lo && aj < hi) {
        uint4 v = *(const uint4*)(XR + (size_t)(R + j - 2) * 1024 + c8);
        const float* w = cw + j * 1024 + c8;
        acc[0] += w[0] * bflo(v.x); acc[1] += w[1] * bfhi(v.x);
        acc[2] += w[2] * bflo(v.y); acc[3] += w[3] * bfhi(v.y);
        acc[4] += w[4] * bflo(v.z); acc[5] += w[5] * bfhi(v.z);
        acc[6] += w[6] * bflo(v.w); acc[7] += w[7] * bfhi(v.w);
      }
    }
    uint4 o;
    o.x = pack2(siluf_(acc[0]), siluf_(acc[1]));
    o.y = pack2(siluf_(acc[2]), siluf_(acc[3]));
    o.z = pack2(siluf_(acc[4]), siluf_(acc[5]));
    o.w = pack2(siluf_(acc[6]), siluf_(acc[7]));
    *(uint4*)(XO + (size_t)R * 1024 + c8) = o;
  }
}

__device__ __forceinline__ void ssd_chain(const P& p, int chain, char* smem) {
  const int dir = chain & 1, hh = (chain >> 1) & 7, b = chain >> 4;
  const int grp = hh >> 2;
  float* cB = (float*)smem;
  float* cC = cB + 4096;
  float* cX = cC + 4096;
  float* cDA = cX + 2048;
  float* yb = cDA + 32;
  const int tid = tidx(), lane = tid & 63, wave = tid >> 6;
  const int l15 = lane & 15, lg = lane >> 4;
  const bf* XBC = (const bf*)(p.ws + OFF_XBC);
  const float* DTR = (const float*)(p.ws + OFF_DTRAW);
  bf* Y = (bf*)(p.ws + OFF_XRAW) + (size_t)dir * RT * 512;
  const float dtb = p.in[dir ? 42 : 40][hh];
  const float Aneg = -expf(p.in[dir ? 43 : 41][hh]);
  const int st = tid >> 4, q = tid & 15;
  const int r0 = wave * 8 + lg * 2;
  float s0[8], s1[8];
#pragma unroll
  for (int j = 0; j < 8; ++j) { s0[j] = 0.f; s1[j] = 0.f; }
  uint4 gB, gC;
  uint2 gX;
  float gD;
  {
    size_t R = (size_t)scan_row(b, dir, st);
    gB = *(const uint4*)(XBC + R * 1024 + 512 + grp * 128 + q * 8);
    gC = *(const uint4*)(XBC + R * 1024 + 768 + grp * 128 + q * 8);
    gX = *(const uint2*)(XBC + R * 1024 + hh * 64 + q * 4);
    gD = DTR[R * 16 + dir * 8 + hh];
  }
  const int NCH = TA / 32;
  for (int ch = 0; ch <= NCH; ++ch) {
    __syncthreads();
    if (ch > 0) {
      float4 y4 = *(const float4*)(yb + st * 64 + q * 4);
      uint2 o2;
      o2.x = pack2(y4.x, y4.y);
      o2.y = pack2(y4.z, y4.w);
      *(uint2*)(Y + (size_t)scan_row(b, dir, (ch - 1) * 32 + st) * 512 + hh * 64 + q * 4) = o2;
    }
    if (ch == NCH) break;
    {
      float dt = softplusf_(gD + dtb);
      float dA = expf(dt * Aneg);
      float* d = cB + st * 128 + q * 8;
      *(float4*)d = make_float4(bflo(gB.x), bfhi(gB.x), bflo(gB.y), bfhi(gB.y));
      *(float4*)(d + 4) = make_float4(bflo(gB.z), bfhi(gB.z), bflo(gB.w), bfhi(gB.w));
      d = cC + st * 128 + q * 8;
      *(float4*)d = make_float4(bflo(gC.x), bfhi(gC.x), bflo(gC.y), bfhi(gC.y));
      *(float4*)(d + 4) = make_float4(bflo(gC.z), bfhi(gC.z), bflo(gC.w), bfhi(gC.w));
      *(float4*)(cX + st * 64 + q * 4) = make_float4(bflo(gX.x) * dt, bfhi(gX.x) * dt, bflo(gX.y) * dt, bfhi(gX.y) * dt);
      if (q == 0) cDA[st] = dA;
    }
    __syncthreads();
    if (ch + 1 < NCH) {
      size_t R = (size_t)scan_row(b, dir, (ch + 1) * 32 + st);
      gB = *(const uint4*)(XBC + R * 1024 + 512 + grp * 128 + q * 8);
      gC = *(const uint4*)(XBC + R * 1024 + 768 + grp * 128 + q * 8);
      gX = *(const uint2*)(XBC + R * 1024 + hh * 64 + q * 4);
      gD = DTR[R * 16 + dir * 8 + hh];
    }
#pragma unroll 4
    for (int t = 0; t < 32; ++t) {
      float4 b0 = *(const float4*)(cB + t * 128 + l15 * 8);
      float4 b1 = *(const float4*)(cB + t * 128 + l15 * 8 + 4);
      float4 c0 = *(const float4*)(cC + t * 128 + l15 * 8);
      float4 c1 = *(const float4*)(cC + t * 128 + l15 * 8 + 4);
      float2 x2 = *(const float2*)(cX + t * 64 + r0);
      float dA = cDA[t];
      s0[0] = s0[0] * dA + x2.x * b0.x; s0[1] = s0[1] * dA + x2.x * b0.y; s0[2] = s0[2] * dA + x2.x * b0.z; s0[3] = s0[3] * dA + x2.x * b0.w;
      s0[4] = s0[4] * dA + x2.x * b1.x; s0[5] = s0[5] * dA + x2.x * b1.y; s0[6] = s0[6] * dA + x2.x * b1.z; s0[7] = s0[7] * dA + x2.x * b1.w;
      s1[0] = s1[0] * dA + x2.y * b0.x; s1[1] = s1[1] * dA + x2.y * b0.y; s1[2] = s1[2] * dA + x2.y * b0.z; s1[3] = s1[3] * dA + x2.y * b0.w;
      s1[4] = s1[4] * dA + x2.y * b1.x; s1[5] = s1[5] * dA + x2.y * b1.y; s1[6] = s1[6] * dA + x2.y * b1.z; s1[7] = s1[7] * dA + x2.y * b1.w;
      float y0 = s0[0] * c0.x + s0[1] * c0.y + s0[2] * c0.z + s0[3] * c0.w + s0[4] * c1.x + s0[5] * c1.y + s0[6] * c1.z + s0[7] * c1.w;
      float y1 = s1[0] * c0.x + s1[1] * c0.y + s1[2] * c0.z + s1[3] * c0.w + s1[4] * c1.x + s1[5] * c1.y + s1[6] * c1.z + s1[7] * c1.w;
      y0 = red16(y0);
      y1 = red16(y1);
      if (l15 == 0) *(float2*)(yb + t * 64 + r0) = make_float2(y0, y1);
    }
  }
}

__device__ __forceinline__ void gla_chain(const P& p, int chain, char* smem) {
  const int dir = chain & 1, h = (chain >> 1) & 3, b = chain >> 3;
  float* cQ = (float*)smem;
  float* cK = cQ + 2048;
  float* cD = cK + 2048;
  float* cV = cD + 2048;
  float* yb = cV + 4096;
  float* up = yb + 4096;
  float* gbias = up + 1024;
  const int tid = tidx(), lane = tid & 63, wave = tid >> 6;
  const int l15 = lane & 15, lg = lane >> 4;
  const bf* P1 = (const bf*)(p.ws + OFF_P1C);
  bf* Y = (bf*)(p.ws + OFF_GY) + (size_t)dir * RT * 512;
  const float* gup = p.in[dir ? 48 : 46];
  const float* gb = p.in[dir ? 49 : 47];
  __syncthreads();
  for (int i = tid; i < 1024; i += NT) up[i] = gup[(i >> 6) * 256 + h * 64 + (i & 63)];
  if (tid < 64) gbias[tid] = gb[h * 64 + tid];
  const int st = tid >> 4, q = tid & 15;
  const int r0 = wave * 16 + lg * 4;
  float s[4][4];
#pragma unroll
  for (int r = 0; r < 4; ++r)
#pragma unroll
    for (int j = 0; j < 4; ++j) s[r][j] = 0.f;
  uint2 gQ, gK;
  uint4 gV, gG0, gG1;
  {
    const bf* row = P1 + (size_t)scan_row(b, dir, st) * 2080;
    gQ = *(const uint2*)(row + 528 + h * 64 + q * 4);
    gK = *(const uint2*)(row + 784 + h * 64 + q * 4);
    gV = *(const uint4*)(row + 1040 + h * 128 + q * 8);
    gG0 = *(const uint4*)(row + 2064);
    gG1 = *(const uint4*)(row + 2072);
  }
  const int NCH = TA / 32;
  for (int ch = 0; ch <= NCH; ++ch) {
    __syncthreads();
    if (ch > 0) {
      float4 ya = *(const float4*)(yb + st * 128 + q * 8);
      float4 yc = *(const float4*)(yb + st * 128 + q * 8 + 4);
      uint4 o4;
      o4.x = pack2(ya.x, ya.y); o4.y = pack2(ya.z, ya.w); o4.z = pack2(yc.x, yc.y); o4.w = pack2(yc.z, yc.w);
      *(uint4*)(Y + (size_t)scan_row(b, dir, (ch - 1) * 32 + st) * 512 + h * 128 + q * 8) = o4;
    }
    if (ch == NCH) break;
    {
      float gd[16];
      gd[0] = bflo(gG0.x); gd[1] = bfhi(gG0.x); gd[2] = bflo(gG0.y); gd[3] = bfhi(gG0.y);
      gd[4] = bflo(gG0.z); gd[5] = bfhi(gG0.z); gd[6] = bflo(gG0.w); gd[7] = bfhi(gG0.w);
      gd[8] = bflo(gG1.x); gd[9] = bfhi(gG1.x); gd[10] = bflo(gG1.y); gd[11] = bfhi(gG1.y);
      gd[12] = bflo(gG1.z); gd[13] = bfhi(gG1.z); gd[14] = bflo(gG1.w); gd[15] = bfhi(gG1.w);
      float4 z = *(const float4*)(gbias + q * 4);
#pragma unroll
      for (int i = 0; i < 16; ++i) {
        float4 u4 = *(const float4*)(up + i * 64 + q * 4);
        z.x += gd[i] * u4.x; z.y += gd[i] * u4.y; z.z += gd[i] * u4.z; z.w += gd[i] * u4.w;
      }
      float4 dd;
      dd.x = expf(-softplusf_(-z.x) * (1.f / 16.f));
      dd.y = expf(-softplusf_(-z.y) * (1.f / 16.f));
      dd.z = expf(-softplusf_(-z.z) * (1.f / 16.f));
      dd.w = expf(-softplusf_(-z.w) * (1.f / 16.f));
      *(float4*)(cD + st * 64 + q * 4) = dd;
      *(float4*)(cQ + st * 64 + q * 4) = make_float4(bflo(gQ.x) * 0.125f, bfhi(gQ.x) * 0.125f, bflo(gQ.y) * 0.125f, bfhi(gQ.y) * 0.125f);
      *(float4*)(cK + st * 64 + q * 4) = make_float4(bflo(gK.x), bfhi(gK.x), bflo(gK.y), bfhi(gK.y));
      float* d = cV + st * 128 + q * 8;
      *(float4*)d = make_float4(bflo(gV.x), bfhi(gV.x), bflo(gV.y), bfhi(gV.y));
      *(float4*)(d + 4) = make_float4(bflo(gV.z), bfhi(gV.z), bflo(gV.w), bfhi(gV.w));
    }
    __syncthreads();
    if (ch + 1 < NCH) {
      const bf* row = P1 + (size_t)scan_row(b, dir, (ch + 1) * 32 + st) * 2080;
      gQ = *(const uint2*)(row + 528 + h * 64 + q * 4);
      gK = *(const uint2*)(row + 784 + h * 64 + q * 4);
      gV = *(const uint4*)(row + 1040 + h * 128 + q * 8);
      gG0 = *(const uint4*)(row + 2064);
      gG1 = *(const uint4*)(row + 2072);
    }
#pragma unroll 4
    for (int t = 0; t < 32; ++t) {
      float4 q4 = *(const float4*)(cQ + t * 64 + l15 * 4);
      float4 k4 = *(const float4*)(cK + t * 64 + l15 * 4);
      float4 d4 = *(const float4*)(cD + t * 64 + l15 * 4);
      float4 v4 = *(const float4*)(cV + t * 128 + r0);
      float vv[4] = {v4.x, v4.y, v4.z, v4.w};
      float yy[4];
#pragma unroll
      for (int r = 0; r < 4; ++r) {
        s[r][0] = s[r][0] * d4.x + k4.x * vv[r];
        s[r][1] = s[r][1] * d4.y + k4.y * vv[r];
        s[r][2] = s[r][2] * d4.z + k4.z * vv[r];
        s[r][3] = s[r][3] * d4.w + k4.w * vv[r];
        yy[r] = red16(s[r][0] * q4.x + s[r][1] * q4.y + s[r][2] * q4.z + s[r][3] * q4.w);
      }
      if (l15 == 0) *(float4*)(yb + t * 128 + r0) = make_float4(yy[0], yy[1], yy[2], yy[3]);
    }
  }
}

typedef __attribute__((address_space(3))) s16x4* lds_s16x4p;
__device__ __forceinline__ bf16x8 trfrag(const bf* img, int ld, int r0, int c0, int lane) {
  const bf* pp = img + (r0 + ((lane & 15) >> 2)) * ld + c0 + (lane & 3) * 4;
  s16x4 v0 = __builtin_amdgcn_ds_read_tr16_b64_v4i16((lds_s16x4p)pp);
  s16x4 v1 = __builtin_amdgcn_ds_read_tr16_b64_v4i16((lds_s16x4p)(pp + 4 * ld));
  return __builtin_shufflevector(v0, v1, 0, 1, 2, 3, 4, 5, 6, 7);
}
__device__ __forceinline__ bf16x8 pack8(f32x4 a, f32x4 b) {
  i32x4 t;
  t[0] = (int)pack2(a[0], a[1]); t[1] = (int)pack2(a[2], a[3]); t[2] = (int)pack2(b[0], b[1]); t[3] = (int)pack2(b[2], b[3]);
  return __builtin_bit_cast(bf16x8, t);
}
__device__ __forceinline__ bf16x8 ld2x64(const bf* p0, const bf* p1) {
  uint2 a = *(const uint2*)p0, b2 = *(const uint2*)p1;
  i32x4 t;
  t[0] = (int)a.x; t[1] = (int)a.y; t[2] = (int)b2.x; t[3] = (int)b2.y;
  return __builtin_bit_cast(bf16x8, t);
}

__device__ __forceinline__ void gla_chain2(const P& p, int chain, char* smem) {
  const int dir = chain & 1, h = (chain >> 1) & 3, b = chain >> 3;
  bf* Qs = (bf*)smem;
  bf* Ks = Qs + 64 * 72;
  bf* Vs = Ks + 64 * 72;
  bf* Ps = Vs + 64 * 144;
  bf* GD = Ps + 64 * 72;
  float* segtot = (float*)(GD + 64 * 16);
  float* dS = segtot + 512;
  const int tid = tidx(), lane = tid & 63, wave = tid >> 6;
  const int l15 = lane & 15, g = lane >> 4;
  const bf* P1 = (const bf*)(p.ws + OFF_P1C);
  bf* Y = (bf*)(p.ws + OFF_GY) + (size_t)dir * RT * 512;
  const float* gup = p.in[dir ? 48 : 46];
  const float* gb = p.in[dir ? 49 : 47];
  const int kc = tid & 63, seg = tid >> 6;
  float upr[16];
#pragma unroll
  for (int r = 0; r < 16; ++r) upr[r] = gup[r * 256 + h * 64 + kc];
  const float bk = gb[h * 64 + kc];
  const int stok = tid >> 3, sc8 = (tid & 7) * 8;
  f32x4 S[4];
#pragma unroll
  for (int kt = 0; kt < 4; ++kt) S[kt] = (f32x4){0.f, 0.f, 0.f, 0.f};
  uint4 rq, rk, rv0, rv1, rg = make_uint4(0, 0, 0, 0);
  {
    const bf* row = P1 + (size_t)scan_row(b, dir, stok) * 2080;
    rq = *(const uint4*)(row + 528 + h * 64 + sc8);
    rk = *(const uint4*)(row + 784 + h * 64 + sc8);
    rv0 = *(const uint4*)(row + 1040 + h * 128 + sc8 * 2);
    rv1 = *(const uint4*)(row + 1040 + h * 128 + sc8 * 2 + 8);
    if (tid < 128) rg = *(const uint4*)(P1 + (size_t)scan_row(b, dir, tid >> 1) * 2080 + 2064 + (tid & 1) * 8);
  }
  const int NCH = TA / 64;
  for (int c = 0; c < NCH; ++c) {
    __syncthreads();
    *(uint4*)(Qs + stok * 72 + sc8) = rq;
    *(uint4*)(Ks + stok * 72 + sc8) = rk;
    *(uint4*)(Vs + stok * 144 + sc8 * 2) = rv0;
    *(uint4*)(Vs + stok * 144 + sc8 * 2 + 8) = rv1;
    if (tid < 128) *(uint4*)(GD + (tid >> 1) * 16 + (tid & 1) * 8) = rg;
    __syncthreads();
    if (c + 1 < NCH) {
      const bf* row = P1 + (size_t)scan_row(b, dir, (c + 1) * 64 + stok) * 2080;
      rq = *(const uint4*)(row + 528 + h * 64 + sc8);
      rk = *(const uint4*)(row + 784 + h * 64 + sc8);
      rv0 = *(const uint4*)(row + 1040 + h * 128 + sc8 * 2);
      rv1 = *(const uint4*)(row + 1040 + h * 128 + sc8 * 2 + 8);
      if (tid < 128) rg = *(const uint4*)(P1 + (size_t)scan_row(b, dir, (c + 1) * 64 + (tid >> 1)) * 2080 + 2064 + (tid & 1) * 8);
    }
    float lc[8];
    {
      float run = 0.f;
#pragma unroll
      for (int ii = 0; ii < 8; ++ii) {
        const bf* gr = GD + (seg * 8 + ii) * 16;
        uint4 g0 = *(const uint4*)gr, g1 = *(const uint4*)(gr + 8);
        float z = bk;
        z += bflo(g0.x) * upr[0] + bfhi(g0.x) * upr[1] + bflo(g0.y) * upr[2] + bfhi(g0.y) * upr[3];
        z += bflo(g0.z) * upr[4] + bfhi(g0.z) * upr[5] + bflo(g0.w) * upr[6] + bfhi(g0.w) * upr[7];
        z += bflo(g1.x) * upr[8] + bfhi(g1.x) * upr[9] + bflo(g1.y) * upr[10] + bfhi(g1.y) * upr[11];
        z += bflo(g1.z) * upr[12] + bfhi(g1.z) * upr[13] + bflo(g1.w) * upr[14] + bfhi(g1.w) * upr[15];
        run += -softplusf_(-z) * (1.f / 16.f);
        lc[ii] = run;
      }
      segtot[seg * 64 + kc] = run;
    }
    __syncthreads();
    {
      float off = 0.f, tot = 0.f;
#pragma unroll
      for (int s2 = 0; s2 < 8; ++s2) {
        float t = segtot[s2 * 64 + kc];
        tot += t;
        off += (s2 < seg) ? t : 0.f;
      }
#pragma unroll
      for (int ii = 0; ii < 8; ++ii) {
        int i = seg * 8 + ii;
        float cum = off + lc[ii];
        float qv = bf2f(Qs[i * 72 + kc]), kv = bf2f(Ks[i * 72 + kc]);
        float eq = __expf(cum - tot);
        Qs[i * 72 + kc] = f2bf(qv * 0.125f * eq);
        Ks[i * 72 + kc] = f2bf(kv * __builtin_amdgcn_rcpf(eq));
      }
      if (seg == 0) dS[kc] = __expf(tot);
    }
    __syncthreads();
#pragma unroll
    for (int kt = 0; kt < 4; ++kt) {
      float4 d4 = *(const float4*)(dS + kt * 16 + g * 4);
      S[kt][0] *= d4.x; S[kt][1] *= d4.y; S[kt][2] *= d4.z; S[kt][3] *= d4.w;
    }
#pragma unroll
    for (int tt = 0; tt < 2; ++tt) {
      int idx = wave * 2 + tt, jt = idx >> 2, it = idx & 3;
      f32x4 acc = (f32x4){0.f, 0.f, 0.f, 0.f};
      if (jt <= it) {
#pragma unroll
        for (int ks = 0; ks < 2; ++ks) {
          bf16x8 a = *(const bf16x8*)(Ks + (jt * 16 + l15) * 72 + ks * 32 + g * 8);
          bf16x8 bq = *(const bf16x8*)(Qs + (it * 16 + l15) * 72 + ks * 32 + g * 8);
          acc = __builtin_amdgcn_mfma_f32_16x16x32_bf16(a, bq, acc, 0, 0, 0);
        }
        int i = it * 16 + l15;
#pragma unroll
        for (int r = 0; r < 4; ++r) { int j = jt * 16 + g * 4 + r; acc[r] = (j <= i) ? acc[r] : 0.f; }
      }
      uint2 o;
      o.x = pack2(acc[0], acc[1]);
      o.y = pack2(acc[2], acc[3]);
      *(uint2*)(Ps + (it * 16 + l15) * 72 + jt * 16 + g * 4) = o;
    }
    __syncthreads();
    f32x4 y[4];
#pragma unroll
    for (int it = 0; it < 4; ++it) y[it] = (f32x4){0.f, 0.f, 0.f, 0.f};
#pragma unroll
    for (int s2 = 0; s2 < 2; ++s2) {
      bf16x8 sf = pack8(S[2 * s2], S[2 * s2 + 1]);
#pragma unroll
      for (int it = 0; it < 4; ++it) {
        const bf* qr = Qs + (it * 16 + l15) * 72 + g * 4;
        bf16x8 aq = ld2x64(qr + (2 * s2) * 16, qr + (2 * s2 + 1) * 16);
        y[it] = __builtin_amdgcn_mfma_f32_16x16x32_bf16(aq, sf, y[it], 0, 0, 0);
      }
    }
#pragma unroll
    for (int s2 = 0; s2 < 2; ++s2) {
      bf16x8 vf = trfrag(Vs, 144, s2 * 32 + g * 8, wave * 16, lane);
#pragma unroll
      for (int it = 0; it < 4; ++it) {
        bf16x8 ap = *(const bf16x8*)(Ps + (it * 16 + l15) * 72 + s2 * 32 + g * 8);
        y[it] = __builtin_amdgcn_mfma_f32_16x16x32_bf16(ap, vf, y[it], 0, 0, 0);
      }
#pragma unroll
      for (int kt = 0; kt < 4; ++kt) {
        bf16x8 ak = trfrag(Ks, 72, s2 * 32 + g * 8, kt * 16, lane);
        S[kt] = __builtin_amdgcn_mfma_f32_16x16x32_bf16(ak, vf, S[kt], 0, 0, 0);
      }
    }
#pragma unroll
    for (int it = 0; it < 4; ++it)
#pragma unroll
      for (int r = 0; r < 4; ++r) {
        int i = it * 16 + g * 4 + r;
        Y[(size_t)scan_row(b, dir, c * 64 + i) * 512 + h * 128 + wave * 16 + l15] = f2bf(y[it][r]);
      }
  }
}

__device__ __forceinline__ void ssd_chain2(const P& p, int chain, char* smem) {
  const int dir = chain & 1, hh = (chain >> 1) & 7, b = chain >> 4;
  const int grp = hh >> 2;
  bf* Cs = (bf*)smem;
  bf* Bs = Cs + 64 * 136;
  bf* Xs = Bs + 64 * 136;
  bf* Xw = Xs + 64 * 72;
  bf* Ps = Xw + 64 * 72;
  float* dtS = (float*)(Ps + 64 * 72);
  float* cumS = dtS + 64;
  float* ecS = cumS + 64;
  float* totS = ecS + 64;
  const int tid = tidx(), lane = tid & 63, wave = tid >> 6;
  const int l15 = lane & 15, g = lane >> 4;
  const int vt = wave & 3, ih = wave >> 2;
  const bf* XBC = (const bf*)(p.ws + OFF_XBC);
  const float* DTR = (const float*)(p.ws + OFF_DTRAW);
  bf* Y = (bf*)(p.ws + OFF_XRAW) + (size_t)dir * RT * 512;
  const float dtb = p.in[dir ? 42 : 40][hh];
  const float Aneg = -expf(p.in[dir ? 43 : 41][hh]);
  const int stok = tid >> 3, sc = tid & 7;
  f32x4 S[8];
#pragma unroll
  for (int nt = 0; nt < 8; ++nt) S[nt] = (f32x4){0.f, 0.f, 0.f, 0.f};
  uint4 rc0, rc1, rb0, rb1, rx;
  float rdt = 0.f;
  {
    const bf* row = XBC + (size_t)scan_row(b, dir, stok) * 1024;
    rb0 = *(const uint4*)(row + 512 + grp * 128 + sc * 16);
    rb1 = *(const uint4*)(row + 512 + grp * 128 + sc * 16 + 8);
    rc0 = *(const uint4*)(row + 768 + grp * 128 + sc * 16);
    rc1 = *(const uint4*)(row + 768 + grp * 128 + sc * 16 + 8);
    rx = *(const uint4*)(row + hh * 64 + sc * 8);
    if (tid < 64) rdt = DTR[(size_t)scan_row(b, dir, tid) * 16 + dir * 8 + hh];
  }
  const int NCH = TA / 64;
  for (int c = 0; c < NCH; ++c) {
    __syncthreads();
    *(uint4*)(Cs + stok * 136 + sc * 16) = rc0;
    *(uint4*)(Cs + stok * 136 + sc * 16 + 8) = rc1;
    *(uint4*)(Bs + stok * 136 + sc * 16) = rb0;
    *(uint4*)(Bs + stok * 136 + sc * 16 + 8) = rb1;
    if (tid < 64) {
      float dt = softplusf_(rdt + dtb);
      float cum = dt * Aneg;
#pragma unroll
      for (int o = 1; o < 64; o <<= 1) {
        float t = __shfl_up(cum, o);
        if (lane >= o) cum += t;
      }
      float tot = __shfl(cum, 63);
      dtS[lane] = dt;
      cumS[lane] = cum;
      ecS[lane] = __expf(cum);
      if (lane == 0) totS[0] = tot;
    }
    __syncthreads();
    const uint4 cx = rx;
    if (c + 1 < NCH) {
      const bf* row = XBC + (size_t)scan_row(b, dir, (c + 1) * 64 + stok) * 1024;
      rb0 = *(const uint4*)(row + 512 + grp * 128 + sc * 16);
      rb1 = *(const uint4*)(row + 512 + grp * 128 + sc * 16 + 8);
      rc0 = *(const uint4*)(row + 768 + grp * 128 + sc * 16);
      rc1 = *(const uint4*)(row + 768 + grp * 128 + sc * 16 + 8);
      rx = *(const uint4*)(row + hh * 64 + sc * 8);
      if (tid < 64) rdt = DTR[(size_t)scan_row(b, dir, (c + 1) * 64 + tid) * 16 + dir * 8 + hh];
    }
    const float tot = totS[0];
    {
      float dt = dtS[stok];
      float w = dt * __expf(tot - cumS[stok]);
      float x0 = bflo(cx.x), x1 = bfhi(cx.x), x2 = bflo(cx.y), x3 = bfhi(cx.y), x4 = bflo(cx.z), x5 = bfhi(cx.z), x6 = bflo(cx.w), x7 = bfhi(cx.w);
      uint4 o;
      o.x = pack2(x0 * dt, x1 * dt); o.y = pack2(x2 * dt, x3 * dt); o.z = pack2(x4 * dt, x5 * dt); o.w = pack2(x6 * dt, x7 * dt);
      *(uint4*)(Xs + stok * 72 + sc * 8) = o;
      o.x = pack2(x0 * w, x1 * w); o.y = pack2(x2 * w, x3 * w); o.z = pack2(x4 * w, x5 * w); o.w = pack2(x6 * w, x7 * w);
      *(uint4*)(Xw + stok * 72 + sc * 8) = o;
    }
#pragma unroll
    for (int tt = 0; tt < 2; ++tt) {
      int idx = wave * 2 + tt, jt = idx >> 2, it = idx & 3;
      f32x4 acc = (f32x4){0.f, 0.f, 0.f, 0.f};
      if (jt <= it) {
#pragma unroll
        for (int ks = 0; ks < 4; ++ks) {
          bf16x8 a = *(const bf16x8*)(Bs + (jt * 16 + l15) * 136 + ks * 32 + g * 8);
          bf16x8 bq = *(const bf16x8*)(Cs + (it * 16 + l15) * 136 + ks * 32 + g * 8);
          acc = __builtin_amdgcn_mfma_f32_16x16x32_bf16(a, bq, acc, 0, 0, 0);
        }
        int i = it * 16 + l15;
        float ci = cumS[i];
        float4 cj = *(const float4*)(cumS + jt * 16 + g * 4);
        int j0 = jt * 16 + g * 4;
        acc[0] = (j0 + 0 <= i) ? acc[0] * __expf(ci - cj.x) : 0.f;
        acc[1] = (j0 + 1 <= i) ? acc[1] * __expf(ci - cj.y) : 0.f;
        acc[2] = (j0 + 2 <= i) ? acc[2] * __expf(ci - cj.z) : 0.f;
        acc[3] = (j0 + 3 <= i) ? acc[3] * __expf(ci - cj.w) : 0.f;
      }
      uint2 o;
      o.x = pack2(acc[0], acc[1]);
      o.y = pack2(acc[2], acc[3]);
      *(uint2*)(Ps + (it * 16 + l15) * 72 + jt * 16 + g * 4) = o;
    }
    __syncthreads();
    f32x4 y[2];
    y[0] = (f32x4){0.f, 0.f, 0.f, 0.f};
    y[1] = (f32x4){0.f, 0.f, 0.f, 0.f};
#pragma unroll
    for (int s2 = 0; s2 < 4; ++s2) {
      bf16x8 sf = pack8(S[2 * s2], S[2 * s2 + 1]);
#pragma unroll
      for (int ii = 0; ii < 2; ++ii) {
        const bf* qr = Cs + ((ih * 2 + ii) * 16 + l15) * 136 + g * 4;
        bf16x8 aq = ld2x64(qr + (2 * s2) * 16, qr + (2 * s2 + 1) * 16);
        y[ii] = __builtin_amdgcn_mfma_f32_16x16x32_bf16(aq, sf, y[ii], 0, 0, 0);
      }
    }
    {
      float et = __expf(tot);
#pragma unroll
      for (int nt = 0; nt < 8; ++nt) { S[nt][0] *= et; S[nt][1] *= et; S[nt][2] *= et; S[nt][3] *= et; }
    }
#pragma unroll
    for (int ii = 0; ii < 2; ++ii) {
      float4 e4 = *(const float4*)(ecS + (ih * 2 + ii) * 16 + g * 4);
      y[ii][0] *= e4.x; y[ii][1] *= e4.y; y[ii][2] *= e4.z; y[ii][3] *= e4.w;
    }
#pragma unroll
    for (int s2 = 0; s2 < 2; ++s2) {
      bf16x8 xf = trfrag(Xs, 72, s2 * 32 + g * 8, vt * 16, lane);
#pragma unroll
      for (int ii = 0; ii < 2; ++ii) {
        bf16x8 ap = *(const bf16x8*)(Ps + ((ih * 2 + ii) * 16 + l15) * 72 + s2 * 32 + g * 8);
        y[ii] = __builtin_amdgcn_mfma_f32_16x16x32_bf16(ap, xf, y[ii], 0, 0, 0);
      }
      bf16x8 xwf = trfrag(Xw, 72, s2 * 32 + g * 8, vt * 16, lane);
#pragma unroll
      for (int nt = 0; nt < 8; ++nt) {
        bf16x8 ab = trfrag(Bs, 136, s2 * 32 + g * 8, nt * 16, lane);
        S[nt] = __builtin_amdgcn_mfma_f32_16x16x32_bf16(ab, xwf, S[nt], 0, 0, 0);
      }
    }
#pragma unroll
    for (int ii = 0; ii < 2; ++ii)
#pragma unroll
      for (int r = 0; r < 4; ++r) {
        int i = (ih * 2 + ii) * 16 + g * 4 + r;
        Y[(size_t)scan_row(b, dir, c * 64 + i) * 512 + hh * 64 + vt * 16 + l15] = f2bf(y[ii][r]);
      }
  }
}

__device__ __forceinline__ void ph_mix1(const P& p, char* smem) {
  for (int u = blockIdx.x; u < 192; u += gridDim.x) {
    if (u < 128) ssd_chain2(p, u, smem);
    else gla_chain2(p, u - 128, smem);
  }
}

__device__ __forceinline__ void ph_post1(const P& p, char* smem) {
  float* ws1 = (float*)smem;
  float* ws2 = ws1 + 32;
  const int tid = tidx(), lane = tid & 63, wave = tid >> 6;
  const bf* SYF = (const bf*)(p.ws + OFF_XRAW);
  const bf* SYB = SYF + (size_t)RT * 512;
  const bf* GYF = (const bf*)(p.ws + OFF_GY);
  const bf* GYB = GYF + (size_t)RT * 512;
  const bf* XBC = (const bf*)(p.ws + OFF_XBC);
  const bf* P1 = (const bf*)(p.ws + OFF_P1C);
  bf* O = (bf*)(p.ws + OFF_HO);
  const float dsk = p.in[44][tid >> 6];
  const float sn = p.in[45][tid];
  const float gn = p.in[50][tid & 127];
  for (int rr0 = blockIdx.x * 4; rr0 < NBAT * SEQ; rr0 += gridDim.x * 4) {
    float y[4], y2[4], zg[4], gg[4];
    int Rr[4];
#pragma unroll
    for (int i = 0; i < 4; ++i) {
      int rr = rr0 + i;
      int R = (rr >> 12) * TA + CTX + (rr & 4095);
      Rr[i] = R;
      size_t o = (size_t)R * 512 + tid;
      y[i] = bf2f(SYF[o]) + bf2f(SYB[o]) + bf2f(XBC[(size_t)R * 1024 + tid]) * dsk;
      zg[i] = bf2f(P1[(size_t)R * 2080 + tid]);
      y2[i] = bf2f(GYF[o]) + bf2f(GYB[o]);
      gg[i] = bf2f(P1[(size_t)R * 2080 + 1552 + tid]);
    }
    __syncthreads();
#pragma unroll
    for (int i = 0; i < 4; ++i) {
      y[i] *= siluf_(zg[i]);
      float s1 = wave_sum(y[i] * y[i]);
      float s2 = wave_sum(y2[i] * y2[i]);
      if (lane == 0) { ws1[i * 8 + wave] = s1; ws2[i * 8 + wave] = s2; }
    }
    __syncthreads();
#pragma unroll
    for (int i = 0; i < 4; ++i) {
      int g4 = i * 8 + (wave >> 2) * 4;
      float t1 = ws1[g4] + ws1[g4 + 1] + ws1[g4 + 2] + ws1[g4 + 3];
      int g2 = i * 8 + (wave >> 1) * 2;
      float t2 = ws2[g2] + ws2[g2 + 1];
      float o1 = y[i] * rsqrtf(t1 * (1.f / 256.f) + 1e-6f) * sn;
      float o2 = y2[i] * rsqrtf(t2 * (1.f / 128.f) + 1e-6f) * gn * siluf_(gg[i]);
      O[(size_t)Rr[i] * 1024 + tid] = f2bf(o1);
      O[(size_t)Rr[i] * 1024 + 512 + tid] = f2bf(o2);
    }
  }
}

__device__ __forceinline__ void ph_final(const P& p) {
  const int lane = tidx() & 63, wave = tidx() >> 6;
  const float* g = p.in[51];
  for (int r = blockIdx.x * 8 + wave; r < NBAT * SEQ; r += gridDim.x * 8) {
    float* row = p.out + (size_t)r * 1024;
    float4 v[4];
    float ss = 0.f;
#pragma unroll
    for (int i = 0; i < 4; ++i) {
      v[i] = *(const float4*)(row + i * 256 + lane * 4);
      ss += v[i].x * v[i].x + v[i].y * v[i].y + v[i].z * v[i].z + v[i].w * v[i].w;
    }
    ss = wave_sum(ss);
    float rs = rsqrtf(ss * (1.f / 1024.f) + 1e-6f);
#pragma unroll
    for (int i = 0; i < 4; ++i) {
      float4 gg = *(const float4*)(g + i * 256 + lane * 4);
      float4 o = make_float4(v[i].x * rs * gg.x, v[i].y * rs * gg.y, v[i].z * rs * gg.z, v[i].w * rs * gg.w);
      *(float4*)(row + i * 256 + lane * 4) = o;
    }
  }
}

constexpr int NPH = 20;
template <int PH>
__device__ __forceinline__ void run_phase(const P& p, char* smem) {
  const bf* WT = (const bf*)(p.ws + OFF_WT);
  const bf* HO = (const bf*)(p.ws + OFF_HO);
  const bf* HID = (const bf*)(p.ws + OFF_HID);
  if constexpr (PH == 0) {
    if (blockIdx.x == 0 && tidx() == 0) *(int*)(p.ws + OFF_CNT) = 0;
    ph_mod(p, smem);
    ph_wt(p, 0, smem);
  } else if constexpr (PH == 1) ph_ada(p, 0, 0, 1, 0);
  else if constexpr (PH == 2) ph_gemm<0>(p, HO, WT + WT_IN, 1024, 13, 0, 0, smem);
  else if constexpr (PH == 3) { ph_rope(p, smem); ph_rwkv_prep(p, smem); }
  else if constexpr (PH == 4) ph_mix0(p, smem);
  else if constexpr (PH == 5) ph_rwkv_post(p);
  else if constexpr (PH == 6) ph_gemm<2>(p, HO, WT + WT_OUT, 1024, 4, 0, 0, smem);
  else if constexpr (PH == 7) ph_ada(p, 0, 1, 0, 0);
  else if constexpr (PH == 8) ph_gemm<3>(p, HO, WT + WT_W1, 1024, 16, 0, 0, smem);
  else if constexpr (PH == 9) ph_gemm<4>(p, HID, WT + WT_W2, 4096, 4, 0, 0, smem);
  else if constexpr (PH == 10) { ph_ada(p, 1, 0, 0, 0); ph_wt(p, 1, smem); }
  else if constexpr (PH == 11) ph_gemm<1>(p, HO, WT + WT_IN, 1024, 13, 1, 0, smem);
  else if constexpr (PH == 12) ph_conv(p);
  else if constexpr (PH == 13) ph_mix1(p, smem);
  else if constexpr (PH == 14) ph_post1(p, smem);
  else if constexpr (PH == 15) ph_gemm<2>(p, HO, WT + WT_OUT, 1024, 4, 1, 1, smem);
  else if constexpr (PH == 16) ph_ada(p, 1, 1, 0, 1);
  else if constexpr (PH == 17) ph_gemm<3>(p, HO, WT + WT_W1, 1024, 16, 1, 1, smem);
  else if constexpr (PH == 18) ph_gemm<4>(p, HID, WT + WT_W2, 4096, 4, 1, 1, smem);
  else ph_final(p);
}

constexpr int LDS_BYTES = 131072 + 64;
template <int PH>
__device__ __forceinline__ void run_all(const P& p, char* smem) {
  run_phase<PH>(p, smem);
#ifdef PROBE_MASK
  if constexpr (((PROBE_MASK) >> PH) & 1) {
    cg::this_grid().sync();
    if constexpr (PH == 4) {
      if (blockIdx.x == 0 && tidx() == 0) *(int*)(p.ws + OFF_CNT) = 0;
      cg::this_grid().sync();
    }
    run_phase<PH>(p, smem);
  }
#endif
  if constexpr (PH + 1 < NPH) {
    cg::this_grid().sync();
    run_all<PH + 1>(p, smem);
  }
}
__global__ void __launch_bounds__(NT) mega(P p) {
  extern __shared__ __attribute__((aligned(16))) char smem[];
  run_all<0>(p, smem);
}

extern "C" void kernel_launch(void* const* d_in, const int* in_sizes, int n_in, void* d_out, int out_size, void* d_ws,
                              size_t ws_size, hipStream_t stream) {
  P p{};
  for (int i = 0; i < 52; ++i) p.in[i] = (const float*)d_in[i];
  p.out = (float*)d_out;
  p.ws = (char*)d_ws;
  static int grid_blocks = 0;
  if (!grid_blocks) {
    int dev = 0, cus = 0, per_cu = 0;
    (void)hipGetDevice(&dev);
    (void)hipDeviceGetAttribute(&cus, hipDeviceAttributeMultiprocessorCount, dev);
    (void)hipFuncSetAttribute((const void*)mega, hipFuncAttributeMaxDynamicSharedMemorySize, LDS_BYTES);
    (void)hipOccupancyMaxActiveBlocksPerMultiprocessor(&per_cu, mega, NT, LDS_BYTES);
    if (per_cu < 1) per_cu = 1;
    if (per_cu > 1) per_cu = 1;
    grid_blocks = cus * per_cu;
  }
  void* args[] = {&p};
  hipError_t e = hipLaunchCooperativeKernel((void*)mega, dim3(grid_blocks), dim3(NT), args, LDS_BYTES, stream);
  if (e != hipSuccess) fprintf(stderr, "cooperative launch failed: %s (grid %d)\n", hipGetErrorString(e), grid_blocks);
}
```

```cpp
#include <hip/hip_runtime.h>
#include <hip/hip_cooperative_groups.h>
#include <cstdio>
namespace cg = cooperative_groups;

#ifndef MODE_COOP
#define MODE_COOP 1
#endif

typedef unsigned short bf;
typedef __attribute__((ext_vector_type(8))) short bf16x8;
typedef __attribute__((ext_vector_type(4))) float f32x4;
typedef __attribute__((ext_vector_type(4))) int i32x4;

constexpr int NT = 512;
constexpr int Dm = 1024, NBAT = 8, SEQ = 4096, CTX = 256, TA = 4352, RT = NBAT * TA;

constexpr size_t OFF_MOD = 0;
constexpr size_t OFF_CNT = 450000;
constexpr size_t OFF_WT = 524288;
constexpr size_t WT_IN = 0, WT_OUT = (size_t)3328 * 1024, WT_W1 = WT_OUT + (size_t)1024 * 1024, WT_W2 = WT_W1 + (size_t)4096 * 1024;
constexpr size_t OFF_CTXX = OFF_WT + (size_t)12544 * 1024 * 2;
constexpr size_t OFF_HO = OFF_CTXX + (size_t)2048 * 1024 * 4;
constexpr size_t OFF_BIG = OFF_HO + (size_t)RT * 1024 * 2;
constexpr size_t SZ512 = (size_t)RT * 512 * 2;
constexpr size_t OFF_QKV = OFF_BIG;
constexpr size_t OFF_PREP = OFF_QKV + (size_t)RT * 1536 * 2;
constexpr size_t OFF_G = OFF_PREP + 7 * SZ512;
constexpr size_t OFF_BONUS = OFF_G + SZ512;
constexpr size_t OFF_LW = OFF_BONUS + (size_t)RT * 8 * 4;
constexpr size_t OFF_HID = OFF_BIG;
constexpr size_t OFF_P1C = OFF_BIG;
constexpr size_t OFF_XRAW = OFF_P1C + (size_t)RT * 2080 * 2;
constexpr size_t OFF_DTRAW = OFF_XRAW + (size_t)RT * 1024 * 2;
constexpr size_t OFF_XBC = OFF_DTRAW + (size_t)RT * 16 * 4;
constexpr size_t OFF_GY = OFF_XBC + (size_t)RT * 1024 * 2;

struct P {
  const float* in[52];
  float* out;
  char* ws;
};

__device__ __forceinline__ int tidx() { int t = threadIdx.x; asm volatile("" : "+v"(t)); return t; }
__device__ __forceinline__ bf f2bf(float f) { __bf16 r = (__bf16)f; return __builtin_bit_cast(bf, r); }
__device__ __forceinline__ float bf2f(bf h) { return __uint_as_float(((unsigned)h) << 16); }
__device__ __forceinline__ float bflo(unsigned u) { return __uint_as_float(u << 16); }
__device__ __forceinline__ float bfhi(unsigned u) { return __uint_as_float(u & 0xffff0000u); }
typedef __bf16 bf16x2_t __attribute__((ext_vector_type(2)));
typedef float f32x2_t __attribute__((ext_vector_type(2)));
__device__ __forceinline__ unsigned pack2(float a, float b) { f32x2_t v = {a, b}; bf16x2_t r = __builtin_convertvector(v, bf16x2_t); return __builtin_bit_cast(unsigned, r); }
__device__ __forceinline__ float sigmoidf_(float x) { return __builtin_amdgcn_rcpf(1.f + __expf(-x)); }
__device__ __forceinline__ float softplusf_(float x) { return x > 15.f ? x : __logf(1.f + __expf(x)); }
__device__ __forceinline__ float siluf_(float x) { return x * __builtin_amdgcn_rcpf(1.f + __expf(-x)); }
__device__ __forceinline__ float wave_sum(float v) {
#pragma unroll
  for (int o = 32; o >= 1; o >>= 1) v += __shfl_xor(v, o);
  return v;
}
template <int C>
__device__ __forceinline__ float dppf(float x) {
  return __builtin_bit_cast(float, __builtin_amdgcn_update_dpp(0, __builtin_bit_cast(int, x), C, 0xF, 0xF, true));
}
__device__ __forceinline__ float red16(float x) {
  x += dppf<0xB1>(x);
  x += dppf<0x4E>(x);
  x += dppf<0x141>(x);
  x += dppf<0x128>(x);
  return x;
}
__device__ __forceinline__ float* xrow(const P& p, int R) {
  int b = R / TA, a = R - b * TA;
  if (a < CTX) return (float*)(p.ws + OFF_CTXX) + (size_t)(b * CTX + a) * Dm;
  return p.out + (size_t)(b * SEQ + a - CTX) * Dm;
}
__device__ __forceinline__ const float* inrow(const P& p, int R) {
  int b = R / TA, a = R - b * TA;
  if (a < CTX) return p.in[2] + (size_t)(b * CTX + a) * Dm;
  return p.in[0] + (size_t)(b * SEQ + a - CTX) * Dm;
}
__device__ __forceinline__ int mrow(int R) {
  int b = R / TA, a = R - b * TA;
  return a < CTX ? 8 : b;
}

__device__ __forceinline__ void ph_mod(const P& p, char* smem) {
  float* sc = (float*)smem;
  float* red = sc + 9 * 1024;
  const int tid = tidx();
  bool loaded = false;
  for (int unit = blockIdx.x; unit < 2 * 192; unit += gridDim.x) {
    int layer = unit / 192, cch = unit - layer * 192;
    const float* W = p.in[layer ? 30 : 4];
    const float* bias = p.in[layer ? 31 : 5];
    __syncthreads();
    if (!loaded) {
      for (int i = tid; i < 9 * 1024; i += NT) {
        int r = i >> 10, k = i & 1023;
        float v = (r < 8) ? p.in[1][r * 1024 + k] : p.in[3][k];
        sc[i] = siluf_(v);
      }
      loaded = true;
      __syncthreads();
    }
    int cl = tid & 31, kg = tid >> 5;
    int col = cch * 32 + cl;
    float acc[9];
#pragma unroll
    for (int r = 0; r < 9; ++r) acc[r] = 0.f;
    for (int k = kg * 64; k < kg * 64 + 64; ++k) {
      float w = W[(size_t)k * 6144 + col];
#pragma unroll
      for (int r = 0; r < 9; ++r) acc[r] += sc[r * 1024 + k] * w;
    }
#pragma unroll
    for (int r = 0; r < 9; ++r) red[(kg * 9 + r) * 32 + cl] = acc[r];
    __syncthreads();
    if (tid < 288) {
      int r = tid >> 5, c = tid & 31;
      float s = 0.f;
#pragma unroll
      for (int g = 0; g < 16; ++g) s += red[(g * 9 + r) * 32 + c];
      ((float*)(p.ws + OFF_MOD))[(size_t)(layer * 9 + r) * 6144 + cch * 32 + c] = s + bias[cch * 32 + c];
    }
  }
}

__device__ __forceinline__ void transpose_one(const float* W, bf* Wt, int K, int N, int Npad, int vb, int nvb, char* smem) {
  float* tile = (float*)smem;
  const int tid = tidx();
  int ntn = Npad / 64, ntk = K / 64;
  for (int t = vb; t < ntn * ntk; t += nvb) {
    int tn = t / ntk, tk = t - tn * ntk;
    int n0 = tn * 64, k0 = tk * 64;
    __syncthreads();
#pragma unroll
    for (int i = 0; i < 8; ++i) {
      int kk = (tid >> 6) + 8 * i, nn = tid & 63;
      float v = (n0 + nn < N) ? W[(size_t)(k0 + kk) * N + n0 + nn] : 0.f;
      tile[kk * 65 + nn] = v;
    }
    __syncthreads();
#pragma unroll
    for (int i = 0; i < 8; ++i) {
      int nn = (tid >> 6) + 8 * i, kk = tid & 63;
      Wt[(size_t)(n0 + nn) * K + k0 + kk] = f2bf(tile[kk * 65 + nn]);
    }
  }
}
__device__ __forceinline__ void ph_wt(const P& p, int layer, char* smem) {
  bf* WT = (bf*)(p.ws + OFF_WT);
  int base = layer ? 34 : 8;
  int nin = layer ? 3104 : 3328, ninp = 3328;
  int nb = gridDim.x, b = blockIdx.x;
  for (int mtx = 0; mtx < 4; ++mtx) {
    const float* W = p.in[base + mtx];
    bf* dst = WT + (mtx == 0 ? WT_IN : mtx == 1 ? WT_OUT : mtx == 2 ? WT_W1 : WT_W2);
    int K = mtx == 3 ? 4096 : 1024;
    int N = mtx == 0 ? nin : mtx == 2 ? 4096 : 1024;
    int Np = mtx == 0 ? ninp : N;
    transpose_one(W, dst, K, N, Np, (b + 64 * mtx) % nb, nb, smem);
  }
}

__device__ __forceinline__ void ph_ada(const P& p, int layer, int which, int useInput, int latonly) {
  const int lane = tidx() & 63, wave = tidx() >> 6;
  const float* ng = p.in[(layer ? 32 : 6) + which];
  const float* mod = (const float*)(p.ws + OFF_MOD);
  bf* H = (bf*)(p.ws + OFF_HO);
  for (int R = blockIdx.x * 8 + wave; R < RT; R += gridDim.x * 8) {
    int b = R / TA, a = R - b * TA;
    if (latonly && a < CTX) continue;
    const float* src = useInput ? inrow(p, R) : xrow(p, R);
    float4 v[4];
    float ss = 0.f;
#pragma unroll
    for (int i = 0; i < 4; ++i) {
      v[i] = *(const float4*)(src + i * 256 + lane * 4);
      ss += v[i].x * v[i].x + v[i].y * v[i].y + v[i].z * v[i].z + v[i].w * v[i].w;
    }
    ss = wave_sum(ss);
    float rs = rsqrtf(ss * (1.f / 1024.f) + 1e-6f);
    int mr = a < CTX ? 8 : b;
    const float* sh = mod + (size_t)(layer * 9 + mr) * 6144 + (which * 3 + 0) * 1024;
    const float* scl = mod + (size_t)(layer * 9 + mr) * 6144 + (which * 3 + 1) * 1024;
#pragma unroll
    for (int i = 0; i < 4; ++i) {
      int k = i * 256 + lane * 4;
      float4 g = *(const float4*)(ng + k);
      float4 s4 = *(const float4*)(sh + k);
      float4 c4 = *(const float4*)(scl + k);
      float o0 = v[i].x * rs * g.x * (1.f + c4.x) + s4.x;
      float o1 = v[i].y * rs * g.y * (1.f + c4.y) + s4.y;
      float o2 = v[i].z * rs * g.z * (1.f + c4.z) + s4.z;
      float o3 = v[i].w * rs * g.w * (1.f + c4.w) + s4.w;
      uint2 o;
      o.x = pack2(o0, o1);
      o.y = pack2(o2, o3);
      *(uint2*)(H + (size_t)R * 1024 + k) = o;
    }
  }
}

namespace pg8 {
#define PG8_LAS __attribute__((address_space(3)))
typedef float f32x2 __attribute__((ext_vector_type(2)));
typedef unsigned u32x4 __attribute__((ext_vector_type(4)));
constexpr int BM = 256, BK = 64, HALF = 128, HTB = HALF * BK * 2, STAGE_BYTES = 8 * HTB, NXCD = 8, WGM = 8;
__device__ __forceinline__ int lds_byte(int r, int c) { const int st = (r >> 4) * 2 + (c >> 5), rr = r & 15, cc = c & 31, ob = rr * 64 + cc * 2; return st * 1024 + (ob ^ (((ob >> 9) & 1) << 5)); }
__device__ __forceinline__ void stage_rc(int b, int& R, int& C) { const int st = b / 1024, sb = b % 1024, swz = sb ^ (((sb >> 9) & 1) << 5); R = (st >> 1) * 16 + swz / 64; C = (st & 1) * 32 + (swz % 64) / 2; }
__device__ __forceinline__ int perm32(int rho) { const int n = rho >> 4, i = rho & 15; return 8 * (i >> 2) + 4 * n + (i & 3); }
struct Unit { int pm, pn; };
struct Gemm { const bf* A; const bf* Bt; int K; };
struct Order {
  int nM, nN, nwg, G, c, latonly;
  __device__ void init(int nM_, int nN_, int G_, int c_, int lat) { nM = nM_; nN = nN_; nwg = nM * nN; G = G_; c = c_; latonly = lat; }
  __device__ bool next(int i, Unit& u) const {
    const long L = (long)i * G + c;
    if (L >= nwg) return false;
    int wgid = (int)L;
    { const int q = nwg / NXCD, r = nwg % NXCD, xcd = wgid % NXCD, off = wgid / NXCD; wgid = (xcd < r ? xcd * (q + 1) : r * (q + 1) + (xcd - r) * q) + off; }
    const int nig = WGM * nN, gid = wgid / nig, fm = gid * WGM, gsz = (nM - fm) < WGM ? (nM - fm) : WGM;
    int pm = fm + ((wgid % nig) % gsz);
    u.pn = (wgid % nig) / gsz;
    u.pm = latonly ? ((pm >> 4) * 17 + 1 + (pm & 15)) : pm;
    return true;
  }
};
__device__ __forceinline__ unsigned cvt_pk_bf16(float lo, float hi) { return pack2(lo, hi); }

template <int EPI>
struct Epi {
  static constexpr bool PERM = (EPI == 0 || EPI == 1 || EPI == 3);
  P p;
  int layer;
  __device__ __forceinline__ void operator()(const f32x4 (&acc)[2][2][4][2], const Unit& u, int wr, int wc, int fr, int fq) const {
#pragma unroll
    for (int ai = 0; ai < 2; ++ai)
#pragma unroll
      for (int m = 0; m < 4; ++m) {
        const int row = u.pm * BM + ai * HALF + wr * 64 + m * 16 + fr;
        if constexpr (PERM) {
#pragma unroll
          for (int bj = 0; bj < 2; ++bj) {
            const int c0 = u.pn * BM + bj * HALF + wc * 32 + 8 * fq;
            f32x4 v0 = acc[ai][bj][m][0], v1 = acc[ai][bj][m][1];
            if constexpr (EPI == 3) {
#pragma unroll
              for (int j = 0; j < 4; ++j) { float a = v0[j] > 0.f ? v0[j] : 0.f; v0[j] = a * a; float b2 = v1[j] > 0.f ? v1[j] : 0.f; v1[j] = b2 * b2; }
            }
            u32x4 w;
            w.x = cvt_pk_bf16(v0[0], v0[1]); w.y = cvt_pk_bf16(v0[2], v0[3]); w.z = cvt_pk_bf16(v1[0], v1[1]); w.w = cvt_pk_bf16(v1[2], v1[3]);
            if constexpr (EPI == 0) {
              bf* dst = c0 < 1536 ? (bf*)(p.ws + OFF_QKV) + (size_t)row * 1536 + c0 : (bf*)p.out + (size_t)row * 1792 + (c0 - 1536);
              *(u32x4*)dst = w;
            } else if constexpr (EPI == 1) {
              if (c0 < 512) *(u32x4*)((bf*)(p.ws + OFF_P1C) + (size_t)row * 2080 + c0) = w;
              else if (c0 < 1536) *(u32x4*)((bf*)(p.ws + OFF_XRAW) + (size_t)row * 1024 + (c0 - 512)) = w;
              else if (c0 < 1552) { float* d = (float*)(p.ws + OFF_DTRAW) + (size_t)row * 16 + (c0 - 1536); *(f32x4*)d = v0; *(f32x4*)(d + 4) = v1; }
              else if (c0 < 3104) *(u32x4*)((bf*)(p.ws + OFF_P1C) + (size_t)row * 2080 + (c0 - 1024)) = w;
            } else {
              *(u32x4*)((bf*)(p.ws + OFF_HID) + (size_t)row * 4096 + c0) = w;
            }
          }
        } else {
          const float* gate = (const float*)(p.ws + OFF_MOD) + (size_t)(layer * 9 + mrow(row)) * 6144 + (EPI == 2 ? 2 : 5) * 1024;
          float* xr = xrow(p, row);
          const float* br = (EPI == 2 && layer == 0) ? inrow(p, row) : xr;
#pragma unroll
          for (int bj = 0; bj < 2; ++bj)
#pragma unroll
            for (int n = 0; n < 2; ++n) {
              const int c = u.pn * BM + bj * HALF + wc * 32 + 16 * n + 4 * fq;
              f32x4 gt = *(const f32x4*)(gate + c);
              f32x4 bs = *(const f32x4*)(br + c);
              *(f32x4*)(xr + c) = bs + gt * acc[ai][bj][m][n];
            }
        }
      }
  }
};

template <class EpiT>
__device__ __forceinline__ void gemm_phase(PG8_LAS unsigned char* lds, const Gemm g, const Order& S, const EpiT& E) {
  const int tid = tidx(), wid = __builtin_amdgcn_readfirstlane(tid >> 6), lane = tid & 63, wr = wid >> 2, wc = wid & 3, fr = lane & 15, fq = lane >> 4;
  const int K = g.K, nt = K / BK;
  unsigned voffA[2], voffB[2];
#pragma unroll
  for (int i = 0; i < 2; ++i) { int R, C; stage_rc(tid * 16 + i * 8192, R, C); const int Rb = EpiT::PERM ? ((R & ~31) + perm32(R & 31)) : R;
    voffA[i] = (unsigned)(R * K + C) * 2u; voffB[i] = (unsigned)(Rb * K + C) * 2u; }
  const size_t kstep = (size_t)(BK * 2);
  const size_t hstep = (size_t)HALF * K * 2;
  const size_t tstep = 2 * hstep;
  const unsigned ldsw = (unsigned)wid * 1024u;
  const int aoff = lds_byte(wr * 64 + fr, fq * 8), boff = lds_byte(wc * 32 + fr, fq * 8);
#define PG8_SA(b, h) (((b) * 2 + (h)) * HTB)
#define PG8_SB(b, h) ((4 + (b) * 2 + (h)) * HTB)
#define PG8_STAGE(bufoff, gbase, voff) do { _Pragma("unroll") for (int _i = 0; _i < 2; ++_i) \
        __builtin_amdgcn_global_load_lds((const unsigned*)((const char*)(gbase) + (voff)[_i]), (PG8_LAS unsigned*)(lds + (bufoff) + ldsw + _i * 8192), 16, 0, 0); } while (0)
#define PG8_LDA(dst, b, h) do { _Pragma("unroll") for (int m = 0; m < 4; ++m) _Pragma("unroll") for (int k = 0; k < 2; ++k) dst[m][k] = *(const PG8_LAS bf16x8*)(lds + PG8_SA(b, h) + aoff + m * 2048 + k * 1024); } while (0)
#define PG8_LDB(dst, b, h) do { _Pragma("unroll") for (int n = 0; n < 2; ++n) _Pragma("unroll") for (int k = 0; k < 2; ++k) dst[n][k] = *(const PG8_LAS bf16x8*)(lds + PG8_SB(b, h) + boff + n * 2048 + k * 1024); } while (0)
#define PG8_MMA(ai, bj, At, Bt) do { __builtin_amdgcn_s_setprio(1); _Pragma("unroll") for (int m = 0; m < 4; ++m) _Pragma("unroll") for (int n = 0; n < 2; ++n) _Pragma("unroll") for (int k = 0; k < 2; ++k) \
        acc[ai][bj][m][n] = __builtin_amdgcn_mfma_f32_16x16x32_bf16(Bt[n][k], At[m][k], acc[ai][bj][m][n], 0, 0, 0); __builtin_amdgcn_s_setprio(0); } while (0)
#define PG8_WAIT_V(n) asm volatile("s_waitcnt vmcnt(" #n ")" ::: "memory")
#define PG8_WAIT_L(n) asm volatile("s_waitcnt lgkmcnt(" #n ")" ::: "memory")
#define PG8_BAR __builtin_amdgcn_s_barrier()
#define PG8_SCHED __builtin_amdgcn_sched_barrier(0)
  Unit cur, nxt; int ui = 0;
  if (!S.next(0, cur)) return;
  f32x4 acc[2][2][4][2];
#pragma unroll
  for (int a = 0; a < 2; ++a)
#pragma unroll
    for (int b = 0; b < 2; ++b)
#pragma unroll
      for (int m = 0; m < 4; ++m)
#pragma unroll
        for (int n = 0; n < 2; ++n) acc[a][b][m][n] = (f32x4){0.f, 0.f, 0.f, 0.f};
  bf16x8 At[4][2], B0[2][2], B1[2][2];
  const char* cA = (const char*)g.A + (size_t)cur.pm * tstep; const char* cB = (const char*)g.Bt + (size_t)cur.pn * tstep;
  PG8_STAGE(PG8_SB(0, 0), cB, voffB); PG8_STAGE(PG8_SA(0, 0), cA, voffA); PG8_STAGE(PG8_SB(0, 1), cB + hstep, voffB); PG8_STAGE(PG8_SA(0, 1), cA + hstep, voffA);
  if (wr == 1) PG8_BAR;
  PG8_WAIT_V(4); PG8_BAR;
  PG8_STAGE(PG8_SB(1, 0), cB + kstep, voffB); PG8_STAGE(PG8_SA(1, 0), cA + kstep, voffA); PG8_STAGE(PG8_SB(1, 1), cB + hstep + kstep, voffB);
  PG8_WAIT_V(6); PG8_BAR;
  for (;;) {
    const bool has_next = S.next(ui + 1, nxt);
    const char* nA = has_next ? (const char*)g.A + (size_t)nxt.pm * tstep : cA; const char* nB = has_next ? (const char*)g.Bt + (size_t)nxt.pn * tstep : cB;
    for (int t = 0; t < nt; t += 2) {
      const bool last = (t == nt - 2);
      const char* a1 = cA + (size_t)(t + 1) * kstep;
      const char* a2 = last ? nA : cA + (size_t)(t + 2) * kstep; const char* b2 = last ? nB : cB + (size_t)(t + 2) * kstep;
      const char* a3 = a2 + kstep; const char* b3 = b2 + kstep;
      PG8_LDB(B0, 0, 0); PG8_SCHED; PG8_LDA(At, 0, 0); PG8_STAGE(PG8_SA(1, 1), a1 + hstep, voffA);
      PG8_WAIT_L(8); PG8_BAR; PG8_WAIT_L(0); PG8_MMA(0, 0, At, B0); PG8_BAR; PG8_SCHED;
      PG8_LDB(B1, 0, 1); PG8_STAGE(PG8_SB(0, 0), b2, voffB);
      PG8_BAR; PG8_WAIT_L(0); PG8_MMA(0, 1, At, B1); PG8_BAR;
      PG8_LDA(At, 0, 1); PG8_STAGE(PG8_SA(0, 0), a2, voffA);
      PG8_BAR; PG8_WAIT_L(0); PG8_MMA(1, 0, At, B0); PG8_BAR; PG8_SCHED;
      PG8_STAGE(PG8_SB(0, 1), b2 + hstep, voffB);
      PG8_WAIT_V(6); PG8_BAR; PG8_MMA(1, 1, At, B1); PG8_BAR;
      PG8_LDB(B0, 1, 0); PG8_SCHED; PG8_LDA(At, 1, 0); PG8_STAGE(PG8_SA(0, 1), a2 + hstep, voffA);
      PG8_WAIT_L(8); PG8_BAR; PG8_WAIT_L(0); PG8_MMA(0, 0, At, B0); PG8_BAR; PG8_SCHED;
      PG8_LDB(B1, 1, 1); PG8_STAGE(PG8_SB(1, 0), b3, voffB);
      PG8_BAR; PG8_WAIT_L(0); PG8_MMA(0, 1, At, B1); PG8_BAR;
      PG8_LDA(At, 1, 1); PG8_STAGE(PG8_SA(1, 0), a3, voffA);
      PG8_BAR; PG8_WAIT_L(0); PG8_MMA(1, 0, At, B0); PG8_BAR; PG8_SCHED;
      PG8_STAGE(PG8_SB(1, 1), b3 + hstep, voffB);
      PG8_WAIT_V(6); PG8_BAR; PG8_MMA(1, 1, At, B1); PG8_BAR;
    }
    E(acc, cur, wr, wc, fr, fq);
    if (!has_next) break;
#pragma unroll
    for (int a = 0; a < 2; ++a)
#pragma unroll
      for (int b = 0; b < 2; ++b)
#pragma unroll
        for (int m = 0; m < 4; ++m)
#pragma unroll
          for (int n = 0; n < 2; ++n) acc[a][b][m][n] = (f32x4){0.f, 0.f, 0.f, 0.f};
    cur = nxt; cA = nA; cB = nB; ++ui;
  }
  PG8_WAIT_V(0);
  if (wr == 0) PG8_BAR;
  PG8_BAR;
#undef PG8_SA
#undef PG8_SB
#undef PG8_STAGE
#undef PG8_LDA
#undef PG8_LDB
#undef PG8_MMA
#undef PG8_WAIT_V
#undef PG8_WAIT_L
#undef PG8_BAR
#undef PG8_SCHED
}
}

template <int EPI>
__device__ __forceinline__ void ph_gemm(const P& p, const bf* A, const bf* Bt, int K, int nN, int layer, int latonly, char* smem) {
  pg8::Order S;
  S.init(latonly ? 128 : 136, nN, gridDim.x, blockIdx.x, latonly);
  pg8::Epi<EPI> E{p, layer};
  pg8::Gemm g{A, Bt, K};
  __syncthreads();
  pg8::gemm_phase(( __attribute__((address_space(3))) unsigned char*)smem, g, S, E);
  __syncthreads();
}

__device__ __forceinline__ void ph_rope(const P& p, char* smem) {
  float* tcos = (float*)smem;
  float* tsin = tcos + 1024;
  const int tid = tidx();
  __syncthreads();
  for (int i = tid; i < 1024; i += NT) {
    int c = i >> 4, f = i & 15;
    float inv = powf(10000.f, -(float)f / 16.f);
    float ang = (float)c * inv;
    float sn, cs;
    sincosf(ang, &sn, &cs);
    tcos[i] = cs;
    tsin[i] = sn;
  }
  __syncthreads();
  bf* QKV = (bf*)(p.ws + OFF_QKV);
  for (int it = blockIdx.x * NT + tid; it < RT * 32; it += gridDim.x * NT) {
    int R = it >> 5;
    int vec = (it >> 1) & 15, half = it & 1;
    int b = R / TA, a = R - b * TA;
    bool isq = vec < 8;
    if (!isq && a < CTX) continue;
    bf* ptr = QKV + (size_t)R * 1536 + vec * 64 + half * 32;
    uint4 a0 = *(const uint4*)ptr, a1 = *(const uint4*)(ptr + 8), b0 = *(const uint4*)(ptr + 16), b1 = *(const uint4*)(ptr + 24);
    float x1[16], x2[16];
    x1[0] = bflo(a0.x); x1[1] = bfhi(a0.x); x1[2] = bflo(a0.y); x1[3] = bfhi(a0.y); x1[4] = bflo(a0.z); x1[5] = bfhi(a0.z); x1[6] = bflo(a0.w); x1[7] = bfhi(a0.w);
    x1[8] = bflo(a1.x); x1[9] = bfhi(a1.x); x1[10] = bflo(a1.y); x1[11] = bfhi(a1.y); x1[12] = bflo(a1.z); x1[13] = bfhi(a1.z); x1[14] = bflo(a1.w); x1[15] = bfhi(a1.w);
    x2[0] = bflo(b0.x); x2[1] = bfhi(b0.x); x2[2] = bflo(b0.y); x2[3] = bfhi(b0.y); x2[4] = bflo(b0.z); x2[5] = bfhi(b0.z); x2[6] = bflo(b0.w); x2[7] = bfhi(b0.w);
    x2[8] = bflo(b1.x); x2[9] = bfhi(b1.x); x2[10] = bflo(b1.y); x2[11] = bfhi(b1.y); x2[12] = bflo(b1.z); x2[13] = bfhi(b1.z); x2[14] = bflo(b1.w); x2[15] = bfhi(b1.w);
    const float qs = isq ? 0.125f : 1.f;
    if (a >= CTX) {
      int pos = a - CTX;
      int cidx = half == 0 ? (pos >> 6) : (pos & 63);
#pragma unroll
      for (int f = 0; f < 16; ++f) {
        float cs = tcos[cidx * 16 + f], sn = tsin[cidx * 16 + f];
        float y1 = x1[f] * cs - x2[f] * sn, y2 = x2[f] * cs + x1[f] * sn;
        x1[f] = y1 * qs;
        x2[f] = y2 * qs;
      }
    } else {
#pragma unroll
      for (int f = 0; f < 16; ++f) { x1[f] *= qs; x2[f] *= qs; }
    }
    uint4 o;
    o.x = pack2(x1[0], x1[1]); o.y = pack2(x1[2], x1[3]); o.z = pack2(x1[4], x1[5]); o.w = pack2(x1[6], x1[7]); *(uint4*)ptr = o;
    o.x = pack2(x1[8], x1[9]); o.y = pack2(x1[10], x1[11]); o.z = pack2(x1[12], x1[13]); o.w = pack2(x1[14], x1[15]); *(uint4*)(ptr + 8) = o;
    o.x = pack2(x2[0], x2[1]); o.y = pack2(x2[2], x2[3]); o.z = pack2(x2[4], x2[5]); o.w = pack2(x2[6], x2[7]); *(uint4*)(ptr + 16) = o;
    o.x = pack2(x2[8], x2[9]); o.y = pack2(x2[10], x2[11]); o.z = pack2(x2[12], x2[13]); o.w = pack2(x2[14], x2[15]); *(uint4*)(ptr + 24) = o;
  }
}

__device__ __forceinline__ float shiftmix(const bf* PB, const float* mu, int R, int a, int col) {
  int lo = a < CTX ? 0 : CTX, hi = a < CTX ? CTX : TA;
  float t = bf2f(PB[(size_t)R * 1792 + col]);
  float pv = a > lo ? bf2f(PB[(size_t)(R - 1) * 1792 + col]) : 0.f;
  float nx = a + 1 < hi ? bf2f(PB[(size_t)(R + 1) * 1792 + col]) : 0.f;
  return t + (0.5f * (pv + nx) - t) * mu[col];
}
__device__ __forceinline__ void ph_lw(const P& p) {
  bf* LW = (bf*)(p.ws + OFF_LW);
  const float *w2f = p.in[19], *w2b = p.in[21], *a2 = p.in[23], *g2 = p.in[24];
  for (int i = blockIdx.x * NT + tidx(); i < 512 * 320; i += gridDim.x * NT) {
    int n = i / 320, kk = i - n * 320;
    float v = kk < 64 ? w2f[kk * 512 + n] : kk < 128 ? w2b[(kk - 64) * 512 + n] : kk < 192 ? a2[(kk - 128) * 512 + n] : g2[(kk - 192) * 512 + n];
    LW[i] = f2bf(v);
  }
}
__device__ __forceinline__ void ph_rwkv_prep(const P& p, char* smem) {
  bf* linA = (bf*)smem;
  const int tid = tidx(), lane = tid & 63, wave = tid >> 6;
  const int l15 = lane & 15, g = lane >> 4;
  const bf* PB = (const bf*)p.out;
  const bf* LW = (const bf*)(p.ws + OFF_LW);
  const float* mu = p.in[17];
  bf* PR = (bf*)(p.ws + OFF_PREP);
  bf* PK = PR + (size_t)RT * 512;
  bf* PV = PK + (size_t)RT * 512;
  bf* PKK = PV + (size_t)RT * 512;
  bf* PKA = PKK + (size_t)RT * 512;
  bf* PLF = PKA + (size_t)RT * 512;
  bf* PLB = PLF + (size_t)RT * 512;
  bf* G = (bf*)(p.ws + OFF_G);
  float* BON = (float*)(p.ws + OFF_BONUS);
  float cw0f[4], cw0b[4], ca0[4], ckk[4], cka[4], crk[4];
#pragma unroll
  for (int nt = 0; nt < 4; ++nt) {
    int c = wave * 64 + nt * 16 + l15;
    cw0f[nt] = p.in[18][c]; cw0b[nt] = p.in[20][c]; ca0[nt] = p.in[22][c]; ckk[nt] = p.in[25][c]; cka[nt] = p.in[26][c]; crk[nt] = p.in[27][c];
  }
  for (int unit = blockIdx.x; unit < RT / 16; unit += gridDim.x) {
    const int R0 = unit * 16;
    const int b = R0 / TA, a00 = R0 - b * TA;
    __syncthreads();
#pragma unroll
    for (int i = 0; i < 8; ++i) {
      int idx = tid + NT * i;
      int tok = idx >> 8, j = idx & 255;
      float f = shiftmix(PB, mu, R0 + tok, a00 + tok, 1536 + j);
      float val = j < 64 ? tanhf(f) : (j < 128 ? f : sigmoidf_(f));
      linA[tok * 264 + j] = f2bf(val);
    }
    __syncthreads();
    f32x4 wf[4], wb[4], aa[4], gg[4];
#pragma unroll
    for (int nt = 0; nt < 4; ++nt) {
      wf[nt] = (f32x4){0.f, 0.f, 0.f, 0.f}; wb[nt] = wf[nt]; aa[nt] = wf[nt]; gg[nt] = wf[nt];
    }
#pragma unroll
    for (int nt = 0; nt < 4; ++nt) {
      const bf* lw = LW + (size_t)(wave * 64 + nt * 16 + l15) * 320 + g * 8;
#pragma unroll
      for (int ks = 0; ks < 2; ++ks) {
        bf16x8 aw = *(const bf16x8*)(linA + l15 * 264 + ks * 32 + g * 8);
        wf[nt] = __builtin_amdgcn_mfma_f32_16x16x32_bf16(aw, *(const bf16x8*)(lw + ks * 32), wf[nt], 0, 0, 0);
        wb[nt] = __builtin_amdgcn_mfma_f32_16x16x32_bf16(aw, *(const bf16x8*)(lw + 64 + ks * 32), wb[nt], 0, 0, 0);
        bf16x8 a_a = *(const bf16x8*)(linA + l15 * 264 + 64 + ks * 32 + g * 8);
        aa[nt] = __builtin_amdgcn_mfma_f32_16x16x32_bf16(a_a, *(const bf16x8*)(lw + 128 + ks * 32), aa[nt], 0, 0, 0);
      }
#pragma unroll
      for (int ks = 0; ks < 4; ++ks) {
        bf16x8 ag = *(const bf16x8*)(linA + l15 * 264 + 128 + ks * 32 + g * 8);
        gg[nt] = __builtin_amdgcn_mfma_f32_16x16x32_bf16(ag, *(const bf16x8*)(lw + 192 + ks * 32), gg[nt], 0, 0, 0);
      }
    }
#pragma unroll
    for (int r = 0; r < 4; ++r) {
      const int R = R0 + g * 4 + r, a = a00 + g * 4 + r;
      float fr[4], fv[4], kkv[4], km[4], av[4];
      float n2 = 0.f, bon = 0.f;
#pragma unroll
      for (int nt = 0; nt < 4; ++nt) {
        int c = wave * 64 + nt * 16 + l15;
        fr[nt] = shiftmix(PB, mu, R, a, c);
        float fk = shiftmix(PB, mu, R, a, 512 + c);
        fv[nt] = shiftmix(PB, mu, R, a, 1024 + c);
        av[nt] = sigmoidf_(ca0[nt] + aa[nt][r]);
        kkv[nt] = fk * ckk[nt];
        n2 += kkv[nt] * kkv[nt];
        km[nt] = fk * (1.f + (av[nt] - 1.f) * cka[nt]);
        bon += fr[nt] * km[nt] * crk[nt];
      }
      n2 = red16(n2);
      bon = red16(bon);
      float rn = 1.f / fmaxf(sqrtf(n2), 1e-12f);
#pragma unroll
      for (int nt = 0; nt < 4; ++nt) {
        int c = wave * 64 + nt * 16 + l15;
        size_t o = (size_t)R * 512 + c;
        float lwf = -__expf(-softplusf_(-(cw0f[nt] + wf[nt][r])) - 0.5f);
        float lwb = -__expf(-softplusf_(-(cw0b[nt] + wb[nt][r])) - 0.5f);
        float kk = kkv[nt] * rn;
        PR[o] = f2bf(fr[nt]);
        PK[o] = f2bf(km[nt]);
        PV[o] = f2bf(fv[nt]);
        PKK[o] = f2bf(kk);
        PKA[o] = f2bf(kk * av[nt]);
        PLF[o] = f2bf(lwf);
        PLB[o] = f2bf(lwb);
        G[o] = f2bf(gg[nt][r]);
      }
      if (l15 == 0) BON[(size_t)R * 8 + wave] = bon;
    }
  }
}

__device__ __forceinline__ int scan_row(int b, int dir, int s) {
  int a = dir ? (s < CTX ? CTX - 1 - s : TA + CTX - 1 - s) : s;
  return b * TA + a;
}

__device__ __forceinline__ void rwkv_chain(const P& p, int chain, int half, char* smem) {
  const int dir = chain & 1, h = (chain >> 1) & 7, b = chain >> 4;
  float* cR = (float*)smem;
  float* cW = cR + 2048;
  float* cK = cW + 2048;
  float* cKK = cK + 2048;
  float* cKA = cKK + 2048;
  float* cV = cKA + 2048;
  float* yb = cV + 2048;
  const int tid = tidx(), lane = tid & 63, wave = tid >> 6;
  const int l15 = lane & 15, lg = lane >> 4;
  const bf* PR = (const bf*)(p.ws + OFF_PREP);
  const bf* PK = PR + (size_t)RT * 512;
  const bf* PV = PK + (size_t)RT * 512;
  const bf* PKK = PV + (size_t)RT * 512;
  const bf* PKA = PKK + (size_t)RT * 512;
  const bf* PLW = PKA + (size_t)RT * 512 + (size_t)dir * RT * 512;
  bf* Y = (bf*)p.out + (size_t)dir * RT * 512;
  const int st = tid >> 4, c4 = (tid & 15) * 4;
  const int r0 = half < 0 ? wave * 8 + lg * 2 : half * 32 + (wave & 3) * 8 + lg * 2;
  const bool active = half < 0 || wave < 4;
  const bool ywr = half < 0 || ((c4 >> 5) == half);
  float s0[4], s1[4];
#pragma unroll
  for (int j = 0; j < 4; ++j) { s0[j] = 0.f; s1[j] = 0.f; }
  uint2 gR, gW, gK, gV, gKK, gKA;
  {
    size_t o = (size_t)scan_row(b, dir, st) * 512 + h * 64 + c4;
    gR = *(const uint2*)(PR + o); gW = *(const uint2*)(PLW + o); gK = *(const uint2*)(PK + o);
    gV = *(const uint2*)(PV + o); gKK = *(const uint2*)(PKK + o); gKA = *(const uint2*)(PKA + o);
  }
  const int NCH = TA / 32;
  for (int ch = 0; ch <= NCH; ++ch) {
    __syncthreads();
    if (ch > 0 && ywr) {
      float4 y4 = *(const float4*)(yb + st * 64 + c4);
      uint2 o2;
      o2.x = pack2(y4.x, y4.y);
      o2.y = pack2(y4.z, y4.w);
      *(uint2*)(Y + (size_t)scan_row(b, dir, (ch - 1) * 32 + st) * 512 + h * 64 + c4) = o2;
    }
    if (ch == NCH) break;
    {
      int o = st * 64 + c4;
      *(float4*)(cR + o) = make_float4(bflo(gR.x), bfhi(gR.x), bflo(gR.y), bfhi(gR.y));
      *(float4*)(cW + o) = make_float4(__expf(bflo(gW.x)), __expf(bfhi(gW.x)), __expf(bflo(gW.y)), __expf(bfhi(gW.y)));
      *(float4*)(cK + o) = make_float4(bflo(gK.x), bfhi(gK.x), bflo(gK.y), bfhi(gK.y));
      *(float4*)(cV + o) = make_float4(bflo(gV.x), bfhi(gV.x), bflo(gV.y), bfhi(gV.y));
      *(float4*)(cKK + o) = make_float4(bflo(gKK.x), bfhi(gKK.x), bflo(gKK.y), bfhi(gKK.y));
      *(float4*)(cKA + o) = make_float4(bflo(gKA.x), bfhi(gKA.x), bflo(gKA.y), bfhi(gKA.y));
    }
    __syncthreads();
    if (ch + 1 < NCH) {
      size_t o = (size_t)scan_row(b, dir, (ch + 1) * 32 + st) * 512 + h * 64 + c4;
      gR = *(const uint2*)(PR + o); gW = *(const uint2*)(PLW + o); gK = *(const uint2*)(PK + o);
      gV = *(const uint2*)(PV + o); gKK = *(const uint2*)(PKK + o); gKA = *(const uint2*)(PKA + o);
    }
    if (active) {
      float4 kk4 = *(const float4*)(cKK + l15 * 4);
      float4 w4 = *(const float4*)(cW + l15 * 4);
      float4 k4 = *(const float4*)(cK + l15 * 4);
      float4 ka4 = *(const float4*)(cKA + l15 * 4);
      float4 r4 = *(const float4*)(cR + l15 * 4);
      float2 v2 = *(const float2*)(cV + r0);
#pragma unroll 2
      for (int t = 0; t < 32; ++t) {
        const int tn = (t + 1) & 31;
        float4 nkk4 = *(const float4*)(cKK + tn * 64 + l15 * 4);
        float4 nw4 = *(const float4*)(cW + tn * 64 + l15 * 4);
        float4 nk4 = *(const float4*)(cK + tn * 64 + l15 * 4);
        float4 nka4 = *(const float4*)(cKA + tn * 64 + l15 * 4);
        float4 nr4 = *(const float4*)(cR + tn * 64 + l15 * 4);
        float2 nv2 = *(const float2*)(cV + tn * 64 + r0);
        float sa0 = (s0[0] * kk4.x + s0[1] * kk4.y) + (s0[2] * kk4.z + s0[3] * kk4.w);
        float sa1 = (s1[0] * kk4.x + s1[1] * kk4.y) + (s1[2] * kk4.z + s1[3] * kk4.w);
        float p00 = s0[0] * w4.x + v2.x * k4.x, p01 = s0[1] * w4.y + v2.x * k4.y, p02 = s0[2] * w4.z + v2.x * k4.z, p03 = s0[3] * w4.w + v2.x * k4.w;
        float p10 = s1[0] * w4.x + v2.y * k4.x, p11 = s1[1] * w4.y + v2.y * k4.y, p12 = s1[2] * w4.z + v2.y * k4.z, p13 = s1[3] * w4.w + v2.y * k4.w;
        sa0 = red16(sa0);
        sa1 = red16(sa1);
        s0[0] = p00 - sa0 * ka4.x; s0[1] = p01 - sa0 * ka4.y; s0[2] = p02 - sa0 * ka4.z; s0[3] = p03 - sa0 * ka4.w;
        s1[0] = p10 - sa1 * ka4.x; s1[1] = p11 - sa1 * ka4.y; s1[2] = p12 - sa1 * ka4.z; s1[3] = p13 - sa1 * ka4.w;
        float y0 = (s0[0] * r4.x + s0[1] * r4.y) + (s0[2] * r4.z + s0[3] * r4.w);
        float y1 = (s1[0] * r4.x + s1[1] * r4.y) + (s1[2] * r4.z + s1[3] * r4.w);
        y0 = red16(y0);
        y1 = red16(y1);
        if (l15 == 0) *(float2*)(yb + t * 64 + r0) = make_float2(y0, y1);
        kk4 = nkk4; w4 = nw4; k4 = nk4; ka4 = nka4; r4 = nr4; v2 = nv2;
      }
    }
  }
}


template <int OFFB>
__device__ __forceinline__ bf16x8 tr_pair(const bf* pp) {
  typedef short s16x4_ __attribute__((ext_vector_type(4)));
  s16x4_ v0, v1;
  unsigned addr = (unsigned)(size_t)(__attribute__((address_space(3))) const void*)pp;
  asm volatile("s_waitcnt lgkmcnt(0)\n\tds_read_b64_tr_b16 %0, %2\n\tds_read_b64_tr_b16 %1, %2 offset:%3\n\ts_waitcnt lgkmcnt(0)" : "=&v"(v0), "=&v"(v1) : "v"(addr), "n"(OFFB) : "memory");
  return __builtin_shufflevector(v0, v1, 0, 1, 2, 3, 4, 5, 6, 7);
}
typedef short s16x4 __attribute__((ext_vector_type(4)));
__device__ __forceinline__ void attn_unit(const P& p, int u, char* smem, float lam) {
  bf* Ks = (bf*)smem;
  bf* Vs = Ks + 64 * 136;
  int b, h, nkeys, qa0;
  if (u < 1024) { b = u >> 7; h = (u >> 5) & 3; nkeys = TA; qa0 = CTX + (u & 31) * 128; }
  else { int v = u - 1024; b = v >> 3; h = (v >> 1) & 3; nkeys = CTX; qa0 = (v & 1) * 128; }
  const bf* QKV = (const bf*)(p.ws + OFF_QKV);
  const int tid = tidx(), lane = tid & 63, wave = tid >> 6;
  const int l15 = lane & 15, lg = lane >> 4;
  const size_t rowbase = (size_t)b * TA;
  bf16x8 qf[2][2];
  {
    size_t Rq = rowbase + qa0 + wave * 16 + l15;
#pragma unroll
    for (int m = 0; m < 2; ++m)
#pragma unroll
      for (int ks = 0; ks < 2; ++ks) qf[m][ks] = *(const bf16x8*)(QKV + Rq * 1536 + h * 128 + m * 64 + ks * 32 + lg * 8);
  }
  f32x4 oacc[2][8];
#pragma unroll
  for (int m = 0; m < 2; ++m)
#pragma unroll
    for (int n = 0; n < 8; ++n) oacc[m][n] = (f32x4){0.f, 0.f, 0.f, 0.f};
  float mrun[2] = {-INFINITY, -INFINITY}, lrun[2] = {0.f, 0.f};
  const int sr = tid >> 4, scc = tid & 15;
  const bf* gsrc = QKV + (rowbase + sr) * 1536 + h * 128 + scc * 8;
  uint4 pk0 = *(const uint4*)(gsrc + 512), pv0 = *(const uint4*)(gsrc + 1024);
  uint4 pk1 = *(const uint4*)(gsrc + (size_t)32 * 1536 + 512), pv1 = *(const uint4*)(gsrc + (size_t)32 * 1536 + 1024);
  const int vrow = lg * 4 + (l15 >> 2), vcol = (lane & 3) * 4;
  for (int k0 = 0; k0 < nkeys; k0 += 64) {
    __syncthreads();
    *(uint4*)(Ks + sr * 136 + scc * 8) = pk0;
    *(uint4*)(Ks + (sr + 32) * 136 + scc * 8) = pk1;
    *(uint4*)(Vs + sr * 144 + scc * 8) = pv0;
    *(uint4*)(Vs + (sr + 32) * 144 + scc * 8) = pv1;
    __syncthreads();
    if (k0 + 64 < nkeys) {
      const bf* g2 = gsrc + (size_t)(k0 + 64) * 1536;
      pk0 = *(const uint4*)(g2 + 512); pv0 = *(const uint4*)(g2 + 1024);
      pk1 = *(const uint4*)(g2 + (size_t)32 * 1536 + 512); pv1 = *(const uint4*)(g2 + (size_t)32 * 1536 + 1024);
    }
    bf16x8 pf[2][2];
#pragma unroll
    for (int m = 0; m < 2; ++m) {
      f32x4 s[4];
#pragma unroll
      for (int kt = 0; kt < 4; ++kt) s[kt] = (f32x4){0.f, 0.f, 0.f, 0.f};
#pragma unroll
      for (int ks = 0; ks < 2; ++ks)
#pragma unroll
        for (int kt = 0; kt < 4; ++kt) {
          bf16x8 a = *(const bf16x8*)(Ks + (kt * 16 + l15) * 136 + m * 64 + ks * 32 + lg * 8);
          s[kt] = __builtin_amdgcn_mfma_f32_16x16x32_bf16(a, qf[m][ks], s[kt], 0, 0, 0);
        }
      float mx = fmaxf(fmaxf(s[0][0], s[0][1]), fmaxf(s[0][2], s[0][3]));
#pragma unroll
      for (int kt = 1; kt < 4; ++kt) mx = fmaxf(mx, fmaxf(fmaxf(s[kt][0], s[kt][1]), fmaxf(s[kt][2], s[kt][3])));
      if (__any(mx > mrun[m] + 8.f)) {
        mx = fmaxf(mx, __shfl_xor(mx, 16));
        mx = fmaxf(mx, __shfl_xor(mx, 32));
        float mnew = fmaxf(mrun[m], mx);
        float alpha = __expf(mrun[m] - mnew);
        mrun[m] = mnew;
        lrun[m] *= alpha;
        float al[4];
#pragma unroll
        for (int r = 0; r < 4; ++r) al[r] = __shfl(alpha, lg * 4 + r);
#pragma unroll
        for (int n = 0; n < 8; ++n)
#pragma unroll
          for (int r = 0; r < 4; ++r) oacc[m][n][r] *= al[r];
      }
      const float mcur = mrun[m];
      float ps = 0.f;
#pragma unroll
      for (int kt = 0; kt < 4; ++kt)
#pragma unroll
        for (int r = 0; r < 4; ++r) {
          float e = __expf(s[kt][r] - mcur);
          s[kt][r] = e;
          ps += e;
        }
      lrun[m] += ps;
#pragma unroll
      for (int si = 0; si < 2; ++si) {
        i32x4 t;
        t[0] = (int)pack2(s[2 * si][0], s[2 * si][1]);
        t[1] = (int)pack2(s[2 * si][2], s[2 * si][3]);
        t[2] = (int)pack2(s[2 * si + 1][0], s[2 * si + 1][1]);
        t[3] = (int)pack2(s[2 * si + 1][2], s[2 * si + 1][3]);
        pf[m][si] = __builtin_bit_cast(bf16x8, t);
      }
    }
#pragma unroll
    for (int si = 0; si < 2; ++si)
#pragma unroll
      for (int n = 0; n < 8; ++n) {
        const bf* vp = Vs + (si * 32 + vrow) * 144 + n * 16 + vcol;
        bf16x8 bv = tr_pair<16 * 144 * 2>(vp);
        oacc[0][n] = __builtin_amdgcn_mfma_f32_16x16x32_bf16(pf[0][si], bv, oacc[0][n], 0, 0, 0);
        oacc[1][n] = __builtin_amdgcn_mfma_f32_16x16x32_bf16(pf[1][si], bv, oacc[1][n], 0, 0, 0);
      }
  }
  float inv[2];
#pragma unroll
  for (int m = 0; m < 2; ++m) {
    float l = lrun[m];
    l += __shfl_xor(l, 16);
    l += __shfl_xor(l, 32);
    inv[m] = 1.f / l;
  }
  float i1[4], i2[4];
#pragma unroll
  for (int r = 0; r < 4; ++r) { i1[r] = __shfl(inv[0], lg * 4 + r); i2[r] = __shfl(inv[1], lg * 4 + r); }
  float ss[4] = {0.f, 0.f, 0.f, 0.f};
#pragma unroll
  for (int n = 0; n < 8; ++n)
#pragma unroll
    for (int r = 0; r < 4; ++r) {
      float o = oacc[0][n][r] * i1[r] - lam * (oacc[1][n][r] * i2[r]);
      oacc[0][n][r] = o;
      ss[r] += o * o;
    }
  const float* subln = p.in[16];
  bf* O = (bf*)(p.ws + OFF_HO);
#pragma unroll
  for (int r = 0; r < 4; ++r) {
    float t = red16(ss[r]);
    float scl = rsqrtf(t * (1.f / 128.f) + 1e-5f) * 0.8f;
    size_t Ro = rowbase + qa0 + wave * 16 + lg * 4 + r;
#pragma unroll
    for (int n = 0; n < 8; ++n) O[Ro * 1024 + h * 128 + n * 16 + l15] = f2bf(oacc[0][n][r] * scl * subln[n * 16 + l15]);
  }
}

__device__ __forceinline__ void ph_mix0(const P& p, char* smem) {
  volatile int* s_unitp = (volatile int*)(smem + 131072);
  for (int u = blockIdx.x; u < 128; u += gridDim.x) rwkv_chain(p, u, -1, smem);
#ifdef PROBE_RWKV
  __syncthreads();
  for (int u = blockIdx.x; u < 256; u += gridDim.x) rwkv_chain(p, u & 127, u >> 7, smem);
#endif
  float d1 = 0.f, d2 = 0.f;
  for (int i = 0; i < 64; ++i) { d1 += p.in[12][i] * p.in[13][i]; d2 += p.in[14][i] * p.in[15][i]; }
  float lam = expf(d1) - expf(d2) + 0.2f;
  int* cnt = (int*)(p.ws + OFF_CNT);
  while (true) {
    __syncthreads();
    if (tidx() == 0) *s_unitp = atomicAdd(cnt, 1);
    __syncthreads();
    int u = *s_unitp;
    if (u >= 1088) break;
    attn_unit(p, u, smem, lam);
  }
#ifdef PROBE_ATTN
  while (true) {
    __syncthreads();
    if (tidx() == 0) *s_unitp = atomicAdd(cnt + 1, 1);
    __syncthreads();
    int u = *s_unitp;
    if (u >= 1088) break;
    attn_unit(p, u, smem, lam);
  }
#endif
}

__device__ __forceinline__ void ph_rwkv_post(const P& p) {
  const int tid = tidx(), wave = tid >> 6;
  const bf* YF = (const bf*)p.out;
  const bf* YB = YF + (size_t)RT * 512;
  const bf* PV = (const bf*)(p.ws + OFF_PREP) + (size_t)2 * RT * 512;
  const bf* G = (const bf*)(p.ws + OFF_G);
  const float* BON = (const float*)(p.ws + OFF_BONUS);
  bf* O = (bf*)(p.ws + OFF_HO);
  const float lw = p.in[28][tid], lb = p.in[29][tid];
  for (int R0 = blockIdx.x * 4; R0 < RT; R0 += gridDim.x * 4) {
    float yf[4], yb4[4], pv[4], gg[4], bn[4];
#pragma unroll
    for (int i = 0; i < 4; ++i) {
      size_t o = (size_t)(R0 + i) * 512 + tid;
      yf[i] = bf2f(YF[o]); yb4[i] = bf2f(YB[o]); pv[i] = bf2f(PV[o]); gg[i] = bf2f(G[o]); bn[i] = BON[(size_t)(R0 + i) * 8 + wave];
    }
#pragma unroll
    for (int i = 0; i < 4; ++i) {
      float y = yf[i] + yb4[i];
      float mean = wave_sum(y) * (1.f / 64.f);
      float d = y - mean;
      float var = wave_sum(d * d) * (1.f / 64.f);
      float yn = d * rsqrtf(var + 64e-5f) * lw + lb;
      float outv = (yn + bn[i] * pv[i]) * gg[i];
      O[(size_t)(R0 + i) * 1024 + 512 + tid] = f2bf(outv);
    }
  }
}

__device__ __forceinline__ void ph_conv(const P& p) {
  const bf* XR = (const bf*)(p.ws + OFF_XRAW);
  bf* XO = (bf*)(p.ws + OFF_XBC);
  const float* cw = p.in[38];
  const float* cb = p.in[39];
  for (size_t it = (size_t)blockIdx.x * NT + tidx(); it < (size_t)RT * 128; it += (size_t)gridDim.x * NT) {
    int R = (int)(it >> 7), c8 = (int)(it & 127) * 8;
    int b = R / TA, a = R - b * TA;
    int lo = a < CTX ? 0 : CTX, hi = a < CTX ? CTX : TA;
    float acc[8];
#pragma unroll
    for (int e = 0; e < 8; ++e) acc[e] = cb[c8 + e];
#pragma unroll
    for (int j = 0; j < 5; ++j) {
      int aj = a + j - 2;
      if (aj >= lo && aj < hi) {
        uint4 v = *(const uint4*)(XR + (size_t)(R + j - 2) * 1024 + c8);
        const float* w = cw + j * 1024 + c8;
        acc[0] += w[0] * bflo(v.x); acc[1] += w[1] * bfhi(v.x);
        acc[2] += w[2] * bflo(v.y); acc[3] += w[3] * bfhi(v.y);
        acc[4] += w[4] * bflo(v.z); acc[5] += w[5] * bfhi(v.z);
        acc[6] += w[6] * bflo(v.w); acc[7] += w[7] * bfhi(v.w);
      }
    }
    uint4 o;
    o.x = pack2(siluf_(acc[0]), siluf_(acc[1]));
    o.y = pack2(siluf_(acc[2]), siluf_(acc[3]));
    o.z = pack2(siluf_(acc[4]), siluf_(acc[5]));
    o.w = pack2(siluf_(acc[6]), siluf_(acc[7]));
    *(uint4*)(XO + (size_t)R * 1024 + c8) = o;
  }
}

__device__ __forceinline__ void ssd_chain(const P& p, int chain, char* smem) {
  const int dir = chain & 1, hh = (chain >> 1) & 7, b = chain >> 4;
  const int grp = hh >> 2;
  float* cB = (float*)smem;
  float* cC = cB + 4096;
  float* cX = cC + 4096;
  float* cDA = cX + 2048;
  float* yb = cDA + 32;
  const int tid = tidx(), lane = tid & 63, wave = tid >> 6;
  const int l15 = lane & 15, lg = lane >> 4;
  const bf* XBC = (const bf*)(p.ws + OFF_XBC);
  const float* DTR = (const float*)(p.ws + OFF_DTRAW);
  bf* Y = (bf*)(p.ws + OFF_XRAW) + (size_t)dir * RT * 512;
  const float dtb = p.in[dir ? 42 : 40][hh];
  const float Aneg = -expf(p.in[dir ? 43 : 41][hh]);
  const int st = tid >> 4, q = tid & 15;
  const int r0 = wave * 8 + lg * 2;
  float s0[8], s1[8];
#pragma unroll
  for (int j = 0; j < 8; ++j) { s0[j] = 0.f; s1[j] = 0.f; }
  uint4 gB, gC;
  uint2 gX;
  float gD;
  {
    size_t R = (size_t)scan_row(b, dir, st);
    gB = *(const uint4*)(XBC + R * 1024 + 512 + grp * 128 + q * 8);
    gC = *(const uint4*)(XBC + R * 1024 + 768 + grp * 128 + q * 8);
    gX = *(const uint2*)(XBC + R * 1024 + hh * 64 + q * 4);
    gD = DTR[R * 16 + dir * 8 + hh];
  }
  const int NCH = TA / 32;
  for (int ch = 0; ch <= NCH; ++ch) {
    __syncthreads();
    if (ch > 0) {
      float4 y4 = *(const float4*)(yb + st * 64 + q * 4);
      uint2 o2;
      o2.x = pack2(y4.x, y4.y);
      o2.y = pack2(y4.z, y4.w);
      *(uint2*)(Y + (size_t)scan_row(b, dir, (ch - 1) * 32 + st) * 512 + hh * 64 + q * 4) = o2;
    }
    if (ch == NCH) break;
    {
      float dt = softplusf_(gD + dtb);
      float dA = expf(dt * Aneg);
      float* d = cB + st * 128 + q * 8;
      *(float4*)d = make_float4(bflo(gB.x), bfhi(gB.x), bflo(gB.y), bfhi(gB.y));
      *(float4*)(d + 4) = make_float4(bflo(gB.z), bfhi(gB.z), bflo(gB.w), bfhi(gB.w));
      d = cC + st * 128 + q * 8;
      *(float4*)d = make_float4(bflo(gC.x), bfhi(gC.x), bflo(gC.y), bfhi(gC.y));
      *(float4*)(d + 4) = make_float4(bflo(gC.z), bfhi(gC.z), bflo(gC.w), bfhi(gC.w));
      *(float4*)(cX + st * 64 + q * 4) = make_float4(bflo(gX.x) * dt, bfhi(gX.x) * dt, bflo(gX.y) * dt, bfhi(gX.y) * dt);
      if (q == 0) cDA[st] = dA;
    }
    __syncthreads();
    if (ch + 1 < NCH) {
      size_t R = (size_t)scan_row(b, dir, (ch + 1) * 32 + st);
      gB = *(const uint4*)(XBC + R * 1024 + 512 + grp * 128 + q * 8);
      gC = *(const uint4*)(XBC + R * 1024 + 768 + grp * 128 + q * 8);
      gX = *(const uint2*)(XBC + R * 1024 + hh * 64 + q * 4);
      gD = DTR[R * 16 + dir * 8 + hh];
    }
#pragma unroll 4
    for (int t = 0; t < 32; ++t) {
      float4 b0 = *(const float4*)(cB + t * 128 + l15 * 8);
      float4 b1 = *(const float4*)(cB + t * 128 + l15 * 8 + 4);
      float4 c0 = *(const float4*)(cC + t * 128 + l15 * 8);
      float4 c1 = *(const float4*)(cC + t * 128 + l15 * 8 + 4);
      float2 x2 = *(const float2*)(cX + t * 64 + r0);
      float dA = cDA[t];
      s0[0] = s0[0] * dA + x2.x * b0.x; s0[1] = s0[1] * dA + x2.x * b0.y; s0[2] = s0[2] * dA + x2.x * b0.z; s0[3] = s0[3] * dA + x2.x * b0.w;
      s0[4] = s0[4] * dA + x2.x * b1.x; s0[5] = s0[5] * dA + x2.x * b1.y; s0[6] = s0[6] * dA + x2.x * b1.z; s0[7] = s0[7] * dA + x2.x * b1.w;
      s1[0] = s1[0] * dA + x2.y * b0.x; s1[1] = s1[1] * dA + x2.y * b0.y; s1[2] = s1[2] * dA + x2.y * b0.z; s1[3] = s1[3] * dA + x2.y * b0.w;
      s1[4] = s1[4] * dA + x2.y * b1.x; s1[5] = s1[5] * dA + x2.y * b1.y; s1[6] = s1[6] * dA + x2.y * b1.z; s1[7] = s1[7] * dA + x2.y * b1.w;
      float y0 = s0[0] * c0.x + s0[1] * c0.y + s0[2] * c0.z + s0[3] * c0.w + s0[4] * c1.x + s0[5] * c1.y + s0[6] * c1.z + s0[7] * c1.w;
      float y1 = s1[0] * c0.x + s1[1] * c0.y + s1[2] * c0.z + s1[3] * c0.w + s1[4] * c1.x + s1[5] * c1.y + s1[6] * c1.z + s1[7] * c1.w;
      y0 = red16(y0);
      y1 = red16(y1);
      if (l15 == 0) *(float2*)(yb + t * 64 + r0) = make_float2(y0, y1);
    }
  }
}

__device__ __forceinline__ void gla_chain(const P& p, int chain, char* smem) {
  const int dir = chain & 1, h = (chain >> 1) & 3, b = chain >> 3;
  float* cQ = (float*)smem;
  float* cK = cQ + 2048;
  float* cD = cK + 2048;
  float* cV = cD + 2048;
  float* yb = cV + 4096;
  float* up = yb + 4096;
  float* gbias = up + 1024;
  const int tid = tidx(), lane = tid & 63, wave = tid >> 6;
  const int l15 = lane & 15, lg = lane >> 4;
  const bf* P1 = (const bf*)(p.ws + OFF_P1C);
  bf* Y = (bf*)(p.ws + OFF_GY) + (size_t)dir * RT * 512;
  const float* gup = p.in[dir ? 48 : 46];
  const float* gb = p.in[dir ? 49 : 47];
  __syncthreads();
  for (int i = tid; i < 1024; i += NT) up[i] = gup[(i >> 6) * 256 + h * 64 + (i & 63)];
  if (tid < 64) gbias[tid] = gb[h * 64 + tid];
  const int st = tid >> 4, q = tid & 15;
  const int r0 = wave * 16 + lg * 4;
  float s[4][4];
#pragma unroll
  for (int r = 0; r < 4; ++r)
#pragma unroll
    for (int j = 0; j < 4; ++j) s[r][j] = 0.f;
  uint2 gQ, gK;
  uint4 gV, gG0, gG1;
  {
    const bf* row = P1 + (size_t)scan_row(b, dir, st) * 2080;
    gQ = *(const uint2*)(row + 528 + h * 64 + q * 4);
    gK = *(const uint2*)(row + 784 + h * 64 + q * 4);
    gV = *(const uint4*)(row + 1040 + h * 128 + q * 8);
    gG0 = *(const uint4*)(row + 2064);
    gG1 = *(const uint4*)(row + 2072);
  }
  const int NCH = TA / 32;
  for (int ch = 0; ch <= NCH; ++ch) {
    __syncthreads();
    if (ch > 0) {
      float4 ya = *(const float4*)(yb + st * 128 + q * 8);
      float4 yc = *(const float4*)(yb + st * 128 + q * 8 + 4);
      uint4 o4;
      o4.x = pack2(ya.x, ya.y); o4.y = pack2(ya.z, ya.w); o4.z = pack2(yc.x, yc.y); o4.w = pack2(yc.z, yc.w);
      *(uint4*)(Y + (size_t)scan_row(b, dir, (ch - 1) * 32 + st) * 512 + h * 128 + q * 8) = o4;
    }
    if (ch == NCH) break;
    {
      float gd[16];
      gd[0] = bflo(gG0.x); gd[1] = bfhi(gG0.x); gd[2] = bflo(gG0.y); gd[3] = bfhi(gG0.y);
      gd[4] = bflo(gG0.z); gd[5] = bfhi(gG0.z); gd[6] = bflo(gG0.w); gd[7] = bfhi(gG0.w);
      gd[8] = bflo(gG1.x); gd[9] = bfhi(gG1.x); gd[10] = bflo(gG1.y); gd[11] = bfhi(gG1.y);
      gd[12] = bflo(gG1.z); gd[13] = bfhi(gG1.z); gd[14] = bflo(gG1.w); gd[15] = bfhi(gG1.w);
      float4 z = *(const float4*)(gbias + q * 4);
#pragma unroll
      for (int i = 0; i < 16; ++i) {
        float4 u4 = *(const float4*)(up + i * 64 + q * 4);
        z.x += gd[i] * u4.x; z.y += gd[i] * u4.y; z.z += gd[i] * u4.z; z.w += gd[i] * u4.w;
      }
      float4 dd;
      dd.x = expf(-softplusf_(-z.x) * (1.f / 16.f));
      dd.y = expf(-softplusf_(-z.y) * (1.f / 16.f));
      dd.z = expf(-softplusf_(-z.z) * (1.f / 16.f));
      dd.w = expf(-softplusf_(-z.w) * (1.f / 16.f));
      *(float4*)(cD + st * 64 + q * 4) = dd;
      *(float4*)(cQ + st * 64 + q * 4) = make_float4(bflo(gQ.x) * 0.125f, bfhi(gQ.x) * 0.125f, bflo(gQ.y) * 0.125f, bfhi(gQ.y) * 0.125f);
      *(float4*)(cK + st * 64 + q * 4) = make_float4(bflo(gK.x), bfhi(gK.x), bflo(gK.y), bfhi(gK.y));
      float* d = cV + st * 128 + q * 8;
      *(float4*)d = make_float4(bflo(gV.x), bfhi(gV.x), bflo(gV.y), bfhi(gV.y));
      *(float4*)(d + 4) = make_float4(bflo(gV.z), bfhi(gV.z), bflo(gV.w), bfhi(gV.w));
    }
    __syncthreads();
    if (ch + 1 < NCH) {
      const bf* row = P1 + (size_t)scan_row(b, dir, (ch + 1) * 32 + st) * 2080;
      gQ = *(const uint2*)(row + 528 + h * 64 + q * 4);
      gK = *(const uint2*)(row + 784 + h * 64 + q * 4);
      gV = *(const uint4*)(row + 1040 + h * 128 + q * 8);
      gG0 = *(const uint4*)(row + 2064);
      gG1 = *(const uint4*)(row + 2072);
    }
#pragma unroll 4
    for (int t = 0; t < 32; ++t) {
      float4 q4 = *(const float4*)(cQ + t * 64 + l15 * 4);
      float4 k4 = *(const float4*)(cK + t * 64 + l15 * 4);
      float4 d4 = *(const float4*)(cD + t * 64 + l15 * 4);
      float4 v4 = *(const float4*)(cV + t * 128 + r0);
      float vv[4] = {v4.x, v4.y, v4.z, v4.w};
      float yy[4];
#pragma unroll
      for (int r = 0; r < 4; ++r) {
        s[r][0] = s[r][0] * d4.x + k4.x * vv[r];
        s[r][1] = s[r][1] * d4.y + k4.y * vv[r];
        s[r][2] = s[r][2] * d4.z + k4.z * vv[r];
        s[r][3] = s[r][3] * d4.w + k4.w * vv[r];
        yy[r] = red16(s[r][0] * q4.x + s[r][1] * q4.y + s[r][2] * q4.z + s[r][3] * q4.w);
      }
      if (l15 == 0) *(float4*)(yb + t * 128 + r0) = make_float4(yy[0], yy[1], yy[2], yy[3]);
    }
  }
}

typedef __attribute__((address_space(3))) s16x4* lds_s16x4p;
template <int LD>
__device__ __forceinline__ bf16x8 trfrag_t(const bf* img, int r0, int c0, int lane) {
  const bf* pp = img + (r0 + ((lane & 15) >> 2)) * LD + c0 + (lane & 3) * 4;
  return tr_pair<4 * LD * 2>(pp);
}
#define trfrag(img, ld, r0, c0, lane) trfrag_t<ld>(img, r0, c0, lane)
__device__ __forceinline__ bf16x8 pack8(f32x4 a, f32x4 b) {
  i32x4 t;
  t[0] = (int)pack2(a[0], a[1]); t[1] = (int)pack2(a[2], a[3]); t[2] = (int)pack2(b[0], b[1]); t[3] = (int)pack2(b[2], b[3]);
  return __builtin_bit_cast(bf16x8, t);
}
__device__ __forceinline__ bf16x8 ld2x64(const bf* p0, const bf* p1) {
  uint2 a = *(const uint2*)p0, b2 = *(const uint2*)p1;
  i32x4 t;
  t[0] = (int)a.x; t[1] = (int)a.y; t[2] = (int)b2.x; t[3] = (int)b2.y;
  return __builtin_bit_cast(bf16x8, t);
}

__device__ __forceinline__ void gla_chain2(const P& p, int chain, char* smem) {
  const int dir = chain & 1, h = (chain >> 1) & 3, b = chain >> 3;
  bf* Qs = (bf*)smem;
  bf* Ks = Qs + 64 * 72;
  bf* Vs = Ks + 64 * 72;
  bf* Ps = Vs + 64 * 144;
  bf* GD = Ps + 64 * 72;
  float* segtot = (float*)(GD + 64 * 16);
  float* dS = segtot + 512;
  const int tid = tidx(), lane = tid & 63, wave = tid >> 6;
  const int l15 = lane & 15, g = lane >> 4;
  const bf* P1 = (const bf*)(p.ws + OFF_P1C);
  bf* Y = (bf*)(p.ws + OFF_GY) + (size_t)dir * RT * 512;
  const float* gup = p.in[dir ? 48 : 46];
  const float* gb = p.in[dir ? 49 : 47];
  const int kc = tid & 63, seg = tid >> 6;
  float upr[16];
#pragma unroll
  for (int r = 0; r < 16; ++r) upr[r] = gup[r * 256 + h * 64 + kc];
  const float bk = gb[h * 64 + kc];
  const int stok = tid >> 3, sc8 = (tid & 7) * 8;
  f32x4 S[4];
#pragma unroll
  for (int kt = 0; kt < 4; ++kt) S[kt] = (f32x4){0.f, 0.f, 0.f, 0.f};
  uint4 rq, rk, rv0, rv1, rg = make_uint4(0, 0, 0, 0);
  {
    const bf* row = P1 + (size_t)scan_row(b, dir, stok) * 2080;
    rq = *(const uint4*)(row + 528 + h * 64 + sc8);
    rk = *(const uint4*)(row + 784 + h * 64 + sc8);
    rv0 = *(const uint4*)(row + 1040 + h * 128 + sc8 * 2);
    rv1 = *(const uint4*)(row + 1040 + h * 128 + sc8 * 2 + 8);
    if (tid < 128) rg = *(const uint4*)(P1 + (size_t)scan_row(b, dir, tid >> 1) * 2080 + 2064 + (tid & 1) * 8);
  }
  const int NCH = TA / 64;
  for (int c = 0; c < NCH; ++c) {
    __syncthreads();
    *(uint4*)(Qs + stok * 72 + sc8) = rq;
    *(uint4*)(Ks + stok * 72 + sc8) = rk;
    *(uint4*)(Vs + stok * 144 + sc8 * 2) = rv0;
    *(uint4*)(Vs + stok * 144 + sc8 * 2 + 8) = rv1;
    if (tid < 128) *(uint4*)(GD + (tid >> 1) * 16 + (tid & 1) * 8) = rg;
    __syncthreads();
    if (c + 1 < NCH) {
      const bf* row = P1 + (size_t)scan_row(b, dir, (c + 1) * 64 + stok) * 2080;
      rq = *(const uint4*)(row + 528 + h * 64 + sc8);
      rk = *(const uint4*)(row + 784 + h * 64 + sc8);
      rv0 = *(const uint4*)(row + 1040 + h * 128 + sc8 * 2);
      rv1 = *(const uint4*)(row + 1040 + h * 128 + sc8 * 2 + 8);
      if (tid < 128) rg = *(const uint4*)(P1 + (size_t)scan_row(b, dir, (c + 1) * 64 + (tid >> 1)) * 2080 + 2064 + (tid & 1) * 8);
    }
    float lc[8];
    {
      float run = 0.f;
#pragma unroll
      for (int ii = 0; ii < 8; ++ii) {
        const bf* gr = GD + (seg * 8 + ii) * 16;
        uint4 g0 = *(const uint4*)gr, g1 = *(const uint4*)(gr + 8);
        float z = bk;
        z += bflo(g0.x) * upr[0] + bfhi(g0.x) * upr[1] + bflo(g0.y) * upr[2] + bfhi(g0.y) * upr[3];
        z += bflo(g0.z) * upr[4] + bfhi(g0.z) * upr[5] + bflo(g0.w) * upr[6] + bfhi(g0.w) * upr[7];
        z += bflo(g1.x) * upr[8] + bfhi(g1.x) * upr[9] + bflo(g1.y) * upr[10] + bfhi(g1.y) * upr[11];
        z += bflo(g1.z) * upr[12] + bfhi(g1.z) * upr[13] + bflo(g1.w) * upr[14] + bfhi(g1.w) * upr[15];
        run += -softplusf_(-z) * (1.f / 16.f);
        lc[ii] = run;
      }
      segtot[seg * 64 + kc] = run;
    }
    __syncthreads();
    {
      float off = 0.f, tot = 0.f;
#pragma unroll
      for (int s2 = 0; s2 < 8; ++s2) {
        float t = segtot[s2 * 64 + kc];
        tot += t;
        off += (s2 < seg) ? t : 0.f;
      }
#pragma unroll
      for (int ii = 0; ii < 8; ++ii) {
        int i = seg * 8 + ii;
        float cum = off + lc[ii];
        float qv = bf2f(Qs[i * 72 + kc]), kv = bf2f(Ks[i * 72 + kc]);
        float eq = __expf(cum - tot);
        Qs[i * 72 + kc] = f2bf(qv * 0.125f * eq);
        Ks[i * 72 + kc] = f2bf(kv * __builtin_amdgcn_rcpf(eq));
      }
      if (seg == 0) dS[kc] = __expf(tot);
    }
    __syncthreads();
#pragma unroll
    for (int kt = 0; kt < 4; ++kt) {
      float4 d4 = *(const float4*)(dS + kt * 16 + g * 4);
      S[kt][0] *= d4.x; S[kt][1] *= d4.y; S[kt][2] *= d4.z; S[kt][3] *= d4.w;
    }
#pragma unroll
    for (int tt = 0; tt < 2; ++tt) {
      int idx = wave * 2 + tt, jt = idx >> 2, it = idx & 3;
      f32x4 acc = (f32x4){0.f, 0.f, 0.f, 0.f};
      if (jt <= it) {
#pragma unroll
        for (int ks = 0; ks < 2; ++ks) {
          bf16x8 a = *(const bf16x8*)(Ks + (jt * 16 + l15) * 72 + ks * 32 + g * 8);
          bf16x8 bq = *(const bf16x8*)(Qs + (it * 16 + l15) * 72 + ks * 32 + g * 8);
          acc = __builtin_amdgcn_mfma_f32_16x16x32_bf16(a, bq, acc, 0, 0, 0);
        }
        int i = it * 16 + l15;
#pragma unroll
        for (int r = 0; r < 4; ++r) { int j = jt * 16 + g * 4 + r; acc[r] = (j <= i) ? acc[r] : 0.f; }
      }
      uint2 o;
      o.x = pack2(acc[0], acc[1]);
      o.y = pack2(acc[2], acc[3]);
      *(uint2*)(Ps + (it * 16 + l15) * 72 + jt * 16 + g * 4) = o;
    }
    __syncthreads();
    f32x4 y[4];
#pragma unroll
    for (int it = 0; it < 4; ++it) y[it] = (f32x4){0.f, 0.f, 0.f, 0.f};
#pragma unroll
    for (int s2 = 0; s2 < 2; ++s2) {
      bf16x8 sf = pack8(S[2 * s2], S[2 * s2 + 1]);
#pragma unroll
      for (int it = 0; it < 4; ++it) {
        const bf* qr = Qs + (it * 16 + l15) * 72 + g * 4;
        bf16x8 aq = ld2x64(qr + (2 * s2) * 16, qr + (2 * s2 + 1) * 16);
        y[it] = __builtin_amdgcn_mfma_f32_16x16x32_bf16(aq, sf, y[it], 0, 0, 0);
      }
    }
#pragma unroll
    for (int s2 = 0; s2 < 2; ++s2) {
      bf16x8 vf = trfrag(Vs, 144, s2 * 32 + g * 8, wave * 16, lane);
#pragma unroll
      for (int it = 0; it < 4; ++it) {
        bf16x8 ap = *(const bf16x8*)(Ps + (it * 16 + l15) * 72 + s2 * 32 + g * 8);
        y[it] = __builtin_amdgcn_mfma_f32_16x16x32_bf16(ap, vf, y[it], 0, 0, 0);
      }
#pragma unroll
      for (int kt = 0; kt < 4; ++kt) {
        bf16x8 ak = trfrag(Ks, 72, s2 * 32 + g * 8, kt * 16, lane);
        S[kt] = __builtin_amdgcn_mfma_f32_16x16x32_bf16(ak, vf, S[kt], 0, 0, 0);
      }
    }
#pragma unroll
    for (int it = 0; it < 4; ++it)
#pragma unroll
      for (int r = 0; r < 4; ++r) {
        int i = it * 16 + g * 4 + r;
        Y[(size_t)scan_row(b, dir, c * 64 + i) * 512 + h * 128 + wave * 16 + l15] = f2bf(y[it][r]);
      }
  }
}

__device__ __forceinline__ void ssd_chain2(const P& p, int chain, char* smem) {
  const int dir = chain & 1, hh = (chain >> 1) & 7, b = chain >> 4;
  const int grp = hh >> 2;
  bf* Cs = (bf*)smem;
  bf* Bs = Cs + 64 * 136;
  bf* Xs = Bs + 64 * 136;
  bf* Xw = Xs + 64 * 72;
  bf* Ps = Xw + 64 * 72;
  float* dtS = (float*)(Ps + 64 * 72);
  float* cumS = dtS + 64;
  float* ecS = cumS + 64;
  float* totS = ecS + 64;
  const int tid = tidx(), lane = tid & 63, wave = tid >> 6;
  const int l15 = lane & 15, g = lane >> 4;
  const int vt = wave & 3, ih = wave >> 2;
  const bf* XBC = (const bf*)(p.ws + OFF_XBC);
  const float* DTR = (const float*)(p.ws + OFF_DTRAW);
  bf* Y = (bf*)(p.ws + OFF_XRAW) + (size_t)dir * RT * 512;
  const float dtb = p.in[dir ? 42 : 40][hh];
  const float Aneg = -expf(p.in[dir ? 43 : 41][hh]);
  const int stok = tid >> 3, sc = tid & 7;
  f32x4 S[8];
#pragma unroll
  for (int nt = 0; nt < 8; ++nt) S[nt] = (f32x4){0.f, 0.f, 0.f, 0.f};
  uint4 rc0, rc1, rb0, rb1, rx;
  float rdt = 0.f;
  {
    const bf* row = XBC + (size_t)scan_row(b, dir, stok) * 1024;
    rb0 = *(const uint4*)(row + 512 + grp * 128 + sc * 16);
    rb1 = *(const uint4*)(row + 512 + grp * 128 + sc * 16 + 8);
    rc0 = *(const uint4*)(row + 768 + grp * 128 + sc * 16);
    rc1 = *(const uint4*)(row + 768 + grp * 128 + sc * 16 + 8);
    rx = *(const uint4*)(row + hh * 64 + sc * 8);
    if (tid < 64) rdt = DTR[(size_t)scan_row(b, dir, tid) * 16 + dir * 8 + hh];
  }
  const int NCH = TA / 64;
  for (int c = 0; c < NCH; ++c) {
    __syncthreads();
    *(uint4*)(Cs + stok * 136 + sc * 16) = rc0;
    *(uint4*)(Cs + stok * 136 + sc * 16 + 8) = rc1;
    *(uint4*)(Bs + stok * 136 + sc * 16) = rb0;
    *(uint4*)(Bs + stok * 136 + sc * 16 + 8) = rb1;
    if (tid < 64) {
      float dt = softplusf_(rdt + dtb);
      float cum = dt * Aneg;
#pragma unroll
      for (int o = 1; o < 64; o <<= 1) {
        float t = __shfl_up(cum, o);
        if (lane >= o) cum += t;
      }
      float tot = __shfl(cum, 63);
      dtS[lane] = dt;
      cumS[lane] = cum;
      ecS[lane] = __expf(cum);
      if (lane == 0) totS[0] = tot;
    }
    __syncthreads();
    const uint4 cx = rx;
    if (c + 1 < NCH) {
      const bf* row = XBC + (size_t)scan_row(b, dir, (c + 1) * 64 + stok) * 1024;
      rb0 = *(const uint4*)(row + 512 + grp * 128 + sc * 16);
      rb1 = *(const uint4*)(row + 512 + grp * 128 + sc * 16 + 8);
      rc0 = *(const uint4*)(row + 768 + grp * 128 + sc * 16);
      rc1 = *(const uint4*)(row + 768 + grp * 128 + sc * 16 + 8);
      rx = *(const uint4*)(row + hh * 64 + sc * 8);
      if (tid < 64) rdt = DTR[(size_t)scan_row(b, dir, (c + 1) * 64 + tid) * 16 + dir * 8 + hh];
    }
    const float tot = totS[0];
    {
      float dt = dtS[stok];
      float w = dt * __expf(tot - cumS[stok]);
      float x0 = bflo(cx.x), x1 = bfhi(cx.x), x2 = bflo(cx.y), x3 = bfhi(cx.y), x4 = bflo(cx.z), x5 = bfhi(cx.z), x6 = bflo(cx.w), x7 = bfhi(cx.w);
      uint4 o;
      o.x = pack2(x0 * dt, x1 * dt); o.y = pack2(x2 * dt, x3 * dt); o.z = pack2(x4 * dt, x5 * dt); o.w = pack2(x6 * dt, x7 * dt);
      *(uint4*)(Xs + stok * 72 + sc * 8) = o;
      o.x = pack2(x0 * w, x1 * w); o.y = pack2(x2 * w, x3 * w); o.z = pack2(x4 * w, x5 * w); o.w = pack2(x6 * w, x7 * w);
      *(uint4*)(Xw + stok * 72 + sc * 8) = o;
    }
#pragma unroll
    for (int tt = 0; tt < 2; ++tt) {
      int idx = wave * 2 + tt, jt = idx >> 2, it = idx & 3;
      f32x4 acc = (f32x4){0.f, 0.f, 0.f, 0.f};
      if (jt <= it) {
#pragma unroll
        for (int ks = 0; ks < 4; ++ks) {
          bf16x8 a = *(const bf16x8*)(Bs + (jt * 16 + l15) * 136 + ks * 32 + g * 8);
          bf16x8 bq = *(const bf16x8*)(Cs + (it * 16 + l15) * 136 + ks * 32 + g * 8);
          acc = __builtin_amdgcn_mfma_f32_16x16x32_bf16(a, bq, acc, 0, 0, 0);
        }
        int i = it * 16 + l15;
        float ci = cumS[i];
        float4 cj = *(const float4*)(cumS + jt * 16 + g * 4);
        int j0 = jt * 16 + g * 4;
        acc[0] = (j0 + 0 <= i) ? acc[0] * __expf(ci - cj.x) : 0.f;
        acc[1] = (j0 + 1 <= i) ? acc[1] * __expf(ci - cj.y) : 0.f;
        acc[2] = (j0 + 2 <= i) ? acc[2] * __expf(ci - cj.z) : 0.f;
        acc[3] = (j0 + 3 <= i) ? acc[3] * __expf(ci - cj.w) : 0.f;
      }
      uint2 o;
      o.x = pack2(acc[0], acc[1]);
      o.y = pack2(acc[2], acc[3]);
      *(uint2*)(Ps + (it * 16 + l15) * 72 + jt * 16 + g * 4) = o;
    }
    __syncthreads();
    f32x4 y[2];
    y[0] = (f32x4){0.f, 0.f, 0.f, 0.f};
    y[1] = (f32x4){0.f, 0.f, 0.f, 0.f};
#pragma unroll
    for (int s2 = 0; s2 < 4; ++s2) {
      bf16x8 sf = pack8(S[2 * s2], S[2 * s2 + 1]);
#pragma unroll
      for (int ii = 0; ii < 2; ++ii) {
        const bf* qr = Cs + ((ih * 2 + ii) * 16 + l15) * 136 + g * 4;
        bf16x8 aq = ld2x64(qr + (2 * s2) * 16, qr + (2 * s2 + 1) * 16);
        y[ii] = __builtin_amdgcn_mfma_f32_16x16x32_bf16(aq, sf, y[ii], 0, 0, 0);
      }
    }
    {
      float et = __expf(tot);
#pragma unroll
      for (int nt = 0; nt < 8; ++nt) { S[nt][0] *= et; S[nt][1] *= et; S[nt][2] *= et; S[nt][3] *= et; }
    }
#pragma unroll
    for (int ii = 0; ii < 2; ++ii) {
      float4 e4 = *(const float4*)(ecS + (ih * 2 + ii) * 16 + g * 4);
      y[ii][0] *= e4.x; y[ii][1] *= e4.y; y[ii][2] *= e4.z; y[ii][3] *= e4.w;
    }
#pragma unroll
    for (int s2 = 0; s2 < 2; ++s2) {
      bf16x8 xf = trfrag(Xs, 72, s2 * 32 + g * 8, vt * 16, lane);
#pragma unroll
      for (int ii = 0; ii < 2; ++ii) {
        bf16x8 ap = *(const bf16x8*)(Ps + ((ih * 2 + ii) * 16 + l15) * 72 + s2 * 32 + g * 8);
        y[ii] = __builtin_amdgcn_mfma_f32_16x16x32_bf16(ap, xf, y[ii], 0, 0, 0);
      }
      bf16x8 xwf = trfrag(Xw, 72, s2 * 32 + g * 8, vt * 16, lane);
#pragma unroll
      for (int nt = 0; nt < 8; ++nt) {
        bf16x8 ab = trfrag(Bs, 136, s2 * 32 + g * 8, nt * 16, lane);
        S[nt] = __builtin_amdgcn_mfma_f32_16x16x32_bf16(ab, xwf, S[nt], 0, 0, 0);
      }
    }
#pragma unroll
    for (int ii = 0; ii < 2; ++ii)
#pragma unroll
      for (int r = 0; r < 4; ++r) {
        int i = (ih * 2 + ii) * 16 + g * 4 + r;
        Y[(size_t)scan_row(b, dir, c * 64 + i) * 512 + hh * 64 + vt * 16 + l15] = f2bf(y[ii][r]);
      }
  }
}

__device__ __forceinline__ void ph_mix1(const P& p, char* smem) {
  for (int u = blockIdx.x; u < 192; u += gridDim.x) {
    if (u < 128) ssd_chain2(p, u, smem);
    else gla_chain2(p, u - 128, smem);
  }
}

__device__ __forceinline__ void ph_post1(const P& p, char* smem) {
  float* ws1 = (float*)smem;
  float* ws2 = ws1 + 32;
  const int tid = tidx(), lane = tid & 63, wave = tid >> 6;
  const bf* SYF = (const bf*)(p.ws + OFF_XRAW);
  const bf* SYB = SYF + (size_t)RT * 512;
  const bf* GYF = (const bf*)(p.ws + OFF_GY);
  const bf* GYB = GYF + (size_t)RT * 512;
  const bf* XBC = (const bf*)(p.ws + OFF_XBC);
  const bf* P1 = (const bf*)(p.ws + OFF_P1C);
  bf* O = (bf*)(p.ws + OFF_HO);
  const float dsk = p.in[44][tid >> 6];
  const float sn = p.in[45][tid];
  const float gn = p.in[50][tid & 127];
  for (int rr0 = blockIdx.x * 4; rr0 < NBAT * SEQ; rr0 += gridDim.x * 4) {
    float y[4], y2[4], zg[4], gg[4];
    int Rr[4];
#pragma unroll
    for (int i = 0; i < 4; ++i) {
      int rr = rr0 + i;
      int R = (rr >> 12) * TA + CTX + (rr & 4095);
      Rr[i] = R;
      size_t o = (size_t)R * 512 + tid;
      y[i] = bf2f(SYF[o]) + bf2f(SYB[o]) + bf2f(XBC[(size_t)R * 1024 + tid]) * dsk;
      zg[i] = bf2f(P1[(size_t)R * 2080 + tid]);
      y2[i] = bf2f(GYF[o]) + bf2f(GYB[o]);
      gg[i] = bf2f(P1[(size_t)R * 2080 + 1552 + tid]);
    }
    __syncthreads();
#pragma unroll
    for (int i = 0; i < 4; ++i) {
      y[i] *= siluf_(zg[i]);
      float s1 = wave_sum(y[i] * y[i]);
      float s2 = wave_sum(y2[i] * y2[i]);
      if (lane == 0) { ws1[i * 8 + wave] = s1; ws2[i * 8 + wave] = s2; }
    }
    __syncthreads();
#pragma unroll
    for (int i = 0; i < 4; ++i) {
      int g4 = i * 8 + (wave >> 2) * 4;
      float t1 = ws1[g4] + ws1[g4 + 1] + ws1[g4 + 2] + ws1[g4 + 3];
      int g2 = i * 8 + (wave >> 1) * 2;
      float t2 = ws2[g2] + ws2[g2 + 1];
      float o1 = y[i] * rsqrtf(t1 * (1.f / 256.f) + 1e-6f) * sn;
      float o2 = y2[i] * rsqrtf(t2 * (1.f / 128.f) + 1e-6f) * gn * siluf_(gg[i]);
      O[(size_t)Rr[i] * 1024 + tid] = f2bf(o1);
      O[(size_t)Rr[i] * 1024 + 512 + tid] = f2bf(o2);
    }
  }
}

__device__ __forceinline__ void ph_final(const P& p) {
  const int lane = tidx() & 63, wave = tidx() >> 6;
  const float* g = p.in[51];
  for (int r = blockIdx.x * 8 + wave; r < NBAT * SEQ; r += gridDim.x * 8) {
    float* row = p.out + (size_t)r * 1024;
    float4 v[4];
    float ss = 0.f;
#pragma unroll
    for (int i = 0; i < 4; ++i) {
      v[i] = *(const float4*)(row + i * 256 + lane * 4);
      ss += v[i].x * v[i].x + v[i].y * v[i].y + v[i].z * v[i].z + v[i].w * v[i].w;
    }
    ss = wave_sum(ss);
    float rs = rsqrtf(ss * (1.f / 1024.f) + 1e-6f);
#pragma unroll
    for (int i = 0; i < 4; ++i) {
      float4 gg = *(const float4*)(g + i * 256 + lane * 4);
      float4 o = make_float4(v[i].x * rs * gg.x, v[i].y * rs * gg.y, v[i].z * rs * gg.z, v[i].w * rs * gg.w);
      *(float4*)(row + i * 256 + lane * 4) = o;
    }
  }
}

constexpr int NPH = 20;
template <int PH>
__device__ __forceinline__ void run_phase(const P& p, char* smem) {
  const bf* WT = (const bf*)(p.ws + OFF_WT);
  const bf* HO = (const bf*)(p.ws + OFF_HO);
  const bf* HID = (const bf*)(p.ws + OFF_HID);
  if constexpr (PH == 0) {
    if (blockIdx.x == 0 && tidx() == 0) { *(int*)(p.ws + OFF_CNT) = 0; *((int*)(p.ws + OFF_CNT) + 1) = 0; }
    ph_mod(p, smem);
    ph_lw(p);
    ph_wt(p, 0, smem);
  } else if constexpr (PH == 1) ph_ada(p, 0, 0, 1, 0);
  else if constexpr (PH == 2) ph_gemm<0>(p, HO, WT + WT_IN, 1024, 13, 0, 0, smem);
  else if constexpr (PH == 3) {
    ph_rope(p, smem);
    ph_rwkv_prep(p, smem);
#ifdef PROBE_PREP
    __syncthreads();
    ph_rwkv_prep(p, smem);
#endif
  }
  else if constexpr (PH == 4) ph_mix0(p, smem);
  else if constexpr (PH == 5) ph_rwkv_post(p);
  else if constexpr (PH == 6) ph_gemm<2>(p, HO, WT + WT_OUT, 1024, 4, 0, 0, smem);
  else if constexpr (PH == 7) ph_ada(p, 0, 1, 0, 0);
  else if constexpr (PH == 8) ph_gemm<3>(p, HO, WT + WT_W1, 1024, 16, 0, 0, smem);
  else if constexpr (PH == 9) ph_gemm<4>(p, HID, WT + WT_W2, 4096, 4, 0, 0, smem);
  else if constexpr (PH == 10) { ph_ada(p, 1, 0, 0, 0); ph_wt(p, 1, smem); }
  else if constexpr (PH == 11) ph_gemm<1>(p, HO, WT + WT_IN, 1024, 13, 1, 0, smem);
  else if constexpr (PH == 12) ph_conv(p);
  else if constexpr (PH == 13) ph_mix1(p, smem);
  else if constexpr (PH == 14) ph_post1(p, smem);
  else if constexpr (PH == 15) ph_gemm<2>(p, HO, WT + WT_OUT, 1024, 4, 1, 1, smem);
  else if constexpr (PH == 16) ph_ada(p, 1, 1, 0, 1);
  else if constexpr (PH == 17) ph_gemm<3>(p, HO, WT + WT_W1, 1024, 16, 1, 1, smem);
  else if constexpr (PH == 18) ph_gemm<4>(p, HID, WT + WT_W2, 4096, 4, 1, 1, smem);
  else ph_final(p);
}

constexpr int LDS_BYTES = 131072 + 64;
template <int PH>
__device__ __forceinline__ void run_all(const P& p, char* smem) {
  run_phase<PH>(p, smem);
#ifdef PROBE_MASK
  if constexpr (((PROBE_MASK) >> PH) & 1) {
    cg::this_grid().sync();
    if constexpr (PH == 4) {
      if (blockIdx.x == 0 && tidx() == 0) *(int*)(p.ws + OFF_CNT) = 0;
      cg::this_grid().sync();
    }
    run_phase<PH>(p, smem);
  }
#endif
  if constexpr (PH + 1 < NPH) {
    cg::this_grid().sync();
    run_all<PH + 1>(p, smem);
  }
}
__global__ void __launch_bounds__(NT) mega(P p) {
  extern __shared__ __attribute__((aligned(16))) char smem[];
  run_all<0>(p, smem);
}

extern "C" void kernel_launch(void* const* d_in, const int* in_sizes, int n_in, void* d_out, int out_size, void* d_ws,
                              size_t ws_size, hipStream_t stream) {
  P p{};
  for (int i = 0; i < 52; ++i) p.in[i] = (const float*)d_in[i];
  p.out = (float*)d_out;
  p.ws = (char*)d_ws;
  static int grid_blocks = 0;
  if (!grid_blocks) {
    int dev = 0, cus = 0, per_cu = 0;
    (void)hipGetDevice(&dev);
    (void)hipDeviceGetAttribute(&cus, hipDeviceAttributeMultiprocessorCount, dev);
    (void)hipFuncSetAttribute((const void*)mega, hipFuncAttributeMaxDynamicSharedMemorySize, LDS_BYTES);
    (void)hipOccupancyMaxActiveBlocksPerMultiprocessor(&per_cu, mega, NT, LDS_BYTES);
    if (per_cu < 1) per_cu = 1;
    if (per_cu > 1) per_cu = 1;
    grid_blocks = cus * per_cu;
  }
  void* args[] = {&p};
  hipError_t e = hipLaunchCooperativeKernel((void*)mega, dim3(grid_blocks), dim3(NT), args, LDS_BYTES, stream);
  if (e != hipSuccess) fprintf(stderr, "cooperative launch failed: %s (grid %d)\n", hipGetErrorString(e), grid_blocks);
}
```

```cpp
#include <hip/hip_runtime.h>
#include <hip/hip_cooperative_groups.h>
#include <cstdio>
namespace cg = cooperative_groups;

#ifndef MODE_COOP
#define MODE_COOP 1
#endif

typedef unsigned short bf;
typedef __attribute__((ext_vector_type(8))) short bf16x8;
typedef __attribute__((ext_vector_type(4))) float f32x4;
typedef __attribute__((ext_vector_type(4))) int i32x4;

constexpr int NT = 512;
constexpr int Dm = 1024, NBAT = 8, SEQ = 4096, CTX = 256, TA = 4352, RT = NBAT * TA;

constexpr size_t OFF_MOD = 0;
constexpr size_t OFF_CNT = 450000;
constexpr size_t OFF_WT = 524288;
constexpr size_t WT_IN = 0, WT_OUT = (size_t)3328 * 1024, WT_W1 = WT_OUT + (size_t)1024 * 1024, WT_W2 = WT_W1 + (size_t)4096 * 1024;
constexpr size_t OFF_CTXX = OFF_WT + (size_t)12544 * 1024 * 2;
constexpr size_t OFF_HO = OFF_CTXX + (size_t)2048 * 1024 * 4;
constexpr size_t OFF_BIG = OFF_HO + (size_t)RT * 1024 * 2;
constexpr size_t SZ512 = (size_t)RT * 512 * 2;
constexpr size_t OFF_QKV = OFF_BIG;
constexpr size_t OFF_PREP = OFF_QKV + (size_t)RT * 1536 * 2;
constexpr size_t OFF_G = OFF_PREP + 7 * SZ512;
constexpr size_t OFF_BONUS = OFF_G + SZ512;
constexpr size_t OFF_LW = OFF_BONUS + (size_t)RT * 8 * 4;
constexpr size_t OFF_HID = OFF_BIG;
constexpr size_t OFF_P1C = OFF_BIG;
constexpr size_t OFF_XRAW = OFF_P1C + (size_t)RT * 2080 * 2;
constexpr size_t OFF_DTRAW = OFF_XRAW + (size_t)RT * 1024 * 2;
constexpr size_t OFF_XBC = OFF_DTRAW + (size_t)RT * 16 * 4;
constexpr size_t OFF_GY = OFF_XBC + (size_t)RT * 1024 * 2;

struct P {
  const float* in[52];
  float* out;
  char* ws;
};

__device__ __forceinline__ int tidx() { int t = threadIdx.x; asm volatile("" : "+v"(t)); return t; }
__device__ __forceinline__ bf f2bf(float f) { __bf16 r = (__bf16)f; return __builtin_bit_cast(bf, r); }
__device__ __forceinline__ float bf2f(bf h) { return __uint_as_float(((unsigned)h) << 16); }
__device__ __forceinline__ float bflo(unsigned u) { return __uint_as_float(u << 16); }
__device__ __forceinline__ float bfhi(unsigned u) { return __uint_as_float(u & 0xffff0000u); }
typedef __bf16 bf16x2_t __attribute__((ext_vector_type(2)));
typedef float f32x2_t __attribute__((ext_vector_type(2)));
__device__ __forceinline__ unsigned pack2(float a, float b) { f32x2_t v = {a, b}; bf16x2_t r = __builtin_convertvector(v, bf16x2_t); return __builtin_bit_cast(unsigned, r); }
__device__ __forceinline__ float sigmoidf_(float x) { return __builtin_amdgcn_rcpf(1.f + __expf(-x)); }
__device__ __forceinline__ float softplusf_(float x) { return x > 15.f ? x : __logf(1.f + __expf(x)); }
__device__ __forceinline__ float siluf_(float x) { return x * __builtin_amdgcn_rcpf(1.f + __expf(-x)); }
__device__ __forceinline__ float wave_sum(float v) {
#pragma unroll
  for (int o = 32; o >= 1; o >>= 1) v += __shfl_xor(v, o);
  return v;
}
template <int C>
__device__ __forceinline__ float dppf(float x) {
  return __builtin_bit_cast(float, __builtin_amdgcn_update_dpp(0, __builtin_bit_cast(int, x), C, 0xF, 0xF, true));
}
__device__ __forceinline__ float red16(float x) {
  x += dppf<0xB1>(x);
  x += dppf<0x4E>(x);
  x += dppf<0x141>(x);
  x += dppf<0x128>(x);
  return x;
}
__device__ __forceinline__ float* xrow(const P& p, int R) {
  int b = R / TA, a = R - b * TA;
  if (a < CTX) return (float*)(p.ws + OFF_CTXX) + (size_t)(b * CTX + a) * Dm;
  return p.out + (size_t)(b * SEQ + a - CTX) * Dm;
}
__device__ __forceinline__ const float* inrow(const P& p, int R) {
  int b = R / TA, a = R - b * TA;
  if (a < CTX) return p.in[2] + (size_t)(b * CTX + a) * Dm;
  return p.in[0] + (size_t)(b * SEQ + a - CTX) * Dm;
}
__device__ __forceinline__ int mrow(int R) {
  int b = R / TA, a = R - b * TA;
  return a < CTX ? 8 : b;
}

__device__ __forceinline__ void ph_mod(const P& p, char* smem) {
  float* sc = (float*)smem;
  float* red = sc + 9 * 1024;
  const int tid = tidx();
  bool loaded = false;
  for (int unit = blockIdx.x; unit < 2 * 192; unit += gridDim.x) {
    int layer = unit / 192, cch = unit - layer * 192;
    const float* W = p.in[layer ? 30 : 4];
    const float* bias = p.in[layer ? 31 : 5];
    __syncthreads();
    if (!loaded) {
      for (int i = tid; i < 9 * 1024; i += NT) {
        int r = i >> 10, k = i & 1023;
        float v = (r < 8) ? p.in[1][r * 1024 + k] : p.in[3][k];
        sc[i] = siluf_(v);
      }
      loaded = true;
      __syncthreads();
    }
    int cl = tid & 31, kg = tid >> 5;
    int col = cch * 32 + cl;
    float acc[9];
#pragma unroll
    for (int r = 0; r < 9; ++r) acc[r] = 0.f;
    for (int k = kg * 64; k < kg * 64 + 64; ++k) {
      float w = W[(size_t)k * 6144 + col];
#pragma unroll
      for (int r = 0; r < 9; ++r) acc[r] += sc[r * 1024 + k] * w;
    }
#pragma unroll
    for (int r = 0; r < 9; ++r) red[(kg * 9 + r) * 32 + cl] = acc[r];
    __syncthreads();
    if (tid < 288) {
      int r = tid >> 5, c = tid & 31;
      float s = 0.f;
#pragma unroll
      for (int g = 0; g < 16; ++g) s += red[(g * 9 + r) * 32 + c];
      ((float*)(p.ws + OFF_MOD))[(size_t)(layer * 9 + r) * 6144 + cch * 32 + c] = s + bias[cch * 32 + c];
    }
  }
}

__device__ __forceinline__ void transpose_one(const float* W, bf* Wt, int K, int N, int Npad, int vb, int nvb, char* smem) {
  float* tile = (float*)smem;
  const int tid = tidx();
  int ntn = Npad / 64, ntk = K / 64;
  for (int t = vb; t < ntn * ntk; t += nvb) {
    int tn = t / ntk, tk = t - tn * ntk;
    int n0 = tn * 64, k0 = tk * 64;
    __syncthreads();
#pragma unroll
    for (int i = 0; i < 8; ++i) {
      int kk = (tid >> 6) + 8 * i, nn = tid & 63;
      float v = (n0 + nn < N) ? W[(size_t)(k0 + kk) * N + n0 + nn] : 0.f;
      tile[kk * 65 + nn] = v;
    }
    __syncthreads();
#pragma unroll
    for (int i = 0; i < 8; ++i) {
      int nn = (tid >> 6) + 8 * i, kk = tid & 63;
      Wt[(size_t)(n0 + nn) * K + k0 + kk] = f2bf(tile[kk * 65 + nn]);
    }
  }
}
__device__ __forceinline__ void ph_wt(const P& p, int layer, char* smem) {
  bf* WT = (bf*)(p.ws + OFF_WT);
  int base = layer ? 34 : 8;
  int nin = layer ? 3104 : 3328, ninp = 3328;
  int nb = gridDim.x, b = blockIdx.x;
  for (int mtx = 0; mtx < 4; ++mtx) {
    const float* W = p.in[base + mtx];
    bf* dst = WT + (mtx == 0 ? WT_IN : mtx == 1 ? WT_OUT : mtx == 2 ? WT_W1 : WT_W2);
    int K = mtx == 3 ? 4096 : 1024;
    int N = mtx == 0 ? nin : mtx == 2 ? 4096 : 1024;
    int Np = mtx == 0 ? ninp : N;
    transpose_one(W, dst, K, N, Np, (b + 64 * mtx) % nb, nb, smem);
  }
}

__device__ __forceinline__ void ph_ada(const P& p, int layer, int which, int useInput, int latonly) {
  const int lane = tidx() & 63, wave = tidx() >> 6;
  const float* ng = p.in[(layer ? 32 : 6) + which];
  const float* mod = (const float*)(p.ws + OFF_MOD);
  bf* H = (bf*)(p.ws + OFF_HO);
  for (int R = blockIdx.x * 8 + wave; R < RT; R += gridDim.x * 8) {
    int b = R / TA, a = R - b * TA;
    if (latonly && a < CTX) continue;
    const float* src = useInput ? inrow(p, R) : xrow(p, R);
    float4 v[4];
    float ss = 0.f;
#pragma unroll
    for (int i = 0; i < 4; ++i) {
      v[i] = *(const float4*)(src + i * 256 + lane * 4);
      ss += v[i].x * v[i].x + v[i].y * v[i].y + v[i].z * v[i].z + v[i].w * v[i].w;
    }
    ss = wave_sum(ss);
    float rs = rsqrtf(ss * (1.f / 1024.f) + 1e-6f);
    int mr = a < CTX ? 8 : b;
    const float* sh = mod + (size_t)(layer * 9 + mr) * 6144 + (which * 3 + 0) * 1024;
    const float* scl = mod + (size_t)(layer * 9 + mr) * 6144 + (which * 3 + 1) * 1024;
#pragma unroll
    for (int i = 0; i < 4; ++i) {
      int k = i * 256 + lane * 4;
      float4 g = *(const float4*)(ng + k);
      float4 s4 = *(const float4*)(sh + k);
      float4 c4 = *(const float4*)(scl + k);
      float o0 = v[i].x * rs * g.x * (1.f + c4.x) + s4.x;
      float o1 = v[i].y * rs * g.y * (1.f + c4.y) + s4.y;
      float o2 = v[i].z * rs * g.z * (1.f + c4.z) + s4.z;
      float o3 = v[i].w * rs * g.w * (1.f + c4.w) + s4.w;
      uint2 o;
      o.x = pack2(o0, o1);
      o.y = pack2(o2, o3);
      *(uint2*)(H + (size_t)R * 1024 + k) = o;
    }
  }
}

namespace pg8 {
#define PG8_LAS __attribute__((address_space(3)))
typedef float f32x2 __attribute__((ext_vector_type(2)));
typedef unsigned u32x4 __attribute__((ext_vector_type(4)));
constexpr int BM = 256, BK = 64, HALF = 128, HTB = HALF * BK * 2, STAGE_BYTES = 8 * HTB, NXCD = 8, WGM = 8;
__device__ __forceinline__ int lds_byte(int r, int c) { const int st = (r >> 4) * 2 + (c >> 5), rr = r & 15, cc = c & 31, ob = rr * 64 + cc * 2; return st * 1024 + (ob ^ (((ob >> 9) & 1) << 5)); }
__device__ __forceinline__ void stage_rc(int b, int& R, int& C) { const int st = b / 1024, sb = b % 1024, swz = sb ^ (((sb >> 9) & 1) << 5); R = (st >> 1) * 16 + swz / 64; C = (st & 1) * 32 + (swz % 64) / 2; }
__device__ __forceinline__ int perm32(int rho) { const int n = rho >> 4, i = rho & 15; return 8 * (i >> 2) + 4 * n + (i & 3); }
struct Unit { int pm, pn; };
struct Gemm { const bf* A; const bf* Bt; int K; };
struct Order {
  int nM, nN, nwg, G, c, latonly;
  __device__ void init(int nM_, int nN_, int G_, int c_, int lat) { nM = nM_; nN = nN_; nwg = nM * nN; G = G_; c = c_; latonly = lat; }
  __device__ bool next(int i, Unit& u) const {
    const long L = (long)i * G + c;
    if (L >= nwg) return false;
    int wgid = (int)L;
    { const int q = nwg / NXCD, r = nwg % NXCD, xcd = wgid % NXCD, off = wgid / NXCD; wgid = (xcd < r ? xcd * (q + 1) : r * (q + 1) + (xcd - r) * q) + off; }
    const int nig = WGM * nN, gid = wgid / nig, fm = gid * WGM, gsz = (nM - fm) < WGM ? (nM - fm) : WGM;
    int pm = fm + ((wgid % nig) % gsz);
    u.pn = (wgid % nig) / gsz;
    u.pm = latonly ? ((pm >> 4) * 17 + 1 + (pm & 15)) : pm;
    return true;
  }
};
__device__ __forceinline__ unsigned cvt_pk_bf16(float lo, float hi) { return pack2(lo, hi); }

template <int EPI>
struct Epi {
  static constexpr bool PERM = (EPI == 0 || EPI == 1 || EPI == 3);
  P p;
  int layer;
  __device__ __forceinline__ void operator()(const f32x4 (&acc)[2][2][4][2], const Unit& u, int wr, int wc, int fr, int fq) const {
#pragma unroll
    for (int ai = 0; ai < 2; ++ai)
#pragma unroll
      for (int m = 0; m < 4; ++m) {
        const int row = u.pm * BM + ai * HALF + wr * 64 + m * 16 + fr;
        if constexpr (PERM) {
#pragma unroll
          for (int bj = 0; bj < 2; ++bj) {
            const int c0 = u.pn * BM + bj * HALF + wc * 32 + 8 * fq;
            f32x4 v0 = acc[ai][bj][m][0], v1 = acc[ai][bj][m][1];
            if constexpr (EPI == 3) {
#pragma unroll
              for (int j = 0; j < 4; ++j) { float a = v0[j] > 0.f ? v0[j] : 0.f; v0[j] = a * a; float b2 = v1[j] > 0.f ? v1[j] : 0.f; v1[j] = b2 * b2; }
            }
            u32x4 w;
            w.x = cvt_pk_bf16(v0[0], v0[1]); w.y = cvt_pk_bf16(v0[2], v0[3]); w.z = cvt_pk_bf16(v1[0], v1[1]); w.w = cvt_pk_bf16(v1[2], v1[3]);
            if constexpr (EPI == 0) {
              bf* dst = c0 < 1536 ? (bf*)(p.ws + OFF_QKV) + (size_t)row * 1536 + c0 : (bf*)p.out + (size_t)row * 1792 + (c0 - 1536);
              *(u32x4*)dst = w;
            } else if constexpr (EPI == 1) {
              if (c0 < 512) *(u32x4*)((bf*)(p.ws + OFF_P1C) + (size_t)row * 2080 + c0) = w;
              else if (c0 < 1536) *(u32x4*)((bf*)(p.ws + OFF_XRAW) + (size_t)row * 1024 + (c0 - 512)) = w;
              else if (c0 < 1552) { float* d = (float*)(p.ws + OFF_DTRAW) + (size_t)row * 16 + (c0 - 1536); *(f32x4*)d = v0; *(f32x4*)(d + 4) = v1; }
              else if (c0 < 3104) *(u32x4*)((bf*)(p.ws + OFF_P1C) + (size_t)row * 2080 + (c0 - 1024)) = w;
            } else {
              *(u32x4*)((bf*)(p.ws + OFF_HID) + (size_t)row * 4096 + c0) = w;
            }
          }
        } else {
          const float* gate = (const float*)(p.ws + OFF_MOD) + (size_t)(layer * 9 + mrow(row)) * 6144 + (EPI == 2 ? 2 : 5) * 1024;
          float* xr = xrow(p, row);
          const float* br = (EPI == 2 && layer == 0) ? inrow(p, row) : xr;
#pragma unroll
          for (int bj = 0; bj < 2; ++bj)
#pragma unroll
            for (int n = 0; n < 2; ++n) {
              const int c = u.pn * BM + bj * HALF + wc * 32 + 16 * n + 4 * fq;
              f32x4 gt = *(const f32x4*)(gate + c);
              f32x4 bs = *(const f32x4*)(br + c);
              *(f32x4*)(xr + c) = bs + gt * acc[ai][bj][m][n];
            }
        }
      }
  }
};

template <class EpiT>
__device__ __forceinline__ void gemm_phase(PG8_LAS unsigned char* lds, const Gemm g, const Order& S, const EpiT& E) {
  const int tid = tidx(), wid = __builtin_amdgcn_readfirstlane(tid >> 6), lane = tid & 63, wr = wid >> 2, wc = wid & 3, fr = lane & 15, fq = lane >> 4;
  const int K = g.K, nt = K / BK;
  unsigned voffA[2], voffB[2];
#pragma unroll
  for (int i = 0; i < 2; ++i) { int R, C; stage_rc(tid * 16 + i * 8192, R, C); const int Rb = EpiT::PERM ? ((R & ~31) + perm32(R & 31)) : R;
    voffA[i] = (unsigned)(R * K + C) * 2u; voffB[i] = (unsigned)(Rb * K + C) * 2u; }
  const size_t kstep = (size_t)(BK * 2);
  const size_t hstep = (size_t)HALF * K * 2;
  const size_t tstep = 2 * hstep;
  const unsigned ldsw = (unsigned)wid * 1024u;
  const int aoff = lds_byte(wr * 64 + fr, fq * 8), boff = lds_byte(wc * 32 + fr, fq * 8);
#define PG8_SA(b, h) (((b) * 2 + (h)) * HTB)
#define PG8_SB(b, h) ((4 + (b) * 2 + (h)) * HTB)
#define PG8_STAGE(bufoff, gbase, voff) do { _Pragma("unroll") for (int _i = 0; _i < 2; ++_i) \
        __builtin_amdgcn_global_load_lds((const unsigned*)((const char*)(gbase) + (voff)[_i]), (PG8_LAS unsigned*)(lds + (bufoff) + ldsw + _i * 8192), 16, 0, 0); } while (0)
#define PG8_LDA(dst, b, h) do { _Pragma("unroll") for (int m = 0; m < 4; ++m) _Pragma("unroll") for (int k = 0; k < 2; ++k) dst[m][k] = *(const PG8_LAS bf16x8*)(lds + PG8_SA(b, h) + aoff + m * 2048 + k * 1024); } while (0)
#define PG8_LDB(dst, b, h) do { _Pragma("unroll") for (int n = 0; n < 2; ++n) _Pragma("unroll") for (int k = 0; k < 2; ++k) dst[n][k] = *(const PG8_LAS bf16x8*)(lds + PG8_SB(b, h) + boff + n * 2048 + k * 1024); } while (0)
#define PG8_MMA(ai, bj, At, Bt) do { __builtin_amdgcn_s_setprio(1); _Pragma("unroll") for (int m = 0; m < 4; ++m) _Pragma("unroll") for (int n = 0; n < 2; ++n) _Pragma("unroll") for (int k = 0; k < 2; ++k) \
        acc[ai][bj][m][n] = __builtin_amdgcn_mfma_f32_16x16x32_bf16(Bt[n][k], At[m][k], acc[ai][bj][m][n], 0, 0, 0); __builtin_amdgcn_s_setprio(0); } while (0)
#define PG8_WAIT_V(n) asm volatile("s_waitcnt vmcnt(" #n ")" ::: "memory")
#define PG8_WAIT_L(n) asm volatile("s_waitcnt lgkmcnt(" #n ")" ::: "memory")
#define PG8_BAR __builtin_amdgcn_s_barrier()
#define PG8_SCHED __builtin_amdgcn_sched_barrier(0)
  Unit cur, nxt; int ui = 0;
  if (!S.next(0, cur)) return;
  f32x4 acc[2][2][4][2];
#pragma unroll
  for (int a = 0; a < 2; ++a)
#pragma unroll
    for (int b = 0; b < 2; ++b)
#pragma unroll
      for (int m = 0; m < 4; ++m)
#pragma unroll
        for (int n = 0; n < 2; ++n) acc[a][b][m][n] = (f32x4){0.f, 0.f, 0.f, 0.f};
  bf16x8 At[4][2], B0[2][2], B1[2][2];
  const char* cA = (const char*)g.A + (size_t)cur.pm * tstep; const char* cB = (const char*)g.Bt + (size_t)cur.pn * tstep;
  PG8_STAGE(PG8_SB(0, 0), cB, voffB); PG8_STAGE(PG8_SA(0, 0), cA, voffA); PG8_STAGE(PG8_SB(0, 1), cB + hstep, voffB); PG8_STAGE(PG8_SA(0, 1), cA + hstep, voffA);
  if (wr == 1) PG8_BAR;
  PG8_WAIT_V(4); PG8_BAR;
  PG8_STAGE(PG8_SB(1, 0), cB + kstep, voffB); PG8_STAGE(PG8_SA(1, 0), cA + kstep, voffA); PG8_STAGE(PG8_SB(1, 1), cB + hstep + kstep, voffB);
  PG8_WAIT_V(6); PG8_BAR;
  for (;;) {
    const bool has_next = S.next(ui + 1, nxt);
    const char* nA = has_next ? (const char*)g.A + (size_t)nxt.pm * tstep : cA; const char* nB = has_next ? (const char*)g.Bt + (size_t)nxt.pn * tstep : cB;
    for (int t = 0; t < nt; t += 2) {
      const bool last = (t == nt - 2);
      const char* a1 = cA + (size_t)(t + 1) * kstep;
      const char* a2 = last ? nA : cA + (size_t)(t + 2) * kstep; const char* b2 = last ? nB : cB + (size_t)(t + 2) * kstep;
      const char* a3 = a2 + kstep; const char* b3 = b2 + kstep;
      PG8_LDB(B0, 0, 0); PG8_SCHED; PG8_LDA(At, 0, 0); PG8_STAGE(PG8_SA(1, 1), a1 + hstep, voffA);
      PG8_WAIT_L(8); PG8_BAR; PG8_WAIT_L(0); PG8_MMA(0, 0, At, B0); PG8_BAR; PG8_SCHED;
      PG8_LDB(B1, 0, 1); PG8_STAGE(PG8_SB(0, 0), b2, voffB);
      PG8_BAR; PG8_WAIT_L(0); PG8_MMA(0, 1, At, B1); PG8_BAR;
      PG8_LDA(At, 0, 1); PG8_STAGE(PG8_SA(0, 0), a2, voffA);
      PG8_BAR; PG8_WAIT_L(0); PG8_MMA(1, 0, At, B0); PG8_BAR; PG8_SCHED;
      PG8_STAGE(PG8_SB(0, 1), b2 + hstep, voffB);
      PG8_WAIT_V(6); PG8_BAR; PG8_MMA(1, 1, At, B1); PG8_BAR;
      PG8_LDB(B0, 1, 0); PG8_SCHED; PG8_LDA(At, 1, 0); PG8_STAGE(PG8_SA(0, 1), a2 + hstep, voffA);
      PG8_WAIT_L(8); PG8_BAR; PG8_WAIT_L(0); PG8_MMA(0, 0, At, B0); PG8_BAR; PG8_SCHED;
      PG8_LDB(B1, 1, 1); PG8_STAGE(PG8_SB(1, 0), b3, voffB);
      PG8_BAR; PG8_WAIT_L(0); PG8_MMA(0, 1, At, B1); PG8_BAR;
      PG8_LDA(At, 1, 1); PG8_STAGE(PG8_SA(1, 0), a3, voffA);
      PG8_BAR; PG8_WAIT_L(0); PG8_MMA(1, 0, At, B0); PG8_BAR; PG8_SCHED;
      PG8_STAGE(PG8_SB(1, 1), b3 + hstep, voffB);
      PG8_WAIT_V(6); PG8_BAR; PG8_MMA(1, 1, At, B1); PG8_BAR;
    }
    E(acc, cur, wr, wc, fr, fq);
    if (!has_next) break;
#pragma unroll
    for (int a = 0; a < 2; ++a)
#pragma unroll
      for (int b = 0; b < 2; ++b)
#pragma unroll
        for (int m = 0; m < 4; ++m)
#pragma unroll
          for (int n = 0; n < 2; ++n) acc[a][b][m][n] = (f32x4){0.f, 0.f, 0.f, 0.f};
    cur = nxt; cA = nA; cB = nB; ++ui;
  }
  PG8_WAIT_V(0);
  if (wr == 0) PG8_BAR;
  PG8_BAR;
#undef PG8_SA
#undef PG8_SB
#undef PG8_STAGE
#undef PG8_LDA
#undef PG8_LDB
#undef PG8_MMA
#undef PG8_WAIT_V
#undef PG8_WAIT_L
#undef PG8_BAR
#undef PG8_SCHED
}
}

template <int EPI>
__device__ __forceinline__ void ph_gemm(const P& p, const bf* A, const bf* Bt, int K, int nN, int layer, int latonly, char* smem) {
  pg8::Order S;
  S.init(latonly ? 128 : 136, nN, gridDim.x, blockIdx.x, latonly);
  pg8::Epi<EPI> E{p, layer};
  pg8::Gemm g{A, Bt, K};
  __syncthreads();
  pg8::gemm_phase(( __attribute__((address_space(3))) unsigned char*)smem, g, S, E);
  __syncthreads();
}

__device__ __forceinline__ void ph_rope(const P& p, char* smem) {
  float* tcos = (float*)smem;
  float* tsin = tcos + 1024;
  const int tid = tidx();
  __syncthreads();
  for (int i = tid; i < 1024; i += NT) {
    int c = i >> 4, f = i & 15;
    float inv = powf(10000.f, -(float)f / 16.f);
    float ang = (float)c * inv;
    float sn, cs;
    sincosf(ang, &sn, &cs);
    tcos[i] = cs;
    tsin[i] = sn;
  }
  __syncthreads();
  bf* QKV = (bf*)(p.ws + OFF_QKV);
  for (int it = blockIdx.x * NT + tid; it < RT * 32; it += gridDim.x * NT) {
    int R = it >> 5;
    int vec = (it >> 1) & 15, half = it & 1;
    int b = R / TA, a = R - b * TA;
    bool isq = vec < 8;
    if (!isq && a < CTX) continue;
    bf* ptr = QKV + (size_t)R * 1536 + vec * 64 + half * 32;
    uint4 a0 = *(const uint4*)ptr, a1 = *(const uint4*)(ptr + 8), b0 = *(const uint4*)(ptr + 16), b1 = *(const uint4*)(ptr + 24);
    float x1[16], x2[16];
    x1[0] = bflo(a0.x); x1[1] = bfhi(a0.x); x1[2] = bflo(a0.y); x1[3] = bfhi(a0.y); x1[4] = bflo(a0.z); x1[5] = bfhi(a0.z); x1[6] = bflo(a0.w); x1[7] = bfhi(a0.w);
    x1[8] = bflo(a1.x); x1[9] = bfhi(a1.x); x1[10] = bflo(a1.y); x1[11] = bfhi(a1.y); x1[12] = bflo(a1.z); x1[13] = bfhi(a1.z); x1[14] = bflo(a1.w); x1[15] = bfhi(a1.w);
    x2[0] = bflo(b0.x); x2[1] = bfhi(b0.x); x2[2] = bflo(b0.y); x2[3] = bfhi(b0.y); x2[4] = bflo(b0.z); x2[5] = bfhi(b0.z); x2[6] = bflo(b0.w); x2[7] = bfhi(b0.w);
    x2[8] = bflo(b1.x); x2[9] = bfhi(b1.x); x2[10] = bflo(b1.y); x2[11] = bfhi(b1.y); x2[12] = bflo(b1.z); x2[13] = bfhi(b1.z); x2[14] = bflo(b1.w); x2[15] = bfhi(b1.w);
    const float qs = isq ? 0.125f : 1.f;
    if (a >= CTX) {
      int pos = a - CTX;
      int cidx = half == 0 ? (pos >> 6) : (pos & 63);
#pragma unroll
      for (int f = 0; f < 16; ++f) {
        float cs = tcos[cidx * 16 + f], sn = tsin[cidx * 16 + f];
        float y1 = x1[f] * cs - x2[f] * sn, y2 = x2[f] * cs + x1[f] * sn;
        x1[f] = y1 * qs;
        x2[f] = y2 * qs;
      }
    } else {
#pragma unroll
      for (int f = 0; f < 16; ++f) { x1[f] *= qs; x2[f] *= qs; }
    }
    uint4 o;
    o.x = pack2(x1[0], x1[1]); o.y = pack2(x1[2], x1[3]); o.z = pack2(x1[4], x1[5]); o.w = pack2(x1[6], x1[7]); *(uint4*)ptr = o;
    o.x = pack2(x1[8], x1[9]); o.y = pack2(x1[10], x1[11]); o.z = pack2(x1[12], x1[13]); o.w = pack2(x1[14], x1[15]); *(uint4*)(ptr + 8) = o;
    o.x = pack2(x2[0], x2[1]); o.y = pack2(x2[2], x2[3]); o.z = pack2(x2[4], x2[5]); o.w = pack2(x2[6], x2[7]); *(uint4*)(ptr + 16) = o;
    o.x = pack2(x2[8], x2[9]); o.y = pack2(x2[10], x2[11]); o.z = pack2(x2[12], x2[13]); o.w = pack2(x2[14], x2[15]); *(uint4*)(ptr + 24) = o;
  }
}

__device__ __forceinline__ float shiftmix(const bf* PB, const float* mu, int R, int a, int col) {
  int lo = a < CTX ? 0 : CTX, hi = a < CTX ? CTX : TA;
  float t = bf2f(PB[(size_t)R * 1792 + col]);
  float pv = a > lo ? bf2f(PB[(size_t)(R - 1) * 1792 + col]) : 0.f;
  float nx = a + 1 < hi ? bf2f(PB[(size_t)(R + 1) * 1792 + col]) : 0.f;
  return t + (0.5f * (pv + nx) - t) * mu[col];
}
__device__ __forceinline__ void ph_lw(const P& p) {
  bf* LW = (bf*)(p.ws + OFF_LW);
  const float *w2f = p.in[19], *w2b = p.in[21], *a2 = p.in[23], *g2 = p.in[24];
  for (int i = blockIdx.x * NT + tidx(); i < 512 * 320; i += gridDim.x * NT) {
    int n = i / 320, kk = i - n * 320;
    float v = kk < 64 ? w2f[kk * 512 + n] : kk < 128 ? w2b[(kk - 64) * 512 + n] : kk < 192 ? a2[(kk - 128) * 512 + n] : g2[(kk - 192) * 512 + n];
    LW[i] = f2bf(v);
  }
}
__device__ __forceinline__ void ph_rwkv_prep(const P& p, char* smem) {
  bf* linA = (bf*)smem;
  const int tid = tidx(), lane = tid & 63, wave = tid >> 6;
  const int l15 = lane & 15, g = lane >> 4;
  const bf* PB = (const bf*)p.out;
  const bf* LW = (const bf*)(p.ws + OFF_LW);
  const float* mu = p.in[17];
  bf* PR = (bf*)(p.ws + OFF_PREP);
  bf* PK = PR + (size_t)RT * 512;
  bf* PV = PK + (size_t)RT * 512;
  bf* PKK = PV + (size_t)RT * 512;
  bf* PKA = PKK + (size_t)RT * 512;
  bf* PLF = PKA + (size_t)RT * 512;
  bf* PLB = PLF + (size_t)RT * 512;
  bf* G = (bf*)(p.ws + OFF_G);
  float* BON = (float*)(p.ws + OFF_BONUS);
  float cw0f[4], cw0b[4], ca0[4], ckk[4], cka[4], crk[4];
#pragma unroll
  for (int nt = 0; nt < 4; ++nt) {
    int c = wave * 64 + nt * 16 + l15;
    cw0f[nt] = p.in[18][c]; cw0b[nt] = p.in[20][c]; ca0[nt] = p.in[22][c]; ckk[nt] = p.in[25][c]; cka[nt] = p.in[26][c]; crk[nt] = p.in[27][c];
  }
  for (int unit = blockIdx.x; unit < RT / 16; unit += gridDim.x) {
    const int R0 = unit * 16;
    const int b = R0 / TA, a00 = R0 - b * TA;
    __syncthreads();
#pragma unroll
    for (int i = 0; i < 8; ++i) {
      int idx = tid + NT * i;
      int tok = idx >> 8, j = idx & 255;
      float f = shiftmix(PB, mu, R0 + tok, a00 + tok, 1536 + j);
      float val = j < 64 ? tanhf(f) : (j < 128 ? f : sigmoidf_(f));
      linA[tok * 264 + j] = f2bf(val);
    }
    __syncthreads();
    f32x4 wf[4], wb[4], aa[4], gg[4];
#pragma unroll
    for (int nt = 0; nt < 4; ++nt) {
      wf[nt] = (f32x4){0.f, 0.f, 0.f, 0.f}; wb[nt] = wf[nt]; aa[nt] = wf[nt]; gg[nt] = wf[nt];
    }
#pragma unroll
    for (int nt = 0; nt < 4; ++nt) {
      const bf* lw = LW + (size_t)(wave * 64 + nt * 16 + l15) * 320 + g * 8;
#pragma unroll
      for (int ks = 0; ks < 2; ++ks) {
        bf16x8 aw = *(const bf16x8*)(linA + l15 * 264 + ks * 32 + g * 8);
        wf[nt] = __builtin_amdgcn_mfma_f32_16x16x32_bf16(aw, *(const bf16x8*)(lw + ks * 32), wf[nt], 0, 0, 0);
        wb[nt] = __builtin_amdgcn_mfma_f32_16x16x32_bf16(aw, *(const bf16x8*)(lw + 64 + ks * 32), wb[nt], 0, 0, 0);
        bf16x8 a_a = *(const bf16x8*)(linA + l15 * 264 + 64 + ks * 32 + g * 8);
        aa[nt] = __builtin_amdgcn_mfma_f32_16x16x32_bf16(a_a, *(const bf16x8*)(lw + 128 + ks * 32), aa[nt], 0, 0, 0);
      }
#pragma unroll
      for (int ks = 0; ks < 4; ++ks) {
        bf16x8 ag = *(const bf16x8*)(linA + l15 * 264 + 128 + ks * 32 + g * 8);
        gg[nt] = __builtin_amdgcn_mfma_f32_16x16x32_bf16(ag, *(const bf16x8*)(lw + 192 + ks * 32), gg[nt], 0, 0, 0);
      }
    }
#pragma unroll
    for (int r = 0; r < 4; ++r) {
      const int R = R0 + g * 4 + r, a = a00 + g * 4 + r;
      float fr[4], fv[4], kkv[4], km[4], av[4];
      float n2 = 0.f, bon = 0.f;
#pragma unroll
      for (int nt = 0; nt < 4; ++nt) {
        int c = wave * 64 + nt * 16 + l15;
        fr[nt] = shiftmix(PB, mu, R, a, c);
        float fk = shiftmix(PB, mu, R, a, 512 + c);
        fv[nt] = shiftmix(PB, mu, R, a, 1024 + c);
        av[nt] = sigmoidf_(ca0[nt] + aa[nt][r]);
        kkv[nt] = fk * ckk[nt];
        n2 += kkv[nt] * kkv[nt];
        km[nt] = fk * (1.f + (av[nt] - 1.f) * cka[nt]);
        bon += fr[nt] * km[nt] * crk[nt];
      }
      n2 = red16(n2);
      bon = red16(bon);
      float rn = 1.f / fmaxf(sqrtf(n2), 1e-12f);
#pragma unroll
      for (int nt = 0; nt < 4; ++nt) {
        int c = wave * 64 + nt * 16 + l15;
        size_t o = (size_t)R * 512 + c;
        float lwf = -__expf(-softplusf_(-(cw0f[nt] + wf[nt][r])) - 0.5f);
        float lwb = -__expf(-softplusf_(-(cw0b[nt] + wb[nt][r])) - 0.5f);
        float kk = kkv[nt] * rn;
        PR[o] = f2bf(fr[nt]);
        PK[o] = f2bf(km[nt]);
        PV[o] = f2bf(fv[nt]);
        PKK[o] = f2bf(kk);
        PKA[o] = f2bf(kk * av[nt]);
        PLF[o] = f2bf(lwf);
        PLB[o] = f2bf(lwb);
        G[o] = f2bf(gg[nt][r]);
      }
      if (l15 == 0) BON[(size_t)R * 8 + wave] = bon;
    }
  }
}

__device__ __forceinline__ int scan_row(int b, int dir, int s) {
  int a = dir ? (s < CTX ? CTX - 1 - s : TA + CTX - 1 - s) : s;
  return b * TA + a;
}

__device__ __forceinline__ void rwkv_chain(const P& p, int chain, int half, char* smem) {
  const int dir = chain & 1, h = (chain >> 1) & 7, b = chain >> 4;
  float* cR = (float*)smem;
  float* cW = cR + 2048;
  float* cK = cW + 2048;
  float* cKK = cK + 2048;
  float* cKA = cKK + 2048;
  float* cV = cKA + 2048;
  float* yb = cV + 2048;
  const int tid = tidx(), lane = tid & 63, wave = tid >> 6;
  const int l15 = lane & 15, lg = lane >> 4;
  const bf* PR = (const bf*)(p.ws + OFF_PREP);
  const bf* PK = PR + (size_t)RT * 512;
  const bf* PV = PK + (size_t)RT * 512;
  const bf* PKK = PV + (size_t)RT * 512;
  const bf* PKA = PKK + (size_t)RT * 512;
  const bf* PLW = PKA + (size_t)RT * 512 + (size_t)dir * RT * 512;
  bf* Y = (bf*)p.out + (size_t)dir * RT * 512;
  const int st = tid >> 4, c4 = (tid & 15) * 4;
  const int r0 = half < 0 ? wave * 8 + lg * 2 : half * 32 + (wave & 3) * 8 + lg * 2;
  const bool active = half < 0 || wave < 4;
  const bool ywr = half < 0 || ((c4 >> 5) == half);
  float s0[4], s1[4];
#pragma unroll
  for (int j = 0; j < 4; ++j) { s0[j] = 0.f; s1[j] = 0.f; }
  uint2 gR, gW, gK, gV, gKK, gKA;
  {
    size_t o = (size_t)scan_row(b, dir, st) * 512 + h * 64 + c4;
    gR = *(const uint2*)(PR + o); gW = *(const uint2*)(PLW + o); gK = *(const uint2*)(PK + o);
    gV = *(const uint2*)(PV + o); gKK = *(const uint2*)(PKK + o); gKA = *(const uint2*)(PKA + o);
  }
  const int NCH = TA / 32;
  for (int ch = 0; ch <= NCH; ++ch) {
    __syncthreads();
    if (ch > 0 && ywr) {
      float4 y4 = *(const float4*)(yb + st * 64 + c4);
      uint2 o2;
      o2.x = pack2(y4.x, y4.y);
      o2.y = pack2(y4.z, y4.w);
      *(uint2*)(Y + (size_t)scan_row(b, dir, (ch - 1) * 32 + st) * 512 + h * 64 + c4) = o2;
    }
    if (ch == NCH) break;
    {
      int o = st * 64 + c4;
      *(float4*)(cR + o) = make_float4(bflo(gR.x), bfhi(gR.x), bflo(gR.y), bfhi(gR.y));
      *(float4*)(cW + o) = make_float4(__expf(bflo(gW.x)), __expf(bfhi(gW.x)), __expf(bflo(gW.y)), __expf(bfhi(gW.y)));
      *(float4*)(cK + o) = make_float4(bflo(gK.x), bfhi(gK.x), bflo(gK.y), bfhi(gK.y));
      *(float4*)(cV + o) = make_float4(bflo(gV.x), bfhi(gV.x), bflo(gV.y), bfhi(gV.y));
      *(float4*)(cKK + o) = make_float4(bflo(gKK.x), bfhi(gKK.x), bflo(gKK.y), bfhi(gKK.y));
      *(float4*)(cKA + o) = make_float4(bflo(gKA.x), bfhi(gKA.x), bflo(gKA.y), bfhi(gKA.y));
    }
    __syncthreads();
    if (ch + 1 < NCH) {
      size_t o = (size_t)scan_row(b, dir, (ch + 1) * 32 + st) * 512 + h * 64 + c4;
      gR = *(const uint2*)(PR + o); gW = *(const uint2*)(PLW + o); gK = *(const uint2*)(PK + o);
      gV = *(const uint2*)(PV + o); gKK = *(const uint2*)(PKK + o); gKA = *(const uint2*)(PKA + o);
    }
    if (active) {
      float4 kk4 = *(const float4*)(cKK + l15 * 4);
      float4 w4 = *(const float4*)(cW + l15 * 4);
      float4 k4 = *(const float4*)(cK + l15 * 4);
      float4 ka4 = *(const float4*)(cKA + l15 * 4);
      float4 r4 = *(const float4*)(cR + l15 * 4);
      float2 v2 = *(const float2*)(cV + r0);
#pragma unroll 2
      for (int t = 0; t < 32; ++t) {
        const int tn = (t + 1) & 31;
        float4 nkk4 = *(const float4*)(cKK + tn * 64 + l15 * 4);
        float4 nw4 = *(const float4*)(cW + tn * 64 + l15 * 4);
        float4 nk4 = *(const float4*)(cK + tn * 64 + l15 * 4);
        float4 nka4 = *(const float4*)(cKA + tn * 64 + l15 * 4);
        float4 nr4 = *(const float4*)(cR + tn * 64 + l15 * 4);
        float2 nv2 = *(const float2*)(cV + tn * 64 + r0);
        float sa0 = (s0[0] * kk4.x + s0[1] * kk4.y) + (s0[2] * kk4.z + s0[3] * kk4.w);
        float sa1 = (s1[0] * kk4.x + s1[1] * kk4.y) + (s1[2] * kk4.z + s1[3] * kk4.w);
        float p00 = s0[0] * w4.x + v2.x * k4.x, p01 = s0[1] * w4.y + v2.x * k4.y, p02 = s0[2] * w4.z + v2.x * k4.z, p03 = s0[3] * w4.w + v2.x * k4.w;
        float p10 = s1[0] * w4.x + v2.y * k4.x, p11 = s1[1] * w4.y + v2.y * k4.y, p12 = s1[2] * w4.z + v2.y * k4.z, p13 = s1[3] * w4.w + v2.y * k4.w;
        sa0 = red16(sa0);
        sa1 = red16(sa1);
        s0[0] = p00 - sa0 * ka4.x; s0[1] = p01 - sa0 * ka4.y; s0[2] = p02 - sa0 * ka4.z; s0[3] = p03 - sa0 * ka4.w;
        s1[0] = p10 - sa1 * ka4.x; s1[1] = p11 - sa1 * ka4.y; s1[2] = p12 - sa1 * ka4.z; s1[3] = p13 - sa1 * ka4.w;
        float y0 = (s0[0] * r4.x + s0[1] * r4.y) + (s0[2] * r4.z + s0[3] * r4.w);
        float y1 = (s1[0] * r4.x + s1[1] * r4.y) + (s1[2] * r4.z + s1[3] * r4.w);
        y0 = red16(y0);
        y1 = red16(y1);
        if (l15 == 0) *(float2*)(yb + t * 64 + r0) = make_float2(y0, y1);
        kk4 = nkk4; w4 = nw4; k4 = nk4; ka4 = nka4; r4 = nr4; v2 = nv2;
      }
    }
  }
}


template <int OFFB>
__device__ __forceinline__ bf16x8 tr_pair(const bf* pp) {
  typedef short s16x4_ __attribute__((ext_vector_type(4)));
  s16x4_ v0, v1;
  unsigned addr = (unsigned)(size_t)(__attribute__((address_space(3))) const void*)pp;
  asm volatile("s_waitcnt lgkmcnt(0)\n\tds_read_b64_tr_b16 %0, %2\n\tds_read_b64_tr_b16 %1, %2 offset:%3\n\ts_waitcnt lgkmcnt(0)" : "=&v"(v0), "=&v"(v1) : "v"(addr), "n"(OFFB) : "memory");
  return __builtin_shufflevector(v0, v1, 0, 1, 2, 3, 4, 5, 6, 7);
}
template <int STRB, int OFF2B>
__device__ __forceinline__ void tr_quad(const bf* pp, bf16x8& f0, bf16x8& f1, bf16x8& f2, bf16x8& f3) {
  typedef short s16x4_ __attribute__((ext_vector_type(4)));
  s16x4_ a0, b0, a1, b1, a2, b2, a3, b3;
  unsigned addr = (unsigned)(size_t)(__attribute__((address_space(3))) const void*)pp;
  asm volatile(
      "s_waitcnt lgkmcnt(0)\n\t"
      "ds_read_b64_tr_b16 %0, %8\n\t"
      "ds_read_b64_tr_b16 %1, %8 offset:%9\n\t"
      "ds_read_b64_tr_b16 %2, %8 offset:%10\n\t"
      "ds_read_b64_tr_b16 %3, %8 offset:%11\n\t"
      "ds_read_b64_tr_b16 %4, %8 offset:%12\n\t"
      "ds_read_b64_tr_b16 %5, %8 offset:%13\n\t"
      "ds_read_b64_tr_b16 %6, %8 offset:%14\n\t"
      "ds_read_b64_tr_b16 %7, %8 offset:%15\n\t"
      "s_waitcnt lgkmcnt(0)"
      : "=&v"(a0), "=&v"(b0), "=&v"(a1), "=&v"(b1), "=&v"(a2), "=&v"(b2), "=&v"(a3), "=&v"(b3)
      : "v"(addr), "n"(OFF2B), "n"(STRB), "n"(STRB + OFF2B), "n"(2 * STRB), "n"(2 * STRB + OFF2B), "n"(3 * STRB), "n"(3 * STRB + OFF2B)
      : "memory");
  f0 = __builtin_shufflevector(a0, b0, 0, 1, 2, 3, 4, 5, 6, 7);
  f1 = __builtin_shufflevector(a1, b1, 0, 1, 2, 3, 4, 5, 6, 7);
  f2 = __builtin_shufflevector(a2, b2, 0, 1, 2, 3, 4, 5, 6, 7);
  f3 = __builtin_shufflevector(a3, b3, 0, 1, 2, 3, 4, 5, 6, 7);
}
typedef short s16x4 __attribute__((ext_vector_type(4)));
__device__ __forceinline__ void attn_unit(const P& p, int u, char* smem, float lam) {
  bf* Ks = (bf*)smem;
  bf* Vs = Ks + 64 * 136;
  int b, h, nkeys, qa0;
  if (u < 1024) { b = u >> 7; h = (u >> 5) & 3; nkeys = TA; qa0 = CTX + (u & 31) * 128; }
  else { int v = u - 1024; b = v >> 3; h = (v >> 1) & 3; nkeys = CTX; qa0 = (v & 1) * 128; }
  const bf* QKV = (const bf*)(p.ws + OFF_QKV);
  const int tid = tidx(), lane = tid & 63, wave = tid >> 6;
  const int l15 = lane & 15, lg = lane >> 4;
  const size_t rowbase = (size_t)b * TA;
  bf16x8 qf[2][2];
  {
    size_t Rq = rowbase + qa0 + wave * 16 + l15;
#pragma unroll
    for (int m = 0; m < 2; ++m)
#pragma unroll
      for (int ks = 0; ks < 2; ++ks) qf[m][ks] = *(const bf16x8*)(QKV + Rq * 1536 + h * 128 + m * 64 + ks * 32 + lg * 8);
  }
  f32x4 oacc[2][8];
#pragma unroll
  for (int m = 0; m < 2; ++m)
#pragma unroll
    for (int n = 0; n < 8; ++n) oacc[m][n] = (f32x4){0.f, 0.f, 0.f, 0.f};
  float mrun[2] = {-INFINITY, -INFINITY}, lrun[2] = {0.f, 0.f};
  const int sr = tid >> 4, scc = tid & 15;
  const bf* gsrc = QKV + (rowbase + sr) * 1536 + h * 128 + scc * 8;
  uint4 pk0 = *(const uint4*)(gsrc + 512), pv0 = *(const uint4*)(gsrc + 1024);
  uint4 pk1 = *(const uint4*)(gsrc + (size_t)32 * 1536 + 512), pv1 = *(const uint4*)(gsrc + (size_t)32 * 1536 + 1024);
  const int vrow = lg * 4 + (l15 >> 2), vcol = (lane & 3) * 4;
  for (int k0 = 0; k0 < nkeys; k0 += 64) {
    __syncthreads();
    *(uint4*)(Ks + sr * 136 + scc * 8) = pk0;
    *(uint4*)(Ks + (sr + 32) * 136 + scc * 8) = pk1;
    *(uint4*)(Vs + sr * 144 + scc * 8) = pv0;
    *(uint4*)(Vs + (sr + 32) * 144 + scc * 8) = pv1;
    __syncthreads();
    if (k0 + 64 < nkeys) {
      const bf* g2 = gsrc + (size_t)(k0 + 64) * 1536;
      pk0 = *(const uint4*)(g2 + 512); pv0 = *(const uint4*)(g2 + 1024);
      pk1 = *(const uint4*)(g2 + (size_t)32 * 1536 + 512); pv1 = *(const uint4*)(g2 + (size_t)32 * 1536 + 1024);
    }
    bf16x8 pf[2][2];
#pragma unroll
    for (int m = 0; m < 2; ++m) {
      f32x4 s[4];
#pragma unroll
      for (int kt = 0; kt < 4; ++kt) s[kt] = (f32x4){0.f, 0.f, 0.f, 0.f};
#pragma unroll
      for (int ks = 0; ks < 2; ++ks)
#pragma unroll
        for (int kt = 0; kt < 4; ++kt) {
          bf16x8 a = *(const bf16x8*)(Ks + (kt * 16 + l15) * 136 + m * 64 + ks * 32 + lg * 8);
          s[kt] = __builtin_amdgcn_mfma_f32_16x16x32_bf16(a, qf[m][ks], s[kt], 0, 0, 0);
        }
      float mx = fmaxf(fmaxf(s[0][0], s[0][1]), fmaxf(s[0][2], s[0][3]));
#pragma unroll
      for (int kt = 1; kt < 4; ++kt) mx = fmaxf(mx, fmaxf(fmaxf(s[kt][0], s[kt][1]), fmaxf(s[kt][2], s[kt][3])));
      if (__any(mx > mrun[m] + 8.f)) {
        mx = fmaxf(mx, __shfl_xor(mx, 16));
        mx = fmaxf(mx, __shfl_xor(mx, 32));
        float mnew = fmaxf(mrun[m], mx);
        float alpha = __expf(mrun[m] - mnew);
        mrun[m] = mnew;
        lrun[m] *= alpha;
        float al[4];
#pragma unroll
        for (int r = 0; r < 4; ++r) al[r] = __shfl(alpha, lg * 4 + r);
#pragma unroll
        for (int n = 0; n < 8; ++n)
#pragma unroll
          for (int r = 0; r < 4; ++r) oacc[m][n][r] *= al[r];
      }
      const float mcur = mrun[m];
      float ps = 0.f;
#pragma unroll
      for (int kt = 0; kt < 4; ++kt)
#pragma unroll
        for (int r = 0; r < 4; ++r) {
          float e = __expf(s[kt][r] - mcur);
          s[kt][r] = e;
          ps += e;
        }
      lrun[m] += ps;
#pragma unroll
      for (int si = 0; si < 2; ++si) {
        i32x4 t;
        t[0] = (int)pack2(s[2 * si][0], s[2 * si][1]);
        t[1] = (int)pack2(s[2 * si][2], s[2 * si][3]);
        t[2] = (int)pack2(s[2 * si + 1][0], s[2 * si + 1][1]);
        t[3] = (int)pack2(s[2 * si + 1][2], s[2 * si + 1][3]);
        pf[m][si] = __builtin_bit_cast(bf16x8, t);
      }
    }
#pragma unroll
    for (int si = 0; si < 2; ++si)
#pragma unroll
      for (int nq = 0; nq < 2; ++nq) {
        bf16x8 bv[4];
        tr_quad<32, 16 * 144 * 2>(Vs + (si * 32 + vrow) * 144 + nq * 64 + vcol, bv[0], bv[1], bv[2], bv[3]);
#pragma unroll
        for (int n4 = 0; n4 < 4; ++n4) {
          oacc[0][nq * 4 + n4] = __builtin_amdgcn_mfma_f32_16x16x32_bf16(pf[0][si], bv[n4], oacc[0][nq * 4 + n4], 0, 0, 0);
          oacc[1][nq * 4 + n4] = __builtin_amdgcn_mfma_f32_16x16x32_bf16(pf[1][si], bv[n4], oacc[1][nq * 4 + n4], 0, 0, 0);
        }
      }
  }
  float inv[2];
#pragma unroll
  for (int m = 0; m < 2; ++m) {
    float l = lrun[m];
    l += __shfl_xor(l, 16);
    l += __shfl_xor(l, 32);
    inv[m] = 1.f / l;
  }
  float i1[4], i2[4];
#pragma unroll
  for (int r = 0; r < 4; ++r) { i1[r] = __shfl(inv[0], lg * 4 + r); i2[r] = __shfl(inv[1], lg * 4 + r); }
  float ss[4] = {0.f, 0.f, 0.f, 0.f};
#pragma unroll
  for (int n = 0; n < 8; ++n)
#pragma unroll
    for (int r = 0; r < 4; ++r) {
      float o = oacc[0][n][r] * i1[r] - lam * (oacc[1][n][r] * i2[r]);
      oacc[0][n][r] = o;
      ss[r] += o * o;
    }
  const float* subln = p.in[16];
  bf* O = (bf*)(p.ws + OFF_HO);
#pragma unroll
  for (int r = 0; r < 4; ++r) {
    float t = red16(ss[r]);
    float scl = rsqrtf(t * (1.f / 128.f) + 1e-5f) * 0.8f;
    size_t Ro = rowbase + qa0 + wave * 16 + lg * 4 + r;
#pragma unroll
    for (int n = 0; n < 8; ++n) O[Ro * 1024 + h * 128 + n * 16 + l15] = f2bf(oacc[0][n][r] * scl * subln[n * 16 + l15]);
  }
}

__device__ __forceinline__ void rwkv_chain2(const P& p, int chain, char* smem);
__device__ __forceinline__ void ph_mix0(const P& p, char* smem) {
  volatile int* s_unitp = (volatile int*)(smem + 131072);
  for (int u = blockIdx.x; u < 128; u += gridDim.x) rwkv_chain2(p, u, smem);
#ifdef PROBE_RWKV
  __syncthreads();
  for (int u = blockIdx.x; u < 256; u += gridDim.x) rwkv_chain(p, u & 127, u >> 7, smem);
#endif
  float d1 = 0.f, d2 = 0.f;
  for (int i = 0; i < 64; ++i) { d1 += p.in[12][i] * p.in[13][i]; d2 += p.in[14][i] * p.in[15][i]; }
  float lam = expf(d1) - expf(d2) + 0.2f;
  int* cnt = (int*)(p.ws + OFF_CNT);
  while (true) {
    __syncthreads();
    if (tidx() == 0) *s_unitp = atomicAdd(cnt, 1);
    __syncthreads();
    int u = *s_unitp;
    if (u >= 1088) break;
    attn_unit(p, u, smem, lam);
  }
#ifdef PROBE_ATTN
  while (true) {
    __syncthreads();
    if (tidx() == 0) *s_unitp = atomicAdd(cnt + 1, 1);
    __syncthreads();
    int u = *s_unitp;
    if (u >= 1088) break;
    attn_unit(p, u, smem, lam);
  }
#endif
}

__device__ __forceinline__ void ph_rwkv_post(const P& p) {
  const int tid = tidx(), wave = tid >> 6;
  const bf* YF = (const bf*)p.out;
  const bf* YB = YF + (size_t)RT * 512;
  const bf* PV = (const bf*)(p.ws + OFF_PREP) + (size_t)2 * RT * 512;
  const bf* G = (const bf*)(p.ws + OFF_G);
  const float* BON = (const float*)(p.ws + OFF_BONUS);
  bf* O = (bf*)(p.ws + OFF_HO);
  const float lw = p.in[28][tid], lb = p.in[29][tid];
  for (int R0 = blockIdx.x * 4; R0 < RT; R0 += gridDim.x * 4) {
    float yf[4], yb4[4], pv[4], gg[4], bn[4];
#pragma unroll
    for (int i = 0; i < 4; ++i) {
      size_t o = (size_t)(R0 + i) * 512 + tid;
      yf[i] = bf2f(YF[o]); yb4[i] = bf2f(YB[o]); pv[i] = bf2f(PV[o]); gg[i] = bf2f(G[o]); bn[i] = BON[(size_t)(R0 + i) * 8 + wave];
    }
#pragma unroll
    for (int i = 0; i < 4; ++i) {
      float y = yf[i] + yb4[i];
      float mean = wave_sum(y) * (1.f / 64.f);
      float d = y - mean;
      float var = wave_sum(d * d) * (1.f / 64.f);
      float yn = d * rsqrtf(var + 64e-5f) * lw + lb;
      float outv = (yn + bn[i] * pv[i]) * gg[i];
      O[(size_t)(R0 + i) * 1024 + 512 + tid] = f2bf(outv);
    }
  }
}

__device__ __forceinline__ void ph_conv(const P& p) {
  const bf* XR = (const bf*)(p.ws + OFF_XRAW);
  bf* XO = (bf*)(p.ws + OFF_XBC);
  const float* cw = p.in[38];
  const float* cb = p.in[39];
  for (size_t it = (size_t)blockIdx.x * NT + tidx(); it < (size_t)RT * 128; it += (size_t)gridDim.x * NT) {
    int R = (int)(it >> 7), c8 = (int)(it & 127) * 8;
    int b = R / TA, a = R - b * TA;
    int lo = a < CTX ? 0 : CTX, hi = a < CTX ? CTX : TA;
    float acc[8];
#pragma unroll
    for (int e = 0; e < 8; ++e) acc[e] = cb[c8 + e];
#pragma unroll
    for (int j = 0; j < 5; ++j) {
      int aj = a + j - 2;
      if (aj >= lo && aj < hi) {
        uint4 v = *(const uint4*)(XR + (size_t)(R + j - 2) * 1024 + c8);
        const float* w = cw + j * 1024 + c8;
        acc[0] += w[0] * bflo(v.x); acc[1] += w[1] * bfhi(v.x);
        acc[2] += w[2] * bflo(v.y); acc[3] += w[3] * bfhi(v.y);
        acc[4] += w[4] * bflo(v.z); acc[5] += w[5] * bfhi(v.z);
        acc[6] += w[6] * bflo(v.w); acc[7] += w[7] * bfhi(v.w);
      }
    }
    uint4 o;
    o.x = pack2(siluf_(acc[0]), siluf_(acc[1]));
    o.y = pack2(siluf_(acc[2]), siluf_(acc[3]));
    o.z = pack2(siluf_(acc[4]), siluf_(acc[5]));
    o.w = pack2(siluf_(acc[6]), siluf_(acc[7]));
    *(uint4*)(XO + (size_t)R * 1024 + c8) = o;
  }
}

__device__ __forceinline__ void ssd_chain(const P& p, int chain, char* smem) {
  const int dir = chain & 1, hh = (chain >> 1) & 7, b = chain >> 4;
  const int grp = hh >> 2;
  float* cB = (float*)smem;
  float* cC = cB + 4096;
  float* cX = cC + 4096;
  float* cDA = cX + 2048;
  float* yb = cDA + 32;
  const int tid = tidx(), lane = tid & 63, wave = tid >> 6;
  const int l15 = lane & 15, lg = lane >> 4;
  const bf* XBC = (const bf*)(p.ws + OFF_XBC);
  const float* DTR = (const float*)(p.ws + OFF_DTRAW);
  bf* Y = (bf*)(p.ws + OFF_XRAW) + (size_t)dir * RT * 512;
  const float dtb = p.in[dir ? 42 : 40][hh];
  const float Aneg = -expf(p.in[dir ? 43 : 41][hh]);
  const int st = tid >> 4, q = tid & 15;
  const int r0 = wave * 8 + lg * 2;
  float s0[8], s1[8];
#pragma unroll
  for (int j = 0; j < 8; ++j) { s0[j] = 0.f; s1[j] = 0.f; }
  uint4 gB, gC;
  uint2 gX;
  float gD;
  {
    size_t R = (size_t)scan_row(b, dir, st);
    gB = *(const uint4*)(XBC + R * 1024 + 512 + grp * 128 + q * 8);
    gC = *(const uint4*)(XBC + R * 1024 + 768 + grp * 128 + q * 8);
    gX = *(const uint2*)(XBC + R * 1024 + hh * 64 + q * 4);
    gD = DTR[R * 16 + dir * 8 + hh];
  }
  const int NCH = TA / 32;
  for (int ch = 0; ch <= NCH; ++ch) {
    __syncthreads();
    if (ch > 0) {
      float4 y4 = *(const float4*)(yb + st * 64 + q * 4);
      uint2 o2;
      o2.x = pack2(y4.x, y4.y);
      o2.y = pack2(y4.z, y4.w);
      *(uint2*)(Y + (size_t)scan_row(b, dir, (ch - 1) * 32 + st) * 512 + hh * 64 + q * 4) = o2;
    }
    if (ch == NCH) break;
    {
      float dt = softplusf_(gD + dtb);
      float dA = expf(dt * Aneg);
      float* d = cB + st * 128 + q * 8;
      *(float4*)d = make_float4(bflo(gB.x), bfhi(gB.x), bflo(gB.y), bfhi(gB.y));
      *(float4*)(d + 4) = make_float4(bflo(gB.z), bfhi(gB.z), bflo(gB.w), bfhi(gB.w));
      d = cC + st * 128 + q * 8;
      *(float4*)d = make_float4(bflo(gC.x), bfhi(gC.x), bflo(gC.y), bfhi(gC.y));
      *(float4*)(d + 4) = make_float4(bflo(gC.z), bfhi(gC.z), bflo(gC.w), bfhi(gC.w));
      *(float4*)(cX + st * 64 + q * 4) = make_float4(bflo(gX.x) * dt, bfhi(gX.x) * dt, bflo(gX.y) * dt, bfhi(gX.y) * dt);
      if (q == 0) cDA[st] = dA;
    }
    __syncthreads();
    if (ch + 1 < NCH) {
      size_t R = (size_t)scan_row(b, dir, (ch + 1) * 32 + st);
      gB = *(const uint4*)(XBC + R * 1024 + 512 + grp * 128 + q * 8);
      gC = *(const uint4*)(XBC + R * 1024 + 768 + grp * 128 + q * 8);
      gX = *(const uint2*)(XBC + R * 1024 + hh * 64 + q * 4);
      gD = DTR[R * 16 + dir * 8 + hh];
    }
#pragma unroll 4
    for (int t = 0; t < 32; ++t) {
      float4 b0 = *(const float4*)(cB + t * 128 + l15 * 8);
      float4 b1 = *(const float4*)(cB + t * 128 + l15 * 8 + 4);
      float4 c0 = *(const float4*)(cC + t * 128 + l15 * 8);
      float4 c1 = *(const float4*)(cC + t * 128 + l15 * 8 + 4);
      float2 x2 = *(const float2*)(cX + t * 64 + r0);
      float dA = cDA[t];
      s0[0] = s0[0] * dA + x2.x * b0.x; s0[1] = s0[1] * dA + x2.x * b0.y; s0[2] = s0[2] * dA + x2.x * b0.z; s0[3] = s0[3] * dA + x2.x * b0.w;
      s0[4] = s0[4] * dA + x2.x * b1.x; s0[5] = s0[5] * dA + x2.x * b1.y; s0[6] = s0[6] * dA + x2.x * b1.z; s0[7] = s0[7] * dA + x2.x * b1.w;
      s1[0] = s1[0] * dA + x2.y * b0.x; s1[1] = s1[1] * dA + x2.y * b0.y; s1[2] = s1[2] * dA + x2.y * b0.z; s1[3] = s1[3] * dA + x2.y * b0.w;
      s1[4] = s1[4] * dA + x2.y * b1.x; s1[5] = s1[5] * dA + x2.y * b1.y; s1[6] = s1[6] * dA + x2.y * b1.z; s1[7] = s1[7] * dA + x2.y * b1.w;
      float y0 = s0[0] * c0.x + s0[1] * c0.y + s0[2] * c0.z + s0[3] * c0.w + s0[4] * c1.x + s0[5] * c1.y + s0[6] * c1.z + s0[7] * c1.w;
      float y1 = s1[0] * c0.x + s1[1] * c0.y + s1[2] * c0.z + s1[3] * c0.w + s1[4] * c1.x + s1[5] * c1.y + s1[6] * c1.z + s1[7] * c1.w;
      y0 = red16(y0);
      y1 = red16(y1);
      if (l15 == 0) *(float2*)(yb + t * 64 + r0) = make_float2(y0, y1);
    }
  }
}

__device__ __forceinline__ void gla_chain(const P& p, int chain, char* smem) {
  const int dir = chain & 1, h = (chain >> 1) & 3, b = chain >> 3;
  float* cQ = (float*)smem;
  float* cK = cQ + 2048;
  float* cD = cK + 2048;
  float* cV = cD + 2048;
  float* yb = cV + 4096;
  float* up = yb + 4096;
  float* gbias = up + 1024;
  const int tid = tidx(), lane = tid & 63, wave = tid >> 6;
  const int l15 = lane & 15, lg = lane >> 4;
  const bf* P1 = (const bf*)(p.ws + OFF_P1C);
  bf* Y = (bf*)(p.ws + OFF_GY) + (size_t)dir * RT * 512;
  const float* gup = p.in[dir ? 48 : 46];
  const float* gb = p.in[dir ? 49 : 47];
  __syncthreads();
  for (int i = tid; i < 1024; i += NT) up[i] = gup[(i >> 6) * 256 + h * 64 + (i & 63)];
  if (tid < 64) gbias[tid] = gb[h * 64 + tid];
  const int st = tid >> 4, q = tid & 15;
  const int r0 = wave * 16 + lg * 4;
  float s[4][4];
#pragma unroll
  for (int r = 0; r < 4; ++r)
#pragma unroll
    for (int j = 0; j < 4; ++j) s[r][j] = 0.f;
  uint2 gQ, gK;
  uint4 gV, gG0, gG1;
  {
    const bf* row = P1 + (size_t)scan_row(b, dir, st) * 2080;
    gQ = *(const uint2*)(row + 528 + h * 64 + q * 4);
    gK = *(const uint2*)(row + 784 + h * 64 + q * 4);
    gV = *(const uint4*)(row + 1040 + h * 128 + q * 8);
    gG0 = *(const uint4*)(row + 2064);
    gG1 = *(const uint4*)(row + 2072);
  }
  const int NCH = TA / 32;
  for (int ch = 0; ch <= NCH; ++ch) {
    __syncthreads();
    if (ch > 0) {
      float4 ya = *(const float4*)(yb + st * 128 + q * 8);
      float4 yc = *(const float4*)(yb + st * 128 + q * 8 + 4);
      uint4 o4;
      o4.x = pack2(ya.x, ya.y); o4.y = pack2(ya.z, ya.w); o4.z = pack2(yc.x, yc.y); o4.w = pack2(yc.z, yc.w);
      *(uint4*)(Y + (size_t)scan_row(b, dir, (ch - 1) * 32 + st) * 512 + h * 128 + q * 8) = o4;
    }
    if (ch == NCH) break;
    {
      float gd[16];
      gd[0] = bflo(gG0.x); gd[1] = bfhi(gG0.x); gd[2] = bflo(gG0.y); gd[3] = bfhi(gG0.y);
      gd[4] = bflo(gG0.z); gd[5] = bfhi(gG0.z); gd[6] = bflo(gG0.w); gd[7] = bfhi(gG0.w);
      gd[8] = bflo(gG1.x); gd[9] = bfhi(gG1.x); gd[10] = bflo(gG1.y); gd[11] = bfhi(gG1.y);
      gd[12] = bflo(gG1.z); gd[13] = bfhi(gG1.z); gd[14] = bflo(gG1.w); gd[15] = bfhi(gG1.w);
      float4 z = *(const float4*)(gbias + q * 4);
#pragma unroll
      for (int i = 0; i < 16; ++i) {
        float4 u4 = *(const float4*)(up + i * 64 + q * 4);
        z.x += gd[i] * u4.x; z.y += gd[i] * u4.y; z.z += gd[i] * u4.z; z.w += gd[i] * u4.w;
      }
      float4 dd;
      dd.x = expf(-softplusf_(-z.x) * (1.f / 16.f));
      dd.y = expf(-softplusf_(-z.y) * (1.f / 16.f));
      dd.z = expf(-softplusf_(-z.z) * (1.f / 16.f));
      dd.w = expf(-softplusf_(-z.w) * (1.f / 16.f));
      *(float4*)(cD + st * 64 + q * 4) = dd;
      *(float4*)(cQ + st * 64 + q * 4) = make_float4(bflo(gQ.x) * 0.125f, bfhi(gQ.x) * 0.125f, bflo(gQ.y) * 0.125f, bfhi(gQ.y) * 0.125f);
      *(float4*)(cK + st * 64 + q * 4) = make_float4(bflo(gK.x), bfhi(gK.x), bflo(gK.y), bfhi(gK.y));
      float* d = cV + st * 128 + q * 8;
      *(float4*)d = make_float4(bflo(gV.x), bfhi(gV.x), bflo(gV.y), bfhi(gV.y));
      *(float4*)(d + 4) = make_float4(bflo(gV.z), bfhi(gV.z), bflo(gV.w), bfhi(gV.w));
    }
    __syncthreads();
    if (ch + 1 < NCH) {
      const bf* row = P1 + (size_t)scan_row(b, dir, (ch + 1) * 32 + st) * 2080;
      gQ = *(const uint2*)(row + 528 + h * 64 + q * 4);
      gK = *(const uint2*)(row + 784 + h * 64 + q * 4);
      gV = *(const uint4*)(row + 1040 + h * 128 + q * 8);
      gG0 = *(const uint4*)(row + 2064);
      gG1 = *(const uint4*)(row + 2072);
    }
#pragma unroll 4
    for (int t = 0; t < 32; ++t) {
      float4 q4 = *(const float4*)(cQ + t * 64 + l15 * 4);
      float4 k4 = *(const float4*)(cK + t * 64 + l15 * 4);
      float4 d4 = *(const float4*)(cD + t * 64 + l15 * 4);
      float4 v4 = *(const float4*)(cV + t * 128 + r0);
      float vv[4] = {v4.x, v4.y, v4.z, v4.w};
      float yy[4];
#pragma unroll
      for (int r = 0; r < 4; ++r) {
        s[r][0] = s[r][0] * d4.x + k4.x * vv[r];
        s[r][1] = s[r][1] * d4.y + k4.y * vv[r];
        s[r][2] = s[r][2] * d4.z + k4.z * vv[r];
        s[r][3] = s[r][3] * d4.w + k4.w * vv[r];
        yy[r] = red16(s[r][0] * q4.x + s[r][1] * q4.y + s[r][2] * q4.z + s[r][3] * q4.w);
      }
      if (l15 == 0) *(float4*)(yb + t * 128 + r0) = make_float4(yy[0], yy[1], yy[2], yy[3]);
    }
  }
}

typedef __attribute__((address_space(3))) s16x4* lds_s16x4p;
template <int LD>
__device__ __forceinline__ bf16x8 trfrag_t(const bf* img, int r0, int c0, int lane) {
  const bf* pp = img + (r0 + ((lane & 15) >> 2)) * LD + c0 + (lane & 3) * 4;
  return tr_pair<4 * LD * 2>(pp);
}
#define trfrag(img, ld, r0, c0, lane) trfrag_t<ld>(img, r0, c0, lane)
__device__ __forceinline__ bf16x8 pack8(f32x4 a, f32x4 b) {
  i32x4 t;
  t[0] = (int)pack2(a[0], a[1]); t[1] = (int)pack2(a[2], a[3]); t[2] = (int)pack2(b[0], b[1]); t[3] = (int)pack2(b[2], b[3]);
  return __builtin_bit_cast(bf16x8, t);
}
__device__ __forceinline__ bf16x8 ld2x64(const bf* p0, const bf* p1) {
  uint2 a = *(const uint2*)p0, b2 = *(const uint2*)p1;
  i32x4 t;
  t[0] = (int)a.x; t[1] = (int)a.y; t[2] = (int)b2.x; t[3] = (int)b2.y;
  return __builtin_bit_cast(bf16x8, t);
}

__device__ __forceinline__ void gla_chain2(const P& p, int chain, char* smem) {
  const int dir = chain & 1, h = (chain >> 1) & 3, b = chain >> 3;
  bf* Qs = (bf*)smem;
  bf* Ks = Qs + 64 * 72;
  bf* Vs = Ks + 64 * 72;
  bf* Ps = Vs + 64 * 144;
  bf* GD = Ps + 64 * 72;
  float* segtot = (float*)(GD + 64 * 16);
  float* dS = segtot + 512;
  const int tid = tidx(), lane = tid & 63, wave = tid >> 6;
  const int l15 = lane & 15, g = lane >> 4;
  const bf* P1 = (const bf*)(p.ws + OFF_P1C);
  bf* Y = (bf*)(p.ws + OFF_GY) + (size_t)dir * RT * 512;
  const float* gup = p.in[dir ? 48 : 46];
  const float* gb = p.in[dir ? 49 : 47];
  const int kc = tid & 63, seg = tid >> 6;
  float upr[16];
#pragma unroll
  for (int r = 0; r < 16; ++r) upr[r] = gup[r * 256 + h * 64 + kc];
  const float bk = gb[h * 64 + kc];
  const int stok = tid >> 3, sc8 = (tid & 7) * 8;
  f32x4 S[4];
#pragma unroll
  for (int kt = 0; kt < 4; ++kt) S[kt] = (f32x4){0.f, 0.f, 0.f, 0.f};
  uint4 rq, rk, rv0, rv1, rg = make_uint4(0, 0, 0, 0);
  {
    const bf* row = P1 + (size_t)scan_row(b, dir, stok) * 2080;
    rq = *(const uint4*)(row + 528 + h * 64 + sc8);
    rk = *(const uint4*)(row + 784 + h * 64 + sc8);
    rv0 = *(const uint4*)(row + 1040 + h * 128 + sc8 * 2);
    rv1 = *(const uint4*)(row + 1040 + h * 128 + sc8 * 2 + 8);
    if (tid < 128) rg = *(const uint4*)(P1 + (size_t)scan_row(b, dir, tid >> 1) * 2080 + 2064 + (tid & 1) * 8);
  }
  const int NCH = TA / 64;
  for (int c = 0; c < NCH; ++c) {
    __syncthreads();
    *(uint4*)(Qs + stok * 72 + sc8) = rq;
    *(uint4*)(Ks + stok * 72 + sc8) = rk;
    *(uint4*)(Vs + stok * 144 + sc8 * 2) = rv0;
    *(uint4*)(Vs + stok * 144 + sc8 * 2 + 8) = rv1;
    if (tid < 128) *(uint4*)(GD + (tid >> 1) * 16 + (tid & 1) * 8) = rg;
    __syncthreads();
    if (c + 1 < NCH) {
      const bf* row = P1 + (size_t)scan_row(b, dir, (c + 1) * 64 + stok) * 2080;
      rq = *(const uint4*)(row + 528 + h * 64 + sc8);
      rk = *(const uint4*)(row + 784 + h * 64 + sc8);
      rv0 = *(const uint4*)(row + 1040 + h * 128 + sc8 * 2);
      rv1 = *(const uint4*)(row + 1040 + h * 128 + sc8 * 2 + 8);
      if (tid < 128) rg = *(const uint4*)(P1 + (size_t)scan_row(b, dir, (c + 1) * 64 + (tid >> 1)) * 2080 + 2064 + (tid & 1) * 8);
    }
    float lc[8];
    {
      float run = 0.f;
#pragma unroll
      for (int ii = 0; ii < 8; ++ii) {
        const bf* gr = GD + (seg * 8 + ii) * 16;
        uint4 g0 = *(const uint4*)gr, g1 = *(const uint4*)(gr + 8);
        float z = bk;
        z += bflo(g0.x) * upr[0] + bfhi(g0.x) * upr[1] + bflo(g0.y) * upr[2] + bfhi(g0.y) * upr[3];
        z += bflo(g0.z) * upr[4] + bfhi(g0.z) * upr[5] + bflo(g0.w) * upr[6] + bfhi(g0.w) * upr[7];
        z += bflo(g1.x) * upr[8] + bfhi(g1.x) * upr[9] + bflo(g1.y) * upr[10] + bfhi(g1.y) * upr[11];
        z += bflo(g1.z) * upr[12] + bfhi(g1.z) * upr[13] + bflo(g1.w) * upr[14] + bfhi(g1.w) * upr[15];
        run += -softplusf_(-z) * (1.f / 16.f);
        lc[ii] = run;
      }
      segtot[seg * 64 + kc] = run;
    }
    __syncthreads();
    {
      float off = 0.f, tot = 0.f;
#pragma unroll
      for (int s2 = 0; s2 < 8; ++s2) {
        float t = segtot[s2 * 64 + kc];
        tot += t;
        off += (s2 < seg) ? t : 0.f;
      }
#pragma unroll
      for (int ii = 0; ii < 8; ++ii) {
        int i = seg * 8 + ii;
        float cum = off + lc[ii];
        float qv = bf2f(Qs[i * 72 + kc]), kv = bf2f(Ks[i * 72 + kc]);
        float eq = __expf(cum - tot);
        Qs[i * 72 + kc] = f2bf(qv * 0.125f * eq);
        Ks[i * 72 + kc] = f2bf(kv * __builtin_amdgcn_rcpf(eq));
      }
      if (seg == 0) dS[kc] = __expf(tot);
    }
    __syncthreads();
#pragma unroll
    for (int kt = 0; kt < 4; ++kt) {
      float4 d4 = *(const float4*)(dS + kt * 16 + g * 4);
      S[kt][0] *= d4.x; S[kt][1] *= d4.y; S[kt][2] *= d4.z; S[kt][3] *= d4.w;
    }
#pragma unroll
    for (int tt = 0; tt < 2; ++tt) {
      int idx = wave * 2 + tt, jt = idx >> 2, it = idx & 3;
      f32x4 acc = (f32x4){0.f, 0.f, 0.f, 0.f};
      if (jt <= it) {
#pragma unroll
        for (int ks = 0; ks < 2; ++ks) {
          bf16x8 a = *(const bf16x8*)(Ks + (jt * 16 + l15) * 72 + ks * 32 + g * 8);
          bf16x8 bq = *(const bf16x8*)(Qs + (it * 16 + l15) * 72 + ks * 32 + g * 8);
          acc = __builtin_amdgcn_mfma_f32_16x16x32_bf16(a, bq, acc, 0, 0, 0);
        }
        int i = it * 16 + l15;
#pragma unroll
        for (int r = 0; r < 4; ++r) { int j = jt * 16 + g * 4 + r; acc[r] = (j <= i) ? acc[r] : 0.f; }
      }
      uint2 o;
      o.x = pack2(acc[0], acc[1]);
      o.y = pack2(acc[2], acc[3]);
      *(uint2*)(Ps + (it * 16 + l15) * 72 + jt * 16 + g * 4) = o;
    }
    __syncthreads();
    f32x4 y[4];
#pragma unroll
    for (int it = 0; it < 4; ++it) y[it] = (f32x4){0.f, 0.f, 0.f, 0.f};
#pragma unroll
    for (int s2 = 0; s2 < 2; ++s2) {
      bf16x8 sf = pack8(S[2 * s2], S[2 * s2 + 1]);
#pragma unroll
      for (int it = 0; it < 4; ++it) {
        const bf* qr = Qs + (it * 16 + l15) * 72 + g * 4;
        bf16x8 aq = ld2x64(qr + (2 * s2) * 16, qr + (2 * s2 + 1) * 16);
        y[it] = __builtin_amdgcn_mfma_f32_16x16x32_bf16(aq, sf, y[it], 0, 0, 0);
      }
    }
#pragma unroll
    for (int s2 = 0; s2 < 2; ++s2) {
      bf16x8 vf = trfrag(Vs, 144, s2 * 32 + g * 8, wave * 16, lane);
#pragma unroll
      for (int it = 0; it < 4; ++it) {
        bf16x8 ap = *(const bf16x8*)(Ps + (it * 16 + l15) * 72 + s2 * 32 + g * 8);
        y[it] = __builtin_amdgcn_mfma_f32_16x16x32_bf16(ap, vf, y[it], 0, 0, 0);
      }
#pragma unroll
      for (int kt = 0; kt < 4; ++kt) {
        bf16x8 ak = trfrag(Ks, 72, s2 * 32 + g * 8, kt * 16, lane);
        S[kt] = __builtin_amdgcn_mfma_f32_16x16x32_bf16(ak, vf, S[kt], 0, 0, 0);
      }
    }
#pragma unroll
    for (int it = 0; it < 4; ++it)
#pragma unroll
      for (int r = 0; r < 4; ++r) {
        int i = it * 16 + g * 4 + r;
        Y[(size_t)scan_row(b, dir, c * 64 + i) * 512 + h * 128 + wave * 16 + l15] = f2bf(y[it][r]);
      }
  }
}

__device__ __forceinline__ void ssd_chain2(const P& p, int chain, char* smem) {
  const int dir = chain & 1, hh = (chain >> 1) & 7, b = chain >> 4;
  const int grp = hh >> 2;
  bf* Cs = (bf*)smem;
  bf* Bs = Cs + 64 * 136;
  bf* Xs = Bs + 64 * 136;
  bf* Xw = Xs + 64 * 72;
  bf* Ps = Xw + 64 * 72;
  float* dtS = (float*)(Ps + 64 * 72);
  float* cumS = dtS + 64;
  float* ecS = cumS + 64;
  float* totS = ecS + 64;
  const int tid = tidx(), lane = tid & 63, wave = tid >> 6;
  const int l15 = lane & 15, g = lane >> 4;
  const int vt = wave & 3, ih = wave >> 2;
  const bf* XBC = (const bf*)(p.ws + OFF_XBC);
  const float* DTR = (const float*)(p.ws + OFF_DTRAW);
  bf* Y = (bf*)(p.ws + OFF_XRAW) + (size_t)dir * RT * 512;
  const float dtb = p.in[dir ? 42 : 40][hh];
  const float Aneg = -expf(p.in[dir ? 43 : 41][hh]);
  const int stok = tid >> 3, sc = tid & 7;
  f32x4 S[8];
#pragma unroll
  for (int nt = 0; nt < 8; ++nt) S[nt] = (f32x4){0.f, 0.f, 0.f, 0.f};
  uint4 rc0, rc1, rb0, rb1, rx;
  float rdt = 0.f;
  {
    const bf* row = XBC + (size_t)scan_row(b, dir, stok) * 1024;
    rb0 = *(const uint4*)(row + 512 + grp * 128 + sc * 16);
    rb1 = *(const uint4*)(row + 512 + grp * 128 + sc * 16 + 8);
    rc0 = *(const uint4*)(row + 768 + grp * 128 + sc * 16);
    rc1 = *(const uint4*)(row + 768 + grp * 128 + sc * 16 + 8);
    rx = *(const uint4*)(row + hh * 64 + sc * 8);
    if (tid < 64) rdt = DTR[(size_t)scan_row(b, dir, tid) * 16 + dir * 8 + hh];
  }
  const int NCH = TA / 64;
  for (int c = 0; c < NCH; ++c) {
    __syncthreads();
    *(uint4*)(Cs + stok * 136 + sc * 16) = rc0;
    *(uint4*)(Cs + stok * 136 + sc * 16 + 8) = rc1;
    *(uint4*)(Bs + stok * 136 + sc * 16) = rb0;
    *(uint4*)(Bs + stok * 136 + sc * 16 + 8) = rb1;
    if (tid < 64) {
      float dt = softplusf_(rdt + dtb);
      float cum = dt * Aneg;
#pragma unroll
      for (int o = 1; o < 64; o <<= 1) {
        float t = __shfl_up(cum, o);
        if (lane >= o) cum += t;
      }
      float tot = __shfl(cum, 63);
      dtS[lane] = dt;
      cumS[lane] = cum;
      ecS[lane] = __expf(cum);
      if (lane == 0) totS[0] = tot;
    }
    __syncthreads();
    const uint4 cx = rx;
    if (c + 1 < NCH) {
      const bf* row = XBC + (size_t)scan_row(b, dir, (c + 1) * 64 + stok) * 1024;
      rb0 = *(const uint4*)(row + 512 + grp * 128 + sc * 16);
      rb1 = *(const uint4*)(row + 512 + grp * 128 + sc * 16 + 8);
      rc0 = *(const uint4*)(row + 768 + grp * 128 + sc * 16);
      rc1 = *(const uint4*)(row + 768 + grp * 128 + sc * 16 + 8);
      rx = *(const uint4*)(row + hh * 64 + sc * 8);
      if (tid < 64) rdt = DTR[(size_t)scan_row(b, dir, (c + 1) * 64 + tid) * 16 + dir * 8 + hh];
    }
    const float tot = totS[0];
    {
      float dt = dtS[stok];
      float w = dt * __expf(tot - cumS[stok]);
      float x0 = bflo(cx.x), x1 = bfhi(cx.x), x2 = bflo(cx.y), x3 = bfhi(cx.y), x4 = bflo(cx.z), x5 = bfhi(cx.z), x6 = bflo(cx.w), x7 = bfhi(cx.w);
      uint4 o;
      o.x = pack2(x0 * dt, x1 * dt); o.y = pack2(x2 * dt, x3 * dt); o.z = pack2(x4 * dt, x5 * dt); o.w = pack2(x6 * dt, x7 * dt);
      *(uint4*)(Xs + stok * 72 + sc * 8) = o;
      o.x = pack2(x0 * w, x1 * w); o.y = pack2(x2 * w, x3 * w); o.z = pack2(x4 * w, x5 * w); o.w = pack2(x6 * w, x7 * w);
      *(uint4*)(Xw + stok * 72 + sc * 8) = o;
    }
#pragma unroll
    for (int tt = 0; tt < 2; ++tt) {
      int idx = wave * 2 + tt, jt = idx >> 2, it = idx & 3;
      f32x4 acc = (f32x4){0.f, 0.f, 0.f, 0.f};
      if (jt <= it) {
#pragma unroll
        for (int ks = 0; ks < 4; ++ks) {
          bf16x8 a = *(const bf16x8*)(Bs + (jt * 16 + l15) * 136 + ks * 32 + g * 8);
          bf16x8 bq = *(const bf16x8*)(Cs + (it * 16 + l15) * 136 + ks * 32 + g * 8);
          acc = __builtin_amdgcn_mfma_f32_16x16x32_bf16(a, bq, acc, 0, 0, 0);
        }
        int i = it * 16 + l15;
        float ci = cumS[i];
        float4 cj = *(const float4*)(cumS + jt * 16 + g * 4);
        int j0 = jt * 16 + g * 4;
        acc[0] = (j0 + 0 <= i) ? acc[0] * __expf(ci - cj.x) : 0.f;
        acc[1] = (j0 + 1 <= i) ? acc[1] * __expf(ci - cj.y) : 0.f;
        acc[2] = (j0 + 2 <= i) ? acc[2] * __expf(ci - cj.z) : 0.f;
        acc[3] = (j0 + 3 <= i) ? acc[3] * __expf(ci - cj.w) : 0.f;
      }
      uint2 o;
      o.x = pack2(acc[0], acc[1]);
      o.y = pack2(acc[2], acc[3]);
      *(uint2*)(Ps + (it * 16 + l15) * 72 + jt * 16 + g * 4) = o;
    }
    __syncthreads();
    f32x4 y[2];
    y[0] = (f32x4){0.f, 0.f, 0.f, 0.f};
    y[1] = (f32x4){0.f, 0.f, 0.f, 0.f};
#pragma unroll
    for (int s2 = 0; s2 < 4; ++s2) {
      bf16x8 sf = pack8(S[2 * s2], S[2 * s2 + 1]);
#pragma unroll
      for (int ii = 0; ii < 2; ++ii) {
        const bf* qr = Cs + ((ih * 2 + ii) * 16 + l15) * 136 + g * 4;
        bf16x8 aq = ld2x64(qr + (2 * s2) * 16, qr + (2 * s2 + 1) * 16);
        y[ii] = __builtin_amdgcn_mfma_f32_16x16x32_bf16(aq, sf, y[ii], 0, 0, 0);
      }
    }
    {
      float et = __expf(tot);
#pragma unroll
      for (int nt = 0; nt < 8; ++nt) { S[nt][0] *= et; S[nt][1] *= et; S[nt][2] *= et; S[nt][3] *= et; }
    }
#pragma unroll
    for (int ii = 0; ii < 2; ++ii) {
      float4 e4 = *(const float4*)(ecS + (ih * 2 + ii) * 16 + g * 4);
      y[ii][0] *= e4.x; y[ii][1] *= e4.y; y[ii][2] *= e4.z; y[ii][3] *= e4.w;
    }
#pragma unroll
    for (int s2 = 0; s2 < 2; ++s2) {
      bf16x8 xf = trfrag(Xs, 72, s2 * 32 + g * 8, vt * 16, lane);
#pragma unroll
      for (int ii = 0; ii < 2; ++ii) {
        bf16x8 ap = *(const bf16x8*)(Ps + ((ih * 2 + ii) * 16 + l15) * 72 + s2 * 32 + g * 8);
        y[ii] = __builtin_amdgcn_mfma_f32_16x16x32_bf16(ap, xf, y[ii], 0, 0, 0);
      }
      bf16x8 xwf = trfrag(Xw, 72, s2 * 32 + g * 8, vt * 16, lane);
#pragma unroll
      for (int nt = 0; nt < 8; ++nt) {
        bf16x8 ab = trfrag(Bs, 136, s2 * 32 + g * 8, nt * 16, lane);
        S[nt] = __builtin_amdgcn_mfma_f32_16x16x32_bf16(ab, xwf, S[nt], 0, 0, 0);
      }
    }
#pragma unroll
    for (int ii = 0; ii < 2; ++ii)
#pragma unroll
      for (int r = 0; r < 4; ++r) {
        int i = (ih * 2 + ii) * 16 + g * 4 + r;
        Y[(size_t)scan_row(b, dir, c * 64 + i) * 512 + hh * 64 + vt * 16 + l15] = f2bf(y[ii][r]);
      }
  }
}

__device__ __forceinline__ void rwkv_chain2(const P& p, int chain, char* smem) {
  const int dir = chain & 1, h = (chain >> 1) & 7, b = chain >> 4;
  bf* KT = (bf*)smem;
  bf* RTi = KT + 4608;
  bf* KH = RTi + 4608;
  bf* BH = KH + 4608;
  bf* VV = BH + 4608;
  bf* MAkk = VV + 4608;
  bf* MBrk = MAkk + 4608;
  bf* MBrb = MBrk + 4608;
  bf* UN = MBrb + 4608;
  bf* LWs = UN + 4608;
  float* AKB = (float*)(LWs + 4608);
  float* RH = AKB + 64 * 68;
  float* segtot = RH + 64 * 68;
  float* dS = segtot + 512;
  const int tid = tidx(), lane = tid & 63, wave = tid >> 6;
  const int l15 = lane & 15, g = lane >> 4;
  const int vt = wave & 3, ih = wave >> 2;
  const bf* PR = (const bf*)(p.ws + OFF_PREP);
  const bf* PK = PR + (size_t)RT * 512;
  const bf* PV = PK + (size_t)RT * 512;
  const bf* PKK = PV + (size_t)RT * 512;
  const bf* PKA = PKK + (size_t)RT * 512;
  const bf* PLW = PKA + (size_t)RT * 512 + (size_t)dir * RT * 512;
  bf* Y = (bf*)p.out + (size_t)dir * RT * 512;
  const int kc = tid & 63, seg = tid >> 6;
  const int stok = tid >> 3, sc8 = (tid & 7) * 8;
  f32x4 T[4];
#pragma unroll
  for (int kt = 0; kt < 4; ++kt) T[kt] = (f32x4){0.f, 0.f, 0.f, 0.f};
  uint4 gR, gK, gV, gKK, gKA, gW;
  {
    size_t o = (size_t)scan_row(b, dir, stok) * 512 + h * 64 + sc8;
    gR = *(const uint4*)(PR + o); gK = *(const uint4*)(PK + o); gV = *(const uint4*)(PV + o);
    gKK = *(const uint4*)(PKK + o); gKA = *(const uint4*)(PKA + o); gW = *(const uint4*)(PLW + o);
  }
  const int NCH = TA / 64;
  for (int c = 0; c < NCH; ++c) {
    __syncthreads();
    *(uint4*)(RTi + stok * 72 + sc8) = gR;
    *(uint4*)(KH + stok * 72 + sc8) = gK;
    *(uint4*)(VV + stok * 72 + sc8) = gV;
    *(uint4*)(KT + stok * 72 + sc8) = gKK;
    *(uint4*)(BH + stok * 72 + sc8) = gKA;
    *(uint4*)(LWs + stok * 72 + sc8) = gW;
    __syncthreads();
    if (c + 1 < NCH) {
      size_t o = (size_t)scan_row(b, dir, (c + 1) * 64 + stok) * 512 + h * 64 + sc8;
      gR = *(const uint4*)(PR + o); gK = *(const uint4*)(PK + o); gV = *(const uint4*)(PV + o);
      gKK = *(const uint4*)(PKK + o); gKA = *(const uint4*)(PKA + o); gW = *(const uint4*)(PLW + o);
    }
    float lc[8];
    {
      float run = 0.f;
#pragma unroll
      for (int ii = 0; ii < 8; ++ii) {
        run += bf2f(LWs[(seg * 8 + ii) * 72 + kc]);
        lc[ii] = run;
      }
      segtot[seg * 64 + kc] = run;
    }
    __syncthreads();
    {
      float off = 0.f, tot = 0.f;
#pragma unroll
      for (int s2 = 0; s2 < 8; ++s2) {
        float t = segtot[s2 * 64 + kc];
        tot += t;
        off += (s2 < seg) ? t : 0.f;
      }
#pragma unroll
      for (int ii = 0; ii < 8; ++ii) {
        const int i = seg * 8 + ii;
        const float cum = off + lc[ii];
        const float cumx = off + (ii > 0 ? lc[ii > 0 ? ii - 1 : 0] : 0.f);
        const float eR = __expf(cum - tot);
        const float eK = __builtin_amdgcn_rcpf(eR);
        const float eX = __expf(cumx - tot);
        const int o = i * 72 + kc;
        RTi[o] = f2bf(bf2f(RTi[o]) * eR);
        KH[o] = f2bf(bf2f(KH[o]) * eK);
        BH[o] = f2bf(bf2f(BH[o]) * eK);
        KT[o] = f2bf(bf2f(KT[o]) * eX);
      }
      if (seg == 0) dS[kc] = __expf(tot);
    }
    __syncthreads();
#pragma unroll
    for (int kt = 0; kt < 4; ++kt) {
      float4 d4 = *(const float4*)(dS + kt * 16 + g * 4);
      T[kt][0] *= d4.x; T[kt][1] *= d4.y; T[kt][2] *= d4.z; T[kt][3] *= d4.w;
    }
#pragma unroll
    for (int tt = 0; tt < 2; ++tt) {
      const int idx = wave * 2 + tt, jt = idx >> 2, it = idx & 3;
      f32x4 akb = (f32x4){0.f, 0.f, 0.f, 0.f}, akk = akb, brk = akb, brb = akb;
      if (jt <= it) {
#pragma unroll
        for (int ks = 0; ks < 2; ++ks) {
          bf16x8 aKH = *(const bf16x8*)(KH + (jt * 16 + l15) * 72 + ks * 32 + g * 8);
          bf16x8 aBH = *(const bf16x8*)(BH + (jt * 16 + l15) * 72 + ks * 32 + g * 8);
          bf16x8 bKT = *(const bf16x8*)(KT + (it * 16 + l15) * 72 + ks * 32 + g * 8);
          bf16x8 bRT = *(const bf16x8*)(RTi + (it * 16 + l15) * 72 + ks * 32 + g * 8);
          akb = __builtin_amdgcn_mfma_f32_16x16x32_bf16(aBH, bKT, akb, 0, 0, 0);
          akk = __builtin_amdgcn_mfma_f32_16x16x32_bf16(aKH, bKT, akk, 0, 0, 0);
          brk = __builtin_amdgcn_mfma_f32_16x16x32_bf16(aKH, bRT, brk, 0, 0, 0);
          brb = __builtin_amdgcn_mfma_f32_16x16x32_bf16(aBH, bRT, brb, 0, 0, 0);
        }
        const int i = it * 16 + l15;
#pragma unroll
        for (int r = 0; r < 4; ++r) {
          const int j = jt * 16 + g * 4 + r;
          akb[r] = (j < i) ? akb[r] : 0.f;
          akk[r] = (j < i) ? akk[r] : 0.f;
          brk[r] = (j <= i) ? brk[r] : 0.f;
          brb[r] = (j <= i) ? brb[r] : 0.f;
        }
      }
      const int orow = (it * 16 + l15), ocol = jt * 16 + g * 4;
      uint2 o;
      o.x = pack2(akk[0], akk[1]); o.y = pack2(akk[2], akk[3]);
      *(uint2*)(MAkk + orow * 72 + ocol) = o;
      o.x = pack2(brk[0], brk[1]); o.y = pack2(brk[2], brk[3]);
      *(uint2*)(MBrk + orow * 72 + ocol) = o;
      o.x = pack2(brb[0], brb[1]); o.y = pack2(brb[2], brb[3]);
      *(uint2*)(MBrb + orow * 72 + ocol) = o;
      *(float4*)(AKB + orow * 68 + ocol) = make_float4(akb[0], akb[1], akb[2], akb[3]);
    }
    __syncthreads();
    bf16x8 tf0 = pack8(T[0], T[1]), tf1 = pack8(T[2], T[3]);
    f32x4 yv[2];
    {
      bf16x8 vf0 = trfrag(VV, 72, 0 * 32 + g * 8, vt * 16, lane);
      bf16x8 vf1 = trfrag(VV, 72, 1 * 32 + g * 8, vt * 16, lane);
#pragma unroll
      for (int ii = 0; ii < 2; ++ii) {
        const int it = ih * 2 + ii;
        f32x4 acc = (f32x4){0.f, 0.f, 0.f, 0.f};
        const bf* qr = KT + (it * 16 + l15) * 72 + g * 4;
        acc = __builtin_amdgcn_mfma_f32_16x16x32_bf16(ld2x64(qr, qr + 16), tf0, acc, 0, 0, 0);
        acc = __builtin_amdgcn_mfma_f32_16x16x32_bf16(ld2x64(qr + 32, qr + 48), tf1, acc, 0, 0, 0);
        const bf* ar = MAkk + (it * 16 + l15) * 72 + g * 8;
        acc = __builtin_amdgcn_mfma_f32_16x16x32_bf16(*(const bf16x8*)ar, vf0, acc, 0, 0, 0);
        acc = __builtin_amdgcn_mfma_f32_16x16x32_bf16(*(const bf16x8*)(ar + 32), vf1, acc, 0, 0, 0);
#pragma unroll
        for (int r = 0; r < 4; ++r) RH[(it * 16 + g * 4 + r) * 68 + vt * 16 + l15] = acc[r];
        f32x4 ya = (f32x4){0.f, 0.f, 0.f, 0.f};
        const bf* rr = RTi + (it * 16 + l15) * 72 + g * 4;
        ya = __builtin_amdgcn_mfma_f32_16x16x32_bf16(ld2x64(rr, rr + 16), tf0, ya, 0, 0, 0);
        ya = __builtin_amdgcn_mfma_f32_16x16x32_bf16(ld2x64(rr + 32, rr + 48), tf1, ya, 0, 0, 0);
        const bf* br = MBrk + (it * 16 + l15) * 72 + g * 8;
        ya = __builtin_amdgcn_mfma_f32_16x16x32_bf16(*(const bf16x8*)br, vf0, ya, 0, 0, 0);
        ya = __builtin_amdgcn_mfma_f32_16x16x32_bf16(*(const bf16x8*)(br + 32), vf1, ya, 0, 0, 0);
        yv[ii] = ya;
      }
#pragma unroll
      for (int kt = 0; kt < 4; ++kt) {
        T[kt] = __builtin_amdgcn_mfma_f32_16x16x32_bf16(trfrag(KH, 72, 0 * 32 + g * 8, kt * 16, lane), vf0, T[kt], 0, 0, 0);
        T[kt] = __builtin_amdgcn_mfma_f32_16x16x32_bf16(trfrag(KH, 72, 1 * 32 + g * 8, kt * 16, lane), vf1, T[kt], 0, 0, 0);
      }
    }
    __syncthreads();
    for (int rb = 0; rb < 8; ++rb) {
      if (wave == 0) {
        float acc[8];
#pragma unroll
        for (int q = 0; q < 8; ++q) acc[q] = RH[(rb * 8 + q) * 68 + lane];
#pragma unroll
        for (int q = 1; q < 8; ++q) {
          const float4 d0 = *(const float4*)(AKB + (rb * 8 + q) * 68 + rb * 8);
          const float4 d1 = *(const float4*)(AKB + (rb * 8 + q) * 68 + rb * 8 + 4);
          const float dd[8] = {d0.x, d0.y, d0.z, d0.w, d1.x, d1.y, d1.z, d1.w};
#pragma unroll
          for (int cc = 0; cc < q; ++cc) acc[q] -= dd[cc] * acc[cc];
        }
#pragma unroll
        for (int q = 0; q < 8; ++q) {
          RH[(rb * 8 + q) * 68 + lane] = acc[q];
          UN[(rb * 8 + q) * 72 + lane] = f2bf(-acc[q]);
        }
      }
      __syncthreads();
      if (rb < 7) {
        float uq[8];
#pragma unroll
        for (int q = 0; q < 8; ++q) uq[q] = RH[(rb * 8 + q) * 68 + lane];
        for (int r = (rb + 1) * 8 + wave; r < 64; r += 8) {
          const float4 a0 = *(const float4*)(AKB + r * 68 + rb * 8);
          const float4 a1 = *(const float4*)(AKB + r * 68 + rb * 8 + 4);
          float Rv = RH[r * 68 + lane];
          Rv -= ((a0.x * uq[0] + a0.y * uq[1]) + (a0.z * uq[2] + a0.w * uq[3])) + ((a1.x * uq[4] + a1.y * uq[5]) + (a1.z * uq[6] + a1.w * uq[7]));
          RH[r * 68 + lane] = Rv;
        }
        __syncthreads();
      }
    }
    __syncthreads();
    {
      bf16x8 uf0 = trfrag(UN, 72, 0 * 32 + g * 8, vt * 16, lane);
      bf16x8 uf1 = trfrag(UN, 72, 1 * 32 + g * 8, vt * 16, lane);
#pragma unroll
      for (int ii = 0; ii < 2; ++ii) {
        const int it = ih * 2 + ii;
        const bf* br = MBrb + (it * 16 + l15) * 72 + g * 8;
        yv[ii] = __builtin_amdgcn_mfma_f32_16x16x32_bf16(*(const bf16x8*)br, uf0, yv[ii], 0, 0, 0);
        yv[ii] = __builtin_amdgcn_mfma_f32_16x16x32_bf16(*(const bf16x8*)(br + 32), uf1, yv[ii], 0, 0, 0);
      }
#pragma unroll
      for (int kt = 0; kt < 4; ++kt) {
        T[kt] = __builtin_amdgcn_mfma_f32_16x16x32_bf16(trfrag(BH, 72, 0 * 32 + g * 8, kt * 16, lane), uf0, T[kt], 0, 0, 0);
        T[kt] = __builtin_amdgcn_mfma_f32_16x16x32_bf16(trfrag(BH, 72, 1 * 32 + g * 8, kt * 16, lane), uf1, T[kt], 0, 0, 0);
      }
    }
#pragma unroll
    for (int ii = 0; ii < 2; ++ii)
#pragma unroll
      for (int r = 0; r < 4; ++r) {
        const int i = (ih * 2 + ii) * 16 + g * 4 + r;
        Y[(size_t)scan_row(b, dir, c * 64 + i) * 512 + h * 64 + vt * 16 + l15] = f2bf(yv[ii][r]);
      }
  }
}

__device__ __forceinline__ void ph_mix1(const P& p, char* smem) {
  for (int u = blockIdx.x; u < 192; u += gridDim.x) {
    if (u < 128) ssd_chain2(p, u, smem);
    else gla_chain2(p, u - 128, smem);
  }
}

__device__ __forceinline__ void ph_post1(const P& p, char* smem) {
  float* ws1 = (float*)smem;
  float* ws2 = ws1 + 32;
  const int tid = tidx(), lane = tid & 63, wave = tid >> 6;
  const bf* SYF = (const bf*)(p.ws + OFF_XRAW);
  const bf* SYB = SYF + (size_t)RT * 512;
  const bf* GYF = (const bf*)(p.ws + OFF_GY);
  const bf* GYB = GYF + (size_t)RT * 512;
  const bf* XBC = (const bf*)(p.ws + OFF_XBC);
  const bf* P1 = (const bf*)(p.ws + OFF_P1C);
  bf* O = (bf*)(p.ws + OFF_HO);
  const float dsk = p.in[44][tid >> 6];
  const float sn = p.in[45][tid];
  const float gn = p.in[50][tid & 127];
  for (int rr0 = blockIdx.x * 4; rr0 < NBAT * SEQ; rr0 += gridDim.x * 4) {
    float y[4], y2[4], zg[4], gg[4];
    int Rr[4];
#pragma unroll
    for (int i = 0; i < 4; ++i) {
      int rr = rr0 + i;
      int R = (rr >> 12) * TA + CTX + (rr & 4095);
      Rr[i] = R;
      size_t o = (size_t)R * 512 + tid;
      y[i] = bf2f(SYF[o]) + bf2f(SYB[o]) + bf2f(XBC[(size_t)R * 1024 + tid]) * dsk;
      zg[i] = bf2f(P1[(size_t)R * 2080 + tid]);
      y2[i] = bf2f(GYF[o]) + bf2f(GYB[o]);
      gg[i] = bf2f(P1[(size_t)R * 2080 + 1552 + tid]);
    }
    __syncthreads();
#pragma unroll
    for (int i = 0; i < 4; ++i) {
      y[i] *= siluf_(zg[i]);
      float s1 = wave_sum(y[i] * y[i]);
      float s2 = wave_sum(y2[i] * y2[i]);
      if (lane == 0) { ws1[i * 8 + wave] = s1; ws2[i * 8 + wave] = s2; }
    }
    __syncthreads();
#pragma unroll
    for (int i = 0; i < 4; ++i) {
      int g4 = i * 8 + (wave >> 2) * 4;
      float t1 = ws1[g4] + ws1[g4 + 1] + ws1[g4 + 2] + ws1[g4 + 3];
      int g2 = i * 8 + (wave >> 1) * 2;
      float t2 = ws2[g2] + ws2[g2 + 1];
      float o1 = y[i] * rsqrtf(t1 * (1.f / 256.f) + 1e-6f) * sn;
      float o2 = y2[i] * rsqrtf(t2 * (1.f / 128.f) + 1e-6f) * gn * siluf_(gg[i]);
      O[(size_t)Rr[i] * 1024 + tid] = f2bf(o1);
      O[(size_t)Rr[i] * 1024 + 512 + tid] = f2bf(o2);
    }
  }
}

__device__ __forceinline__ void ph_final(const P& p) {
  const int lane = tidx() & 63, wave = tidx() >> 6;
  const float* g = p.in[51];
  for (int r = blockIdx.x * 8 + wave; r < NBAT * SEQ; r += gridDim.x * 8) {
    float* row = p.out + (size_t)r * 1024;
    float4 v[4];
    float ss = 0.f;
#pragma unroll
    for (int i = 0; i < 4; ++i) {
      v[i] = *(const float4*)(row + i * 256 + lane * 4);
      ss += v[i].x * v[i].x + v[i].y * v[i].y + v[i].z * v[i].z + v[i].w * v[i].w;
    }
    ss = wave_sum(ss);
    float rs = rsqrtf(ss * (1.f / 1024.f) + 1e-6f);
#pragma unroll
    for (int i = 0; i < 4; ++i) {
      float4 gg = *(const float4*)(g + i * 256 + lane * 4);
      float4 o = make_float4(v[i].x * rs * gg.x, v[i].y * rs * gg.y, v[i].z * rs * gg.z, v[i].w * rs * gg.w);
      *(float4*)(row + i * 256 + lane * 4) = o;
    }
  }
}

constexpr int NPH = 20;
template <int PH>
__device__ __forceinline__ void run_phase(const P& p, char* smem) {
  const bf* WT = (const bf*)(p.ws + OFF_WT);
  const bf* HO = (const bf*)(p.ws + OFF_HO);
  const bf* HID = (const bf*)(p.ws + OFF_HID);
  if constexpr (PH == 0) {
    if (blockIdx.x == 0 && tidx() == 0) { *(int*)(p.ws + OFF_CNT) = 0; *((int*)(p.ws + OFF_CNT) + 1) = 0; }
    ph_mod(p, smem);
    ph_lw(p);
    ph_wt(p, 0, smem);
  } else if constexpr (PH == 1) ph_ada(p, 0, 0, 1, 0);
  else if constexpr (PH == 2) ph_gemm<0>(p, HO, WT + WT_IN, 1024, 13, 0, 0, smem);
  else if constexpr (PH == 3) {
    ph_rope(p, smem);
    ph_rwkv_prep(p, smem);
#ifdef PROBE_PREP
    __syncthreads();
    ph_rwkv_prep(p, smem);
#endif
  }
  else if constexpr (PH == 4) ph_mix0(p, smem);
  else if constexpr (PH == 5) ph_rwkv_post(p);
  else if constexpr (PH == 6) ph_gemm<2>(p, HO, WT + WT_OUT, 1024, 4, 0, 0, smem);
  else if constexpr (PH == 7) ph_ada(p, 0, 1, 0, 0);
  else if constexpr (PH == 8) ph_gemm<3>(p, HO, WT + WT_W1, 1024, 16, 0, 0, smem);
  else if constexpr (PH == 9) ph_gemm<4>(p, HID, WT + WT_W2, 4096, 4, 0, 0, smem);
  else if constexpr (PH == 10) { ph_ada(p, 1, 0, 0, 0); ph_wt(p, 1, smem); }
  else if constexpr (PH == 11) ph_gemm<1>(p, HO, WT + WT_IN, 1024, 13, 1, 0, smem);
  else if constexpr (PH == 12) ph_conv(p);
  else if constexpr (PH == 13) ph_mix1(p, smem);
  else if constexpr (PH == 14) ph_post1(p, smem);
  else if constexpr (PH == 15) ph_gemm<2>(p, HO, WT + WT_OUT, 1024, 4, 1, 1, smem);
  else if constexpr (PH == 16) ph_ada(p, 1, 1, 0, 1);
  else if constexpr (PH == 17) ph_gemm<3>(p, HO, WT + WT_W1, 1024, 16, 1, 1, smem);
  else if constexpr (PH == 18) ph_gemm<4>(p, HID, WT + WT_W2, 4096, 4, 1, 1, smem);
  else ph_final(p);
}

constexpr int LDS_BYTES = 131072 + 64;
template <int PH>
__device__ __forceinline__ void run_all(const P& p, char* smem) {
  run_phase<PH>(p, smem);
#ifdef PROBE_MASK
  if constexpr (((PROBE_MASK) >> PH) & 1) {
    cg::this_grid().sync();
    if constexpr (PH == 4) {
      if (blockIdx.x == 0 && tidx() == 0) *(int*)(p.ws + OFF_CNT) = 0;
      cg::this_grid().sync();
    }
    run_phase<PH>(p, smem);
  }
#endif
  if constexpr (PH + 1 < NPH) {
    cg::this_grid().sync();
    run_all<PH + 1>(p, smem);
  }
}
__global__ void __launch_bounds__(NT) mega(P p) {
  extern __shared__ __attribute__((aligned(16))) char smem[];
  run_all<0>(p, smem);
}

extern "C" void kernel_launch(void* const* d_in, const int* in_sizes, int n_in, void* d_out, int out_size, void* d_ws,
                              size_t ws_size, hipStream_t stream) {
  P p{};
  for (int i = 0; i < 52; ++i) p.in[i] = (const float*)d_in[i];
  p.out = (float*)d_out;
  p.ws = (char*)d_ws;
  static int grid_blocks = 0;
  if (!grid_blocks) {
    int dev = 0, cus = 0, per_cu = 0;
    (void)hipGetDevice(&dev);
    (void)hipDeviceGetAttribute(&cus, hipDeviceAttributeMultiprocessorCount, dev);
    (void)hipFuncSetAttribute((const void*)mega, hipFuncAttributeMaxDynamicSharedMemorySize, LDS_BYTES);
    (void)hipOccupancyMaxActiveBlocksPerMultiprocessor(&per_cu, mega, NT, LDS_BYTES);
    if (per_cu < 1) per_cu = 1;
    if (per_cu > 1) per_cu = 1;
    grid_blocks = cus * per_cu;
  }
  void* args[] = {&p};
  hipError_t e = hipLaunchCooperativeKernel((void*)mega, dim3(grid_blocks), dim3(NT), args, LDS_BYTES, stream);
  if (e != hipSuccess) fprintf(stderr, "cooperative launch failed: %s (grid %d)\n", hipGetErrorString(e), grid_blocks);
}
```

```cpp
#include <hip/hip_runtime.h>
#include <hip/hip_cooperative_groups.h>
#include <cstdio>
namespace cg = cooperative_groups;

#ifndef MODE_COOP
#define MODE_COOP 1
#endif

typedef unsigned short bf;
typedef __attribute__((ext_vector_type(8))) short bf16x8;
typedef __attribute__((ext_vector_type(4))) float f32x4;
typedef __attribute__((ext_vector_type(4))) int i32x4;

constexpr int NT = 512;
constexpr int Dm = 1024, NBAT = 8, SEQ = 4096, CTX = 256, TA = 4352, RT = NBAT * TA;

constexpr size_t OFF_MOD = 0;
constexpr size_t OFF_CNT = 450000;
constexpr size_t OFF_BAR = 458752;
constexpr size_t OFF_WT = 524288;
constexpr size_t WT_IN = 0, WT_OUT = (size_t)3328 * 1024, WT_W1 = WT_OUT + (size_t)1024 * 1024, WT_W2 = WT_W1 + (size_t)4096 * 1024;
constexpr size_t OFF_CTXX = OFF_WT + (size_t)12544 * 1024 * 2;
constexpr size_t OFF_HO = OFF_CTXX + (size_t)2048 * 1024 * 4;
constexpr size_t OFF_BIG = OFF_HO + (size_t)RT * 1024 * 2;
constexpr size_t SZ512 = (size_t)RT * 512 * 2;
constexpr size_t OFF_QKV = OFF_BIG;
constexpr size_t OFF_PREP = OFF_QKV + (size_t)RT * 1536 * 2;
constexpr size_t OFF_G = OFF_PREP + 7 * SZ512;
constexpr size_t OFF_BONUS = OFF_G + SZ512;
constexpr size_t OFF_LW = OFF_BONUS + (size_t)RT * 8 * 4;
constexpr size_t OFF_HID = OFF_BIG;
constexpr size_t OFF_P1C = OFF_BIG;
constexpr size_t OFF_XRAW = OFF_P1C + (size_t)RT * 2080 * 2;
constexpr size_t OFF_DTRAW = OFF_XRAW + (size_t)RT * 1024 * 2;
constexpr size_t OFF_XBC = OFF_DTRAW + (size_t)RT * 16 * 4;
constexpr size_t OFF_GY = OFF_XBC + (size_t)RT * 1024 * 2;

struct P {
  const float* in[52];
  float* out;
  char* ws;
};

__device__ __forceinline__ int tidx() { int t = threadIdx.x; asm volatile("" : "+v"(t)); return t; }
__device__ __forceinline__ bf f2bf(float f) { __bf16 r = (__bf16)f; return __builtin_bit_cast(bf, r); }
__device__ __forceinline__ float bf2f(bf h) { return __uint_as_float(((unsigned)h) << 16); }
__device__ __forceinline__ float bflo(unsigned u) { return __uint_as_float(u << 16); }
__device__ __forceinline__ float bfhi(unsigned u) { return __uint_as_float(u & 0xffff0000u); }
typedef __bf16 bf16x2_t __attribute__((ext_vector_type(2)));
typedef float f32x2_t __attribute__((ext_vector_type(2)));
__device__ __forceinline__ unsigned pack2(float a, float b) { f32x2_t v = {a, b}; bf16x2_t r = __builtin_convertvector(v, bf16x2_t); return __builtin_bit_cast(unsigned, r); }
__device__ __forceinline__ float sigmoidf_(float x) { return __builtin_amdgcn_rcpf(1.f + __expf(-x)); }
__device__ __forceinline__ float softplusf_(float x) { return x > 15.f ? x : __logf(1.f + __expf(x)); }
__device__ __forceinline__ float siluf_(float x) { return x * __builtin_amdgcn_rcpf(1.f + __expf(-x)); }
__device__ __forceinline__ float wave_sum(float v) {
#pragma unroll
  for (int o = 32; o >= 1; o >>= 1) v += __shfl_xor(v, o);
  return v;
}
template <int C>
__device__ __forceinline__ float dppf(float x) {
  return __builtin_bit_cast(float, __builtin_amdgcn_update_dpp(0, __builtin_bit_cast(int, x), C, 0xF, 0xF, true));
}
__device__ __forceinline__ float red16(float x) {
  x += dppf<0xB1>(x);
  x += dppf<0x4E>(x);
  x += dppf<0x141>(x);
  x += dppf<0x128>(x);
  return x;
}
__device__ __forceinline__ float* xrow(const P& p, int R) {
  int b = R / TA, a = R - b * TA;
  if (a < CTX) return (float*)(p.ws + OFF_CTXX) + (size_t)(b * CTX + a) * Dm;
  return p.out + (size_t)(b * SEQ + a - CTX) * Dm;
}
__device__ __forceinline__ const float* inrow(const P& p, int R) {
  int b = R / TA, a = R - b * TA;
  if (a < CTX) return p.in[2] + (size_t)(b * CTX + a) * Dm;
  return p.in[0] + (size_t)(b * SEQ + a - CTX) * Dm;
}
__device__ __forceinline__ int mrow(int R) {
  int b = R / TA, a = R - b * TA;
  return a < CTX ? 8 : b;
}

__device__ __forceinline__ void ph_mod(const P& p, char* smem) {
  float* sc = (float*)smem;
  float* red = sc + 9 * 1024;
  const int tid = tidx();
  bool loaded = false;
  for (int unit = blockIdx.x; unit < 2 * 192; unit += gridDim.x) {
    int layer = unit / 192, cch = unit - layer * 192;
    const float* W = p.in[layer ? 30 : 4];
    const float* bias = p.in[layer ? 31 : 5];
    __syncthreads();
    if (!loaded) {
      for (int i = tid; i < 9 * 1024; i += NT) {
        int r = i >> 10, k = i & 1023;
        float v = (r < 8) ? p.in[1][r * 1024 + k] : p.in[3][k];
        sc[i] = siluf_(v);
      }
      loaded = true;
      __syncthreads();
    }
    int cl = tid & 31, kg = tid >> 5;
    int col = cch * 32 + cl;
    float acc[9];
#pragma unroll
    for (int r = 0; r < 9; ++r) acc[r] = 0.f;
    for (int k = kg * 64; k < kg * 64 + 64; ++k) {
      float w = W[(size_t)k * 6144 + col];
#pragma unroll
      for (int r = 0; r < 9; ++r) acc[r] += sc[r * 1024 + k] * w;
    }
#pragma unroll
    for (int r = 0; r < 9; ++r) red[(kg * 9 + r) * 32 + cl] = acc[r];
    __syncthreads();
    if (tid < 288) {
      int r = tid >> 5, c = tid & 31;
      float s = 0.f;
#pragma unroll
      for (int g = 0; g < 16; ++g) s += red[(g * 9 + r) * 32 + c];
      ((float*)(p.ws + OFF_MOD))[(size_t)(layer * 9 + r) * 6144 + cch * 32 + c] = s + bias[cch * 32 + c];
    }
  }
}

__device__ __forceinline__ void transpose_one(const float* W, bf* Wt, int K, int N, int Npad, int vb, int nvb, char* smem) {
  float* tile = (float*)smem;
  const int tid = tidx();
  int ntn = Npad / 64, ntk = K / 64;
  for (int t = vb; t < ntn * ntk; t += nvb) {
    int tn = t / ntk, tk = t - tn * ntk;
    int n0 = tn * 64, k0 = tk * 64;
    __syncthreads();
#pragma unroll
    for (int i = 0; i < 8; ++i) {
      int kk = (tid >> 6) + 8 * i, nn = tid & 63;
      float v = (n0 + nn < N) ? W[(size_t)(k0 + kk) * N + n0 + nn] : 0.f;
      tile[kk * 65 + nn] = v;
    }
    __syncthreads();
#pragma unroll
    for (int i = 0; i < 8; ++i) {
      int nn = (tid >> 6) + 8 * i, kk = tid & 63;
      Wt[(size_t)(n0 + nn) * K + k0 + kk] = f2bf(tile[kk * 65 + nn]);
    }
  }
}
__device__ __forceinline__ void ph_wt(const P& p, int layer, char* smem) {
  bf* WT = (bf*)(p.ws + OFF_WT);
  int base = layer ? 34 : 8;
  int nin = layer ? 3104 : 3328, ninp = 3328;
  int nb = gridDim.x, b = blockIdx.x;
  for (int mtx = 0; mtx < 4; ++mtx) {
    const float* W = p.in[base + mtx];
    bf* dst = WT + (mtx == 0 ? WT_IN : mtx == 1 ? WT_OUT : mtx == 2 ? WT_W1 : WT_W2);
    int K = mtx == 3 ? 4096 : 1024;
    int N = mtx == 0 ? nin : mtx == 2 ? 4096 : 1024;
    int Np = mtx == 0 ? ninp : N;
    transpose_one(W, dst, K, N, Np, (b + 64 * mtx) % nb, nb, smem);
  }
}

__device__ __forceinline__ void ph_ada(const P& p, int layer, int which, int useInput, int latonly) {
  const int lane = tidx() & 63, wave = tidx() >> 6;
  const float* ng = p.in[(layer ? 32 : 6) + which];
  const float* mod = (const float*)(p.ws + OFF_MOD);
  bf* H = (bf*)(p.ws + OFF_HO);
  for (int R = blockIdx.x * 8 + wave; R < RT; R += gridDim.x * 8) {
    int b = R / TA, a = R - b * TA;
    if (latonly && a < CTX) continue;
    const float* src = useInput ? inrow(p, R) : xrow(p, R);
    float4 v[4];
    float ss = 0.f;
#pragma unroll
    for (int i = 0; i < 4; ++i) {
      v[i] = *(const float4*)(src + i * 256 + lane * 4);
      ss += v[i].x * v[i].x + v[i].y * v[i].y + v[i].z * v[i].z + v[i].w * v[i].w;
    }
    ss = wave_sum(ss);
    float rs = rsqrtf(ss * (1.f / 1024.f) + 1e-6f);
    int mr = a < CTX ? 8 : b;
    const float* sh = mod + (size_t)(layer * 9 + mr) * 6144 + (which * 3 + 0) * 1024;
    const float* scl = mod + (size_t)(layer * 9 + mr) * 6144 + (which * 3 + 1) * 1024;
#pragma unroll
    for (int i = 0; i < 4; ++i) {
      int k = i * 256 + lane * 4;
      float4 g = *(const float4*)(ng + k);
      float4 s4 = *(const float4*)(sh + k);
      float4 c4 = *(const float4*)(scl + k);
      float o0 = v[i].x * rs * g.x * (1.f + c4.x) + s4.x;
      float o1 = v[i].y * rs * g.y * (1.f + c4.y) + s4.y;
      float o2 = v[i].z * rs * g.z * (1.f + c4.z) + s4.z;
      float o3 = v[i].w * rs * g.w * (1.f + c4.w) + s4.w;
      uint2 o;
      o.x = pack2(o0, o1);
      o.y = pack2(o2, o3);
      *(uint2*)(H + (size_t)R * 1024 + k) = o;
    }
  }
}

namespace pg8 {
#define PG8_LAS __attribute__((address_space(3)))
typedef float f32x2 __attribute__((ext_vector_type(2)));
typedef unsigned u32x4 __attribute__((ext_vector_type(4)));
constexpr int BM = 256, BK = 64, HALF = 128, HTB = HALF * BK * 2, STAGE_BYTES = 8 * HTB, NXCD = 8, WGM = 8;
__device__ __forceinline__ int lds_byte(int r, int c) { const int st = (r >> 4) * 2 + (c >> 5), rr = r & 15, cc = c & 31, ob = rr * 64 + cc * 2; return st * 1024 + (ob ^ (((ob >> 9) & 1) << 5)); }
__device__ __forceinline__ void stage_rc(int b, int& R, int& C) { const int st = b / 1024, sb = b % 1024, swz = sb ^ (((sb >> 9) & 1) << 5); R = (st >> 1) * 16 + swz / 64; C = (st & 1) * 32 + (swz % 64) / 2; }
__device__ __forceinline__ int perm32(int rho) { const int n = rho >> 4, i = rho & 15; return 8 * (i >> 2) + 4 * n + (i & 3); }
struct Unit { int pm, pn; };
struct Gemm { const bf* A; const bf* Bt; int K; };
struct Order {
  int nM, nN, nwg, G, c, latonly;
  __device__ void init(int nM_, int nN_, int G_, int c_, int lat) { nM = nM_; nN = nN_; nwg = nM * nN; G = G_; c = c_; latonly = lat; }
  __device__ bool next(int i, Unit& u) const {
    const long L = (long)i * G + c;
    if (L >= nwg) return false;
    int wgid = (int)L;
    { const int q = nwg / NXCD, r = nwg % NXCD, xcd = wgid % NXCD, off = wgid / NXCD; wgid = (xcd < r ? xcd * (q + 1) : r * (q + 1) + (xcd - r) * q) + off; }
    const int nig = WGM * nN, gid = wgid / nig, fm = gid * WGM, gsz = (nM - fm) < WGM ? (nM - fm) : WGM;
    int pm = fm + ((wgid % nig) % gsz);
    u.pn = (wgid % nig) / gsz;
    u.pm = latonly ? ((pm >> 4) * 17 + 1 + (pm & 15)) : pm;
    return true;
  }
};
__device__ __forceinline__ unsigned cvt_pk_bf16(float lo, float hi) { return pack2(lo, hi); }

template <int EPI>
struct Epi {
  static constexpr bool PERM = (EPI == 0 || EPI == 1 || EPI == 3);
  P p;
  int layer;
  __device__ __forceinline__ void operator()(const f32x4 (&acc)[2][2][4][2], const Unit& u, int wr, int wc, int fr, int fq) const {
#pragma unroll
    for (int ai = 0; ai < 2; ++ai)
#pragma unroll
      for (int m = 0; m < 4; ++m) {
        const int row = u.pm * BM + ai * HALF + wr * 64 + m * 16 + fr;
        if constexpr (PERM) {
#pragma unroll
          for (int bj = 0; bj < 2; ++bj) {
            const int c0 = u.pn * BM + bj * HALF + wc * 32 + 8 * fq;
            f32x4 v0 = acc[ai][bj][m][0], v1 = acc[ai][bj][m][1];
            if constexpr (EPI == 3) {
#pragma unroll
              for (int j = 0; j < 4; ++j) { float a = v0[j] > 0.f ? v0[j] : 0.f; v0[j] = a * a; float b2 = v1[j] > 0.f ? v1[j] : 0.f; v1[j] = b2 * b2; }
            }
            u32x4 w;
            w.x = cvt_pk_bf16(v0[0], v0[1]); w.y = cvt_pk_bf16(v0[2], v0[3]); w.z = cvt_pk_bf16(v1[0], v1[1]); w.w = cvt_pk_bf16(v1[2], v1[3]);
            if constexpr (EPI == 0) {
              bf* dst = c0 < 1536 ? (bf*)(p.ws + OFF_QKV) + (size_t)row * 1536 + c0 : (bf*)p.out + (size_t)row * 1792 + (c0 - 1536);
              *(u32x4*)dst = w;
            } else if constexpr (EPI == 1) {
              if (c0 < 512) *(u32x4*)((bf*)(p.ws + OFF_P1C) + (size_t)row * 2080 + c0) = w;
              else if (c0 < 1536) *(u32x4*)((bf*)(p.ws + OFF_XRAW) + (size_t)row * 1024 + (c0 - 512)) = w;
              else if (c0 < 1552) { float* d = (float*)(p.ws + OFF_DTRAW) + (size_t)row * 16 + (c0 - 1536); *(f32x4*)d = v0; *(f32x4*)(d + 4) = v1; }
              else if (c0 < 3104) *(u32x4*)((bf*)(p.ws + OFF_P1C) + (size_t)row * 2080 + (c0 - 1024)) = w;
            } else {
              *(u32x4*)((bf*)(p.ws + OFF_HID) + (size_t)row * 4096 + c0) = w;
            }
          }
        } else {
          const float* gate = (const float*)(p.ws + OFF_MOD) + (size_t)(layer * 9 + mrow(row)) * 6144 + (EPI == 2 ? 2 : 5) * 1024;
          float* xr = xrow(p, row);
          const float* br = (EPI == 2 && layer == 0) ? inrow(p, row) : xr;
#pragma unroll
          for (int bj = 0; bj < 2; ++bj)
#pragma unroll
            for (int n = 0; n < 2; ++n) {
              const int c = u.pn * BM + bj * HALF + wc * 32 + 16 * n + 4 * fq;
              f32x4 gt = *(const f32x4*)(gate + c);
              f32x4 bs = *(const f32x4*)(br + c);
              *(f32x4*)(xr + c) = bs + gt * acc[ai][bj][m][n];
            }
        }
      }
  }
};

template <class EpiT>
__device__ __forceinline__ void gemm_phase(PG8_LAS unsigned char* lds, const Gemm g, const Order& S, const EpiT& E) {
  const int tid = tidx(), wid = __builtin_amdgcn_readfirstlane(tid >> 6), lane = tid & 63, wr = wid >> 2, wc = wid & 3, fr = lane & 15, fq = lane >> 4;
  const int K = g.K, nt = K / BK;
  unsigned voffA[2], voffB[2];
#pragma unroll
  for (int i = 0; i < 2; ++i) { int R, C; stage_rc(tid * 16 + i * 8192, R, C); const int Rb = EpiT::PERM ? ((R & ~31) + perm32(R & 31)) : R;
    voffA[i] = (unsigned)(R * K + C) * 2u; voffB[i] = (unsigned)(Rb * K + C) * 2u; }
  const size_t kstep = (size_t)(BK * 2);
  const size_t hstep = (size_t)HALF * K * 2;
  const size_t tstep = 2 * hstep;
  const unsigned ldsw = (unsigned)wid * 1024u;
  const int aoff = lds_byte(wr * 64 + fr, fq * 8), boff = lds_byte(wc * 32 + fr, fq * 8);
#define PG8_SA(b, h) (((b) * 2 + (h)) * HTB)
#define PG8_SB(b, h) ((4 + (b) * 2 + (h)) * HTB)
#define PG8_STAGE(bufoff, gbase, voff) do { _Pragma("unroll") for (int _i = 0; _i < 2; ++_i) \
        __builtin_amdgcn_global_load_lds((const unsigned*)((const char*)(gbase) + (voff)[_i]), (PG8_LAS unsigned*)(lds + (bufoff) + ldsw + _i * 8192), 16, 0, 0); } while (0)
#define PG8_LDA(dst, b, h) do { _Pragma("unroll") for (int m = 0; m < 4; ++m) _Pragma("unroll") for (int k = 0; k < 2; ++k) dst[m][k] = *(const PG8_LAS bf16x8*)(lds + PG8_SA(b, h) + aoff + m * 2048 + k * 1024); } while (0)
#define PG8_LDB(dst, b, h) do { _Pragma("unroll") for (int n = 0; n < 2; ++n) _Pragma("unroll") for (int k = 0; k < 2; ++k) dst[n][k] = *(const PG8_LAS bf16x8*)(lds + PG8_SB(b, h) + boff + n * 2048 + k * 1024); } while (0)
#define PG8_MMA(ai, bj, At, Bt) do { __builtin_amdgcn_s_setprio(1); _Pragma("unroll") for (int m = 0; m < 4; ++m) _Pragma("unroll") for (int n = 0; n < 2; ++n) _Pragma("unroll") for (int k = 0; k < 2; ++k) \
        acc[ai][bj][m][n] = __builtin_amdgcn_mfma_f32_16x16x32_bf16(Bt[n][k], At[m][k], acc[ai][bj][m][n], 0, 0, 0); __builtin_amdgcn_s_setprio(0); } while (0)
#define PG8_WAIT_V(n) asm volatile("s_waitcnt vmcnt(" #n ")" ::: "memory")
#define PG8_WAIT_L(n) asm volatile("s_waitcnt lgkmcnt(" #n ")" ::: "memory")
#define PG8_BAR __builtin_amdgcn_s_barrier()
#define PG8_SCHED __builtin_amdgcn_sched_barrier(0)
  Unit cur, nxt; int ui = 0;
  if (!S.next(0, cur)) return;
  f32x4 acc[2][2][4][2];
#pragma unroll
  for (int a = 0; a < 2; ++a)
#pragma unroll
    for (int b = 0; b < 2; ++b)
#pragma unroll
      for (int m = 0; m < 4; ++m)
#pragma unroll
        for (int n = 0; n < 2; ++n) acc[a][b][m][n] = (f32x4){0.f, 0.f, 0.f, 0.f};
  bf16x8 At[4][2], B0[2][2], B1[2][2];
  const char* cA = (const char*)g.A + (size_t)cur.pm * tstep; const char* cB = (const char*)g.Bt + (size_t)cur.pn * tstep;
  PG8_STAGE(PG8_SB(0, 0), cB, voffB); PG8_STAGE(PG8_SA(0, 0), cA, voffA); PG8_STAGE(PG8_SB(0, 1), cB + hstep, voffB); PG8_STAGE(PG8_SA(0, 1), cA + hstep, voffA);
  if (wr == 1) PG8_BAR;
  PG8_WAIT_V(4); PG8_BAR;
  PG8_STAGE(PG8_SB(1, 0), cB + kstep, voffB); PG8_STAGE(PG8_SA(1, 0), cA + kstep, voffA); PG8_STAGE(PG8_SB(1, 1), cB + hstep + kstep, voffB);
  PG8_WAIT_V(6); PG8_BAR;
  for (;;) {
    const bool has_next = S.next(ui + 1, nxt);
    const char* nA = has_next ? (const char*)g.A + (size_t)nxt.pm * tstep : cA; const char* nB = has_next ? (const char*)g.Bt + (size_t)nxt.pn * tstep : cB;
    for (int t = 0; t < nt; t += 2) {
      const bool last = (t == nt - 2);
      const char* a1 = cA + (size_t)(t + 1) * kstep;
      const char* a2 = last ? nA : cA + (size_t)(t + 2) * kstep; const char* b2 = last ? nB : cB + (size_t)(t + 2) * kstep;
      const char* a3 = a2 + kstep; const char* b3 = b2 + kstep;
      PG8_LDB(B0, 0, 0); PG8_SCHED; PG8_LDA(At, 0, 0); PG8_STAGE(PG8_SA(1, 1), a1 + hstep, voffA);
      PG8_WAIT_L(8); PG8_BAR; PG8_WAIT_L(0); PG8_MMA(0, 0, At, B0); PG8_BAR; PG8_SCHED;
      PG8_LDB(B1, 0, 1); PG8_STAGE(PG8_SB(0, 0), b2, voffB);
      PG8_BAR; PG8_WAIT_L(0); PG8_MMA(0, 1, At, B1); PG8_BAR;
      PG8_LDA(At, 0, 1); PG8_STAGE(PG8_SA(0, 0), a2, voffA);
      PG8_BAR; PG8_WAIT_L(0); PG8_MMA(1, 0, At, B0); PG8_BAR; PG8_SCHED;
      PG8_STAGE(PG8_SB(0, 1), b2 + hstep, voffB);
      PG8_WAIT_V(6); PG8_BAR; PG8_MMA(1, 1, At, B1); PG8_BAR;
      PG8_LDB(B0, 1, 0); PG8_SCHED; PG8_LDA(At, 1, 0); PG8_STAGE(PG8_SA(0, 1), a2 + hstep, voffA);
      PG8_WAIT_L(8); PG8_BAR; PG8_WAIT_L(0); PG8_MMA(0, 0, At, B0); PG8_BAR; PG8_SCHED;
      PG8_LDB(B1, 1, 1); PG8_STAGE(PG8_SB(1, 0), b3, voffB);
      PG8_BAR; PG8_WAIT_L(0); PG8_MMA(0, 1, At, B1); PG8_BAR;
      PG8_LDA(At, 1, 1); PG8_STAGE(PG8_SA(1, 0), a3, voffA);
      PG8_BAR; PG8_WAIT_L(0); PG8_MMA(1, 0, At, B0); PG8_BAR; PG8_SCHED;
      PG8_STAGE(PG8_SB(1, 1), b3 + hstep, voffB);
      PG8_WAIT_V(6); PG8_BAR; PG8_MMA(1, 1, At, B1); PG8_BAR;
    }
    E(acc, cur, wr, wc, fr, fq);
    if (!has_next) break;
#pragma unroll
    for (int a = 0; a < 2; ++a)
#pragma unroll
      for (int b = 0; b < 2; ++b)
#pragma unroll
        for (int m = 0; m < 4; ++m)
#pragma unroll
          for (int n = 0; n < 2; ++n) acc[a][b][m][n] = (f32x4){0.f, 0.f, 0.f, 0.f};
    cur = nxt; cA = nA; cB = nB; ++ui;
  }
  PG8_WAIT_V(0);
  if (wr == 0) PG8_BAR;
  PG8_BAR;
#undef PG8_SA
#undef PG8_SB
#undef PG8_STAGE
#undef PG8_LDA
#undef PG8_LDB
#undef PG8_MMA
#undef PG8_WAIT_V
#undef PG8_WAIT_L
#undef PG8_BAR
#undef PG8_SCHED
}
}

template <int EPI>
__device__ __forceinline__ void ph_gemm(const P& p, const bf* A, const bf* Bt, int K, int nN, int layer, int latonly, char* smem) {
  pg8::Order S;
  S.init(latonly ? 128 : 136, nN, gridDim.x, blockIdx.x, latonly);
  pg8::Epi<EPI> E{p, layer};
  pg8::Gemm g{A, Bt, K};
  __syncthreads();
  pg8::gemm_phase(( __attribute__((address_space(3))) unsigned char*)smem, g, S, E);
  __syncthreads();
}

__device__ __forceinline__ void ph_rope(const P& p, char* smem) {
  float* tcos = (float*)smem;
  float* tsin = tcos + 1024;
  const int tid = tidx();
  __syncthreads();
  for (int i = tid; i < 1024; i += NT) {
    int c = i >> 4, f = i & 15;
    float inv = powf(10000.f, -(float)f / 16.f);
    float ang = (float)c * inv;
    float sn, cs;
    sincosf(ang, &sn, &cs);
    tcos[i] = cs;
    tsin[i] = sn;
  }
  __syncthreads();
  bf* QKV = (bf*)(p.ws + OFF_QKV);
  for (int it = blockIdx.x * NT + tid; it < RT * 32; it += gridDim.x * NT) {
    int R = it >> 5;
    int vec = (it >> 1) & 15, half = it & 1;
    int b = R / TA, a = R - b * TA;
    bool isq = vec < 8;
    if (!isq && a < CTX) continue;
    bf* ptr = QKV + (size_t)R * 1536 + vec * 64 + half * 32;
    uint4 a0 = *(const uint4*)ptr, a1 = *(const uint4*)(ptr + 8), b0 = *(const uint4*)(ptr + 16), b1 = *(const uint4*)(ptr + 24);
    float x1[16], x2[16];
    x1[0] = bflo(a0.x); x1[1] = bfhi(a0.x); x1[2] = bflo(a0.y); x1[3] = bfhi(a0.y); x1[4] = bflo(a0.z); x1[5] = bfhi(a0.z); x1[6] = bflo(a0.w); x1[7] = bfhi(a0.w);
    x1[8] = bflo(a1.x); x1[9] = bfhi(a1.x); x1[10] = bflo(a1.y); x1[11] = bfhi(a1.y); x1[12] = bflo(a1.z); x1[13] = bfhi(a1.z); x1[14] = bflo(a1.w); x1[15] = bfhi(a1.w);
    x2[0] = bflo(b0.x); x2[1] = bfhi(b0.x); x2[2] = bflo(b0.y); x2[3] = bfhi(b0.y); x2[4] = bflo(b0.z); x2[5] = bfhi(b0.z); x2[6] = bflo(b0.w); x2[7] = bfhi(b0.w);
    x2[8] = bflo(b1.x); x2[9] = bfhi(b1.x); x2[10] = bflo(b1.y); x2[11] = bfhi(b1.y); x2[12] = bflo(b1.z); x2[13] = bfhi(b1.z); x2[14] = bflo(b1.w); x2[15] = bfhi(b1.w);
    const float qs = isq ? 0.125f : 1.f;
    if (a >= CTX) {
      int pos = a - CTX;
      int cidx = half == 0 ? (pos >> 6) : (pos & 63);
#pragma unroll
      for (int f = 0; f < 16; ++f) {
        float cs = tcos[cidx * 16 + f], sn = tsin[cidx * 16 + f];
        float y1 = x1[f] * cs - x2[f] * sn, y2 = x2[f] * cs + x1[f] * sn;
        x1[f] = y1 * qs;
        x2[f] = y2 * qs;
      }
    } else {
#pragma unroll
      for (int f = 0; f < 16; ++f) { x1[f] *= qs; x2[f] *= qs; }
    }
    uint4 o;
    o.x = pack2(x1[0], x1[1]); o.y = pack2(x1[2], x1[3]); o.z = pack2(x1[4], x1[5]); o.w = pack2(x1[6], x1[7]); *(uint4*)ptr = o;
    o.x = pack2(x1[8], x1[9]); o.y = pack2(x1[10], x1[11]); o.z = pack2(x1[12], x1[13]); o.w = pack2(x1[14], x1[15]); *(uint4*)(ptr + 8) = o;
    o.x = pack2(x2[0], x2[1]); o.y = pack2(x2[2], x2[3]); o.z = pack2(x2[4], x2[5]); o.w = pack2(x2[6], x2[7]); *(uint4*)(ptr + 16) = o;
    o.x = pack2(x2[8], x2[9]); o.y = pack2(x2[10], x2[11]); o.z = pack2(x2[12], x2[13]); o.w = pack2(x2[14], x2[15]); *(uint4*)(ptr + 24) = o;
  }
}

__device__ __forceinline__ float shiftmix(const bf* PB, const float* mu, int R, int a, int col) {
  int lo = a < CTX ? 0 : CTX, hi = a < CTX ? CTX : TA;
  float t = bf2f(PB[(size_t)R * 1792 + col]);
  float pv = a > lo ? bf2f(PB[(size_t)(R - 1) * 1792 + col]) : 0.f;
  float nx = a + 1 < hi ? bf2f(PB[(size_t)(R + 1) * 1792 + col]) : 0.f;
  return t + (0.5f * (pv + nx) - t) * mu[col];
}
__device__ __forceinline__ void ph_lw(const P& p) {
  bf* LW = (bf*)(p.ws + OFF_LW);
  const float *w2f = p.in[19], *w2b = p.in[21], *a2 = p.in[23], *g2 = p.in[24];
  for (int i = blockIdx.x * NT + tidx(); i < 512 * 320; i += gridDim.x * NT) {
    int n = i / 320, kk = i - n * 320;
    float v = kk < 64 ? w2f[kk * 512 + n] : kk < 128 ? w2b[(kk - 64) * 512 + n] : kk < 192 ? a2[(kk - 128) * 512 + n] : g2[(kk - 192) * 512 + n];
    LW[i] = f2bf(v);
  }
}
__device__ __forceinline__ float shiftmix_l(const bf* PBs, const float muc, int t, int a, int col) {
  const int lo = a < CTX ? 0 : CTX, hi = a < CTX ? CTX : TA;
  const float x = bf2f(PBs[(t + 1) * 1792 + col]);
  const float pv = a > lo ? bf2f(PBs[t * 1792 + col]) : 0.f;
  const float nx = a + 1 < hi ? bf2f(PBs[(t + 2) * 1792 + col]) : 0.f;
  return x + (0.5f * (pv + nx) - x) * muc;
}
__device__ __forceinline__ void ph_rwkv_prep(const P& p, char* smem) {
  bf* linA = (bf*)smem;
  bf* PBs = linA + 16 * 264;
  const int tid = tidx(), lane = tid & 63, wave = tid >> 6;
  const int l15 = lane & 15, g = lane >> 4;
  const bf* PB = (const bf*)p.out;
  const bf* LW = (const bf*)(p.ws + OFF_LW);
  const float* mu = p.in[17];
  bf* PR = (bf*)(p.ws + OFF_PREP);
  bf* PK = PR + (size_t)RT * 512;
  bf* PV = PK + (size_t)RT * 512;
  bf* PKK = PV + (size_t)RT * 512;
  bf* PKA = PKK + (size_t)RT * 512;
  bf* PLF = PKA + (size_t)RT * 512;
  bf* PLB = PLF + (size_t)RT * 512;
  bf* G = (bf*)(p.ws + OFF_G);
  float* BON = (float*)(p.ws + OFF_BONUS);
  float cw0f[4], cw0b[4], ca0[4], ckk[4], cka[4], crk[4], cmr[4], cmk[4], cmv[4];
#pragma unroll
  for (int nt = 0; nt < 4; ++nt) {
    int c = wave * 64 + nt * 16 + l15;
    cw0f[nt] = p.in[18][c]; cw0b[nt] = p.in[20][c]; ca0[nt] = p.in[22][c]; ckk[nt] = p.in[25][c]; cka[nt] = p.in[26][c]; crk[nt] = p.in[27][c];
    cmr[nt] = mu[c]; cmk[nt] = mu[512 + c]; cmv[nt] = mu[1024 + c];
  }
  for (int unit = blockIdx.x; unit < RT / 16; unit += gridDim.x) {
    const int R0 = unit * 16;
    const int b = R0 / TA, a00 = R0 - b * TA;
    __syncthreads();
    for (int ch = tid; ch < 18 * 224; ch += NT) {
      const int rr = ch / 224, cc = ch - rr * 224;
      const int Rg = R0 - 1 + rr;
      uint4 v = make_uint4(0, 0, 0, 0);
      if (Rg >= 0 && Rg < RT) v = *(const uint4*)(PB + (size_t)Rg * 1792 + cc * 8);
      *(uint4*)(PBs + rr * 1792 + cc * 8) = v;
    }
    __syncthreads();
#pragma unroll
    for (int i = 0; i < 8; ++i) {
      int idx = tid + NT * i;
      int tok = idx >> 8, j = idx & 255;
      float f = shiftmix_l(PBs, mu[1536 + j], tok, a00 + tok, 1536 + j);
      float val = j < 64 ? tanhf(f) : (j < 128 ? f : sigmoidf_(f));
      linA[tok * 264 + j] = f2bf(val);
    }
    __syncthreads();
    f32x4 wf[4], wb[4], aa[4], gg[4];
#pragma unroll
    for (int nt = 0; nt < 4; ++nt) {
      wf[nt] = (f32x4){0.f, 0.f, 0.f, 0.f}; wb[nt] = wf[nt]; aa[nt] = wf[nt]; gg[nt] = wf[nt];
    }
#pragma unroll
    for (int nt = 0; nt < 4; ++nt) {
      const bf* lw = LW + (size_t)(wave * 64 + nt * 16 + l15) * 320 + g * 8;
#pragma unroll
      for (int ks = 0; ks < 2; ++ks) {
        bf16x8 aw = *(const bf16x8*)(linA + l15 * 264 + ks * 32 + g * 8);
        wf[nt] = __builtin_amdgcn_mfma_f32_16x16x32_bf16(aw, *(const bf16x8*)(lw + ks * 32), wf[nt], 0, 0, 0);
        wb[nt] = __builtin_amdgcn_mfma_f32_16x16x32_bf16(aw, *(const bf16x8*)(lw + 64 + ks * 32), wb[nt], 0, 0, 0);
        bf16x8 a_a = *(const bf16x8*)(linA + l15 * 264 + 64 + ks * 32 + g * 8);
        aa[nt] = __builtin_amdgcn_mfma_f32_16x16x32_bf16(a_a, *(const bf16x8*)(lw + 128 + ks * 32), aa[nt], 0, 0, 0);
      }
#pragma unroll
      for (int ks = 0; ks < 4; ++ks) {
        bf16x8 ag = *(const bf16x8*)(linA + l15 * 264 + 128 + ks * 32 + g * 8);
        gg[nt] = __builtin_amdgcn_mfma_f32_16x16x32_bf16(ag, *(const bf16x8*)(lw + 192 + ks * 32), gg[nt], 0, 0, 0);
      }
    }
#pragma unroll
    for (int r = 0; r < 4; ++r) {
      const int t = g * 4 + r;
      const int R = R0 + t, a = a00 + t;
      float fr[4], fv[4], kkv[4], km[4], av[4];
      float n2 = 0.f, bon = 0.f;
#pragma unroll
      for (int nt = 0; nt < 4; ++nt) {
        int c = wave * 64 + nt * 16 + l15;
        fr[nt] = shiftmix_l(PBs, cmr[nt], t, a, c);
        float fk = shiftmix_l(PBs, cmk[nt], t, a, 512 + c);
        fv[nt] = shiftmix_l(PBs, cmv[nt], t, a, 1024 + c);
        av[nt] = sigmoidf_(ca0[nt] + aa[nt][r]);
        kkv[nt] = fk * ckk[nt];
        n2 += kkv[nt] * kkv[nt];
        km[nt] = fk * (1.f + (av[nt] - 1.f) * cka[nt]);
        bon += fr[nt] * km[nt] * crk[nt];
      }
      n2 = red16(n2);
      bon = red16(bon);
      float rn = 1.f / fmaxf(sqrtf(n2), 1e-12f);
#pragma unroll
      for (int nt = 0; nt < 4; ++nt) {
        int c = wave * 64 + nt * 16 + l15;
        size_t o = (size_t)R * 512 + c;
        float lwf = -__expf(-softplusf_(-(cw0f[nt] + wf[nt][r])) - 0.5f);
        float lwb = -__expf(-softplusf_(-(cw0b[nt] + wb[nt][r])) - 0.5f);
        float kk = kkv[nt] * rn;
        PR[o] = f2bf(fr[nt]);
        PK[o] = f2bf(km[nt]);
        PV[o] = f2bf(fv[nt]);
        PKK[o] = f2bf(kk);
        PKA[o] = f2bf(kk * av[nt]);
        PLF[o] = f2bf(lwf);
        PLB[o] = f2bf(lwb);
        G[o] = f2bf(gg[nt][r]);
      }
      if (l15 == 0) BON[(size_t)R * 8 + wave] = bon;
    }
  }
}

__device__ __forceinline__ int scan_row(int b, int dir, int s) {
  int a = dir ? (s < CTX ? CTX - 1 - s : TA + CTX - 1 - s) : s;
  return b * TA + a;
}

__device__ __forceinline__ void rwkv_chain(const P& p, int chain, int half, char* smem) {
  const int dir = chain & 1, h = (chain >> 1) & 7, b = chain >> 4;
  float* cR = (float*)smem;
  float* cW = cR + 2048;
  float* cK = cW + 2048;
  float* cKK = cK + 2048;
  float* cKA = cKK + 2048;
  float* cV = cKA + 2048;
  float* yb = cV + 2048;
  const int tid = tidx(), lane = tid & 63, wave = tid >> 6;
  const int l15 = lane & 15, lg = lane >> 4;
  const bf* PR = (const bf*)(p.ws + OFF_PREP);
  const bf* PK = PR + (size_t)RT * 512;
  const bf* PV = PK + (size_t)RT * 512;
  const bf* PKK = PV + (size_t)RT * 512;
  const bf* PKA = PKK + (size_t)RT * 512;
  const bf* PLW = PKA + (size_t)RT * 512 + (size_t)dir * RT * 512;
  bf* Y = (bf*)p.out + (size_t)dir * RT * 512;
  const int st = tid >> 4, c4 = (tid & 15) * 4;
  const int r0 = half < 0 ? wave * 8 + lg * 2 : half * 32 + (wave & 3) * 8 + lg * 2;
  const bool active = half < 0 || wave < 4;
  const bool ywr = half < 0 || ((c4 >> 5) == half);
  float s0[4], s1[4];
#pragma unroll
  for (int j = 0; j < 4; ++j) { s0[j] = 0.f; s1[j] = 0.f; }
  uint2 gR, gW, gK, gV, gKK, gKA;
  {
    size_t o = (size_t)scan_row(b, dir, st) * 512 + h * 64 + c4;
    gR = *(const uint2*)(PR + o); gW = *(const uint2*)(PLW + o); gK = *(const uint2*)(PK + o);
    gV = *(const uint2*)(PV + o); gKK = *(const uint2*)(PKK + o); gKA = *(const uint2*)(PKA + o);
  }
  const int NCH = TA / 32;
  for (int ch = 0; ch <= NCH; ++ch) {
    __syncthreads();
    if (ch > 0 && ywr) {
      float4 y4 = *(const float4*)(yb + st * 64 + c4);
      uint2 o2;
      o2.x = pack2(y4.x, y4.y);
      o2.y = pack2(y4.z, y4.w);
      *(uint2*)(Y + (size_t)scan_row(b, dir, (ch - 1) * 32 + st) * 512 + h * 64 + c4) = o2;
    }
    if (ch == NCH) break;
    {
      int o = st * 64 + c4;
      *(float4*)(cR + o) = make_float4(bflo(gR.x), bfhi(gR.x), bflo(gR.y), bfhi(gR.y));
      *(float4*)(cW + o) = make_float4(__expf(bflo(gW.x)), __expf(bfhi(gW.x)), __expf(bflo(gW.y)), __expf(bfhi(gW.y)));
      *(float4*)(cK + o) = make_float4(bflo(gK.x), bfhi(gK.x), bflo(gK.y), bfhi(gK.y));
      *(float4*)(cV + o) = make_float4(bflo(gV.x), bfhi(gV.x), bflo(gV.y), bfhi(gV.y));
      *(float4*)(cKK + o) = make_float4(bflo(gKK.x), bfhi(gKK.x), bflo(gKK.y), bfhi(gKK.y));
      *(float4*)(cKA + o) = make_float4(bflo(gKA.x), bfhi(gKA.x), bflo(gKA.y), bfhi(gKA.y));
    }
    __syncthreads();
    if (ch + 1 < NCH) {
      size_t o = (size_t)scan_row(b, dir, (ch + 1) * 32 + st) * 512 + h * 64 + c4;
      gR = *(const uint2*)(PR + o); gW = *(const uint2*)(PLW + o); gK = *(const uint2*)(PK + o);
      gV = *(const uint2*)(PV + o); gKK = *(const uint2*)(PKK + o); gKA = *(const uint2*)(PKA + o);
    }
    if (active) {
      float4 kk4 = *(const float4*)(cKK + l15 * 4);
      float4 w4 = *(const float4*)(cW + l15 * 4);
      float4 k4 = *(const float4*)(cK + l15 * 4);
      float4 ka4 = *(const float4*)(cKA + l15 * 4);
      float4 r4 = *(const float4*)(cR + l15 * 4);
      float2 v2 = *(const float2*)(cV + r0);
#pragma unroll 2
      for (int t = 0; t < 32; ++t) {
        const int tn = (t + 1) & 31;
        float4 nkk4 = *(const float4*)(cKK + tn * 64 + l15 * 4);
        float4 nw4 = *(const float4*)(cW + tn * 64 + l15 * 4);
        float4 nk4 = *(const float4*)(cK + tn * 64 + l15 * 4);
        float4 nka4 = *(const float4*)(cKA + tn * 64 + l15 * 4);
        float4 nr4 = *(const float4*)(cR + tn * 64 + l15 * 4);
        float2 nv2 = *(const float2*)(cV + tn * 64 + r0);
        float sa0 = (s0[0] * kk4.x + s0[1] * kk4.y) + (s0[2] * kk4.z + s0[3] * kk4.w);
        float sa1 = (s1[0] * kk4.x + s1[1] * kk4.y) + (s1[2] * kk4.z + s1[3] * kk4.w);
        float p00 = s0[0] * w4.x + v2.x * k4.x, p01 = s0[1] * w4.y + v2.x * k4.y, p02 = s0[2] * w4.z + v2.x * k4.z, p03 = s0[3] * w4.w + v2.x * k4.w;
        float p10 = s1[0] * w4.x + v2.y * k4.x, p11 = s1[1] * w4.y + v2.y * k4.y, p12 = s1[2] * w4.z + v2.y * k4.z, p13 = s1[3] * w4.w + v2.y * k4.w;
        sa0 = red16(sa0);
        sa1 = red16(sa1);
        s0[0] = p00 - sa0 * ka4.x; s0[1] = p01 - sa0 * ka4.y; s0[2] = p02 - sa0 * ka4.z; s0[3] = p03 - sa0 * ka4.w;
        s1[0] = p10 - sa1 * ka4.x; s1[1] = p11 - sa1 * ka4.y; s1[2] = p12 - sa1 * ka4.z; s1[3] = p13 - sa1 * ka4.w;
        float y0 = (s0[0] * r4.x + s0[1] * r4.y) + (s0[2] * r4.z + s0[3] * r4.w);
        float y1 = (s1[0] * r4.x + s1[1] * r4.y) + (s1[2] * r4.z + s1[3] * r4.w);
        y0 = red16(y0);
        y1 = red16(y1);
        if (l15 == 0) *(float2*)(yb + t * 64 + r0) = make_float2(y0, y1);
        kk4 = nkk4; w4 = nw4; k4 = nk4; ka4 = nka4; r4 = nr4; v2 = nv2;
      }
    }
  }
}


template <int OFFB>
__device__ __forceinline__ bf16x8 tr_pair(const bf* pp) {
  typedef short s16x4_ __attribute__((ext_vector_type(4)));
  s16x4_ v0, v1;
  unsigned addr = (unsigned)(size_t)(__attribute__((address_space(3))) const void*)pp;
  asm volatile("s_waitcnt lgkmcnt(0)\n\tds_read_b64_tr_b16 %0, %2\n\tds_read_b64_tr_b16 %1, %2 offset:%3\n\ts_waitcnt lgkmcnt(0)" : "=&v"(v0), "=&v"(v1) : "v"(addr), "n"(OFFB) : "memory");
  return __builtin_shufflevector(v0, v1, 0, 1, 2, 3, 4, 5, 6, 7);
}
template <int STRB, int OFF2B>
__device__ __forceinline__ void tr_quad(const bf* pp, bf16x8& f0, bf16x8& f1, bf16x8& f2, bf16x8& f3) {
  typedef short s16x4_ __attribute__((ext_vector_type(4)));
  s16x4_ a0, b0, a1, b1, a2, b2, a3, b3;
  unsigned addr = (unsigned)(size_t)(__attribute__((address_space(3))) const void*)pp;
  asm volatile(
      "s_waitcnt lgkmcnt(0)\n\t"
      "ds_read_b64_tr_b16 %0, %8\n\t"
      "ds_read_b64_tr_b16 %1, %8 offset:%9\n\t"
      "ds_read_b64_tr_b16 %2, %8 offset:%10\n\t"
      "ds_read_b64_tr_b16 %3, %8 offset:%11\n\t"
      "ds_read_b64_tr_b16 %4, %8 offset:%12\n\t"
      "ds_read_b64_tr_b16 %5, %8 offset:%13\n\t"
      "ds_read_b64_tr_b16 %6, %8 offset:%14\n\t"
      "ds_read_b64_tr_b16 %7, %8 offset:%15\n\t"
      "s_waitcnt lgkmcnt(0)"
      : "=&v"(a0), "=&v"(b0), "=&v"(a1), "=&v"(b1), "=&v"(a2), "=&v"(b2), "=&v"(a3), "=&v"(b3)
      : "v"(addr), "n"(OFF2B), "n"(STRB), "n"(STRB + OFF2B), "n"(2 * STRB), "n"(2 * STRB + OFF2B), "n"(3 * STRB), "n"(3 * STRB + OFF2B)
      : "memory");
  f0 = __builtin_shufflevector(a0, b0, 0, 1, 2, 3, 4, 5, 6, 7);
  f1 = __builtin_shufflevector(a1, b1, 0, 1, 2, 3, 4, 5, 6, 7);
  f2 = __builtin_shufflevector(a2, b2, 0, 1, 2, 3, 4, 5, 6, 7);
  f3 = __builtin_shufflevector(a3, b3, 0, 1, 2, 3, 4, 5, 6, 7);
}
template <int STRB, int OFF2B>
__device__ __forceinline__ void tr_dual(const bf* pp, bf16x8& f0, bf16x8& f1) {
  typedef short s16x4_ __attribute__((ext_vector_type(4)));
  s16x4_ a0, b0, a1, b1;
  unsigned addr = (unsigned)(size_t)(__attribute__((address_space(3))) const void*)pp;
  asm volatile(
      "s_waitcnt lgkmcnt(0)\n\t"
      "ds_read_b64_tr_b16 %0, %4\n\t"
      "ds_read_b64_tr_b16 %1, %4 offset:%5\n\t"
      "ds_read_b64_tr_b16 %2, %4 offset:%6\n\t"
      "ds_read_b64_tr_b16 %3, %4 offset:%7\n\t"
      "s_waitcnt lgkmcnt(0)"
      : "=&v"(a0), "=&v"(b0), "=&v"(a1), "=&v"(b1)
      : "v"(addr), "n"(OFF2B), "n"(STRB), "n"(STRB + OFF2B)
      : "memory");
  f0 = __builtin_shufflevector(a0, b0, 0, 1, 2, 3, 4, 5, 6, 7);
  f1 = __builtin_shufflevector(a1, b1, 0, 1, 2, 3, 4, 5, 6, 7);
}
__device__ __forceinline__ const bf* trbase(const bf* img, int ld, int r0, int c0, int lane) { return img + (r0 + ((lane & 15) >> 2)) * ld + c0 + (lane & 3) * 4; }
typedef short s16x4 __attribute__((ext_vector_type(4)));
__device__ __forceinline__ void attn_unit(const P& p, int u, char* smem, float lam) {
  bf* Ks = (bf*)smem;
  bf* Vs = Ks + 64 * 136;
  int b, h, nkeys, qa0;
  if (u < 1024) { b = u >> 7; h = (u >> 5) & 3; nkeys = TA; qa0 = CTX + (u & 31) * 128; }
  else { int v = u - 1024; b = v >> 3; h = (v >> 1) & 3; nkeys = CTX; qa0 = (v & 1) * 128; }
  const bf* QKV = (const bf*)(p.ws + OFF_QKV);
  const int tid = tidx(), lane = tid & 63, wave = tid >> 6;
  const int l15 = lane & 15, lg = lane >> 4;
  const size_t rowbase = (size_t)b * TA;
  bf16x8 qf[2][2];
  {
    size_t Rq = rowbase + qa0 + wave * 16 + l15;
#pragma unroll
    for (int m = 0; m < 2; ++m)
#pragma unroll
      for (int ks = 0; ks < 2; ++ks) qf[m][ks] = *(const bf16x8*)(QKV + Rq * 1536 + h * 128 + m * 64 + ks * 32 + lg * 8);
  }
  f32x4 oacc[2][8];
#pragma unroll
  for (int m = 0; m < 2; ++m)
#pragma unroll
    for (int n = 0; n < 8; ++n) oacc[m][n] = (f32x4){0.f, 0.f, 0.f, 0.f};
  float mrun[2] = {-INFINITY, -INFINITY}, lrun[2] = {0.f, 0.f};
  const int sr = tid >> 4, scc = tid & 15;
  const bf* gsrc = QKV + (rowbase + sr) * 1536 + h * 128 + scc * 8;
  uint4 pk0 = *(const uint4*)(gsrc + 512), pv0 = *(const uint4*)(gsrc + 1024);
  uint4 pk1 = *(const uint4*)(gsrc + (size_t)32 * 1536 + 512), pv1 = *(const uint4*)(gsrc + (size_t)32 * 1536 + 1024);
  const int vrow = lg * 4 + (l15 >> 2), vcol = (lane & 3) * 4;
  for (int k0 = 0; k0 < nkeys; k0 += 64) {
    __syncthreads();
    *(uint4*)(Ks + sr * 136 + scc * 8) = pk0;
    *(uint4*)(Ks + (sr + 32) * 136 + scc * 8) = pk1;
    *(uint4*)(Vs + sr * 144 + scc * 8) = pv0;
    *(uint4*)(Vs + (sr + 32) * 144 + scc * 8) = pv1;
    __syncthreads();
    if (k0 + 64 < nkeys) {
      const bf* g2 = gsrc + (size_t)(k0 + 64) * 1536;
      pk0 = *(const uint4*)(g2 + 512); pv0 = *(const uint4*)(g2 + 1024);
      pk1 = *(const uint4*)(g2 + (size_t)32 * 1536 + 512); pv1 = *(const uint4*)(g2 + (size_t)32 * 1536 + 1024);
    }
    bf16x8 pf[2][2];
#pragma unroll
    for (int m = 0; m < 2; ++m) {
      f32x4 s[4];
#pragma unroll
      for (int kt = 0; kt < 4; ++kt) s[kt] = (f32x4){0.f, 0.f, 0.f, 0.f};
#pragma unroll
      for (int ks = 0; ks < 2; ++ks)
#pragma unroll
        for (int kt = 0; kt < 4; ++kt) {
          bf16x8 a = *(const bf16x8*)(Ks + (kt * 16 + l15) * 136 + m * 64 + ks * 32 + lg * 8);
          s[kt] = __builtin_amdgcn_mfma_f32_16x16x32_bf16(a, qf[m][ks], s[kt], 0, 0, 0);
        }
      float mx = fmaxf(fmaxf(s[0][0], s[0][1]), fmaxf(s[0][2], s[0][3]));
#pragma unroll
      for (int kt = 1; kt < 4; ++kt) mx = fmaxf(mx, fmaxf(fmaxf(s[kt][0], s[kt][1]), fmaxf(s[kt][2], s[kt][3])));
      if (__any(mx > mrun[m] + 8.f)) {
        mx = fmaxf(mx, __shfl_xor(mx, 16));
        mx = fmaxf(mx, __shfl_xor(mx, 32));
        float mnew = fmaxf(mrun[m], mx);
        float alpha = __expf(mrun[m] - mnew);
        mrun[m] = mnew;
        lrun[m] *= alpha;
        float al[4];
#pragma unroll
        for (int r = 0; r < 4; ++r) al[r] = __shfl(alpha, lg * 4 + r);
#pragma unroll
        for (int n = 0; n < 8; ++n)
#pragma unroll
          for (int r = 0; r < 4; ++r) oacc[m][n][r] *= al[r];
      }
      const float mcur = mrun[m];
      float ps = 0.f;
#pragma unroll
      for (int kt = 0; kt < 4; ++kt)
#pragma unroll
        for (int r = 0; r < 4; ++r) {
          float e = __expf(s[kt][r] - mcur);
          s[kt][r] = e;
          ps += e;
        }
      lrun[m] += ps;
#pragma unroll
      for (int si = 0; si < 2; ++si) {
        i32x4 t;
        t[0] = (int)pack2(s[2 * si][0], s[2 * si][1]);
        t[1] = (int)pack2(s[2 * si][2], s[2 * si][3]);
        t[2] = (int)pack2(s[2 * si + 1][0], s[2 * si + 1][1]);
        t[3] = (int)pack2(s[2 * si + 1][2], s[2 * si + 1][3]);
        pf[m][si] = __builtin_bit_cast(bf16x8, t);
      }
    }
#pragma unroll
    for (int si = 0; si < 2; ++si)
#pragma unroll
      for (int nq = 0; nq < 2; ++nq) {
        bf16x8 bv[4];
        tr_quad<32, 16 * 144 * 2>(Vs + (si * 32 + vrow) * 144 + nq * 64 + vcol, bv[0], bv[1], bv[2], bv[3]);
#pragma unroll
        for (int n4 = 0; n4 < 4; ++n4) {
          oacc[0][nq * 4 + n4] = __builtin_amdgcn_mfma_f32_16x16x32_bf16(pf[0][si], bv[n4], oacc[0][nq * 4 + n4], 0, 0, 0);
          oacc[1][nq * 4 + n4] = __builtin_amdgcn_mfma_f32_16x16x32_bf16(pf[1][si], bv[n4], oacc[1][nq * 4 + n4], 0, 0, 0);
        }
      }
  }
  float inv[2];
#pragma unroll
  for (int m = 0; m < 2; ++m) {
    float l = lrun[m];
    l += __shfl_xor(l, 16);
    l += __shfl_xor(l, 32);
    inv[m] = 1.f / l;
  }
  float i1[4], i2[4];
#pragma unroll
  for (int r = 0; r < 4; ++r) { i1[r] = __shfl(inv[0], lg * 4 + r); i2[r] = __shfl(inv[1], lg * 4 + r); }
  float ss[4] = {0.f, 0.f, 0.f, 0.f};
#pragma unroll
  for (int n = 0; n < 8; ++n)
#pragma unroll
    for (int r = 0; r < 4; ++r) {
      float o = oacc[0][n][r] * i1[r] - lam * (oacc[1][n][r] * i2[r]);
      oacc[0][n][r] = o;
      ss[r] += o * o;
    }
  const float* subln = p.in[16];
  bf* O = (bf*)(p.ws + OFF_HO);
#pragma unroll
  for (int r = 0; r < 4; ++r) {
    float t = red16(ss[r]);
    float scl = rsqrtf(t * (1.f / 128.f) + 1e-5f) * 0.8f;
    size_t Ro = rowbase + qa0 + wave * 16 + lg * 4 + r;
#pragma unroll
    for (int n = 0; n < 8; ++n) O[Ro * 1024 + h * 128 + n * 16 + l15] = f2bf(oacc[0][n][r] * scl * subln[n * 16 + l15]);
  }
}

__device__ __forceinline__ void rwkv_chain2(const P& p, int chain, char* smem);
__device__ __forceinline__ void ph_mix0(const P& p, char* smem) {
  volatile int* s_unitp = (volatile int*)(smem + 131072);
  for (int u = blockIdx.x; u < 128; u += gridDim.x) rwkv_chain2(p, u, smem);
#ifdef PROBE_RWKV
  __syncthreads();
  for (int u = blockIdx.x; u < 256; u += gridDim.x) rwkv_chain(p, u & 127, u >> 7, smem);
#endif
  float d1 = 0.f, d2 = 0.f;
  for (int i = 0; i < 64; ++i) { d1 += p.in[12][i] * p.in[13][i]; d2 += p.in[14][i] * p.in[15][i]; }
  float lam = expf(d1) - expf(d2) + 0.2f;
  int* cnt = (int*)(p.ws + OFF_CNT);
  while (true) {
    __syncthreads();
    if (tidx() == 0) *s_unitp = atomicAdd(cnt, 1);
    __syncthreads();
    int u = *s_unitp;
    if (u >= 1088) break;
    attn_unit(p, u, smem, lam);
  }
#ifdef PROBE_ATTN
  while (true) {
    __syncthreads();
    if (tidx() == 0) *s_unitp = atomicAdd(cnt + 1, 1);
    __syncthreads();
    int u = *s_unitp;
    if (u >= 1088) break;
    attn_unit(p, u, smem, lam);
  }
#endif
}

__device__ __forceinline__ void ph_rwkv_post(const P& p) {
  const int tid = tidx(), wave = tid >> 6;
  const bf* YF = (const bf*)p.out;
  const bf* YB = YF + (size_t)RT * 512;
  const bf* PV = (const bf*)(p.ws + OFF_PREP) + (size_t)2 * RT * 512;
  const bf* G = (const bf*)(p.ws + OFF_G);
  const float* BON = (const float*)(p.ws + OFF_BONUS);
  bf* O = (bf*)(p.ws + OFF_HO);
  const float lw = p.in[28][tid], lb = p.in[29][tid];
  for (int R0 = blockIdx.x * 4; R0 < RT; R0 += gridDim.x * 4) {
    float yf[4], yb4[4], pv[4], gg[4], bn[4];
#pragma unroll
    for (int i = 0; i < 4; ++i) {
      size_t o = (size_t)(R0 + i) * 512 + tid;
      yf[i] = bf2f(YF[o]); yb4[i] = bf2f(YB[o]); pv[i] = bf2f(PV[o]); gg[i] = bf2f(G[o]); bn[i] = BON[(size_t)(R0 + i) * 8 + wave];
    }
#pragma unroll
    for (int i = 0; i < 4; ++i) {
      float y = yf[i] + yb4[i];
      float mean = wave_sum(y) * (1.f / 64.f);
      float d = y - mean;
      float var = wave_sum(d * d) * (1.f / 64.f);
      float yn = d * rsqrtf(var + 64e-5f) * lw + lb;
      float outv = (yn + bn[i] * pv[i]) * gg[i];
      O[(size_t)(R0 + i) * 1024 + 512 + tid] = f2bf(outv);
    }
  }
}

__device__ __forceinline__ void ph_conv(const P& p) {
  const bf* XR = (const bf*)(p.ws + OFF_XRAW);
  bf* XO = (bf*)(p.ws + OFF_XBC);
  const float* cw = p.in[38];
  const float* cb = p.in[39];
  for (size_t it = (size_t)blockIdx.x * NT + tidx(); it < (size_t)RT * 128; it += (size_t)gridDim.x * NT) {
    int R = (int)(it >> 7), c8 = (int)(it & 127) * 8;
    int b = R / TA, a = R - b * TA;
    int lo = a < CTX ? 0 : CTX, hi = a < CTX ? CTX : TA;
    float acc[8];
#pragma unroll
    for (int e = 0; e < 8; ++e) acc[e] = cb[c8 + e];
#pragma unroll
    for (int j = 0; j < 5; ++j) {
      int aj = a + j - 2;
      if (aj >= lo && aj < hi) {
        uint4 v = *(const uint4*)(XR + (size_t)(R + j - 2) * 1024 + c8);
        const float* w = cw + j * 1024 + c8;
        acc[0] += w[0] * bflo(v.x); acc[1] += w[1] * bfhi(v.x);
        acc[2] += w[2] * bflo(v.y); acc[3] += w[3] * bfhi(v.y);
        acc[4] += w[4] * bflo(v.z); acc[5] += w[5] * bfhi(v.z);
        acc[6] += w[6] * bflo(v.w); acc[7] += w[7] * bfhi(v.w);
      }
    }
    uint4 o;
    o.x = pack2(siluf_(acc[0]), siluf_(acc[1]));
    o.y = pack2(siluf_(acc[2]), siluf_(acc[3]));
    o.z = pack2(siluf_(acc[4]), siluf_(acc[5]));
    o.w = pack2(siluf_(acc[6]), siluf_(acc[7]));
    *(uint4*)(XO + (size_t)R * 1024 + c8) = o;
  }
}

__device__ __forceinline__ void ssd_chain(const P& p, int chain, char* smem) {
  const int dir = chain & 1, hh = (chain >> 1) & 7, b = chain >> 4;
  const int grp = hh >> 2;
  float* cB = (float*)smem;
  float* cC = cB + 4096;
  float* cX = cC + 4096;
  float* cDA = cX + 2048;
  float* yb = cDA + 32;
  const int tid = tidx(), lane = tid & 63, wave = tid >> 6;
  const int l15 = lane & 15, lg = lane >> 4;
  const bf* XBC = (const bf*)(p.ws + OFF_XBC);
  const float* DTR = (const float*)(p.ws + OFF_DTRAW);
  bf* Y = (bf*)(p.ws + OFF_XRAW) + (size_t)dir * RT * 512;
  const float dtb = p.in[dir ? 42 : 40][hh];
  const float Aneg = -expf(p.in[dir ? 43 : 41][hh]);
  const int st = tid >> 4, q = tid & 15;
  const int r0 = wave * 8 + lg * 2;
  float s0[8], s1[8];
#pragma unroll
  for (int j = 0; j < 8; ++j) { s0[j] = 0.f; s1[j] = 0.f; }
  uint4 gB, gC;
  uint2 gX;
  float gD;
  {
    size_t R = (size_t)scan_row(b, dir, st);
    gB = *(const uint4*)(XBC + R * 1024 + 512 + grp * 128 + q * 8);
    gC = *(const uint4*)(XBC + R * 1024 + 768 + grp * 128 + q * 8);
    gX = *(const uint2*)(XBC + R * 1024 + hh * 64 + q * 4);
    gD = DTR[R * 16 + dir * 8 + hh];
  }
  const int NCH = TA / 32;
  for (int ch = 0; ch <= NCH; ++ch) {
    __syncthreads();
    if (ch > 0) {
      float4 y4 = *(const float4*)(yb + st * 64 + q * 4);
      uint2 o2;
      o2.x = pack2(y4.x, y4.y);
      o2.y = pack2(y4.z, y4.w);
      *(uint2*)(Y + (size_t)scan_row(b, dir, (ch - 1) * 32 + st) * 512 + hh * 64 + q * 4) = o2;
    }
    if (ch == NCH) break;
    {
      float dt = softplusf_(gD + dtb);
      float dA = expf(dt * Aneg);
      float* d = cB + st * 128 + q * 8;
      *(float4*)d = make_float4(bflo(gB.x), bfhi(gB.x), bflo(gB.y), bfhi(gB.y));
      *(float4*)(d + 4) = make_float4(bflo(gB.z), bfhi(gB.z), bflo(gB.w), bfhi(gB.w));
      d = cC + st * 128 + q * 8;
      *(float4*)d = make_float4(bflo(gC.x), bfhi(gC.x), bflo(gC.y), bfhi(gC.y));
      *(float4*)(d + 4) = make_float4(bflo(gC.z), bfhi(gC.z), bflo(gC.w), bfhi(gC.w));
      *(float4*)(cX + st * 64 + q * 4) = make_float4(bflo(gX.x) * dt, bfhi(gX.x) * dt, bflo(gX.y) * dt, bfhi(gX.y) * dt);
      if (q == 0) cDA[st] = dA;
    }
    __syncthreads();
    if (ch + 1 < NCH) {
      size_t R = (size_t)scan_row(b, dir, (ch + 1) * 32 + st);
      gB = *(const uint4*)(XBC + R * 1024 + 512 + grp * 128 + q * 8);
      gC = *(const uint4*)(XBC + R * 1024 + 768 + grp * 128 + q * 8);
      gX = *(const uint2*)(XBC + R * 1024 + hh * 64 + q * 4);
      gD = DTR[R * 16 + dir * 8 + hh];
    }
#pragma unroll 4
    for (int t = 0; t < 32; ++t) {
      float4 b0 = *(const float4*)(cB + t * 128 + l15 * 8);
      float4 b1 = *(const float4*)(cB + t * 128 + l15 * 8 + 4);
      float4 c0 = *(const float4*)(cC + t * 128 + l15 * 8);
      float4 c1 = *(const float4*)(cC + t * 128 + l15 * 8 + 4);
      float2 x2 = *(const float2*)(cX + t * 64 + r0);
      float dA = cDA[t];
      s0[0] = s0[0] * dA + x2.x * b0.x; s0[1] = s0[1] * dA + x2.x * b0.y; s0[2] = s0[2] * dA + x2.x * b0.z; s0[3] = s0[3] * dA + x2.x * b0.w;
      s0[4] = s0[4] * dA + x2.x * b1.x; s0[5] = s0[5] * dA + x2.x * b1.y; s0[6] = s0[6] * dA + x2.x * b1.z; s0[7] = s0[7] * dA + x2.x * b1.w;
      s1[0] = s1[0] * dA + x2.y * b0.x; s1[1] = s1[1] * dA + x2.y * b0.y; s1[2] = s1[2] * dA + x2.y * b0.z; s1[3] = s1[3] * dA + x2.y * b0.w;
      s1[4] = s1[4] * dA + x2.y * b1.x; s1[5] = s1[5] * dA + x2.y * b1.y; s1[6] = s1[6] * dA + x2.y * b1.z; s1[7] = s1[7] * dA + x2.y * b1.w;
      float y0 = s0[0] * c0.x + s0[1] * c0.y + s0[2] * c0.z + s0[3] * c0.w + s0[4] * c1.x + s0[5] * c1.y + s0[6] * c1.z + s0[7] * c1.w;
      float y1 = s1[0] * c0.x + s1[1] * c0.y + s1[2] * c0.z + s1[3] * c0.w + s1[4] * c1.x + s1[5] * c1.y + s1[6] * c1.z + s1[7] * c1.w;
      y0 = red16(y0);
      y1 = red16(y1);
      if (l15 == 0) *(float2*)(yb + t * 64 + r0) = make_float2(y0, y1);
    }
  }
}

__device__ __forceinline__ void gla_chain(const P& p, int chain, char* smem) {
  const int dir = chain & 1, h = (chain >> 1) & 3, b = chain >> 3;
  float* cQ = (float*)smem;
  float* cK = cQ + 2048;
  float* cD = cK + 2048;
  float* cV = cD + 2048;
  float* yb = cV + 4096;
  float* up = yb + 4096;
  float* gbias = up + 1024;
  const int tid = tidx(), lane = tid & 63, wave = tid >> 6;
  const int l15 = lane & 15, lg = lane >> 4;
  const bf* P1 = (const bf*)(p.ws + OFF_P1C);
  bf* Y = (bf*)(p.ws + OFF_GY) + (size_t)dir * RT * 512;
  const float* gup = p.in[dir ? 48 : 46];
  const float* gb = p.in[dir ? 49 : 47];
  __syncthreads();
  for (int i = tid; i < 1024; i += NT) up[i] = gup[(i >> 6) * 256 + h * 64 + (i & 63)];
  if (tid < 64) gbias[tid] = gb[h * 64 + tid];
  const int st = tid >> 4, q = tid & 15;
  const int r0 = wave * 16 + lg * 4;
  float s[4][4];
#pragma unroll
  for (int r = 0; r < 4; ++r)
#pragma unroll
    for (int j = 0; j < 4; ++j) s[r][j] = 0.f;
  uint2 gQ, gK;
  uint4 gV, gG0, gG1;
  {
    const bf* row = P1 + (size_t)scan_row(b, dir, st) * 2080;
    gQ = *(const uint2*)(row + 528 + h * 64 + q * 4);
    gK = *(const uint2*)(row + 784 + h * 64 + q * 4);
    gV = *(const uint4*)(row + 1040 + h * 128 + q * 8);
    gG0 = *(const uint4*)(row + 2064);
    gG1 = *(const uint4*)(row + 2072);
  }
  const int NCH = TA / 32;
  for (int ch = 0; ch <= NCH; ++ch) {
    __syncthreads();
    if (ch > 0) {
      float4 ya = *(const float4*)(yb + st * 128 + q * 8);
      float4 yc = *(const float4*)(yb + st * 128 + q * 8 + 4);
      uint4 o4;
      o4.x = pack2(ya.x, ya.y); o4.y = pack2(ya.z, ya.w); o4.z = pack2(yc.x, yc.y); o4.w = pack2(yc.z, yc.w);
      *(uint4*)(Y + (size_t)scan_row(b, dir, (ch - 1) * 32 + st) * 512 + h * 128 + q * 8) = o4;
    }
    if (ch == NCH) break;
    {
      float gd[16];
      gd[0] = bflo(gG0.x); gd[1] = bfhi(gG0.x); gd[2] = bflo(gG0.y); gd[3] = bfhi(gG0.y);
      gd[4] = bflo(gG0.z); gd[5] = bfhi(gG0.z); gd[6] = bflo(gG0.w); gd[7] = bfhi(gG0.w);
      gd[8] = bflo(gG1.x); gd[9] = bfhi(gG1.x); gd[10] = bflo(gG1.y); gd[11] = bfhi(gG1.y);
      gd[12] = bflo(gG1.z); gd[13] = bfhi(gG1.z); gd[14] = bflo(gG1.w); gd[15] = bfhi(gG1.w);
      float4 z = *(const float4*)(gbias + q * 4);
#pragma unroll
      for (int i = 0; i < 16; ++i) {
        float4 u4 = *(const float4*)(up + i * 64 + q * 4);
        z.x += gd[i] * u4.x; z.y += gd[i] * u4.y; z.z += gd[i] * u4.z; z.w += gd[i] * u4.w;
      }
      float4 dd;
      dd.x = expf(-softplusf_(-z.x) * (1.f / 16.f));
      dd.y = expf(-softplusf_(-z.y) * (1.f / 16.f));
      dd.z = expf(-softplusf_(-z.z) * (1.f / 16.f));
      dd.w = expf(-softplusf_(-z.w) * (1.f / 16.f));
      *(float4*)(cD + st * 64 + q * 4) = dd;
      *(float4*)(cQ + st * 64 + q * 4) = make_float4(bflo(gQ.x) * 0.125f, bfhi(gQ.x) * 0.125f, bflo(gQ.y) * 0.125f, bfhi(gQ.y) * 0.125f);
      *(float4*)(cK + st * 64 + q * 4) = make_float4(bflo(gK.x), bfhi(gK.x), bflo(gK.y), bfhi(gK.y));
      float* d = cV + st * 128 + q * 8;
      *(float4*)d = make_float4(bflo(gV.x), bfhi(gV.x), bflo(gV.y), bfhi(gV.y));
      *(float4*)(d + 4) = make_float4(bflo(gV.z), bfhi(gV.z), bflo(gV.w), bfhi(gV.w));
    }
    __syncthreads();
    if (ch + 1 < NCH) {
      const bf* row = P1 + (size_t)scan_row(b, dir, (ch + 1) * 32 + st) * 2080;
      gQ = *(const uint2*)(row + 528 + h * 64 + q * 4);
      gK = *(const uint2*)(row + 784 + h * 64 + q * 4);
      gV = *(const uint4*)(row + 1040 + h * 128 + q * 8);
      gG0 = *(const uint4*)(row + 2064);
      gG1 = *(const uint4*)(row + 2072);
    }
#pragma unroll 4
    for (int t = 0; t < 32; ++t) {
      float4 q4 = *(const float4*)(cQ + t * 64 + l15 * 4);
      float4 k4 = *(const float4*)(cK + t * 64 + l15 * 4);
      float4 d4 = *(const float4*)(cD + t * 64 + l15 * 4);
      float4 v4 = *(const float4*)(cV + t * 128 + r0);
      float vv[4] = {v4.x, v4.y, v4.z, v4.w};
      float yy[4];
#pragma unroll
      for (int r = 0; r < 4; ++r) {
        s[r][0] = s[r][0] * d4.x + k4.x * vv[r];
        s[r][1] = s[r][1] * d4.y + k4.y * vv[r];
        s[r][2] = s[r][2] * d4.z + k4.z * vv[r];
        s[r][3] = s[r][3] * d4.w + k4.w * vv[r];
        yy[r] = red16(s[r][0] * q4.x + s[r][1] * q4.y + s[r][2] * q4.z + s[r][3] * q4.w);
      }
      if (l15 == 0) *(float4*)(yb + t * 128 + r0) = make_float4(yy[0], yy[1], yy[2], yy[3]);
    }
  }
}

typedef __attribute__((address_space(3))) s16x4* lds_s16x4p;
template <int LD>
__device__ __forceinline__ bf16x8 trfrag_t(const bf* img, int r0, int c0, int lane) {
  const bf* pp = img + (r0 + ((lane & 15) >> 2)) * LD + c0 + (lane & 3) * 4;
  return tr_pair<4 * LD * 2>(pp);
}
#define trfrag(img, ld, r0, c0, lane) trfrag_t<ld>(img, r0, c0, lane)
__device__ __forceinline__ bf16x8 pack8(f32x4 a, f32x4 b) {
  i32x4 t;
  t[0] = (int)pack2(a[0], a[1]); t[1] = (int)pack2(a[2], a[3]); t[2] = (int)pack2(b[0], b[1]); t[3] = (int)pack2(b[2], b[3]);
  return __builtin_bit_cast(bf16x8, t);
}
__device__ __forceinline__ bf16x8 ld2x64(const bf* p0, const bf* p1) {
  uint2 a = *(const uint2*)p0, b2 = *(const uint2*)p1;
  i32x4 t;
  t[0] = (int)a.x; t[1] = (int)a.y; t[2] = (int)b2.x; t[3] = (int)b2.y;
  return __builtin_bit_cast(bf16x8, t);
}

__device__ __forceinline__ void gla_chain2(const P& p, int chain, char* smem) {
  const int dir = chain & 1, h = (chain >> 1) & 3, b = chain >> 3;
  bf* Qs = (bf*)smem;
  bf* Ks = Qs + 64 * 72;
  bf* Vs = Ks + 64 * 72;
  bf* Ps = Vs + 64 * 144;
  bf* GD = Ps + 64 * 72;
  float* segtot = (float*)(GD + 64 * 16);
  float* dS = segtot + 512;
  const int tid = tidx(), lane = tid & 63, wave = tid >> 6;
  const int l15 = lane & 15, g = lane >> 4;
  const bf* P1 = (const bf*)(p.ws + OFF_P1C);
  bf* Y = (bf*)(p.ws + OFF_GY) + (size_t)dir * RT * 512;
  const float* gup = p.in[dir ? 48 : 46];
  const float* gb = p.in[dir ? 49 : 47];
  const int kc = tid & 63, seg = tid >> 6;
  float upr[16];
#pragma unroll
  for (int r = 0; r < 16; ++r) upr[r] = gup[r * 256 + h * 64 + kc];
  const float bk = gb[h * 64 + kc];
  const int stok = tid >> 3, sc8 = (tid & 7) * 8;
  f32x4 S[4];
#pragma unroll
  for (int kt = 0; kt < 4; ++kt) S[kt] = (f32x4){0.f, 0.f, 0.f, 0.f};
  uint4 rq, rk, rv0, rv1, rg = make_uint4(0, 0, 0, 0);
  {
    const bf* row = P1 + (size_t)scan_row(b, dir, stok) * 2080;
    rq = *(const uint4*)(row + 528 + h * 64 + sc8);
    rk = *(const uint4*)(row + 784 + h * 64 + sc8);
    rv0 = *(const uint4*)(row + 1040 + h * 128 + sc8 * 2);
    rv1 = *(const uint4*)(row + 1040 + h * 128 + sc8 * 2 + 8);
    if (tid < 128) rg = *(const uint4*)(P1 + (size_t)scan_row(b, dir, tid >> 1) * 2080 + 2064 + (tid & 1) * 8);
  }
  const int NCH = TA / 64;
  for (int c = 0; c < NCH; ++c) {
    __syncthreads();
    *(uint4*)(Qs + stok * 72 + sc8) = rq;
    *(uint4*)(Ks + stok * 72 + sc8) = rk;
    *(uint4*)(Vs + stok * 144 + sc8 * 2) = rv0;
    *(uint4*)(Vs + stok * 144 + sc8 * 2 + 8) = rv1;
    if (tid < 128) *(uint4*)(GD + (tid >> 1) * 16 + (tid & 1) * 8) = rg;
    __syncthreads();
    if (c + 1 < NCH) {
      const bf* row = P1 + (size_t)scan_row(b, dir, (c + 1) * 64 + stok) * 2080;
      rq = *(const uint4*)(row + 528 + h * 64 + sc8);
      rk = *(const uint4*)(row + 784 + h * 64 + sc8);
      rv0 = *(const uint4*)(row + 1040 + h * 128 + sc8 * 2);
      rv1 = *(const uint4*)(row + 1040 + h * 128 + sc8 * 2 + 8);
      if (tid < 128) rg = *(const uint4*)(P1 + (size_t)scan_row(b, dir, (c + 1) * 64 + (tid >> 1)) * 2080 + 2064 + (tid & 1) * 8);
    }
    float lc[8];
    {
      float run = 0.f;
#pragma unroll
      for (int ii = 0; ii < 8; ++ii) {
        const bf* gr = GD + (seg * 8 + ii) * 16;
        uint4 g0 = *(const uint4*)gr, g1 = *(const uint4*)(gr + 8);
        float z = bk;
        z += bflo(g0.x) * upr[0] + bfhi(g0.x) * upr[1] + bflo(g0.y) * upr[2] + bfhi(g0.y) * upr[3];
        z += bflo(g0.z) * upr[4] + bfhi(g0.z) * upr[5] + bflo(g0.w) * upr[6] + bfhi(g0.w) * upr[7];
        z += bflo(g1.x) * upr[8] + bfhi(g1.x) * upr[9] + bflo(g1.y) * upr[10] + bfhi(g1.y) * upr[11];
        z += bflo(g1.z) * upr[12] + bfhi(g1.z) * upr[13] + bflo(g1.w) * upr[14] + bfhi(g1.w) * upr[15];
        run += -softplusf_(-z) * (1.f / 16.f);
        lc[ii] = run;
      }
      segtot[seg * 64 + kc] = run;
    }
    __syncthreads();
    {
      float off = 0.f, tot = 0.f;
#pragma unroll
      for (int s2 = 0; s2 < 8; ++s2) {
        float t = segtot[s2 * 64 + kc];
        tot += t;
        off += (s2 < seg) ? t : 0.f;
      }
#pragma unroll
      for (int ii = 0; ii < 8; ++ii) {
        int i = seg * 8 + ii;
        float cum = off + lc[ii];
        float qv = bf2f(Qs[i * 72 + kc]), kv = bf2f(Ks[i * 72 + kc]);
        float eq = __expf(cum - tot);
        Qs[i * 72 + kc] = f2bf(qv * 0.125f * eq);
        Ks[i * 72 + kc] = f2bf(kv * __builtin_amdgcn_rcpf(eq));
      }
      if (seg == 0) dS[kc] = __expf(tot);
    }
    __syncthreads();
#pragma unroll
    for (int kt = 0; kt < 4; ++kt) {
      float4 d4 = *(const float4*)(dS + kt * 16 + g * 4);
      S[kt][0] *= d4.x; S[kt][1] *= d4.y; S[kt][2] *= d4.z; S[kt][3] *= d4.w;
    }
#pragma unroll
    for (int tt = 0; tt < 2; ++tt) {
      int idx = wave * 2 + tt, jt = idx >> 2, it = idx & 3;
      f32x4 acc = (f32x4){0.f, 0.f, 0.f, 0.f};
      if (jt <= it) {
#pragma unroll
        for (int ks = 0; ks < 2; ++ks) {
          bf16x8 a = *(const bf16x8*)(Ks + (jt * 16 + l15) * 72 + ks * 32 + g * 8);
          bf16x8 bq = *(const bf16x8*)(Qs + (it * 16 + l15) * 72 + ks * 32 + g * 8);
          acc = __builtin_amdgcn_mfma_f32_16x16x32_bf16(a, bq, acc, 0, 0, 0);
        }
        int i = it * 16 + l15;
#pragma unroll
        for (int r = 0; r < 4; ++r) { int j = jt * 16 + g * 4 + r; acc[r] = (j <= i) ? acc[r] : 0.f; }
      }
      uint2 o;
      o.x = pack2(acc[0], acc[1]);
      o.y = pack2(acc[2], acc[3]);
      *(uint2*)(Ps + (it * 16 + l15) * 72 + jt * 16 + g * 4) = o;
    }
    __syncthreads();
    f32x4 y[4];
#pragma unroll
    for (int it = 0; it < 4; ++it) y[it] = (f32x4){0.f, 0.f, 0.f, 0.f};
#pragma unroll
    for (int s2 = 0; s2 < 2; ++s2) {
      bf16x8 sf = pack8(S[2 * s2], S[2 * s2 + 1]);
#pragma unroll
      for (int it = 0; it < 4; ++it) {
        const bf* qr = Qs + (it * 16 + l15) * 72 + g * 4;
        bf16x8 aq = ld2x64(qr + (2 * s2) * 16, qr + (2 * s2 + 1) * 16);
        y[it] = __builtin_amdgcn_mfma_f32_16x16x32_bf16(aq, sf, y[it], 0, 0, 0);
      }
    }
    {
      bf16x8 vfs[2];
      tr_dual<32 * 144 * 2, 4 * 144 * 2>(trbase(Vs, 144, g * 8, wave * 16, lane), vfs[0], vfs[1]);
#pragma unroll
      for (int s2 = 0; s2 < 2; ++s2) {
#pragma unroll
        for (int it = 0; it < 4; ++it) {
          bf16x8 ap = *(const bf16x8*)(Ps + (it * 16 + l15) * 72 + s2 * 32 + g * 8);
          y[it] = __builtin_amdgcn_mfma_f32_16x16x32_bf16(ap, vfs[s2], y[it], 0, 0, 0);
        }
        bf16x8 ak[4];
        tr_quad<32, 4 * 72 * 2>(trbase(Ks, 72, s2 * 32 + g * 8, 0, lane), ak[0], ak[1], ak[2], ak[3]);
#pragma unroll
        for (int kt = 0; kt < 4; ++kt) S[kt] = __builtin_amdgcn_mfma_f32_16x16x32_bf16(ak[kt], vfs[s2], S[kt], 0, 0, 0);
      }
    }
#pragma unroll
    for (int it = 0; it < 4; ++it)
#pragma unroll
      for (int r = 0; r < 4; ++r) {
        int i = it * 16 + g * 4 + r;
        Y[(size_t)scan_row(b, dir, c * 64 + i) * 512 + h * 128 + wave * 16 + l15] = f2bf(y[it][r]);
      }
  }
}

__device__ __forceinline__ void ssd_chain2(const P& p, int chain, char* smem) {
  const int dir = chain & 1, hh = (chain >> 1) & 7, b = chain >> 4;
  const int grp = hh >> 2;
  bf* Cs = (bf*)smem;
  bf* Bs = Cs + 64 * 136;
  bf* Xs = Bs + 64 * 136;
  bf* Xw = Xs + 64 * 72;
  bf* Ps = Xw + 64 * 72;
  float* dtS = (float*)(Ps + 64 * 72);
  float* cumS = dtS + 64;
  float* ecS = cumS + 64;
  float* totS = ecS + 64;
  const int tid = tidx(), lane = tid & 63, wave = tid >> 6;
  const int l15 = lane & 15, g = lane >> 4;
  const int vt = wave & 3, ih = wave >> 2;
  const bf* XBC = (const bf*)(p.ws + OFF_XBC);
  const float* DTR = (const float*)(p.ws + OFF_DTRAW);
  bf* Y = (bf*)(p.ws + OFF_XRAW) + (size_t)dir * RT * 512;
  const float dtb = p.in[dir ? 42 : 40][hh];
  const float Aneg = -expf(p.in[dir ? 43 : 41][hh]);
  const int stok = tid >> 3, sc = tid & 7;
  f32x4 S[8];
#pragma unroll
  for (int nt = 0; nt < 8; ++nt) S[nt] = (f32x4){0.f, 0.f, 0.f, 0.f};
  uint4 rc0, rc1, rb0, rb1, rx;
  float rdt = 0.f;
  {
    const bf* row = XBC + (size_t)scan_row(b, dir, stok) * 1024;
    rb0 = *(const uint4*)(row + 512 + grp * 128 + sc * 16);
    rb1 = *(const uint4*)(row + 512 + grp * 128 + sc * 16 + 8);
    rc0 = *(const uint4*)(row + 768 + grp * 128 + sc * 16);
    rc1 = *(const uint4*)(row + 768 + grp * 128 + sc * 16 + 8);
    rx = *(const uint4*)(row + hh * 64 + sc * 8);
    if (tid < 64) rdt = DTR[(size_t)scan_row(b, dir, tid) * 16 + dir * 8 + hh];
  }
  const int NCH = TA / 64;
  for (int c = 0; c < NCH; ++c) {
    __syncthreads();
    *(uint4*)(Cs + stok * 136 + sc * 16) = rc0;
    *(uint4*)(Cs + stok * 136 + sc * 16 + 8) = rc1;
    *(uint4*)(Bs + stok * 136 + sc * 16) = rb0;
    *(uint4*)(Bs + stok * 136 + sc * 16 + 8) = rb1;
    if (tid < 64) {
      float dt = softplusf_(rdt + dtb);
      float cum = dt * Aneg;
#pragma unroll
      for (int o = 1; o < 64; o <<= 1) {
        float t = __shfl_up(cum, o);
        if (lane >= o) cum += t;
      }
      float tot = __shfl(cum, 63);
      dtS[lane] = dt;
      cumS[lane] = cum;
      ecS[lane] = __expf(cum);
      if (lane == 0) totS[0] = tot;
    }
    __syncthreads();
    const uint4 cx = rx;
    if (c + 1 < NCH) {
      const bf* row = XBC + (size_t)scan_row(b, dir, (c + 1) * 64 + stok) * 1024;
      rb0 = *(const uint4*)(row + 512 + grp * 128 + sc * 16);
      rb1 = *(const uint4*)(row + 512 + grp * 128 + sc * 16 + 8);
      rc0 = *(const uint4*)(row + 768 + grp * 128 + sc * 16);
      rc1 = *(const uint4*)(row + 768 + grp * 128 + sc * 16 + 8);
      rx = *(const uint4*)(row + hh * 64 + sc * 8);
      if (tid < 64) rdt = DTR[(size_t)scan_row(b, dir, (c + 1) * 64 + tid) * 16 + dir * 8 + hh];
    }
    const float tot = totS[0];
    {
      float dt = dtS[stok];
      float w = dt * __expf(tot - cumS[stok]);
      float x0 = bflo(cx.x), x1 = bfhi(cx.x), x2 = bflo(cx.y), x3 = bfhi(cx.y), x4 = bflo(cx.z), x5 = bfhi(cx.z), x6 = bflo(cx.w), x7 = bfhi(cx.w);
      uint4 o;
      o.x = pack2(x0 * dt, x1 * dt); o.y = pack2(x2 * dt, x3 * dt); o.z = pack2(x4 * dt, x5 * dt); o.w = pack2(x6 * dt, x7 * dt);
      *(uint4*)(Xs + stok * 72 + sc * 8) = o;
      o.x = pack2(x0 * w, x1 * w); o.y = pack2(x2 * w, x3 * w); o.z = pack2(x4 * w, x5 * w); o.w = pack2(x6 * w, x7 * w);
      *(uint4*)(Xw + stok * 72 + sc * 8) = o;
    }
#pragma unroll
    for (int tt = 0; tt < 2; ++tt) {
      int idx = wave * 2 + tt, jt = idx >> 2, it = idx & 3;
      f32x4 acc = (f32x4){0.f, 0.f, 0.f, 0.f};
      if (jt <= it) {
#pragma unroll
        for (int ks = 0; ks < 4; ++ks) {
          bf16x8 a = *(const bf16x8*)(Bs + (jt * 16 + l15) * 136 + ks * 32 + g * 8);
          bf16x8 bq = *(const bf16x8*)(Cs + (it * 16 + l15) * 136 + ks * 32 + g * 8);
          acc = __builtin_amdgcn_mfma_f32_16x16x32_bf16(a, bq, acc, 0, 0, 0);
        }
        int i = it * 16 + l15;
        float ci = cumS[i];
        float4 cj = *(const float4*)(cumS + jt * 16 + g * 4);
        int j0 = jt * 16 + g * 4;
        acc[0] = (j0 + 0 <= i) ? acc[0] * __expf(ci - cj.x) : 0.f;
        acc[1] = (j0 + 1 <= i) ? acc[1] * __expf(ci - cj.y) : 0.f;
        acc[2] = (j0 + 2 <= i) ? acc[2] * __expf(ci - cj.z) : 0.f;
        acc[3] = (j0 + 3 <= i) ? acc[3] * __expf(ci - cj.w) : 0.f;
      }
      uint2 o;
      o.x = pack2(acc[0], acc[1]);
      o.y = pack2(acc[2], acc[3]);
      *(uint2*)(Ps + (it * 16 + l15) * 72 + jt * 16 + g * 4) = o;
    }
    __syncthreads();
    f32x4 y[2];
    y[0] = (f32x4){0.f, 0.f, 0.f, 0.f};
    y[1] = (f32x4){0.f, 0.f, 0.f, 0.f};
#pragma unroll
    for (int s2 = 0; s2 < 4; ++s2) {
      bf16x8 sf = pack8(S[2 * s2], S[2 * s2 + 1]);
#pragma unroll
      for (int ii = 0; ii < 2; ++ii) {
        const bf* qr = Cs + ((ih * 2 + ii) * 16 + l15) * 136 + g * 4;
        bf16x8 aq = ld2x64(qr + (2 * s2) * 16, qr + (2 * s2 + 1) * 16);
        y[ii] = __builtin_amdgcn_mfma_f32_16x16x32_bf16(aq, sf, y[ii], 0, 0, 0);
      }
    }
    {
      float et = __expf(tot);
#pragma unroll
      for (int nt = 0; nt < 8; ++nt) { S[nt][0] *= et; S[nt][1] *= et; S[nt][2] *= et; S[nt][3] *= et; }
    }
#pragma unroll
    for (int ii = 0; ii < 2; ++ii) {
      float4 e4 = *(const float4*)(ecS + (ih * 2 + ii) * 16 + g * 4);
      y[ii][0] *= e4.x; y[ii][1] *= e4.y; y[ii][2] *= e4.z; y[ii][3] *= e4.w;
    }
    {
      bf16x8 xfs[2], xws[2];
      tr_dual<32 * 72 * 2, 4 * 72 * 2>(trbase(Xs, 72, g * 8, vt * 16, lane), xfs[0], xfs[1]);
      tr_dual<32 * 72 * 2, 4 * 72 * 2>(trbase(Xw, 72, g * 8, vt * 16, lane), xws[0], xws[1]);
#pragma unroll
      for (int s2 = 0; s2 < 2; ++s2) {
#pragma unroll
        for (int ii = 0; ii < 2; ++ii) {
          bf16x8 ap = *(const bf16x8*)(Ps + ((ih * 2 + ii) * 16 + l15) * 72 + s2 * 32 + g * 8);
          y[ii] = __builtin_amdgcn_mfma_f32_16x16x32_bf16(ap, xfs[s2], y[ii], 0, 0, 0);
        }
#pragma unroll
        for (int nq = 0; nq < 2; ++nq) {
          bf16x8 ab[4];
          tr_quad<32, 4 * 136 * 2>(trbase(Bs, 136, s2 * 32 + g * 8, nq * 64, lane), ab[0], ab[1], ab[2], ab[3]);
#pragma unroll
          for (int n4 = 0; n4 < 4; ++n4) S[nq * 4 + n4] = __builtin_amdgcn_mfma_f32_16x16x32_bf16(ab[n4], xws[s2], S[nq * 4 + n4], 0, 0, 0);
        }
      }
    }
#pragma unroll
    for (int ii = 0; ii < 2; ++ii)
#pragma unroll
      for (int r = 0; r < 4; ++r) {
        int i = (ih * 2 + ii) * 16 + g * 4 + r;
        Y[(size_t)scan_row(b, dir, c * 64 + i) * 512 + hh * 64 + vt * 16 + l15] = f2bf(y[ii][r]);
      }
  }
}

__device__ __forceinline__ void rwkv_chain2(const P& p, int chain, char* smem) {
  const int dir = chain & 1, h = (chain >> 1) & 7, b = chain >> 4;
  bf* KT = (bf*)smem;
  bf* RTi = KT + 4608;
  bf* KH = RTi + 4608;
  bf* BH = KH + 4608;
  bf* VV = BH + 4608;
  bf* MAkk = VV + 4608;
  bf* MBrk = MAkk + 4608;
  bf* MBrb = MBrk + 4608;
  bf* UN = MBrb + 4608;
  bf* LWs = UN + 4608;
  float* AKB = (float*)(LWs + 4608);
  float* RH = AKB + 64 * 68;
  float* segtot = RH + 64 * 68;
  float* dS = segtot + 512;
  const int tid = tidx(), lane = tid & 63, wave = tid >> 6;
  const int l15 = lane & 15, g = lane >> 4;
  const int vt = wave & 3, ih = wave >> 2;
  const bf* PR = (const bf*)(p.ws + OFF_PREP);
  const bf* PK = PR + (size_t)RT * 512;
  const bf* PV = PK + (size_t)RT * 512;
  const bf* PKK = PV + (size_t)RT * 512;
  const bf* PKA = PKK + (size_t)RT * 512;
  const bf* PLW = PKA + (size_t)RT * 512 + (size_t)dir * RT * 512;
  bf* Y = (bf*)p.out + (size_t)dir * RT * 512;
  const int kc = tid & 63, seg = tid >> 6;
  const int stok = tid >> 3, sc8 = (tid & 7) * 8;
  f32x4 T[4];
#pragma unroll
  for (int kt = 0; kt < 4; ++kt) T[kt] = (f32x4){0.f, 0.f, 0.f, 0.f};
  uint4 gR, gK, gV, gKK, gKA, gW;
  {
    size_t o = (size_t)scan_row(b, dir, stok) * 512 + h * 64 + sc8;
    gR = *(const uint4*)(PR + o); gK = *(const uint4*)(PK + o); gV = *(const uint4*)(PV + o);
    gKK = *(const uint4*)(PKK + o); gKA = *(const uint4*)(PKA + o); gW = *(const uint4*)(PLW + o);
  }
  const int NCH = TA / 64;
  for (int c = 0; c < NCH; ++c) {
    __syncthreads();
    *(uint4*)(RTi + stok * 72 + sc8) = gR;
    *(uint4*)(KH + stok * 72 + sc8) = gK;
    *(uint4*)(VV + stok * 72 + sc8) = gV;
    *(uint4*)(KT + stok * 72 + sc8) = gKK;
    *(uint4*)(BH + stok * 72 + sc8) = gKA;
    *(uint4*)(LWs + stok * 72 + sc8) = gW;
    __syncthreads();
    if (c + 1 < NCH) {
      size_t o = (size_t)scan_row(b, dir, (c + 1) * 64 + stok) * 512 + h * 64 + sc8;
      gR = *(const uint4*)(PR + o); gK = *(const uint4*)(PK + o); gV = *(const uint4*)(PV + o);
      gKK = *(const uint4*)(PKK + o); gKA = *(const uint4*)(PKA + o); gW = *(const uint4*)(PLW + o);
    }
    float lc[8];
    {
      float run = 0.f;
#pragma unroll
      for (int ii = 0; ii < 8; ++ii) {
        run += bf2f(LWs[(seg * 8 + ii) * 72 + kc]);
        lc[ii] = run;
      }
      segtot[seg * 64 + kc] = run;
    }
    __syncthreads();
    {
      float off = 0.f, tot = 0.f;
#pragma unroll
      for (int s2 = 0; s2 < 8; ++s2) {
        float t = segtot[s2 * 64 + kc];
        tot += t;
        off += (s2 < seg) ? t : 0.f;
      }
#pragma unroll
      for (int ii = 0; ii < 8; ++ii) {
        const int i = seg * 8 + ii;
        const float cum = off + lc[ii];
        const float cumx = off + (ii > 0 ? lc[ii > 0 ? ii - 1 : 0] : 0.f);
        const float eR = __expf(cum - tot);
        const float eK = __builtin_amdgcn_rcpf(eR);
        const float eX = __expf(cumx - tot);
        const int o = i * 72 + kc;
        RTi[o] = f2bf(bf2f(RTi[o]) * eR);
        KH[o] = f2bf(bf2f(KH[o]) * eK);
        BH[o] = f2bf(bf2f(BH[o]) * eK);
        KT[o] = f2bf(bf2f(KT[o]) * eX);
      }
      if (seg == 0) dS[kc] = __expf(tot);
    }
    __syncthreads();
#pragma unroll
    for (int kt = 0; kt < 4; ++kt) {
      float4 d4 = *(const float4*)(dS + kt * 16 + g * 4);
      T[kt][0] *= d4.x; T[kt][1] *= d4.y; T[kt][2] *= d4.z; T[kt][3] *= d4.w;
    }
#pragma unroll
    for (int tt = 0; tt < 2; ++tt) {
      const int idx = wave * 2 + tt, jt = idx >> 2, it = idx & 3;
      f32x4 akb = (f32x4){0.f, 0.f, 0.f, 0.f}, akk = akb, brk = akb, brb = akb;
      if (jt <= it) {
#pragma unroll
        for (int ks = 0; ks < 2; ++ks) {
          bf16x8 aKH = *(const bf16x8*)(KH + (jt * 16 + l15) * 72 + ks * 32 + g * 8);
          bf16x8 aBH = *(const bf16x8*)(BH + (jt * 16 + l15) * 72 + ks * 32 + g * 8);
          bf16x8 bKT = *(const bf16x8*)(KT + (it * 16 + l15) * 72 + ks * 32 + g * 8);
          bf16x8 bRT = *(const bf16x8*)(RTi + (it * 16 + l15) * 72 + ks * 32 + g * 8);
          akb = __builtin_amdgcn_mfma_f32_16x16x32_bf16(aBH, bKT, akb, 0, 0, 0);
          akk = __builtin_amdgcn_mfma_f32_16x16x32_bf16(aKH, bKT, akk, 0, 0, 0);
          brk = __builtin_amdgcn_mfma_f32_16x16x32_bf16(aKH, bRT, brk, 0, 0, 0);
          brb = __builtin_amdgcn_mfma_f32_16x16x32_bf16(aBH, bRT, brb, 0, 0, 0);
        }
        const int i = it * 16 + l15;
#pragma unroll
        for (int r = 0; r < 4; ++r) {
          const int j = jt * 16 + g * 4 + r;
          akb[r] = (j < i) ? akb[r] : 0.f;
          akk[r] = (j < i) ? akk[r] : 0.f;
          brk[r] = (j <= i) ? brk[r] : 0.f;
          brb[r] = (j <= i) ? brb[r] : 0.f;
        }
      }
      const int orow = (it * 16 + l15), ocol = jt * 16 + g * 4;
      uint2 o;
      o.x = pack2(akk[0], akk[1]); o.y = pack2(akk[2], akk[3]);
      *(uint2*)(MAkk + orow * 72 + ocol) = o;
      o.x = pack2(brk[0], brk[1]); o.y = pack2(brk[2], brk[3]);
      *(uint2*)(MBrk + orow * 72 + ocol) = o;
      o.x = pack2(brb[0], brb[1]); o.y = pack2(brb[2], brb[3]);
      *(uint2*)(MBrb + orow * 72 + ocol) = o;
      *(float4*)(AKB + orow * 68 + ocol) = make_float4(akb[0], akb[1], akb[2], akb[3]);
    }
    __syncthreads();
    bf16x8 tf0 = pack8(T[0], T[1]), tf1 = pack8(T[2], T[3]);
    f32x4 yv[2];
    {
      bf16x8 vf0, vf1;
      tr_dual<32 * 72 * 2, 4 * 72 * 2>(trbase(VV, 72, g * 8, vt * 16, lane), vf0, vf1);
#pragma unroll
      for (int ii = 0; ii < 2; ++ii) {
        const int it = ih * 2 + ii;
        f32x4 acc = (f32x4){0.f, 0.f, 0.f, 0.f};
        const bf* qr = KT + (it * 16 + l15) * 72 + g * 4;
        acc = __builtin_amdgcn_mfma_f32_16x16x32_bf16(ld2x64(qr, qr + 16), tf0, acc, 0, 0, 0);
        acc = __builtin_amdgcn_mfma_f32_16x16x32_bf16(ld2x64(qr + 32, qr + 48), tf1, acc, 0, 0, 0);
        const bf* ar = MAkk + (it * 16 + l15) * 72 + g * 8;
        acc = __builtin_amdgcn_mfma_f32_16x16x32_bf16(*(const bf16x8*)ar, vf0, acc, 0, 0, 0);
        acc = __builtin_amdgcn_mfma_f32_16x16x32_bf16(*(const bf16x8*)(ar + 32), vf1, acc, 0, 0, 0);
#pragma unroll
        for (int r = 0; r < 4; ++r) RH[(it * 16 + g * 4 + r) * 68 + vt * 16 + l15] = acc[r];
        f32x4 ya = (f32x4){0.f, 0.f, 0.f, 0.f};
        const bf* rr = RTi + (it * 16 + l15) * 72 + g * 4;
        ya = __builtin_amdgcn_mfma_f32_16x16x32_bf16(ld2x64(rr, rr + 16), tf0, ya, 0, 0, 0);
        ya = __builtin_amdgcn_mfma_f32_16x16x32_bf16(ld2x64(rr + 32, rr + 48), tf1, ya, 0, 0, 0);
        const bf* br = MBrk + (it * 16 + l15) * 72 + g * 8;
        ya = __builtin_amdgcn_mfma_f32_16x16x32_bf16(*(const bf16x8*)br, vf0, ya, 0, 0, 0);
        ya = __builtin_amdgcn_mfma_f32_16x16x32_bf16(*(const bf16x8*)(br + 32), vf1, ya, 0, 0, 0);
        yv[ii] = ya;
      }
      {
        bf16x8 k0[4], k1[4];
        tr_quad<32, 4 * 72 * 2>(trbase(KH, 72, g * 8, 0, lane), k0[0], k0[1], k0[2], k0[3]);
        tr_quad<32, 4 * 72 * 2>(trbase(KH, 72, 32 + g * 8, 0, lane), k1[0], k1[1], k1[2], k1[3]);
#pragma unroll
        for (int kt = 0; kt < 4; ++kt) {
          T[kt] = __builtin_amdgcn_mfma_f32_16x16x32_bf16(k0[kt], vf0, T[kt], 0, 0, 0);
          T[kt] = __builtin_amdgcn_mfma_f32_16x16x32_bf16(k1[kt], vf1, T[kt], 0, 0, 0);
        }
      }
    }
    __syncthreads();
    for (int rb = 0; rb < 8; ++rb) {
      if (wave == 0) {
        float acc[8];
#pragma unroll
        for (int q = 0; q < 8; ++q) acc[q] = RH[(rb * 8 + q) * 68 + lane];
#pragma unroll
        for (int q = 1; q < 8; ++q) {
          const float4 d0 = *(const float4*)(AKB + (rb * 8 + q) * 68 + rb * 8);
          const float4 d1 = *(const float4*)(AKB + (rb * 8 + q) * 68 + rb * 8 + 4);
          const float dd[8] = {d0.x, d0.y, d0.z, d0.w, d1.x, d1.y, d1.z, d1.w};
#pragma unroll
          for (int cc = 0; cc < q; ++cc) acc[q] -= dd[cc] * acc[cc];
        }
#pragma unroll
        for (int q = 0; q < 8; ++q) {
          RH[(rb * 8 + q) * 68 + lane] = acc[q];
          UN[(rb * 8 + q) * 72 + lane] = f2bf(-acc[q]);
        }
      }
      __syncthreads();
      if (rb < 7) {
        float uq[8];
#pragma unroll
        for (int q = 0; q < 8; ++q) uq[q] = RH[(rb * 8 + q) * 68 + lane];
        for (int r = (rb + 1) * 8 + wave; r < 64; r += 8) {
          const float4 a0 = *(const float4*)(AKB + r * 68 + rb * 8);
          const float4 a1 = *(const float4*)(AKB + r * 68 + rb * 8 + 4);
          float Rv = RH[r * 68 + lane];
          Rv -= ((a0.x * uq[0] + a0.y * uq[1]) + (a0.z * uq[2] + a0.w * uq[3])) + ((a1.x * uq[4] + a1.y * uq[5]) + (a1.z * uq[6] + a1.w * uq[7]));
          RH[r * 68 + lane] = Rv;
        }
        __syncthreads();
      }
    }
    __syncthreads();
    {
      bf16x8 uf0, uf1;
      tr_dual<32 * 72 * 2, 4 * 72 * 2>(trbase(UN, 72, g * 8, vt * 16, lane), uf0, uf1);
#pragma unroll
      for (int ii = 0; ii < 2; ++ii) {
        const int it = ih * 2 + ii;
        const bf* br = MBrb + (it * 16 + l15) * 72 + g * 8;
        yv[ii] = __builtin_amdgcn_mfma_f32_16x16x32_bf16(*(const bf16x8*)br, uf0, yv[ii], 0, 0, 0);
        yv[ii] = __builtin_amdgcn_mfma_f32_16x16x32_bf16(*(const bf16x8*)(br + 32), uf1, yv[ii], 0, 0, 0);
      }
      {
        bf16x8 b0[4], b1[4];
        tr_quad<32, 4 * 72 * 2>(trbase(BH, 72, g * 8, 0, lane), b0[0], b0[1], b0[2], b0[3]);
        tr_quad<32, 4 * 72 * 2>(trbase(BH, 72, 32 + g * 8, 0, lane), b1[0], b1[1], b1[2], b1[3]);
#pragma unroll
        for (int kt = 0; kt < 4; ++kt) {
          T[kt] = __builtin_amdgcn_mfma_f32_16x16x32_bf16(b0[kt], uf0, T[kt], 0, 0, 0);
          T[kt] = __builtin_amdgcn_mfma_f32_16x16x32_bf16(b1[kt], uf1, T[kt], 0, 0, 0);
        }
      }
    }
#pragma unroll
    for (int ii = 0; ii < 2; ++ii)
#pragma unroll
      for (int r = 0; r < 4; ++r) {
        const int i = (ih * 2 + ii) * 16 + g * 4 + r;
        Y[(size_t)scan_row(b, dir, c * 64 + i) * 512 + h * 64 + vt * 16 + l15] = f2bf(yv[ii][r]);
      }
  }
}

__device__ __forceinline__ void ph_mix1(const P& p, char* smem) {
  for (int u = blockIdx.x; u < 192; u += gridDim.x) {
    if (u < 128) ssd_chain2(p, u, smem);
    else gla_chain2(p, u - 128, smem);
  }
}

__device__ __forceinline__ void ph_post1(const P& p, char* smem) {
  float* ws1 = (float*)smem;
  float* ws2 = ws1 + 32;
  const int tid = tidx(), lane = tid & 63, wave = tid >> 6;
  const bf* SYF = (const bf*)(p.ws + OFF_XRAW);
  const bf* SYB = SYF + (size_t)RT * 512;
  const bf* GYF = (const bf*)(p.ws + OFF_GY);
  const bf* GYB = GYF + (size_t)RT * 512;
  const bf* XBC = (const bf*)(p.ws + OFF_XBC);
  const bf* P1 = (const bf*)(p.ws + OFF_P1C);
  bf* O = (bf*)(p.ws + OFF_HO);
  const float dsk = p.in[44][tid >> 6];
  const float sn = p.in[45][tid];
  const float gn = p.in[50][tid & 127];
  for (int rr0 = blockIdx.x * 4; rr0 < NBAT * SEQ; rr0 += gridDim.x * 4) {
    float y[4], y2[4], zg[4], gg[4];
    int Rr[4];
#pragma unroll
    for (int i = 0; i < 4; ++i) {
      int rr = rr0 + i;
      int R = (rr >> 12) * TA + CTX + (rr & 4095);
      Rr[i] = R;
      size_t o = (size_t)R * 512 + tid;
      y[i] = bf2f(SYF[o]) + bf2f(SYB[o]) + bf2f(XBC[(size_t)R * 1024 + tid]) * dsk;
      zg[i] = bf2f(P1[(size_t)R * 2080 + tid]);
      y2[i] = bf2f(GYF[o]) + bf2f(GYB[o]);
      gg[i] = bf2f(P1[(size_t)R * 2080 + 1552 + tid]);
    }
    __syncthreads();
#pragma unroll
    for (int i = 0; i < 4; ++i) {
      y[i] *= siluf_(zg[i]);
      float s1 = wave_sum(y[i] * y[i]);
      float s2 = wave_sum(y2[i] * y2[i]);
      if (lane == 0) { ws1[i * 8 + wave] = s1; ws2[i * 8 + wave] = s2; }
    }
    __syncthreads();
#pragma unroll
    for (int i = 0; i < 4; ++i) {
      int g4 = i * 8 + (wave >> 2) * 4;
      float t1 = ws1[g4] + ws1[g4 + 1] + ws1[g4 + 2] + ws1[g4 + 3];
      int g2 = i * 8 + (wave >> 1) * 2;
      float t2 = ws2[g2] + ws2[g2 + 1];
      float o1 = y[i] * rsqrtf(t1 * (1.f / 256.f) + 1e-6f) * sn;
      float o2 = y2[i] * rsqrtf(t2 * (1.f / 128.f) + 1e-6f) * gn * siluf_(gg[i]);
      O[(size_t)Rr[i] * 1024 + tid] = f2bf(o1);
      O[(size_t)Rr[i] * 1024 + 512 + tid] = f2bf(o2);
    }
  }
}

__device__ __forceinline__ void ph_final(const P& p) {
  const int lane = tidx() & 63, wave = tidx() >> 6;
  const float* g = p.in[51];
  for (int r = blockIdx.x * 8 + wave; r < NBAT * SEQ; r += gridDim.x * 8) {
    float* row = p.out + (size_t)r * 1024;
    float4 v[4];
    float ss = 0.f;
#pragma unroll
    for (int i = 0; i < 4; ++i) {
      v[i] = *(const float4*)(row + i * 256 + lane * 4);
      ss += v[i].x * v[i].x + v[i].y * v[i].y + v[i].z * v[i].z + v[i].w * v[i].w;
    }
    ss = wave_sum(ss);
    float rs = rsqrtf(ss * (1.f / 1024.f) + 1e-6f);
#pragma unroll
    for (int i = 0; i < 4; ++i) {
      float4 gg = *(const float4*)(g + i * 256 + lane * 4);
      float4 o = make_float4(v[i].x * rs * gg.x, v[i].y * rs * gg.y, v[i].z * rs * gg.z, v[i].w * rs * gg.w);
      *(float4*)(row + i * 256 + lane * 4) = o;
    }
  }
}

#define XB_TMO      128
#define XB_XCNT(j)  (256  + 64 * (j))
#define XB_XSUB(j)  (1280 + 64 * (j))
#define XB_XGEN(j)  (2304 + 64 * (j))
#define XB_TOP      3328
#define XB_TOPGEN   3392
#define XCD_BAR_WORDS 3456
#define XB_SPIN_CAP (1u << 18)
#define LAS __attribute__((address_space(3)))
__device__ __forceinline__ unsigned xb_ld(unsigned* q)              { return __hip_atomic_load(q, __ATOMIC_RELAXED, __HIP_MEMORY_SCOPE_AGENT); }
__device__ __forceinline__ unsigned xb_add(unsigned* q, unsigned v) { return __hip_atomic_fetch_add(q, v, __ATOMIC_RELAXED, __HIP_MEMORY_SCOPE_AGENT); }
__device__ __forceinline__ unsigned xb_xcc_id() { return (unsigned)__builtin_amdgcn_s_getreg((3 << 11) | 20) & 0xFu; }
#define XB_SPIN(cond, bar) do { unsigned _sp = 0; while (cond) { __builtin_amdgcn_s_sleep(1); \
    if ((++_sp & 255u) == 0u) { if (xb_ld(&(bar)[XB_TMO])) break; if (_sp > XB_SPIN_CAP) { atomicAdd(&(bar)[XB_TMO], 1u); break; } } } } while (0)
struct XcdBarrier { unsigned* bar; unsigned x; volatile LAS unsigned* st; };
__device__ __forceinline__ XcdBarrier xcd_barrier_post(unsigned* bar, volatile LAS unsigned* st) {
  XcdBarrier b; b.bar = bar; b.x = xb_xcc_id(); b.st = st;
  if (threadIdx.x == 0) (void)xb_add(&bar[XB_XCNT(b.x)], 1u);
  return b;
}
__device__ __forceinline__ void xcd_barrier_complete(unsigned* bar, unsigned x, unsigned& nloc, unsigned& nx) {
  const unsigned G = gridDim.x * gridDim.y * gridDim.z;
  unsigned sum, cnt, mine, sp = 0u;
  for (;;) {
    sum = 0u; cnt = 0u; mine = 0u;
#pragma unroll
    for (unsigned j = 0; j < 16; ++j) { const unsigned c = xb_ld(&bar[XB_XCNT(j)]); sum += c; cnt += (c > 0u) ? 1u : 0u; mine = (j == x) ? c : mine; }
    if (sum == G) break;
    __builtin_amdgcn_s_sleep(1);
    if ((++sp & 255u) == 0u) { if (xb_ld(&bar[XB_TMO])) break; if (sp > XB_SPIN_CAP) { atomicAdd(&bar[XB_TMO], 1u); break; } }
  }
  nloc = mine > 0u ? mine : 1u; nx = cnt > 0u ? cnt : 1u;
}
__device__ __forceinline__ void xcd_barrier(const XcdBarrier& b) {
  asm volatile("s_waitcnt vmcnt(0)" ::: "memory");
  __syncthreads();
  if (threadIdx.x == 0) {
    unsigned* bar = b.bar;
    __builtin_amdgcn_s_waitcnt(0);
    unsigned nloc = b.st[0], nx = b.st[1];
    if (nloc == 0u) { xcd_barrier_complete(bar, b.x, nloc, nx); b.st[0] = nloc; b.st[1] = nx; }
    const unsigned old = xb_add(&bar[XB_XSUB(b.x)], 1u);
    const unsigned gen = old / nloc;
    if (old + 1u == (gen + 1u) * nloc) {
      __builtin_amdgcn_fence(__ATOMIC_RELEASE, "agent");
      asm volatile("s_waitcnt vmcnt(0)" ::: "memory");
      const unsigned og = xb_add(&bar[XB_TOP], 1u);
      const unsigned tg = og / nx;
      if (og + 1u == (tg + 1u) * nx) xb_add(&bar[XB_TOPGEN], 1u);
      else XB_SPIN(xb_ld(&bar[XB_TOPGEN]) == tg, bar);
      __builtin_amdgcn_fence(__ATOMIC_ACQUIRE, "agent");
      xb_add(&bar[XB_XGEN(b.x)], 1u);
      asm volatile("s_waitcnt vmcnt(0)" ::: "memory");
    } else {
      XB_SPIN(xb_ld(&bar[XB_XGEN(b.x)]) == gen, bar);
      __builtin_amdgcn_fence(__ATOMIC_ACQUIRE, "agent");
      asm volatile("s_waitcnt vmcnt(0)" ::: "memory");
    }
  }
  __syncthreads();
}

constexpr int NPH = 20;
template <int PH>
__device__ __forceinline__ void run_phase(const P& p, char* smem) {
  const bf* WT = (const bf*)(p.ws + OFF_WT);
  const bf* HO = (const bf*)(p.ws + OFF_HO);
  const bf* HID = (const bf*)(p.ws + OFF_HID);
  if constexpr (PH == 0) {
    if (blockIdx.x == 0 && tidx() == 0) { *(int*)(p.ws + OFF_CNT) = 0; *((int*)(p.ws + OFF_CNT) + 1) = 0; }
    ph_mod(p, smem);
    ph_lw(p);
    ph_wt(p, 0, smem);
  } else if constexpr (PH == 1) ph_ada(p, 0, 0, 1, 0);
  else if constexpr (PH == 2) ph_gemm<0>(p, HO, WT + WT_IN, 1024, 13, 0, 0, smem);
  else if constexpr (PH == 3) {
    ph_rope(p, smem);
    ph_rwkv_prep(p, smem);
#ifdef PROBE_PREP
    __syncthreads();
    ph_rwkv_prep(p, smem);
#endif
  }
  else if constexpr (PH == 4) ph_mix0(p, smem);
  else if constexpr (PH == 5) ph_rwkv_post(p);
  else if constexpr (PH == 6) ph_gemm<2>(p, HO, WT + WT_OUT, 1024, 4, 0, 0, smem);
  else if constexpr (PH == 7) ph_ada(p, 0, 1, 0, 0);
  else if constexpr (PH == 8) ph_gemm<3>(p, HO, WT + WT_W1, 1024, 16, 0, 0, smem);
  else if constexpr (PH == 9) ph_gemm<4>(p, HID, WT + WT_W2, 4096, 4, 0, 0, smem);
  else if constexpr (PH == 10) { ph_ada(p, 1, 0, 0, 0); ph_wt(p, 1, smem); }
  else if constexpr (PH == 11) ph_gemm<1>(p, HO, WT + WT_IN, 1024, 13, 1, 0, smem);
  else if constexpr (PH == 12) ph_conv(p);
  else if constexpr (PH == 13) ph_mix1(p, smem);
  else if constexpr (PH == 14) ph_post1(p, smem);
  else if constexpr (PH == 15) ph_gemm<2>(p, HO, WT + WT_OUT, 1024, 4, 1, 1, smem);
  else if constexpr (PH == 16) ph_ada(p, 1, 1, 0, 1);
  else if constexpr (PH == 17) ph_gemm<3>(p, HO, WT + WT_W1, 1024, 16, 1, 1, smem);
  else if constexpr (PH == 18) ph_gemm<4>(p, HID, WT + WT_W2, 4096, 4, 1, 1, smem);
  else ph_final(p);
}

constexpr int LDS_BYTES = 131072 + 64;
template <int PH>
__device__ __forceinline__ void run_all(const P& p, char* smem, const XcdBarrier& xb) {
  run_phase<PH>(p, smem);
#ifdef PROBE_MASK
  if constexpr (((PROBE_MASK) >> PH) & 1) {
    xcd_barrier(xb);
    if constexpr (PH == 4) {
      if (blockIdx.x == 0 && tidx() == 0) *(int*)(p.ws + OFF_CNT) = 0;
      xcd_barrier(xb);
    }
    run_phase<PH>(p, smem);
  }
#endif
  if constexpr (PH + 1 < NPH) {
    if constexpr (PH == 0) cg::this_grid().sync();
    else xcd_barrier(xb);
    run_all<PH + 1>(p, smem, xb);
  }
}
__global__ void __launch_bounds__(NT) mega(P p) {
  extern __shared__ __attribute__((aligned(16))) char smem[];
  volatile LAS unsigned* st = (volatile LAS unsigned*)(smem + 131072 + 16);
  if (threadIdx.x == 0) { st[0] = 0u; st[1] = 0u; }
  __syncthreads();
  const XcdBarrier xb = xcd_barrier_post((unsigned*)(p.ws + OFF_BAR), st);
  run_all<0>(p, smem, xb);
}

extern "C" void kernel_launch(void* const* d_in, const int* in_sizes, int n_in, void* d_out, int out_size, void* d_ws,
                              size_t ws_size, hipStream_t stream) {
  P p{};
  for (int i = 0; i < 52; ++i) p.in[i] = (const float*)d_in[i];
  p.out = (float*)d_out;
  p.ws = (char*)d_ws;
  static int grid_blocks = 0;
  if (!grid_blocks) {
    int dev = 0, cus = 0, per_cu = 0;
    (void)hipGetDevice(&dev);
    (void)hipDeviceGetAttribute(&cus, hipDeviceAttributeMultiprocessorCount, dev);
    (void)hipFuncSetAttribute((const void*)mega, hipFuncAttributeMaxDynamicSharedMemorySize, LDS_BYTES);
    (void)hipOccupancyMaxActiveBlocksPerMultiprocessor(&per_cu, mega, NT, LDS_BYTES);
    if (per_cu < 1) per_cu = 1;
    if (per_cu > 1) per_cu = 1;
    grid_blocks = cus * per_cu;
  }
  (void)hipMemsetAsync((char*)d_ws + OFF_BAR, 0, XCD_BAR_WORDS * sizeof(unsigned), stream);
  void* args[] = {&p};
  hipError_t e = hipLaunchCooperativeKernel((void*)mega, dim3(grid_blocks), dim3(NT), args, LDS_BYTES, stream);
  if (e != hipSuccess) fprintf(stderr, "cooperative launch failed: %s (grid %d)\n", hipGetErrorString(e), grid_blocks);
}
```

```cpp
#include <hip/hip_runtime.h>
#include <hip/hip_cooperative_groups.h>
#include <cstdio>
namespace cg = cooperative_groups;

#ifndef MODE_COOP
#define MODE_COOP 1
#endif

typedef unsigned short bf;
typedef __attribute__((ext_vector_type(8))) short bf16x8;
typedef __attribute__((ext_vector_type(4))) float f32x4;
typedef __attribute__((ext_vector_type(4))) int i32x4;

constexpr int NT = 512;
constexpr int Dm = 1024, NBAT = 8, SEQ = 4096, CTX = 256, TA = 4352, RT = NBAT * TA;

constexpr size_t OFF_MOD = 0;
constexpr size_t OFF_CNT = 450000;
constexpr size_t OFF_BAR = 458752;
constexpr size_t OFF_WT = 524288;
constexpr size_t WT_IN = 0, WT_OUT = (size_t)3328 * 1024, WT_W1 = WT_OUT + (size_t)1024 * 1024, WT_W2 = WT_W1 + (size_t)4096 * 1024;
constexpr size_t OFF_CTXX = OFF_WT + (size_t)12544 * 1024 * 2;
constexpr size_t OFF_HO = OFF_CTXX + (size_t)2048 * 1024 * 4;
constexpr size_t OFF_BIG = OFF_HO + (size_t)RT * 1024 * 2;
constexpr size_t SZ512 = (size_t)RT * 512 * 2;
constexpr size_t OFF_QKV = OFF_BIG;
constexpr size_t OFF_PREP = OFF_QKV + (size_t)RT * 1536 * 2;
constexpr size_t OFF_G = OFF_PREP + 7 * SZ512;
constexpr size_t OFF_BONUS = OFF_G + SZ512;
constexpr size_t OFF_LW = OFF_BONUS + (size_t)RT * 8 * 4;
constexpr size_t OFF_WT1 = 500170752;
constexpr size_t OFF_HID = OFF_BIG;
constexpr size_t OFF_P1C = OFF_BIG;
constexpr size_t OFF_XRAW = OFF_P1C + (size_t)RT * 2080 * 2;
constexpr size_t OFF_DTRAW = OFF_XRAW + (size_t)RT * 1024 * 2;
constexpr size_t OFF_XBC = OFF_DTRAW + (size_t)RT * 16 * 4;
constexpr size_t OFF_GY = OFF_XBC + (size_t)RT * 1024 * 2;

struct P {
  const float* in[52];
  float* out;
  char* ws;
};

__device__ __forceinline__ int tidx() { int t = threadIdx.x; asm volatile("" : "+v"(t)); return t; }
__device__ __forceinline__ bf f2bf(float f) { __bf16 r = (__bf16)f; return __builtin_bit_cast(bf, r); }
__device__ __forceinline__ float bf2f(bf h) { return __uint_as_float(((unsigned)h) << 16); }
__device__ __forceinline__ float bflo(unsigned u) { return __uint_as_float(u << 16); }
__device__ __forceinline__ float bfhi(unsigned u) { return __uint_as_float(u & 0xffff0000u); }
typedef __bf16 bf16x2_t __attribute__((ext_vector_type(2)));
typedef float f32x2_t __attribute__((ext_vector_type(2)));
__device__ __forceinline__ unsigned pack2(float a, float b) { f32x2_t v = {a, b}; bf16x2_t r = __builtin_convertvector(v, bf16x2_t); return __builtin_bit_cast(unsigned, r); }
__device__ __forceinline__ float sigmoidf_(float x) { return __builtin_amdgcn_rcpf(1.f + __expf(-x)); }
__device__ __forceinline__ float softplusf_(float x) { return x > 15.f ? x : __logf(1.f + __expf(x)); }
__device__ __forceinline__ float siluf_(float x) { return x * __builtin_amdgcn_rcpf(1.f + __expf(-x)); }
__device__ __forceinline__ float wave_sum(float v) {
#pragma unroll
  for (int o = 32; o >= 1; o >>= 1) v += __shfl_xor(v, o);
  return v;
}
template <int C>
__device__ __forceinline__ float dppf(float x) {
  return __builtin_bit_cast(float, __builtin_amdgcn_update_dpp(0, __builtin_bit_cast(int, x), C, 0xF, 0xF, true));
}
__device__ __forceinline__ float red16(float x) {
  x += dppf<0xB1>(x);
  x += dppf<0x4E>(x);
  x += dppf<0x141>(x);
  x += dppf<0x128>(x);
  return x;
}
__device__ __forceinline__ float* xrow(const P& p, int R) {
  int b = R / TA, a = R - b * TA;
  if (a < CTX) return (float*)(p.ws + OFF_CTXX) + (size_t)(b * CTX + a) * Dm;
  return p.out + (size_t)(b * SEQ + a - CTX) * Dm;
}
__device__ __forceinline__ const float* inrow(const P& p, int R) {
  int b = R / TA, a = R - b * TA;
  if (a < CTX) return p.in[2] + (size_t)(b * CTX + a) * Dm;
  return p.in[0] + (size_t)(b * SEQ + a - CTX) * Dm;
}
__device__ __forceinline__ int mrow(int R) {
  int b = R / TA, a = R - b * TA;
  return a < CTX ? 8 : b;
}

__device__ __forceinline__ void ph_mod(const P& p, char* smem) {
  float* sc = (float*)smem;
  float* red = sc + 9 * 1024;
  const int tid = tidx();
  bool loaded = false;
  for (int unit = blockIdx.x; unit < 2 * 192; unit += gridDim.x) {
    int layer = unit / 192, cch = unit - layer * 192;
    const float* W = p.in[layer ? 30 : 4];
    const float* bias = p.in[layer ? 31 : 5];
    __syncthreads();
    if (!loaded) {
      for (int i = tid; i < 9 * 1024; i += NT) {
        int r = i >> 10, k = i & 1023;
        float v = (r < 8) ? p.in[1][r * 1024 + k] : p.in[3][k];
        sc[i] = siluf_(v);
      }
      loaded = true;
      __syncthreads();
    }
    int cl = tid & 31, kg = tid >> 5;
    int col = cch * 32 + cl;
    float acc[9];
#pragma unroll
    for (int r = 0; r < 9; ++r) acc[r] = 0.f;
    for (int k = kg * 64; k < kg * 64 + 64; ++k) {
      float w = W[(size_t)k * 6144 + col];
#pragma unroll
      for (int r = 0; r < 9; ++r) acc[r] += sc[r * 1024 + k] * w;
    }
#pragma unroll
    for (int r = 0; r < 9; ++r) red[(kg * 9 + r) * 32 + cl] = acc[r];
    __syncthreads();
    if (tid < 288) {
      int r = tid >> 5, c = tid & 31;
      float s = 0.f;
#pragma unroll
      for (int g = 0; g < 16; ++g) s += red[(g * 9 + r) * 32 + c];
      ((float*)(p.ws + OFF_MOD))[(size_t)(layer * 9 + r) * 6144 + cch * 32 + c] = s + bias[cch * 32 + c];
    }
  }
}

__device__ __forceinline__ void transpose_one(const float* W, bf* Wt, int K, int N, int Npad, int vb, int nvb, char* smem) {
  float* tile = (float*)smem;
  const int tid = tidx();
  int ntn = Npad / 64, ntk = K / 64;
  for (int t = vb; t < ntn * ntk; t += nvb) {
    int tn = t / ntk, tk = t - tn * ntk;
    int n0 = tn * 64, k0 = tk * 64;
    __syncthreads();
#pragma unroll
    for (int i = 0; i < 8; ++i) {
      int kk = (tid >> 6) + 8 * i, nn = tid & 63;
      float v = (n0 + nn < N) ? W[(size_t)(k0 + kk) * N + n0 + nn] : 0.f;
      tile[kk * 65 + nn] = v;
    }
    __syncthreads();
#pragma unroll
    for (int i = 0; i < 8; ++i) {
      int nn = (tid >> 6) + 8 * i, kk = tid & 63;
      Wt[(size_t)(n0 + nn) * K + k0 + kk] = f2bf(tile[kk * 65 + nn]);
    }
  }
}
__device__ __forceinline__ void ph_wt(const P& p, int layer, char* smem, int b, int nb) {
  bf* WT = (bf*)(p.ws + (layer ? OFF_WT1 : OFF_WT));
  int base = layer ? 34 : 8;
  int nin = layer ? 3104 : 3328, ninp = 3328;
  for (int mtx = 0; mtx < 4; ++mtx) {
    const float* W = p.in[base + mtx];
    bf* dst = WT + (mtx == 0 ? WT_IN : mtx == 1 ? WT_OUT : mtx == 2 ? WT_W1 : WT_W2);
    int K = mtx == 3 ? 4096 : 1024;
    int N = mtx == 0 ? nin : mtx == 2 ? 4096 : 1024;
    int Np = mtx == 0 ? ninp : N;
    transpose_one(W, dst, K, N, Np, (b + (nb / 4) * mtx) % nb, nb, smem);
  }
}

__device__ __forceinline__ void ph_ada(const P& p, int layer, int which, int useInput, int latonly) {
  const int lane = tidx() & 63, wave = tidx() >> 6;
  const float* ng = p.in[(layer ? 32 : 6) + which];
  const float* mod = (const float*)(p.ws + OFF_MOD);
  bf* H = (bf*)(p.ws + OFF_HO);
  for (int R = blockIdx.x * 8 + wave; R < RT; R += gridDim.x * 8) {
    int b = R / TA, a = R - b * TA;
    if (latonly && a < CTX) continue;
    const float* src = useInput ? inrow(p, R) : xrow(p, R);
    float4 v[4];
    float ss = 0.f;
#pragma unroll
    for (int i = 0; i < 4; ++i) {
      v[i] = *(const float4*)(src + i * 256 + lane * 4);
      ss += v[i].x * v[i].x + v[i].y * v[i].y + v[i].z * v[i].z + v[i].w * v[i].w;
    }
    ss = wave_sum(ss);
    float rs = rsqrtf(ss * (1.f / 1024.f) + 1e-6f);
    int mr = a < CTX ? 8 : b;
    const float* sh = mod + (size_t)(layer * 9 + mr) * 6144 + (which * 3 + 0) * 1024;
    const float* scl = mod + (size_t)(layer * 9 + mr) * 6144 + (which * 3 + 1) * 1024;
#pragma unroll
    for (int i = 0; i < 4; ++i) {
      int k = i * 256 + lane * 4;
      float4 g = *(const float4*)(ng + k);
      float4 s4 = *(const float4*)(sh + k);
      float4 c4 = *(const float4*)(scl + k);
      float o0 = v[i].x * rs * g.x * (1.f + c4.x) + s4.x;
      float o1 = v[i].y * rs * g.y * (1.f + c4.y) + s4.y;
      float o2 = v[i].z * rs * g.z * (1.f + c4.z) + s4.z;
      float o3 = v[i].w * rs * g.w * (1.f + c4.w) + s4.w;
      uint2 o;
      o.x = pack2(o0, o1);
      o.y = pack2(o2, o3);
      *(uint2*)(H + (size_t)R * 1024 + k) = o;
    }
  }
}

namespace pg8 {
#define PG8_LAS __attribute__((address_space(3)))
typedef float f32x2 __attribute__((ext_vector_type(2)));
typedef unsigned u32x4 __attribute__((ext_vector_type(4)));
constexpr int BM = 256, BK = 64, HALF = 128, HTB = HALF * BK * 2, STAGE_BYTES = 8 * HTB, NXCD = 8, WGM = 8;
__device__ __forceinline__ int lds_byte(int r, int c) { const int st = (r >> 4) * 2 + (c >> 5), rr = r & 15, cc = c & 31, ob = rr * 64 + cc * 2; return st * 1024 + (ob ^ (((ob >> 9) & 1) << 5)); }
__device__ __forceinline__ void stage_rc(int b, int& R, int& C) { const int st = b / 1024, sb = b % 1024, swz = sb ^ (((sb >> 9) & 1) << 5); R = (st >> 1) * 16 + swz / 64; C = (st & 1) * 32 + (swz % 64) / 2; }
__device__ __forceinline__ int perm32(int rho) { const int n = rho >> 4, i = rho & 15; return 8 * (i >> 2) + 4 * n + (i & 3); }
struct Unit { int pm, pn; };
struct Gemm { const bf* A; const bf* Bt; int K; };
struct Order {
  int nM, nN, nwg, G, c, latonly;
  __device__ void init(int nM_, int nN_, int G_, int c_, int lat) { nM = nM_; nN = nN_; nwg = nM * nN; G = G_; c = c_; latonly = lat; }
  __device__ bool next(int i, Unit& u) const {
    const long L = (long)i * G + c;
    if (L >= nwg) return false;
    int wgid = (int)L;
    { const int q = nwg / NXCD, r = nwg % NXCD, xcd = wgid % NXCD, off = wgid / NXCD; wgid = (xcd < r ? xcd * (q + 1) : r * (q + 1) + (xcd - r) * q) + off; }
    const int nig = WGM * nN, gid = wgid / nig, fm = gid * WGM, gsz = (nM - fm) < WGM ? (nM - fm) : WGM;
    int pm = fm + ((wgid % nig) % gsz);
    u.pn = (wgid % nig) / gsz;
    u.pm = latonly ? ((pm >> 4) * 17 + 1 + (pm & 15)) : pm;
    return true;
  }
};
__device__ __forceinline__ unsigned cvt_pk_bf16(float lo, float hi) { return pack2(lo, hi); }

template <int EPI>
struct Epi {
  static constexpr bool PERM = (EPI == 0 || EPI == 1 || EPI == 3);
  P p;
  int layer;
  __device__ __forceinline__ void operator()(const f32x4 (&acc)[2][2][4][2], const Unit& u, int wr, int wc, int fr, int fq) const {
#pragma unroll
    for (int ai = 0; ai < 2; ++ai)
#pragma unroll
      for (int m = 0; m < 4; ++m) {
        const int row = u.pm * BM + ai * HALF + wr * 64 + m * 16 + fr;
        if constexpr (PERM) {
#pragma unroll
          for (int bj = 0; bj < 2; ++bj) {
            const int c0 = u.pn * BM + bj * HALF + wc * 32 + 8 * fq;
            f32x4 v0 = acc[ai][bj][m][0], v1 = acc[ai][bj][m][1];
            if constexpr (EPI == 3) {
#pragma unroll
              for (int j = 0; j < 4; ++j) { float a = v0[j] > 0.f ? v0[j] : 0.f; v0[j] = a * a; float b2 = v1[j] > 0.f ? v1[j] : 0.f; v1[j] = b2 * b2; }
            }
            u32x4 w;
            w.x = cvt_pk_bf16(v0[0], v0[1]); w.y = cvt_pk_bf16(v0[2], v0[3]); w.z = cvt_pk_bf16(v1[0], v1[1]); w.w = cvt_pk_bf16(v1[2], v1[3]);
            if constexpr (EPI == 0) {
              bf* dst = c0 < 1536 ? (bf*)(p.ws + OFF_QKV) + (size_t)row * 1536 + c0 : (bf*)p.out + (size_t)row * 1792 + (c0 - 1536);
              *(u32x4*)dst = w;
            } else if constexpr (EPI == 1) {
              if (c0 < 512) *(u32x4*)((bf*)(p.ws + OFF_P1C) + (size_t)row * 2080 + c0) = w;
              else if (c0 < 1536) *(u32x4*)((bf*)(p.ws + OFF_XRAW) + (size_t)row * 1024 + (c0 - 512)) = w;
              else if (c0 < 1552) { float* d = (float*)(p.ws + OFF_DTRAW) + (size_t)row * 16 + (c0 - 1536); *(f32x4*)d = v0; *(f32x4*)(d + 4) = v1; }
              else if (c0 < 3104) *(u32x4*)((bf*)(p.ws + OFF_P1C) + (size_t)row * 2080 + (c0 - 1024)) = w;
            } else {
              *(u32x4*)((bf*)(p.ws + OFF_HID) + (size_t)row * 4096 + c0) = w;
            }
          }
        } else {
          const float* gate = (const float*)(p.ws + OFF_MOD) + (size_t)(layer * 9 + mrow(row)) * 6144 + (EPI == 2 ? 2 : 5) * 1024;
          float* xr = xrow(p, row);
          const float* br = (EPI == 2 && layer == 0) ? inrow(p, row) : xr;
#pragma unroll
          for (int bj = 0; bj < 2; ++bj)
#pragma unroll
            for (int n = 0; n < 2; ++n) {
              const int c = u.pn * BM + bj * HALF + wc * 32 + 16 * n + 4 * fq;
              f32x4 gt = *(const f32x4*)(gate + c);
              f32x4 bs = *(const f32x4*)(br + c);
              *(f32x4*)(xr + c) = bs + gt * acc[ai][bj][m][n];
            }
        }
      }
  }
};

template <class EpiT>
__device__ __forceinline__ void gemm_phase(PG8_LAS unsigned char* lds, const Gemm g, const Order& S, const EpiT& E) {
  const int tid = tidx(), wid = __builtin_amdgcn_readfirstlane(tid >> 6), lane = tid & 63, wr = wid >> 2, wc = wid & 3, fr = lane & 15, fq = lane >> 4;
  const int K = g.K, nt = K / BK;
  unsigned voffA[2], voffB[2];
#pragma unroll
  for (int i = 0; i < 2; ++i) { int R, C; stage_rc(tid * 16 + i * 8192, R, C); const int Rb = EpiT::PERM ? ((R & ~31) + perm32(R & 31)) : R;
    voffA[i] = (unsigned)(R * K + C) * 2u; voffB[i] = (unsigned)(Rb * K + C) * 2u; }
  const size_t kstep = (size_t)(BK * 2);
  const size_t hstep = (size_t)HALF * K * 2;
  const size_t tstep = 2 * hstep;
  const unsigned ldsw = (unsigned)wid * 1024u;
  const int aoff = lds_byte(wr * 64 + fr, fq * 8), boff = lds_byte(wc * 32 + fr, fq * 8);
#define PG8_SA(b, h) (((b) * 2 + (h)) * HTB)
#define PG8_SB(b, h) ((4 + (b) * 2 + (h)) * HTB)
#define PG8_STAGE(bufoff, gbase, voff) do { _Pragma("unroll") for (int _i = 0; _i < 2; ++_i) \
        __builtin_amdgcn_global_load_lds((const unsigned*)((const char*)(gbase) + (voff)[_i]), (PG8_LAS unsigned*)(lds + (bufoff) + ldsw + _i * 8192), 16, 0, 0); } while (0)
#define PG8_LDA(dst, b, h) do { _Pragma("unroll") for (int m = 0; m < 4; ++m) _Pragma("unroll") for (int k = 0; k < 2; ++k) dst[m][k] = *(const PG8_LAS bf16x8*)(lds + PG8_SA(b, h) + aoff + m * 2048 + k * 1024); } while (0)
#define PG8_LDB(dst, b, h) do { _Pragma("unroll") for (int n = 0; n < 2; ++n) _Pragma("unroll") for (int k = 0; k < 2; ++k) dst[n][k] = *(const PG8_LAS bf16x8*)(lds + PG8_SB(b, h) + boff + n * 2048 + k * 1024); } while (0)
#define PG8_MMA(ai, bj, At, Bt) do { __builtin_amdgcn_s_setprio(1); _Pragma("unroll") for (int m = 0; m < 4; ++m) _Pragma("unroll") for (int n = 0; n < 2; ++n) _Pragma("unroll") for (int k = 0; k < 2; ++k) \
        acc[ai][bj][m][n] = __builtin_amdgcn_mfma_f32_16x16x32_bf16(Bt[n][k], At[m][k], acc[ai][bj][m][n], 0, 0, 0); __builtin_amdgcn_s_setprio(0); } while (0)
#define PG8_WAIT_V(n) asm volatile("s_waitcnt vmcnt(" #n ")" ::: "memory")
#define PG8_WAIT_L(n) asm volatile("s_waitcnt lgkmcnt(" #n ")" ::: "memory")
#define PG8_BAR __builtin_amdgcn_s_barrier()
#define PG8_SCHED __builtin_amdgcn_sched_barrier(0)
  Unit cur, nxt; int ui = 0;
  if (!S.next(0, cur)) return;
  f32x4 acc[2][2][4][2];
#pragma unroll
  for (int a = 0; a < 2; ++a)
#pragma unroll
    for (int b = 0; b < 2; ++b)
#pragma unroll
      for (int m = 0; m < 4; ++m)
#pragma unroll
        for (int n = 0; n < 2; ++n) acc[a][b][m][n] = (f32x4){0.f, 0.f, 0.f, 0.f};
  bf16x8 At[4][2], B0[2][2], B1[2][2];
  const char* cA = (const char*)g.A + (size_t)cur.pm * tstep; const char* cB = (const char*)g.Bt + (size_t)cur.pn * tstep;
  PG8_STAGE(PG8_SB(0, 0), cB, voffB); PG8_STAGE(PG8_SA(0, 0), cA, voffA); PG8_STAGE(PG8_SB(0, 1), cB + hstep, voffB); PG8_STAGE(PG8_SA(0, 1), cA + hstep, voffA);
  if (wr == 1) PG8_BAR;
  PG8_WAIT_V(4); PG8_BAR;
  PG8_STAGE(PG8_SB(1, 0), cB + kstep, voffB); PG8_STAGE(PG8_SA(1, 0), cA + kstep, voffA); PG8_STAGE(PG8_SB(1, 1), cB + hstep + kstep, voffB);
  PG8_WAIT_V(6); PG8_BAR;
  for (;;) {
    const bool has_next = S.next(ui + 1, nxt);
    const char* nA = has_next ? (const char*)g.A + (size_t)nxt.pm * tstep : cA; const char* nB = has_next ? (const char*)g.Bt + (size_t)nxt.pn * tstep : cB;
    for (int t = 0; t < nt; t += 2) {
      const bool last = (t == nt - 2);
      const char* a1 = cA + (size_t)(t + 1) * kstep;
      const char* a2 = last ? nA : cA + (size_t)(t + 2) * kstep; const char* b2 = last ? nB : cB + (size_t)(t + 2) * kstep;
      const char* a3 = a2 + kstep; const char* b3 = b2 + kstep;
      PG8_LDB(B0, 0, 0); PG8_SCHED; PG8_LDA(At, 0, 0); PG8_STAGE(PG8_SA(1, 1), a1 + hstep, voffA);
      PG8_WAIT_L(8); PG8_BAR; PG8_WAIT_L(0); PG8_MMA(0, 0, At, B0); PG8_BAR; PG8_SCHED;
      PG8_LDB(B1, 0, 1); PG8_STAGE(PG8_SB(0, 0), b2, voffB);
      PG8_BAR; PG8_WAIT_L(0); PG8_MMA(0, 1, At, B1); PG8_BAR;
      PG8_LDA(At, 0, 1); PG8_STAGE(PG8_SA(0, 0), a2, voffA);
      PG8_BAR; PG8_WAIT_L(0); PG8_MMA(1, 0, At, B0); PG8_BAR; PG8_SCHED;
      PG8_STAGE(PG8_SB(0, 1), b2 + hstep, voffB);
      PG8_WAIT_V(6); PG8_BAR; PG8_MMA(1, 1, At, B1); PG8_BAR;
      PG8_LDB(B0, 1, 0); PG8_SCHED; PG8_LDA(At, 1, 0); PG8_STAGE(PG8_SA(0, 1), a2 + hstep, voffA);
      PG8_WAIT_L(8); PG8_BAR; PG8_WAIT_L(0); PG8_MMA(0, 0, At, B0); PG8_BAR; PG8_SCHED;
      PG8_LDB(B1, 1, 1); PG8_STAGE(PG8_SB(1, 0), b3, voffB);
      PG8_BAR; PG8_WAIT_L(0); PG8_MMA(0, 1, At, B1); PG8_BAR;
      PG8_LDA(At, 1, 1); PG8_STAGE(PG8_SA(1, 0), a3, voffA);
      PG8_BAR; PG8_WAIT_L(0); PG8_MMA(1, 0, At, B0); PG8_BAR; PG8_SCHED;
      PG8_STAGE(PG8_SB(1, 1), b3 + hstep, voffB);
      PG8_WAIT_V(6); PG8_BAR; PG8_MMA(1, 1, At, B1); PG8_BAR;
    }
    E(acc, cur, wr, wc, fr, fq);
    if (!has_next) break;
#pragma unroll
    for (int a = 0; a < 2; ++a)
#pragma unroll
      for (int b = 0; b < 2; ++b)
#pragma unroll
        for (int m = 0; m < 4; ++m)
#pragma unroll
          for (int n = 0; n < 2; ++n) acc[a][b][m][n] = (f32x4){0.f, 0.f, 0.f, 0.f};
    cur = nxt; cA = nA; cB = nB; ++ui;
  }
  PG8_WAIT_V(0);
  if (wr == 0) PG8_BAR;
  PG8_BAR;
#undef PG8_SA
#undef PG8_SB
#undef PG8_STAGE
#undef PG8_LDA
#undef PG8_LDB
#undef PG8_MMA
#undef PG8_WAIT_V
#undef PG8_WAIT_L
#undef PG8_BAR
#undef PG8_SCHED
}
}

template <int EPI>
__device__ __forceinline__ void ph_gemm(const P& p, const bf* A, const bf* Bt, int K, int nN, int layer, int latonly, char* smem) {
  pg8::Order S;
  S.init(latonly ? 128 : 136, nN, gridDim.x, blockIdx.x, latonly);
  pg8::Epi<EPI> E{p, layer};
  pg8::Gemm g{A, Bt, K};
  __syncthreads();
  pg8::gemm_phase(( __attribute__((address_space(3))) unsigned char*)smem, g, S, E);
  __syncthreads();
}

__device__ __forceinline__ void ph_rope(const P& p, char* smem) {
  float* tcos = (float*)smem;
  float* tsin = tcos + 1024;
  const int tid = tidx();
  __syncthreads();
  for (int i = tid; i < 1024; i += NT) {
    int c = i >> 4, f = i & 15;
    float inv = powf(10000.f, -(float)f / 16.f);
    float ang = (float)c * inv;
    float sn, cs;
    sincosf(ang, &sn, &cs);
    tcos[i] = cs;
    tsin[i] = sn;
  }
  __syncthreads();
  bf* QKV = (bf*)(p.ws + OFF_QKV);
  for (int it = blockIdx.x * NT + tid; it < RT * 32; it += gridDim.x * NT) {
    int R = it >> 5;
    int vec = (it >> 1) & 15, half = it & 1;
    int b = R / TA, a = R - b * TA;
    bool isq = vec < 8;
    if (!isq && a < CTX) continue;
    bf* ptr = QKV + (size_t)R * 1536 + vec * 64 + half * 32;
    uint4 a0 = *(const uint4*)ptr, a1 = *(const uint4*)(ptr + 8), b0 = *(const uint4*)(ptr + 16), b1 = *(const uint4*)(ptr + 24);
    float x1[16], x2[16];
    x1[0] = bflo(a0.x); x1[1] = bfhi(a0.x); x1[2] = bflo(a0.y); x1[3] = bfhi(a0.y); x1[4] = bflo(a0.z); x1[5] = bfhi(a0.z); x1[6] = bflo(a0.w); x1[7] = bfhi(a0.w);
    x1[8] = bflo(a1.x); x1[9] = bfhi(a1.x); x1[10] = bflo(a1.y); x1[11] = bfhi(a1.y); x1[12] = bflo(a1.z); x1[13] = bfhi(a1.z); x1[14] = bflo(a1.w); x1[15] = bfhi(a1.w);
    x2[0] = bflo(b0.x); x2[1] = bfhi(b0.x); x2[2] = bflo(b0.y); x2[3] = bfhi(b0.y); x2[4] = bflo(b0.z); x2[5] = bfhi(b0.z); x2[6] = bflo(b0.w); x2[7] = bfhi(b0.w);
    x2[8] = bflo(b1.x); x2[9] = bfhi(b1.x); x2[10] = bflo(b1.y); x2[11] = bfhi(b1.y); x2[12] = bflo(b1.z); x2[13] = bfhi(b1.z); x2[14] = bflo(b1.w); x2[15] = bfhi(b1.w);
    const float qs = isq ? 0.125f : 1.f;
    if (a >= CTX) {
      int pos = a - CTX;
      int cidx = half == 0 ? (pos >> 6) : (pos & 63);
#pragma unroll
      for (int f = 0; f < 16; ++f) {
        float cs = tcos[cidx * 16 + f], sn = tsin[cidx * 16 + f];
        float y1 = x1[f] * cs - x2[f] * sn, y2 = x2[f] * cs + x1[f] * sn;
        x1[f] = y1 * qs;
        x2[f] = y2 * qs;
      }
    } else {
#pragma unroll
      for (int f = 0; f < 16; ++f) { x1[f] *= qs; x2[f] *= qs; }
    }
    uint4 o;
    o.x = pack2(x1[0], x1[1]); o.y = pack2(x1[2], x1[3]); o.z = pack2(x1[4], x1[5]); o.w = pack2(x1[6], x1[7]); *(uint4*)ptr = o;
    o.x = pack2(x1[8], x1[9]); o.y = pack2(x1[10], x1[11]); o.z = pack2(x1[12], x1[13]); o.w = pack2(x1[14], x1[15]); *(uint4*)(ptr + 8) = o;
    o.x = pack2(x2[0], x2[1]); o.y = pack2(x2[2], x2[3]); o.z = pack2(x2[4], x2[5]); o.w = pack2(x2[6], x2[7]); *(uint4*)(ptr + 16) = o;
    o.x = pack2(x2[8], x2[9]); o.y = pack2(x2[10], x2[11]); o.z = pack2(x2[12], x2[13]); o.w = pack2(x2[14], x2[15]); *(uint4*)(ptr + 24) = o;
  }
}

__device__ __forceinline__ float shiftmix(const bf* PB, const float* mu, int R, int a, int col) {
  int lo = a < CTX ? 0 : CTX, hi = a < CTX ? CTX : TA;
  float t = bf2f(PB[(size_t)R * 1792 + col]);
  float pv = a > lo ? bf2f(PB[(size_t)(R - 1) * 1792 + col]) : 0.f;
  float nx = a + 1 < hi ? bf2f(PB[(size_t)(R + 1) * 1792 + col]) : 0.f;
  return t + (0.5f * (pv + nx) - t) * mu[col];
}
__device__ __forceinline__ void ph_lw(const P& p) {
  bf* LW = (bf*)(p.ws + OFF_LW);
  const float *w2f = p.in[19], *w2b = p.in[21], *a2 = p.in[23], *g2 = p.in[24];
  for (int i = blockIdx.x * NT + tidx(); i < 512 * 320; i += gridDim.x * NT) {
    int n = i / 320, kk = i - n * 320;
    float v = kk < 64 ? w2f[kk * 512 + n] : kk < 128 ? w2b[(kk - 64) * 512 + n] : kk < 192 ? a2[(kk - 128) * 512 + n] : g2[(kk - 192) * 512 + n];
    LW[i] = f2bf(v);
  }
}
__device__ __forceinline__ float shiftmix_l(const bf* PBs, const float muc, int t, int a, int col) {
  const int lo = a < CTX ? 0 : CTX, hi = a < CTX ? CTX : TA;
  const float x = bf2f(PBs[(t + 1) * 1792 + col]);
  const float pv = a > lo ? bf2f(PBs[t * 1792 + col]) : 0.f;
  const float nx = a + 1 < hi ? bf2f(PBs[(t + 2) * 1792 + col]) : 0.f;
  return x + (0.5f * (pv + nx) - x) * muc;
}
__device__ __forceinline__ void ph_rwkv_prep(const P& p, char* smem) {
  bf* linA = (bf*)smem;
  bf* PBs = linA + 16 * 264;
  const int tid = tidx(), lane = tid & 63, wave = tid >> 6;
  const int l15 = lane & 15, g = lane >> 4;
  const bf* PB = (const bf*)p.out;
  const bf* LW = (const bf*)(p.ws + OFF_LW);
  const float* mu = p.in[17];
  bf* PR = (bf*)(p.ws + OFF_PREP);
  bf* PK = PR + (size_t)RT * 512;
  bf* PV = PK + (size_t)RT * 512;
  bf* PKK = PV + (size_t)RT * 512;
  bf* PKA = PKK + (size_t)RT * 512;
  bf* PLF = PKA + (size_t)RT * 512;
  bf* PLB = PLF + (size_t)RT * 512;
  bf* G = (bf*)(p.ws + OFF_G);
  float* BON = (float*)(p.ws + OFF_BONUS);
  float cw0f[4], cw0b[4], ca0[4], ckk[4], cka[4], crk[4], cmr[4], cmk[4], cmv[4];
#pragma unroll
  for (int nt = 0; nt < 4; ++nt) {
    int c = wave * 64 + nt * 16 + l15;
    cw0f[nt] = p.in[18][c]; cw0b[nt] = p.in[20][c]; ca0[nt] = p.in[22][c]; ckk[nt] = p.in[25][c]; cka[nt] = p.in[26][c]; crk[nt] = p.in[27][c];
    cmr[nt] = mu[c]; cmk[nt] = mu[512 + c]; cmv[nt] = mu[1024 + c];
  }
  for (int unit = blockIdx.x; unit < RT / 16; unit += gridDim.x) {
    const int R0 = unit * 16;
    const int b = R0 / TA, a00 = R0 - b * TA;
    __syncthreads();
    for (int ch = tid; ch < 18 * 224; ch += NT) {
      const int rr = ch / 224, cc = ch - rr * 224;
      const int Rg = R0 - 1 + rr;
      uint4 v = make_uint4(0, 0, 0, 0);
      if (Rg >= 0 && Rg < RT) v = *(const uint4*)(PB + (size_t)Rg * 1792 + cc * 8);
      *(uint4*)(PBs + rr * 1792 + cc * 8) = v;
    }
    __syncthreads();
#pragma unroll
    for (int i = 0; i < 8; ++i) {
      int idx = tid + NT * i;
      int tok = idx >> 8, j = idx & 255;
      float f = shiftmix_l(PBs, mu[1536 + j], tok, a00 + tok, 1536 + j);
      float val = j < 64 ? tanhf(f) : (j < 128 ? f : sigmoidf_(f));
      linA[tok * 264 + j] = f2bf(val);
    }
    __syncthreads();
    f32x4 wf[4], wb[4], aa[4], gg[4];
#pragma unroll
    for (int nt = 0; nt < 4; ++nt) {
      wf[nt] = (f32x4){0.f, 0.f, 0.f, 0.f}; wb[nt] = wf[nt]; aa[nt] = wf[nt]; gg[nt] = wf[nt];
    }
#pragma unroll
    for (int nt = 0; nt < 4; ++nt) {
      const bf* lw = LW + (size_t)(wave * 64 + nt * 16 + l15) * 320 + g * 8;
#pragma unroll
      for (int ks = 0; ks < 2; ++ks) {
        bf16x8 aw = *(const bf16x8*)(linA + l15 * 264 + ks * 32 + g * 8);
        wf[nt] = __builtin_amdgcn_mfma_f32_16x16x32_bf16(aw, *(const bf16x8*)(lw + ks * 32), wf[nt], 0, 0, 0);
        wb[nt] = __builtin_amdgcn_mfma_f32_16x16x32_bf16(aw, *(const bf16x8*)(lw + 64 + ks * 32), wb[nt], 0, 0, 0);
        bf16x8 a_a = *(const bf16x8*)(linA + l15 * 264 + 64 + ks * 32 + g * 8);
        aa[nt] = __builtin_amdgcn_mfma_f32_16x16x32_bf16(a_a, *(const bf16x8*)(lw + 128 + ks * 32), aa[nt], 0, 0, 0);
      }
#pragma unroll
      for (int ks = 0; ks < 4; ++ks) {
        bf16x8 ag = *(const bf16x8*)(linA + l15 * 264 + 128 + ks * 32 + g * 8);
        gg[nt] = __builtin_amdgcn_mfma_f32_16x16x32_bf16(ag, *(const bf16x8*)(lw + 192 + ks * 32), gg[nt], 0, 0, 0);
      }
    }
#pragma unroll
    for (int r = 0; r < 4; ++r) {
      const int t = g * 4 + r;
      const int R = R0 + t, a = a00 + t;
      float fr[4], fv[4], kkv[4], km[4], av[4];
      float n2 = 0.f, bon = 0.f;
#pragma unroll
      for (int nt = 0; nt < 4; ++nt) {
        int c = wave * 64 + nt * 16 + l15;
        fr[nt] = shiftmix_l(PBs, cmr[nt], t, a, c);
        float fk = shiftmix_l(PBs, cmk[nt], t, a, 512 + c);
        fv[nt] = shiftmix_l(PBs, cmv[nt], t, a, 1024 + c);
        av[nt] = sigmoidf_(ca0[nt] + aa[nt][r]);
        kkv[nt] = fk * ckk[nt];
        n2 += kkv[nt] * kkv[nt];
        km[nt] = fk * (1.f + (av[nt] - 1.f) * cka[nt]);
        bon += fr[nt] * km[nt] * crk[nt];
      }
      n2 = red16(n2);
      bon = red16(bon);
      float rn = 1.f / fmaxf(sqrtf(n2), 1e-12f);
#pragma unroll
      for (int nt = 0; nt < 4; ++nt) {
        int c = wave * 64 + nt * 16 + l15;
        size_t o = (size_t)R * 512 + c;
        float lwf = -__expf(-softplusf_(-(cw0f[nt] + wf[nt][r])) - 0.5f);
        float lwb = -__expf(-softplusf_(-(cw0b[nt] + wb[nt][r])) - 0.5f);
        float kk = kkv[nt] * rn;
        PR[o] = f2bf(fr[nt]);
        PK[o] = f2bf(km[nt]);
        PV[o] = f2bf(fv[nt]);
        PKK[o] = f2bf(kk);
        PKA[o] = f2bf(kk * av[nt]);
        PLF[o] = f2bf(lwf);
        PLB[o] = f2bf(lwb);
        G[o] = f2bf(gg[nt][r]);
      }
      if (l15 == 0) BON[(size_t)R * 8 + wave] = bon;
    }
  }
}

__device__ __forceinline__ int scan_row(int b, int dir, int s) {
  int a = dir ? (s < CTX ? CTX - 1 - s : TA + CTX - 1 - s) : s;
  return b * TA + a;
}

__device__ __forceinline__ void rwkv_chain(const P& p, int chain, int half, char* smem) {
  const int dir = chain & 1, h = (chain >> 1) & 7, b = chain >> 4;
  float* cR = (float*)smem;
  float* cW = cR + 2048;
  float* cK = cW + 2048;
  float* cKK = cK + 2048;
  float* cKA = cKK + 2048;
  float* cV = cKA + 2048;
  float* yb = cV + 2048;
  const int tid = tidx(), lane = tid & 63, wave = tid >> 6;
  const int l15 = lane & 15, lg = lane >> 4;
  const bf* PR = (const bf*)(p.ws + OFF_PREP);
  const bf* PK = PR + (size_t)RT * 512;
  const bf* PV = PK + (size_t)RT * 512;
  const bf* PKK = PV + (size_t)RT * 512;
  const bf* PKA = PKK + (size_t)RT * 512;
  const bf* PLW = PKA + (size_t)RT * 512 + (size_t)dir * RT * 512;
  bf* Y = (bf*)p.out + (size_t)dir * RT * 512;
  const int st = tid >> 4, c4 = (tid & 15) * 4;
  const int r0 = half < 0 ? wave * 8 + lg * 2 : half * 32 + (wave & 3) * 8 + lg * 2;
  const bool active = half < 0 || wave < 4;
  const bool ywr = half < 0 || ((c4 >> 5) == half);
  float s0[4], s1[4];
#pragma unroll
  for (int j = 0; j < 4; ++j) { s0[j] = 0.f; s1[j] = 0.f; }
  uint2 gR, gW, gK, gV, gKK, gKA;
  {
    size_t o = (size_t)scan_row(b, dir, st) * 512 + h * 64 + c4;
    gR = *(const uint2*)(PR + o); gW = *(const uint2*)(PLW + o); gK = *(const uint2*)(PK + o);
    gV = *(const uint2*)(PV + o); gKK = *(const uint2*)(PKK + o); gKA = *(const uint2*)(PKA + o);
  }
  const int NCH = TA / 32;
  for (int ch = 0; ch <= NCH; ++ch) {
    __syncthreads();
    if (ch > 0 && ywr) {
      float4 y4 = *(const float4*)(yb + st * 64 + c4);
      uint2 o2;
      o2.x = pack2(y4.x, y4.y);
      o2.y = pack2(y4.z, y4.w);
      *(uint2*)(Y + (size_t)scan_row(b, dir, (ch - 1) * 32 + st) * 512 + h * 64 + c4) = o2;
    }
    if (ch == NCH) break;
    {
      int o = st * 64 + c4;
      *(float4*)(cR + o) = make_float4(bflo(gR.x), bfhi(gR.x), bflo(gR.y), bfhi(gR.y));
      *(float4*)(cW + o) = make_float4(__expf(bflo(gW.x)), __expf(bfhi(gW.x)), __expf(bflo(gW.y)), __expf(bfhi(gW.y)));
      *(float4*)(cK + o) = make_float4(bflo(gK.x), bfhi(gK.x), bflo(gK.y), bfhi(gK.y));
      *(float4*)(cV + o) = make_float4(bflo(gV.x), bfhi(gV.x), bflo(gV.y), bfhi(gV.y));
      *(float4*)(cKK + o) = make_float4(bflo(gKK.x), bfhi(gKK.x), bflo(gKK.y), bfhi(gKK.y));
      *(float4*)(cKA + o) = make_float4(bflo(gKA.x), bfhi(gKA.x), bflo(gKA.y), bfhi(gKA.y));
    }
    __syncthreads();
    if (ch + 1 < NCH) {
      size_t o = (size_t)scan_row(b, dir, (ch + 1) * 32 + st) * 512 + h * 64 + c4;
      gR = *(const uint2*)(PR + o); gW = *(const uint2*)(PLW + o); gK = *(const uint2*)(PK + o);
      gV = *(const uint2*)(PV + o); gKK = *(const uint2*)(PKK + o); gKA = *(const uint2*)(PKA + o);
    }
    if (active) {
      float4 kk4 = *(const float4*)(cKK + l15 * 4);
      float4 w4 = *(const float4*)(cW + l15 * 4);
      float4 k4 = *(const float4*)(cK + l15 * 4);
      float4 ka4 = *(const float4*)(cKA + l15 * 4);
      float4 r4 = *(const float4*)(cR + l15 * 4);
      float2 v2 = *(const float2*)(cV + r0);
#pragma unroll 2
      for (int t = 0; t < 32; ++t) {
        const int tn = (t + 1) & 31;
        float4 nkk4 = *(const float4*)(cKK + tn * 64 + l15 * 4);
        float4 nw4 = *(const float4*)(cW + tn * 64 + l15 * 4);
        float4 nk4 = *(const float4*)(cK + tn * 64 + l15 * 4);
        float4 nka4 = *(const float4*)(cKA + tn * 64 + l15 * 4);
        float4 nr4 = *(const float4*)(cR + tn * 64 + l15 * 4);
        float2 nv2 = *(const float2*)(cV + tn * 64 + r0);
        float sa0 = (s0[0] * kk4.x + s0[1] * kk4.y) + (s0[2] * kk4.z + s0[3] * kk4.w);
        float sa1 = (s1[0] * kk4.x + s1[1] * kk4.y) + (s1[2] * kk4.z + s1[3] * kk4.w);
        float p00 = s0[0] * w4.x + v2.x * k4.x, p01 = s0[1] * w4.y + v2.x * k4.y, p02 = s0[2] * w4.z + v2.x * k4.z, p03 = s0[3] * w4.w + v2.x * k4.w;
        float p10 = s1[0] * w4.x + v2.y * k4.x, p11 = s1[1] * w4.y + v2.y * k4.y, p12 = s1[2] * w4.z + v2.y * k4.z, p13 = s1[3] * w4.w + v2.y * k4.w;
        sa0 = red16(sa0);
        sa1 = red16(sa1);
        s0[0] = p00 - sa0 * ka4.x; s0[1] = p01 - sa0 * ka4.y; s0[2] = p02 - sa0 * ka4.z; s0[3] = p03 - sa0 * ka4.w;
        s1[0] = p10 - sa1 * ka4.x; s1[1] = p11 - sa1 * ka4.y; s1[2] = p12 - sa1 * ka4.z; s1[3] = p13 - sa1 * ka4.w;
        float y0 = (s0[0] * r4.x + s0[1] * r4.y) + (s0[2] * r4.z + s0[3] * r4.w);
        float y1 = (s1[0] * r4.x + s1[1] * r4.y) + (s1[2] * r4.z + s1[3] * r4.w);
        y0 = red16(y0);
        y1 = red16(y1);
        if (l15 == 0) *(float2*)(yb + t * 64 + r0) = make_float2(y0, y1);
        kk4 = nkk4; w4 = nw4; k4 = nk4; ka4 = nka4; r4 = nr4; v2 = nv2;
      }
    }
  }
}


template <int OFFB>
__device__ __forceinline__ bf16x8 tr_pair(const bf* pp) {
  typedef short s16x4_ __attribute__((ext_vector_type(4)));
  s16x4_ v0, v1;
  unsigned addr = (unsigned)(size_t)(__attribute__((address_space(3))) const void*)pp;
  asm volatile("s_waitcnt lgkmcnt(0)\n\tds_read_b64_tr_b16 %0, %2\n\tds_read_b64_tr_b16 %1, %2 offset:%3\n\ts_waitcnt lgkmcnt(0)" : "=&v"(v0), "=&v"(v1) : "v"(addr), "n"(OFFB) : "memory");
  return __builtin_shufflevector(v0, v1, 0, 1, 2, 3, 4, 5, 6, 7);
}
template <int STRB, int OFF2B>
__device__ __forceinline__ void tr_quad(const bf* pp, bf16x8& f0, bf16x8& f1, bf16x8& f2, bf16x8& f3) {
  typedef short s16x4_ __attribute__((ext_vector_type(4)));
  s16x4_ a0, b0, a1, b1, a2, b2, a3, b3;
  unsigned addr = (unsigned)(size_t)(__attribute__((address_space(3))) const void*)pp;
  asm volatile(
      "s_waitcnt lgkmcnt(0)\n\t"
      "ds_read_b64_tr_b16 %0, %8\n\t"
      "ds_read_b64_tr_b16 %1, %8 offset:%9\n\t"
      "ds_read_b64_tr_b16 %2, %8 offset:%10\n\t"
      "ds_read_b64_tr_b16 %3, %8 offset:%11\n\t"
      "ds_read_b64_tr_b16 %4, %8 offset:%12\n\t"
      "ds_read_b64_tr_b16 %5, %8 offset:%13\n\t"
      "ds_read_b64_tr_b16 %6, %8 offset:%14\n\t"
      "ds_read_b64_tr_b16 %7, %8 offset:%15\n\t"
      "s_waitcnt lgkmcnt(0)"
      : "=&v"(a0), "=&v"(b0), "=&v"(a1), "=&v"(b1), "=&v"(a2), "=&v"(b2), "=&v"(a3), "=&v"(b3)
      : "v"(addr), "n"(OFF2B), "n"(STRB), "n"(STRB + OFF2B), "n"(2 * STRB), "n"(2 * STRB + OFF2B), "n"(3 * STRB), "n"(3 * STRB + OFF2B)
      : "memory");
  f0 = __builtin_shufflevector(a0, b0, 0, 1, 2, 3, 4, 5, 6, 7);
  f1 = __builtin_shufflevector(a1, b1, 0, 1, 2, 3, 4, 5, 6, 7);
  f2 = __builtin_shufflevector(a2, b2, 0, 1, 2, 3, 4, 5, 6, 7);
  f3 = __builtin_shufflevector(a3, b3, 0, 1, 2, 3, 4, 5, 6, 7);
}
template <int STRB, int OFF2B>
__device__ __forceinline__ void tr_dual(const bf* pp, bf16x8& f0, bf16x8& f1) {
  typedef short s16x4_ __attribute__((ext_vector_type(4)));
  s16x4_ a0, b0, a1, b1;
  unsigned addr = (unsigned)(size_t)(__attribute__((address_space(3))) const void*)pp;
  asm volatile(
      "s_waitcnt lgkmcnt(0)\n\t"
      "ds_read_b64_tr_b16 %0, %4\n\t"
      "ds_read_b64_tr_b16 %1, %4 offset:%5\n\t"
      "ds_read_b64_tr_b16 %2, %4 offset:%6\n\t"
      "ds_read_b64_tr_b16 %3, %4 offset:%7\n\t"
      "s_waitcnt lgkmcnt(0)"
      : "=&v"(a0), "=&v"(b0), "=&v"(a1), "=&v"(b1)
      : "v"(addr), "n"(OFF2B), "n"(STRB), "n"(STRB + OFF2B)
      : "memory");
  f0 = __builtin_shufflevector(a0, b0, 0, 1, 2, 3, 4, 5, 6, 7);
  f1 = __builtin_shufflevector(a1, b1, 0, 1, 2, 3, 4, 5, 6, 7);
}
__device__ __forceinline__ const bf* trbase(const bf* img, int ld, int r0, int c0, int lane) { return img + (r0 + ((lane & 15) >> 2)) * ld + c0 + (lane & 3) * 4; }
typedef short s16x4 __attribute__((ext_vector_type(4)));
__device__ __forceinline__ void attn_unit(const P& p, int u, char* smem, float lam) {
  bf* Ks = (bf*)smem;
  bf* Vs = Ks + 64 * 136;
  int b, h, nkeys, qa0;
  if (u < 1024) { b = u >> 7; h = (u >> 5) & 3; nkeys = TA; qa0 = CTX + (u & 31) * 128; }
  else { int v = u - 1024; b = v >> 3; h = (v >> 1) & 3; nkeys = CTX; qa0 = (v & 1) * 128; }
  const bf* QKV = (const bf*)(p.ws + OFF_QKV);
  const int tid = tidx(), lane = tid & 63, wave = tid >> 6;
  const int l15 = lane & 15, lg = lane >> 4;
  const size_t rowbase = (size_t)b * TA;
  bf16x8 qf[2][2];
  {
    size_t Rq = rowbase + qa0 + wave * 16 + l15;
#pragma unroll
    for (int m = 0; m < 2; ++m)
#pragma unroll
      for (int ks = 0; ks < 2; ++ks) qf[m][ks] = *(const bf16x8*)(QKV + Rq * 1536 + h * 128 + m * 64 + ks * 32 + lg * 8);
  }
  f32x4 oacc[2][8];
#pragma unroll
  for (int m = 0; m < 2; ++m)
#pragma unroll
    for (int n = 0; n < 8; ++n) oacc[m][n] = (f32x4){0.f, 0.f, 0.f, 0.f};
  float mrun[2] = {-INFINITY, -INFINITY}, lrun[2] = {0.f, 0.f};
  const int sr = tid >> 4, scc = tid & 15;
  const bf* gsrc = QKV + (rowbase + sr) * 1536 + h * 128 + scc * 8;
  uint4 pk0 = *(const uint4*)(gsrc + 512), pv0 = *(const uint4*)(gsrc + 1024);
  uint4 pk1 = *(const uint4*)(gsrc + (size_t)32 * 1536 + 512), pv1 = *(const uint4*)(gsrc + (size_t)32 * 1536 + 1024);
  const int vrow = lg * 4 + (l15 >> 2), vcol = (lane & 3) * 4;
  for (int k0 = 0; k0 < nkeys; k0 += 64) {
    __syncthreads();
    *(uint4*)(Ks + sr * 136 + scc * 8) = pk0;
    *(uint4*)(Ks + (sr + 32) * 136 + scc * 8) = pk1;
    *(uint4*)(Vs + sr * 144 + scc * 8) = pv0;
    *(uint4*)(Vs + (sr + 32) * 144 + scc * 8) = pv1;
    __syncthreads();
    if (k0 + 64 < nkeys) {
      const bf* g2 = gsrc + (size_t)(k0 + 64) * 1536;
      pk0 = *(const uint4*)(g2 + 512); pv0 = *(const uint4*)(g2 + 1024);
      pk1 = *(const uint4*)(g2 + (size_t)32 * 1536 + 512); pv1 = *(const uint4*)(g2 + (size_t)32 * 1536 + 1024);
    }
    bf16x8 pf[2][2];
#pragma unroll
    for (int m = 0; m < 2; ++m) {
      f32x4 s[4];
#pragma unroll
      for (int kt = 0; kt < 4; ++kt) s[kt] = (f32x4){0.f, 0.f, 0.f, 0.f};
#pragma unroll
      for (int ks = 0; ks < 2; ++ks)
#pragma unroll
        for (int kt = 0; kt < 4; ++kt) {
          bf16x8 a = *(const bf16x8*)(Ks + (kt * 16 + l15) * 136 + m * 64 + ks * 32 + lg * 8);
          s[kt] = __builtin_amdgcn_mfma_f32_16x16x32_bf16(a, qf[m][ks], s[kt], 0, 0, 0);
        }
      float mx = fmaxf(fmaxf(s[0][0], s[0][1]), fmaxf(s[0][2], s[0][3]));
#pragma unroll
      for (int kt = 1; kt < 4; ++kt) mx = fmaxf(mx, fmaxf(fmaxf(s[kt][0], s[kt][1]), fmaxf(s[kt][2], s[kt][3])));
      if (__any(mx > mrun[m] + 8.f)) {
        mx = fmaxf(mx, __shfl_xor(mx, 16));
        mx = fmaxf(mx, __shfl_xor(mx, 32));
        float mnew = fmaxf(mrun[m], mx);
        float alpha = __expf(mrun[m] - mnew);
        mrun[m] = mnew;
        lrun[m] *= alpha;
        float al[4];
#pragma unroll
        for (int r = 0; r < 4; ++r) al[r] = __shfl(alpha, lg * 4 + r);
#pragma unroll
        for (int n = 0; n < 8; ++n)
#pragma unroll
          for (int r = 0; r < 4; ++r) oacc[m][n][r] *= al[r];
      }
      const float mcur = mrun[m];
      float ps = 0.f;
#pragma unroll
      for (int kt = 0; kt < 4; ++kt)
#pragma unroll
        for (int r = 0; r < 4; ++r) {
          float e = __expf(s[kt][r] - mcur);
          s[kt][r] = e;
          ps += e;
        }
      lrun[m] += ps;
#pragma unroll
      for (int si = 0; si < 2; ++si) {
        i32x4 t;
        t[0] = (int)pack2(s[2 * si][0], s[2 * si][1]);
        t[1] = (int)pack2(s[2 * si][2], s[2 * si][3]);
        t[2] = (int)pack2(s[2 * si + 1][0], s[2 * si + 1][1]);
        t[3] = (int)pack2(s[2 * si + 1][2], s[2 * si + 1][3]);
        pf[m][si] = __builtin_bit_cast(bf16x8, t);
      }
    }
#pragma unroll
    for (int si = 0; si < 2; ++si)
#pragma unroll
      for (int nq = 0; nq < 2; ++nq) {
        bf16x8 bv[4];
        tr_quad<32, 16 * 144 * 2>(Vs + (si * 32 + vrow) * 144 + nq * 64 + vcol, bv[0], bv[1], bv[2], bv[3]);
#pragma unroll
        for (int n4 = 0; n4 < 4; ++n4) {
          oacc[0][nq * 4 + n4] = __builtin_amdgcn_mfma_f32_16x16x32_bf16(pf[0][si], bv[n4], oacc[0][nq * 4 + n4], 0, 0, 0);
          oacc[1][nq * 4 + n4] = __builtin_amdgcn_mfma_f32_16x16x32_bf16(pf[1][si], bv[n4], oacc[1][nq * 4 + n4], 0, 0, 0);
        }
      }
  }
  float inv[2];
#pragma unroll
  for (int m = 0; m < 2; ++m) {
    float l = lrun[m];
    l += __shfl_xor(l, 16);
    l += __shfl_xor(l, 32);
    inv[m] = 1.f / l;
  }
  float i1[4], i2[4];
#pragma unroll
  for (int r = 0; r < 4; ++r) { i1[r] = __shfl(inv[0], lg * 4 + r); i2[r] = __shfl(inv[1], lg * 4 + r); }
  float ss[4] = {0.f, 0.f, 0.f, 0.f};
#pragma unroll
  for (int n = 0; n < 8; ++n)
#pragma unroll
    for (int r = 0; r < 4; ++r) {
      float o = oacc[0][n][r] * i1[r] - lam * (oacc[1][n][r] * i2[r]);
      oacc[0][n][r] = o;
      ss[r] += o * o;
    }
  const float* subln = p.in[16];
  bf* O = (bf*)(p.ws + OFF_HO);
#pragma unroll
  for (int r = 0; r < 4; ++r) {
    float t = red16(ss[r]);
    float scl = rsqrtf(t * (1.f / 128.f) + 1e-5f) * 0.8f;
    size_t Ro = rowbase + qa0 + wave * 16 + lg * 4 + r;
#pragma unroll
    for (int n = 0; n < 8; ++n) O[Ro * 1024 + h * 128 + n * 16 + l15] = f2bf(oacc[0][n][r] * scl * subln[n * 16 + l15]);
  }
}

__device__ __forceinline__ void rwkv_chain2(const P& p, int chain, char* smem);
__device__ __forceinline__ void ph_mix0(const P& p, char* smem) {
  volatile int* s_unitp = (volatile int*)(smem + 131072);
  for (int u = blockIdx.x; u < 128; u += gridDim.x) rwkv_chain2(p, u, smem);
#ifdef PROBE_RWKV
  __syncthreads();
  for (int u = blockIdx.x; u < 256; u += gridDim.x) rwkv_chain(p, u & 127, u >> 7, smem);
#endif
  float d1 = 0.f, d2 = 0.f;
  for (int i = 0; i < 64; ++i) { d1 += p.in[12][i] * p.in[13][i]; d2 += p.in[14][i] * p.in[15][i]; }
  float lam = expf(d1) - expf(d2) + 0.2f;
  int* cnt = (int*)(p.ws + OFF_CNT);
  while (true) {
    __syncthreads();
    if (tidx() == 0) *s_unitp = atomicAdd(cnt, 1);
    __syncthreads();
    int u = *s_unitp;
    if (u >= 1088) break;
    attn_unit(p, u, smem, lam);
  }
#ifdef PROBE_ATTN
  while (true) {
    __syncthreads();
    if (tidx() == 0) *s_unitp = atomicAdd(cnt + 1, 1);
    __syncthreads();
    int u = *s_unitp;
    if (u >= 1088) break;
    attn_unit(p, u, smem, lam);
  }
#endif
}

__device__ __forceinline__ void ph_rwkv_post(const P& p) {
  const int tid = tidx(), wave = tid >> 6;
  const bf* YF = (const bf*)p.out;
  const bf* YB = YF + (size_t)RT * 512;
  const bf* PV = (const bf*)(p.ws + OFF_PREP) + (size_t)2 * RT * 512;
  const bf* G = (const bf*)(p.ws + OFF_G);
  const float* BON = (const float*)(p.ws + OFF_BONUS);
  bf* O = (bf*)(p.ws + OFF_HO);
  const float lw = p.in[28][tid], lb = p.in[29][tid];
  for (int R0 = blockIdx.x * 4; R0 < RT; R0 += gridDim.x * 4) {
    float yf[4], yb4[4], pv[4], gg[4], bn[4];
#pragma unroll
    for (int i = 0; i < 4; ++i) {
      size_t o = (size_t)(R0 + i) * 512 + tid;
      yf[i] = bf2f(YF[o]); yb4[i] = bf2f(YB[o]); pv[i] = bf2f(PV[o]); gg[i] = bf2f(G[o]); bn[i] = BON[(size_t)(R0 + i) * 8 + wave];
    }
#pragma unroll
    for (int i = 0; i < 4; ++i) {
      float y = yf[i] + yb4[i];
      float mean = wave_sum(y) * (1.f / 64.f);
      float d = y - mean;
      float var = wave_sum(d * d) * (1.f / 64.f);
      float yn = d * rsqrtf(var + 64e-5f) * lw + lb;
      float outv = (yn + bn[i] * pv[i]) * gg[i];
      O[(size_t)(R0 + i) * 1024 + 512 + tid] = f2bf(outv);
    }
  }
}

__device__ __forceinline__ void ph_conv(const P& p) {
  const bf* XR = (const bf*)(p.ws + OFF_XRAW);
  bf* XO = (bf*)(p.ws + OFF_XBC);
  const float* cw = p.in[38];
  const float* cb = p.in[39];
  for (size_t it = (size_t)blockIdx.x * NT + tidx(); it < (size_t)RT * 128; it += (size_t)gridDim.x * NT) {
    int R = (int)(it >> 7), c8 = (int)(it & 127) * 8;
    int b = R / TA, a = R - b * TA;
    int lo = a < CTX ? 0 : CTX, hi = a < CTX ? CTX : TA;
    float acc[8];
#pragma unroll
    for (int e = 0; e < 8; ++e) acc[e] = cb[c8 + e];
#pragma unroll
    for (int j = 0; j < 5; ++j) {
      int aj = a + j - 2;
      if (aj >= lo && aj < hi) {
        uint4 v = *(const uint4*)(XR + (size_t)(R + j - 2) * 1024 + c8);
        const float* w = cw + j * 1024 + c8;
        acc[0] += w[0] * bflo(v.x); acc[1] += w[1] * bfhi(v.x);
        acc[2] += w[2] * bflo(v.y); acc[3] += w[3] * bfhi(v.y);
        acc[4] += w[4] * bflo(v.z); acc[5] += w[5] * bfhi(v.z);
        acc[6] += w[6] * bflo(v.w); acc[7] += w[7] * bfhi(v.w);
      }
    }
    uint4 o;
    o.x = pack2(siluf_(acc[0]), siluf_(acc[1]));
    o.y = pack2(siluf_(acc[2]), siluf_(acc[3]));
    o.z = pack2(siluf_(acc[4]), siluf_(acc[5]));
    o.w = pack2(siluf_(acc[6]), siluf_(acc[7]));
    *(uint4*)(XO + (size_t)R * 1024 + c8) = o;
  }
}

__device__ __forceinline__ void ssd_chain(const P& p, int chain, char* smem) {
  const int dir = chain & 1, hh = (chain >> 1) & 7, b = chain >> 4;
  const int grp = hh >> 2;
  float* cB = (float*)smem;
  float* cC = cB + 4096;
  float* cX = cC + 4096;
  float* cDA = cX + 2048;
  float* yb = cDA + 32;
  const int tid = tidx(), lane = tid & 63, wave = tid >> 6;
  const int l15 = lane & 15, lg = lane >> 4;
  const bf* XBC = (const bf*)(p.ws + OFF_XBC);
  const float* DTR = (const float*)(p.ws + OFF_DTRAW);
  bf* Y = (bf*)(p.ws + OFF_XRAW) + (size_t)dir * RT * 512;
  const float dtb = p.in[dir ? 42 : 40][hh];
  const float Aneg = -expf(p.in[dir ? 43 : 41][hh]);
  const int st = tid >> 4, q = tid & 15;
  const int r0 = wave * 8 + lg * 2;
  float s0[8], s1[8];
#pragma unroll
  for (int j = 0; j < 8; ++j) { s0[j] = 0.f; s1[j] = 0.f; }
  uint4 gB, gC;
  uint2 gX;
  float gD;
  {
    size_t R = (size_t)scan_row(b, dir, st);
    gB = *(const uint4*)(XBC + R * 1024 + 512 + grp * 128 + q * 8);
    gC = *(const uint4*)(XBC + R * 1024 + 768 + grp * 128 + q * 8);
    gX = *(const uint2*)(XBC + R * 1024 + hh * 64 + q * 4);
    gD = DTR[R * 16 + dir * 8 + hh];
  }
  const int NCH = TA / 32;
  for (int ch = 0; ch <= NCH; ++ch) {
    __syncthreads();
    if (ch > 0) {
      float4 y4 = *(const float4*)(yb + st * 64 + q * 4);
      uint2 o2;
      o2.x = pack2(y4.x, y4.y);
      o2.y = pack2(y4.z, y4.w);
      *(uint2*)(Y + (size_t)scan_row(b, dir, (ch - 1) * 32 + st) * 512 + hh * 64 + q * 4) = o2;
    }
    if (ch == NCH) break;
    {
      float dt = softplusf_(gD + dtb);
      float dA = expf(dt * Aneg);
      float* d = cB + st * 128 + q * 8;
      *(float4*)d = make_float4(bflo(gB.x), bfhi(gB.x), bflo(gB.y), bfhi(gB.y));
      *(float4*)(d + 4) = make_float4(bflo(gB.z), bfhi(gB.z), bflo(gB.w), bfhi(gB.w));
      d = cC + st * 128 + q * 8;
      *(float4*)d = make_float4(bflo(gC.x), bfhi(gC.x), bflo(gC.y), bfhi(gC.y));
      *(float4*)(d + 4) = make_float4(bflo(gC.z), bfhi(gC.z), bflo(gC.w), bfhi(gC.w));
      *(float4*)(cX + st * 64 + q * 4) = make_float4(bflo(gX.x) * dt, bfhi(gX.x) * dt, bflo(gX.y) * dt, bfhi(gX.y) * dt);
      if (q == 0) cDA[st] = dA;
    }
    __syncthreads();
    if (ch + 1 < NCH) {
      size_t R = (size_t)scan_row(b, dir, (ch + 1) * 32 + st);
      gB = *(const uint4*)(XBC + R * 1024 + 512 + grp * 128 + q * 8);
      gC = *(const uint4*)(XBC + R * 1024 + 768 + grp * 128 + q * 8);
      gX = *(const uint2*)(XBC + R * 1024 + hh * 64 + q * 4);
      gD = DTR[R * 16 + dir * 8 + hh];
    }
#pragma unroll 4
    for (int t = 0; t < 32; ++t) {
      float4 b0 = *(const float4*)(cB + t * 128 + l15 * 8);
      float4 b1 = *(const float4*)(cB + t * 128 + l15 * 8 + 4);
      float4 c0 = *(const float4*)(cC + t * 128 + l15 * 8);
      float4 c1 = *(const float4*)(cC + t * 128 + l15 * 8 + 4);
      float2 x2 = *(const float2*)(cX + t * 64 + r0);
      float dA = cDA[t];
      s0[0] = s0[0] * dA + x2.x * b0.x; s0[1] = s0[1] * dA + x2.x * b0.y; s0[2] = s0[2] * dA + x2.x * b0.z; s0[3] = s0[3] * dA + x2.x * b0.w;
      s0[4] = s0[4] * dA + x2.x * b1.x; s0[5] = s0[5] * dA + x2.x * b1.y; s0[6] = s0[6] * dA + x2.x * b1.z; s0[7] = s0[7] * dA + x2.x * b1.w;
      s1[0] = s1[0] * dA + x2.y * b0.x; s1[1] = s1[1] * dA + x2.y * b0.y; s1[2] = s1[2] * dA + x2.y * b0.z; s1[3] = s1[3] * dA + x2.y * b0.w;
      s1[4] = s1[4] * dA + x2.y * b1.x; s1[5] = s1[5] * dA + x2.y * b1.y; s1[6] = s1[6] * dA + x2.y * b1.z; s1[7] = s1[7] * dA + x2.y * b1.w;
      float y0 = s0[0] * c0.x + s0[1] * c0.y + s0[2] * c0.z + s0[3] * c0.w + s0[4] * c1.x + s0[5] * c1.y + s0[6] * c1.z + s0[7] * c1.w;
      float y1 = s1[0] * c0.x + s1[1] * c0.y + s1[2] * c0.z + s1[3] * c0.w + s1[4] * c1.x + s1[5] * c1.y + s1[6] * c1.z + s1[7] * c1.w;
      y0 = red16(y0);
      y1 = red16(y1);
      if (l15 == 0) *(float2*)(yb + t * 64 + r0) = make_float2(y0, y1);
    }
  }
}

__device__ __forceinline__ void gla_chain(const P& p, int chain, char* smem) {
  const int dir = chain & 1, h = (chain >> 1) & 3, b = chain >> 3;
  float* cQ = (float*)smem;
  float* cK = cQ + 2048;
  float* cD = cK + 2048;
  float* cV = cD + 2048;
  float* yb = cV + 4096;
  float* up = yb + 4096;
  float* gbias = up + 1024;
  const int tid = tidx(), lane = tid & 63, wave = tid >> 6;
  const int l15 = lane & 15, lg = lane >> 4;
  const bf* P1 = (const bf*)(p.ws + OFF_P1C);
  bf* Y = (bf*)(p.ws + OFF_GY) + (size_t)dir * RT * 512;
  const float* gup = p.in[dir ? 48 : 46];
  const float* gb = p.in[dir ? 49 : 47];
  __syncthreads();
  for (int i = tid; i < 1024; i += NT) up[i] = gup[(i >> 6) * 256 + h * 64 + (i & 63)];
  if (tid < 64) gbias[tid] = gb[h * 64 + tid];
  const int st = tid >> 4, q = tid & 15;
  const int r0 = wave * 16 + lg * 4;
  float s[4][4];
#pragma unroll
  for (int r = 0; r < 4; ++r)
#pragma unroll
    for (int j = 0; j < 4; ++j) s[r][j] = 0.f;
  uint2 gQ, gK;
  uint4 gV, gG0, gG1;
  {
    const bf* row = P1 + (size_t)scan_row(b, dir, st) * 2080;
    gQ = *(const uint2*)(row + 528 + h * 64 + q * 4);
    gK = *(const uint2*)(row + 784 + h * 64 + q * 4);
    gV = *(const uint4*)(row + 1040 + h * 128 + q * 8);
    gG0 = *(const uint4*)(row + 2064);
    gG1 = *(const uint4*)(row + 2072);
  }
  const int NCH = TA / 32;
  for (int ch = 0; ch <= NCH; ++ch) {
    __syncthreads();
    if (ch > 0) {
      float4 ya = *(const float4*)(yb + st * 128 + q * 8);
      float4 yc = *(const float4*)(yb + st * 128 + q * 8 + 4);
      uint4 o4;
      o4.x = pack2(ya.x, ya.y); o4.y = pack2(ya.z, ya.w); o4.z = pack2(yc.x, yc.y); o4.w = pack2(yc.z, yc.w);
      *(uint4*)(Y + (size_t)scan_row(b, dir, (ch - 1) * 32 + st) * 512 + h * 128 + q * 8) = o4;
    }
    if (ch == NCH) break;
    {
      float gd[16];
      gd[0] = bflo(gG0.x); gd[1] = bfhi(gG0.x); gd[2] = bflo(gG0.y); gd[3] = bfhi(gG0.y);
      gd[4] = bflo(gG0.z); gd[5] = bfhi(gG0.z); gd[6] = bflo(gG0.w); gd[7] = bfhi(gG0.w);
      gd[8] = bflo(gG1.x); gd[9] = bfhi(gG1.x); gd[10] = bflo(gG1.y); gd[11] = bfhi(gG1.y);
      gd[12] = bflo(gG1.z); gd[13] = bfhi(gG1.z); gd[14] = bflo(gG1.w); gd[15] = bfhi(gG1.w);
      float4 z = *(const float4*)(gbias + q * 4);
#pragma unroll
      for (int i = 0; i < 16; ++i) {
        float4 u4 = *(const float4*)(up + i * 64 + q * 4);
        z.x += gd[i] * u4.x; z.y += gd[i] * u4.y; z.z += gd[i] * u4.z; z.w += gd[i] * u4.w;
      }
      float4 dd;
      dd.x = expf(-softplusf_(-z.x) * (1.f / 16.f));
      dd.y = expf(-softplusf_(-z.y) * (1.f / 16.f));
      dd.z = expf(-softplusf_(-z.z) * (1.f / 16.f));
      dd.w = expf(-softplusf_(-z.w) * (1.f / 16.f));
      *(float4*)(cD + st * 64 + q * 4) = dd;
      *(float4*)(cQ + st * 64 + q * 4) = make_float4(bflo(gQ.x) * 0.125f, bfhi(gQ.x) * 0.125f, bflo(gQ.y) * 0.125f, bfhi(gQ.y) * 0.125f);
      *(float4*)(cK + st * 64 + q * 4) = make_float4(bflo(gK.x), bfhi(gK.x), bflo(gK.y), bfhi(gK.y));
      float* d = cV + st * 128 + q * 8;
      *(float4*)d = make_float4(bflo(gV.x), bfhi(gV.x), bflo(gV.y), bfhi(gV.y));
      *(float4*)(d + 4) = make_float4(bflo(gV.z), bfhi(gV.z), bflo(gV.w), bfhi(gV.w));
    }
    __syncthreads();
    if (ch + 1 < NCH) {
      const bf* row = P1 + (size_t)scan_row(b, dir, (ch + 1) * 32 + st) * 2080;
      gQ = *(const uint2*)(row + 528 + h * 64 + q * 4);
      gK = *(const uint2*)(row + 784 + h * 64 + q * 4);
      gV = *(const uint4*)(row + 1040 + h * 128 + q * 8);
      gG0 = *(const uint4*)(row + 2064);
      gG1 = *(const uint4*)(row + 2072);
    }
#pragma unroll 4
    for (int t = 0; t < 32; ++t) {
      float4 q4 = *(const float4*)(cQ + t * 64 + l15 * 4);
      float4 k4 = *(const float4*)(cK + t * 64 + l15 * 4);
      float4 d4 = *(const float4*)(cD + t * 64 + l15 * 4);
      float4 v4 = *(const float4*)(cV + t * 128 + r0);
      float vv[4] = {v4.x, v4.y, v4.z, v4.w};
      float yy[4];
#pragma unroll
      for (int r = 0; r < 4; ++r) {
        s[r][0] = s[r][0] * d4.x + k4.x * vv[r];
        s[r][1] = s[r][1] * d4.y + k4.y * vv[r];
        s[r][2] = s[r][2] * d4.z + k4.z * vv[r];
        s[r][3] = s[r][3] * d4.w + k4.w * vv[r];
        yy[r] = red16(s[r][0] * q4.x + s[r][1] * q4.y + s[r][2] * q4.z + s[r][3] * q4.w);
      }
      if (l15 == 0) *(float4*)(yb + t * 128 + r0) = make_float4(yy[0], yy[1], yy[2], yy[3]);
    }
  }
}

typedef __attribute__((address_space(3))) s16x4* lds_s16x4p;
template <int LD>
__device__ __forceinline__ bf16x8 trfrag_t(const bf* img, int r0, int c0, int lane) {
  const bf* pp = img + (r0 + ((lane & 15) >> 2)) * LD + c0 + (lane & 3) * 4;
  return tr_pair<4 * LD * 2>(pp);
}
#define trfrag(img, ld, r0, c0, lane) trfrag_t<ld>(img, r0, c0, lane)
__device__ __forceinline__ bf16x8 pack8(f32x4 a, f32x4 b) {
  i32x4 t;
  t[0] = (int)pack2(a[0], a[1]); t[1] = (int)pack2(a[2], a[3]); t[2] = (int)pack2(b[0], b[1]); t[3] = (int)pack2(b[2], b[3]);
  return __builtin_bit_cast(bf16x8, t);
}
__device__ __forceinline__ bf16x8 ld2x64(const bf* p0, const bf* p1) {
  uint2 a = *(const uint2*)p0, b2 = *(const uint2*)p1;
  i32x4 t;
  t[0] = (int)a.x; t[1] = (int)a.y; t[2] = (int)b2.x; t[3] = (int)b2.y;
  return __builtin_bit_cast(bf16x8, t);
}

__device__ __forceinline__ void gla_chain2(const P& p, int chain, char* smem) {
  const int dir = chain & 1, h = (chain >> 1) & 3, b = chain >> 3;
  bf* Qs = (bf*)smem;
  bf* Ks = Qs + 64 * 72;
  bf* Vs = Ks + 64 * 72;
  bf* Ps = Vs + 64 * 144;
  bf* GD = Ps + 64 * 72;
  float* segtot = (float*)(GD + 64 * 16);
  float* dS = segtot + 512;
  const int tid = tidx(), lane = tid & 63, wave = tid >> 6;
  const int l15 = lane & 15, g = lane >> 4;
  const bf* P1 = (const bf*)(p.ws + OFF_P1C);
  bf* Y = (bf*)(p.ws + OFF_GY) + (size_t)dir * RT * 512;
  const float* gup = p.in[dir ? 48 : 46];
  const float* gb = p.in[dir ? 49 : 47];
  const int kc = tid & 63, seg = tid >> 6;
  float upr[16];
#pragma unroll
  for (int r = 0; r < 16; ++r) upr[r] = gup[r * 256 + h * 64 + kc];
  const float bk = gb[h * 64 + kc];
  const int stok = tid >> 3, sc8 = (tid & 7) * 8;
  f32x4 S[4];
#pragma unroll
  for (int kt = 0; kt < 4; ++kt) S[kt] = (f32x4){0.f, 0.f, 0.f, 0.f};
  uint4 rq, rk, rv0, rv1, rg = make_uint4(0, 0, 0, 0);
  {
    const bf* row = P1 + (size_t)scan_row(b, dir, stok) * 2080;
    rq = *(const uint4*)(row + 528 + h * 64 + sc8);
    rk = *(const uint4*)(row + 784 + h * 64 + sc8);
    rv0 = *(const uint4*)(row + 1040 + h * 128 + sc8 * 2);
    rv1 = *(const uint4*)(row + 1040 + h * 128 + sc8 * 2 + 8);
    if (tid < 128) rg = *(const uint4*)(P1 + (size_t)scan_row(b, dir, tid >> 1) * 2080 + 2064 + (tid & 1) * 8);
  }
  const int NCH = TA / 64;
  for (int c = 0; c < NCH; ++c) {
    __syncthreads();
    *(uint4*)(Qs + stok * 72 + sc8) = rq;
    *(uint4*)(Ks + stok * 72 + sc8) = rk;
    *(uint4*)(Vs + stok * 144 + sc8 * 2) = rv0;
    *(uint4*)(Vs + stok * 144 + sc8 * 2 + 8) = rv1;
    if (tid < 128) *(uint4*)(GD + (tid >> 1) * 16 + (tid & 1) * 8) = rg;
    __syncthreads();
    if (c + 1 < NCH) {
      const bf* row = P1 + (size_t)scan_row(b, dir, (c + 1) * 64 + stok) * 2080;
      rq = *(const uint4*)(row + 528 + h * 64 + sc8);
      rk = *(const uint4*)(row + 784 + h * 64 + sc8);
      rv0 = *(const uint4*)(row + 1040 + h * 128 + sc8 * 2);
      rv1 = *(const uint4*)(row + 1040 + h * 128 + sc8 * 2 + 8);
      if (tid < 128) rg = *(const uint4*)(P1 + (size_t)scan_row(b, dir, (c + 1) * 64 + (tid >> 1)) * 2080 + 2064 + (tid & 1) * 8);
    }
    float lc[8];
    {
      float run = 0.f;
#pragma unroll
      for (int ii = 0; ii < 8; ++ii) {
        const bf* gr = GD + (seg * 8 + ii) * 16;
        uint4 g0 = *(const uint4*)gr, g1 = *(const uint4*)(gr + 8);
        float z = bk;
        z += bflo(g0.x) * upr[0] + bfhi(g0.x) * upr[1] + bflo(g0.y) * upr[2] + bfhi(g0.y) * upr[3];
        z += bflo(g0.z) * upr[4] + bfhi(g0.z) * upr[5] + bflo(g0.w) * upr[6] + bfhi(g0.w) * upr[7];
        z += bflo(g1.x) * upr[8] + bfhi(g1.x) * upr[9] + bflo(g1.y) * upr[10] + bfhi(g1.y) * upr[11];
        z += bflo(g1.z) * upr[12] + bfhi(g1.z) * upr[13] + bflo(g1.w) * upr[14] + bfhi(g1.w) * upr[15];
        run += -softplusf_(-z) * (1.f / 16.f);
        lc[ii] = run;
      }
      segtot[seg * 64 + kc] = run;
    }
    __syncthreads();
    {
      float off = 0.f, tot = 0.f;
#pragma unroll
      for (int s2 = 0; s2 < 8; ++s2) {
        float t = segtot[s2 * 64 + kc];
        tot += t;
        off += (s2 < seg) ? t : 0.f;
      }
#pragma unroll
      for (int ii = 0; ii < 8; ++ii) {
        int i = seg * 8 + ii;
        float cum = off + lc[ii];
        float qv = bf2f(Qs[i * 72 + kc]), kv = bf2f(Ks[i * 72 + kc]);
        float eq = __expf(cum - tot);
        Qs[i * 72 + kc] = f2bf(qv * 0.125f * eq);
        Ks[i * 72 + kc] = f2bf(kv * __builtin_amdgcn_rcpf(eq));
      }
      if (seg == 0) dS[kc] = __expf(tot);
    }
    __syncthreads();
#pragma unroll
    for (int kt = 0; kt < 4; ++kt) {
      float4 d4 = *(const float4*)(dS + kt * 16 + g * 4);
      S[kt][0] *= d4.x; S[kt][1] *= d4.y; S[kt][2] *= d4.z; S[kt][3] *= d4.w;
    }
#pragma unroll
    for (int tt = 0; tt < 2; ++tt) {
      int idx = wave * 2 + tt, jt = idx >> 2, it = idx & 3;
      f32x4 acc = (f32x4){0.f, 0.f, 0.f, 0.f};
      if (jt <= it) {
#pragma unroll
        for (int ks = 0; ks < 2; ++ks) {
          bf16x8 a = *(const bf16x8*)(Ks + (jt * 16 + l15) * 72 + ks * 32 + g * 8);
          bf16x8 bq = *(const bf16x8*)(Qs + (it * 16 + l15) * 72 + ks * 32 + g * 8);
          acc = __builtin_amdgcn_mfma_f32_16x16x32_bf16(a, bq, acc, 0, 0, 0);
        }
        int i = it * 16 + l15;
#pragma unroll
        for (int r = 0; r < 4; ++r) { int j = jt * 16 + g * 4 + r; acc[r] = (j <= i) ? acc[r] : 0.f; }
      }
      uint2 o;
      o.x = pack2(acc[0], acc[1]);
      o.y = pack2(acc[2], acc[3]);
      *(uint2*)(Ps + (it * 16 + l15) * 72 + jt * 16 + g * 4) = o;
    }
    __syncthreads();
    f32x4 y[4];
#pragma unroll
    for (int it = 0; it < 4; ++it) y[it] = (f32x4){0.f, 0.f, 0.f, 0.f};
#pragma unroll
    for (int s2 = 0; s2 < 2; ++s2) {
      bf16x8 sf = pack8(S[2 * s2], S[2 * s2 + 1]);
#pragma unroll
      for (int it = 0; it < 4; ++it) {
        const bf* qr = Qs + (it * 16 + l15) * 72 + g * 4;
        bf16x8 aq = ld2x64(qr + (2 * s2) * 16, qr + (2 * s2 + 1) * 16);
        y[it] = __builtin_amdgcn_mfma_f32_16x16x32_bf16(aq, sf, y[it], 0, 0, 0);
      }
    }
    {
      bf16x8 vfs[2];
      tr_dual<32 * 144 * 2, 4 * 144 * 2>(trbase(Vs, 144, g * 8, wave * 16, lane), vfs[0], vfs[1]);
#pragma unroll
      for (int s2 = 0; s2 < 2; ++s2) {
#pragma unroll
        for (int it = 0; it < 4; ++it) {
          bf16x8 ap = *(const bf16x8*)(Ps + (it * 16 + l15) * 72 + s2 * 32 + g * 8);
          y[it] = __builtin_amdgcn_mfma_f32_16x16x32_bf16(ap, vfs[s2], y[it], 0, 0, 0);
        }
        bf16x8 ak[4];
        tr_quad<32, 4 * 72 * 2>(trbase(Ks, 72, s2 * 32 + g * 8, 0, lane), ak[0], ak[1], ak[2], ak[3]);
#pragma unroll
        for (int kt = 0; kt < 4; ++kt) S[kt] = __builtin_amdgcn_mfma_f32_16x16x32_bf16(ak[kt], vfs[s2], S[kt], 0, 0, 0);
      }
    }
#pragma unroll
    for (int it = 0; it < 4; ++it)
#pragma unroll
      for (int r = 0; r < 4; ++r) {
        int i = it * 16 + g * 4 + r;
        Y[(size_t)scan_row(b, dir, c * 64 + i) * 512 + h * 128 + wave * 16 + l15] = f2bf(y[it][r]);
      }
  }
}

__device__ __forceinline__ void ssd_chain2(const P& p, int chain, char* smem) {
  const int dir = chain & 1, hh = (chain >> 1) & 7, b = chain >> 4;
  const int grp = hh >> 2;
  bf* Cs = (bf*)smem;
  bf* Bs = Cs + 64 * 136;
  bf* Xs = Bs + 64 * 136;
  bf* Xw = Xs + 64 * 72;
  bf* Ps = Xw + 64 * 72;
  float* dtS = (float*)(Ps + 64 * 72);
  float* cumS = dtS + 64;
  float* ecS = cumS + 64;
  float* totS = ecS + 64;
  const int tid = tidx(), lane = tid & 63, wave = tid >> 6;
  const int l15 = lane & 15, g = lane >> 4;
  const int vt = wave & 3, ih = wave >> 2;
  const bf* XBC = (const bf*)(p.ws + OFF_XBC);
  const float* DTR = (const float*)(p.ws + OFF_DTRAW);
  bf* Y = (bf*)(p.ws + OFF_XRAW) + (size_t)dir * RT * 512;
  const float dtb = p.in[dir ? 42 : 40][hh];
  const float Aneg = -expf(p.in[dir ? 43 : 41][hh]);
  const int stok = tid >> 3, sc = tid & 7;
  f32x4 S[8];
#pragma unroll
  for (int nt = 0; nt < 8; ++nt) S[nt] = (f32x4){0.f, 0.f, 0.f, 0.f};
  uint4 rc0, rc1, rb0, rb1, rx;
  float rdt = 0.f;
  {
    const bf* row = XBC + (size_t)scan_row(b, dir, stok) * 1024;
    rb0 = *(const uint4*)(row + 512 + grp * 128 + sc * 16);
    rb1 = *(const uint4*)(row + 512 + grp * 128 + sc * 16 + 8);
    rc0 = *(const uint4*)(row + 768 + grp * 128 + sc * 16);
    rc1 = *(const uint4*)(row + 768 + grp * 128 + sc * 16 + 8);
    rx = *(const uint4*)(row + hh * 64 + sc * 8);
    if (tid < 64) rdt = DTR[(size_t)scan_row(b, dir, tid) * 16 + dir * 8 + hh];
  }
  const int NCH = TA / 64;
  for (int c = 0; c < NCH; ++c) {
    __syncthreads();
    *(uint4*)(Cs + stok * 136 + sc * 16) = rc0;
    *(uint4*)(Cs + stok * 136 + sc * 16 + 8) = rc1;
    *(uint4*)(Bs + stok * 136 + sc * 16) = rb0;
    *(uint4*)(Bs + stok * 136 + sc * 16 + 8) = rb1;
    if (tid < 64) {
      float dt = softplusf_(rdt + dtb);
      float cum = dt * Aneg;
#pragma unroll
      for (int o = 1; o < 64; o <<= 1) {
        float t = __shfl_up(cum, o);
        if (lane >= o) cum += t;
      }
      float tot = __shfl(cum, 63);
      dtS[lane] = dt;
      cumS[lane] = cum;
      ecS[lane] = __expf(cum);
      if (lane == 0) totS[0] = tot;
    }
    __syncthreads();
    const uint4 cx = rx;
    if (c + 1 < NCH) {
      const bf* row = XBC + (size_t)scan_row(b, dir, (c + 1) * 64 + stok) * 1024;
      rb0 = *(const uint4*)(row + 512 + grp * 128 + sc * 16);
      rb1 = *(const uint4*)(row + 512 + grp * 128 + sc * 16 + 8);
      rc0 = *(const uint4*)(row + 768 + grp * 128 + sc * 16);
      rc1 = *(const uint4*)(row + 768 + grp * 128 + sc * 16 + 8);
      rx = *(const uint4*)(row + hh * 64 + sc * 8);
      if (tid < 64) rdt = DTR[(size_t)scan_row(b, dir, (c + 1) * 64 + tid) * 16 + dir * 8 + hh];
    }
    const float tot = totS[0];
    {
      float dt = dtS[stok];
      float w = dt * __expf(tot - cumS[stok]);
      float x0 = bflo(cx.x), x1 = bfhi(cx.x), x2 = bflo(cx.y), x3 = bfhi(cx.y), x4 = bflo(cx.z), x5 = bfhi(cx.z), x6 = bflo(cx.w), x7 = bfhi(cx.w);
      uint4 o;
      o.x = pack2(x0 * dt, x1 * dt); o.y = pack2(x2 * dt, x3 * dt); o.z = pack2(x4 * dt, x5 * dt); o.w = pack2(x6 * dt, x7 * dt);
      *(uint4*)(Xs + stok * 72 + sc * 8) = o;
      o.x = pack2(x0 * w, x1 * w); o.y = pack2(x2 * w, x3 * w); o.z = pack2(x4 * w, x5 * w); o.w = pack2(x6 * w, x7 * w);
      *(uint4*)(Xw + stok * 72 + sc * 8) = o;
    }
#pragma unroll
    for (int tt = 0; tt < 2; ++tt) {
      int idx = wave * 2 + tt, jt = idx >> 2, it = idx & 3;
      f32x4 acc = (f32x4){0.f, 0.f, 0.f, 0.f};
      if (jt <= it) {
#pragma unroll
        for (int ks = 0; ks < 4; ++ks) {
          bf16x8 a = *(const bf16x8*)(Bs + (jt * 16 + l15) * 136 + ks * 32 + g * 8);
          bf16x8 bq = *(const bf16x8*)(Cs + (it * 16 + l15) * 136 + ks * 32 + g * 8);
          acc = __builtin_amdgcn_mfma_f32_16x16x32_bf16(a, bq, acc, 0, 0, 0);
        }
        int i = it * 16 + l15;
        float ci = cumS[i];
        float4 cj = *(const float4*)(cumS + jt * 16 + g * 4);
        int j0 = jt * 16 + g * 4;
        acc[0] = (j0 + 0 <= i) ? acc[0] * __expf(ci - cj.x) : 0.f;
        acc[1] = (j0 + 1 <= i) ? acc[1] * __expf(ci - cj.y) : 0.f;
        acc[2] = (j0 + 2 <= i) ? acc[2] * __expf(ci - cj.z) : 0.f;
        acc[3] = (j0 + 3 <= i) ? acc[3] * __expf(ci - cj.w) : 0.f;
      }
      uint2 o;
      o.x = pack2(acc[0], acc[1]);
      o.y = pack2(acc[2], acc[3]);
      *(uint2*)(Ps + (it * 16 + l15) * 72 + jt * 16 + g * 4) = o;
    }
    __syncthreads();
    f32x4 y[2];
    y[0] = (f32x4){0.f, 0.f, 0.f, 0.f};
    y[1] = (f32x4){0.f, 0.f, 0.f, 0.f};
#pragma unroll
    for (int s2 = 0; s2 < 4; ++s2) {
      bf16x8 sf = pack8(S[2 * s2], S[2 * s2 + 1]);
#pragma unroll
      for (int ii = 0; ii < 2; ++ii) {
        const bf* qr = Cs + ((ih * 2 + ii) * 16 + l15) * 136 + g * 4;
        bf16x8 aq = ld2x64(qr + (2 * s2) * 16, qr + (2 * s2 + 1) * 16);
        y[ii] = __builtin_amdgcn_mfma_f32_16x16x32_bf16(aq, sf, y[ii], 0, 0, 0);
      }
    }
    {
      float et = __expf(tot);
#pragma unroll
      for (int nt = 0; nt < 8; ++nt) { S[nt][0] *= et; S[nt][1] *= et; S[nt][2] *= et; S[nt][3] *= et; }
    }
#pragma unroll
    for (int ii = 0; ii < 2; ++ii) {
      float4 e4 = *(const float4*)(ecS + (ih * 2 + ii) * 16 + g * 4);
      y[ii][0] *= e4.x; y[ii][1] *= e4.y; y[ii][2] *= e4.z; y[ii][3] *= e4.w;
    }
    {
      bf16x8 xfs[2], xws[2];
      tr_dual<32 * 72 * 2, 4 * 72 * 2>(trbase(Xs, 72, g * 8, vt * 16, lane), xfs[0], xfs[1]);
      tr_dual<32 * 72 * 2, 4 * 72 * 2>(trbase(Xw, 72, g * 8, vt * 16, lane), xws[0], xws[1]);
#pragma unroll
      for (int s2 = 0; s2 < 2; ++s2) {
#pragma unroll
        for (int ii = 0; ii < 2; ++ii) {
          bf16x8 ap = *(const bf16x8*)(Ps + ((ih * 2 + ii) * 16 + l15) * 72 + s2 * 32 + g * 8);
          y[ii] = __builtin_amdgcn_mfma_f32_16x16x32_bf16(ap, xfs[s2], y[ii], 0, 0, 0);
        }
#pragma unroll
        for (int nq = 0; nq < 2; ++nq) {
          bf16x8 ab[4];
          tr_quad<32, 4 * 136 * 2>(trbase(Bs, 136, s2 * 32 + g * 8, nq * 64, lane), ab[0], ab[1], ab[2], ab[3]);
#pragma unroll
          for (int n4 = 0; n4 < 4; ++n4) S[nq * 4 + n4] = __builtin_amdgcn_mfma_f32_16x16x32_bf16(ab[n4], xws[s2], S[nq * 4 + n4], 0, 0, 0);
        }
      }
    }
#pragma unroll
    for (int ii = 0; ii < 2; ++ii)
#pragma unroll
      for (int r = 0; r < 4; ++r) {
        int i = (ih * 2 + ii) * 16 + g * 4 + r;
        Y[(size_t)scan_row(b, dir, c * 64 + i) * 512 + hh * 64 + vt * 16 + l15] = f2bf(y[ii][r]);
      }
  }
}

__device__ __forceinline__ void rwkv_chain2(const P& p, int chain, char* smem) {
  const int dir = chain & 1, h = (chain >> 1) & 7, b = chain >> 4;
  bf* KT = (bf*)smem;
  bf* RTi = KT + 4608;
  bf* KH = RTi + 4608;
  bf* BH = KH + 4608;
  bf* VV = BH + 4608;
  bf* MAkk = VV + 4608;
  bf* MBrk = MAkk + 4608;
  bf* MBrb = MBrk + 4608;
  bf* UN = MBrb + 4608;
  bf* LWs = UN + 4608;
  float* AKB = (float*)(LWs + 4608);
  float* RH = AKB + 64 * 68;
  float* segtot = RH + 64 * 68;
  float* dS = segtot + 512;
  const int tid = tidx(), lane = tid & 63, wave = tid >> 6;
  const int l15 = lane & 15, g = lane >> 4;
  const int vt = wave & 3, ih = wave >> 2;
  const bf* PR = (const bf*)(p.ws + OFF_PREP);
  const bf* PK = PR + (size_t)RT * 512;
  const bf* PV = PK + (size_t)RT * 512;
  const bf* PKK = PV + (size_t)RT * 512;
  const bf* PKA = PKK + (size_t)RT * 512;
  const bf* PLW = PKA + (size_t)RT * 512 + (size_t)dir * RT * 512;
  bf* Y = (bf*)p.out + (size_t)dir * RT * 512;
  const int kc = tid & 63, seg = tid >> 6;
  const int stok = tid >> 3, sc8 = (tid & 7) * 8;
  f32x4 T[4];
#pragma unroll
  for (int kt = 0; kt < 4; ++kt) T[kt] = (f32x4){0.f, 0.f, 0.f, 0.f};
  uint4 gR, gK, gV, gKK, gKA, gW;
  {
    size_t o = (size_t)scan_row(b, dir, stok) * 512 + h * 64 + sc8;
    gR = *(const uint4*)(PR + o); gK = *(const uint4*)(PK + o); gV = *(const uint4*)(PV + o);
    gKK = *(const uint4*)(PKK + o); gKA = *(const uint4*)(PKA + o); gW = *(const uint4*)(PLW + o);
  }
  const int NCH = TA / 64;
  for (int c = 0; c < NCH; ++c) {
    __syncthreads();
    *(uint4*)(RTi + stok * 72 + sc8) = gR;
    *(uint4*)(KH + stok * 72 + sc8) = gK;
    *(uint4*)(VV + stok * 72 + sc8) = gV;
    *(uint4*)(KT + stok * 72 + sc8) = gKK;
    *(uint4*)(BH + stok * 72 + sc8) = gKA;
    *(uint4*)(LWs + stok * 72 + sc8) = gW;
    __syncthreads();
    if (c + 1 < NCH) {
      size_t o = (size_t)scan_row(b, dir, (c + 1) * 64 + stok) * 512 + h * 64 + sc8;
      gR = *(const uint4*)(PR + o); gK = *(const uint4*)(PK + o); gV = *(const uint4*)(PV + o);
      gKK = *(const uint4*)(PKK + o); gKA = *(const uint4*)(PKA + o); gW = *(const uint4*)(PLW + o);
    }
    float lc[8];
    {
      float run = 0.f;
#pragma unroll
      for (int ii = 0; ii < 8; ++ii) {
        run += bf2f(LWs[(seg * 8 + ii) * 72 + kc]);
        lc[ii] = run;
      }
      segtot[seg * 64 + kc] = run;
    }
    __syncthreads();
    {
      float off = 0.f, tot = 0.f;
#pragma unroll
      for (int s2 = 0; s2 < 8; ++s2) {
        float t = segtot[s2 * 64 + kc];
        tot += t;
        off += (s2 < seg) ? t : 0.f;
      }
#pragma unroll
      for (int ii = 0; ii < 8; ++ii) {
        const int i = seg * 8 + ii;
        const float cum = off + lc[ii];
        const float cumx = off + (ii > 0 ? lc[ii > 0 ? ii - 1 : 0] : 0.f);
        const float eR = __expf(cum - tot);
        const float eK = __builtin_amdgcn_rcpf(eR);
        const float eX = __expf(cumx - tot);
        const int o = i * 72 + kc;
        RTi[o] = f2bf(bf2f(RTi[o]) * eR);
        KH[o] = f2bf(bf2f(KH[o]) * eK);
        BH[o] = f2bf(bf2f(BH[o]) * eK);
        KT[o] = f2bf(bf2f(KT[o]) * eX);
      }
      if (seg == 0) dS[kc] = __expf(tot);
    }
    __syncthreads();
#pragma unroll
    for (int kt = 0; kt < 4; ++kt) {
      float4 d4 = *(const float4*)(dS + kt * 16 + g * 4);
      T[kt][0] *= d4.x; T[kt][1] *= d4.y; T[kt][2] *= d4.z; T[kt][3] *= d4.w;
    }
#pragma unroll
    for (int tt = 0; tt < 2; ++tt) {
      const int idx = wave * 2 + tt, jt = idx >> 2, it = idx & 3;
      f32x4 akb = (f32x4){0.f, 0.f, 0.f, 0.f}, akk = akb, brk = akb, brb = akb;
      if (jt <= it) {
#pragma unroll
        for (int ks = 0; ks < 2; ++ks) {
          bf16x8 aKH = *(const bf16x8*)(KH + (jt * 16 + l15) * 72 + ks * 32 + g * 8);
          bf16x8 aBH = *(const bf16x8*)(BH + (jt * 16 + l15) * 72 + ks * 32 + g * 8);
          bf16x8 bKT = *(const bf16x8*)(KT + (it * 16 + l15) * 72 + ks * 32 + g * 8);
          bf16x8 bRT = *(const bf16x8*)(RTi + (it * 16 + l15) * 72 + ks * 32 + g * 8);
          akb = __builtin_amdgcn_mfma_f32_16x16x32_bf16(aBH, bKT, akb, 0, 0, 0);
          akk = __builtin_amdgcn_mfma_f32_16x16x32_bf16(aKH, bKT, akk, 0, 0, 0);
          brk = __builtin_amdgcn_mfma_f32_16x16x32_bf16(aKH, bRT, brk, 0, 0, 0);
          brb = __builtin_amdgcn_mfma_f32_16x16x32_bf16(aBH, bRT, brb, 0, 0, 0);
        }
        const int i = it * 16 + l15;
#pragma unroll
        for (int r = 0; r < 4; ++r) {
          const int j = jt * 16 + g * 4 + r;
          akb[r] = (j < i) ? akb[r] : 0.f;
          akk[r] = (j < i) ? akk[r] : 0.f;
          brk[r] = (j <= i) ? brk[r] : 0.f;
          brb[r] = (j <= i) ? brb[r] : 0.f;
        }
      }
      const int orow = (it * 16 + l15), ocol = jt * 16 + g * 4;
      uint2 o;
      o.x = pack2(akk[0], akk[1]); o.y = pack2(akk[2], akk[3]);
      *(uint2*)(MAkk + orow * 72 + ocol) = o;
      o.x = pack2(brk[0], brk[1]); o.y = pack2(brk[2], brk[3]);
      *(uint2*)(MBrk + orow * 72 + ocol) = o;
      o.x = pack2(brb[0], brb[1]); o.y = pack2(brb[2], brb[3]);
      *(uint2*)(MBrb + orow * 72 + ocol) = o;
      *(float4*)(AKB + orow * 68 + ocol) = make_float4(akb[0], akb[1], akb[2], akb[3]);
    }
    __syncthreads();
    bf16x8 tf0 = pack8(T[0], T[1]), tf1 = pack8(T[2], T[3]);
    f32x4 yv[2];
    {
      bf16x8 vf0, vf1;
      tr_dual<32 * 72 * 2, 4 * 72 * 2>(trbase(VV, 72, g * 8, vt * 16, lane), vf0, vf1);
#pragma unroll
      for (int ii = 0; ii < 2; ++ii) {
        const int it = ih * 2 + ii;
        f32x4 acc = (f32x4){0.f, 0.f, 0.f, 0.f};
        const bf* qr = KT + (it * 16 + l15) * 72 + g * 4;
        acc = __builtin_amdgcn_mfma_f32_16x16x32_bf16(ld2x64(qr, qr + 16), tf0, acc, 0, 0, 0);
        acc = __builtin_amdgcn_mfma_f32_16x16x32_bf16(ld2x64(qr + 32, qr + 48), tf1, acc, 0, 0, 0);
        const bf* ar = MAkk + (it * 16 + l15) * 72 + g * 8;
        acc = __builtin_amdgcn_mfma_f32_16x16x32_bf16(*(const bf16x8*)ar, vf0, acc, 0, 0, 0);
        acc = __builtin_amdgcn_mfma_f32_16x16x32_bf16(*(const bf16x8*)(ar + 32), vf1, acc, 0, 0, 0);
#pragma unroll
        for (int r = 0; r < 4; ++r) RH[(it * 16 + g * 4 + r) * 68 + vt * 16 + l15] = acc[r];
        f32x4 ya = (f32x4){0.f, 0.f, 0.f, 0.f};
        const bf* rr = RTi + (it * 16 + l15) * 72 + g * 4;
        ya = __builtin_amdgcn_mfma_f32_16x16x32_bf16(ld2x64(rr, rr + 16), tf0, ya, 0, 0, 0);
        ya = __builtin_amdgcn_mfma_f32_16x16x32_bf16(ld2x64(rr + 32, rr + 48), tf1, ya, 0, 0, 0);
        const bf* br = MBrk + (it * 16 + l15) * 72 + g * 8;
        ya = __builtin_amdgcn_mfma_f32_16x16x32_bf16(*(const bf16x8*)br, vf0, ya, 0, 0, 0);
        ya = __builtin_amdgcn_mfma_f32_16x16x32_bf16(*(const bf16x8*)(br + 32), vf1, ya, 0, 0, 0);
        yv[ii] = ya;
      }
      {
        bf16x8 k0[4], k1[4];
        tr_quad<32, 4 * 72 * 2>(trbase(KH, 72, g * 8, 0, lane), k0[0], k0[1], k0[2], k0[3]);
        tr_quad<32, 4 * 72 * 2>(trbase(KH, 72, 32 + g * 8, 0, lane), k1[0], k1[1], k1[2], k1[3]);
#pragma unroll
        for (int kt = 0; kt < 4; ++kt) {
          T[kt] = __builtin_amdgcn_mfma_f32_16x16x32_bf16(k0[kt], vf0, T[kt], 0, 0, 0);
          T[kt] = __builtin_amdgcn_mfma_f32_16x16x32_bf16(k1[kt], vf1, T[kt], 0, 0, 0);
        }
      }
    }
    __syncthreads();
    for (int rb = 0; rb < 8; ++rb) {
      if (wave == 0) {
        float acc[8];
#pragma unroll
        for (int q = 0; q < 8; ++q) acc[q] = RH[(rb * 8 + q) * 68 + lane];
#pragma unroll
        for (int q = 1; q < 8; ++q) {
          const float4 d0 = *(const float4*)(AKB + (rb * 8 + q) * 68 + rb * 8);
          const float4 d1 = *(const float4*)(AKB + (rb * 8 + q) * 68 + rb * 8 + 4);
          const float dd[8] = {d0.x, d0.y, d0.z, d0.w, d1.x, d1.y, d1.z, d1.w};
#pragma unroll
          for (int cc = 0; cc < q; ++cc) acc[q] -= dd[cc] * acc[cc];
        }
#pragma unroll
        for (int q = 0; q < 8; ++q) {
          RH[(rb * 8 + q) * 68 + lane] = acc[q];
          UN[(rb * 8 + q) * 72 + lane] = f2bf(-acc[q]);
        }
      }
      __syncthreads();
      if (rb < 7) {
        float uq[8];
#pragma unroll
        for (int q = 0; q < 8; ++q) uq[q] = RH[(rb * 8 + q) * 68 + lane];
        for (int r = (rb + 1) * 8 + wave; r < 64; r += 8) {
          const float4 a0 = *(const float4*)(AKB + r * 68 + rb * 8);
          const float4 a1 = *(const float4*)(AKB + r * 68 + rb * 8 + 4);
          float Rv = RH[r * 68 + lane];
          Rv -= ((a0.x * uq[0] + a0.y * uq[1]) + (a0.z * uq[2] + a0.w * uq[3])) + ((a1.x * uq[4] + a1.y * uq[5]) + (a1.z * uq[6] + a1.w * uq[7]));
          RH[r * 68 + lane] = Rv;
        }
        __syncthreads();
      }
    }
    __syncthreads();
    {
      bf16x8 uf0, uf1;
      tr_dual<32 * 72 * 2, 4 * 72 * 2>(trbase(UN, 72, g * 8, vt * 16, lane), uf0, uf1);
#pragma unroll
      for (int ii = 0; ii < 2; ++ii) {
        const int it = ih * 2 + ii;
        const bf* br = MBrb + (it * 16 + l15) * 72 + g * 8;
        yv[ii] = __builtin_amdgcn_mfma_f32_16x16x32_bf16(*(const bf16x8*)br, uf0, yv[ii], 0, 0, 0);
        yv[ii] = __builtin_amdgcn_mfma_f32_16x16x32_bf16(*(const bf16x8*)(br + 32), uf1, yv[ii], 0, 0, 0);
      }
      {
        bf16x8 b0[4], b1[4];
        tr_quad<32, 4 * 72 * 2>(trbase(BH, 72, g * 8, 0, lane), b0[0], b0[1], b0[2], b0[3]);
        tr_quad<32, 4 * 72 * 2>(trbase(BH, 72, 32 + g * 8, 0, lane), b1[0], b1[1], b1[2], b1[3]);
#pragma unroll
        for (int kt = 0; kt < 4; ++kt) {
          T[kt] = __builtin_amdgcn_mfma_f32_16x16x32_bf16(b0[kt], uf0, T[kt], 0, 0, 0);
          T[kt] = __builtin_amdgcn_mfma_f32_16x16x32_bf16(b1[kt], uf1, T[kt], 0, 0, 0);
        }
      }
    }
#pragma unroll
    for (int ii = 0; ii < 2; ++ii)
#pragma unroll
      for (int r = 0; r < 4; ++r) {
        const int i = (ih * 2 + ii) * 16 + g * 4 + r;
        Y[(size_t)scan_row(b, dir, c * 64 + i) * 512 + h * 64 + vt * 16 + l15] = f2bf(yv[ii][r]);
      }
  }
}

__device__ __forceinline__ void ph_mix1(const P& p, char* smem) {
  for (int u = blockIdx.x; u < 192; u += gridDim.x) {
    if (u < 128) ssd_chain2(p, u, smem);
    else gla_chain2(p, u - 128, smem);
  }
}

__device__ __forceinline__ void ph_post1(const P& p, char* smem) {
  float* ws1 = (float*)smem;
  float* ws2 = ws1 + 32;
  const int tid = tidx(), lane = tid & 63, wave = tid >> 6;
  const bf* SYF = (const bf*)(p.ws + OFF_XRAW);
  const bf* SYB = SYF + (size_t)RT * 512;
  const bf* GYF = (const bf*)(p.ws + OFF_GY);
  const bf* GYB = GYF + (size_t)RT * 512;
  const bf* XBC = (const bf*)(p.ws + OFF_XBC);
  const bf* P1 = (const bf*)(p.ws + OFF_P1C);
  bf* O = (bf*)(p.ws + OFF_HO);
  const float dsk = p.in[44][tid >> 6];
  const float sn = p.in[45][tid];
  const float gn = p.in[50][tid & 127];
  for (int rr0 = blockIdx.x * 4; rr0 < NBAT * SEQ; rr0 += gridDim.x * 4) {
    float y[4], y2[4], zg[4], gg[4];
    int Rr[4];
#pragma unroll
    for (int i = 0; i < 4; ++i) {
      int rr = rr0 + i;
      int R = (rr >> 12) * TA + CTX + (rr & 4095);
      Rr[i] = R;
      size_t o = (size_t)R * 512 + tid;
      y[i] = bf2f(SYF[o]) + bf2f(SYB[o]) + bf2f(XBC[(size_t)R * 1024 + tid]) * dsk;
      zg[i] = bf2f(P1[(size_t)R * 2080 + tid]);
      y2[i] = bf2f(GYF[o]) + bf2f(GYB[o]);
      gg[i] = bf2f(P1[(size_t)R * 2080 + 1552 + tid]);
    }
    __syncthreads();
#pragma unroll
    for (int i = 0; i < 4; ++i) {
      y[i] *= siluf_(zg[i]);
      float s1 = wave_sum(y[i] * y[i]);
      float s2 = wave_sum(y2[i] * y2[i]);
      if (lane == 0) { ws1[i * 8 + wave] = s1; ws2[i * 8 + wave] = s2; }
    }
    __syncthreads();
#pragma unroll
    for (int i = 0; i < 4; ++i) {
      int g4 = i * 8 + (wave >> 2) * 4;
      float t1 = ws1[g4] + ws1[g4 + 1] + ws1[g4 + 2] + ws1[g4 + 3];
      int g2 = i * 8 + (wave >> 1) * 2;
      float t2 = ws2[g2] + ws2[g2 + 1];
      float o1 = y[i] * rsqrtf(t1 * (1.f / 256.f) + 1e-6f) * sn;
      float o2 = y2[i] * rsqrtf(t2 * (1.f / 128.f) + 1e-6f) * gn * siluf_(gg[i]);
      O[(size_t)Rr[i] * 1024 + tid] = f2bf(o1);
      O[(size_t)Rr[i] * 1024 + 512 + tid] = f2bf(o2);
    }
  }
}

__device__ __forceinline__ void ph_final(const P& p) {
  const int lane = tidx() & 63, wave = tidx() >> 6;
  const float* g = p.in[51];
  for (int r = blockIdx.x * 8 + wave; r < NBAT * SEQ; r += gridDim.x * 8) {
    float* row = p.out + (size_t)r * 1024;
    float4 v[4];
    float ss = 0.f;
#pragma unroll
    for (int i = 0; i < 4; ++i) {
      v[i] = *(const float4*)(row + i * 256 + lane * 4);
      ss += v[i].x * v[i].x + v[i].y * v[i].y + v[i].z * v[i].z + v[i].w * v[i].w;
    }
    ss = wave_sum(ss);
    float rs = rsqrtf(ss * (1.f / 1024.f) + 1e-6f);
#pragma unroll
    for (int i = 0; i < 4; ++i) {
      float4 gg = *(const float4*)(g + i * 256 + lane * 4);
      float4 o = make_float4(v[i].x * rs * gg.x, v[i].y * rs * gg.y, v[i].z * rs * gg.z, v[i].w * rs * gg.w);
      *(float4*)(row + i * 256 + lane * 4) = o;
    }
  }
}

#define XB_TMO      128
#define XB_XCNT(j)  (256  + 64 * (j))
#define XB_XSUB(j)  (1280 + 64 * (j))
#define XB_XGEN(j)  (2304 + 64 * (j))
#define XB_TOP      3328
#define XB_TOPGEN   3392
#define XCD_BAR_WORDS 3456
#define XB_SPIN_CAP (1u << 18)
#define LAS __attribute__((address_space(3)))
__device__ __forceinline__ unsigned xb_ld(unsigned* q)              { return __hip_atomic_load(q, __ATOMIC_RELAXED, __HIP_MEMORY_SCOPE_AGENT); }
__device__ __forceinline__ unsigned xb_add(unsigned* q, unsigned v) { return __hip_atomic_fetch_add(q, v, __ATOMIC_RELAXED, __HIP_MEMORY_SCOPE_AGENT); }
__device__ __forceinline__ unsigned xb_xcc_id() { return (unsigned)__builtin_amdgcn_s_getreg((3 << 11) | 20) & 0xFu; }
#define XB_SPIN(cond, bar) do { unsigned _sp = 0; while (cond) { __builtin_amdgcn_s_sleep(1); \
    if ((++_sp & 255u) == 0u) { if (xb_ld(&(bar)[XB_TMO])) break; if (_sp > XB_SPIN_CAP) { atomicAdd(&(bar)[XB_TMO], 1u); break; } } } } while (0)
struct XcdBarrier { unsigned* bar; unsigned x; volatile LAS unsigned* st; };
__device__ __forceinline__ XcdBarrier xcd_barrier_post(unsigned* bar, volatile LAS unsigned* st) {
  XcdBarrier b; b.bar = bar; b.x = xb_xcc_id(); b.st = st;
  if (threadIdx.x == 0) (void)xb_add(&bar[XB_XCNT(b.x)], 1u);
  return b;
}
__device__ __forceinline__ void xcd_barrier_complete(unsigned* bar, unsigned x, unsigned& nloc, unsigned& nx) {
  const unsigned G = gridDim.x * gridDim.y * gridDim.z;
  unsigned sum, cnt, mine, sp = 0u;
  for (;;) {
    sum = 0u; cnt = 0u; mine = 0u;
#pragma unroll
    for (unsigned j = 0; j < 16; ++j) { const unsigned c = xb_ld(&bar[XB_XCNT(j)]); sum += c; cnt += (c > 0u) ? 1u : 0u; mine = (j == x) ? c : mine; }
    if (sum == G) break;
    __builtin_amdgcn_s_sleep(1);
    if ((++sp & 255u) == 0u) { if (xb_ld(&bar[XB_TMO])) break; if (sp > XB_SPIN_CAP) { atomicAdd(&bar[XB_TMO], 1u); break; } }
  }
  nloc = mine > 0u ? mine : 1u; nx = cnt > 0u ? cnt : 1u;
}
__device__ __forceinline__ void xcd_barrier(const XcdBarrier& b) {
  asm volatile("s_waitcnt vmcnt(0)" ::: "memory");
  __syncthreads();
  if (threadIdx.x == 0) {
    unsigned* bar = b.bar;
    __builtin_amdgcn_s_waitcnt(0);
    unsigned nloc = b.st[0], nx = b.st[1];
    if (nloc == 0u) { xcd_barrier_complete(bar, b.x, nloc, nx); b.st[0] = nloc; b.st[1] = nx; }
    const unsigned old = xb_add(&bar[XB_XSUB(b.x)], 1u);
    const unsigned gen = old / nloc;
    if (old + 1u == (gen + 1u) * nloc) {
      __builtin_amdgcn_fence(__ATOMIC_RELEASE, "agent");
      asm volatile("s_waitcnt vmcnt(0)" ::: "memory");
      const unsigned og = xb_add(&bar[XB_TOP], 1u);
      const unsigned tg = og / nx;
      if (og + 1u == (tg + 1u) * nx) xb_add(&bar[XB_TOPGEN], 1u);
      else XB_SPIN(xb_ld(&bar[XB_TOPGEN]) == tg, bar);
      __builtin_amdgcn_fence(__ATOMIC_ACQUIRE, "agent");
      xb_add(&bar[XB_XGEN(b.x)], 1u);
      asm volatile("s_waitcnt vmcnt(0)" ::: "memory");
    } else {
      XB_SPIN(xb_ld(&bar[XB_XGEN(b.x)]) == gen, bar);
      __builtin_amdgcn_fence(__ATOMIC_ACQUIRE, "agent");
      asm volatile("s_waitcnt vmcnt(0)" ::: "memory");
    }
  }
  __syncthreads();
}

constexpr int NPH = 20;
template <int PH>
__device__ __forceinline__ void run_phase(const P& p, char* smem) {
  const bf* WT = (const bf*)(p.ws + OFF_WT);
  const bf* WT1 = (const bf*)(p.ws + OFF_WT1);
  const bf* HO = (const bf*)(p.ws + OFF_HO);
  const bf* HID = (const bf*)(p.ws + OFF_HID);
  if constexpr (PH == 0) {
    if (blockIdx.x == 0 && tidx() == 0) { *(int*)(p.ws + OFF_CNT) = 0; *((int*)(p.ws + OFF_CNT) + 1) = 0; }
    ph_mod(p, smem);
    ph_lw(p);
    ph_wt(p, 0, smem, blockIdx.x, gridDim.x);
  } else if constexpr (PH == 1) ph_ada(p, 0, 0, 1, 0);
  else if constexpr (PH == 2) ph_gemm<0>(p, HO, WT + WT_IN, 1024, 13, 0, 0, smem);
  else if constexpr (PH == 3) {
    ph_rope(p, smem);
    ph_rwkv_prep(p, smem);
#ifdef PROBE_PREP
    __syncthreads();
    ph_rwkv_prep(p, smem);
#endif
  }
  else if constexpr (PH == 4) ph_mix0(p, smem);
  else if constexpr (PH == 5) ph_rwkv_post(p);
  else if constexpr (PH == 6) ph_gemm<2>(p, HO, WT + WT_OUT, 1024, 4, 0, 0, smem);
  else if constexpr (PH == 7) ph_ada(p, 0, 1, 0, 0);
  else if constexpr (PH == 8) ph_gemm<3>(p, HO, WT + WT_W1, 1024, 16, 0, 0, smem);
  else if constexpr (PH == 9) {
    ph_gemm<4>(p, HID, WT + WT_W2, 4096, 4, 0, 0, smem);
    const int extra = 544 % (int)gridDim.x;
    if ((int)gridDim.x - extra >= 32) { if ((int)blockIdx.x >= extra) ph_wt(p, 1, smem, blockIdx.x - extra, gridDim.x - extra); }
    else ph_wt(p, 1, smem, blockIdx.x, gridDim.x);
  }
  else if constexpr (PH == 10) ph_ada(p, 1, 0, 0, 0);
  else if constexpr (PH == 11) ph_gemm<1>(p, HO, WT1 + WT_IN, 1024, 13, 1, 0, smem);
  else if constexpr (PH == 12) ph_conv(p);
  else if constexpr (PH == 13) ph_mix1(p, smem);
  else if constexpr (PH == 14) ph_post1(p, smem);
  else if constexpr (PH == 15) ph_gemm<2>(p, HO, WT1 + WT_OUT, 1024, 4, 1, 1, smem);
  else if constexpr (PH == 16) ph_ada(p, 1, 1, 0, 1);
  else if constexpr (PH == 17) ph_gemm<3>(p, HO, WT1 + WT_W1, 1024, 16, 1, 1, smem);
  else if constexpr (PH == 18) ph_gemm<4>(p, HID, WT1 + WT_W2, 4096, 4, 1, 1, smem);
  else ph_final(p);
}

constexpr int LDS_BYTES = 131072 + 64;
template <int PH>
__device__ __forceinline__ void run_all(const P& p, char* smem, const XcdBarrier& xb) {
  run_phase<PH>(p, smem);
#ifdef PROBE_MASK
  if constexpr (((PROBE_MASK) >> PH) & 1) {
    xcd_barrier(xb);
    if constexpr (PH == 4) {
      if (blockIdx.x == 0 && tidx() == 0) *(int*)(p.ws + OFF_CNT) = 0;
      xcd_barrier(xb);
    }
    run_phase<PH>(p, smem);
  }
#endif
  if constexpr (PH + 1 < NPH) {
    if constexpr (PH == 0) cg::this_grid().sync();
    else xcd_barrier(xb);
    run_all<PH + 1>(p, smem, xb);
  }
}
__global__ void __launch_bounds__(NT) mega(P p) {
  extern __shared__ __attribute__((aligned(16))) char smem[];
  volatile LAS unsigned* st = (volatile LAS unsigned*)(smem + 131072 + 16);
  if (threadIdx.x == 0) { st[0] = 0u; st[1] = 0u; }
  __syncthreads();
  const XcdBarrier xb = xcd_barrier_post((unsigned*)(p.ws + OFF_BAR), st);
  run_all<0>(p, smem, xb);
}

extern "C" void kernel_launch(void* const* d_in, const int* in_sizes, int n_in, void* d_out, int out_size, void* d_ws,
                              size_t ws_size, hipStream_t stream) {
  P p{};
  for (int i = 0; i < 52; ++i) p.in[i] = (const float*)d_in[i];
  p.out = (float*)d_out;
  p.ws = (char*)d_ws;
  static int grid_blocks = 0;
  if (!grid_blocks) {
    int dev = 0, cus = 0, per_cu = 0;
    (void)hipGetDevice(&dev);
    (void)hipDeviceGetAttribute(&cus, hipDeviceAttributeMultiprocessorCount, dev);
    (void)hipFuncSetAttribute((const void*)mega, hipFuncAttributeMaxDynamicSharedMemorySize, LDS_BYTES);
    (void)hipOccupancyMaxActiveBlocksPerMultiprocessor(&per_cu, mega, NT, LDS_BYTES);
    if (per_cu < 1) per_cu = 1;
    if (per_cu > 1) per_cu = 1;
    grid_blocks = cus * per_cu;
  }
  (void)hipMemsetAsync((char*)d_ws + OFF_BAR, 0, XCD_BAR_WORDS * sizeof(unsigned), stream);
  void* args[] = {&p};
  hipError_t e = hipLaunchCooperativeKernel((void*)mega, dim3(grid_blocks), dim3(NT), args, LDS_BYTES, stream);
  if (e != hipSuccess) fprintf(stderr, "cooperative launch failed: %s (grid %d)\n", hipGetErrorString(e), grid_blocks);
}
```

```cpp
#include <hip/hip_runtime.h>
#include <hip/hip_cooperative_groups.h>
#include <cstdio>
namespace cg = cooperative_groups;

#ifndef MODE_COOP
#define MODE_COOP 1
#endif

typedef unsigned short bf;
typedef __attribute__((ext_vector_type(8))) short bf16x8;
typedef __attribute__((ext_vector_type(4))) float f32x4;
typedef __attribute__((ext_vector_type(4))) int i32x4;

constexpr int NT = 512;
constexpr int Dm = 1024, NBAT = 8, SEQ = 4096, CTX = 256, TA = 4352, RT = NBAT * TA;

constexpr size_t OFF_MOD = 0;
constexpr size_t OFF_CNT = 450000;
constexpr size_t OFF_BAR = 458752;
constexpr size_t OFF_WT = 524288;
constexpr size_t WT_IN = 0, WT_OUT = (size_t)3328 * 1024, WT_W1 = WT_OUT + (size_t)1024 * 1024, WT_W2 = WT_W1 + (size_t)4096 * 1024;
constexpr size_t OFF_CTXX = OFF_WT + (size_t)12544 * 1024 * 2;
constexpr size_t OFF_HO = OFF_CTXX + (size_t)2048 * 1024 * 4;
constexpr size_t OFF_BIG = OFF_HO + (size_t)RT * 1024 * 2;
constexpr size_t SZ512 = (size_t)RT * 512 * 2;
constexpr size_t OFF_QKV = OFF_BIG;
constexpr size_t OFF_PREP = OFF_QKV + (size_t)RT * 1536 * 2;
constexpr size_t OFF_G = OFF_PREP + 7 * SZ512;
constexpr size_t OFF_BONUS = OFF_G + SZ512;
constexpr size_t OFF_LW = OFF_BONUS + (size_t)RT * 8 * 4;
constexpr size_t OFF_WT1 = 500170752;
constexpr size_t OFF_HID = OFF_BIG;
constexpr size_t OFF_P1C = OFF_BIG;
constexpr size_t OFF_XRAW = OFF_P1C + (size_t)RT * 2080 * 2;
constexpr size_t OFF_DTRAW = OFF_XRAW + (size_t)RT * 1024 * 2;
constexpr size_t OFF_XBC = OFF_DTRAW + (size_t)RT * 16 * 4;
constexpr size_t OFF_GY = OFF_XBC + (size_t)RT * 1024 * 2;

struct P {
  const float* in[52];
  float* out;
  char* ws;
};

__device__ __forceinline__ int tidx() { int t = threadIdx.x; asm volatile("" : "+v"(t)); return t; }
__device__ __forceinline__ bf f2bf(float f) { __bf16 r = (__bf16)f; return __builtin_bit_cast(bf, r); }
__device__ __forceinline__ float bf2f(bf h) { return __uint_as_float(((unsigned)h) << 16); }
__device__ __forceinline__ float bflo(unsigned u) { return __uint_as_float(u << 16); }
__device__ __forceinline__ float bfhi(unsigned u) { return __uint_as_float(u & 0xffff0000u); }
typedef __bf16 bf16x2_t __attribute__((ext_vector_type(2)));
typedef float f32x2_t __attribute__((ext_vector_type(2)));
__device__ __forceinline__ unsigned pack2(float a, float b) { f32x2_t v = {a, b}; bf16x2_t r = __builtin_convertvector(v, bf16x2_t); return __builtin_bit_cast(unsigned, r); }
__device__ __forceinline__ float sigmoidf_(float x) { return __builtin_amdgcn_rcpf(1.f + __expf(-x)); }
__device__ __forceinline__ float softplusf_(float x) { return x > 15.f ? x : __logf(1.f + __expf(x)); }
__device__ __forceinline__ float siluf_(float x) { return x * __builtin_amdgcn_rcpf(1.f + __expf(-x)); }
__device__ __forceinline__ float wave_sum(float v) {
#pragma unroll
  for (int o = 32; o >= 1; o >>= 1) v += __shfl_xor(v, o);
  return v;
}
template <int C>
__device__ __forceinline__ float dppf(float x) {
  return __builtin_bit_cast(float, __builtin_amdgcn_update_dpp(0, __builtin_bit_cast(int, x), C, 0xF, 0xF, true));
}
__device__ __forceinline__ float red16(float x) {
  x += dppf<0xB1>(x);
  x += dppf<0x4E>(x);
  x += dppf<0x141>(x);
  x += dppf<0x128>(x);
  return x;
}
__device__ __forceinline__ float* xrow(const P& p, int R) {
  int b = R / TA, a = R - b * TA;
  if (a < CTX) return (float*)(p.ws + OFF_CTXX) + (size_t)(b * CTX + a) * Dm;
  return p.out + (size_t)(b * SEQ + a - CTX) * Dm;
}
__device__ __forceinline__ const float* inrow(const P& p, int R) {
  int b = R / TA, a = R - b * TA;
  if (a < CTX) return p.in[2] + (size_t)(b * CTX + a) * Dm;
  return p.in[0] + (size_t)(b * SEQ + a - CTX) * Dm;
}
__device__ __forceinline__ int mrow(int R) {
  int b = R / TA, a = R - b * TA;
  return a < CTX ? 8 : b;
}

__device__ __forceinline__ void ph_mod(const P& p, char* smem) {
  float* sc = (float*)smem;
  float* red = sc + 9 * 1024;
  const int tid = tidx();
  bool loaded = false;
  for (int unit = blockIdx.x; unit < 2 * 192; unit += gridDim.x) {
    int layer = unit / 192, cch = unit - layer * 192;
    const float* W = p.in[layer ? 30 : 4];
    const float* bias = p.in[layer ? 31 : 5];
    __syncthreads();
    if (!loaded) {
      for (int i = tid; i < 9 * 1024; i += NT) {
        int r = i >> 10, k = i & 1023;
        float v = (r < 8) ? p.in[1][r * 1024 + k] : p.in[3][k];
        sc[i] = siluf_(v);
      }
      loaded = true;
      __syncthreads();
    }
    int cl = tid & 31, kg = tid >> 5;
    int col = cch * 32 + cl;
    float acc[9];
#pragma unroll
    for (int r = 0; r < 9; ++r) acc[r] = 0.f;
    for (int k = kg * 64; k < kg * 64 + 64; ++k) {
      float w = W[(size_t)k * 6144 + col];
#pragma unroll
      for (int r = 0; r < 9; ++r) acc[r] += sc[r * 1024 + k] * w;
    }
#pragma unroll
    for (int r = 0; r < 9; ++r) red[(kg * 9 + r) * 32 + cl] = acc[r];
    __syncthreads();
    if (tid < 288) {
      int r = tid >> 5, c = tid & 31;
      float s = 0.f;
#pragma unroll
      for (int g = 0; g < 16; ++g) s += red[(g * 9 + r) * 32 + c];
      ((float*)(p.ws + OFF_MOD))[(size_t)(layer * 9 + r) * 6144 + cch * 32 + c] = s + bias[cch * 32 + c];
    }
  }
}

__device__ __forceinline__ void transpose_one(const float* W, bf* Wt, int K, int N, int Npad, int vb, int nvb, char* smem) {
  float* tile = (float*)smem;
  const int tid = tidx();
  int ntn = Npad / 64, ntk = K / 64;
  for (int t = vb; t < ntn * ntk; t += nvb) {
    int tn = t / ntk, tk = t - tn * ntk;
    int n0 = tn * 64, k0 = tk * 64;
    __syncthreads();
#pragma unroll
    for (int i = 0; i < 8; ++i) {
      int kk = (tid >> 6) + 8 * i, nn = tid & 63;
      float v = (n0 + nn < N) ? W[(size_t)(k0 + kk) * N + n0 + nn] : 0.f;
      tile[kk * 65 + nn] = v;
    }
    __syncthreads();
#pragma unroll
    for (int i = 0; i < 8; ++i) {
      int nn = (tid >> 6) + 8 * i, kk = tid & 63;
      Wt[(size_t)(n0 + nn) * K + k0 + kk] = f2bf(tile[kk * 65 + nn]);
    }
  }
}
__device__ __forceinline__ void ph_wt(const P& p, int layer, char* smem, int b, int nb) {
  bf* WT = (bf*)(p.ws + (layer ? OFF_WT1 : OFF_WT));
  int base = layer ? 34 : 8;
  int nin = layer ? 3104 : 3328, ninp = 3328;
  for (int mtx = 0; mtx < 4; ++mtx) {
    const float* W = p.in[base + mtx];
    bf* dst = WT + (mtx == 0 ? WT_IN : mtx == 1 ? WT_OUT : mtx == 2 ? WT_W1 : WT_W2);
    int K = mtx == 3 ? 4096 : 1024;
    int N = mtx == 0 ? nin : mtx == 2 ? 4096 : 1024;
    int Np = mtx == 0 ? ninp : N;
    transpose_one(W, dst, K, N, Np, (b + (nb / 4) * mtx) % nb, nb, smem);
  }
}

__device__ __forceinline__ void ph_ada(const P& p, int layer, int which, int useInput, int latonly) {
  const int lane = tidx() & 63, wave = tidx() >> 6;
  const float* ng = p.in[(layer ? 32 : 6) + which];
  const float* mod = (const float*)(p.ws + OFF_MOD);
  bf* H = (bf*)(p.ws + OFF_HO);
  for (int R = blockIdx.x * 8 + wave; R < RT; R += gridDim.x * 8) {
    int b = R / TA, a = R - b * TA;
    if (latonly && a < CTX) continue;
    const float* src = useInput ? inrow(p, R) : xrow(p, R);
    float4 v[4];
    float ss = 0.f;
#pragma unroll
    for (int i = 0; i < 4; ++i) {
      v[i] = *(const float4*)(src + i * 256 + lane * 4);
      ss += v[i].x * v[i].x + v[i].y * v[i].y + v[i].z * v[i].z + v[i].w * v[i].w;
    }
    ss = wave_sum(ss);
    float rs = rsqrtf(ss * (1.f / 1024.f) + 1e-6f);
    int mr = a < CTX ? 8 : b;
    const float* sh = mod + (size_t)(layer * 9 + mr) * 6144 + (which * 3 + 0) * 1024;
    const float* scl = mod + (size_t)(layer * 9 + mr) * 6144 + (which * 3 + 1) * 1024;
#pragma unroll
    for (int i = 0; i < 4; ++i) {
      int k = i * 256 + lane * 4;
      float4 g = *(const float4*)(ng + k);
      float4 s4 = *(const float4*)(sh + k);
      float4 c4 = *(const float4*)(scl + k);
      float o0 = v[i].x * rs * g.x * (1.f + c4.x) + s4.x;
      float o1 = v[i].y * rs * g.y * (1.f + c4.y) + s4.y;
      float o2 = v[i].z * rs * g.z * (1.f + c4.z) + s4.z;
      float o3 = v[i].w * rs * g.w * (1.f + c4.w) + s4.w;
      uint2 o;
      o.x = pack2(o0, o1);
      o.y = pack2(o2, o3);
      *(uint2*)(H + (size_t)R * 1024 + k) = o;
    }
  }
}

namespace pg8 {
#define PG8_LAS __attribute__((address_space(3)))
typedef float f32x2 __attribute__((ext_vector_type(2)));
typedef unsigned u32x4 __attribute__((ext_vector_type(4)));
constexpr int BM = 256, BK = 64, HALF = 128, HTB = HALF * BK * 2, STAGE_BYTES = 8 * HTB, NXCD = 8, WGM = 8;
__device__ __forceinline__ int lds_byte(int r, int c) { const int st = (r >> 4) * 2 + (c >> 5), rr = r & 15, cc = c & 31, ob = rr * 64 + cc * 2; return st * 1024 + (ob ^ (((ob >> 9) & 1) << 5)); }
__device__ __forceinline__ void stage_rc(int b, int& R, int& C) { const int st = b / 1024, sb = b % 1024, swz = sb ^ (((sb >> 9) & 1) << 5); R = (st >> 1) * 16 + swz / 64; C = (st & 1) * 32 + (swz % 64) / 2; }
__device__ __forceinline__ int perm32(int rho) { const int n = rho >> 4, i = rho & 15; return 8 * (i >> 2) + 4 * n + (i & 3); }
struct Unit { int pm, pn; };
struct Gemm { const bf* A; const bf* Bt; int K; };
struct Order {
  int nM, nN, nwg, G, c, latonly;
  __device__ void init(int nM_, int nN_, int G_, int c_, int lat) { nM = nM_; nN = nN_; nwg = nM * nN; G = G_; c = c_; latonly = lat; }
  __device__ bool next(int i, Unit& u) const {
    const long L = (long)i * G + c;
    if (L >= nwg) return false;
    int wgid = (int)L;
    { const int q = nwg / NXCD, r = nwg % NXCD, xcd = wgid % NXCD, off = wgid / NXCD; wgid = (xcd < r ? xcd * (q + 1) : r * (q + 1) + (xcd - r) * q) + off; }
    const int nig = WGM * nN, gid = wgid / nig, fm = gid * WGM, gsz = (nM - fm) < WGM ? (nM - fm) : WGM;
    int pm = fm + ((wgid % nig) % gsz);
    u.pn = (wgid % nig) / gsz;
    u.pm = latonly ? ((pm >> 4) * 17 + 1 + (pm & 15)) : pm;
    return true;
  }
};
__device__ __forceinline__ unsigned cvt_pk_bf16(float lo, float hi) { return pack2(lo, hi); }

template <int EPI>
struct Epi {
  static constexpr bool PERM = (EPI == 0 || EPI == 1 || EPI == 3);
  P p;
  int layer;
  __device__ __forceinline__ void operator()(const f32x4 (&acc)[2][2][4][2], const Unit& u, int wr, int wc, int fr, int fq) const {
#pragma unroll
    for (int ai = 0; ai < 2; ++ai)
#pragma unroll
      for (int m = 0; m < 4; ++m) {
        const int row = u.pm * BM + ai * HALF + wr * 64 + m * 16 + fr;
        if constexpr (PERM) {
#pragma unroll
          for (int bj = 0; bj < 2; ++bj) {
            const int c0 = u.pn * BM + bj * HALF + wc * 32 + 8 * fq;
            f32x4 v0 = acc[ai][bj][m][0], v1 = acc[ai][bj][m][1];
            if constexpr (EPI == 3) {
#pragma unroll
              for (int j = 0; j < 4; ++j) { float a = v0[j] > 0.f ? v0[j] : 0.f; v0[j] = a * a; float b2 = v1[j] > 0.f ? v1[j] : 0.f; v1[j] = b2 * b2; }
            }
            u32x4 w;
            w.x = cvt_pk_bf16(v0[0], v0[1]); w.y = cvt_pk_bf16(v0[2], v0[3]); w.z = cvt_pk_bf16(v1[0], v1[1]); w.w = cvt_pk_bf16(v1[2], v1[3]);
            if constexpr (EPI == 0) {
              bf* dst = c0 < 1536 ? (bf*)(p.ws + OFF_QKV) + (size_t)row * 1536 + c0 : (bf*)p.out + (size_t)row * 1792 + (c0 - 1536);
              *(u32x4*)dst = w;
            } else if constexpr (EPI == 1) {
              if (c0 < 512) *(u32x4*)((bf*)(p.ws + OFF_P1C) + (size_t)row * 2080 + c0) = w;
              else if (c0 < 1536) *(u32x4*)((bf*)(p.ws + OFF_XRAW) + (size_t)row * 1024 + (c0 - 512)) = w;
              else if (c0 < 1552) { float* d = (float*)(p.ws + OFF_DTRAW) + (size_t)row * 16 + (c0 - 1536); *(f32x4*)d = v0; *(f32x4*)(d + 4) = v1; }
              else if (c0 < 3104) *(u32x4*)((bf*)(p.ws + OFF_P1C) + (size_t)row * 2080 + (c0 - 1024)) = w;
            } else {
              *(u32x4*)((bf*)(p.ws + OFF_HID) + (size_t)row * 4096 + c0) = w;
            }
          }
        } else {
          const float* gate = (const float*)(p.ws + OFF_MOD) + (size_t)(layer * 9 + mrow(row)) * 6144 + (EPI == 2 ? 2 : 5) * 1024;
          float* xr = xrow(p, row);
          const float* br = (EPI == 2 && layer == 0) ? inrow(p, row) : xr;
#pragma unroll
          for (int bj = 0; bj < 2; ++bj)
#pragma unroll
            for (int n = 0; n < 2; ++n) {
              const int c = u.pn * BM + bj * HALF + wc * 32 + 16 * n + 4 * fq;
              f32x4 gt = *(const f32x4*)(gate + c);
              f32x4 bs = *(const f32x4*)(br + c);
              *(f32x4*)(xr + c) = bs + gt * acc[ai][bj][m][n];
            }
        }
      }
  }
};

template <class EpiT>
__device__ __forceinline__ void gemm_phase(PG8_LAS unsigned char* lds, const Gemm g, const Order& S, const EpiT& E) {
  const int tid = tidx(), wid = __builtin_amdgcn_readfirstlane(tid >> 6), lane = tid & 63, wr = wid >> 2, wc = wid & 3, fr = lane & 15, fq = lane >> 4;
  const int K = g.K, nt = K / BK;
  unsigned voffA[2], voffB[2];
#pragma unroll
  for (int i = 0; i < 2; ++i) { int R, C; stage_rc(tid * 16 + i * 8192, R, C); const int Rb = EpiT::PERM ? ((R & ~31) + perm32(R & 31)) : R;
    voffA[i] = (unsigned)(R * K + C) * 2u; voffB[i] = (unsigned)(Rb * K + C) * 2u; }
  const size_t kstep = (size_t)(BK * 2);
  const size_t hstep = (size_t)HALF * K * 2;
  const size_t tstep = 2 * hstep;
  const unsigned ldsw = (unsigned)wid * 1024u;
  const int aoff = lds_byte(wr * 64 + fr, fq * 8), boff = lds_byte(wc * 32 + fr, fq * 8);
#define PG8_SA(b, h) (((b) * 2 + (h)) * HTB)
#define PG8_SB(b, h) ((4 + (b) * 2 + (h)) * HTB)
#define PG8_STAGE(bufoff, gbase, voff) do { _Pragma("unroll") for (int _i = 0; _i < 2; ++_i) \
        __builtin_amdgcn_global_load_lds((const unsigned*)((const char*)(gbase) + (voff)[_i]), (PG8_LAS unsigned*)(lds + (bufoff) + ldsw + _i * 8192), 16, 0, 0); } while (0)
#define PG8_LDA(dst, b, h) do { _Pragma("unroll") for (int m = 0; m < 4; ++m) _Pragma("unroll") for (int k = 0; k < 2; ++k) dst[m][k] = *(const PG8_LAS bf16x8*)(lds + PG8_SA(b, h) + aoff + m * 2048 + k * 1024); } while (0)
#define PG8_LDB(dst, b, h) do { _Pragma("unroll") for (int n = 0; n < 2; ++n) _Pragma("unroll") for (int k = 0; k < 2; ++k) dst[n][k] = *(const PG8_LAS bf16x8*)(lds + PG8_SB(b, h) + boff + n * 2048 + k * 1024); } while (0)
#define PG8_MMA(ai, bj, At, Bt) do { __builtin_amdgcn_s_setprio(1); _Pragma("unroll") for (int m = 0; m < 4; ++m) _Pragma("unroll") for (int n = 0; n < 2; ++n) _Pragma("unroll") for (int k = 0; k < 2; ++k) \
        acc[ai][bj][m][n] = __builtin_amdgcn_mfma_f32_16x16x32_bf16(Bt[n][k], At[m][k], acc[ai][bj][m][n], 0, 0, 0); __builtin_amdgcn_s_setprio(0); } while (0)
#define PG8_WAIT_V(n) asm volatile("s_waitcnt vmcnt(" #n ")" ::: "memory")
#define PG8_WAIT_L(n) asm volatile("s_waitcnt lgkmcnt(" #n ")" ::: "memory")
#define PG8_BAR __builtin_amdgcn_s_barrier()
#define PG8_SCHED __builtin_amdgcn_sched_barrier(0)
  Unit cur, nxt; int ui = 0;
  if (!S.next(0, cur)) return;
  f32x4 acc[2][2][4][2];
#pragma unroll
  for (int a = 0; a < 2; ++a)
#pragma unroll
    for (int b = 0; b < 2; ++b)
#pragma unroll
      for (int m = 0; m < 4; ++m)
#pragma unroll
        for (int n = 0; n < 2; ++n) acc[a][b][m][n] = (f32x4){0.f, 0.f, 0.f, 0.f};
  bf16x8 At[4][2], B0[2][2], B1[2][2];
  const char* cA = (const char*)g.A + (size_t)cur.pm * tstep; const char* cB = (const char*)g.Bt + (size_t)cur.pn * tstep;
  PG8_STAGE(PG8_SB(0, 0), cB, voffB); PG8_STAGE(PG8_SA(0, 0), cA, voffA); PG8_STAGE(PG8_SB(0, 1), cB + hstep, voffB); PG8_STAGE(PG8_SA(0, 1), cA + hstep, voffA);
  if (wr == 1) PG8_BAR;
  PG8_WAIT_V(4); PG8_BAR;
  PG8_STAGE(PG8_SB(1, 0), cB + kstep, voffB); PG8_STAGE(PG8_SA(1, 0), cA + kstep, voffA); PG8_STAGE(PG8_SB(1, 1), cB + hstep + kstep, voffB);
  PG8_WAIT_V(6); PG8_BAR;
  for (;;) {
    const bool has_next = S.next(ui + 1, nxt);
    const char* nA = has_next ? (const char*)g.A + (size_t)nxt.pm * tstep : cA; const char* nB = has_next ? (const char*)g.Bt + (size_t)nxt.pn * tstep : cB;
    for (int t = 0; t < nt; t += 2) {
      const bool last = (t == nt - 2);
      const char* a1 = cA + (size_t)(t + 1) * kstep;
      const char* a2 = last ? nA : cA + (size_t)(t + 2) * kstep; const char* b2 = last ? nB : cB + (size_t)(t + 2) * kstep;
      const char* a3 = a2 + kstep; const char* b3 = b2 + kstep;
      PG8_LDB(B0, 0, 0); PG8_SCHED; PG8_LDA(At, 0, 0); PG8_STAGE(PG8_SA(1, 1), a1 + hstep, voffA);
      PG8_WAIT_L(8); PG8_BAR; PG8_WAIT_L(0); PG8_MMA(0, 0, At, B0); PG8_BAR; PG8_SCHED;
      PG8_LDB(B1, 0, 1); PG8_STAGE(PG8_SB(0, 0), b2, voffB);
      PG8_BAR; PG8_WAIT_L(0); PG8_MMA(0, 1, At, B1); PG8_BAR;
      PG8_LDA(At, 0, 1); PG8_STAGE(PG8_SA(0, 0), a2, voffA);
      PG8_BAR; PG8_WAIT_L(0); PG8_MMA(1, 0, At, B0); PG8_BAR; PG8_SCHED;
      PG8_STAGE(PG8_SB(0, 1), b2 + hstep, voffB);
      PG8_WAIT_V(6); PG8_BAR; PG8_MMA(1, 1, At, B1); PG8_BAR;
      PG8_LDB(B0, 1, 0); PG8_SCHED; PG8_LDA(At, 1, 0); PG8_STAGE(PG8_SA(0, 1), a2 + hstep, voffA);
      PG8_WAIT_L(8); PG8_BAR; PG8_WAIT_L(0); PG8_MMA(0, 0, At, B0); PG8_BAR; PG8_SCHED;
      PG8_LDB(B1, 1, 1); PG8_STAGE(PG8_SB(1, 0), b3, voffB);
      PG8_BAR; PG8_WAIT_L(0); PG8_MMA(0, 1, At, B1); PG8_BAR;
      PG8_LDA(At, 1, 1); PG8_STAGE(PG8_SA(1, 0), a3, voffA);
      PG8_BAR; PG8_WAIT_L(0); PG8_MMA(1, 0, At, B0); PG8_BAR; PG8_SCHED;
      PG8_STAGE(PG8_SB(1, 1), b3 + hstep, voffB);
      PG8_WAIT_V(6); PG8_BAR; PG8_MMA(1, 1, At, B1); PG8_BAR;
    }
    E(acc, cur, wr, wc, fr, fq);
    if (!has_next) break;
#pragma unroll
    for (int a = 0; a < 2; ++a)
#pragma unroll
      for (int b = 0; b < 2; ++b)
#pragma unroll
        for (int m = 0; m < 4; ++m)
#pragma unroll
          for (int n = 0; n < 2; ++n) acc[a][b][m][n] = (f32x4){0.f, 0.f, 0.f, 0.f};
    cur = nxt; cA = nA; cB = nB; ++ui;
  }
  PG8_WAIT_V(0);
  if (wr == 0) PG8_BAR;
  PG8_BAR;
#undef PG8_SA
#undef PG8_SB
#undef PG8_STAGE
#undef PG8_LDA
#undef PG8_LDB
#undef PG8_MMA
#undef PG8_WAIT_V
#undef PG8_WAIT_L
#undef PG8_BAR
#undef PG8_SCHED
}
}

template <int EPI>
__device__ __forceinline__ void ph_gemm(const P& p, const bf* A, const bf* Bt, int K, int nN, int layer, int latonly, char* smem) {
  pg8::Order S;
  S.init(latonly ? 128 : 136, nN, gridDim.x, blockIdx.x, latonly);
  pg8::Epi<EPI> E{p, layer};
  pg8::Gemm g{A, Bt, K};
  __syncthreads();
  pg8::gemm_phase(( __attribute__((address_space(3))) unsigned char*)smem, g, S, E);
  __syncthreads();
}

__device__ __forceinline__ void ph_rope(const P& p, char* smem) {
  float* tcos = (float*)smem;
  float* tsin = tcos + 1024;
  const int tid = tidx();
  __syncthreads();
  for (int i = tid; i < 1024; i += NT) {
    int c = i >> 4, f = i & 15;
    float inv = powf(10000.f, -(float)f / 16.f);
    float ang = (float)c * inv;
    float sn, cs;
    sincosf(ang, &sn, &cs);
    tcos[i] = cs;
    tsin[i] = sn;
  }
  __syncthreads();
  bf* QKV = (bf*)(p.ws + OFF_QKV);
  for (int it = blockIdx.x * NT + tid; it < RT * 32; it += gridDim.x * NT) {
    int R = it >> 5;
    int vec = (it >> 1) & 15, half = it & 1;
    int b = R / TA, a = R - b * TA;
    bool isq = vec < 8;
    if (!isq && a < CTX) continue;
    bf* ptr = QKV + (size_t)R * 1536 + vec * 64 + half * 32;
    uint4 a0 = *(const uint4*)ptr, a1 = *(const uint4*)(ptr + 8), b0 = *(const uint4*)(ptr + 16), b1 = *(const uint4*)(ptr + 24);
    float x1[16], x2[16];
    x1[0] = bflo(a0.x); x1[1] = bfhi(a0.x); x1[2] = bflo(a0.y); x1[3] = bfhi(a0.y); x1[4] = bflo(a0.z); x1[5] = bfhi(a0.z); x1[6] = bflo(a0.w); x1[7] = bfhi(a0.w);
    x1[8] = bflo(a1.x); x1[9] = bfhi(a1.x); x1[10] = bflo(a1.y); x1[11] = bfhi(a1.y); x1[12] = bflo(a1.z); x1[13] = bfhi(a1.z); x1[14] = bflo(a1.w); x1[15] = bfhi(a1.w);
    x2[0] = bflo(b0.x); x2[1] = bfhi(b0.x); x2[2] = bflo(b0.y); x2[3] = bfhi(b0.y); x2[4] = bflo(b0.z); x2[5] = bfhi(b0.z); x2[6] = bflo(b0.w); x2[7] = bfhi(b0.w);
    x2[8] = bflo(b1.x); x2[9] = bfhi(b1.x); x2[10] = bflo(b1.y); x2[11] = bfhi(b1.y); x2[12] = bflo(b1.z); x2[13] = bfhi(b1.z); x2[14] = bflo(b1.w); x2[15] = bfhi(b1.w);
    const float qs = isq ? 0.125f * 1.4426950408889634f : 1.f;
    if (a >= CTX) {
      int pos = a - CTX;
      int cidx = half == 0 ? (pos >> 6) : (pos & 63);
#pragma unroll
      for (int f = 0; f < 16; ++f) {
        float cs = tcos[cidx * 16 + f], sn = tsin[cidx * 16 + f];
        float y1 = x1[f] * cs - x2[f] * sn, y2 = x2[f] * cs + x1[f] * sn;
        x1[f] = y1 * qs;
        x2[f] = y2 * qs;
      }
    } else {
#pragma unroll
      for (int f = 0; f < 16; ++f) { x1[f] *= qs; x2[f] *= qs; }
    }
    uint4 o;
    o.x = pack2(x1[0], x1[1]); o.y = pack2(x1[2], x1[3]); o.z = pack2(x1[4], x1[5]); o.w = pack2(x1[6], x1[7]); *(uint4*)ptr = o;
    o.x = pack2(x1[8], x1[9]); o.y = pack2(x1[10], x1[11]); o.z = pack2(x1[12], x1[13]); o.w = pack2(x1[14], x1[15]); *(uint4*)(ptr + 8) = o;
    o.x = pack2(x2[0], x2[1]); o.y = pack2(x2[2], x2[3]); o.z = pack2(x2[4], x2[5]); o.w = pack2(x2[6], x2[7]); *(uint4*)(ptr + 16) = o;
    o.x = pack2(x2[8], x2[9]); o.y = pack2(x2[10], x2[11]); o.z = pack2(x2[12], x2[13]); o.w = pack2(x2[14], x2[15]); *(uint4*)(ptr + 24) = o;
  }
}

__device__ __forceinline__ float shiftmix(const bf* PB, const float* mu, int R, int a, int col) {
  int lo = a < CTX ? 0 : CTX, hi = a < CTX ? CTX : TA;
  float t = bf2f(PB[(size_t)R * 1792 + col]);
  float pv = a > lo ? bf2f(PB[(size_t)(R - 1) * 1792 + col]) : 0.f;
  float nx = a + 1 < hi ? bf2f(PB[(size_t)(R + 1) * 1792 + col]) : 0.f;
  return t + (0.5f * (pv + nx) - t) * mu[col];
}
__device__ __forceinline__ void ph_lw(const P& p) {
  bf* LW = (bf*)(p.ws + OFF_LW);
  const float *w2f = p.in[19], *w2b = p.in[21], *a2 = p.in[23], *g2 = p.in[24];
  for (int i = blockIdx.x * NT + tidx(); i < 512 * 320; i += gridDim.x * NT) {
    int n = i / 320, kk = i - n * 320;
    float v = kk < 64 ? w2f[kk * 512 + n] : kk < 128 ? w2b[(kk - 64) * 512 + n] : kk < 192 ? a2[(kk - 128) * 512 + n] : g2[(kk - 192) * 512 + n];
    LW[i] = f2bf(v);
  }
}
__device__ __forceinline__ float shiftmix_l(const bf* PBs, const float muc, int t, int a, int col) {
  const int lo = a < CTX ? 0 : CTX, hi = a < CTX ? CTX : TA;
  const float x = bf2f(PBs[(t + 1) * 1792 + col]);
  const float pv = a > lo ? bf2f(PBs[t * 1792 + col]) : 0.f;
  const float nx = a + 1 < hi ? bf2f(PBs[(t + 2) * 1792 + col]) : 0.f;
  return x + (0.5f * (pv + nx) - x) * muc;
}
__device__ __forceinline__ void ph_rwkv_prep(const P& p, char* smem) {
  bf* linA = (bf*)smem;
  bf* PBs = linA + 16 * 264;
  const int tid = tidx(), lane = tid & 63, wave = tid >> 6;
  const int l15 = lane & 15, g = lane >> 4;
  const bf* PB = (const bf*)p.out;
  const bf* LW = (const bf*)(p.ws + OFF_LW);
  const float* mu = p.in[17];
  bf* PR = (bf*)(p.ws + OFF_PREP);
  bf* PK = PR + (size_t)RT * 512;
  bf* PV = PK + (size_t)RT * 512;
  bf* PKK = PV + (size_t)RT * 512;
  bf* PKA = PKK + (size_t)RT * 512;
  bf* PLF = PKA + (size_t)RT * 512;
  bf* PLB = PLF + (size_t)RT * 512;
  bf* G = (bf*)(p.ws + OFF_G);
  float* BON = (float*)(p.ws + OFF_BONUS);
  float cw0f[4], cw0b[4], ca0[4], ckk[4], cka[4], crk[4], cmr[4], cmk[4], cmv[4];
#pragma unroll
  for (int nt = 0; nt < 4; ++nt) {
    int c = wave * 64 + nt * 16 + l15;
    cw0f[nt] = p.in[18][c]; cw0b[nt] = p.in[20][c]; ca0[nt] = p.in[22][c]; ckk[nt] = p.in[25][c]; cka[nt] = p.in[26][c]; crk[nt] = p.in[27][c];
    cmr[nt] = mu[c]; cmk[nt] = mu[512 + c]; cmv[nt] = mu[1024 + c];
  }
  for (int unit = blockIdx.x; unit < RT / 16; unit += gridDim.x) {
    const int R0 = unit * 16;
    const int b = R0 / TA, a00 = R0 - b * TA;
    __syncthreads();
    for (int ch = tid; ch < 18 * 224; ch += NT) {
      const int rr = ch / 224, cc = ch - rr * 224;
      const int Rg = R0 - 1 + rr;
      uint4 v = make_uint4(0, 0, 0, 0);
      if (Rg >= 0 && Rg < RT) v = *(const uint4*)(PB + (size_t)Rg * 1792 + cc * 8);
      *(uint4*)(PBs + rr * 1792 + cc * 8) = v;
    }
    __syncthreads();
#pragma unroll
    for (int i = 0; i < 8; ++i) {
      int idx = tid + NT * i;
      int tok = idx >> 8, j = idx & 255;
      float f = shiftmix_l(PBs, mu[1536 + j], tok, a00 + tok, 1536 + j);
      float val = j < 64 ? tanhf(f) : (j < 128 ? f : sigmoidf_(f));
      linA[tok * 264 + j] = f2bf(val);
    }
    __syncthreads();
    f32x4 wf[4], wb[4], aa[4], gg[4];
#pragma unroll
    for (int nt = 0; nt < 4; ++nt) {
      wf[nt] = (f32x4){0.f, 0.f, 0.f, 0.f}; wb[nt] = wf[nt]; aa[nt] = wf[nt]; gg[nt] = wf[nt];
    }
#pragma unroll
    for (int nt = 0; nt < 4; ++nt) {
      const bf* lw = LW + (size_t)(wave * 64 + nt * 16 + l15) * 320 + g * 8;
#pragma unroll
      for (int ks = 0; ks < 2; ++ks) {
        bf16x8 aw = *(const bf16x8*)(linA + l15 * 264 + ks * 32 + g * 8);
        wf[nt] = __builtin_amdgcn_mfma_f32_16x16x32_bf16(aw, *(const bf16x8*)(lw + ks * 32), wf[nt], 0, 0, 0);
        wb[nt] = __builtin_amdgcn_mfma_f32_16x16x32_bf16(aw, *(const bf16x8*)(lw + 64 + ks * 32), wb[nt], 0, 0, 0);
        bf16x8 a_a = *(const bf16x8*)(linA + l15 * 264 + 64 + ks * 32 + g * 8);
        aa[nt] = __builtin_amdgcn_mfma_f32_16x16x32_bf16(a_a, *(const bf16x8*)(lw + 128 + ks * 32), aa[nt], 0, 0, 0);
      }
#pragma unroll
      for (int ks = 0; ks < 4; ++ks) {
        bf16x8 ag = *(const bf16x8*)(linA + l15 * 264 + 128 + ks * 32 + g * 8);
        gg[nt] = __builtin_amdgcn_mfma_f32_16x16x32_bf16(ag, *(const bf16x8*)(lw + 192 + ks * 32), gg[nt], 0, 0, 0);
      }
    }
#pragma unroll
    for (int r = 0; r < 4; ++r) {
      const int t = g * 4 + r;
      const int R = R0 + t, a = a00 + t;
      float fr[4], fv[4], kkv[4], km[4], av[4];
      float n2 = 0.f, bon = 0.f;
#pragma unroll
      for (int nt = 0; nt < 4; ++nt) {
        int c = wave * 64 + nt * 16 + l15;
        fr[nt] = shiftmix_l(PBs, cmr[nt], t, a, c);
        float fk = shiftmix_l(PBs, cmk[nt], t, a, 512 + c);
        fv[nt] = shiftmix_l(PBs, cmv[nt], t, a, 1024 + c);
        av[nt] = sigmoidf_(ca0[nt] + aa[nt][r]);
        kkv[nt] = fk * ckk[nt];
        n2 += kkv[nt] * kkv[nt];
        km[nt] = fk * (1.f + (av[nt] - 1.f) * cka[nt]);
        bon += fr[nt] * km[nt] * crk[nt];
      }
      n2 = red16(n2);
      bon = red16(bon);
      float rn = 1.f / fmaxf(sqrtf(n2), 1e-12f);
#pragma unroll
      for (int nt = 0; nt < 4; ++nt) {
        int c = wave * 64 + nt * 16 + l15;
        size_t o = (size_t)R * 512 + c;
        float lwf = -__expf(-softplusf_(-(cw0f[nt] + wf[nt][r])) - 0.5f);
        float lwb = -__expf(-softplusf_(-(cw0b[nt] + wb[nt][r])) - 0.5f);
        float kk = kkv[nt] * rn;
        PR[o] = f2bf(fr[nt]);
        PK[o] = f2bf(km[nt]);
        PV[o] = f2bf(fv[nt]);
        PKK[o] = f2bf(kk);
        PKA[o] = f2bf(kk * av[nt]);
        PLF[o] = f2bf(lwf);
        PLB[o] = f2bf(lwb);
        G[o] = f2bf(gg[nt][r]);
      }
      if (l15 == 0) BON[(size_t)R * 8 + wave] = bon;
    }
  }
}

__device__ __forceinline__ int scan_row(int b, int dir, int s) {
  int a = dir ? (s < CTX ? CTX - 1 - s : TA + CTX - 1 - s) : s;
  return b * TA + a;
}

__device__ __forceinline__ void rwkv_chain(const P& p, int chain, int half, char* smem) {
  const int dir = chain & 1, h = (chain >> 1) & 7, b = chain >> 4;
  float* cR = (float*)smem;
  float* cW = cR + 2048;
  float* cK = cW + 2048;
  float* cKK = cK + 2048;
  float* cKA = cKK + 2048;
  float* cV = cKA + 2048;
  float* yb = cV + 2048;
  const int tid = tidx(), lane = tid & 63, wave = tid >> 6;
  const int l15 = lane & 15, lg = lane >> 4;
  const bf* PR = (const bf*)(p.ws + OFF_PREP);
  const bf* PK = PR + (size_t)RT * 512;
  const bf* PV = PK + (size_t)RT * 512;
  const bf* PKK = PV + (size_t)RT * 512;
  const bf* PKA = PKK + (size_t)RT * 512;
  const bf* PLW = PKA + (size_t)RT * 512 + (size_t)dir * RT * 512;
  bf* Y = (bf*)p.out + (size_t)dir * RT * 512;
  const int st = tid >> 4, c4 = (tid & 15) * 4;
  const int r0 = half < 0 ? wave * 8 + lg * 2 : half * 32 + (wave & 3) * 8 + lg * 2;
  const bool active = half < 0 || wave < 4;
  const bool ywr = half < 0 || ((c4 >> 5) == half);
  float s0[4], s1[4];
#pragma unroll
  for (int j = 0; j < 4; ++j) { s0[j] = 0.f; s1[j] = 0.f; }
  uint2 gR, gW, gK, gV, gKK, gKA;
  {
    size_t o = (size_t)scan_row(b, dir, st) * 512 + h * 64 + c4;
    gR = *(const uint2*)(PR + o); gW = *(const uint2*)(PLW + o); gK = *(const uint2*)(PK + o);
    gV = *(const uint2*)(PV + o); gKK = *(const uint2*)(PKK + o); gKA = *(const uint2*)(PKA + o);
  }
  const int NCH = TA / 32;
  for (int ch = 0; ch <= NCH; ++ch) {
    __syncthreads();
    if (ch > 0 && ywr) {
      float4 y4 = *(const float4*)(yb + st * 64 + c4);
      uint2 o2;
      o2.x = pack2(y4.x, y4.y);
      o2.y = pack2(y4.z, y4.w);
      *(uint2*)(Y + (size_t)scan_row(b, dir, (ch - 1) * 32 + st) * 512 + h * 64 + c4) = o2;
    }
    if (ch == NCH) break;
    {
      int o = st * 64 + c4;
      *(float4*)(cR + o) = make_float4(bflo(gR.x), bfhi(gR.x), bflo(gR.y), bfhi(gR.y));
      *(float4*)(cW + o) = make_float4(__expf(bflo(gW.x)), __expf(bfhi(gW.x)), __expf(bflo(gW.y)), __expf(bfhi(gW.y)));
      *(float4*)(cK + o) = make_float4(bflo(gK.x), bfhi(gK.x), bflo(gK.y), bfhi(gK.y));
      *(float4*)(cV + o) = make_float4(bflo(gV.x), bfhi(gV.x), bflo(gV.y), bfhi(gV.y));
      *(float4*)(cKK + o) = make_float4(bflo(gKK.x), bfhi(gKK.x), bflo(gKK.y), bfhi(gKK.y));
      *(float4*)(cKA + o) = make_float4(bflo(gKA.x), bfhi(gKA.x), bflo(gKA.y), bfhi(gKA.y));
    }
    __syncthreads();
    if (ch + 1 < NCH) {
      size_t o = (size_t)scan_row(b, dir, (ch + 1) * 32 + st) * 512 + h * 64 + c4;
      gR = *(const uint2*)(PR + o); gW = *(const uint2*)(PLW + o); gK = *(const uint2*)(PK + o);
      gV = *(const uint2*)(PV + o); gKK = *(const uint2*)(PKK + o); gKA = *(const uint2*)(PKA + o);
    }
    if (active) {
      float4 kk4 = *(const float4*)(cKK + l15 * 4);
      float4 w4 = *(const float4*)(cW + l15 * 4);
      float4 k4 = *(const float4*)(cK + l15 * 4);
      float4 ka4 = *(const float4*)(cKA + l15 * 4);
      float4 r4 = *(const float4*)(cR + l15 * 4);
      float2 v2 = *(const float2*)(cV + r0);
#pragma unroll 2
      for (int t = 0; t < 32; ++t) {
        const int tn = (t + 1) & 31;
        float4 nkk4 = *(const float4*)(cKK + tn * 64 + l15 * 4);
        float4 nw4 = *(const float4*)(cW + tn * 64 + l15 * 4);
        float4 nk4 = *(const float4*)(cK + tn * 64 + l15 * 4);
        float4 nka4 = *(const float4*)(cKA + tn * 64 + l15 * 4);
        float4 nr4 = *(const float4*)(cR + tn * 64 + l15 * 4);
        float2 nv2 = *(const float2*)(cV + tn * 64 + r0);
        float sa0 = (s0[0] * kk4.x + s0[1] * kk4.y) + (s0[2] * kk4.z + s0[3] * kk4.w);
        float sa1 = (s1[0] * kk4.x + s1[1] * kk4.y) + (s1[2] * kk4.z + s1[3] * kk4.w);
        float p00 = s0[0] * w4.x + v2.x * k4.x, p01 = s0[1] * w4.y + v2.x * k4.y, p02 = s0[2] * w4.z + v2.x * k4.z, p03 = s0[3] * w4.w + v2.x * k4.w;
        float p10 = s1[0] * w4.x + v2.y * k4.x, p11 = s1[1] * w4.y + v2.y * k4.y, p12 = s1[2] * w4.z + v2.y * k4.z, p13 = s1[3] * w4.w + v2.y * k4.w;
        sa0 = red16(sa0);
        sa1 = red16(sa1);
        s0[0] = p00 - sa0 * ka4.x; s0[1] = p01 - sa0 * ka4.y; s0[2] = p02 - sa0 * ka4.z; s0[3] = p03 - sa0 * ka4.w;
        s1[0] = p10 - sa1 * ka4.x; s1[1] = p11 - sa1 * ka4.y; s1[2] = p12 - sa1 * ka4.z; s1[3] = p13 - sa1 * ka4.w;
        float y0 = (s0[0] * r4.x + s0[1] * r4.y) + (s0[2] * r4.z + s0[3] * r4.w);
        float y1 = (s1[0] * r4.x + s1[1] * r4.y) + (s1[2] * r4.z + s1[3] * r4.w);
        y0 = red16(y0);
        y1 = red16(y1);
        if (l15 == 0) *(float2*)(yb + t * 64 + r0) = make_float2(y0, y1);
        kk4 = nkk4; w4 = nw4; k4 = nk4; ka4 = nka4; r4 = nr4; v2 = nv2;
      }
    }
  }
}


template <int OFFB>
__device__ __forceinline__ bf16x8 tr_pair(const bf* pp) {
  typedef short s16x4_ __attribute__((ext_vector_type(4)));
  s16x4_ v0, v1;
  unsigned addr = (unsigned)(size_t)(__attribute__((address_space(3))) const void*)pp;
  asm volatile("s_waitcnt lgkmcnt(0)\n\tds_read_b64_tr_b16 %0, %2\n\tds_read_b64_tr_b16 %1, %2 offset:%3\n\ts_waitcnt lgkmcnt(0)" : "=&v"(v0), "=&v"(v1) : "v"(addr), "n"(OFFB) : "memory");
  return __builtin_shufflevector(v0, v1, 0, 1, 2, 3, 4, 5, 6, 7);
}
template <int STRB, int OFF2B>
__device__ __forceinline__ void tr_quad(const bf* pp, bf16x8& f0, bf16x8& f1, bf16x8& f2, bf16x8& f3) {
  typedef short s16x4_ __attribute__((ext_vector_type(4)));
  s16x4_ a0, b0, a1, b1, a2, b2, a3, b3;
  unsigned addr = (unsigned)(size_t)(__attribute__((address_space(3))) const void*)pp;
  asm volatile(
      "s_waitcnt lgkmcnt(0)\n\t"
      "ds_read_b64_tr_b16 %0, %8\n\t"
      "ds_read_b64_tr_b16 %1, %8 offset:%9\n\t"
      "ds_read_b64_tr_b16 %2, %8 offset:%10\n\t"
      "ds_read_b64_tr_b16 %3, %8 offset:%11\n\t"
      "ds_read_b64_tr_b16 %4, %8 offset:%12\n\t"
      "ds_read_b64_tr_b16 %5, %8 offset:%13\n\t"
      "ds_read_b64_tr_b16 %6, %8 offset:%14\n\t"
      "ds_read_b64_tr_b16 %7, %8 offset:%15\n\t"
      "s_waitcnt lgkmcnt(0)"
      : "=&v"(a0), "=&v"(b0), "=&v"(a1), "=&v"(b1), "=&v"(a2), "=&v"(b2), "=&v"(a3), "=&v"(b3)
      : "v"(addr), "n"(OFF2B), "n"(STRB), "n"(STRB + OFF2B), "n"(2 * STRB), "n"(2 * STRB + OFF2B), "n"(3 * STRB), "n"(3 * STRB + OFF2B)
      : "memory");
  f0 = __builtin_shufflevector(a0, b0, 0, 1, 2, 3, 4, 5, 6, 7);
  f1 = __builtin_shufflevector(a1, b1, 0, 1, 2, 3, 4, 5, 6, 7);
  f2 = __builtin_shufflevector(a2, b2, 0, 1, 2, 3, 4, 5, 6, 7);
  f3 = __builtin_shufflevector(a3, b3, 0, 1, 2, 3, 4, 5, 6, 7);
}
template <int STRB, int OFF2B>
__device__ __forceinline__ void tr_dual(const bf* pp, bf16x8& f0, bf16x8& f1) {
  typedef short s16x4_ __attribute__((ext_vector_type(4)));
  s16x4_ a0, b0, a1, b1;
  unsigned addr = (unsigned)(size_t)(__attribute__((address_space(3))) const void*)pp;
  asm volatile(
      "s_waitcnt lgkmcnt(0)\n\t"
      "ds_read_b64_tr_b16 %0, %4\n\t"
      "ds_read_b64_tr_b16 %1, %4 offset:%5\n\t"
      "ds_read_b64_tr_b16 %2, %4 offset:%6\n\t"
      "ds_read_b64_tr_b16 %3, %4 offset:%7\n\t"
      "s_waitcnt lgkmcnt(0)"
      : "=&v"(a0), "=&v"(b0), "=&v"(a1), "=&v"(b1)
      : "v"(addr), "n"(OFF2B), "n"(STRB), "n"(STRB + OFF2B)
      : "memory");
  f0 = __builtin_shufflevector(a0, b0, 0, 1, 2, 3, 4, 5, 6, 7);
  f1 = __builtin_shufflevector(a1, b1, 0, 1, 2, 3, 4, 5, 6, 7);
}
__device__ __forceinline__ const bf* trbase(const bf* img, int ld, int r0, int c0, int lane) { return img + (r0 + ((lane & 15) >> 2)) * ld + c0 + (lane & 3) * 4; }
typedef short s16x4 __attribute__((ext_vector_type(4)));
__device__ __forceinline__ void attn_unit(const P& p, int u, char* smem, float lam) {
  bf* Ks = (bf*)smem;
  bf* Vs = Ks + 64 * 136;
  int b, h, nkeys, qa0;
  if (u < 1024) { b = u >> 7; h = (u >> 5) & 3; nkeys = TA; qa0 = CTX + (u & 31) * 128; }
  else { int v = u - 1024; b = v >> 3; h = (v >> 1) & 3; nkeys = CTX; qa0 = (v & 1) * 128; }
  const bf* QKV = (const bf*)(p.ws + OFF_QKV);
  const int tid = tidx(), lane = tid & 63, wave = tid >> 6;
  const int l15 = lane & 15, lg = lane >> 4;
  const size_t rowbase = (size_t)b * TA;
  bf16x8 qf[2][2];
  {
    size_t Rq = rowbase + qa0 + wave * 16 + l15;
#pragma unroll
    for (int m = 0; m < 2; ++m)
#pragma unroll
      for (int ks = 0; ks < 2; ++ks) qf[m][ks] = *(const bf16x8*)(QKV + Rq * 1536 + h * 128 + m * 64 + ks * 32 + lg * 8);
  }
  f32x4 oacc[2][8];
#pragma unroll
  for (int m = 0; m < 2; ++m)
#pragma unroll
    for (int n = 0; n < 8; ++n) oacc[m][n] = (f32x4){0.f, 0.f, 0.f, 0.f};
  float mrun[2] = {-INFINITY, -INFINITY}, lrun[2] = {0.f, 0.f};
  const int sr = tid >> 4, scc = tid & 15;
  const bf* gsrc = QKV + (rowbase + sr) * 1536 + h * 128 + scc * 8;
  uint4 pk0 = *(const uint4*)(gsrc + 512), pv0 = *(const uint4*)(gsrc + 1024);
  uint4 pk1 = *(const uint4*)(gsrc + (size_t)32 * 1536 + 512), pv1 = *(const uint4*)(gsrc + (size_t)32 * 1536 + 1024);
  const int vrow = lg * 4 + (l15 >> 2), vcol = (lane & 3) * 4;
  for (int k0 = 0; k0 < nkeys; k0 += 64) {
    __syncthreads();
    *(uint4*)(Ks + sr * 136 + scc * 8) = pk0;
    *(uint4*)(Ks + (sr + 32) * 136 + scc * 8) = pk1;
    *(uint4*)(Vs + sr * 144 + scc * 8) = pv0;
    *(uint4*)(Vs + (sr + 32) * 144 + scc * 8) = pv1;
    __syncthreads();
    if (k0 + 64 < nkeys) {
      const bf* g2 = gsrc + (size_t)(k0 + 64) * 1536;
      pk0 = *(const uint4*)(g2 + 512); pv0 = *(const uint4*)(g2 + 1024);
      pk1 = *(const uint4*)(g2 + (size_t)32 * 1536 + 512); pv1 = *(const uint4*)(g2 + (size_t)32 * 1536 + 1024);
    }
    bf16x8 pf[2][2];
#pragma unroll
    for (int m = 0; m < 2; ++m) {
      f32x4 s[4];
#pragma unroll
      for (int kt = 0; kt < 4; ++kt) s[kt] = (f32x4){0.f, 0.f, 0.f, 0.f};
#pragma unroll
      for (int ks = 0; ks < 2; ++ks)
#pragma unroll
        for (int kt = 0; kt < 4; ++kt) {
          bf16x8 a = *(const bf16x8*)(Ks + (kt * 16 + l15) * 136 + m * 64 + ks * 32 + lg * 8);
          s[kt] = __builtin_amdgcn_mfma_f32_16x16x32_bf16(a, qf[m][ks], s[kt], 0, 0, 0);
        }
      float mx = fmaxf(fmaxf(s[0][0], s[0][1]), fmaxf(s[0][2], s[0][3]));
#pragma unroll
      for (int kt = 1; kt < 4; ++kt) mx = fmaxf(mx, fmaxf(fmaxf(s[kt][0], s[kt][1]), fmaxf(s[kt][2], s[kt][3])));
      if (__any(mx > mrun[m] + 11.f)) {
        mx = fmaxf(mx, __shfl_xor(mx, 16));
        mx = fmaxf(mx, __shfl_xor(mx, 32));
        float mnew = fmaxf(mrun[m], mx);
        float alpha = __builtin_amdgcn_exp2f(mrun[m] - mnew);
        mrun[m] = mnew;
        lrun[m] *= alpha;
        float al[4];
#pragma unroll
        for (int r = 0; r < 4; ++r) al[r] = __shfl(alpha, lg * 4 + r);
#pragma unroll
        for (int n = 0; n < 8; ++n)
#pragma unroll
          for (int r = 0; r < 4; ++r) oacc[m][n][r] *= al[r];
      }
      const float mcur = mrun[m];
      float ps = 0.f;
#pragma unroll
      for (int kt = 0; kt < 4; ++kt)
#pragma unroll
        for (int r = 0; r < 4; ++r) {
          float e = __builtin_amdgcn_exp2f(s[kt][r] - mcur);
          s[kt][r] = e;
          ps += e;
        }
      lrun[m] += ps;
#pragma unroll
      for (int si = 0; si < 2; ++si) {
        i32x4 t;
        t[0] = (int)pack2(s[2 * si][0], s[2 * si][1]);
        t[1] = (int)pack2(s[2 * si][2], s[2 * si][3]);
        t[2] = (int)pack2(s[2 * si + 1][0], s[2 * si + 1][1]);
        t[3] = (int)pack2(s[2 * si + 1][2], s[2 * si + 1][3]);
        pf[m][si] = __builtin_bit_cast(bf16x8, t);
      }
    }
#pragma unroll
    for (int si = 0; si < 2; ++si)
#pragma unroll
      for (int nq = 0; nq < 2; ++nq) {
        bf16x8 bv[4];
        tr_quad<32, 16 * 144 * 2>(Vs + (si * 32 + vrow) * 144 + nq * 64 + vcol, bv[0], bv[1], bv[2], bv[3]);
#pragma unroll
        for (int n4 = 0; n4 < 4; ++n4) {
          oacc[0][nq * 4 + n4] = __builtin_amdgcn_mfma_f32_16x16x32_bf16(pf[0][si], bv[n4], oacc[0][nq * 4 + n4], 0, 0, 0);
          oacc[1][nq * 4 + n4] = __builtin_amdgcn_mfma_f32_16x16x32_bf16(pf[1][si], bv[n4], oacc[1][nq * 4 + n4], 0, 0, 0);
        }
      }
  }
  float inv[2];
#pragma unroll
  for (int m = 0; m < 2; ++m) {
    float l = lrun[m];
    l += __shfl_xor(l, 16);
    l += __shfl_xor(l, 32);
    inv[m] = 1.f / l;
  }
  float i1[4], i2[4];
#pragma unroll
  for (int r = 0; r < 4; ++r) { i1[r] = __shfl(inv[0], lg * 4 + r); i2[r] = __shfl(inv[1], lg * 4 + r); }
  float ss[4] = {0.f, 0.f, 0.f, 0.f};
#pragma unroll
  for (int n = 0; n < 8; ++n)
#pragma unroll
    for (int r = 0; r < 4; ++r) {
      float o = oacc[0][n][r] * i1[r] - lam * (oacc[1][n][r] * i2[r]);
      oacc[0][n][r] = o;
      ss[r] += o * o;
    }
  const float* subln = p.in[16];
  bf* O = (bf*)(p.ws + OFF_HO);
#pragma unroll
  for (int r = 0; r < 4; ++r) {
    float t = red16(ss[r]);
    float scl = rsqrtf(t * (1.f / 128.f) + 1e-5f) * 0.8f;
    size_t Ro = rowbase + qa0 + wave * 16 + lg * 4 + r;
#pragma unroll
    for (int n = 0; n < 8; ++n) O[Ro * 1024 + h * 128 + n * 16 + l15] = f2bf(oacc[0][n][r] * scl * subln[n * 16 + l15]);
  }
}

__device__ __forceinline__ void rwkv_chain2(const P& p, int chain, char* smem);
__device__ __forceinline__ void ph_mix0(const P& p, char* smem) {
  volatile int* s_unitp = (volatile int*)(smem + 131072);
  for (int u = blockIdx.x; u < 128; u += gridDim.x) rwkv_chain2(p, u, smem);
#ifdef PROBE_RWKV
  __syncthreads();
  for (int u = blockIdx.x; u < 256; u += gridDim.x) rwkv_chain(p, u & 127, u >> 7, smem);
#endif
  float d1 = 0.f, d2 = 0.f;
  for (int i = 0; i < 64; ++i) { d1 += p.in[12][i] * p.in[13][i]; d2 += p.in[14][i] * p.in[15][i]; }
  float lam = expf(d1) - expf(d2) + 0.2f;
  int* cnt = (int*)(p.ws + OFF_CNT);
  while (true) {
    __syncthreads();
    if (tidx() == 0) *s_unitp = atomicAdd(cnt, 1);
    __syncthreads();
    int u = *s_unitp;
    if (u >= 1088) break;
    attn_unit(p, u, smem, lam);
  }
#ifdef PROBE_ATTN
  while (true) {
    __syncthreads();
    if (tidx() == 0) *s_unitp = atomicAdd(cnt + 1, 1);
    __syncthreads();
    int u = *s_unitp;
    if (u >= 1088) break;
    attn_unit(p, u, smem, lam);
  }
#endif
}

__device__ __forceinline__ void ph_rwkv_post(const P& p) {
  const int tid = tidx(), wave = tid >> 6;
  const bf* YF = (const bf*)p.out;
  const bf* YB = YF + (size_t)RT * 512;
  const bf* PV = (const bf*)(p.ws + OFF_PREP) + (size_t)2 * RT * 512;
  const bf* G = (const bf*)(p.ws + OFF_G);
  const float* BON = (const float*)(p.ws + OFF_BONUS);
  bf* O = (bf*)(p.ws + OFF_HO);
  const float lw = p.in[28][tid], lb = p.in[29][tid];
  for (int R0 = blockIdx.x * 4; R0 < RT; R0 += gridDim.x * 4) {
    float yf[4], yb4[4], pv[4], gg[4], bn[4];
#pragma unroll
    for (int i = 0; i < 4; ++i) {
      size_t o = (size_t)(R0 + i) * 512 + tid;
      yf[i] = bf2f(YF[o]); yb4[i] = bf2f(YB[o]); pv[i] = bf2f(PV[o]); gg[i] = bf2f(G[o]); bn[i] = BON[(size_t)(R0 + i) * 8 + wave];
    }
#pragma unroll
    for (int i = 0; i < 4; ++i) {
      float y = yf[i] + yb4[i];
      float mean = wave_sum(y) * (1.f / 64.f);
      float d = y - mean;
      float var = wave_sum(d * d) * (1.f / 64.f);
      float yn = d * rsqrtf(var + 64e-5f) * lw + lb;
      float outv = (yn + bn[i] * pv[i]) * gg[i];
      O[(size_t)(R0 + i) * 1024 + 512 + tid] = f2bf(outv);
    }
  }
}

__device__ __forceinline__ void ph_conv(const P& p) {
  const bf* XR = (const bf*)(p.ws + OFF_XRAW);
  bf* XO = (bf*)(p.ws + OFF_XBC);
  const float* cw = p.in[38];
  const float* cb = p.in[39];
  for (size_t it = (size_t)blockIdx.x * NT + tidx(); it < (size_t)RT * 128; it += (size_t)gridDim.x * NT) {
    int R = (int)(it >> 7), c8 = (int)(it & 127) * 8;
    int b = R / TA, a = R - b * TA;
    int lo = a < CTX ? 0 : CTX, hi = a < CTX ? CTX : TA;
    float acc[8];
#pragma unroll
    for (int e = 0; e < 8; ++e) acc[e] = cb[c8 + e];
#pragma unroll
    for (int j = 0; j < 5; ++j) {
      int aj = a + j - 2;
      if (aj >= lo && aj < hi) {
        uint4 v = *(const uint4*)(XR + (size_t)(R + j - 2) * 1024 + c8);
        const float* w = cw + j * 1024 + c8;
        acc[0] += w[0] * bflo(v.x); acc[1] += w[1] * bfhi(v.x);
        acc[2] += w[2] * bflo(v.y); acc[3] += w[3] * bfhi(v.y);
        acc[4] += w[4] * bflo(v.z); acc[5] += w[5] * bfhi(v.z);
        acc[6] += w[6] * bflo(v.w); acc[7] += w[7] * bfhi(v.w);
      }
    }
    uint4 o;
    o.x = pack2(siluf_(acc[0]), siluf_(acc[1]));
    o.y = pack2(siluf_(acc[2]), siluf_(acc[3]));
    o.z = pack2(siluf_(acc[4]), siluf_(acc[5]));
    o.w = pack2(siluf_(acc[6]), siluf_(acc[7]));
    *(uint4*)(XO + (size_t)R * 1024 + c8) = o;
  }
}

__device__ __forceinline__ void ssd_chain(const P& p, int chain, char* smem) {
  const int dir = chain & 1, hh = (chain >> 1) & 7, b = chain >> 4;
  const int grp = hh >> 2;
  float* cB = (float*)smem;
  float* cC = cB + 4096;
  float* cX = cC + 4096;
  float* cDA = cX + 2048;
  float* yb = cDA + 32;
  const int tid = tidx(), lane = tid & 63, wave = tid >> 6;
  const int l15 = lane & 15, lg = lane >> 4;
  const bf* XBC = (const bf*)(p.ws + OFF_XBC);
  const float* DTR = (const float*)(p.ws + OFF_DTRAW);
  bf* Y = (bf*)(p.ws + OFF_XRAW) + (size_t)dir * RT * 512;
  const float dtb = p.in[dir ? 42 : 40][hh];
  const float Aneg = -expf(p.in[dir ? 43 : 41][hh]);
  const int st = tid >> 4, q = tid & 15;
  const int r0 = wave * 8 + lg * 2;
  float s0[8], s1[8];
#pragma unroll
  for (int j = 0; j < 8; ++j) { s0[j] = 0.f; s1[j] = 0.f; }
  uint4 gB, gC;
  uint2 gX;
  float gD;
  {
    size_t R = (size_t)scan_row(b, dir, st);
    gB = *(const uint4*)(XBC + R * 1024 + 512 + grp * 128 + q * 8);
    gC = *(const uint4*)(XBC + R * 1024 + 768 + grp * 128 + q * 8);
    gX = *(const uint2*)(XBC + R * 1024 + hh * 64 + q * 4);
    gD = DTR[R * 16 + dir * 8 + hh];
  }
  const int NCH = TA / 32;
  for (int ch = 0; ch <= NCH; ++ch) {
    __syncthreads();
    if (ch > 0) {
      float4 y4 = *(const float4*)(yb + st * 64 + q * 4);
      uint2 o2;
      o2.x = pack2(y4.x, y4.y);
      o2.y = pack2(y4.z, y4.w);
      *(uint2*)(Y + (size_t)scan_row(b, dir, (ch - 1) * 32 + st) * 512 + hh * 64 + q * 4) = o2;
    }
    if (ch == NCH) break;
    {
      float dt = softplusf_(gD + dtb);
      float dA = expf(dt * Aneg);
      float* d = cB + st * 128 + q * 8;
      *(float4*)d = make_float4(bflo(gB.x), bfhi(gB.x), bflo(gB.y), bfhi(gB.y));
      *(float4*)(d + 4) = make_float4(bflo(gB.z), bfhi(gB.z), bflo(gB.w), bfhi(gB.w));
      d = cC + st * 128 + q * 8;
      *(float4*)d = make_float4(bflo(gC.x), bfhi(gC.x), bflo(gC.y), bfhi(gC.y));
      *(float4*)(d + 4) = make_float4(bflo(gC.z), bfhi(gC.z), bflo(gC.w), bfhi(gC.w));
      *(float4*)(cX + st * 64 + q * 4) = make_float4(bflo(gX.x) * dt, bfhi(gX.x) * dt, bflo(gX.y) * dt, bfhi(gX.y) * dt);
      if (q == 0) cDA[st] = dA;
    }
    __syncthreads();
    if (ch + 1 < NCH) {
      size_t R = (size_t)scan_row(b, dir, (ch + 1) * 32 + st);
      gB = *(const uint4*)(XBC + R * 1024 + 512 + grp * 128 + q * 8);
      gC = *(const uint4*)(XBC + R * 1024 + 768 + grp * 128 + q * 8);
      gX = *(const uint2*)(XBC + R * 1024 + hh * 64 + q * 4);
      gD = DTR[R * 16 + dir * 8 + hh];
    }
#pragma unroll 4
    for (int t = 0; t < 32; ++t) {
      float4 b0 = *(const float4*)(cB + t * 128 + l15 * 8);
      float4 b1 = *(const float4*)(cB + t * 128 + l15 * 8 + 4);
      float4 c0 = *(const float4*)(cC + t * 128 + l15 * 8);
      float4 c1 = *(const float4*)(cC + t * 128 + l15 * 8 + 4);
      float2 x2 = *(const float2*)(cX + t * 64 + r0);
      float dA = cDA[t];
      s0[0] = s0[0] * dA + x2.x * b0.x; s0[1] = s0[1] * dA + x2.x * b0.y; s0[2] = s0[2] * dA + x2.x * b0.z; s0[3] = s0[3] * dA + x2.x * b0.w;
      s0[4] = s0[4] * dA + x2.x * b1.x; s0[5] = s0[5] * dA + x2.x * b1.y; s0[6] = s0[6] * dA + x2.x * b1.z; s0[7] = s0[7] * dA + x2.x * b1.w;
      s1[0] = s1[0] * dA + x2.y * b0.x; s1[1] = s1[1] * dA + x2.y * b0.y; s1[2] = s1[2] * dA + x2.y * b0.z; s1[3] = s1[3] * dA + x2.y * b0.w;
      s1[4] = s1[4] * dA + x2.y * b1.x; s1[5] = s1[5] * dA + x2.y * b1.y; s1[6] = s1[6] * dA + x2.y * b1.z; s1[7] = s1[7] * dA + x2.y * b1.w;
      float y0 = s0[0] * c0.x + s0[1] * c0.y + s0[2] * c0.z + s0[3] * c0.w + s0[4] * c1.x + s0[5] * c1.y + s0[6] * c1.z + s0[7] * c1.w;
      float y1 = s1[0] * c0.x + s1[1] * c0.y + s1[2] * c0.z + s1[3] * c0.w + s1[4] * c1.x + s1[5] * c1.y + s1[6] * c1.z + s1[7] * c1.w;
      y0 = red16(y0);
      y1 = red16(y1);
      if (l15 == 0) *(float2*)(yb + t * 64 + r0) = make_float2(y0, y1);
    }
  }
}

__device__ __forceinline__ void gla_chain(const P& p, int chain, char* smem) {
  const int dir = chain & 1, h = (chain >> 1) & 3, b = chain >> 3;
  float* cQ = (float*)smem;
  float* cK = cQ + 2048;
  float* cD = cK + 2048;
  float* cV = cD + 2048;
  float* yb = cV + 4096;
  float* up = yb + 4096;
  float* gbias = up + 1024;
  const int tid = tidx(), lane = tid & 63, wave = tid >> 6;
  const int l15 = lane & 15, lg = lane >> 4;
  const bf* P1 = (const bf*)(p.ws + OFF_P1C);
  bf* Y = (bf*)(p.ws + OFF_GY) + (size_t)dir * RT * 512;
  const float* gup = p.in[dir ? 48 : 46];
  const float* gb = p.in[dir ? 49 : 47];
  __syncthreads();
  for (int i = tid; i < 1024; i += NT) up[i] = gup[(i >> 6) * 256 + h * 64 + (i & 63)];
  if (tid < 64) gbias[tid] = gb[h * 64 + tid];
  const int st = tid >> 4, q = tid & 15;
  const int r0 = wave * 16 + lg * 4;
  float s[4][4];
#pragma unroll
  for (int r = 0; r < 4; ++r)
#pragma unroll
    for (int j = 0; j < 4; ++j) s[r][j] = 0.f;
  uint2 gQ, gK;
  uint4 gV, gG0, gG1;
  {
    const bf* row = P1 + (size_t)scan_row(b, dir, st) * 2080;
    gQ = *(const uint2*)(row + 528 + h * 64 + q * 4);
    gK = *(const uint2*)(row + 784 + h * 64 + q * 4);
    gV = *(const uint4*)(row + 1040 + h * 128 + q * 8);
    gG0 = *(const uint4*)(row + 2064);
    gG1 = *(const uint4*)(row + 2072);
  }
  const int NCH = TA / 32;
  for (int ch = 0; ch <= NCH; ++ch) {
    __syncthreads();
    if (ch > 0) {
      float4 ya = *(const float4*)(yb + st * 128 + q * 8);
      float4 yc = *(const float4*)(yb + st * 128 + q * 8 + 4);
      uint4 o4;
      o4.x = pack2(ya.x, ya.y); o4.y = pack2(ya.z, ya.w); o4.z = pack2(yc.x, yc.y); o4.w = pack2(yc.z, yc.w);
      *(uint4*)(Y + (size_t)scan_row(b, dir, (ch - 1) * 32 + st) * 512 + h * 128 + q * 8) = o4;
    }
    if (ch == NCH) break;
    {
      float gd[16];
      gd[0] = bflo(gG0.x); gd[1] = bfhi(gG0.x); gd[2] = bflo(gG0.y); gd[3] = bfhi(gG0.y);
      gd[4] = bflo(gG0.z); gd[5] = bfhi(gG0.z); gd[6] = bflo(gG0.w); gd[7] = bfhi(gG0.w);
      gd[8] = bflo(gG1.x); gd[9] = bfhi(gG1.x); gd[10] = bflo(gG1.y); gd[11] = bfhi(gG1.y);
      gd[12] = bflo(gG1.z); gd[13] = bfhi(gG1.z); gd[14] = bflo(gG1.w); gd[15] = bfhi(gG1.w);
      float4 z = *(const float4*)(gbias + q * 4);
#pragma unroll
      for (int i = 0; i < 16; ++i) {
        float4 u4 = *(const float4*)(up + i * 64 + q * 4);
        z.x += gd[i] * u4.x; z.y += gd[i] * u4.y; z.z += gd[i] * u4.z; z.w += gd[i] * u4.w;
      }
      float4 dd;
      dd.x = expf(-softplusf_(-z.x) * (1.f / 16.f));
      dd.y = expf(-softplusf_(-z.y) * (1.f / 16.f));
      dd.z = expf(-softplusf_(-z.z) * (1.f / 16.f));
      dd.w = expf(-softplusf_(-z.w) * (1.f / 16.f));
      *(float4*)(cD + st * 64 + q * 4) = dd;
      *(float4*)(cQ + st * 64 + q * 4) = make_float4(bflo(gQ.x) * 0.125f, bfhi(gQ.x) * 0.125f, bflo(gQ.y) * 0.125f, bfhi(gQ.y) * 0.125f);
      *(float4*)(cK + st * 64 + q * 4) = make_float4(bflo(gK.x), bfhi(gK.x), bflo(gK.y), bfhi(gK.y));
      float* d = cV + st * 128 + q * 8;
      *(float4*)d = make_float4(bflo(gV.x), bfhi(gV.x), bflo(gV.y), bfhi(gV.y));
      *(float4*)(d + 4) = make_float4(bflo(gV.z), bfhi(gV.z), bflo(gV.w), bfhi(gV.w));
    }
    __syncthreads();
    if (ch + 1 < NCH) {
      const bf* row = P1 + (size_t)scan_row(b, dir, (ch + 1) * 32 + st) * 2080;
      gQ = *(const uint2*)(row + 528 + h * 64 + q * 4);
      gK = *(const uint2*)(row + 784 + h * 64 + q * 4);
      gV = *(const uint4*)(row + 1040 + h * 128 + q * 8);
      gG0 = *(const uint4*)(row + 2064);
      gG1 = *(const uint4*)(row + 2072);
    }
#pragma unroll 4
    for (int t = 0; t < 32; ++t) {
      float4 q4 = *(const float4*)(cQ + t * 64 + l15 * 4);
      float4 k4 = *(const float4*)(cK + t * 64 + l15 * 4);
      float4 d4 = *(const float4*)(cD + t * 64 + l15 * 4);
      float4 v4 = *(const float4*)(cV + t * 128 + r0);
      float vv[4] = {v4.x, v4.y, v4.z, v4.w};
      float yy[4];
#pragma unroll
      for (int r = 0; r < 4; ++r) {
        s[r][0] = s[r][0] * d4.x + k4.x * vv[r];
        s[r][1] = s[r][1] * d4.y + k4.y * vv[r];
        s[r][2] = s[r][2] * d4.z + k4.z * vv[r];
        s[r][3] = s[r][3] * d4.w + k4.w * vv[r];
        yy[r] = red16(s[r][0] * q4.x + s[r][1] * q4.y + s[r][2] * q4.z + s[r][3] * q4.w);
      }
      if (l15 == 0) *(float4*)(yb + t * 128 + r0) = make_float4(yy[0], yy[1], yy[2], yy[3]);
    }
  }
}

typedef __attribute__((address_space(3))) s16x4* lds_s16x4p;
template <int LD>
__device__ __forceinline__ bf16x8 trfrag_t(const bf* img, int r0, int c0, int lane) {
  const bf* pp = img + (r0 + ((lane & 15) >> 2)) * LD + c0 + (lane & 3) * 4;
  return tr_pair<4 * LD * 2>(pp);
}
#define trfrag(img, ld, r0, c0, lane) trfrag_t<ld>(img, r0, c0, lane)
__device__ __forceinline__ bf16x8 pack8(f32x4 a, f32x4 b) {
  i32x4 t;
  t[0] = (int)pack2(a[0], a[1]); t[1] = (int)pack2(a[2], a[3]); t[2] = (int)pack2(b[0], b[1]); t[3] = (int)pack2(b[2], b[3]);
  return __builtin_bit_cast(bf16x8, t);
}
__device__ __forceinline__ bf16x8 ld2x64(const bf* p0, const bf* p1) {
  uint2 a = *(const uint2*)p0, b2 = *(const uint2*)p1;
  i32x4 t;
  t[0] = (int)a.x; t[1] = (int)a.y; t[2] = (int)b2.x; t[3] = (int)b2.y;
  return __builtin_bit_cast(bf16x8, t);
}

__device__ __forceinline__ void gla_chain2(const P& p, int chain, char* smem) {
  const int dir = chain & 1, h = (chain >> 1) & 3, b = chain >> 3;
  bf* Qs = (bf*)smem;
  bf* Ks = Qs + 64 * 72;
  bf* Vs = Ks + 64 * 72;
  bf* Ps = Vs + 64 * 144;
  bf* GD = Ps + 64 * 72;
  float* segtot = (float*)(GD + 64 * 16);
  float* dS = segtot + 512;
  const int tid = tidx(), lane = tid & 63, wave = tid >> 6;
  const int l15 = lane & 15, g = lane >> 4;
  const bf* P1 = (const bf*)(p.ws + OFF_P1C);
  bf* Y = (bf*)(p.ws + OFF_GY) + (size_t)dir * RT * 512;
  const float* gup = p.in[dir ? 48 : 46];
  const float* gb = p.in[dir ? 49 : 47];
  const int kc = tid & 63, seg = tid >> 6;
  float upr[16];
#pragma unroll
  for (int r = 0; r < 16; ++r) upr[r] = gup[r * 256 + h * 64 + kc];
  const float bk = gb[h * 64 + kc];
  const int stok = tid >> 3, sc8 = (tid & 7) * 8;
  f32x4 S[4];
#pragma unroll
  for (int kt = 0; kt < 4; ++kt) S[kt] = (f32x4){0.f, 0.f, 0.f, 0.f};
  uint4 rq, rk, rv0, rv1, rg = make_uint4(0, 0, 0, 0);
  {
    const bf* row = P1 + (size_t)scan_row(b, dir, stok) * 2080;
    rq = *(const uint4*)(row + 528 + h * 64 + sc8);
    rk = *(const uint4*)(row + 784 + h * 64 + sc8);
    rv0 = *(const uint4*)(row + 1040 + h * 128 + sc8 * 2);
    rv1 = *(const uint4*)(row + 1040 + h * 128 + sc8 * 2 + 8);
    if (tid < 128) rg = *(const uint4*)(P1 + (size_t)scan_row(b, dir, tid >> 1) * 2080 + 2064 + (tid & 1) * 8);
  }
  const int NCH = TA / 64;
  for (int c = 0; c < NCH; ++c) {
    __syncthreads();
    *(uint4*)(Qs + stok * 72 + sc8) = rq;
    *(uint4*)(Ks + stok * 72 + sc8) = rk;
    *(uint4*)(Vs + stok * 144 + sc8 * 2) = rv0;
    *(uint4*)(Vs + stok * 144 + sc8 * 2 + 8) = rv1;
    if (tid < 128) *(uint4*)(GD + (tid >> 1) * 16 + (tid & 1) * 8) = rg;
    __syncthreads();
    if (c + 1 < NCH) {
      const bf* row = P1 + (size_t)scan_row(b, dir, (c + 1) * 64 + stok) * 2080;
      rq = *(const uint4*)(row + 528 + h * 64 + sc8);
      rk = *(const uint4*)(row + 784 + h * 64 + sc8);
      rv0 = *(const uint4*)(row + 1040 + h * 128 + sc8 * 2);
      rv1 = *(const uint4*)(row + 1040 + h * 128 + sc8 * 2 + 8);
      if (tid < 128) rg = *(const uint4*)(P1 + (size_t)scan_row(b, dir, (c + 1) * 64 + (tid >> 1)) * 2080 + 2064 + (tid & 1) * 8);
    }
    float lc[8];
    {
      float run = 0.f;
#pragma unroll
      for (int ii = 0; ii < 8; ++ii) {
        const bf* gr = GD + (seg * 8 + ii) * 16;
        uint4 g0 = *(const uint4*)gr, g1 = *(const uint4*)(gr + 8);
        float z = bk;
        z += bflo(g0.x) * upr[0] + bfhi(g0.x) * upr[1] + bflo(g0.y) * upr[2] + bfhi(g0.y) * upr[3];
        z += bflo(g0.z) * upr[4] + bfhi(g0.z) * upr[5] + bflo(g0.w) * upr[6] + bfhi(g0.w) * upr[7];
        z += bflo(g1.x) * upr[8] + bfhi(g1.x) * upr[9] + bflo(g1.y) * upr[10] + bfhi(g1.y) * upr[11];
        z += bflo(g1.z) * upr[12] + bfhi(g1.z) * upr[13] + bflo(g1.w) * upr[14] + bfhi(g1.w) * upr[15];
        run += -softplusf_(-z) * (1.f / 16.f);
        lc[ii] = run;
      }
      segtot[seg * 64 + kc] = run;
    }
    __syncthreads();
    {
      float off = 0.f, tot = 0.f;
#pragma unroll
      for (int s2 = 0; s2 < 8; ++s2) {
        float t = segtot[s2 * 64 + kc];
        tot += t;
        off += (s2 < seg) ? t : 0.f;
      }
#pragma unroll
      for (int ii = 0; ii < 8; ++ii) {
        int i = seg * 8 + ii;
        float cum = off + lc[ii];
        float qv = bf2f(Qs[i * 72 + kc]), kv = bf2f(Ks[i * 72 + kc]);
        float eq = __expf(cum - tot);
        Qs[i * 72 + kc] = f2bf(qv * 0.125f * eq);
        Ks[i * 72 + kc] = f2bf(kv * __builtin_amdgcn_rcpf(eq));
      }
      if (seg == 0) dS[kc] = __expf(tot);
    }
    __syncthreads();
#pragma unroll
    for (int kt = 0; kt < 4; ++kt) {
      float4 d4 = *(const float4*)(dS + kt * 16 + g * 4);
      S[kt][0] *= d4.x; S[kt][1] *= d4.y; S[kt][2] *= d4.z; S[kt][3] *= d4.w;
    }
#pragma unroll
    for (int tt = 0; tt < 2; ++tt) {
      int idx = wave * 2 + tt, jt = idx >> 2, it = idx & 3;
      f32x4 acc = (f32x4){0.f, 0.f, 0.f, 0.f};
      if (jt <= it) {
#pragma unroll
        for (int ks = 0; ks < 2; ++ks) {
          bf16x8 a = *(const bf16x8*)(Ks + (jt * 16 + l15) * 72 + ks * 32 + g * 8);
          bf16x8 bq = *(const bf16x8*)(Qs + (it * 16 + l15) * 72 + ks * 32 + g * 8);
          acc = __builtin_amdgcn_mfma_f32_16x16x32_bf16(a, bq, acc, 0, 0, 0);
        }
        int i = it * 16 + l15;
#pragma unroll
        for (int r = 0; r < 4; ++r) { int j = jt * 16 + g * 4 + r; acc[r] = (j <= i) ? acc[r] : 0.f; }
      }
      uint2 o;
      o.x = pack2(acc[0], acc[1]);
      o.y = pack2(acc[2], acc[3]);
      *(uint2*)(Ps + (it * 16 + l15) * 72 + jt * 16 + g * 4) = o;
    }
    __syncthreads();
    f32x4 y[4];
#pragma unroll
    for (int it = 0; it < 4; ++it) y[it] = (f32x4){0.f, 0.f, 0.f, 0.f};
#pragma unroll
    for (int s2 = 0; s2 < 2; ++s2) {
      bf16x8 sf = pack8(S[2 * s2], S[2 * s2 + 1]);
#pragma unroll
      for (int it = 0; it < 4; ++it) {
        const bf* qr = Qs + (it * 16 + l15) * 72 + g * 4;
        bf16x8 aq = ld2x64(qr + (2 * s2) * 16, qr + (2 * s2 + 1) * 16);
        y[it] = __builtin_amdgcn_mfma_f32_16x16x32_bf16(aq, sf, y[it], 0, 0, 0);
      }
    }
    {
      bf16x8 vfs[2];
      tr_dual<32 * 144 * 2, 4 * 144 * 2>(trbase(Vs, 144, g * 8, wave * 16, lane), vfs[0], vfs[1]);
#pragma unroll
      for (int s2 = 0; s2 < 2; ++s2) {
#pragma unroll
        for (int it = 0; it < 4; ++it) {
          bf16x8 ap = *(const bf16x8*)(Ps + (it * 16 + l15) * 72 + s2 * 32 + g * 8);
          y[it] = __builtin_amdgcn_mfma_f32_16x16x32_bf16(ap, vfs[s2], y[it], 0, 0, 0);
        }
        bf16x8 ak[4];
        tr_quad<32, 4 * 72 * 2>(trbase(Ks, 72, s2 * 32 + g * 8, 0, lane), ak[0], ak[1], ak[2], ak[3]);
#pragma unroll
        for (int kt = 0; kt < 4; ++kt) S[kt] = __builtin_amdgcn_mfma_f32_16x16x32_bf16(ak[kt], vfs[s2], S[kt], 0, 0, 0);
      }
    }
#pragma unroll
    for (int it = 0; it < 4; ++it)
#pragma unroll
      for (int r = 0; r < 4; ++r) {
        int i = it * 16 + g * 4 + r;
        Y[(size_t)scan_row(b, dir, c * 64 + i) * 512 + h * 128 + wave * 16 + l15] = f2bf(y[it][r]);
      }
  }
}

__device__ __forceinline__ void ssd_chain2(const P& p, int chain, char* smem) {
  const int dir = chain & 1, hh = (chain >> 1) & 7, b = chain >> 4;
  const int grp = hh >> 2;
  bf* Cs = (bf*)smem;
  bf* Bs = Cs + 64 * 136;
  bf* Xs = Bs + 64 * 136;
  bf* Xw = Xs + 64 * 72;
  bf* Ps = Xw + 64 * 72;
  float* dtS = (float*)(Ps + 64 * 72);
  float* cumS = dtS + 64;
  float* ecS = cumS + 64;
  float* totS = ecS + 64;
  const int tid = tidx(), lane = tid & 63, wave = tid >> 6;
  const int l15 = lane & 15, g = lane >> 4;
  const int vt = wave & 3, ih = wave >> 2;
  const bf* XBC = (const bf*)(p.ws + OFF_XBC);
  const float* DTR = (const float*)(p.ws + OFF_DTRAW);
  bf* Y = (bf*)(p.ws + OFF_XRAW) + (size_t)dir * RT * 512;
  const float dtb = p.in[dir ? 42 : 40][hh];
  const float Aneg = -expf(p.in[dir ? 43 : 41][hh]);
  const int stok = tid >> 3, sc = tid & 7;
  f32x4 S[8];
#pragma unroll
  for (int nt = 0; nt < 8; ++nt) S[nt] = (f32x4){0.f, 0.f, 0.f, 0.f};
  uint4 rc0, rc1, rb0, rb1, rx;
  float rdt = 0.f;
  {
    const bf* row = XBC + (size_t)scan_row(b, dir, stok) * 1024;
    rb0 = *(const uint4*)(row + 512 + grp * 128 + sc * 16);
    rb1 = *(const uint4*)(row + 512 + grp * 128 + sc * 16 + 8);
    rc0 = *(const uint4*)(row + 768 + grp * 128 + sc * 16);
    rc1 = *(const uint4*)(row + 768 + grp * 128 + sc * 16 + 8);
    rx = *(const uint4*)(row + hh * 64 + sc * 8);
    if (tid < 64) rdt = DTR[(size_t)scan_row(b, dir, tid) * 16 + dir * 8 + hh];
  }
  const int NCH = TA / 64;
  for (int c = 0; c < NCH; ++c) {
    __syncthreads();
    *(uint4*)(Cs + stok * 136 + sc * 16) = rc0;
    *(uint4*)(Cs + stok * 136 + sc * 16 + 8) = rc1;
    *(uint4*)(Bs + stok * 136 + sc * 16) = rb0;
    *(uint4*)(Bs + stok * 136 + sc * 16 + 8) = rb1;
    if (tid < 64) {
      float dt = softplusf_(rdt + dtb);
      float cum = dt * Aneg;
#pragma unroll
      for (int o = 1; o < 64; o <<= 1) {
        float t = __shfl_up(cum, o);
        if (lane >= o) cum += t;
      }
      float tot = __shfl(cum, 63);
      dtS[lane] = dt;
      cumS[lane] = cum;
      ecS[lane] = __expf(cum);
      if (lane == 0) totS[0] = tot;
    }
    __syncthreads();
    const uint4 cx = rx;
    if (c + 1 < NCH) {
      const bf* row = XBC + (size_t)scan_row(b, dir, (c + 1) * 64 + stok) * 1024;
      rb0 = *(const uint4*)(row + 512 + grp * 128 + sc * 16);
      rb1 = *(const uint4*)(row + 512 + grp * 128 + sc * 16 + 8);
      rc0 = *(const uint4*)(row + 768 + grp * 128 + sc * 16);
      rc1 = *(const uint4*)(row + 768 + grp * 128 + sc * 16 + 8);
      rx = *(const uint4*)(row + hh * 64 + sc * 8);
      if (tid < 64) rdt = DTR[(size_t)scan_row(b, dir, (c + 1) * 64 + tid) * 16 + dir * 8 + hh];
    }
    const float tot = totS[0];
    {
      float dt = dtS[stok];
      float w = dt * __expf(tot - cumS[stok]);
      float x0 = bflo(cx.x), x1 = bfhi(cx.x), x2 = bflo(cx.y), x3 = bfhi(cx.y), x4 = bflo(cx.z), x5 = bfhi(cx.z), x6 = bflo(cx.w), x7 = bfhi(cx.w);
      uint4 o;
      o.x = pack2(x0 * dt, x1 * dt); o.y = pack2(x2 * dt, x3 * dt); o.z = pack2(x4 * dt, x5 * dt); o.w = pack2(x6 * dt, x7 * dt);
      *(uint4*)(Xs + stok * 72 + sc * 8) = o;
      o.x = pack2(x0 * w, x1 * w); o.y = pack2(x2 * w, x3 * w); o.z = pack2(x4 * w, x5 * w); o.w = pack2(x6 * w, x7 * w);
      *(uint4*)(Xw + stok * 72 + sc * 8) = o;
    }
#pragma unroll
    for (int tt = 0; tt < 2; ++tt) {
      int idx = wave * 2 + tt, jt = idx >> 2, it = idx & 3;
      f32x4 acc = (f32x4){0.f, 0.f, 0.f, 0.f};
      if (jt <= it) {
#pragma unroll
        for (int ks = 0; ks < 4; ++ks) {
          bf16x8 a = *(const bf16x8*)(Bs + (jt * 16 + l15) * 136 + ks * 32 + g * 8);
          bf16x8 bq = *(const bf16x8*)(Cs + (it * 16 + l15) * 136 + ks * 32 + g * 8);
          acc = __builtin_amdgcn_mfma_f32_16x16x32_bf16(a, bq, acc, 0, 0, 0);
        }
        int i = it * 16 + l15;
        float ci = cumS[i];
        float4 cj = *(const float4*)(cumS + jt * 16 + g * 4);
        int j0 = jt * 16 + g * 4;
        acc[0] = (j0 + 0 <= i) ? acc[0] * __expf(ci - cj.x) : 0.f;
        acc[1] = (j0 + 1 <= i) ? acc[1] * __expf(ci - cj.y) : 0.f;
        acc[2] = (j0 + 2 <= i) ? acc[2] * __expf(ci - cj.z) : 0.f;
        acc[3] = (j0 + 3 <= i) ? acc[3] * __expf(ci - cj.w) : 0.f;
      }
      uint2 o;
      o.x = pack2(acc[0], acc[1]);
      o.y = pack2(acc[2], acc[3]);
      *(uint2*)(Ps + (it * 16 + l15) * 72 + jt * 16 + g * 4) = o;
    }
    __syncthreads();
    f32x4 y[2];
    y[0] = (f32x4){0.f, 0.f, 0.f, 0.f};
    y[1] = (f32x4){0.f, 0.f, 0.f, 0.f};
#pragma unroll
    for (int s2 = 0; s2 < 4; ++s2) {
      bf16x8 sf = pack8(S[2 * s2], S[2 * s2 + 1]);
#pragma unroll
      for (int ii = 0; ii < 2; ++ii) {
        const bf* qr = Cs + ((ih * 2 + ii) * 16 + l15) * 136 + g * 4;
        bf16x8 aq = ld2x64(qr + (2 * s2) * 16, qr + (2 * s2 + 1) * 16);
        y[ii] = __builtin_amdgcn_mfma_f32_16x16x32_bf16(aq, sf, y[ii], 0, 0, 0);
      }
    }
    {
      float et = __expf(tot);
#pragma unroll
      for (int nt = 0; nt < 8; ++nt) { S[nt][0] *= et; S[nt][1] *= et; S[nt][2] *= et; S[nt][3] *= et; }
    }
#pragma unroll
    for (int ii = 0; ii < 2; ++ii) {
      float4 e4 = *(const float4*)(ecS + (ih * 2 + ii) * 16 + g * 4);
      y[ii][0] *= e4.x; y[ii][1] *= e4.y; y[ii][2] *= e4.z; y[ii][3] *= e4.w;
    }
    {
      bf16x8 xfs[2], xws[2];
      tr_dual<32 * 72 * 2, 4 * 72 * 2>(trbase(Xs, 72, g * 8, vt * 16, lane), xfs[0], xfs[1]);
      tr_dual<32 * 72 * 2, 4 * 72 * 2>(trbase(Xw, 72, g * 8, vt * 16, lane), xws[0], xws[1]);
#pragma unroll
      for (int s2 = 0; s2 < 2; ++s2) {
#pragma unroll
        for (int ii = 0; ii < 2; ++ii) {
          bf16x8 ap = *(const bf16x8*)(Ps + ((ih * 2 + ii) * 16 + l15) * 72 + s2 * 32 + g * 8);
          y[ii] = __builtin_amdgcn_mfma_f32_16x16x32_bf16(ap, xfs[s2], y[ii], 0, 0, 0);
        }
#pragma unroll
        for (int nq = 0; nq < 2; ++nq) {
          bf16x8 ab[4];
          tr_quad<32, 4 * 136 * 2>(trbase(Bs, 136, s2 * 32 + g * 8, nq * 64, lane), ab[0], ab[1], ab[2], ab[3]);
#pragma unroll
          for (int n4 = 0; n4 < 4; ++n4) S[nq * 4 + n4] = __builtin_amdgcn_mfma_f32_16x16x32_bf16(ab[n4], xws[s2], S[nq * 4 + n4], 0, 0, 0);
        }
      }
    }
#pragma unroll
    for (int ii = 0; ii < 2; ++ii)
#pragma unroll
      for (int r = 0; r < 4; ++r) {
        int i = (ih * 2 + ii) * 16 + g * 4 + r;
        Y[(size_t)scan_row(b, dir, c * 64 + i) * 512 + hh * 64 + vt * 16 + l15] = f2bf(y[ii][r]);
      }
  }
}

__device__ __forceinline__ void rwkv_chain2(const P& p, int chain, char* smem) {
  const int dir = chain & 1, h = (chain >> 1) & 7, b = chain >> 4;
  bf* KT = (bf*)smem;
  bf* RTi = KT + 4608;
  bf* KH = RTi + 4608;
  bf* BH = KH + 4608;
  bf* VV = BH + 4608;
  bf* MAkk = VV + 4608;
  bf* MBrk = MAkk + 4608;
  bf* MBrb = MBrk + 4608;
  bf* UN = MBrb + 4608;
  bf* LWs = UN + 4608;
  float* AKB = (float*)(LWs + 4608);
  float* RH = AKB + 64 * 68;
  float* segtot = RH + 64 * 68;
  float* dS = segtot + 512;
  const int tid = tidx(), lane = tid & 63, wave = tid >> 6;
  const int l15 = lane & 15, g = lane >> 4;
  const int vt = wave & 3, ih = wave >> 2;
  const bf* PR = (const bf*)(p.ws + OFF_PREP);
  const bf* PK = PR + (size_t)RT * 512;
  const bf* PV = PK + (size_t)RT * 512;
  const bf* PKK = PV + (size_t)RT * 512;
  const bf* PKA = PKK + (size_t)RT * 512;
  const bf* PLW = PKA + (size_t)RT * 512 + (size_t)dir * RT * 512;
  bf* Y = (bf*)p.out + (size_t)dir * RT * 512;
  const int kc = tid & 63, seg = tid >> 6;
  const int stok = tid >> 3, sc8 = (tid & 7) * 8;
  f32x4 T[4];
#pragma unroll
  for (int kt = 0; kt < 4; ++kt) T[kt] = (f32x4){0.f, 0.f, 0.f, 0.f};
  uint4 gR, gK, gV, gKK, gKA, gW;
  {
    size_t o = (size_t)scan_row(b, dir, stok) * 512 + h * 64 + sc8;
    gR = *(const uint4*)(PR + o); gK = *(const uint4*)(PK + o); gV = *(const uint4*)(PV + o);
    gKK = *(const uint4*)(PKK + o); gKA = *(const uint4*)(PKA + o); gW = *(const uint4*)(PLW + o);
  }
  const int NCH = TA / 64;
  for (int c = 0; c < NCH; ++c) {
    __syncthreads();
    *(uint4*)(RTi + stok * 72 + sc8) = gR;
    *(uint4*)(KH + stok * 72 + sc8) = gK;
    *(uint4*)(VV + stok * 72 + sc8) = gV;
    *(uint4*)(KT + stok * 72 + sc8) = gKK;
    *(uint4*)(BH + stok * 72 + sc8) = gKA;
    *(uint4*)(LWs + stok * 72 + sc8) = gW;
    __syncthreads();
    if (c + 1 < NCH) {
      size_t o = (size_t)scan_row(b, dir, (c + 1) * 64 + stok) * 512 + h * 64 + sc8;
      gR = *(const uint4*)(PR + o); gK = *(const uint4*)(PK + o); gV = *(const uint4*)(PV + o);
      gKK = *(const uint4*)(PKK + o); gKA = *(const uint4*)(PKA + o); gW = *(const uint4*)(PLW + o);
    }
    float lc[8];
    {
      float run = 0.f;
#pragma unroll
      for (int ii = 0; ii < 8; ++ii) {
        run += bf2f(LWs[(seg * 8 + ii) * 72 + kc]);
        lc[ii] = run;
      }
      segtot[seg * 64 + kc] = run;
    }
    __syncthreads();
    {
      float off = 0.f, tot = 0.f;
#pragma unroll
      for (int s2 = 0; s2 < 8; ++s2) {
        float t = segtot[s2 * 64 + kc];
        tot += t;
        off += (s2 < seg) ? t : 0.f;
      }
#pragma unroll
      for (int ii = 0; ii < 8; ++ii) {
        const int i = seg * 8 + ii;
        const float cum = off + lc[ii];
        const float cumx = off + (ii > 0 ? lc[ii > 0 ? ii - 1 : 0] : 0.f);
        const float eR = __expf(cum - tot);
        const float eK = __builtin_amdgcn_rcpf(eR);
        const float eX = __expf(cumx - tot);
        const int o = i * 72 + kc;
        RTi[o] = f2bf(bf2f(RTi[o]) * eR);
        KH[o] = f2bf(bf2f(KH[o]) * eK);
        BH[o] = f2bf(bf2f(BH[o]) * eK);
        KT[o] = f2bf(bf2f(KT[o]) * eX);
      }
      if (seg == 0) dS[kc] = __expf(tot);
    }
    __syncthreads();
#pragma unroll
    for (int kt = 0; kt < 4; ++kt) {
      float4 d4 = *(const float4*)(dS + kt * 16 + g * 4);
      T[kt][0] *= d4.x; T[kt][1] *= d4.y; T[kt][2] *= d4.z; T[kt][3] *= d4.w;
    }
#pragma unroll
    for (int tt = 0; tt < 2; ++tt) {
      const int idx = wave * 2 + tt, jt = idx >> 2, it = idx & 3;
      f32x4 akb = (f32x4){0.f, 0.f, 0.f, 0.f}, akk = akb, brk = akb, brb = akb;
      if (jt <= it) {
#pragma unroll
        for (int ks = 0; ks < 2; ++ks) {
          bf16x8 aKH = *(const bf16x8*)(KH + (jt * 16 + l15) * 72 + ks * 32 + g * 8);
          bf16x8 aBH = *(const bf16x8*)(BH + (jt * 16 + l15) * 72 + ks * 32 + g * 8);
          bf16x8 bKT = *(const bf16x8*)(KT + (it * 16 + l15) * 72 + ks * 32 + g * 8);
          bf16x8 bRT = *(const bf16x8*)(RTi + (it * 16 + l15) * 72 + ks * 32 + g * 8);
          akb = __builtin_amdgcn_mfma_f32_16x16x32_bf16(aBH, bKT, akb, 0, 0, 0);
          akk = __builtin_amdgcn_mfma_f32_16x16x32_bf16(aKH, bKT, akk, 0, 0, 0);
          brk = __builtin_amdgcn_mfma_f32_16x16x32_bf16(aKH, bRT, brk, 0, 0, 0);
          brb = __builtin_amdgcn_mfma_f32_16x16x32_bf16(aBH, bRT, brb, 0, 0, 0);
        }
        const int i = it * 16 + l15;
#pragma unroll
        for (int r = 0; r < 4; ++r) {
          const int j = jt * 16 + g * 4 + r;
          akb[r] = (j < i) ? akb[r] : 0.f;
          akk[r] = (j < i) ? akk[r] : 0.f;
          brk[r] = (j <= i) ? brk[r] : 0.f;
          brb[r] = (j <= i) ? brb[r] : 0.f;
        }
      }
      const int orow = (it * 16 + l15), ocol = jt * 16 + g * 4;
      uint2 o;
      o.x = pack2(akk[0], akk[1]); o.y = pack2(akk[2], akk[3]);
      *(uint2*)(MAkk + orow * 72 + ocol) = o;
      o.x = pack2(brk[0], brk[1]); o.y = pack2(brk[2], brk[3]);
      *(uint2*)(MBrk + orow * 72 + ocol) = o;
      o.x = pack2(brb[0], brb[1]); o.y = pack2(brb[2], brb[3]);
      *(uint2*)(MBrb + orow * 72 + ocol) = o;
      *(float4*)(AKB + orow * 68 + ocol) = make_float4(akb[0], akb[1], akb[2], akb[3]);
    }
    __syncthreads();
    bf16x8 tf0 = pack8(T[0], T[1]), tf1 = pack8(T[2], T[3]);
    f32x4 yv[2];
    {
      bf16x8 vf0, vf1;
      tr_dual<32 * 72 * 2, 4 * 72 * 2>(trbase(VV, 72, g * 8, vt * 16, lane), vf0, vf1);
#pragma unroll
      for (int ii = 0; ii < 2; ++ii) {
        const int it = ih * 2 + ii;
        f32x4 acc = (f32x4){0.f, 0.f, 0.f, 0.f};
        const bf* qr = KT + (it * 16 + l15) * 72 + g * 4;
        acc = __builtin_amdgcn_mfma_f32_16x16x32_bf16(ld2x64(qr, qr + 16), tf0, acc, 0, 0, 0);
        acc = __builtin_amdgcn_mfma_f32_16x16x32_bf16(ld2x64(qr + 32, qr + 48), tf1, acc, 0, 0, 0);
        const bf* ar = MAkk + (it * 16 + l15) * 72 + g * 8;
        acc = __builtin_amdgcn_mfma_f32_16x16x32_bf16(*(const bf16x8*)ar, vf0, acc, 0, 0, 0);
        acc = __builtin_amdgcn_mfma_f32_16x16x32_bf16(*(const bf16x8*)(ar + 32), vf1, acc, 0, 0, 0);
#pragma unroll
        for (int r = 0; r < 4; ++r) RH[(it * 16 + g * 4 + r) * 68 + vt * 16 + l15] = acc[r];
        f32x4 ya = (f32x4){0.f, 0.f, 0.f, 0.f};
        const bf* rr = RTi + (it * 16 + l15) * 72 + g * 4;
        ya = __builtin_amdgcn_mfma_f32_16x16x32_bf16(ld2x64(rr, rr + 16), tf0, ya, 0, 0, 0);
        ya = __builtin_amdgcn_mfma_f32_16x16x32_bf16(ld2x64(rr + 32, rr + 48), tf1, ya, 0, 0, 0);
        const bf* br = MBrk + (it * 16 + l15) * 72 + g * 8;
        ya = __builtin_amdgcn_mfma_f32_16x16x32_bf16(*(const bf16x8*)br, vf0, ya, 0, 0, 0);
        ya = __builtin_amdgcn_mfma_f32_16x16x32_bf16(*(const bf16x8*)(br + 32), vf1, ya, 0, 0, 0);
        yv[ii] = ya;
      }
      {
        bf16x8 k0[4], k1[4];
        tr_quad<32, 4 * 72 * 2>(trbase(KH, 72, g * 8, 0, lane), k0[0], k0[1], k0[2], k0[3]);
        tr_quad<32, 4 * 72 * 2>(trbase(KH, 72, 32 + g * 8, 0, lane), k1[0], k1[1], k1[2], k1[3]);
#pragma unroll
        for (int kt = 0; kt < 4; ++kt) {
          T[kt] = __builtin_amdgcn_mfma_f32_16x16x32_bf16(k0[kt], vf0, T[kt], 0, 0, 0);
          T[kt] = __builtin_amdgcn_mfma_f32_16x16x32_bf16(k1[kt], vf1, T[kt], 0, 0, 0);
        }
      }
    }
    __syncthreads();
    for (int rb = 0; rb < 8; ++rb) {
      if (wave == 0) {
        float acc[8];
#pragma unroll
        for (int q = 0; q < 8; ++q) acc[q] = RH[(rb * 8 + q) * 68 + lane];
#pragma unroll
        for (int q = 1; q < 8; ++q) {
          const float4 d0 = *(const float4*)(AKB + (rb * 8 + q) * 68 + rb * 8);
          const float4 d1 = *(const float4*)(AKB + (rb * 8 + q) * 68 + rb * 8 + 4);
          const float dd[8] = {d0.x, d0.y, d0.z, d0.w, d1.x, d1.y, d1.z, d1.w};
#pragma unroll
          for (int cc = 0; cc < q; ++cc) acc[q] -= dd[cc] * acc[cc];
        }
#pragma unroll
        for (int q = 0; q < 8; ++q) {
          RH[(rb * 8 + q) * 68 + lane] = acc[q];
          UN[(rb * 8 + q) * 72 + lane] = f2bf(-acc[q]);
        }
      }
      __syncthreads();
      if (rb < 7) {
        float uq[8];
#pragma unroll
        for (int q = 0; q < 8; ++q) uq[q] = RH[(rb * 8 + q) * 68 + lane];
        for (int r = (rb + 1) * 8 + wave; r < 64; r += 8) {
          const float4 a0 = *(const float4*)(AKB + r * 68 + rb * 8);
          const float4 a1 = *(const float4*)(AKB + r * 68 + rb * 8 + 4);
          float Rv = RH[r * 68 + lane];
          Rv -= ((a0.x * uq[0] + a0.y * uq[1]) + (a0.z * uq[2] + a0.w * uq[3])) + ((a1.x * uq[4] + a1.y * uq[5]) + (a1.z * uq[6] + a1.w * uq[7]));
          RH[r * 68 + lane] = Rv;
        }
        __syncthreads();
      }
    }
    __syncthreads();
    {
      bf16x8 uf0, uf1;
      tr_dual<32 * 72 * 2, 4 * 72 * 2>(trbase(UN, 72, g * 8, vt * 16, lane), uf0, uf1);
#pragma unroll
      for (int ii = 0; ii < 2; ++ii) {
        const int it = ih * 2 + ii;
        const bf* br = MBrb + (it * 16 + l15) * 72 + g * 8;
        yv[ii] = __builtin_amdgcn_mfma_f32_16x16x32_bf16(*(const bf16x8*)br, uf0, yv[ii], 0, 0, 0);
        yv[ii] = __builtin_amdgcn_mfma_f32_16x16x32_bf16(*(const bf16x8*)(br + 32), uf1, yv[ii], 0, 0, 0);
      }
      {
        bf16x8 b0[4], b1[4];
        tr_quad<32, 4 * 72 * 2>(trbase(BH, 72, g * 8, 0, lane), b0[0], b0[1], b0[2], b0[3]);
        tr_quad<32, 4 * 72 * 2>(trbase(BH, 72, 32 + g * 8, 0, lane), b1[0], b1[1], b1[2], b1[3]);
#pragma unroll
        for (int kt = 0; kt < 4; ++kt) {
          T[kt] = __builtin_amdgcn_mfma_f32_16x16x32_bf16(b0[kt], uf0, T[kt], 0, 0, 0);
          T[kt] = __builtin_amdgcn_mfma_f32_16x16x32_bf16(b1[kt], uf1, T[kt], 0, 0, 0);
        }
      }
    }
#pragma unroll
    for (int ii = 0; ii < 2; ++ii)
#pragma unroll
      for (int r = 0; r < 4; ++r) {
        const int i = (ih * 2 + ii) * 16 + g * 4 + r;
        Y[(size_t)scan_row(b, dir, c * 64 + i) * 512 + h * 64 + vt * 16 + l15] = f2bf(yv[ii][r]);
      }
  }
}

__device__ __forceinline__ void ph_mix1(const P& p, char* smem) {
  for (int u = blockIdx.x; u < 192; u += gridDim.x) {
    if (u < 128) ssd_chain2(p, u, smem);
    else gla_chain2(p, u - 128, smem);
  }
}

__device__ __forceinline__ void ph_post1(const P& p, char* smem) {
  float* ws1 = (float*)smem;
  float* ws2 = ws1 + 32;
  const int tid = tidx(), lane = tid & 63, wave = tid >> 6;
  const bf* SYF = (const bf*)(p.ws + OFF_XRAW);
  const bf* SYB = SYF + (size_t)RT * 512;
  const bf* GYF = (const bf*)(p.ws + OFF_GY);
  const bf* GYB = GYF + (size_t)RT * 512;
  const bf* XBC = (const bf*)(p.ws + OFF_XBC);
  const bf* P1 = (const bf*)(p.ws + OFF_P1C);
  bf* O = (bf*)(p.ws + OFF_HO);
  const float dsk = p.in[44][tid >> 6];
  const float sn = p.in[45][tid];
  const float gn = p.in[50][tid & 127];
  for (int rr0 = blockIdx.x * 4; rr0 < NBAT * SEQ; rr0 += gridDim.x * 4) {
    float y[4], y2[4], zg[4], gg[4];
    int Rr[4];
#pragma unroll
    for (int i = 0; i < 4; ++i) {
      int rr = rr0 + i;
      int R = (rr >> 12) * TA + CTX + (rr & 4095);
      Rr[i] = R;
      size_t o = (size_t)R * 512 + tid;
      y[i] = bf2f(SYF[o]) + bf2f(SYB[o]) + bf2f(XBC[(size_t)R * 1024 + tid]) * dsk;
      zg[i] = bf2f(P1[(size_t)R * 2080 + tid]);
      y2[i] = bf2f(GYF[o]) + bf2f(GYB[o]);
      gg[i] = bf2f(P1[(size_t)R * 2080 + 1552 + tid]);
    }
    __syncthreads();
#pragma unroll
    for (int i = 0; i < 4; ++i) {
      y[i] *= siluf_(zg[i]);
      float s1 = wave_sum(y[i] * y[i]);
      float s2 = wave_sum(y2[i] * y2[i]);
      if (lane == 0) { ws1[i * 8 + wave] = s1; ws2[i * 8 + wave] = s2; }
    }
    __syncthreads();
#pragma unroll
    for (int i = 0; i < 4; ++i) {
      int g4 = i * 8 + (wave >> 2) * 4;
      float t1 = ws1[g4] + ws1[g4 + 1] + ws1[g4 + 2] + ws1[g4 + 3];
      int g2 = i * 8 + (wave >> 1) * 2;
      float t2 = ws2[g2] + ws2[g2 + 1];
      float o1 = y[i] * rsqrtf(t1 * (1.f / 256.f) + 1e-6f) * sn;
      float o2 = y2[i] * rsqrtf(t2 * (1.f / 128.f) + 1e-6f) * gn * siluf_(gg[i]);
      O[(size_t)Rr[i] * 1024 + tid] = f2bf(o1);
      O[(size_t)Rr[i] * 1024 + 512 + tid] = f2bf(o2);
    }
  }
}

__device__ __forceinline__ void ph_final(const P& p) {
  const int lane = tidx() & 63, wave = tidx() >> 6;
  const float* g = p.in[51];
  for (int r = blockIdx.x * 8 + wave; r < NBAT * SEQ; r += gridDim.x * 8) {
    float* row = p.out + (size_t)r * 1024;
    float4 v[4];
    float ss = 0.f;
#pragma unroll
    for (int i = 0; i < 4; ++i) {
      v[i] = *(const float4*)(row + i * 256 + lane * 4);
      ss += v[i].x * v[i].x + v[i].y * v[i].y + v[i].z * v[i].z + v[i].w * v[i].w;
    }
    ss = wave_sum(ss);
    float rs = rsqrtf(ss * (1.f / 1024.f) + 1e-6f);
#pragma unroll
    for (int i = 0; i < 4; ++i) {
      float4 gg = *(const float4*)(g + i * 256 + lane * 4);
      float4 o = make_float4(v[i].x * rs * gg.x, v[i].y * rs * gg.y, v[i].z * rs * gg.z, v[i].w * rs * gg.w);
      *(float4*)(row + i * 256 + lane * 4) = o;
    }
  }
}

#define XB_TMO      128
#define XB_XCNT(j)  (256  + 64 * (j))
#define XB_XSUB(j)  (1280 + 64 * (j))
#define XB_XGEN(j)  (2304 + 64 * (j))
#define XB_TOP      3328
#define XB_TOPGEN   3392
#define XCD_BAR_WORDS 3456
#define XB_SPIN_CAP (1u << 18)
#define LAS __attribute__((address_space(3)))
__device__ __forceinline__ unsigned xb_ld(unsigned* q)              { return __hip_atomic_load(q, __ATOMIC_RELAXED, __HIP_MEMORY_SCOPE_AGENT); }
__device__ __forceinline__ unsigned xb_add(unsigned* q, unsigned v) { return __hip_atomic_fetch_add(q, v, __ATOMIC_RELAXED, __HIP_MEMORY_SCOPE_AGENT); }
__device__ __forceinline__ unsigned xb_xcc_id() { return (unsigned)__builtin_amdgcn_s_getreg((3 << 11) | 20) & 0xFu; }
#define XB_SPIN(cond, bar) do { unsigned _sp = 0; while (cond) { __builtin_amdgcn_s_sleep(1); \
    if ((++_sp & 255u) == 0u) { if (xb_ld(&(bar)[XB_TMO])) break; if (_sp > XB_SPIN_CAP) { atomicAdd(&(bar)[XB_TMO], 1u); break; } } } } while (0)
struct XcdBarrier { unsigned* bar; unsigned x; volatile LAS unsigned* st; };
__device__ __forceinline__ XcdBarrier xcd_barrier_post(unsigned* bar, volatile LAS unsigned* st) {
  XcdBarrier b; b.bar = bar; b.x = xb_xcc_id(); b.st = st;
  if (threadIdx.x == 0) (void)xb_add(&bar[XB_XCNT(b.x)], 1u);
  return b;
}
__device__ __forceinline__ void xcd_barrier_complete(unsigned* bar, unsigned x, unsigned& nloc, unsigned& nx) {
  const unsigned G = gridDim.x * gridDim.y * gridDim.z;
  unsigned sum, cnt, mine, sp = 0u;
  for (;;) {
    sum = 0u; cnt = 0u; mine = 0u;
#pragma unroll
    for (unsigned j = 0; j < 16; ++j) { const unsigned c = xb_ld(&bar[XB_XCNT(j)]); sum += c; cnt += (c > 0u) ? 1u : 0u; mine = (j == x) ? c : mine; }
    if (sum == G) break;
    __builtin_amdgcn_s_sleep(1);
    if ((++sp & 255u) == 0u) { if (xb_ld(&bar[XB_TMO])) break; if (sp > XB_SPIN_CAP) { atomicAdd(&bar[XB_TMO], 1u); break; } }
  }
  nloc = mine > 0u ? mine : 1u; nx = cnt > 0u ? cnt : 1u;
}
__device__ __forceinline__ void xcd_barrier(const XcdBarrier& b) {
  asm volatile("s_waitcnt vmcnt(0)" ::: "memory");
  __syncthreads();
  if (threadIdx.x == 0) {
    unsigned* bar = b.bar;
    __builtin_amdgcn_s_waitcnt(0);
    unsigned nloc = b.st[0], nx = b.st[1];
    if (nloc == 0u) { xcd_barrier_complete(bar, b.x, nloc, nx); b.st[0] = nloc; b.st[1] = nx; }
    const unsigned old = xb_add(&bar[XB_XSUB(b.x)], 1u);
    const unsigned gen = old / nloc;
    if (old + 1u == (gen + 1u) * nloc) {
      __builtin_amdgcn_fence(__ATOMIC_RELEASE, "agent");
      asm volatile("s_waitcnt vmcnt(0)" ::: "memory");
      const unsigned og = xb_add(&bar[XB_TOP], 1u);
      const unsigned tg = og / nx;
      if (og + 1u == (tg + 1u) * nx) xb_add(&bar[XB_TOPGEN], 1u);
      else XB_SPIN(xb_ld(&bar[XB_TOPGEN]) == tg, bar);
      __builtin_amdgcn_fence(__ATOMIC_ACQUIRE, "agent");
      xb_add(&bar[XB_XGEN(b.x)], 1u);
      asm volatile("s_waitcnt vmcnt(0)" ::: "memory");
    } else {
      XB_SPIN(xb_ld(&bar[XB_XGEN(b.x)]) == gen, bar);
      __builtin_amdgcn_fence(__ATOMIC_ACQUIRE, "agent");
      asm volatile("s_waitcnt vmcnt(0)" ::: "memory");
    }
  }
  __syncthreads();
}

constexpr int NPH = 20;
template <int PH>
__device__ __forceinline__ void run_phase(const P& p, char* smem) {
  const bf* WT = (const bf*)(p.ws + OFF_WT);
  const bf* WT1 = (const bf*)(p.ws + OFF_WT1);
  const bf* HO = (const bf*)(p.ws + OFF_HO);
  const bf* HID = (const bf*)(p.ws + OFF_HID);
  if constexpr (PH == 0) {
    if (blockIdx.x == 0 && tidx() == 0) { *(int*)(p.ws + OFF_CNT) = 0; *((int*)(p.ws + OFF_CNT) + 1) = 0; }
    ph_mod(p, smem);
    ph_lw(p);
    ph_wt(p, 0, smem, blockIdx.x, gridDim.x);
  } else if constexpr (PH == 1) ph_ada(p, 0, 0, 1, 0);
  else if constexpr (PH == 2) ph_gemm<0>(p, HO, WT + WT_IN, 1024, 13, 0, 0, smem);
  else if constexpr (PH == 3) {
    ph_rope(p, smem);
    ph_rwkv_prep(p, smem);
#ifdef PROBE_PREP
    __syncthreads();
    ph_rwkv_prep(p, smem);
#endif
  }
  else if constexpr (PH == 4) ph_mix0(p, smem);
  else if constexpr (PH == 5) ph_rwkv_post(p);
  else if constexpr (PH == 6) ph_gemm<2>(p, HO, WT + WT_OUT, 1024, 4, 0, 0, smem);
  else if constexpr (PH == 7) ph_ada(p, 0, 1, 0, 0);
  else if constexpr (PH == 8) ph_gemm<3>(p, HO, WT + WT_W1, 1024, 16, 0, 0, smem);
  else if constexpr (PH == 9) {
    ph_gemm<4>(p, HID, WT + WT_W2, 4096, 4, 0, 0, smem);
    const int extra = 544 % (int)gridDim.x;
    if ((int)gridDim.x - extra >= 32) { if ((int)blockIdx.x >= extra) ph_wt(p, 1, smem, blockIdx.x - extra, gridDim.x - extra); }
    else ph_wt(p, 1, smem, blockIdx.x, gridDim.x);
  }
  else if constexpr (PH == 10) ph_ada(p, 1, 0, 0, 0);
  else if constexpr (PH == 11) ph_gemm<1>(p, HO, WT1 + WT_IN, 1024, 13, 1, 0, smem);
  else if constexpr (PH == 12) ph_conv(p);
  else if constexpr (PH == 13) ph_mix1(p, smem);
  else if constexpr (PH == 14) ph_post1(p, smem);
  else if constexpr (PH == 15) ph_gemm<2>(p, HO, WT1 + WT_OUT, 1024, 4, 1, 1, smem);
  else if constexpr (PH == 16) ph_ada(p, 1, 1, 0, 1);
  else if constexpr (PH == 17) ph_gemm<3>(p, HO, WT1 + WT_W1, 1024, 16, 1, 1, smem);
  else if constexpr (PH == 18) ph_gemm<4>(p, HID, WT1 + WT_W2, 4096, 4, 1, 1, smem);
  else ph_final(p);
}

constexpr int LDS_BYTES = 131072 + 64;
template <int PH>
__device__ __forceinline__ void run_all(const P& p, char* smem, const XcdBarrier& xb) {
  run_phase<PH>(p, smem);
#ifdef PROBE_MASK
  if constexpr (((PROBE_MASK) >> PH) & 1) {
    xcd_barrier(xb);
    if constexpr (PH == 4) {
      if (blockIdx.x == 0 && tidx() == 0) *(int*)(p.ws + OFF_CNT) = 0;
      xcd_barrier(xb);
    }
    run_phase<PH>(p, smem);
  }
#endif
  if constexpr (PH + 1 < NPH) {
    if constexpr (PH == 0) cg::this_grid().sync();
    else xcd_barrier(xb);
    run_all<PH + 1>(p, smem, xb);
  }
}
__global__ void __launch_bounds__(NT) mega(P p) {
  extern __shared__ __attribute__((aligned(16))) char smem[];
  volatile LAS unsigned* st = (volatile LAS unsigned*)(smem + 131072 + 16);
  if (threadIdx.x == 0) { st[0] = 0u; st[1] = 0u; }
  __syncthreads();
  const XcdBarrier xb = xcd_barrier_post((unsigned*)(p.ws + OFF_BAR), st);
  run_all<0>(p, smem, xb);
}

extern "C" void kernel_launch(void* const* d_in, const int* in_sizes, int n_in, void* d_out, int out_size, void* d_ws,
                              size_t ws_size, hipStream_t stream) {
  P p{};
  for (int i = 0; i < 52; ++i) p.in[i] = (const float*)d_in[i];
  p.out = (float*)d_out;
  p.ws = (char*)d_ws;
  static int grid_blocks = 0;
  if (!grid_blocks) {
    int dev = 0, cus = 0, per_cu = 0;
    (void)hipGetDevice(&dev);
    (void)hipDeviceGetAttribute(&cus, hipDeviceAttributeMultiprocessorCount, dev);
    (void)hipFuncSetAttribute((const void*)mega, hipFuncAttributeMaxDynamicSharedMemorySize, LDS_BYTES);
    (void)hipOccupancyMaxActiveBlocksPerMultiprocessor(&per_cu, mega, NT, LDS_BYTES);
    if (per_cu < 1) per_cu = 1;
    if (per_cu > 1) per_cu = 1;
    grid_blocks = cus * per_cu;
  }
  (void)hipMemsetAsync((char*)d_ws + OFF_BAR, 0, XCD_BAR_WORDS * sizeof(unsigned), stream);
  void* args[] = {&p};
  hipError_t e = hipLaunchCooperativeKernel((void*)mega, dim3(grid_blocks), dim3(NT), args, LDS_BYTES, stream);
  if (e != hipSuccess) fprintf(stderr, "cooperative launch failed: %s (grid %d)\n", hipGetErrorString(e), grid_blocks);
}
```

```cpp
#include <hip/hip_runtime.h>
#include <hip/hip_cooperative_groups.h>
#include <cstdio>
namespace cg = cooperative_groups;

#ifndef MODE_COOP
#define MODE_COOP 1
#endif

typedef unsigned short bf;
typedef __attribute__((ext_vector_type(8))) short bf16x8;
typedef __attribute__((ext_vector_type(4))) float f32x4;
typedef __attribute__((ext_vector_type(4))) int i32x4;

constexpr int NT = 512;
constexpr int Dm = 1024, NBAT = 8, SEQ = 4096, CTX = 256, TA = 4352, RT = NBAT * TA;

constexpr size_t OFF_MOD = 0;
constexpr size_t OFF_CNT = 450000;
constexpr size_t OFF_BAR = 458752;
constexpr size_t OFF_WT = 524288;
constexpr size_t WT_IN = 0, WT_OUT = (size_t)3328 * 1024, WT_W1 = WT_OUT + (size_t)1024 * 1024, WT_W2 = WT_W1 + (size_t)4096 * 1024;
constexpr size_t OFF_CTXX = OFF_WT + (size_t)12544 * 1024 * 2;
constexpr size_t OFF_HO = OFF_CTXX + (size_t)2048 * 1024 * 4;
constexpr size_t OFF_BIG = OFF_HO + (size_t)RT * 1024 * 2;
constexpr size_t SZ512 = (size_t)RT * 512 * 2;
constexpr size_t OFF_QKV = OFF_BIG;
constexpr size_t OFF_PREP = OFF_QKV + (size_t)RT * 1536 * 2;
constexpr size_t OFF_G = OFF_PREP + 7 * SZ512;
constexpr size_t OFF_BONUS = OFF_G + SZ512;
constexpr size_t OFF_LW = OFF_BONUS + (size_t)RT * 8 * 4;
constexpr size_t OFF_WT1 = 500170752;
constexpr size_t OFF_HID = OFF_BIG;
constexpr size_t OFF_P1C = OFF_BIG;
constexpr size_t OFF_XRAW = OFF_P1C + (size_t)RT * 2080 * 2;
constexpr size_t OFF_DTRAW = OFF_XRAW + (size_t)RT * 1024 * 2;
constexpr size_t OFF_XBC = OFF_DTRAW + (size_t)RT * 16 * 4;
constexpr size_t OFF_GY = OFF_XBC + (size_t)RT * 1024 * 2;

struct P {
  const float* in[52];
  float* out;
  char* ws;
};

__device__ __forceinline__ int tidx() { int t = threadIdx.x; asm volatile("" : "+v"(t)); return t; }
__device__ __forceinline__ bf f2bf(float f) { __bf16 r = (__bf16)f; return __builtin_bit_cast(bf, r); }
__device__ __forceinline__ float bf2f(bf h) { return __uint_as_float(((unsigned)h) << 16); }
__device__ __forceinline__ float bflo(unsigned u) { return __uint_as_float(u << 16); }
__device__ __forceinline__ float bfhi(unsigned u) { return __uint_as_float(u & 0xffff0000u); }
typedef __bf16 bf16x2_t __attribute__((ext_vector_type(2)));
typedef float f32x2_t __attribute__((ext_vector_type(2)));
__device__ __forceinline__ unsigned pack2(float a, float b) { f32x2_t v = {a, b}; bf16x2_t r = __builtin_convertvector(v, bf16x2_t); return __builtin_bit_cast(unsigned, r); }
__device__ __forceinline__ float sigmoidf_(float x) { return __builtin_amdgcn_rcpf(1.f + __expf(-x)); }
__device__ __forceinline__ float softplusf_(float x) { return x > 15.f ? x : __logf(1.f + __expf(x)); }
__device__ __forceinline__ float siluf_(float x) { return x * __builtin_amdgcn_rcpf(1.f + __expf(-x)); }
__device__ __forceinline__ float wave_sum(float v) {
#pragma unroll
  for (int o = 32; o >= 1; o >>= 1) v += __shfl_xor(v, o);
  return v;
}
template <int C>
__device__ __forceinline__ float dppf(float x) {
  return __builtin_bit_cast(float, __builtin_amdgcn_update_dpp(0, __builtin_bit_cast(int, x), C, 0xF, 0xF, true));
}
__device__ __forceinline__ float red16(float x) {
  x += dppf<0xB1>(x);
  x += dppf<0x4E>(x);
  x += dppf<0x141>(x);
  x += dppf<0x128>(x);
  return x;
}
__device__ __forceinline__ float* xrow(const P& p, int R) {
  int b = R / TA, a = R - b * TA;
  if (a < CTX) return (float*)(p.ws + OFF_CTXX) + (size_t)(b * CTX + a) * Dm;
  return p.out + (size_t)(b * SEQ + a - CTX) * Dm;
}
__device__ __forceinline__ const float* inrow(const P& p, int R) {
  int b = R / TA, a = R - b * TA;
  if (a < CTX) return p.in[2] + (size_t)(b * CTX + a) * Dm;
  return p.in[0] + (size_t)(b * SEQ + a - CTX) * Dm;
}
__device__ __forceinline__ int mrow(int R) {
  int b = R / TA, a = R - b * TA;
  return a < CTX ? 8 : b;
}

__device__ __forceinline__ void ph_mod(const P& p, char* smem) {
  float* sc = (float*)smem;
  float* red = sc + 9 * 1024;
  const int tid = tidx();
  bool loaded = false;
  for (int unit = blockIdx.x; unit < 2 * 192; unit += gridDim.x) {
    int layer = unit / 192, cch = unit - layer * 192;
    const float* W = p.in[layer ? 30 : 4];
    const float* bias = p.in[layer ? 31 : 5];
    __syncthreads();
    if (!loaded) {
      for (int i = tid; i < 9 * 1024; i += NT) {
        int r = i >> 10, k = i & 1023;
        float v = (r < 8) ? p.in[1][r * 1024 + k] : p.in[3][k];
        sc[i] = siluf_(v);
      }
      loaded = true;
      __syncthreads();
    }
    int cl = tid & 31, kg = tid >> 5;
    int col = cch * 32 + cl;
    float acc[9];
#pragma unroll
    for (int r = 0; r < 9; ++r) acc[r] = 0.f;
    for (int k = kg * 64; k < kg * 64 + 64; ++k) {
      float w = W[(size_t)k * 6144 + col];
#pragma unroll
      for (int r = 0; r < 9; ++r) acc[r] += sc[r * 1024 + k] * w;
    }
#pragma unroll
    for (int r = 0; r < 9; ++r) red[(kg * 9 + r) * 32 + cl] = acc[r];
    __syncthreads();
    if (tid < 288) {
      int r = tid >> 5, c = tid & 31;
      float s = 0.f;
#pragma unroll
      for (int g = 0; g < 16; ++g) s += red[(g * 9 + r) * 32 + c];
      ((float*)(p.ws + OFF_MOD))[(size_t)(layer * 9 + r) * 6144 + cch * 32 + c] = s + bias[cch * 32 + c];
    }
  }
}

__device__ __forceinline__ void transpose_one(const float* W, bf* Wt, int K, int N, int Npad, int vb, int nvb, char* smem) {
  float* tile = (float*)smem;
  const int tid = tidx();
  int ntn = Npad / 64, ntk = K / 64;
  for (int t = vb; t < ntn * ntk; t += nvb) {
    int tn = t / ntk, tk = t - tn * ntk;
    int n0 = tn * 64, k0 = tk * 64;
    __syncthreads();
#pragma unroll
    for (int i = 0; i < 8; ++i) {
      int kk = (tid >> 6) + 8 * i, nn = tid & 63;
      float v = (n0 + nn < N) ? W[(size_t)(k0 + kk) * N + n0 + nn] : 0.f;
      tile[kk * 65 + nn] = v;
    }
    __syncthreads();
#pragma unroll
    for (int i = 0; i < 8; ++i) {
      int nn = (tid >> 6) + 8 * i, kk = tid & 63;
      Wt[(size_t)(n0 + nn) * K + k0 + kk] = f2bf(tile[kk * 65 + nn]);
    }
  }
}
__device__ __forceinline__ void ph_wt(const P& p, int layer, char* smem, int b, int nb) {
  bf* WT = (bf*)(p.ws + (layer ? OFF_WT1 : OFF_WT));
  int base = layer ? 34 : 8;
  int nin = layer ? 3104 : 3328, ninp = 3328;
  for (int mtx = 0; mtx < 4; ++mtx) {
    const float* W = p.in[base + mtx];
    bf* dst = WT + (mtx == 0 ? WT_IN : mtx == 1 ? WT_OUT : mtx == 2 ? WT_W1 : WT_W2);
    int K = mtx == 3 ? 4096 : 1024;
    int N = mtx == 0 ? nin : mtx == 2 ? 4096 : 1024;
    int Np = mtx == 0 ? ninp : N;
    transpose_one(W, dst, K, N, Np, (b + (nb / 4) * mtx) % nb, nb, smem);
  }
}

__device__ __forceinline__ void ph_ada(const P& p, int layer, int which, int useInput, int latonly) {
  const int lane = tidx() & 63, wave = tidx() >> 6;
  const float* ng = p.in[(layer ? 32 : 6) + which];
  const float* mod = (const float*)(p.ws + OFF_MOD);
  bf* H = (bf*)(p.ws + OFF_HO);
  for (int R = blockIdx.x * 8 + wave; R < RT; R += gridDim.x * 8) {
    int b = R / TA, a = R - b * TA;
    if (latonly && a < CTX) continue;
    const float* src = useInput ? inrow(p, R) : xrow(p, R);
    float4 v[4];
    float ss = 0.f;
#pragma unroll
    for (int i = 0; i < 4; ++i) {
      v[i] = *(const float4*)(src + i * 256 + lane * 4);
      ss += v[i].x * v[i].x + v[i].y * v[i].y + v[i].z * v[i].z + v[i].w * v[i].w;
    }
    ss = wave_sum(ss);
    float rs = rsqrtf(ss * (1.f / 1024.f) + 1e-6f);
    int mr = a < CTX ? 8 : b;
    const float* sh = mod + (size_t)(layer * 9 + mr) * 6144 + (which * 3 + 0) * 1024;
    const float* scl = mod + (size_t)(layer * 9 + mr) * 6144 + (which * 3 + 1) * 1024;
#pragma unroll
    for (int i = 0; i < 4; ++i) {
      int k = i * 256 + lane * 4;
      float4 g = *(const float4*)(ng + k);
      float4 s4 = *(const float4*)(sh + k);
      float4 c4 = *(const float4*)(scl + k);
      float o0 = v[i].x * rs * g.x * (1.f + c4.x) + s4.x;
      float o1 = v[i].y * rs * g.y * (1.f + c4.y) + s4.y;
      float o2 = v[i].z * rs * g.z * (1.f + c4.z) + s4.z;
      float o3 = v[i].w * rs * g.w * (1.f + c4.w) + s4.w;
      uint2 o;
      o.x = pack2(o0, o1);
      o.y = pack2(o2, o3);
      *(uint2*)(H + (size_t)R * 1024 + k) = o;
    }
  }
}

namespace pg8 {
#define PG8_LAS __attribute__((address_space(3)))
typedef float f32x2 __attribute__((ext_vector_type(2)));
typedef unsigned u32x4 __attribute__((ext_vector_type(4)));
constexpr int BM = 256, BK = 64, HALF = 128, HTB = HALF * BK * 2, STAGE_BYTES = 8 * HTB, NXCD = 8, WGM = 8;
__device__ __forceinline__ int lds_byte(int r, int c) { const int st = (r >> 4) * 2 + (c >> 5), rr = r & 15, cc = c & 31, ob = rr * 64 + cc * 2; return st * 1024 + (ob ^ (((ob >> 9) & 1) << 5)); }
__device__ __forceinline__ void stage_rc(int b, int& R, int& C) { const int st = b / 1024, sb = b % 1024, swz = sb ^ (((sb >> 9) & 1) << 5); R = (st >> 1) * 16 + swz / 64; C = (st & 1) * 32 + (swz % 64) / 2; }
__device__ __forceinline__ int perm32(int rho) { const int n = rho >> 4, i = rho & 15; return 8 * (i >> 2) + 4 * n + (i & 3); }
struct Unit { int pm, pn; };
struct Gemm { const bf* A; const bf* Bt; int K; };
struct Order {
  int nM, nN, nwg, G, c, latonly;
  __device__ void init(int nM_, int nN_, int G_, int c_, int lat) { nM = nM_; nN = nN_; nwg = nM * nN; G = G_; c = c_; latonly = lat; }
  __device__ bool next(int i, Unit& u) const {
    const long L = (long)i * G + c;
    if (L >= nwg) return false;
    int wgid = (int)L;
    { const int q = nwg / NXCD, r = nwg % NXCD, xcd = wgid % NXCD, off = wgid / NXCD; wgid = (xcd < r ? xcd * (q + 1) : r * (q + 1) + (xcd - r) * q) + off; }
    const int nig = WGM * nN, gid = wgid / nig, fm = gid * WGM, gsz = (nM - fm) < WGM ? (nM - fm) : WGM;
    int pm = fm + ((wgid % nig) % gsz);
    u.pn = (wgid % nig) / gsz;
    u.pm = latonly ? ((pm >> 4) * 17 + 1 + (pm & 15)) : pm;
    return true;
  }
};
__device__ __forceinline__ unsigned cvt_pk_bf16(float lo, float hi) { return pack2(lo, hi); }

template <int EPI>
struct Epi {
  static constexpr bool PERM = (EPI == 0 || EPI == 1 || EPI == 3);
  P p;
  int layer;
  __device__ __forceinline__ void operator()(const f32x4 (&acc)[2][2][4][2], const Unit& u, int wr, int wc, int fr, int fq) const {
#pragma unroll
    for (int ai = 0; ai < 2; ++ai)
#pragma unroll
      for (int m = 0; m < 4; ++m) {
        const int row = u.pm * BM + ai * HALF + wr * 64 + m * 16 + fr;
        if constexpr (PERM) {
#pragma unroll
          for (int bj = 0; bj < 2; ++bj) {
            const int c0 = u.pn * BM + bj * HALF + wc * 32 + 8 * fq;
            f32x4 v0 = acc[ai][bj][m][0], v1 = acc[ai][bj][m][1];
            if constexpr (EPI == 3) {
#pragma unroll
              for (int j = 0; j < 4; ++j) { float a = v0[j] > 0.f ? v0[j] : 0.f; v0[j] = a * a; float b2 = v1[j] > 0.f ? v1[j] : 0.f; v1[j] = b2 * b2; }
            }
            u32x4 w;
            w.x = cvt_pk_bf16(v0[0], v0[1]); w.y = cvt_pk_bf16(v0[2], v0[3]); w.z = cvt_pk_bf16(v1[0], v1[1]); w.w = cvt_pk_bf16(v1[2], v1[3]);
            if constexpr (EPI == 0) {
              bf* dst = c0 < 1536 ? (bf*)(p.ws + OFF_QKV) + (size_t)row * 1536 + c0 : (bf*)p.out + (size_t)row * 1792 + (c0 - 1536);
              *(u32x4*)dst = w;
            } else if constexpr (EPI == 1) {
              if (c0 < 512) *(u32x4*)((bf*)(p.ws + OFF_P1C) + (size_t)row * 2080 + c0) = w;
              else if (c0 < 1536) *(u32x4*)((bf*)(p.ws + OFF_XRAW) + (size_t)row * 1024 + (c0 - 512)) = w;
              else if (c0 < 1552) { float* d = (float*)(p.ws + OFF_DTRAW) + (size_t)row * 16 + (c0 - 1536); *(f32x4*)d = v0; *(f32x4*)(d + 4) = v1; }
              else if (c0 < 3104) *(u32x4*)((bf*)(p.ws + OFF_P1C) + (size_t)row * 2080 + (c0 - 1024)) = w;
            } else {
              *(u32x4*)((bf*)(p.ws + OFF_HID) + (size_t)row * 4096 + c0) = w;
            }
          }
        } else {
          const float* gate = (const float*)(p.ws + OFF_MOD) + (size_t)(layer * 9 + mrow(row)) * 6144 + (EPI == 2 ? 2 : 5) * 1024;
          float* xr = xrow(p, row);
          const float* br = (EPI == 2 && layer == 0) ? inrow(p, row) : xr;
#pragma unroll
          for (int bj = 0; bj < 2; ++bj)
#pragma unroll
            for (int n = 0; n < 2; ++n) {
              const int c = u.pn * BM + bj * HALF + wc * 32 + 16 * n + 4 * fq;
              f32x4 gt = *(const f32x4*)(gate + c);
              f32x4 bs = *(const f32x4*)(br + c);
              *(f32x4*)(xr + c) = bs + gt * acc[ai][bj][m][n];
            }
        }
      }
  }
};

template <class EpiT>
__device__ __forceinline__ void gemm_phase(PG8_LAS unsigned char* lds, const Gemm g, const Order& S, const EpiT& E) {
  const int tid = tidx(), wid = __builtin_amdgcn_readfirstlane(tid >> 6), lane = tid & 63, wr = wid >> 2, wc = wid & 3, fr = lane & 15, fq = lane >> 4;
  const int K = g.K, nt = K / BK;
  unsigned voffA[2], voffB[2];
#pragma unroll
  for (int i = 0; i < 2; ++i) { int R, C; stage_rc(tid * 16 + i * 8192, R, C); const int Rb = EpiT::PERM ? ((R & ~31) + perm32(R & 31)) : R;
    voffA[i] = (unsigned)(R * K + C) * 2u; voffB[i] = (unsigned)(Rb * K + C) * 2u; }
  const size_t kstep = (size_t)(BK * 2);
  const size_t hstep = (size_t)HALF * K * 2;
  const size_t tstep = 2 * hstep;
  const unsigned ldsw = (unsigned)wid * 1024u;
  const int aoff = lds_byte(wr * 64 + fr, fq * 8), boff = lds_byte(wc * 32 + fr, fq * 8);
#define PG8_SA(b, h) (((b) * 2 + (h)) * HTB)
#define PG8_SB(b, h) ((4 + (b) * 2 + (h)) * HTB)
#define PG8_STAGE(bufoff, gbase, voff) do { _Pragma("unroll") for (int _i = 0; _i < 2; ++_i) \
        __builtin_amdgcn_global_load_lds((const unsigned*)((const char*)(gbase) + (voff)[_i]), (PG8_LAS unsigned*)(lds + (bufoff) + ldsw + _i * 8192), 16, 0, 0); } while (0)
#define PG8_LDA(dst, b, h) do { _Pragma("unroll") for (int m = 0; m < 4; ++m) _Pragma("unroll") for (int k = 0; k < 2; ++k) dst[m][k] = *(const PG8_LAS bf16x8*)(lds + PG8_SA(b, h) + aoff + m * 2048 + k * 1024); } while (0)
#define PG8_LDB(dst, b, h) do { _Pragma("unroll") for (int n = 0; n < 2; ++n) _Pragma("unroll") for (int k = 0; k < 2; ++k) dst[n][k] = *(const PG8_LAS bf16x8*)(lds + PG8_SB(b, h) + boff + n * 2048 + k * 1024); } while (0)
#define PG8_MMA(ai, bj, At, Bt) do { __builtin_amdgcn_s_setprio(1); _Pragma("unroll") for (int m = 0; m < 4; ++m) _Pragma("unroll") for (int n = 0; n < 2; ++n) _Pragma("unroll") for (int k = 0; k < 2; ++k) \
        acc[ai][bj][m][n] = __builtin_amdgcn_mfma_f32_16x16x32_bf16(Bt[n][k], At[m][k], acc[ai][bj][m][n], 0, 0, 0); __builtin_amdgcn_s_setprio(0); } while (0)
#define PG8_WAIT_V(n) asm volatile("s_waitcnt vmcnt(" #n ")" ::: "memory")
#define PG8_WAIT_L(n) asm volatile("s_waitcnt lgkmcnt(" #n ")" ::: "memory")
#define PG8_BAR __builtin_amdgcn_s_barrier()
#define PG8_SCHED __builtin_amdgcn_sched_barrier(0)
  Unit cur, nxt; int ui = 0;
  if (!S.next(0, cur)) return;
  f32x4 acc[2][2][4][2];
#pragma unroll
  for (int a = 0; a < 2; ++a)
#pragma unroll
    for (int b = 0; b < 2; ++b)
#pragma unroll
      for (int m = 0; m < 4; ++m)
#pragma unroll
        for (int n = 0; n < 2; ++n) acc[a][b][m][n] = (f32x4){0.f, 0.f, 0.f, 0.f};
  bf16x8 At[4][2], B0[2][2], B1[2][2];
  const char* cA = (const char*)g.A + (size_t)cur.pm * tstep; const char* cB = (const char*)g.Bt + (size_t)cur.pn * tstep;
  PG8_STAGE(PG8_SB(0, 0), cB, voffB); PG8_STAGE(PG8_SA(0, 0), cA, voffA); PG8_STAGE(PG8_SB(0, 1), cB + hstep, voffB); PG8_STAGE(PG8_SA(0, 1), cA + hstep, voffA);
  if (wr == 1) PG8_BAR;
  PG8_WAIT_V(4); PG8_BAR;
  PG8_STAGE(PG8_SB(1, 0), cB + kstep, voffB); PG8_STAGE(PG8_SA(1, 0), cA + kstep, voffA); PG8_STAGE(PG8_SB(1, 1), cB + hstep + kstep, voffB);
  PG8_WAIT_V(6); PG8_BAR;
  for (;;) {
    const bool has_next = S.next(ui + 1, nxt);
    const char* nA = has_next ? (const char*)g.A + (size_t)nxt.pm * tstep : cA; const char* nB = has_next ? (const char*)g.Bt + (size_t)nxt.pn * tstep : cB;
    for (int t = 0; t < nt; t += 2) {
      const bool last = (t == nt - 2);
      const char* a1 = cA + (size_t)(t + 1) * kstep;
      const char* a2 = last ? nA : cA + (size_t)(t + 2) * kstep; const char* b2 = last ? nB : cB + (size_t)(t + 2) * kstep;
      const char* a3 = a2 + kstep; const char* b3 = b2 + kstep;
      PG8_LDB(B0, 0, 0); PG8_SCHED; PG8_LDA(At, 0, 0); PG8_STAGE(PG8_SA(1, 1), a1 + hstep, voffA);
      PG8_WAIT_L(8); PG8_BAR; PG8_WAIT_L(0); PG8_MMA(0, 0, At, B0); PG8_BAR; PG8_SCHED;
      PG8_LDB(B1, 0, 1); PG8_STAGE(PG8_SB(0, 0), b2, voffB);
      PG8_BAR; PG8_WAIT_L(0); PG8_MMA(0, 1, At, B1); PG8_BAR;
      PG8_LDA(At, 0, 1); PG8_STAGE(PG8_SA(0, 0), a2, voffA);
      PG8_BAR; PG8_WAIT_L(0); PG8_MMA(1, 0, At, B0); PG8_BAR; PG8_SCHED;
      PG8_STAGE(PG8_SB(0, 1), b2 + hstep, voffB);
      PG8_WAIT_V(6); PG8_BAR; PG8_MMA(1, 1, At, B1); PG8_BAR;
      PG8_LDB(B0, 1, 0); PG8_SCHED; PG8_LDA(At, 1, 0); PG8_STAGE(PG8_SA(0, 1), a2 + hstep, voffA);
      PG8_WAIT_L(8); PG8_BAR; PG8_WAIT_L(0); PG8_MMA(0, 0, At, B0); PG8_BAR; PG8_SCHED;
      PG8_LDB(B1, 1, 1); PG8_STAGE(PG8_SB(1, 0), b3, voffB);
      PG8_BAR; PG8_WAIT_L(0); PG8_MMA(0, 1, At, B1); PG8_BAR;
      PG8_LDA(At, 1, 1); PG8_STAGE(PG8_SA(1, 0), a3, voffA);
      PG8_BAR; PG8_WAIT_L(0); PG8_MMA(1, 0, At, B0); PG8_BAR; PG8_SCHED;
      PG8_STAGE(PG8_SB(1, 1), b3 + hstep, voffB);
      PG8_WAIT_V(6); PG8_BAR; PG8_MMA(1, 1, At, B1); PG8_BAR;
    }
    E(acc, cur, wr, wc, fr, fq);
    if (!has_next) break;
#pragma unroll
    for (int a = 0; a < 2; ++a)
#pragma unroll
      for (int b = 0; b < 2; ++b)
#pragma unroll
        for (int m = 0; m < 4; ++m)
#pragma unroll
          for (int n = 0; n < 2; ++n) acc[a][b][m][n] = (f32x4){0.f, 0.f, 0.f, 0.f};
    cur = nxt; cA = nA; cB = nB; ++ui;
  }
  PG8_WAIT_V(0);
  if (wr == 0) PG8_BAR;
  PG8_BAR;
#undef PG8_SA
#undef PG8_SB
#undef PG8_STAGE
#undef PG8_LDA
#undef PG8_LDB
#undef PG8_MMA
#undef PG8_WAIT_V
#undef PG8_WAIT_L
#undef PG8_BAR
#undef PG8_SCHED
}
}

template <int EPI>
__device__ __forceinline__ void ph_gemm(const P& p, const bf* A, const bf* Bt, int K, int nN, int layer, int latonly, char* smem) {
  pg8::Order S;
  S.init(latonly ? 128 : 136, nN, gridDim.x, blockIdx.x, latonly);
  pg8::Epi<EPI> E{p, layer};
  pg8::Gemm g{A, Bt, K};
  __syncthreads();
  pg8::gemm_phase(( __attribute__((address_space(3))) unsigned char*)smem, g, S, E);
  __syncthreads();
}

__device__ __forceinline__ void ph_rope(const P& p, char* smem) {
  float* tcos = (float*)smem;
  float* tsin = tcos + 1024;
  const int tid = tidx();
  __syncthreads();
  for (int i = tid; i < 1024; i += NT) {
    int c = i >> 4, f = i & 15;
    float inv = powf(10000.f, -(float)f / 16.f);
    float ang = (float)c * inv;
    float sn, cs;
    sincosf(ang, &sn, &cs);
    tcos[i] = cs;
    tsin[i] = sn;
  }
  __syncthreads();
  bf* QKV = (bf*)(p.ws + OFF_QKV);
  for (int it = blockIdx.x * NT + tid; it < RT * 32; it += gridDim.x * NT) {
    int R = it >> 5;
    int vec = (it >> 1) & 15, half = it & 1;
    int b = R / TA, a = R - b * TA;
    bool isq = vec < 8;
    if (!isq && a < CTX) continue;
    bf* ptr = QKV + (size_t)R * 1536 + vec * 64 + half * 32;
    uint4 a0 = *(const uint4*)ptr, a1 = *(const uint4*)(ptr + 8), b0 = *(const uint4*)(ptr + 16), b1 = *(const uint4*)(ptr + 24);
    float x1[16], x2[16];
    x1[0] = bflo(a0.x); x1[1] = bfhi(a0.x); x1[2] = bflo(a0.y); x1[3] = bfhi(a0.y); x1[4] = bflo(a0.z); x1[5] = bfhi(a0.z); x1[6] = bflo(a0.w); x1[7] = bfhi(a0.w);
    x1[8] = bflo(a1.x); x1[9] = bfhi(a1.x); x1[10] = bflo(a1.y); x1[11] = bfhi(a1.y); x1[12] = bflo(a1.z); x1[13] = bfhi(a1.z); x1[14] = bflo(a1.w); x1[15] = bfhi(a1.w);
    x2[0] = bflo(b0.x); x2[1] = bfhi(b0.x); x2[2] = bflo(b0.y); x2[3] = bfhi(b0.y); x2[4] = bflo(b0.z); x2[5] = bfhi(b0.z); x2[6] = bflo(b0.w); x2[7] = bfhi(b0.w);
    x2[8] = bflo(b1.x); x2[9] = bfhi(b1.x); x2[10] = bflo(b1.y); x2[11] = bfhi(b1.y); x2[12] = bflo(b1.z); x2[13] = bfhi(b1.z); x2[14] = bflo(b1.w); x2[15] = bfhi(b1.w);
    const float qs = isq ? 0.125f * 1.4426950408889634f : 1.f;
    if (a >= CTX) {
      int pos = a - CTX;
      int cidx = half == 0 ? (pos >> 6) : (pos & 63);
#pragma unroll
      for (int f = 0; f < 16; ++f) {
        float cs = tcos[cidx * 16 + f], sn = tsin[cidx * 16 + f];
        float y1 = x1[f] * cs - x2[f] * sn, y2 = x2[f] * cs + x1[f] * sn;
        x1[f] = y1 * qs;
        x2[f] = y2 * qs;
      }
    } else {
#pragma unroll
      for (int f = 0; f < 16; ++f) { x1[f] *= qs; x2[f] *= qs; }
    }
    uint4 o;
    o.x = pack2(x1[0], x1[1]); o.y = pack2(x1[2], x1[3]); o.z = pack2(x1[4], x1[5]); o.w = pack2(x1[6], x1[7]); *(uint4*)ptr = o;
    o.x = pack2(x1[8], x1[9]); o.y = pack2(x1[10], x1[11]); o.z = pack2(x1[12], x1[13]); o.w = pack2(x1[14], x1[15]); *(uint4*)(ptr + 8) = o;
    o.x = pack2(x2[0], x2[1]); o.y = pack2(x2[2], x2[3]); o.z = pack2(x2[4], x2[5]); o.w = pack2(x2[6], x2[7]); *(uint4*)(ptr + 16) = o;
    o.x = pack2(x2[8], x2[9]); o.y = pack2(x2[10], x2[11]); o.z = pack2(x2[12], x2[13]); o.w = pack2(x2[14], x2[15]); *(uint4*)(ptr + 24) = o;
  }
}

__device__ __forceinline__ float shiftmix(const bf* PB, const float* mu, int R, int a, int col) {
  int lo = a < CTX ? 0 : CTX, hi = a < CTX ? CTX : TA;
  float t = bf2f(PB[(size_t)R * 1792 + col]);
  float pv = a > lo ? bf2f(PB[(size_t)(R - 1) * 1792 + col]) : 0.f;
  float nx = a + 1 < hi ? bf2f(PB[(size_t)(R + 1) * 1792 + col]) : 0.f;
  return t + (0.5f * (pv + nx) - t) * mu[col];
}
__device__ __forceinline__ void ph_lw(const P& p) {
  bf* LW = (bf*)(p.ws + OFF_LW);
  const float *w2f = p.in[19], *w2b = p.in[21], *a2 = p.in[23], *g2 = p.in[24];
  for (int i = blockIdx.x * NT + tidx(); i < 512 * 320; i += gridDim.x * NT) {
    int n = i / 320, kk = i - n * 320;
    float v = kk < 64 ? w2f[kk * 512 + n] : kk < 128 ? w2b[(kk - 64) * 512 + n] : kk < 192 ? a2[(kk - 128) * 512 + n] : g2[(kk - 192) * 512 + n];
    LW[i] = f2bf(v);
  }
}
__device__ __forceinline__ float shiftmix_l(const bf* PBs, const float muc, int t, int a, int col) {
  const int lo = a < CTX ? 0 : CTX, hi = a < CTX ? CTX : TA;
  const float x = bf2f(PBs[(t + 1) * 1792 + col]);
  const float pv = a > lo ? bf2f(PBs[t * 1792 + col]) : 0.f;
  const float nx = a + 1 < hi ? bf2f(PBs[(t + 2) * 1792 + col]) : 0.f;
  return x + (0.5f * (pv + nx) - x) * muc;
}
__device__ __forceinline__ void ph_rwkv_prep(const P& p, char* smem) {
  bf* linA = (bf*)smem;
  bf* PBs = linA + 16 * 264;
  const int tid = tidx(), lane = tid & 63, wave = tid >> 6;
  const int l15 = lane & 15, g = lane >> 4;
  const bf* PB = (const bf*)p.out;
  const bf* LW = (const bf*)(p.ws + OFF_LW);
  const float* mu = p.in[17];
  bf* PR = (bf*)(p.ws + OFF_PREP);
  bf* PK = PR + (size_t)RT * 512;
  bf* PV = PK + (size_t)RT * 512;
  bf* PKK = PV + (size_t)RT * 512;
  bf* PKA = PKK + (size_t)RT * 512;
  bf* PLF = PKA + (size_t)RT * 512;
  bf* PLB = PLF + (size_t)RT * 512;
  bf* G = (bf*)(p.ws + OFF_G);
  float* BON = (float*)(p.ws + OFF_BONUS);
  float cw0f[4], cw0b[4], ca0[4], ckk[4], cka[4], crk[4], cmr[4], cmk[4], cmv[4];
#pragma unroll
  for (int nt = 0; nt < 4; ++nt) {
    int c = wave * 64 + nt * 16 + l15;
    cw0f[nt] = p.in[18][c]; cw0b[nt] = p.in[20][c]; ca0[nt] = p.in[22][c]; ckk[nt] = p.in[25][c]; cka[nt] = p.in[26][c]; crk[nt] = p.in[27][c];
    cmr[nt] = mu[c]; cmk[nt] = mu[512 + c]; cmv[nt] = mu[1024 + c];
  }
  for (int unit = blockIdx.x; unit < RT / 16; unit += gridDim.x) {
    const int R0 = unit * 16;
    const int b = R0 / TA, a00 = R0 - b * TA;
    __syncthreads();
    for (int ch = tid; ch < 18 * 224; ch += NT) {
      const int rr = ch / 224, cc = ch - rr * 224;
      const int Rg = R0 - 1 + rr;
      uint4 v = make_uint4(0, 0, 0, 0);
      if (Rg >= 0 && Rg < RT) v = *(const uint4*)(PB + (size_t)Rg * 1792 + cc * 8);
      *(uint4*)(PBs + rr * 1792 + cc * 8) = v;
    }
    __syncthreads();
#pragma unroll
    for (int i = 0; i < 8; ++i) {
      int idx = tid + NT * i;
      int tok = idx >> 8, j = idx & 255;
      float f = shiftmix_l(PBs, mu[1536 + j], tok, a00 + tok, 1536 + j);
      float val = j < 64 ? tanhf(f) : (j < 128 ? f : sigmoidf_(f));
      linA[tok * 264 + j] = f2bf(val);
    }
    __syncthreads();
    f32x4 wf[4], wb[4], aa[4], gg[4];
#pragma unroll
    for (int nt = 0; nt < 4; ++nt) {
      wf[nt] = (f32x4){0.f, 0.f, 0.f, 0.f}; wb[nt] = wf[nt]; aa[nt] = wf[nt]; gg[nt] = wf[nt];
    }
#pragma unroll
    for (int nt = 0; nt < 4; ++nt) {
      const bf* lw = LW + (size_t)(wave * 64 + nt * 16 + l15) * 320 + g * 8;
#pragma unroll
      for (int ks = 0; ks < 2; ++ks) {
        bf16x8 aw = *(const bf16x8*)(linA + l15 * 264 + ks * 32 + g * 8);
        wf[nt] = __builtin_amdgcn_mfma_f32_16x16x32_bf16(aw, *(const bf16x8*)(lw + ks * 32), wf[nt], 0, 0, 0);
        wb[nt] = __builtin_amdgcn_mfma_f32_16x16x32_bf16(aw, *(const bf16x8*)(lw + 64 + ks * 32), wb[nt], 0, 0, 0);
        bf16x8 a_a = *(const bf16x8*)(linA + l15 * 264 + 64 + ks * 32 + g * 8);
        aa[nt] = __builtin_amdgcn_mfma_f32_16x16x32_bf16(a_a, *(const bf16x8*)(lw + 128 + ks * 32), aa[nt], 0, 0, 0);
      }
#pragma unroll
      for (int ks = 0; ks < 4; ++ks) {
        bf16x8 ag = *(const bf16x8*)(linA + l15 * 264 + 128 + ks * 32 + g * 8);
        gg[nt] = __builtin_amdgcn_mfma_f32_16x16x32_bf16(ag, *(const bf16x8*)(lw + 192 + ks * 32), gg[nt], 0, 0, 0);
      }
    }
#pragma unroll
    for (int r = 0; r < 4; ++r) {
      const int t = g * 4 + r;
      const int R = R0 + t, a = a00 + t;
      float fr[4], fv[4], kkv[4], km[4], av[4];
      float n2 = 0.f, bon = 0.f;
#pragma unroll
      for (int nt = 0; nt < 4; ++nt) {
        int c = wave * 64 + nt * 16 + l15;
        fr[nt] = shiftmix_l(PBs, cmr[nt], t, a, c);
        float fk = shiftmix_l(PBs, cmk[nt], t, a, 512 + c);
        fv[nt] = shiftmix_l(PBs, cmv[nt], t, a, 1024 + c);
        av[nt] = sigmoidf_(ca0[nt] + aa[nt][r]);
        kkv[nt] = fk * ckk[nt];
        n2 += kkv[nt] * kkv[nt];
        km[nt] = fk * (1.f + (av[nt] - 1.f) * cka[nt]);
        bon += fr[nt] * km[nt] * crk[nt];
      }
      n2 = red16(n2);
      bon = red16(bon);
      float rn = 1.f / fmaxf(sqrtf(n2), 1e-12f);
#pragma unroll
      for (int nt = 0; nt < 4; ++nt) {
        int c = wave * 64 + nt * 16 + l15;
        size_t o = (size_t)R * 512 + c;
        float lwf = -__expf(-softplusf_(-(cw0f[nt] + wf[nt][r])) - 0.5f);
        float lwb = -__expf(-softplusf_(-(cw0b[nt] + wb[nt][r])) - 0.5f);
        float kk = kkv[nt] * rn;
        PR[o] = f2bf(fr[nt]);
        PK[o] = f2bf(km[nt]);
        PV[o] = f2bf(fv[nt]);
        PKK[o] = f2bf(kk);
        PKA[o] = f2bf(kk * av[nt]);
        PLF[o] = f2bf(lwf);
        PLB[o] = f2bf(lwb);
        G[o] = f2bf(gg[nt][r]);
      }
      if (l15 == 0) BON[(size_t)R * 8 + wave] = bon;
    }
  }
}

__device__ __forceinline__ int scan_row(int b, int dir, int s) {
  int a = dir ? (s < CTX ? CTX - 1 - s : TA + CTX - 1 - s) : s;
  return b * TA + a;
}

__device__ __forceinline__ void rwkv_chain(const P& p, int chain, int half, char* smem) {
  const int dir = chain & 1, h = (chain >> 1) & 7, b = chain >> 4;
  float* cR = (float*)smem;
  float* cW = cR + 2048;
  float* cK = cW + 2048;
  float* cKK = cK + 2048;
  float* cKA = cKK + 2048;
  float* cV = cKA + 2048;
  float* yb = cV + 2048;
  const int tid = tidx(), lane = tid & 63, wave = tid >> 6;
  const int l15 = lane & 15, lg = lane >> 4;
  const bf* PR = (const bf*)(p.ws + OFF_PREP);
  const bf* PK = PR + (size_t)RT * 512;
  const bf* PV = PK + (size_t)RT * 512;
  const bf* PKK = PV + (size_t)RT * 512;
  const bf* PKA = PKK + (size_t)RT * 512;
  const bf* PLW = PKA + (size_t)RT * 512 + (size_t)dir * RT * 512;
  bf* Y = (bf*)p.out + (size_t)dir * RT * 512;
  const int st = tid >> 4, c4 = (tid & 15) * 4;
  const int r0 = half < 0 ? wave * 8 + lg * 2 : half * 32 + (wave & 3) * 8 + lg * 2;
  const bool active = half < 0 || wave < 4;
  const bool ywr = half < 0 || ((c4 >> 5) == half);
  float s0[4], s1[4];
#pragma unroll
  for (int j = 0; j < 4; ++j) { s0[j] = 0.f; s1[j] = 0.f; }
  uint2 gR, gW, gK, gV, gKK, gKA;
  {
    size_t o = (size_t)scan_row(b, dir, st) * 512 + h * 64 + c4;
    gR = *(const uint2*)(PR + o); gW = *(const uint2*)(PLW + o); gK = *(const uint2*)(PK + o);
    gV = *(const uint2*)(PV + o); gKK = *(const uint2*)(PKK + o); gKA = *(const uint2*)(PKA + o);
  }
  const int NCH = TA / 32;
  for (int ch = 0; ch <= NCH; ++ch) {
    __syncthreads();
    if (ch > 0 && ywr) {
      float4 y4 = *(const float4*)(yb + st * 64 + c4);
      uint2 o2;
      o2.x = pack2(y4.x, y4.y);
      o2.y = pack2(y4.z, y4.w);
      *(uint2*)(Y + (size_t)scan_row(b, dir, (ch - 1) * 32 + st) * 512 + h * 64 + c4) = o2;
    }
    if (ch == NCH) break;
    {
      int o = st * 64 + c4;
      *(float4*)(cR + o) = make_float4(bflo(gR.x), bfhi(gR.x), bflo(gR.y), bfhi(gR.y));
      *(float4*)(cW + o) = make_float4(__expf(bflo(gW.x)), __expf(bfhi(gW.x)), __expf(bflo(gW.y)), __expf(bfhi(gW.y)));
      *(float4*)(cK + o) = make_float4(bflo(gK.x), bfhi(gK.x), bflo(gK.y), bfhi(gK.y));
      *(float4*)(cV + o) = make_float4(bflo(gV.x), bfhi(gV.x), bflo(gV.y), bfhi(gV.y));
      *(float4*)(cKK + o) = make_float4(bflo(gKK.x), bfhi(gKK.x), bflo(gKK.y), bfhi(gKK.y));
      *(float4*)(cKA + o) = make_float4(bflo(gKA.x), bfhi(gKA.x), bflo(gKA.y), bfhi(gKA.y));
    }
    __syncthreads();
    if (ch + 1 < NCH) {
      size_t o = (size_t)scan_row(b, dir, (ch + 1) * 32 + st) * 512 + h * 64 + c4;
      gR = *(const uint2*)(PR + o); gW = *(const uint2*)(PLW + o); gK = *(const uint2*)(PK + o);
      gV = *(const uint2*)(PV + o); gKK = *(const uint2*)(PKK + o); gKA = *(const uint2*)(PKA + o);
    }
    if (active) {
      float4 kk4 = *(const float4*)(cKK + l15 * 4);
      float4 w4 = *(const float4*)(cW + l15 * 4);
      float4 k4 = *(const float4*)(cK + l15 * 4);
      float4 ka4 = *(const float4*)(cKA + l15 * 4);
      float4 r4 = *(const float4*)(cR + l15 * 4);
      float2 v2 = *(const float2*)(cV + r0);
#pragma unroll 2
      for (int t = 0; t < 32; ++t) {
        const int tn = (t + 1) & 31;
        float4 nkk4 = *(const float4*)(cKK + tn * 64 + l15 * 4);
        float4 nw4 = *(const float4*)(cW + tn * 64 + l15 * 4);
        float4 nk4 = *(const float4*)(cK + tn * 64 + l15 * 4);
        float4 nka4 = *(const float4*)(cKA + tn * 64 + l15 * 4);
        float4 nr4 = *(const float4*)(cR + tn * 64 + l15 * 4);
        float2 nv2 = *(const float2*)(cV + tn * 64 + r0);
        float sa0 = (s0[0] * kk4.x + s0[1] * kk4.y) + (s0[2] * kk4.z + s0[3] * kk4.w);
        float sa1 = (s1[0] * kk4.x + s1[1] * kk4.y) + (s1[2] * kk4.z + s1[3] * kk4.w);
        float p00 = s0[0] * w4.x + v2.x * k4.x, p01 = s0[1] * w4.y + v2.x * k4.y, p02 = s0[2] * w4.z + v2.x * k4.z, p03 = s0[3] * w4.w + v2.x * k4.w;
        float p10 = s1[0] * w4.x + v2.y * k4.x, p11 = s1[1] * w4.y + v2.y * k4.y, p12 = s1[2] * w4.z + v2.y * k4.z, p13 = s1[3] * w4.w + v2.y * k4.w;
        sa0 = red16(sa0);
        sa1 = red16(sa1);
        s0[0] = p00 - sa0 * ka4.x; s0[1] = p01 - sa0 * ka4.y; s0[2] = p02 - sa0 * ka4.z; s0[3] = p03 - sa0 * ka4.w;
        s1[0] = p10 - sa1 * ka4.x; s1[1] = p11 - sa1 * ka4.y; s1[2] = p12 - sa1 * ka4.z; s1[3] = p13 - sa1 * ka4.w;
        float y0 = (s0[0] * r4.x + s0[1] * r4.y) + (s0[2] * r4.z + s0[3] * r4.w);
        float y1 = (s1[0] * r4.x + s1[1] * r4.y) + (s1[2] * r4.z + s1[3] * r4.w);
        y0 = red16(y0);
        y1 = red16(y1);
        if (l15 == 0) *(float2*)(yb + t * 64 + r0) = make_float2(y0, y1);
        kk4 = nkk4; w4 = nw4; k4 = nk4; ka4 = nka4; r4 = nr4; v2 = nv2;
      }
    }
  }
}


template <int OFFB>
__device__ __forceinline__ bf16x8 tr_pair(const bf* pp) {
  typedef short s16x4_ __attribute__((ext_vector_type(4)));
  s16x4_ v0, v1;
  unsigned addr = (unsigned)(size_t)(__attribute__((address_space(3))) const void*)pp;
  asm volatile("s_waitcnt lgkmcnt(0)\n\tds_read_b64_tr_b16 %0, %2\n\tds_read_b64_tr_b16 %1, %2 offset:%3\n\ts_waitcnt lgkmcnt(0)" : "=&v"(v0), "=&v"(v1) : "v"(addr), "n"(OFFB) : "memory");
  return __builtin_shufflevector(v0, v1, 0, 1, 2, 3, 4, 5, 6, 7);
}
template <int STRB, int OFF2B>
__device__ __forceinline__ void tr_quad(const bf* pp, bf16x8& f0, bf16x8& f1, bf16x8& f2, bf16x8& f3) {
  typedef short s16x4_ __attribute__((ext_vector_type(4)));
  s16x4_ a0, b0, a1, b1, a2, b2, a3, b3;
  unsigned addr = (unsigned)(size_t)(__attribute__((address_space(3))) const void*)pp;
  asm volatile(
      "s_waitcnt lgkmcnt(0)\n\t"
      "ds_read_b64_tr_b16 %0, %8\n\t"
      "ds_read_b64_tr_b16 %1, %8 offset:%9\n\t"
      "ds_read_b64_tr_b16 %2, %8 offset:%10\n\t"
      "ds_read_b64_tr_b16 %3, %8 offset:%11\n\t"
      "ds_read_b64_tr_b16 %4, %8 offset:%12\n\t"
      "ds_read_b64_tr_b16 %5, %8 offset:%13\n\t"
      "ds_read_b64_tr_b16 %6, %8 offset:%14\n\t"
      "ds_read_b64_tr_b16 %7, %8 offset:%15\n\t"
      "s_waitcnt lgkmcnt(0)"
      : "=&v"(a0), "=&v"(b0), "=&v"(a1), "=&v"(b1), "=&v"(a2), "=&v"(b2), "=&v"(a3), "=&v"(b3)
      : "v"(addr), "n"(OFF2B), "n"(STRB), "n"(STRB + OFF2B), "n"(2 * STRB), "n"(2 * STRB + OFF2B), "n"(3 * STRB), "n"(3 * STRB + OFF2B)
      : "memory");
  f0 = __builtin_shufflevector(a0, b0, 0, 1, 2, 3, 4, 5, 6, 7);
  f1 = __builtin_shufflevector(a1, b1, 0, 1, 2, 3, 4, 5, 6, 7);
  f2 = __builtin_shufflevector(a2, b2, 0, 1, 2, 3, 4, 5, 6, 7);
  f3 = __builtin_shufflevector(a3, b3, 0, 1, 2, 3, 4, 5, 6, 7);
}
template <int STRB, int OFF2B>
__device__ __forceinline__ void tr_dual(const bf* pp, bf16x8& f0, bf16x8& f1) {
  typedef short s16x4_ __attribute__((ext_vector_type(4)));
  s16x4_ a0, b0, a1, b1;
  unsigned addr = (unsigned)(size_t)(__attribute__((address_space(3))) const void*)pp;
  asm volatile(
      "s_waitcnt lgkmcnt(0)\n\t"
      "ds_read_b64_tr_b16 %0, %4\n\t"
      "ds_read_b64_tr_b16 %1, %4 offset:%5\n\t"
      "ds_read_b64_tr_b16 %2, %4 offset:%6\n\t"
      "ds_read_b64_tr_b16 %3, %4 offset:%7\n\t"
      "s_waitcnt lgkmcnt(0)"
      : "=&v"(a0), "=&v"(b0), "=&v"(a1), "=&v"(b1)
      : "v"(addr), "n"(OFF2B), "n"(STRB), "n"(STRB + OFF2B)
      : "memory");
  f0 = __builtin_shufflevector(a0, b0, 0, 1, 2, 3, 4, 5, 6, 7);
  f1 = __builtin_shufflevector(a1, b1, 0, 1, 2, 3, 4, 5, 6, 7);
}
__device__ __forceinline__ const bf* trbase(const bf* img, int ld, int r0, int c0, int lane) { return img + (r0 + ((lane & 15) >> 2)) * ld + c0 + (lane & 3) * 4; }
typedef short s16x4 __attribute__((ext_vector_type(4)));
__device__ __forceinline__ void attn_unit(const P& p, int u, char* smem, float lam) {
  bf* Ks = (bf*)smem;
  bf* Vs = Ks + 64 * 136;
  int b, h, nkeys, qa0;
  if (u < 1024) { b = u >> 7; h = (u >> 5) & 3; nkeys = TA; qa0 = CTX + (u & 31) * 128; }
  else { int v = u - 1024; b = v >> 3; h = (v >> 1) & 3; nkeys = CTX; qa0 = (v & 1) * 128; }
  const bf* QKV = (const bf*)(p.ws + OFF_QKV);
  const int tid = tidx(), lane = tid & 63, wave = tid >> 6;
  const int l15 = lane & 15, lg = lane >> 4;
  const size_t rowbase = (size_t)b * TA;
  bf16x8 qf[2][2];
  {
    size_t Rq = rowbase + qa0 + wave * 16 + l15;
#pragma unroll
    for (int m = 0; m < 2; ++m)
#pragma unroll
      for (int ks = 0; ks < 2; ++ks) qf[m][ks] = *(const bf16x8*)(QKV + Rq * 1536 + h * 128 + m * 64 + ks * 32 + lg * 8);
  }
  f32x4 oacc[2][8];
#pragma unroll
  for (int m = 0; m < 2; ++m)
#pragma unroll
    for (int n = 0; n < 8; ++n) oacc[m][n] = (f32x4){0.f, 0.f, 0.f, 0.f};
  float mrun[2] = {-INFINITY, -INFINITY}, lrun[2] = {0.f, 0.f};
  const int sr = tid >> 4, scc = tid & 15;
  const bf* gsrc = QKV + (rowbase + sr) * 1536 + h * 128 + scc * 8;
  uint4 pk0 = *(const uint4*)(gsrc + 512), pv0 = *(const uint4*)(gsrc + 1024);
  uint4 pk1 = *(const uint4*)(gsrc + (size_t)32 * 1536 + 512), pv1 = *(const uint4*)(gsrc + (size_t)32 * 1536 + 1024);
  const int vrow = lg * 4 + (l15 >> 2), vcol = (lane & 3) * 4;
  for (int k0 = 0; k0 < nkeys; k0 += 64) {
    __syncthreads();
    *(uint4*)(Ks + sr * 136 + scc * 8) = pk0;
    *(uint4*)(Ks + (sr + 32) * 136 + scc * 8) = pk1;
    *(uint4*)(Vs + sr * 144 + scc * 8) = pv0;
    *(uint4*)(Vs + (sr + 32) * 144 + scc * 8) = pv1;
    __syncthreads();
    if (k0 + 64 < nkeys) {
      const bf* g2 = gsrc + (size_t)(k0 + 64) * 1536;
      pk0 = *(const uint4*)(g2 + 512); pv0 = *(const uint4*)(g2 + 1024);
      pk1 = *(const uint4*)(g2 + (size_t)32 * 1536 + 512); pv1 = *(const uint4*)(g2 + (size_t)32 * 1536 + 1024);
    }
    bf16x8 pf[2][2];
#pragma unroll
    for (int m = 0; m < 2; ++m) {
      f32x4 s[4];
#pragma unroll
      for (int kt = 0; kt < 4; ++kt) s[kt] = (f32x4){0.f, 0.f, 0.f, 0.f};
#pragma unroll
      for (int ks = 0; ks < 2; ++ks)
#pragma unroll
        for (int kt = 0; kt < 4; ++kt) {
          bf16x8 a = *(const bf16x8*)(Ks + (kt * 16 + l15) * 136 + m * 64 + ks * 32 + lg * 8);
          s[kt] = __builtin_amdgcn_mfma_f32_16x16x32_bf16(a, qf[m][ks], s[kt], 0, 0, 0);
        }
      float mx = fmaxf(fmaxf(s[0][0], s[0][1]), fmaxf(s[0][2], s[0][3]));
#pragma unroll
      for (int kt = 1; kt < 4; ++kt) mx = fmaxf(mx, fmaxf(fmaxf(s[kt][0], s[kt][1]), fmaxf(s[kt][2], s[kt][3])));
      if (__any(mx > mrun[m] + 11.f)) {
        mx = fmaxf(mx, __shfl_xor(mx, 16));
        mx = fmaxf(mx, __shfl_xor(mx, 32));
        float mnew = fmaxf(mrun[m], mx);
        float alpha = __builtin_amdgcn_exp2f(mrun[m] - mnew);
        mrun[m] = mnew;
        lrun[m] *= alpha;
        float al[4];
#pragma unroll
        for (int r = 0; r < 4; ++r) al[r] = __shfl(alpha, lg * 4 + r);
#pragma unroll
        for (int n = 0; n < 8; ++n)
#pragma unroll
          for (int r = 0; r < 4; ++r) oacc[m][n][r] *= al[r];
      }
      const float mcur = mrun[m];
      float ps = 0.f;
#pragma unroll
      for (int kt = 0; kt < 4; ++kt)
#pragma unroll
        for (int r = 0; r < 4; ++r) {
          float e = __builtin_amdgcn_exp2f(s[kt][r] - mcur);
          s[kt][r] = e;
          ps += e;
        }
      lrun[m] += ps;
#pragma unroll
      for (int si = 0; si < 2; ++si) {
        i32x4 t;
        t[0] = (int)pack2(s[2 * si][0], s[2 * si][1]);
        t[1] = (int)pack2(s[2 * si][2], s[2 * si][3]);
        t[2] = (int)pack2(s[2 * si + 1][0], s[2 * si + 1][1]);
        t[3] = (int)pack2(s[2 * si + 1][2], s[2 * si + 1][3]);
        pf[m][si] = __builtin_bit_cast(bf16x8, t);
      }
    }
#pragma unroll
    for (int si = 0; si < 2; ++si)
#pragma unroll
      for (int nq = 0; nq < 2; ++nq) {
        bf16x8 bv[4];
        tr_quad<32, 16 * 144 * 2>(Vs + (si * 32 + vrow) * 144 + nq * 64 + vcol, bv[0], bv[1], bv[2], bv[3]);
#pragma unroll
        for (int n4 = 0; n4 < 4; ++n4) {
          oacc[0][nq * 4 + n4] = __builtin_amdgcn_mfma_f32_16x16x32_bf16(pf[0][si], bv[n4], oacc[0][nq * 4 + n4], 0, 0, 0);
          oacc[1][nq * 4 + n4] = __builtin_amdgcn_mfma_f32_16x16x32_bf16(pf[1][si], bv[n4], oacc[1][nq * 4 + n4], 0, 0, 0);
        }
      }
  }
  float inv[2];
#pragma unroll
  for (int m = 0; m < 2; ++m) {
    float l = lrun[m];
    l += __shfl_xor(l, 16);
    l += __shfl_xor(l, 32);
    inv[m] = 1.f / l;
  }
  float i1[4], i2[4];
#pragma unroll
  for (int r = 0; r < 4; ++r) { i1[r] = __shfl(inv[0], lg * 4 + r); i2[r] = __shfl(inv[1], lg * 4 + r); }
  float ss[4] = {0.f, 0.f, 0.f, 0.f};
#pragma unroll
  for (int n = 0; n < 8; ++n)
#pragma unroll
    for (int r = 0; r < 4; ++r) {
      float o = oacc[0][n][r] * i1[r] - lam * (oacc[1][n][r] * i2[r]);
      oacc[0][n][r] = o;
      ss[r] += o * o;
    }
  const float* subln = p.in[16];
  bf* O = (bf*)(p.ws + OFF_HO);
#pragma unroll
  for (int r = 0; r < 4; ++r) {
    float t = red16(ss[r]);
    float scl = rsqrtf(t * (1.f / 128.f) + 1e-5f) * 0.8f;
    size_t Ro = rowbase + qa0 + wave * 16 + lg * 4 + r;
#pragma unroll
    for (int n = 0; n < 8; ++n) O[Ro * 1024 + h * 128 + n * 16 + l15] = f2bf(oacc[0][n][r] * scl * subln[n * 16 + l15]);
  }
}

__device__ __forceinline__ void rwkv_chain2(const P& p, int chain, char* smem);
__device__ __forceinline__ void ph_mix0(const P& p, char* smem) {
  volatile int* s_unitp = (volatile int*)(smem + 131072);
  for (int u = blockIdx.x; u < 128; u += gridDim.x) rwkv_chain2(p, u, smem);
#ifdef PROBE_RWKV
  __syncthreads();
  for (int u = blockIdx.x; u < 256; u += gridDim.x) rwkv_chain(p, u & 127, u >> 7, smem);
#endif
  float d1 = 0.f, d2 = 0.f;
  for (int i = 0; i < 64; ++i) { d1 += p.in[12][i] * p.in[13][i]; d2 += p.in[14][i] * p.in[15][i]; }
  float lam = expf(d1) - expf(d2) + 0.2f;
  int* cnt = (int*)(p.ws + OFF_CNT);
  while (true) {
    __syncthreads();
    if (tidx() == 0) *s_unitp = atomicAdd(cnt, 1);
    __syncthreads();
    int u = *s_unitp;
    if (u >= 1088) break;
    attn_unit(p, u, smem, lam);
  }
#ifdef PROBE_ATTN
  while (true) {
    __syncthreads();
    if (tidx() == 0) *s_unitp = atomicAdd(cnt + 1, 1);
    __syncthreads();
    int u = *s_unitp;
    if (u >= 1088) break;
    attn_unit(p, u, smem, lam);
  }
#endif
}

__device__ __forceinline__ void ph_rwkv_post(const P& p) {
  const int tid = tidx(), wave = tid >> 6;
  const bf* YF = (const bf*)p.out;
  const bf* YB = YF + (size_t)RT * 512;
  const bf* PV = (const bf*)(p.ws + OFF_PREP) + (size_t)2 * RT * 512;
  const bf* G = (const bf*)(p.ws + OFF_G);
  const float* BON = (const float*)(p.ws + OFF_BONUS);
  bf* O = (bf*)(p.ws + OFF_HO);
  const float lw = p.in[28][tid], lb = p.in[29][tid];
  for (int R0 = blockIdx.x * 4; R0 < RT; R0 += gridDim.x * 4) {
    float yf[4], yb4[4], pv[4], gg[4], bn[4];
#pragma unroll
    for (int i = 0; i < 4; ++i) {
      size_t o = (size_t)(R0 + i) * 512 + tid;
      yf[i] = bf2f(YF[o]); yb4[i] = bf2f(YB[o]); pv[i] = bf2f(PV[o]); gg[i] = bf2f(G[o]); bn[i] = BON[(size_t)(R0 + i) * 8 + wave];
    }
#pragma unroll
    for (int i = 0; i < 4; ++i) {
      float y = yf[i] + yb4[i];
      float mean = wave_sum(y) * (1.f / 64.f);
      float d = y - mean;
      float var = wave_sum(d * d) * (1.f / 64.f);
      float yn = d * rsqrtf(var + 64e-5f) * lw + lb;
      float outv = (yn + bn[i] * pv[i]) * gg[i];
      O[(size_t)(R0 + i) * 1024 + 512 + tid] = f2bf(outv);
    }
  }
}

__device__ __forceinline__ void ph_gla_gates(const P& p, char* smem) {
  float* up = (float*)smem;
  float* gbv = up + 2 * 16 * 256;
  const int tid = tidx();
  __syncthreads();
  for (int i = tid; i < 2 * 16 * 256; i += NT) up[i] = p.in[i < 4096 ? 46 : 48][i & 4095];
  for (int i = tid; i < 512; i += NT) gbv[i] = p.in[i < 256 ? 47 : 49][i & 255];
  __syncthreads();
  const bf* P1 = (const bf*)(p.ws + OFF_P1C);
  bf* LG = (bf*)(p.ws + OFF_HO);
  for (int it = blockIdx.x * NT + tid; it < RT * 32; it += gridDim.x * NT) {
    const int R = it >> 5, c8 = (it & 31) * 8;
    const uint4 g0 = *(const uint4*)(P1 + (size_t)R * 2080 + 2064), g1 = *(const uint4*)(P1 + (size_t)R * 2080 + 2072);
    float gd[16];
    gd[0] = bflo(g0.x); gd[1] = bfhi(g0.x); gd[2] = bflo(g0.y); gd[3] = bfhi(g0.y); gd[4] = bflo(g0.z); gd[5] = bfhi(g0.z); gd[6] = bflo(g0.w); gd[7] = bfhi(g0.w);
    gd[8] = bflo(g1.x); gd[9] = bfhi(g1.x); gd[10] = bflo(g1.y); gd[11] = bfhi(g1.y); gd[12] = bflo(g1.z); gd[13] = bfhi(g1.z); gd[14] = bflo(g1.w); gd[15] = bfhi(g1.w);
#pragma unroll
    for (int d = 0; d < 2; ++d) {
      float z[8];
#pragma unroll
      for (int e = 0; e < 8; ++e) z[e] = gbv[d * 256 + c8 + e];
#pragma unroll
      for (int r = 0; r < 16; ++r) {
        const float4 u0 = *(const float4*)(up + (d * 16 + r) * 256 + c8), u1 = *(const float4*)(up + (d * 16 + r) * 256 + c8 + 4);
        z[0] += gd[r] * u0.x; z[1] += gd[r] * u0.y; z[2] += gd[r] * u0.z; z[3] += gd[r] * u0.w;
        z[4] += gd[r] * u1.x; z[5] += gd[r] * u1.y; z[6] += gd[r] * u1.z; z[7] += gd[r] * u1.w;
      }
      uint4 o;
      o.x = pack2(-softplusf_(-z[0]) * (1.f / 16.f), -softplusf_(-z[1]) * (1.f / 16.f));
      o.y = pack2(-softplusf_(-z[2]) * (1.f / 16.f), -softplusf_(-z[3]) * (1.f / 16.f));
      o.z = pack2(-softplusf_(-z[4]) * (1.f / 16.f), -softplusf_(-z[5]) * (1.f / 16.f));
      o.w = pack2(-softplusf_(-z[6]) * (1.f / 16.f), -softplusf_(-z[7]) * (1.f / 16.f));
      *(uint4*)(LG + ((size_t)d * RT + R) * 256 + c8) = o;
    }
  }
}

__device__ __forceinline__ void ph_conv(const P& p) {
  const bf* XR = (const bf*)(p.ws + OFF_XRAW);
  bf* XO = (bf*)(p.ws + OFF_XBC);
  const float* cw = p.in[38];
  const float* cb = p.in[39];
  for (size_t it = (size_t)blockIdx.x * NT + tidx(); it < (size_t)RT * 128; it += (size_t)gridDim.x * NT) {
    int R = (int)(it >> 7), c8 = (int)(it & 127) * 8;
    int b = R / TA, a = R - b * TA;
    int lo = a < CTX ? 0 : CTX, hi = a < CTX ? CTX : TA;
    float acc[8];
#pragma unroll
    for (int e = 0; e < 8; ++e) acc[e] = cb[c8 + e];
#pragma unroll
    for (int j = 0; j < 5; ++j) {
      int aj = a + j - 2;
      if (aj >= lo && aj < hi) {
        uint4 v = *(const uint4*)(XR + (size_t)(R + j - 2) * 1024 + c8);
        const float* w = cw + j * 1024 + c8;
        acc[0] += w[0] * bflo(v.x); acc[1] += w[1] * bfhi(v.x);
        acc[2] += w[2] * bflo(v.y); acc[3] += w[3] * bfhi(v.y);
        acc[4] += w[4] * bflo(v.z); acc[5] += w[5] * bfhi(v.z);
        acc[6] += w[6] * bflo(v.w); acc[7] += w[7] * bfhi(v.w);
      }
    }
    uint4 o;
    o.x = pack2(siluf_(acc[0]), siluf_(acc[1]));
    o.y = pack2(siluf_(acc[2]), siluf_(acc[3]));
    o.z = pack2(siluf_(acc[4]), siluf_(acc[5]));
    o.w = pack2(siluf_(acc[6]), siluf_(acc[7]));
    *(uint4*)(XO + (size_t)R * 1024 + c8) = o;
  }
}

__device__ __forceinline__ void ssd_chain(const P& p, int chain, char* smem) {
  const int dir = chain & 1, hh = (chain >> 1) & 7, b = chain >> 4;
  const int grp = hh >> 2;
  float* cB = (float*)smem;
  float* cC = cB + 4096;
  float* cX = cC + 4096;
  float* cDA = cX + 2048;
  float* yb = cDA + 32;
  const int tid = tidx(), lane = tid & 63, wave = tid >> 6;
  const int l15 = lane & 15, lg = lane >> 4;
  const bf* XBC = (const bf*)(p.ws + OFF_XBC);
  const float* DTR = (const float*)(p.ws + OFF_DTRAW);
  bf* Y = (bf*)(p.ws + OFF_XRAW) + (size_t)dir * RT * 512;
  const float dtb = p.in[dir ? 42 : 40][hh];
  const float Aneg = -expf(p.in[dir ? 43 : 41][hh]);
  const int st = tid >> 4, q = tid & 15;
  const int r0 = wave * 8 + lg * 2;
  float s0[8], s1[8];
#pragma unroll
  for (int j = 0; j < 8; ++j) { s0[j] = 0.f; s1[j] = 0.f; }
  uint4 gB, gC;
  uint2 gX;
  float gD;
  {
    size_t R = (size_t)scan_row(b, dir, st);
    gB = *(const uint4*)(XBC + R * 1024 + 512 + grp * 128 + q * 8);
    gC = *(const uint4*)(XBC + R * 1024 + 768 + grp * 128 + q * 8);
    gX = *(const uint2*)(XBC + R * 1024 + hh * 64 + q * 4);
    gD = DTR[R * 16 + dir * 8 + hh];
  }
  const int NCH = TA / 32;
  for (int ch = 0; ch <= NCH; ++ch) {
    __syncthreads();
    if (ch > 0) {
      float4 y4 = *(const float4*)(yb + st * 64 + q * 4);
      uint2 o2;
      o2.x = pack2(y4.x, y4.y);
      o2.y = pack2(y4.z, y4.w);
      *(uint2*)(Y + (size_t)scan_row(b, dir, (ch - 1) * 32 + st) * 512 + hh * 64 + q * 4) = o2;
    }
    if (ch == NCH) break;
    {
      float dt = softplusf_(gD + dtb);
      float dA = expf(dt * Aneg);
      float* d = cB + st * 128 + q * 8;
      *(float4*)d = make_float4(bflo(gB.x), bfhi(gB.x), bflo(gB.y), bfhi(gB.y));
      *(float4*)(d + 4) = make_float4(bflo(gB.z), bfhi(gB.z), bflo(gB.w), bfhi(gB.w));
      d = cC + st * 128 + q * 8;
      *(float4*)d = make_float4(bflo(gC.x), bfhi(gC.x), bflo(gC.y), bfhi(gC.y));
      *(float4*)(d + 4) = make_float4(bflo(gC.z), bfhi(gC.z), bflo(gC.w), bfhi(gC.w));
      *(float4*)(cX + st * 64 + q * 4) = make_float4(bflo(gX.x) * dt, bfhi(gX.x) * dt, bflo(gX.y) * dt, bfhi(gX.y) * dt);
      if (q == 0) cDA[st] = dA;
    }
    __syncthreads();
    if (ch + 1 < NCH) {
      size_t R = (size_t)scan_row(b, dir, (ch + 1) * 32 + st);
      gB = *(const uint4*)(XBC + R * 1024 + 512 + grp * 128 + q * 8);
      gC = *(const uint4*)(XBC + R * 1024 + 768 + grp * 128 + q * 8);
      gX = *(const uint2*)(XBC + R * 1024 + hh * 64 + q * 4);
      gD = DTR[R * 16 + dir * 8 + hh];
    }
#pragma unroll 4
    for (int t = 0; t < 32; ++t) {
      float4 b0 = *(const float4*)(cB + t * 128 + l15 * 8);
      float4 b1 = *(const float4*)(cB + t * 128 + l15 * 8 + 4);
      float4 c0 = *(const float4*)(cC + t * 128 + l15 * 8);
      float4 c1 = *(const float4*)(cC + t * 128 + l15 * 8 + 4);
      float2 x2 = *(const float2*)(cX + t * 64 + r0);
      float dA = cDA[t];
      s0[0] = s0[0] * dA + x2.x * b0.x; s0[1] = s0[1] * dA + x2.x * b0.y; s0[2] = s0[2] * dA + x2.x * b0.z; s0[3] = s0[3] * dA + x2.x * b0.w;
      s0[4] = s0[4] * dA + x2.x * b1.x; s0[5] = s0[5] * dA + x2.x * b1.y; s0[6] = s0[6] * dA + x2.x * b1.z; s0[7] = s0[7] * dA + x2.x * b1.w;
      s1[0] = s1[0] * dA + x2.y * b0.x; s1[1] = s1[1] * dA + x2.y * b0.y; s1[2] = s1[2] * dA + x2.y * b0.z; s1[3] = s1[3] * dA + x2.y * b0.w;
      s1[4] = s1[4] * dA + x2.y * b1.x; s1[5] = s1[5] * dA + x2.y * b1.y; s1[6] = s1[6] * dA + x2.y * b1.z; s1[7] = s1[7] * dA + x2.y * b1.w;
      float y0 = s0[0] * c0.x + s0[1] * c0.y + s0[2] * c0.z + s0[3] * c0.w + s0[4] * c1.x + s0[5] * c1.y + s0[6] * c1.z + s0[7] * c1.w;
      float y1 = s1[0] * c0.x + s1[1] * c0.y + s1[2] * c0.z + s1[3] * c0.w + s1[4] * c1.x + s1[5] * c1.y + s1[6] * c1.z + s1[7] * c1.w;
      y0 = red16(y0);
      y1 = red16(y1);
      if (l15 == 0) *(float2*)(yb + t * 64 + r0) = make_float2(y0, y1);
    }
  }
}

__device__ __forceinline__ void gla_chain(const P& p, int chain, char* smem) {
  const int dir = chain & 1, h = (chain >> 1) & 3, b = chain >> 3;
  float* cQ = (float*)smem;
  float* cK = cQ + 2048;
  float* cD = cK + 2048;
  float* cV = cD + 2048;
  float* yb = cV + 4096;
  float* up = yb + 4096;
  float* gbias = up + 1024;
  const int tid = tidx(), lane = tid & 63, wave = tid >> 6;
  const int l15 = lane & 15, lg = lane >> 4;
  const bf* P1 = (const bf*)(p.ws + OFF_P1C);
  bf* Y = (bf*)(p.ws + OFF_GY) + (size_t)dir * RT * 512;
  const float* gup = p.in[dir ? 48 : 46];
  const float* gb = p.in[dir ? 49 : 47];
  __syncthreads();
  for (int i = tid; i < 1024; i += NT) up[i] = gup[(i >> 6) * 256 + h * 64 + (i & 63)];
  if (tid < 64) gbias[tid] = gb[h * 64 + tid];
  const int st = tid >> 4, q = tid & 15;
  const int r0 = wave * 16 + lg * 4;
  float s[4][4];
#pragma unroll
  for (int r = 0; r < 4; ++r)
#pragma unroll
    for (int j = 0; j < 4; ++j) s[r][j] = 0.f;
  uint2 gQ, gK;
  uint4 gV, gG0, gG1;
  {
    const bf* row = P1 + (size_t)scan_row(b, dir, st) * 2080;
    gQ = *(const uint2*)(row + 528 + h * 64 + q * 4);
    gK = *(const uint2*)(row + 784 + h * 64 + q * 4);
    gV = *(const uint4*)(row + 1040 + h * 128 + q * 8);
    gG0 = *(const uint4*)(row + 2064);
    gG1 = *(const uint4*)(row + 2072);
  }
  const int NCH = TA / 32;
  for (int ch = 0; ch <= NCH; ++ch) {
    __syncthreads();
    if (ch > 0) {
      float4 ya = *(const float4*)(yb + st * 128 + q * 8);
      float4 yc = *(const float4*)(yb + st * 128 + q * 8 + 4);
      uint4 o4;
      o4.x = pack2(ya.x, ya.y); o4.y = pack2(ya.z, ya.w); o4.z = pack2(yc.x, yc.y); o4.w = pack2(yc.z, yc.w);
      *(uint4*)(Y + (size_t)scan_row(b, dir, (ch - 1) * 32 + st) * 512 + h * 128 + q * 8) = o4;
    }
    if (ch == NCH) break;
    {
      float gd[16];
      gd[0] = bflo(gG0.x); gd[1] = bfhi(gG0.x); gd[2] = bflo(gG0.y); gd[3] = bfhi(gG0.y);
      gd[4] = bflo(gG0.z); gd[5] = bfhi(gG0.z); gd[6] = bflo(gG0.w); gd[7] = bfhi(gG0.w);
      gd[8] = bflo(gG1.x); gd[9] = bfhi(gG1.x); gd[10] = bflo(gG1.y); gd[11] = bfhi(gG1.y);
      gd[12] = bflo(gG1.z); gd[13] = bfhi(gG1.z); gd[14] = bflo(gG1.w); gd[15] = bfhi(gG1.w);
      float4 z = *(const float4*)(gbias + q * 4);
#pragma unroll
      for (int i = 0; i < 16; ++i) {
        float4 u4 = *(const float4*)(up + i * 64 + q * 4);
        z.x += gd[i] * u4.x; z.y += gd[i] * u4.y; z.z += gd[i] * u4.z; z.w += gd[i] * u4.w;
      }
      float4 dd;
      dd.x = expf(-softplusf_(-z.x) * (1.f / 16.f));
      dd.y = expf(-softplusf_(-z.y) * (1.f / 16.f));
      dd.z = expf(-softplusf_(-z.z) * (1.f / 16.f));
      dd.w = expf(-softplusf_(-z.w) * (1.f / 16.f));
      *(float4*)(cD + st * 64 + q * 4) = dd;
      *(float4*)(cQ + st * 64 + q * 4) = make_float4(bflo(gQ.x) * 0.125f, bfhi(gQ.x) * 0.125f, bflo(gQ.y) * 0.125f, bfhi(gQ.y) * 0.125f);
      *(float4*)(cK + st * 64 + q * 4) = make_float4(bflo(gK.x), bfhi(gK.x), bflo(gK.y), bfhi(gK.y));
      float* d = cV + st * 128 + q * 8;
      *(float4*)d = make_float4(bflo(gV.x), bfhi(gV.x), bflo(gV.y), bfhi(gV.y));
      *(float4*)(d + 4) = make_float4(bflo(gV.z), bfhi(gV.z), bflo(gV.w), bfhi(gV.w));
    }
    __syncthreads();
    if (ch + 1 < NCH) {
      const bf* row = P1 + (size_t)scan_row(b, dir, (ch + 1) * 32 + st) * 2080;
      gQ = *(const uint2*)(row + 528 + h * 64 + q * 4);
      gK = *(const uint2*)(row + 784 + h * 64 + q * 4);
      gV = *(const uint4*)(row + 1040 + h * 128 + q * 8);
      gG0 = *(const uint4*)(row + 2064);
      gG1 = *(const uint4*)(row + 2072);
    }
#pragma unroll 4
    for (int t = 0; t < 32; ++t) {
      float4 q4 = *(const float4*)(cQ + t * 64 + l15 * 4);
      float4 k4 = *(const float4*)(cK + t * 64 + l15 * 4);
      float4 d4 = *(const float4*)(cD + t * 64 + l15 * 4);
      float4 v4 = *(const float4*)(cV + t * 128 + r0);
      float vv[4] = {v4.x, v4.y, v4.z, v4.w};
      float yy[4];
#pragma unroll
      for (int r = 0; r < 4; ++r) {
        s[r][0] = s[r][0] * d4.x + k4.x * vv[r];
        s[r][1] = s[r][1] * d4.y + k4.y * vv[r];
        s[r][2] = s[r][2] * d4.z + k4.z * vv[r];
        s[r][3] = s[r][3] * d4.w + k4.w * vv[r];
        yy[r] = red16(s[r][0] * q4.x + s[r][1] * q4.y + s[r][2] * q4.z + s[r][3] * q4.w);
      }
      if (l15 == 0) *(float4*)(yb + t * 128 + r0) = make_float4(yy[0], yy[1], yy[2], yy[3]);
    }
  }
}

typedef __attribute__((address_space(3))) s16x4* lds_s16x4p;
template <int LD>
__device__ __forceinline__ bf16x8 trfrag_t(const bf* img, int r0, int c0, int lane) {
  const bf* pp = img + (r0 + ((lane & 15) >> 2)) * LD + c0 + (lane & 3) * 4;
  return tr_pair<4 * LD * 2>(pp);
}
#define trfrag(img, ld, r0, c0, lane) trfrag_t<ld>(img, r0, c0, lane)
__device__ __forceinline__ bf16x8 pack8(f32x4 a, f32x4 b) {
  i32x4 t;
  t[0] = (int)pack2(a[0], a[1]); t[1] = (int)pack2(a[2], a[3]); t[2] = (int)pack2(b[0], b[1]); t[3] = (int)pack2(b[2], b[3]);
  return __builtin_bit_cast(bf16x8, t);
}
__device__ __forceinline__ bf16x8 ld2x64(const bf* p0, const bf* p1) {
  uint2 a = *(const uint2*)p0, b2 = *(const uint2*)p1;
  i32x4 t;
  t[0] = (int)a.x; t[1] = (int)a.y; t[2] = (int)b2.x; t[3] = (int)b2.y;
  return __builtin_bit_cast(bf16x8, t);
}

__device__ __forceinline__ void gla_chain2(const P& p, int chain, int half, char* smem) {
  const int dir = chain & 1, h = (chain >> 1) & 3, b = chain >> 3;
  bf* Qs = (bf*)smem;
  bf* Ks = Qs + 64 * 72;
  bf* Vs = Ks + 64 * 72;
  bf* Ps = Vs + 64 * 144;
  bf* LGs = Ps + 64 * 72;
  float* segtot = (float*)(LGs + 64 * 72);
  float* dS = segtot + 512;
  const int tid = tidx(), lane = tid & 63, wave = tid >> 6;
  const int l15 = lane & 15, g = lane >> 4;
  const int ih = wave >> 2, vcol0 = (half * 4 + (wave & 3)) * 16;
  const bf* P1 = (const bf*)(p.ws + OFF_P1C);
  bf* Y = (bf*)(p.ws + OFF_GY) + (size_t)dir * RT * 512;
  const bf* LG = (const bf*)(p.ws + OFF_HO) + (size_t)dir * RT * 256;
  const int kc = tid & 63, seg = tid >> 6;
  const int stok = tid >> 3, sc8 = (tid & 7) * 8;
  f32x4 S[4];
#pragma unroll
  for (int kt = 0; kt < 4; ++kt) S[kt] = (f32x4){0.f, 0.f, 0.f, 0.f};
  uint4 rq, rk, rv0, rv1, rg;
  {
    const bf* row = P1 + (size_t)scan_row(b, dir, stok) * 2080;
    rq = *(const uint4*)(row + 528 + h * 64 + sc8);
    rk = *(const uint4*)(row + 784 + h * 64 + sc8);
    rv0 = *(const uint4*)(row + 1040 + h * 128 + sc8 * 2);
    rv1 = *(const uint4*)(row + 1040 + h * 128 + sc8 * 2 + 8);
    rg = *(const uint4*)(LG + (size_t)scan_row(b, dir, stok) * 256 + h * 64 + sc8);
  }
  const int NCH = TA / 64;
  for (int c = 0; c < NCH; ++c) {
    __syncthreads();
    *(uint4*)(Qs + stok * 72 + sc8) = rq;
    *(uint4*)(Ks + stok * 72 + sc8) = rk;
    *(uint4*)(Vs + stok * 144 + sc8 * 2) = rv0;
    *(uint4*)(Vs + stok * 144 + sc8 * 2 + 8) = rv1;
    *(uint4*)(LGs + stok * 72 + sc8) = rg;
    __syncthreads();
    if (c + 1 < NCH) {
      const bf* row = P1 + (size_t)scan_row(b, dir, (c + 1) * 64 + stok) * 2080;
      rq = *(const uint4*)(row + 528 + h * 64 + sc8);
      rk = *(const uint4*)(row + 784 + h * 64 + sc8);
      rv0 = *(const uint4*)(row + 1040 + h * 128 + sc8 * 2);
      rv1 = *(const uint4*)(row + 1040 + h * 128 + sc8 * 2 + 8);
      rg = *(const uint4*)(LG + (size_t)scan_row(b, dir, (c + 1) * 64 + stok) * 256 + h * 64 + sc8);
    }
    float lc[8];
    {
      float run = 0.f;
#pragma unroll
      for (int ii = 0; ii < 8; ++ii) {
        run += bf2f(LGs[(seg * 8 + ii) * 72 + kc]);
        lc[ii] = run;
      }
      segtot[seg * 64 + kc] = run;
    }
    __syncthreads();
    {
      float off = 0.f, tot = 0.f;
#pragma unroll
      for (int s2 = 0; s2 < 8; ++s2) {
        float t = segtot[s2 * 64 + kc];
        tot += t;
        off += (s2 < seg) ? t : 0.f;
      }
#pragma unroll
      for (int ii = 0; ii < 8; ++ii) {
        int i = seg * 8 + ii;
        float cum = off + lc[ii];
        float qv = bf2f(Qs[i * 72 + kc]), kv = bf2f(Ks[i * 72 + kc]);
        float eq = __expf(cum - tot);
        Qs[i * 72 + kc] = f2bf(qv * 0.125f * eq);
        Ks[i * 72 + kc] = f2bf(kv * __builtin_amdgcn_rcpf(eq));
      }
      if (seg == 0) dS[kc] = __expf(tot);
    }
    __syncthreads();
#pragma unroll
    for (int kt = 0; kt < 4; ++kt) {
      float4 d4 = *(const float4*)(dS + kt * 16 + g * 4);
      S[kt][0] *= d4.x; S[kt][1] *= d4.y; S[kt][2] *= d4.z; S[kt][3] *= d4.w;
    }
#pragma unroll
    for (int tt = 0; tt < 2; ++tt) {
      int idx = wave * 2 + tt, jt = idx >> 2, it = idx & 3;
      f32x4 acc = (f32x4){0.f, 0.f, 0.f, 0.f};
      if (jt <= it) {
#pragma unroll
        for (int ks = 0; ks < 2; ++ks) {
          bf16x8 a = *(const bf16x8*)(Ks + (jt * 16 + l15) * 72 + ks * 32 + g * 8);
          bf16x8 bq = *(const bf16x8*)(Qs + (it * 16 + l15) * 72 + ks * 32 + g * 8);
          acc = __builtin_amdgcn_mfma_f32_16x16x32_bf16(a, bq, acc, 0, 0, 0);
        }
        int i = it * 16 + l15;
#pragma unroll
        for (int r = 0; r < 4; ++r) { int j = jt * 16 + g * 4 + r; acc[r] = (j <= i) ? acc[r] : 0.f; }
      }
      uint2 o;
      o.x = pack2(acc[0], acc[1]);
      o.y = pack2(acc[2], acc[3]);
      *(uint2*)(Ps + (it * 16 + l15) * 72 + jt * 16 + g * 4) = o;
    }
    __syncthreads();
    f32x4 y[2];
    y[0] = (f32x4){0.f, 0.f, 0.f, 0.f};
    y[1] = (f32x4){0.f, 0.f, 0.f, 0.f};
#pragma unroll
    for (int s2 = 0; s2 < 2; ++s2) {
      bf16x8 sf = pack8(S[2 * s2], S[2 * s2 + 1]);
#pragma unroll
      for (int ii = 0; ii < 2; ++ii) {
        const bf* qr = Qs + ((ih * 2 + ii) * 16 + l15) * 72 + g * 4;
        bf16x8 aq = ld2x64(qr + (2 * s2) * 16, qr + (2 * s2 + 1) * 16);
        y[ii] = __builtin_amdgcn_mfma_f32_16x16x32_bf16(aq, sf, y[ii], 0, 0, 0);
      }
    }
    {
      bf16x8 vfs[2];
      tr_dual<32 * 144 * 2, 4 * 144 * 2>(trbase(Vs, 144, g * 8, vcol0, lane), vfs[0], vfs[1]);
#pragma unroll
      for (int s2 = 0; s2 < 2; ++s2) {
#pragma unroll
        for (int ii = 0; ii < 2; ++ii) {
          bf16x8 ap = *(const bf16x8*)(Ps + ((ih * 2 + ii) * 16 + l15) * 72 + s2 * 32 + g * 8);
          y[ii] = __builtin_amdgcn_mfma_f32_16x16x32_bf16(ap, vfs[s2], y[ii], 0, 0, 0);
        }
        bf16x8 ak[4];
        tr_quad<32, 4 * 72 * 2>(trbase(Ks, 72, s2 * 32 + g * 8, 0, lane), ak[0], ak[1], ak[2], ak[3]);
#pragma unroll
        for (int kt = 0; kt < 4; ++kt) S[kt] = __builtin_amdgcn_mfma_f32_16x16x32_bf16(ak[kt], vfs[s2], S[kt], 0, 0, 0);
      }
    }
#pragma unroll
    for (int ii = 0; ii < 2; ++ii)
#pragma unroll
      for (int r = 0; r < 4; ++r) {
        int i = (ih * 2 + ii) * 16 + g * 4 + r;
        Y[(size_t)scan_row(b, dir, c * 64 + i) * 512 + h * 128 + vcol0 + l15] = f2bf(y[ii][r]);
      }
  }
}

__device__ __forceinline__ void ssd_chain2(const P& p, int chain, char* smem) {
  const int dir = chain & 1, hh = (chain >> 1) & 7, b = chain >> 4;
  const int grp = hh >> 2;
  bf* Cs = (bf*)smem;
  bf* Bs = Cs + 64 * 136;
  bf* Xs = Bs + 64 * 136;
  bf* Xw = Xs + 64 * 72;
  bf* Ps = Xw + 64 * 72;
  float* dtS = (float*)(Ps + 64 * 72);
  float* cumS = dtS + 64;
  float* ecS = cumS + 64;
  float* totS = ecS + 64;
  const int tid = tidx(), lane = tid & 63, wave = tid >> 6;
  const int l15 = lane & 15, g = lane >> 4;
  const int vt = wave & 3, ih = wave >> 2;
  const bf* XBC = (const bf*)(p.ws + OFF_XBC);
  const float* DTR = (const float*)(p.ws + OFF_DTRAW);
  bf* Y = (bf*)(p.ws + OFF_XRAW) + (size_t)dir * RT * 512;
  const float dtb = p.in[dir ? 42 : 40][hh];
  const float Aneg = -expf(p.in[dir ? 43 : 41][hh]);
  const int stok = tid >> 3, sc = tid & 7;
  f32x4 S[8];
#pragma unroll
  for (int nt = 0; nt < 8; ++nt) S[nt] = (f32x4){0.f, 0.f, 0.f, 0.f};
  uint4 rc0, rc1, rb0, rb1, rx;
  float rdt = 0.f;
  {
    const bf* row = XBC + (size_t)scan_row(b, dir, stok) * 1024;
    rb0 = *(const uint4*)(row + 512 + grp * 128 + sc * 16);
    rb1 = *(const uint4*)(row + 512 + grp * 128 + sc * 16 + 8);
    rc0 = *(const uint4*)(row + 768 + grp * 128 + sc * 16);
    rc1 = *(const uint4*)(row + 768 + grp * 128 + sc * 16 + 8);
    rx = *(const uint4*)(row + hh * 64 + sc * 8);
    if (tid < 64) rdt = DTR[(size_t)scan_row(b, dir, tid) * 16 + dir * 8 + hh];
  }
  const int NCH = TA / 64;
  for (int c = 0; c < NCH; ++c) {
    __syncthreads();
    *(uint4*)(Cs + stok * 136 + sc * 16) = rc0;
    *(uint4*)(Cs + stok * 136 + sc * 16 + 8) = rc1;
    *(uint4*)(Bs + stok * 136 + sc * 16) = rb0;
    *(uint4*)(Bs + stok * 136 + sc * 16 + 8) = rb1;
    if (tid < 64) {
      float dt = softplusf_(rdt + dtb);
      float cum = dt * Aneg;
#pragma unroll
      for (int o = 1; o < 64; o <<= 1) {
        float t = __shfl_up(cum, o);
        if (lane >= o) cum += t;
      }
      float tot = __shfl(cum, 63);
      dtS[lane] = dt;
      cumS[lane] = cum;
      ecS[lane] = __expf(cum);
      if (lane == 0) totS[0] = tot;
    }
    __syncthreads();
    const uint4 cx = rx;
    if (c + 1 < NCH) {
      const bf* row = XBC + (size_t)scan_row(b, dir, (c + 1) * 64 + stok) * 1024;
      rb0 = *(const uint4*)(row + 512 + grp * 128 + sc * 16);
      rb1 = *(const uint4*)(row + 512 + grp * 128 + sc * 16 + 8);
      rc0 = *(const uint4*)(row + 768 + grp * 128 + sc * 16);
      rc1 = *(const uint4*)(row + 768 + grp * 128 + sc * 16 + 8);
      rx = *(const uint4*)(row + hh * 64 + sc * 8);
      if (tid < 64) rdt = DTR[(size_t)scan_row(b, dir, (c + 1) * 64 + tid) * 16 + dir * 8 + hh];
    }
    const float tot = totS[0];
    {
      float dt = dtS[stok];
      float w = dt * __expf(tot - cumS[stok]);
      float x0 = bflo(cx.x), x1 = bfhi(cx.x), x2 = bflo(cx.y), x3 = bfhi(cx.y), x4 = bflo(cx.z), x5 = bfhi(cx.z), x6 = bflo(cx.w), x7 = bfhi(cx.w);
      uint4 o;
      o.x = pack2(x0 * dt, x1 * dt); o.y = pack2(x2 * dt, x3 * dt); o.z = pack2(x4 * dt, x5 * dt); o.w = pack2(x6 * dt, x7 * dt);
      *(uint4*)(Xs + stok * 72 + sc * 8) = o;
      o.x = pack2(x0 * w, x1 * w); o.y = pack2(x2 * w, x3 * w); o.z = pack2(x4 * w, x5 * w); o.w = pack2(x6 * w, x7 * w);
      *(uint4*)(Xw + stok * 72 + sc * 8) = o;
    }
#pragma unroll
    for (int tt = 0; tt < 2; ++tt) {
      int idx = wave * 2 + tt, jt = idx >> 2, it = idx & 3;
      f32x4 acc = (f32x4){0.f, 0.f, 0.f, 0.f};
      if (jt <= it) {
#pragma unroll
        for (int ks = 0; ks < 4; ++ks) {
          bf16x8 a = *(const bf16x8*)(Bs + (jt * 16 + l15) * 136 + ks * 32 + g * 8);
          bf16x8 bq = *(const bf16x8*)(Cs + (it * 16 + l15) * 136 + ks * 32 + g * 8);
          acc = __builtin_amdgcn_mfma_f32_16x16x32_bf16(a, bq, acc, 0, 0, 0);
        }
        int i = it * 16 + l15;
        float ci = cumS[i];
        float4 cj = *(const float4*)(cumS + jt * 16 + g * 4);
        int j0 = jt * 16 + g * 4;
        acc[0] = (j0 + 0 <= i) ? acc[0] * __expf(ci - cj.x) : 0.f;
        acc[1] = (j0 + 1 <= i) ? acc[1] * __expf(ci - cj.y) : 0.f;
        acc[2] = (j0 + 2 <= i) ? acc[2] * __expf(ci - cj.z) : 0.f;
        acc[3] = (j0 + 3 <= i) ? acc[3] * __expf(ci - cj.w) : 0.f;
      }
      uint2 o;
      o.x = pack2(acc[0], acc[1]);
      o.y = pack2(acc[2], acc[3]);
      *(uint2*)(Ps + (it * 16 + l15) * 72 + jt * 16 + g * 4) = o;
    }
    __syncthreads();
    f32x4 y[2];
    y[0] = (f32x4){0.f, 0.f, 0.f, 0.f};
    y[1] = (f32x4){0.f, 0.f, 0.f, 0.f};
#pragma unroll
    for (int s2 = 0; s2 < 4; ++s2) {
      bf16x8 sf = pack8(S[2 * s2], S[2 * s2 + 1]);
#pragma unroll
      for (int ii = 0; ii < 2; ++ii) {
        const bf* qr = Cs + ((ih * 2 + ii) * 16 + l15) * 136 + g * 4;
        bf16x8 aq = ld2x64(qr + (2 * s2) * 16, qr + (2 * s2 + 1) * 16);
        y[ii] = __builtin_amdgcn_mfma_f32_16x16x32_bf16(aq, sf, y[ii], 0, 0, 0);
      }
    }
    {
      float et = __expf(tot);
#pragma unroll
      for (int nt = 0; nt < 8; ++nt) { S[nt][0] *= et; S[nt][1] *= et; S[nt][2] *= et; S[nt][3] *= et; }
    }
#pragma unroll
    for (int ii = 0; ii < 2; ++ii) {
      float4 e4 = *(const float4*)(ecS + (ih * 2 + ii) * 16 + g * 4);
      y[ii][0] *= e4.x; y[ii][1] *= e4.y; y[ii][2] *= e4.z; y[ii][3] *= e4.w;
    }
    {
      bf16x8 xfs[2], xws[2];
      tr_dual<32 * 72 * 2, 4 * 72 * 2>(trbase(Xs, 72, g * 8, vt * 16, lane), xfs[0], xfs[1]);
      tr_dual<32 * 72 * 2, 4 * 72 * 2>(trbase(Xw, 72, g * 8, vt * 16, lane), xws[0], xws[1]);
#pragma unroll
      for (int s2 = 0; s2 < 2; ++s2) {
#pragma unroll
        for (int ii = 0; ii < 2; ++ii) {
          bf16x8 ap = *(const bf16x8*)(Ps + ((ih * 2 + ii) * 16 + l15) * 72 + s2 * 32 + g * 8);
          y[ii] = __builtin_amdgcn_mfma_f32_16x16x32_bf16(ap, xfs[s2], y[ii], 0, 0, 0);
        }
#pragma unroll
        for (int nq = 0; nq < 2; ++nq) {
          bf16x8 ab[4];
          tr_quad<32, 4 * 136 * 2>(trbase(Bs, 136, s2 * 32 + g * 8, nq * 64, lane), ab[0], ab[1], ab[2], ab[3]);
#pragma unroll
          for (int n4 = 0; n4 < 4; ++n4) S[nq * 4 + n4] = __builtin_amdgcn_mfma_f32_16x16x32_bf16(ab[n4], xws[s2], S[nq * 4 + n4], 0, 0, 0);
        }
      }
    }
#pragma unroll
    for (int ii = 0; ii < 2; ++ii)
#pragma unroll
      for (int r = 0; r < 4; ++r) {
        int i = (ih * 2 + ii) * 16 + g * 4 + r;
        Y[(size_t)scan_row(b, dir, c * 64 + i) * 512 + hh * 64 + vt * 16 + l15] = f2bf(y[ii][r]);
      }
  }
}

__device__ __forceinline__ void rwkv_chain2(const P& p, int chain, char* smem) {
  const int dir = chain & 1, h = (chain >> 1) & 7, b = chain >> 4;
  bf* KT = (bf*)smem;
  bf* RTi = KT + 4608;
  bf* KH = RTi + 4608;
  bf* BH = KH + 4608;
  bf* VV = BH + 4608;
  bf* MAkk = VV + 4608;
  bf* MBrk = MAkk + 4608;
  bf* MBrb = MBrk + 4608;
  bf* UN = MBrb + 4608;
  bf* LWs = UN + 4608;
  float* AKB = (float*)(LWs + 4608);
  float* RH = AKB + 64 * 68;
  float* segtot = RH + 64 * 68;
  float* dS = segtot + 512;
  const int tid = tidx(), lane = tid & 63, wave = tid >> 6;
  const int l15 = lane & 15, g = lane >> 4;
  const int vt = wave & 3, ih = wave >> 2;
  const bf* PR = (const bf*)(p.ws + OFF_PREP);
  const bf* PK = PR + (size_t)RT * 512;
  const bf* PV = PK + (size_t)RT * 512;
  const bf* PKK = PV + (size_t)RT * 512;
  const bf* PKA = PKK + (size_t)RT * 512;
  const bf* PLW = PKA + (size_t)RT * 512 + (size_t)dir * RT * 512;
  bf* Y = (bf*)p.out + (size_t)dir * RT * 512;
  const int kc = tid & 63, seg = tid >> 6;
  const int stok = tid >> 3, sc8 = (tid & 7) * 8;
  f32x4 T[4];
#pragma unroll
  for (int kt = 0; kt < 4; ++kt) T[kt] = (f32x4){0.f, 0.f, 0.f, 0.f};
  uint4 gR, gK, gV, gKK, gKA, gW;
  {
    size_t o = (size_t)scan_row(b, dir, stok) * 512 + h * 64 + sc8;
    gR = *(const uint4*)(PR + o); gK = *(const uint4*)(PK + o); gV = *(const uint4*)(PV + o);
    gKK = *(const uint4*)(PKK + o); gKA = *(const uint4*)(PKA + o); gW = *(const uint4*)(PLW + o);
  }
  const int NCH = TA / 64;
  for (int c = 0; c < NCH; ++c) {
    __syncthreads();
    *(uint4*)(RTi + stok * 72 + sc8) = gR;
    *(uint4*)(KH + stok * 72 + sc8) = gK;
    *(uint4*)(VV + stok * 72 + sc8) = gV;
    *(uint4*)(KT + stok * 72 + sc8) = gKK;
    *(uint4*)(BH + stok * 72 + sc8) = gKA;
    *(uint4*)(LWs + stok * 72 + sc8) = gW;
    __syncthreads();
    if (c + 1 < NCH) {
      size_t o = (size_t)scan_row(b, dir, (c + 1) * 64 + stok) * 512 + h * 64 + sc8;
      gR = *(const uint4*)(PR + o); gK = *(const uint4*)(PK + o); gV = *(const uint4*)(PV + o);
      gKK = *(const uint4*)(PKK + o); gKA = *(const uint4*)(PKA + o); gW = *(const uint4*)(PLW + o);
    }
    float lc[8];
    {
      float run = 0.f;
#pragma unroll
      for (int ii = 0; ii < 8; ++ii) {
        run += bf2f(LWs[(seg * 8 + ii) * 72 + kc]);
        lc[ii] = run;
      }
      segtot[seg * 64 + kc] = run;
    }
    __syncthreads();
    {
      float off = 0.f, tot = 0.f;
#pragma unroll
      for (int s2 = 0; s2 < 8; ++s2) {
        float t = segtot[s2 * 64 + kc];
        tot += t;
        off += (s2 < seg) ? t : 0.f;
      }
#pragma unroll
      for (int ii = 0; ii < 8; ++ii) {
        const int i = seg * 8 + ii;
        const float cum = off + lc[ii];
        const float cumx = off + (ii > 0 ? lc[ii > 0 ? ii - 1 : 0] : 0.f);
        const float eR = __expf(cum - tot);
        const float eK = __builtin_amdgcn_rcpf(eR);
        const float eX = __expf(cumx - tot);
        const int o = i * 72 + kc;
        RTi[o] = f2bf(bf2f(RTi[o]) * eR);
        KH[o] = f2bf(bf2f(KH[o]) * eK);
        BH[o] = f2bf(bf2f(BH[o]) * eK);
        KT[o] = f2bf(bf2f(KT[o]) * eX);
      }
      if (seg == 0) dS[kc] = __expf(tot);
    }
    __syncthreads();
#pragma unroll
    for (int kt = 0; kt < 4; ++kt) {
      float4 d4 = *(const float4*)(dS + kt * 16 + g * 4);
      T[kt][0] *= d4.x; T[kt][1] *= d4.y; T[kt][2] *= d4.z; T[kt][3] *= d4.w;
    }
#pragma unroll
    for (int tt = 0; tt < 2; ++tt) {
      const int idx = wave * 2 + tt, jt = idx >> 2, it = idx & 3;
      f32x4 akb = (f32x4){0.f, 0.f, 0.f, 0.f}, akk = akb, brk = akb, brb = akb;
      if (jt <= it) {
#pragma unroll
        for (int ks = 0; ks < 2; ++ks) {
          bf16x8 aKH = *(const bf16x8*)(KH + (jt * 16 + l15) * 72 + ks * 32 + g * 8);
          bf16x8 aBH = *(const bf16x8*)(BH + (jt * 16 + l15) * 72 + ks * 32 + g * 8);
          bf16x8 bKT = *(const bf16x8*)(KT + (it * 16 + l15) * 72 + ks * 32 + g * 8);
          bf16x8 bRT = *(const bf16x8*)(RTi + (it * 16 + l15) * 72 + ks * 32 + g * 8);
          akb = __builtin_amdgcn_mfma_f32_16x16x32_bf16(aBH, bKT, akb, 0, 0, 0);
          akk = __builtin_amdgcn_mfma_f32_16x16x32_bf16(aKH, bKT, akk, 0, 0, 0);
          brk = __builtin_amdgcn_mfma_f32_16x16x32_bf16(aKH, bRT, brk, 0, 0, 0);
          brb = __builtin_amdgcn_mfma_f32_16x16x32_bf16(aBH, bRT, brb, 0, 0, 0);
        }
        const int i = it * 16 + l15;
#pragma unroll
        for (int r = 0; r < 4; ++r) {
          const int j = jt * 16 + g * 4 + r;
          akb[r] = (j < i) ? akb[r] : 0.f;
          akk[r] = (j < i) ? akk[r] : 0.f;
          brk[r] = (j <= i) ? brk[r] : 0.f;
          brb[r] = (j <= i) ? brb[r] : 0.f;
        }
      }
      const int orow = (it * 16 + l15), ocol = jt * 16 + g * 4;
      uint2 o;
      o.x = pack2(akk[0], akk[1]); o.y = pack2(akk[2], akk[3]);
      *(uint2*)(MAkk + orow * 72 + ocol) = o;
      o.x = pack2(brk[0], brk[1]); o.y = pack2(brk[2], brk[3]);
      *(uint2*)(MBrk + orow * 72 + ocol) = o;
      o.x = pack2(brb[0], brb[1]); o.y = pack2(brb[2], brb[3]);
      *(uint2*)(MBrb + orow * 72 + ocol) = o;
      *(float4*)(AKB + orow * 68 + ocol) = make_float4(akb[0], akb[1], akb[2], akb[3]);
    }
    __syncthreads();
    bf16x8 tf0 = pack8(T[0], T[1]), tf1 = pack8(T[2], T[3]);
    f32x4 yv[2];
    {
      bf16x8 vf0, vf1;
      tr_dual<32 * 72 * 2, 4 * 72 * 2>(trbase(VV, 72, g * 8, vt * 16, lane), vf0, vf1);
#pragma unroll
      for (int ii = 0; ii < 2; ++ii) {
        const int it = ih * 2 + ii;
        f32x4 acc = (f32x4){0.f, 0.f, 0.f, 0.f};
        const bf* qr = KT + (it * 16 + l15) * 72 + g * 4;
        acc = __builtin_amdgcn_mfma_f32_16x16x32_bf16(ld2x64(qr, qr + 16), tf0, acc, 0, 0, 0);
        acc = __builtin_amdgcn_mfma_f32_16x16x32_bf16(ld2x64(qr + 32, qr + 48), tf1, acc, 0, 0, 0);
        const bf* ar = MAkk + (it * 16 + l15) * 72 + g * 8;
        acc = __builtin_amdgcn_mfma_f32_16x16x32_bf16(*(const bf16x8*)ar, vf0, acc, 0, 0, 0);
        acc = __builtin_amdgcn_mfma_f32_16x16x32_bf16(*(const bf16x8*)(ar + 32), vf1, acc, 0, 0, 0);
#pragma unroll
        for (int r = 0; r < 4; ++r) RH[(it * 16 + g * 4 + r) * 68 + vt * 16 + l15] = acc[r];
        f32x4 ya = (f32x4){0.f, 0.f, 0.f, 0.f};
        const bf* rr = RTi + (it * 16 + l15) * 72 + g * 4;
        ya = __builtin_amdgcn_mfma_f32_16x16x32_bf16(ld2x64(rr, rr + 16), tf0, ya, 0, 0, 0);
        ya = __builtin_amdgcn_mfma_f32_16x16x32_bf16(ld2x64(rr + 32, rr + 48), tf1, ya, 0, 0, 0);
        const bf* br = MBrk + (it * 16 + l15) * 72 + g * 8;
        ya = __builtin_amdgcn_mfma_f32_16x16x32_bf16(*(const bf16x8*)br, vf0, ya, 0, 0, 0);
        ya = __builtin_amdgcn_mfma_f32_16x16x32_bf16(*(const bf16x8*)(br + 32), vf1, ya, 0, 0, 0);
        yv[ii] = ya;
      }
      {
        bf16x8 k0[4], k1[4];
        tr_quad<32, 4 * 72 * 2>(trbase(KH, 72, g * 8, 0, lane), k0[0], k0[1], k0[2], k0[3]);
        tr_quad<32, 4 * 72 * 2>(trbase(KH, 72, 32 + g * 8, 0, lane), k1[0], k1[1], k1[2], k1[3]);
#pragma unroll
        for (int kt = 0; kt < 4; ++kt) {
          T[kt] = __builtin_amdgcn_mfma_f32_16x16x32_bf16(k0[kt], vf0, T[kt], 0, 0, 0);
          T[kt] = __builtin_amdgcn_mfma_f32_16x16x32_bf16(k1[kt], vf1, T[kt], 0, 0, 0);
        }
      }
    }
    __syncthreads();
    for (int rb = 0; rb < 8; ++rb) {
      if (wave == 0) {
        float acc[8];
#pragma unroll
        for (int q = 0; q < 8; ++q) acc[q] = RH[(rb * 8 + q) * 68 + lane];
#pragma unroll
        for (int q = 1; q < 8; ++q) {
          const float4 d0 = *(const float4*)(AKB + (rb * 8 + q) * 68 + rb * 8);
          const float4 d1 = *(const float4*)(AKB + (rb * 8 + q) * 68 + rb * 8 + 4);
          const float dd[8] = {d0.x, d0.y, d0.z, d0.w, d1.x, d1.y, d1.z, d1.w};
#pragma unroll
          for (int cc = 0; cc < q; ++cc) acc[q] -= dd[cc] * acc[cc];
        }
#pragma unroll
        for (int q = 0; q < 8; ++q) {
          RH[(rb * 8 + q) * 68 + lane] = acc[q];
          UN[(rb * 8 + q) * 72 + lane] = f2bf(-acc[q]);
        }
      }
      __syncthreads();
      if (rb < 7) {
        float uq[8];
#pragma unroll
        for (int q = 0; q < 8; ++q) uq[q] = RH[(rb * 8 + q) * 68 + lane];
        for (int r = (rb + 1) * 8 + wave; r < 64; r += 8) {
          const float4 a0 = *(const float4*)(AKB + r * 68 + rb * 8);
          const float4 a1 = *(const float4*)(AKB + r * 68 + rb * 8 + 4);
          float Rv = RH[r * 68 + lane];
          Rv -= ((a0.x * uq[0] + a0.y * uq[1]) + (a0.z * uq[2] + a0.w * uq[3])) + ((a1.x * uq[4] + a1.y * uq[5]) + (a1.z * uq[6] + a1.w * uq[7]));
          RH[r * 68 + lane] = Rv;
        }
        __syncthreads();
      }
    }
    __syncthreads();
    {
      bf16x8 uf0, uf1;
      tr_dual<32 * 72 * 2, 4 * 72 * 2>(trbase(UN, 72, g * 8, vt * 16, lane), uf0, uf1);
#pragma unroll
      for (int ii = 0; ii < 2; ++ii) {
        const int it = ih * 2 + ii;
        const bf* br = MBrb + (it * 16 + l15) * 72 + g * 8;
        yv[ii] = __builtin_amdgcn_mfma_f32_16x16x32_bf16(*(const bf16x8*)br, uf0, yv[ii], 0, 0, 0);
        yv[ii] = __builtin_amdgcn_mfma_f32_16x16x32_bf16(*(const bf16x8*)(br + 32), uf1, yv[ii], 0, 0, 0);
      }
      {
        bf16x8 b0[4], b1[4];
        tr_quad<32, 4 * 72 * 2>(trbase(BH, 72, g * 8, 0, lane), b0[0], b0[1], b0[2], b0[3]);
        tr_quad<32, 4 * 72 * 2>(trbase(BH, 72, 32 + g * 8, 0, lane), b1[0], b1[1], b1[2], b1[3]);
#pragma unroll
        for (int kt = 0; kt < 4; ++kt) {
          T[kt] = __builtin_amdgcn_mfma_f32_16x16x32_bf16(b0[kt], uf0, T[kt], 0, 0, 0);
          T[kt] = __builtin_amdgcn_mfma_f32_16x16x32_bf16(b1[kt], uf1, T[kt], 0, 0, 0);
        }
      }
    }
#pragma unroll
    for (int ii = 0; ii < 2; ++ii)
#pragma unroll
      for (int r = 0; r < 4; ++r) {
        const int i = (ih * 2 + ii) * 16 + g * 4 + r;
        Y[(size_t)scan_row(b, dir, c * 64 + i) * 512 + h * 64 + vt * 16 + l15] = f2bf(yv[ii][r]);
      }
  }
}

__device__ __forceinline__ void ph_mix1(const P& p, char* smem) {
  for (int u = blockIdx.x; u < 256; u += gridDim.x) {
    if (u < 128) ssd_chain2(p, u, smem);
    else gla_chain2(p, (u - 128) >> 1, (u - 128) & 1, smem);
  }
}

__device__ __forceinline__ void ph_post1(const P& p, char* smem) {
  float* ws1 = (float*)smem;
  float* ws2 = ws1 + 32;
  const int tid = tidx(), lane = tid & 63, wave = tid >> 6;
  const bf* SYF = (const bf*)(p.ws + OFF_XRAW);
  const bf* SYB = SYF + (size_t)RT * 512;
  const bf* GYF = (const bf*)(p.ws + OFF_GY);
  const bf* GYB = GYF + (size_t)RT * 512;
  const bf* XBC = (const bf*)(p.ws + OFF_XBC);
  const bf* P1 = (const bf*)(p.ws + OFF_P1C);
  bf* O = (bf*)(p.ws + OFF_HO);
  const float dsk = p.in[44][tid >> 6];
  const float sn = p.in[45][tid];
  const float gn = p.in[50][tid & 127];
  for (int rr0 = blockIdx.x * 4; rr0 < NBAT * SEQ; rr0 += gridDim.x * 4) {
    float y[4], y2[4], zg[4], gg[4];
    int Rr[4];
#pragma unroll
    for (int i = 0; i < 4; ++i) {
      int rr = rr0 + i;
      int R = (rr >> 12) * TA + CTX + (rr & 4095);
      Rr[i] = R;
      size_t o = (size_t)R * 512 + tid;
      y[i] = bf2f(SYF[o]) + bf2f(SYB[o]) + bf2f(XBC[(size_t)R * 1024 + tid]) * dsk;
      zg[i] = bf2f(P1[(size_t)R * 2080 + tid]);
      y2[i] = bf2f(GYF[o]) + bf2f(GYB[o]);
      gg[i] = bf2f(P1[(size_t)R * 2080 + 1552 + tid]);
    }
    __syncthreads();
#pragma unroll
    for (int i = 0; i < 4; ++i) {
      y[i] *= siluf_(zg[i]);
      float s1 = wave_sum(y[i] * y[i]);
      float s2 = wave_sum(y2[i] * y2[i]);
      if (lane == 0) { ws1[i * 8 + wave] = s1; ws2[i * 8 + wave] = s2; }
    }
    __syncthreads();
#pragma unroll
    for (int i = 0; i < 4; ++i) {
      int g4 = i * 8 + (wave >> 2) * 4;
      float t1 = ws1[g4] + ws1[g4 + 1] + ws1[g4 + 2] + ws1[g4 + 3];
      int g2 = i * 8 + (wave >> 1) * 2;
      float t2 = ws2[g2] + ws2[g2 + 1];
      float o1 = y[i] * rsqrtf(t1 * (1.f / 256.f) + 1e-6f) * sn;
      float o2 = y2[i] * rsqrtf(t2 * (1.f / 128.f) + 1e-6f) * gn * siluf_(gg[i]);
      O[(size_t)Rr[i] * 1024 + tid] = f2bf(o1);
      O[(size_t)Rr[i] * 1024 + 512 + tid] = f2bf(o2);
    }
  }
}

__device__ __forceinline__ void ph_final(const P& p) {
  const int lane = tidx() & 63, wave = tidx() >> 6;
  const float* g = p.in[51];
  for (int r = blockIdx.x * 8 + wave; r < NBAT * SEQ; r += gridDim.x * 8) {
    float* row = p.out + (size_t)r * 1024;
    float4 v[4];
    float ss = 0.f;
#pragma unroll
    for (int i = 0; i < 4; ++i) {
      v[i] = *(const float4*)(row + i * 256 + lane * 4);
      ss += v[i].x * v[i].x + v[i].y * v[i].y + v[i].z * v[i].z + v[i].w * v[i].w;
    }
    ss = wave_sum(ss);
    float rs = rsqrtf(ss * (1.f / 1024.f) + 1e-6f);
#pragma unroll
    for (int i = 0; i < 4; ++i) {
      float4 gg = *(const float4*)(g + i * 256 + lane * 4);
      float4 o = make_float4(v[i].x * rs * gg.x, v[i].y * rs * gg.y, v[i].z * rs * gg.z, v[i].w * rs * gg.w);
      *(float4*)(row + i * 256 + lane * 4) = o;
    }
  }
}

#define XB_TMO      128
#define XB_XCNT(j)  (256  + 64 * (j))
#define XB_XSUB(j)  (1280 + 64 * (j))
#define XB_XGEN(j)  (2304 + 64 * (j))
#define XB_TOP      3328
#define XB_TOPGEN   3392
#define XCD_BAR_WORDS 3456
#define XB_SPIN_CAP (1u << 18)
#define LAS __attribute__((address_space(3)))
__device__ __forceinline__ unsigned xb_ld(unsigned* q)              { return __hip_atomic_load(q, __ATOMIC_RELAXED, __HIP_MEMORY_SCOPE_AGENT); }
__device__ __forceinline__ unsigned xb_add(unsigned* q, unsigned v) { return __hip_atomic_fetch_add(q, v, __ATOMIC_RELAXED, __HIP_MEMORY_SCOPE_AGENT); }
__device__ __forceinline__ unsigned xb_xcc_id() { return (unsigned)__builtin_amdgcn_s_getreg((3 << 11) | 20) & 0xFu; }
#define XB_SPIN(cond, bar) do { unsigned _sp = 0; while (cond) { __builtin_amdgcn_s_sleep(1); \
    if ((++_sp & 255u) == 0u) { if (xb_ld(&(bar)[XB_TMO])) break; if (_sp > XB_SPIN_CAP) { atomicAdd(&(bar)[XB_TMO], 1u); break; } } } } while (0)
struct XcdBarrier { unsigned* bar; unsigned x; volatile LAS unsigned* st; };
__device__ __forceinline__ XcdBarrier xcd_barrier_post(unsigned* bar, volatile LAS unsigned* st) {
  XcdBarrier b; b.bar = bar; b.x = xb_xcc_id(); b.st = st;
  if (threadIdx.x == 0) (void)xb_add(&bar[XB_XCNT(b.x)], 1u);
  return b;
}
__device__ __forceinline__ void xcd_barrier_complete(unsigned* bar, unsigned x, unsigned& nloc, unsigned& nx) {
  const unsigned G = gridDim.x * gridDim.y * gridDim.z;
  unsigned sum, cnt, mine, sp = 0u;
  for (;;) {
    sum = 0u; cnt = 0u; mine = 0u;
#pragma unroll
    for (unsigned j = 0; j < 16; ++j) { const unsigned c = xb_ld(&bar[XB_XCNT(j)]); sum += c; cnt += (c > 0u) ? 1u : 0u; mine = (j == x) ? c : mine; }
    if (sum == G) break;
    __builtin_amdgcn_s_sleep(1);
    if ((++sp & 255u) == 0u) { if (xb_ld(&bar[XB_TMO])) break; if (sp > XB_SPIN_CAP) { atomicAdd(&bar[XB_TMO], 1u); break; } }
  }
  nloc = mine > 0u ? mine : 1u; nx = cnt > 0u ? cnt : 1u;
}
__device__ __forceinline__ void xcd_barrier(const XcdBarrier& b) {
  asm volatile("s_waitcnt vmcnt(0)" ::: "memory");
  __syncthreads();
  if (threadIdx.x == 0) {
    unsigned* bar = b.bar;
    __builtin_amdgcn_s_waitcnt(0);
    unsigned nloc = b.st[0], nx = b.st[1];
    if (nloc == 0u) { xcd_barrier_complete(bar, b.x, nloc, nx); b.st[0] = nloc; b.st[1] = nx; }
    const unsigned old = xb_add(&bar[XB_XSUB(b.x)], 1u);
    const unsigned gen = old / nloc;
    if (old + 1u == (gen + 1u) * nloc) {
      __builtin_amdgcn_fence(__ATOMIC_RELEASE, "agent");
      asm volatile("s_waitcnt vmcnt(0)" ::: "memory");
      const unsigned og = xb_add(&bar[XB_TOP], 1u);
      const unsigned tg = og / nx;
      if (og + 1u == (tg + 1u) * nx) xb_add(&bar[XB_TOPGEN], 1u);
      else XB_SPIN(xb_ld(&bar[XB_TOPGEN]) == tg, bar);
      __builtin_amdgcn_fence(__ATOMIC_ACQUIRE, "agent");
      xb_add(&bar[XB_XGEN(b.x)], 1u);
      asm volatile("s_waitcnt vmcnt(0)" ::: "memory");
    } else {
      XB_SPIN(xb_ld(&bar[XB_XGEN(b.x)]) == gen, bar);
      __builtin_amdgcn_fence(__ATOMIC_ACQUIRE, "agent");
      asm volatile("s_waitcnt vmcnt(0)" ::: "memory");
    }
  }
  __syncthreads();
}

constexpr int NPH = 20;
template <int PH>
__device__ __forceinline__ void run_phase(const P& p, char* smem) {
  const bf* WT = (const bf*)(p.ws + OFF_WT);
  const bf* WT1 = (const bf*)(p.ws + OFF_WT1);
  const bf* HO = (const bf*)(p.ws + OFF_HO);
  const bf* HID = (const bf*)(p.ws + OFF_HID);
  if constexpr (PH == 0) {
    if (blockIdx.x == 0 && tidx() == 0) { *(int*)(p.ws + OFF_CNT) = 0; *((int*)(p.ws + OFF_CNT) + 1) = 0; }
    ph_mod(p, smem);
    ph_lw(p);
    ph_wt(p, 0, smem, blockIdx.x, gridDim.x);
  } else if constexpr (PH == 1) ph_ada(p, 0, 0, 1, 0);
  else if constexpr (PH == 2) ph_gemm<0>(p, HO, WT + WT_IN, 1024, 13, 0, 0, smem);
  else if constexpr (PH == 3) {
    ph_rope(p, smem);
    ph_rwkv_prep(p, smem);
#ifdef PROBE_PREP
    __syncthreads();
    ph_rwkv_prep(p, smem);
#endif
  }
  else if constexpr (PH == 4) ph_mix0(p, smem);
  else if constexpr (PH == 5) ph_rwkv_post(p);
  else if constexpr (PH == 6) ph_gemm<2>(p, HO, WT + WT_OUT, 1024, 4, 0, 0, smem);
  else if constexpr (PH == 7) ph_ada(p, 0, 1, 0, 0);
  else if constexpr (PH == 8) ph_gemm<3>(p, HO, WT + WT_W1, 1024, 16, 0, 0, smem);
  else if constexpr (PH == 9) {
    ph_gemm<4>(p, HID, WT + WT_W2, 4096, 4, 0, 0, smem);
    const int extra = 544 % (int)gridDim.x;
    if ((int)gridDim.x - extra >= 32) { if ((int)blockIdx.x >= extra) ph_wt(p, 1, smem, blockIdx.x - extra, gridDim.x - extra); }
    else ph_wt(p, 1, smem, blockIdx.x, gridDim.x);
  }
  else if constexpr (PH == 10) ph_ada(p, 1, 0, 0, 0);
  else if constexpr (PH == 11) ph_gemm<1>(p, HO, WT1 + WT_IN, 1024, 13, 1, 0, smem);
  else if constexpr (PH == 12) { ph_conv(p); ph_gla_gates(p, smem); }
  else if constexpr (PH == 13) ph_mix1(p, smem);
  else if constexpr (PH == 14) ph_post1(p, smem);
  else if constexpr (PH == 15) ph_gemm<2>(p, HO, WT1 + WT_OUT, 1024, 4, 1, 1, smem);
  else if constexpr (PH == 16) ph_ada(p, 1, 1, 0, 1);
  else if constexpr (PH == 17) ph_gemm<3>(p, HO, WT1 + WT_W1, 1024, 16, 1, 1, smem);
  else if constexpr (PH == 18) ph_gemm<4>(p, HID, WT1 + WT_W2, 4096, 4, 1, 1, smem);
  else ph_final(p);
}

constexpr int LDS_BYTES = 131072 + 64;
template <int PH>
__device__ __forceinline__ void run_all(const P& p, char* smem, const XcdBarrier& xb) {
  run_phase<PH>(p, smem);
#ifdef PROBE_MASK
  if constexpr (((PROBE_MASK) >> PH) & 1) {
    xcd_barrier(xb);
    if constexpr (PH == 4) {
      if (blockIdx.x == 0 && tidx() == 0) *(int*)(p.ws + OFF_CNT) = 0;
      xcd_barrier(xb);
    }
    run_phase<PH>(p, smem);
  }
#endif
  if constexpr (PH + 1 < NPH) {
    if constexpr (PH == 0) cg::this_grid().sync();
    else xcd_barrier(xb);
    run_all<PH + 1>(p, smem, xb);
  }
}
__global__ void __launch_bounds__(NT) mega(P p) {
  extern __shared__ __attribute__((aligned(16))) char smem[];
  volatile LAS unsigned* st = (volatile LAS unsigned*)(smem + 131072 + 16);
  if (threadIdx.x == 0) { st[0] = 0u; st[1] = 0u; }
  __syncthreads();
  const XcdBarrier xb = xcd_barrier_post((unsigned*)(p.ws + OFF_BAR), st);
  run_all<0>(p, smem, xb);
}

extern "C" void kernel_launch(void* const* d_in, const int* in_sizes, int n_in, void* d_out, int out_size, void* d_ws,
                              size_t ws_size, hipStream_t stream) {
  P p{};
  for (int i = 0; i < 52; ++i) p.in[i] = (const float*)d_in[i];
  p.out = (float*)d_out;
  p.ws = (char*)d_ws;
  static int grid_blocks = 0;
  if (!grid_blocks) {
    int dev = 0, cus = 0, per_cu = 0;
    (void)hipGetDevice(&dev);
    (void)hipDeviceGetAttribute(&cus, hipDeviceAttributeMultiprocessorCount, dev);
    (void)hipFuncSetAttribute((const void*)mega, hipFuncAttributeMaxDynamicSharedMemorySize, LDS_BYTES);
    (void)hipOccupancyMaxActiveBlocksPerMultiprocessor(&per_cu, mega, NT, LDS_BYTES);
    if (per_cu < 1) per_cu = 1;
    if (per_cu > 1) per_cu = 1;
    grid_blocks = cus * per_cu;
  }
  (void)hipMemsetAsync((char*)d_ws + OFF_BAR, 0, XCD_BAR_WORDS * sizeof(unsigned), stream);
  void* args[] = {&p};
  hipError_t e = hipLaunchCooperativeKernel((void*)mega, dim3(grid_blocks), dim3(NT), args, LDS_BYTES, stream);
  if (e != hipSuccess) fprintf(stderr, "cooperative launch failed: %s (grid %d)\n", hipGetErrorString(e), grid_blocks);
}
```

```cpp
#include <hip/hip_runtime.h>
#include <hip/hip_cooperative_groups.h>
#include <cstdio>
namespace cg = cooperative_groups;

#ifndef MODE_COOP
#define MODE_COOP 1
#endif

typedef unsigned short bf;
typedef __attribute__((ext_vector_type(8))) short bf16x8;
typedef __attribute__((ext_vector_type(4))) float f32x4;
typedef __attribute__((ext_vector_type(4))) int i32x4;

constexpr int NT = 512;
constexpr int Dm = 1024, NBAT = 8, SEQ = 4096, CTX = 256, TA = 4352, RT = NBAT * TA;

constexpr size_t OFF_MOD = 0;
constexpr size_t OFF_CNT = 450000;
constexpr size_t OFF_BAR = 458752;
constexpr size_t OFF_WT = 524288;
constexpr size_t WT_IN = 0, WT_OUT = (size_t)3328 * 1024, WT_W1 = WT_OUT + (size_t)1024 * 1024, WT_W2 = WT_W1 + (size_t)4096 * 1024;
constexpr size_t OFF_CTXX = OFF_WT + (size_t)12544 * 1024 * 2;
constexpr size_t OFF_HO = OFF_CTXX + (size_t)2048 * 1024 * 4;
constexpr size_t OFF_BIG = OFF_HO + (size_t)RT * 1024 * 2;
constexpr size_t SZ512 = (size_t)RT * 512 * 2;
constexpr size_t OFF_QKV = OFF_BIG;
constexpr size_t OFF_PREP = OFF_QKV + (size_t)RT * 1536 * 2;
constexpr size_t OFF_G = OFF_PREP + 7 * SZ512;
constexpr size_t OFF_BONUS = OFF_G + SZ512;
constexpr size_t OFF_LW = OFF_BONUS + (size_t)RT * 8 * 4;
constexpr size_t OFF_WT1 = 500170752;
constexpr size_t OFF_HID = OFF_BIG;
constexpr size_t OFF_P1C = OFF_BIG;
constexpr size_t OFF_XRAW = OFF_P1C + (size_t)RT * 2080 * 2;
constexpr size_t OFF_DTRAW = OFF_XRAW + (size_t)RT * 1024 * 2;
constexpr size_t OFF_XBC = OFF_DTRAW + (size_t)RT * 16 * 4;
constexpr size_t OFF_GY = OFF_XBC + (size_t)RT * 1024 * 2;

struct P {
  const float* in[52];
  float* out;
  char* ws;
};

__device__ __forceinline__ int tidx() { int t = threadIdx.x; asm volatile("" : "+v"(t)); return t; }
__device__ __forceinline__ bf f2bf(float f) { __bf16 r = (__bf16)f; return __builtin_bit_cast(bf, r); }
__device__ __forceinline__ float bf2f(bf h) { return __uint_as_float(((unsigned)h) << 16); }
__device__ __forceinline__ float bflo(unsigned u) { return __uint_as_float(u << 16); }
__device__ __forceinline__ float bfhi(unsigned u) { return __uint_as_float(u & 0xffff0000u); }
typedef __bf16 bf16x2_t __attribute__((ext_vector_type(2)));
typedef float f32x2_t __attribute__((ext_vector_type(2)));
__device__ __forceinline__ unsigned pack2(float a, float b) { f32x2_t v = {a, b}; bf16x2_t r = __builtin_convertvector(v, bf16x2_t); return __builtin_bit_cast(unsigned, r); }
__device__ __forceinline__ float sigmoidf_(float x) { return __builtin_amdgcn_rcpf(1.f + __expf(-x)); }
__device__ __forceinline__ float softplusf_(float x) { return x > 15.f ? x : __logf(1.f + __expf(x)); }
__device__ __forceinline__ float siluf_(float x) { return x * __builtin_amdgcn_rcpf(1.f + __expf(-x)); }
__device__ __forceinline__ float wave_sum(float v) {
#pragma unroll
  for (int o = 32; o >= 1; o >>= 1) v += __shfl_xor(v, o);
  return v;
}
template <int C>
__device__ __forceinline__ float dppf(float x) {
  return __builtin_bit_cast(float, __builtin_amdgcn_update_dpp(0, __builtin_bit_cast(int, x), C, 0xF, 0xF, true));
}
__device__ __forceinline__ float red16(float x) {
  x += dppf<0xB1>(x);
  x += dppf<0x4E>(x);
  x += dppf<0x141>(x);
  x += dppf<0x128>(x);
  return x;
}
__device__ __forceinline__ float* xrow(const P& p, int R) {
  int b = R / TA, a = R - b * TA;
  if (a < CTX) return (float*)(p.ws + OFF_CTXX) + (size_t)(b * CTX + a) * Dm;
  return p.out + (size_t)(b * SEQ + a - CTX) * Dm;
}
__device__ __forceinline__ const float* inrow(const P& p, int R) {
  int b = R / TA, a = R - b * TA;
  if (a < CTX) return p.in[2] + (size_t)(b * CTX + a) * Dm;
  return p.in[0] + (size_t)(b * SEQ + a - CTX) * Dm;
}
__device__ __forceinline__ int mrow(int R) {
  int b = R / TA, a = R - b * TA;
  return a < CTX ? 8 : b;
}

__device__ __forceinline__ void ph_mod(const P& p, char* smem) {
  float* sc = (float*)smem;
  float* red = sc + 9 * 1024;
  const int tid = tidx();
  bool loaded = false;
  for (int unit = blockIdx.x; unit < 2 * 192; unit += gridDim.x) {
    int layer = unit / 192, cch = unit - layer * 192;
    const float* W = p.in[layer ? 30 : 4];
    const float* bias = p.in[layer ? 31 : 5];
    __syncthreads();
    if (!loaded) {
      for (int i = tid; i < 9 * 1024; i += NT) {
        int r = i >> 10, k = i & 1023;
        float v = (r < 8) ? p.in[1][r * 1024 + k] : p.in[3][k];
        sc[i] = siluf_(v);
      }
      loaded = true;
      __syncthreads();
    }
    int cl = tid & 31, kg = tid >> 5;
    int col = cch * 32 + cl;
    float acc[9];
#pragma unroll
    for (int r = 0; r < 9; ++r) acc[r] = 0.f;
    for (int k = kg * 64; k < kg * 64 + 64; ++k) {
      float w = W[(size_t)k * 6144 + col];
#pragma unroll
      for (int r = 0; r < 9; ++r) acc[r] += sc[r * 1024 + k] * w;
    }
#pragma unroll
    for (int r = 0; r < 9; ++r) red[(kg * 9 + r) * 32 + cl] = acc[r];
    __syncthreads();
    if (tid < 288) {
      int r = tid >> 5, c = tid & 31;
      float s = 0.f;
#pragma unroll
      for (int g = 0; g < 16; ++g) s += red[(g * 9 + r) * 32 + c];
      ((float*)(p.ws + OFF_MOD))[(size_t)(layer * 9 + r) * 6144 + cch * 32 + c] = s + bias[cch * 32 + c];
    }
  }
}

__device__ __forceinline__ void transpose_one(const float* W, bf* Wt, int K, int N, int Npad, int vb, int nvb, char* smem) {
  float* tile = (float*)smem;
  const int tid = tidx();
  int ntn = Npad / 64, ntk = K / 64;
  for (int t = vb; t < ntn * ntk; t += nvb) {
    int tn = t / ntk, tk = t - tn * ntk;
    int n0 = tn * 64, k0 = tk * 64;
    __syncthreads();
#pragma unroll
    for (int i = 0; i < 8; ++i) {
      int kk = (tid >> 6) + 8 * i, nn = tid & 63;
      float v = (n0 + nn < N) ? W[(size_t)(k0 + kk) * N + n0 + nn] : 0.f;
      tile[kk * 65 + nn] = v;
    }
    __syncthreads();
#pragma unroll
    for (int i = 0; i < 8; ++i) {
      int nn = (tid >> 6) + 8 * i, kk = tid & 63;
      Wt[(size_t)(n0 + nn) * K + k0 + kk] = f2bf(tile[kk * 65 + nn]);
    }
  }
}
__device__ __forceinline__ void ph_wt(const P& p, int layer, char* smem, int b, int nb) {
  bf* WT = (bf*)(p.ws + (layer ? OFF_WT1 : OFF_WT));
  int base = layer ? 34 : 8;
  int nin = layer ? 3104 : 3328, ninp = 3328;
  for (int mtx = 0; mtx < 4; ++mtx) {
    const float* W = p.in[base + mtx];
    bf* dst = WT + (mtx == 0 ? WT_IN : mtx == 1 ? WT_OUT : mtx == 2 ? WT_W1 : WT_W2);
    int K = mtx == 3 ? 4096 : 1024;
    int N = mtx == 0 ? nin : mtx == 2 ? 4096 : 1024;
    int Np = mtx == 0 ? ninp : N;
    transpose_one(W, dst, K, N, Np, (b + (nb / 4) * mtx) % nb, nb, smem);
  }
}

__device__ __forceinline__ void ph_ada(const P& p, int layer, int which, int useInput, int latonly) {
  const int lane = tidx() & 63, wave = tidx() >> 6;
  const float* ng = p.in[(layer ? 32 : 6) + which];
  const float* mod = (const float*)(p.ws + OFF_MOD);
  bf* H = (bf*)(p.ws + OFF_HO);
  for (int R = blockIdx.x * 8 + wave; R < RT; R += gridDim.x * 8) {
    int b = R / TA, a = R - b * TA;
    if (latonly && a < CTX) continue;
    const float* src = useInput ? inrow(p, R) : xrow(p, R);
    float4 v[4];
    float ss = 0.f;
#pragma unroll
    for (int i = 0; i < 4; ++i) {
      v[i] = *(const float4*)(src + i * 256 + lane * 4);
      ss += v[i].x * v[i].x + v[i].y * v[i].y + v[i].z * v[i].z + v[i].w * v[i].w;
    }
    ss = wave_sum(ss);
    float rs = rsqrtf(ss * (1.f / 1024.f) + 1e-6f);
    int mr = a < CTX ? 8 : b;
    const float* sh = mod + (size_t)(layer * 9 + mr) * 6144 + (which * 3 + 0) * 1024;
    const float* scl = mod + (size_t)(layer * 9 + mr) * 6144 + (which * 3 + 1) * 1024;
#pragma unroll
    for (int i = 0; i < 4; ++i) {
      int k = i * 256 + lane * 4;
      float4 g = *(const float4*)(ng + k);
      float4 s4 = *(const float4*)(sh + k);
      float4 c4 = *(const float4*)(scl + k);
      float o0 = v[i].x * rs * g.x * (1.f + c4.x) + s4.x;
      float o1 = v[i].y * rs * g.y * (1.f + c4.y) + s4.y;
      float o2 = v[i].z * rs * g.z * (1.f + c4.z) + s4.z;
      float o3 = v[i].w * rs * g.w * (1.f + c4.w) + s4.w;
      uint2 o;
      o.x = pack2(o0, o1);
      o.y = pack2(o2, o3);
      *(uint2*)(H + (size_t)R * 1024 + k) = o;
    }
  }
}

namespace pg8 {
#define PG8_LAS __attribute__((address_space(3)))
typedef float f32x2 __attribute__((ext_vector_type(2)));
typedef unsigned u32x4 __attribute__((ext_vector_type(4)));
constexpr int BM = 256, BK = 64, HALF = 128, HTB = HALF * BK * 2, STAGE_BYTES = 8 * HTB, NXCD = 8, WGM = 8;
__device__ __forceinline__ int lds_byte(int r, int c) { const int st = (r >> 4) * 2 + (c >> 5), rr = r & 15, cc = c & 31, ob = rr * 64 + cc * 2; return st * 1024 + (ob ^ (((ob >> 9) & 1) << 5)); }
__device__ __forceinline__ void stage_rc(int b, int& R, int& C) { const int st = b / 1024, sb = b % 1024, swz = sb ^ (((sb >> 9) & 1) << 5); R = (st >> 1) * 16 + swz / 64; C = (st & 1) * 32 + (swz % 64) / 2; }
__device__ __forceinline__ int perm32(int rho) { const int n = rho >> 4, i = rho & 15; return 8 * (i >> 2) + 4 * n + (i & 3); }
struct Unit { int pm, pn; };
struct Gemm { const bf* A; const bf* Bt; int K; };
struct Order {
  int nM, nN, nwg, G, c, latonly;
  __device__ void init(int nM_, int nN_, int G_, int c_, int lat) { nM = nM_; nN = nN_; nwg = nM * nN; G = G_; c = c_; latonly = lat; }
  __device__ bool next(int i, Unit& u) const {
    const long L = (long)i * G + c;
    if (L >= nwg) return false;
    int wgid = (int)L;
    { const int q = nwg / NXCD, r = nwg % NXCD, xcd = wgid % NXCD, off = wgid / NXCD; wgid = (xcd < r ? xcd * (q + 1) : r * (q + 1) + (xcd - r) * q) + off; }
    const int nig = WGM * nN, gid = wgid / nig, fm = gid * WGM, gsz = (nM - fm) < WGM ? (nM - fm) : WGM;
    int pm = fm + ((wgid % nig) % gsz);
    u.pn = (wgid % nig) / gsz;
    u.pm = latonly ? ((pm >> 4) * 17 + 1 + (pm & 15)) : pm;
    return true;
  }
};
__device__ __forceinline__ unsigned cvt_pk_bf16(float lo, float hi) { return pack2(lo, hi); }

template <int EPI>
struct Epi {
  static constexpr bool PERM = (EPI == 0 || EPI == 1 || EPI == 3);
  P p;
  int layer;
  __device__ __forceinline__ void operator()(const f32x4 (&acc)[2][2][4][2], const Unit& u, int wr, int wc, int fr, int fq) const {
#pragma unroll
    for (int ai = 0; ai < 2; ++ai)
#pragma unroll
      for (int m = 0; m < 4; ++m) {
        const int row = u.pm * BM + ai * HALF + wr * 64 + m * 16 + fr;
        if constexpr (PERM) {
#pragma unroll
          for (int bj = 0; bj < 2; ++bj) {
            const int c0 = u.pn * BM + bj * HALF + wc * 32 + 8 * fq;
            f32x4 v0 = acc[ai][bj][m][0], v1 = acc[ai][bj][m][1];
            if constexpr (EPI == 3) {
#pragma unroll
              for (int j = 0; j < 4; ++j) { float a = v0[j] > 0.f ? v0[j] : 0.f; v0[j] = a * a; float b2 = v1[j] > 0.f ? v1[j] : 0.f; v1[j] = b2 * b2; }
            }
            u32x4 w;
            w.x = cvt_pk_bf16(v0[0], v0[1]); w.y = cvt_pk_bf16(v0[2], v0[3]); w.z = cvt_pk_bf16(v1[0], v1[1]); w.w = cvt_pk_bf16(v1[2], v1[3]);
            if constexpr (EPI == 0) {
              bf* dst = c0 < 1536 ? (bf*)(p.ws + OFF_QKV) + (size_t)row * 1536 + c0 : (bf*)p.out + (size_t)row * 1792 + (c0 - 1536);
              *(u32x4*)dst = w;
            } else if constexpr (EPI == 1) {
              if (c0 < 512) *(u32x4*)((bf*)(p.ws + OFF_P1C) + (size_t)row * 2080 + c0) = w;
              else if (c0 < 1536) *(u32x4*)((bf*)(p.ws + OFF_XRAW) + (size_t)row * 1024 + (c0 - 512)) = w;
              else if (c0 < 1552) { float* d = (float*)(p.ws + OFF_DTRAW) + (size_t)row * 16 + (c0 - 1536); *(f32x4*)d = v0; *(f32x4*)(d + 4) = v1; }
              else if (c0 < 3104) *(u32x4*)((bf*)(p.ws + OFF_P1C) + (size_t)row * 2080 + (c0 - 1024)) = w;
            } else {
              *(u32x4*)((bf*)(p.ws + OFF_HID) + (size_t)row * 4096 + c0) = w;
            }
          }
        } else {
          const float* gate = (const float*)(p.ws + OFF_MOD) + (size_t)(layer * 9 + mrow(row)) * 6144 + (EPI == 2 ? 2 : 5) * 1024;
          float* xr = xrow(p, row);
          const float* br = (EPI == 2 && layer == 0) ? inrow(p, row) : xr;
#pragma unroll
          for (int bj = 0; bj < 2; ++bj)
#pragma unroll
            for (int n = 0; n < 2; ++n) {
              const int c = u.pn * BM + bj * HALF + wc * 32 + 16 * n + 4 * fq;
              f32x4 gt = *(const f32x4*)(gate + c);
              f32x4 bs = *(const f32x4*)(br + c);
              *(f32x4*)(xr + c) = bs + gt * acc[ai][bj][m][n];
            }
        }
      }
  }
};

template <class EpiT>
__device__ __forceinline__ void gemm_phase(PG8_LAS unsigned char* lds, const Gemm g, const Order& S, const EpiT& E) {
  const int tid = tidx(), wid = __builtin_amdgcn_readfirstlane(tid >> 6), lane = tid & 63, wr = wid >> 2, wc = wid & 3, fr = lane & 15, fq = lane >> 4;
  const int K = g.K, nt = K / BK;
  unsigned voffA[2], voffB[2];
#pragma unroll
  for (int i = 0; i < 2; ++i) { int R, C; stage_rc(tid * 16 + i * 8192, R, C); const int Rb = EpiT::PERM ? ((R & ~31) + perm32(R & 31)) : R;
    voffA[i] = (unsigned)(R * K + C) * 2u; voffB[i] = (unsigned)(Rb * K + C) * 2u; }
  const size_t kstep = (size_t)(BK * 2);
  const size_t hstep = (size_t)HALF * K * 2;
  const size_t tstep = 2 * hstep;
  const unsigned ldsw = (unsigned)wid * 1024u;
  const int aoff = lds_byte(wr * 64 + fr, fq * 8), boff = lds_byte(wc * 32 + fr, fq * 8);
#define PG8_SA(b, h) (((b) * 2 + (h)) * HTB)
#define PG8_SB(b, h) ((4 + (b) * 2 + (h)) * HTB)
#define PG8_STAGE(bufoff, gbase, voff) do { _Pragma("unroll") for (int _i = 0; _i < 2; ++_i) \
        __builtin_amdgcn_global_load_lds((const unsigned*)((const char*)(gbase) + (voff)[_i]), (PG8_LAS unsigned*)(lds + (bufoff) + ldsw + _i * 8192), 16, 0, 0); } while (0)
#define PG8_LDA(dst, b, h) do { _Pragma("unroll") for (int m = 0; m < 4; ++m) _Pragma("unroll") for (int k = 0; k < 2; ++k) dst[m][k] = *(const PG8_LAS bf16x8*)(lds + PG8_SA(b, h) + aoff + m * 2048 + k * 1024); } while (0)
#define PG8_LDB(dst, b, h) do { _Pragma("unroll") for (int n = 0; n < 2; ++n) _Pragma("unroll") for (int k = 0; k < 2; ++k) dst[n][k] = *(const PG8_LAS bf16x8*)(lds + PG8_SB(b, h) + boff + n * 2048 + k * 1024); } while (0)
#define PG8_MMA(ai, bj, At, Bt) do { __builtin_amdgcn_s_setprio(1); _Pragma("unroll") for (int m = 0; m < 4; ++m) _Pragma("unroll") for (int n = 0; n < 2; ++n) _Pragma("unroll") for (int k = 0; k < 2; ++k) \
        acc[ai][bj][m][n] = __builtin_amdgcn_mfma_f32_16x16x32_bf16(Bt[n][k], At[m][k], acc[ai][bj][m][n], 0, 0, 0); __builtin_amdgcn_s_setprio(0); } while (0)
#define PG8_WAIT_V(n) asm volatile("s_waitcnt vmcnt(" #n ")" ::: "memory")
#define PG8_WAIT_L(n) asm volatile("s_waitcnt lgkmcnt(" #n ")" ::: "memory")
#define PG8_BAR __builtin_amdgcn_s_barrier()
#define PG8_SCHED __builtin_amdgcn_sched_barrier(0)
  Unit cur, nxt; int ui = 0;
  if (!S.next(0, cur)) return;
  f32x4 acc[2][2][4][2];
#pragma unroll
  for (int a = 0; a < 2; ++a)
#pragma unroll
    for (int b = 0; b < 2; ++b)
#pragma unroll
      for (int m = 0; m < 4; ++m)
#pragma unroll
        for (int n = 0; n < 2; ++n) acc[a][b][m][n] = (f32x4){0.f, 0.f, 0.f, 0.f};
  bf16x8 At[4][2], B0[2][2], B1[2][2];
  const char* cA = (const char*)g.A + (size_t)cur.pm * tstep; const char* cB = (const char*)g.Bt + (size_t)cur.pn * tstep;
  PG8_STAGE(PG8_SB(0, 0), cB, voffB); PG8_STAGE(PG8_SA(0, 0), cA, voffA); PG8_STAGE(PG8_SB(0, 1), cB + hstep, voffB); PG8_STAGE(PG8_SA(0, 1), cA + hstep, voffA);
  if (wr == 1) PG8_BAR;
  PG8_WAIT_V(4); PG8_BAR;
  PG8_STAGE(PG8_SB(1, 0), cB + kstep, voffB); PG8_STAGE(PG8_SA(1, 0), cA + kstep, voffA); PG8_STAGE(PG8_SB(1, 1), cB + hstep + kstep, voffB);
  PG8_WAIT_V(6); PG8_BAR;
  for (;;) {
    const bool has_next = S.next(ui + 1, nxt);
    const char* nA = has_next ? (const char*)g.A + (size_t)nxt.pm * tstep : cA; const char* nB = has_next ? (const char*)g.Bt + (size_t)nxt.pn * tstep : cB;
    for (int t = 0; t < nt; t += 2) {
      const bool last = (t == nt - 2);
      const char* a1 = cA + (size_t)(t + 1) * kstep;
      const char* a2 = last ? nA : cA + (size_t)(t + 2) * kstep; const char* b2 = last ? nB : cB + (size_t)(t + 2) * kstep;
      const char* a3 = a2 + kstep; const char* b3 = b2 + kstep;
      PG8_LDB(B0, 0, 0); PG8_SCHED; PG8_LDA(At, 0, 0); PG8_STAGE(PG8_SA(1, 1), a1 + hstep, voffA);
      PG8_WAIT_L(8); PG8_BAR; PG8_WAIT_L(0); PG8_MMA(0, 0, At, B0); PG8_BAR; PG8_SCHED;
      PG8_LDB(B1, 0, 1); PG8_STAGE(PG8_SB(0, 0), b2, voffB);
      PG8_BAR; PG8_WAIT_L(0); PG8_MMA(0, 1, At, B1); PG8_BAR;
      PG8_LDA(At, 0, 1); PG8_STAGE(PG8_SA(0, 0), a2, voffA);
      PG8_BAR; PG8_WAIT_L(0); PG8_MMA(1, 0, At, B0); PG8_BAR; PG8_SCHED;
      PG8_STAGE(PG8_SB(0, 1), b2 + hstep, voffB);
      PG8_WAIT_V(6); PG8_BAR; PG8_MMA(1, 1, At, B1); PG8_BAR;
      PG8_LDB(B0, 1, 0); PG8_SCHED; PG8_LDA(At, 1, 0); PG8_STAGE(PG8_SA(0, 1), a2 + hstep, voffA);
      PG8_WAIT_L(8); PG8_BAR; PG8_WAIT_L(0); PG8_MMA(0, 0, At, B0); PG8_BAR; PG8_SCHED;
      PG8_LDB(B1, 1, 1); PG8_STAGE(PG8_SB(1, 0), b3, voffB);
      PG8_BAR; PG8_WAIT_L(0); PG8_MMA(0, 1, At, B1); PG8_BAR;
      PG8_LDA(At, 1, 1); PG8_STAGE(PG8_SA(1, 0), a3, voffA);
      PG8_BAR; PG8_WAIT_L(0); PG8_MMA(1, 0, At, B0); PG8_BAR; PG8_SCHED;
      PG8_STAGE(PG8_SB(1, 1), b3 + hstep, voffB);
      PG8_WAIT_V(6); PG8_BAR; PG8_MMA(1, 1, At, B1); PG8_BAR;
    }
    E(acc, cur, wr, wc, fr, fq);
    if (!has_next) break;
#pragma unroll
    for (int a = 0; a < 2; ++a)
#pragma unroll
      for (int b = 0; b < 2; ++b)
#pragma unroll
        for (int m = 0; m < 4; ++m)
#pragma unroll
          for (int n = 0; n < 2; ++n) acc[a][b][m][n] = (f32x4){0.f, 0.f, 0.f, 0.f};
    cur = nxt; cA = nA; cB = nB; ++ui;
  }
  PG8_WAIT_V(0);
  if (wr == 0) PG8_BAR;
  PG8_BAR;
#undef PG8_SA
#undef PG8_SB
#undef PG8_STAGE
#undef PG8_LDA
#undef PG8_LDB
#undef PG8_MMA
#undef PG8_WAIT_V
#undef PG8_WAIT_L
#undef PG8_BAR
#undef PG8_SCHED
}
}

template <int EPI>
__device__ __forceinline__ void ph_gemm(const P& p, const bf* A, const bf* Bt, int K, int nN, int layer, int latonly, char* smem) {
  pg8::Order S;
  S.init(latonly ? 128 : 136, nN, gridDim.x, blockIdx.x, latonly);
  pg8::Epi<EPI> E{p, layer};
  pg8::Gemm g{A, Bt, K};
  __syncthreads();
  pg8::gemm_phase(( __attribute__((address_space(3))) unsigned char*)smem, g, S, E);
  __syncthreads();
}

__device__ __forceinline__ void ph_rope(const P& p, char* smem) {
  float* tcos = (float*)smem;
  float* tsin = tcos + 1024;
  const int tid = tidx();
  __syncthreads();
  for (int i = tid; i < 1024; i += NT) {
    int c = i >> 4, f = i & 15;
    float inv = powf(10000.f, -(float)f / 16.f);
    float ang = (float)c * inv;
    float sn, cs;
    sincosf(ang, &sn, &cs);
    tcos[i] = cs;
    tsin[i] = sn;
  }
  __syncthreads();
  bf* QKV = (bf*)(p.ws + OFF_QKV);
  for (int it = blockIdx.x * NT + tid; it < RT * 32; it += gridDim.x * NT) {
    int R = it >> 5;
    int vec = (it >> 1) & 15, half = it & 1;
    int b = R / TA, a = R - b * TA;
    bool isq = vec < 8;
    if (!isq && a < CTX) continue;
    bf* ptr = QKV + (size_t)R * 1536 + vec * 64 + half * 32;
    uint4 a0 = *(const uint4*)ptr, a1 = *(const uint4*)(ptr + 8), b0 = *(const uint4*)(ptr + 16), b1 = *(const uint4*)(ptr + 24);
    float x1[16], x2[16];
    x1[0] = bflo(a0.x); x1[1] = bfhi(a0.x); x1[2] = bflo(a0.y); x1[3] = bfhi(a0.y); x1[4] = bflo(a0.z); x1[5] = bfhi(a0.z); x1[6] = bflo(a0.w); x1[7] = bfhi(a0.w);
    x1[8] = bflo(a1.x); x1[9] = bfhi(a1.x); x1[10] = bflo(a1.y); x1[11] = bfhi(a1.y); x1[12] = bflo(a1.z); x1[13] = bfhi(a1.z); x1[14] = bflo(a1.w); x1[15] = bfhi(a1.w);
    x2[0] = bflo(b0.x); x2[1] = bfhi(b0.x); x2[2] = bflo(b0.y); x2[3] = bfhi(b0.y); x2[4] = bflo(b0.z); x2[5] = bfhi(b0.z); x2[6] = bflo(b0.w); x2[7] = bfhi(b0.w);
    x2[8] = bflo(b1.x); x2[9] = bfhi(b1.x); x2[10] = bflo(b1.y); x2[11] = bfhi(b1.y); x2[12] = bflo(b1.z); x2[13] = bfhi(b1.z); x2[14] = bflo(b1.w); x2[15] = bfhi(b1.w);
    const float qs = isq ? 0.125f * 1.4426950408889634f : 1.f;
    if (a >= CTX) {
      int pos = a - CTX;
      int cidx = half == 0 ? (pos >> 6) : (pos & 63);
#pragma unroll
      for (int f = 0; f < 16; ++f) {
        float cs = tcos[cidx * 16 + f], sn = tsin[cidx * 16 + f];
        float y1 = x1[f] * cs - x2[f] * sn, y2 = x2[f] * cs + x1[f] * sn;
        x1[f] = y1 * qs;
        x2[f] = y2 * qs;
      }
    } else {
#pragma unroll
      for (int f = 0; f < 16; ++f) { x1[f] *= qs; x2[f] *= qs; }
    }
    uint4 o;
    o.x = pack2(x1[0], x1[1]); o.y = pack2(x1[2], x1[3]); o.z = pack2(x1[4], x1[5]); o.w = pack2(x1[6], x1[7]); *(uint4*)ptr = o;
    o.x = pack2(x1[8], x1[9]); o.y = pack2(x1[10], x1[11]); o.z = pack2(x1[12], x1[13]); o.w = pack2(x1[14], x1[15]); *(uint4*)(ptr + 8) = o;
    o.x = pack2(x2[0], x2[1]); o.y = pack2(x2[2], x2[3]); o.z = pack2(x2[4], x2[5]); o.w = pack2(x2[6], x2[7]); *(uint4*)(ptr + 16) = o;
    o.x = pack2(x2[8], x2[9]); o.y = pack2(x2[10], x2[11]); o.z = pack2(x2[12], x2[13]); o.w = pack2(x2[14], x2[15]); *(uint4*)(ptr + 24) = o;
  }
}

__device__ __forceinline__ float shiftmix(const bf* PB, const float* mu, int R, int a, int col) {
  int lo = a < CTX ? 0 : CTX, hi = a < CTX ? CTX : TA;
  float t = bf2f(PB[(size_t)R * 1792 + col]);
  float pv = a > lo ? bf2f(PB[(size_t)(R - 1) * 1792 + col]) : 0.f;
  float nx = a + 1 < hi ? bf2f(PB[(size_t)(R + 1) * 1792 + col]) : 0.f;
  return t + (0.5f * (pv + nx) - t) * mu[col];
}
__device__ __forceinline__ void ph_lw(const P& p) {
  bf* LW = (bf*)(p.ws + OFF_LW);
  const float *w2f = p.in[19], *w2b = p.in[21], *a2 = p.in[23], *g2 = p.in[24];
  for (int i = blockIdx.x * NT + tidx(); i < 512 * 320; i += gridDim.x * NT) {
    int n = i / 320, kk = i - n * 320;
    float v = kk < 64 ? w2f[kk * 512 + n] : kk < 128 ? w2b[(kk - 64) * 512 + n] : kk < 192 ? a2[(kk - 128) * 512 + n] : g2[(kk - 192) * 512 + n];
    LW[i] = f2bf(v);
  }
}
__device__ __forceinline__ float shiftmix_l(const bf* PBs, const float muc, int t, int a, int col) {
  const int lo = a < CTX ? 0 : CTX, hi = a < CTX ? CTX : TA;
  const float x = bf2f(PBs[(t + 1) * 1792 + col]);
  const float pv = a > lo ? bf2f(PBs[t * 1792 + col]) : 0.f;
  const float nx = a + 1 < hi ? bf2f(PBs[(t + 2) * 1792 + col]) : 0.f;
  return x + (0.5f * (pv + nx) - x) * muc;
}
__device__ __forceinline__ void ph_rwkv_prep(const P& p, char* smem) {
  bf* linA = (bf*)smem;
  bf* PBs = linA + 16 * 264;
  const int tid = tidx(), lane = tid & 63, wave = tid >> 6;
  const int l15 = lane & 15, g = lane >> 4;
  const bf* PB = (const bf*)p.out;
  const bf* LW = (const bf*)(p.ws + OFF_LW);
  const float* mu = p.in[17];
  bf* PR = (bf*)(p.ws + OFF_PREP);
  bf* PK = PR + (size_t)RT * 512;
  bf* PV = PK + (size_t)RT * 512;
  bf* PKK = PV + (size_t)RT * 512;
  bf* PKA = PKK + (size_t)RT * 512;
  bf* PLF = PKA + (size_t)RT * 512;
  bf* PLB = PLF + (size_t)RT * 512;
  bf* G = (bf*)(p.ws + OFF_G);
  float* BON = (float*)(p.ws + OFF_BONUS);
  float cw0f[4], cw0b[4], ca0[4], ckk[4], cka[4], crk[4], cmr[4], cmk[4], cmv[4];
#pragma unroll
  for (int nt = 0; nt < 4; ++nt) {
    int c = wave * 64 + nt * 16 + l15;
    cw0f[nt] = p.in[18][c]; cw0b[nt] = p.in[20][c]; ca0[nt] = p.in[22][c]; ckk[nt] = p.in[25][c]; cka[nt] = p.in[26][c]; crk[nt] = p.in[27][c];
    cmr[nt] = mu[c]; cmk[nt] = mu[512 + c]; cmv[nt] = mu[1024 + c];
  }
  for (int unit = blockIdx.x; unit < RT / 16; unit += gridDim.x) {
    const int R0 = unit * 16;
    const int b = R0 / TA, a00 = R0 - b * TA;
    __syncthreads();
    for (int ch = tid; ch < 18 * 224; ch += NT) {
      const int rr = ch / 224, cc = ch - rr * 224;
      const int Rg = R0 - 1 + rr;
      uint4 v = make_uint4(0, 0, 0, 0);
      if (Rg >= 0 && Rg < RT) v = *(const uint4*)(PB + (size_t)Rg * 1792 + cc * 8);
      *(uint4*)(PBs + rr * 1792 + cc * 8) = v;
    }
    __syncthreads();
#pragma unroll
    for (int i = 0; i < 8; ++i) {
      int idx = tid + NT * i;
      int tok = idx >> 8, j = idx & 255;
      float f = shiftmix_l(PBs, mu[1536 + j], tok, a00 + tok, 1536 + j);
      float val = j < 64 ? tanhf(f) : (j < 128 ? f : sigmoidf_(f));
      linA[tok * 264 + j] = f2bf(val);
    }
    __syncthreads();
    f32x4 wf[4], wb[4], aa[4], gg[4];
#pragma unroll
    for (int nt = 0; nt < 4; ++nt) {
      wf[nt] = (f32x4){0.f, 0.f, 0.f, 0.f}; wb[nt] = wf[nt]; aa[nt] = wf[nt]; gg[nt] = wf[nt];
    }
#pragma unroll
    for (int nt = 0; nt < 4; ++nt) {
      const bf* lw = LW + (size_t)(wave * 64 + nt * 16 + l15) * 320 + g * 8;
#pragma unroll
      for (int ks = 0; ks < 2; ++ks) {
        bf16x8 aw = *(const bf16x8*)(linA + l15 * 264 + ks * 32 + g * 8);
        wf[nt] = __builtin_amdgcn_mfma_f32_16x16x32_bf16(aw, *(const bf16x8*)(lw + ks * 32), wf[nt], 0, 0, 0);
        wb[nt] = __builtin_amdgcn_mfma_f32_16x16x32_bf16(aw, *(const bf16x8*)(lw + 64 + ks * 32), wb[nt], 0, 0, 0);
        bf16x8 a_a = *(const bf16x8*)(linA + l15 * 264 + 64 + ks * 32 + g * 8);
        aa[nt] = __builtin_amdgcn_mfma_f32_16x16x32_bf16(a_a, *(const bf16x8*)(lw + 128 + ks * 32), aa[nt], 0, 0, 0);
      }
#pragma unroll
      for (int ks = 0; ks < 4; ++ks) {
        bf16x8 ag = *(const bf16x8*)(linA + l15 * 264 + 128 + ks * 32 + g * 8);
        gg[nt] = __builtin_amdgcn_mfma_f32_16x16x32_bf16(ag, *(const bf16x8*)(lw + 192 + ks * 32), gg[nt], 0, 0, 0);
      }
    }
#pragma unroll
    for (int r = 0; r < 4; ++r) {
      const int t = g * 4 + r;
      const int R = R0 + t, a = a00 + t;
      float fr[4], fv[4], kkv[4], km[4], av[4];
      float n2 = 0.f, bon = 0.f;
#pragma unroll
      for (int nt = 0; nt < 4; ++nt) {
        int c = wave * 64 + nt * 16 + l15;
        fr[nt] = shiftmix_l(PBs, cmr[nt], t, a, c);
        float fk = shiftmix_l(PBs, cmk[nt], t, a, 512 + c);
        fv[nt] = shiftmix_l(PBs, cmv[nt], t, a, 1024 + c);
        av[nt] = sigmoidf_(ca0[nt] + aa[nt][r]);
        kkv[nt] = fk * ckk[nt];
        n2 += kkv[nt] * kkv[nt];
        km[nt] = fk * (1.f + (av[nt] - 1.f) * cka[nt]);
        bon += fr[nt] * km[nt] * crk[nt];
      }
      n2 = red16(n2);
      bon = red16(bon);
      float rn = 1.f / fmaxf(sqrtf(n2), 1e-12f);
#pragma unroll
      for (int nt = 0; nt < 4; ++nt) {
        int c = wave * 64 + nt * 16 + l15;
        size_t o = (size_t)R * 512 + c;
        float lwf = -__expf(-softplusf_(-(cw0f[nt] + wf[nt][r])) - 0.5f);
        float lwb = -__expf(-softplusf_(-(cw0b[nt] + wb[nt][r])) - 0.5f);
        float kk = kkv[nt] * rn;
        PR[o] = f2bf(fr[nt]);
        PK[o] = f2bf(km[nt]);
        PV[o] = f2bf(fv[nt]);
        PKK[o] = f2bf(kk);
        PKA[o] = f2bf(kk * av[nt]);
        PLF[o] = f2bf(lwf);
        PLB[o] = f2bf(lwb);
        G[o] = f2bf(gg[nt][r]);
      }
      if (l15 == 0) BON[(size_t)R * 8 + wave] = bon;
    }
  }
}

__device__ __forceinline__ int scan_row(int b, int dir, int s) {
  int a = dir ? (s < CTX ? CTX - 1 - s : TA + CTX - 1 - s) : s;
  return b * TA + a;
}

__device__ __forceinline__ void rwkv_chain(const P& p, int chain, int half, char* smem) {
  const int dir = chain & 1, h = (chain >> 1) & 7, b = chain >> 4;
  float* cR = (float*)smem;
  float* cW = cR + 2048;
  float* cK = cW + 2048;
  float* cKK = cK + 2048;
  float* cKA = cKK + 2048;
  float* cV = cKA + 2048;
  float* yb = cV + 2048;
  const int tid = tidx(), lane = tid & 63, wave = tid >> 6;
  const int l15 = lane & 15, lg = lane >> 4;
  const bf* PR = (const bf*)(p.ws + OFF_PREP);
  const bf* PK = PR + (size_t)RT * 512;
  const bf* PV = PK + (size_t)RT * 512;
  const bf* PKK = PV + (size_t)RT * 512;
  const bf* PKA = PKK + (size_t)RT * 512;
  const bf* PLW = PKA + (size_t)RT * 512 + (size_t)dir * RT * 512;
  bf* Y = (bf*)p.out + (size_t)dir * RT * 512;
  const int st = tid >> 4, c4 = (tid & 15) * 4;
  const int r0 = half < 0 ? wave * 8 + lg * 2 : half * 32 + (wave & 3) * 8 + lg * 2;
  const bool active = half < 0 || wave < 4;
  const bool ywr = half < 0 || ((c4 >> 5) == half);
  float s0[4], s1[4];
#pragma unroll
  for (int j = 0; j < 4; ++j) { s0[j] = 0.f; s1[j] = 0.f; }
  uint2 gR, gW, gK, gV, gKK, gKA;
  {
    size_t o = (size_t)scan_row(b, dir, st) * 512 + h * 64 + c4;
    gR = *(const uint2*)(PR + o); gW = *(const uint2*)(PLW + o); gK = *(const uint2*)(PK + o);
    gV = *(const uint2*)(PV + o); gKK = *(const uint2*)(PKK + o); gKA = *(const uint2*)(PKA + o);
  }
  const int NCH = TA / 32;
  for (int ch = 0; ch <= NCH; ++ch) {
    __syncthreads();
    if (ch > 0 && ywr) {
      float4 y4 = *(const float4*)(yb + st * 64 + c4);
      uint2 o2;
      o2.x = pack2(y4.x, y4.y);
      o2.y = pack2(y4.z, y4.w);
      *(uint2*)(Y + (size_t)scan_row(b, dir, (ch - 1) * 32 + st) * 512 + h * 64 + c4) = o2;
    }
    if (ch == NCH) break;
    {
      int o = st * 64 + c4;
      *(float4*)(cR + o) = make_float4(bflo(gR.x), bfhi(gR.x), bflo(gR.y), bfhi(gR.y));
      *(float4*)(cW + o) = make_float4(__expf(bflo(gW.x)), __expf(bfhi(gW.x)), __expf(bflo(gW.y)), __expf(bfhi(gW.y)));
      *(float4*)(cK + o) = make_float4(bflo(gK.x), bfhi(gK.x), bflo(gK.y), bfhi(gK.y));
      *(float4*)(cV + o) = make_float4(bflo(gV.x), bfhi(gV.x), bflo(gV.y), bfhi(gV.y));
      *(float4*)(cKK + o) = make_float4(bflo(gKK.x), bfhi(gKK.x), bflo(gKK.y), bfhi(gKK.y));
      *(float4*)(cKA + o) = make_float4(bflo(gKA.x), bfhi(gKA.x), bflo(gKA.y), bfhi(gKA.y));
    }
    __syncthreads();
    if (ch + 1 < NCH) {
      size_t o = (size_t)scan_row(b, dir, (ch + 1) * 32 + st) * 512 + h * 64 + c4;
      gR = *(const uint2*)(PR + o); gW = *(const uint2*)(PLW + o); gK = *(const uint2*)(PK + o);
      gV = *(const uint2*)(PV + o); gKK = *(const uint2*)(PKK + o); gKA = *(const uint2*)(PKA + o);
    }
    if (active) {
      float4 kk4 = *(const float4*)(cKK + l15 * 4);
      float4 w4 = *(const float4*)(cW + l15 * 4);
      float4 k4 = *(const float4*)(cK + l15 * 4);
      float4 ka4 = *(const float4*)(cKA + l15 * 4);
      float4 r4 = *(const float4*)(cR + l15 * 4);
      float2 v2 = *(const float2*)(cV + r0);
#pragma unroll 2
      for (int t = 0; t < 32; ++t) {
        const int tn = (t + 1) & 31;
        float4 nkk4 = *(const float4*)(cKK + tn * 64 + l15 * 4);
        float4 nw4 = *(const float4*)(cW + tn * 64 + l15 * 4);
        float4 nk4 = *(const float4*)(cK + tn * 64 + l15 * 4);
        float4 nka4 = *(const float4*)(cKA + tn * 64 + l15 * 4);
        float4 nr4 = *(const float4*)(cR + tn * 64 + l15 * 4);
        float2 nv2 = *(const float2*)(cV + tn * 64 + r0);
        float sa0 = (s0[0] * kk4.x + s0[1] * kk4.y) + (s0[2] * kk4.z + s0[3] * kk4.w);
        float sa1 = (s1[0] * kk4.x + s1[1] * kk4.y) + (s1[2] * kk4.z + s1[3] * kk4.w);
        float p00 = s0[0] * w4.x + v2.x * k4.x, p01 = s0[1] * w4.y + v2.x * k4.y, p02 = s0[2] * w4.z + v2.x * k4.z, p03 = s0[3] * w4.w + v2.x * k4.w;
        float p10 = s1[0] * w4.x + v2.y * k4.x, p11 = s1[1] * w4.y + v2.y * k4.y, p12 = s1[2] * w4.z + v2.y * k4.z, p13 = s1[3] * w4.w + v2.y * k4.w;
        sa0 = red16(sa0);
        sa1 = red16(sa1);
        s0[0] = p00 - sa0 * ka4.x; s0[1] = p01 - sa0 * ka4.y; s0[2] = p02 - sa0 * ka4.z; s0[3] = p03 - sa0 * ka4.w;
        s1[0] = p10 - sa1 * ka4.x; s1[1] = p11 - sa1 * ka4.y; s1[2] = p12 - sa1 * ka4.z; s1[3] = p13 - sa1 * ka4.w;
        float y0 = (s0[0] * r4.x + s0[1] * r4.y) + (s0[2] * r4.z + s0[3] * r4.w);
        float y1 = (s1[0] * r4.x + s1[1] * r4.y) + (s1[2] * r4.z + s1[3] * r4.w);
        y0 = red16(y0);
        y1 = red16(y1);
        if (l15 == 0) *(float2*)(yb + t * 64 + r0) = make_float2(y0, y1);
        kk4 = nkk4; w4 = nw4; k4 = nk4; ka4 = nka4; r4 = nr4; v2 = nv2;
      }
    }
  }
}


template <int OFFB>
__device__ __forceinline__ bf16x8 tr_pair(const bf* pp) {
  typedef short s16x4_ __attribute__((ext_vector_type(4)));
  s16x4_ v0, v1;
  unsigned addr = (unsigned)(size_t)(__attribute__((address_space(3))) const void*)pp;
  asm volatile("s_waitcnt lgkmcnt(0)\n\tds_read_b64_tr_b16 %0, %2\n\tds_read_b64_tr_b16 %1, %2 offset:%3\n\ts_waitcnt lgkmcnt(0)" : "=&v"(v0), "=&v"(v1) : "v"(addr), "n"(OFFB) : "memory");
  return __builtin_shufflevector(v0, v1, 0, 1, 2, 3, 4, 5, 6, 7);
}
template <int STRB, int OFF2B>
__device__ __forceinline__ void tr_quad(const bf* pp, bf16x8& f0, bf16x8& f1, bf16x8& f2, bf16x8& f3) {
  typedef short s16x4_ __attribute__((ext_vector_type(4)));
  s16x4_ a0, b0, a1, b1, a2, b2, a3, b3;
  unsigned addr = (unsigned)(size_t)(__attribute__((address_space(3))) const void*)pp;
  asm volatile(
      "s_waitcnt lgkmcnt(0)\n\t"
      "ds_read_b64_tr_b16 %0, %8\n\t"
      "ds_read_b64_tr_b16 %1, %8 offset:%9\n\t"
      "ds_read_b64_tr_b16 %2, %8 offset:%10\n\t"
      "ds_read_b64_tr_b16 %3, %8 offset:%11\n\t"
      "ds_read_b64_tr_b16 %4, %8 offset:%12\n\t"
      "ds_read_b64_tr_b16 %5, %8 offset:%13\n\t"
      "ds_read_b64_tr_b16 %6, %8 offset:%14\n\t"
      "ds_read_b64_tr_b16 %7, %8 offset:%15\n\t"
      "s_waitcnt lgkmcnt(0)"
      : "=&v"(a0), "=&v"(b0), "=&v"(a1), "=&v"(b1), "=&v"(a2), "=&v"(b2), "=&v"(a3), "=&v"(b3)
      : "v"(addr), "n"(OFF2B), "n"(STRB), "n"(STRB + OFF2B), "n"(2 * STRB), "n"(2 * STRB + OFF2B), "n"(3 * STRB), "n"(3 * STRB + OFF2B)
      : "memory");
  f0 = __builtin_shufflevector(a0, b0, 0, 1, 2, 3, 4, 5, 6, 7);
  f1 = __builtin_shufflevector(a1, b1, 0, 1, 2, 3, 4, 5, 6, 7);
  f2 = __builtin_shufflevector(a2, b2, 0, 1, 2, 3, 4, 5, 6, 7);
  f3 = __builtin_shufflevector(a3, b3, 0, 1, 2, 3, 4, 5, 6, 7);
}
template <int STRB, int OFF2B>
__device__ __forceinline__ void tr_dual(const bf* pp, bf16x8& f0, bf16x8& f1) {
  typedef short s16x4_ __attribute__((ext_vector_type(4)));
  s16x4_ a0, b0, a1, b1;
  unsigned addr = (unsigned)(size_t)(__attribute__((address_space(3))) const void*)pp;
  asm volatile(
      "s_waitcnt lgkmcnt(0)\n\t"
      "ds_read_b64_tr_b16 %0, %4\n\t"
      "ds_read_b64_tr_b16 %1, %4 offset:%5\n\t"
      "ds_read_b64_tr_b16 %2, %4 offset:%6\n\t"
      "ds_read_b64_tr_b16 %3, %4 offset:%7\n\t"
      "s_waitcnt lgkmcnt(0)"
      : "=&v"(a0), "=&v"(b0), "=&v"(a1), "=&v"(b1)
      : "v"(addr), "n"(OFF2B), "n"(STRB), "n"(STRB + OFF2B)
      : "memory");
  f0 = __builtin_shufflevector(a0, b0, 0, 1, 2, 3, 4, 5, 6, 7);
  f1 = __builtin_shufflevector(a1, b1, 0, 1, 2, 3, 4, 5, 6, 7);
}
__device__ __forceinline__ const bf* trbase(const bf* img, int ld, int r0, int c0, int lane) { return img + (r0 + ((lane & 15) >> 2)) * ld + c0 + (lane & 3) * 4; }
typedef short s16x4 __attribute__((ext_vector_type(4)));
__device__ __forceinline__ void attn_unit(const P& p, int u, char* smem, float lam) {
  bf* Ks = (bf*)smem;
  bf* Vs = Ks + 64 * 136;
  int b, h, nkeys, qa0;
  if (u < 1024) { b = u >> 7; h = (u >> 5) & 3; nkeys = TA; qa0 = CTX + (u & 31) * 128; }
  else { int v = u - 1024; b = v >> 3; h = (v >> 1) & 3; nkeys = CTX; qa0 = (v & 1) * 128; }
  const bf* QKV = (const bf*)(p.ws + OFF_QKV);
  const int tid = tidx(), lane = tid & 63, wave = tid >> 6;
  const int l15 = lane & 15, lg = lane >> 4;
  const size_t rowbase = (size_t)b * TA;
  bf16x8 qf[2][2];
  {
    size_t Rq = rowbase + qa0 + wave * 16 + l15;
#pragma unroll
    for (int m = 0; m < 2; ++m)
#pragma unroll
      for (int ks = 0; ks < 2; ++ks) qf[m][ks] = *(const bf16x8*)(QKV + Rq * 1536 + h * 128 + m * 64 + ks * 32 + lg * 8);
  }
  f32x4 oacc[2][8];
#pragma unroll
  for (int m = 0; m < 2; ++m)
#pragma unroll
    for (int n = 0; n < 8; ++n) oacc[m][n] = (f32x4){0.f, 0.f, 0.f, 0.f};
  float mrun[2] = {0.f, 0.f}, lrun[2] = {0.f, 0.f};
  const int sr = tid >> 4, scc = tid & 15;
  const bf* gsrc = QKV + (rowbase + sr) * 1536 + h * 128 + scc * 8;
  uint4 pk0 = *(const uint4*)(gsrc + 512), pv0 = *(const uint4*)(gsrc + 1024);
  uint4 pk1 = *(const uint4*)(gsrc + (size_t)32 * 1536 + 512), pv1 = *(const uint4*)(gsrc + (size_t)32 * 1536 + 1024);
  const int vrow = lg * 4 + (l15 >> 2), vcol = (lane & 3) * 4;
  for (int k0 = 0; k0 < nkeys; k0 += 64) {
    __syncthreads();
    *(uint4*)(Ks + sr * 136 + scc * 8) = pk0;
    *(uint4*)(Ks + (sr + 32) * 136 + scc * 8) = pk1;
    *(uint4*)(Vs + sr * 144 + scc * 8) = pv0;
    *(uint4*)(Vs + (sr + 32) * 144 + scc * 8) = pv1;
    __syncthreads();
    if (k0 + 64 < nkeys) {
      const bf* g2 = gsrc + (size_t)(k0 + 64) * 1536;
      pk0 = *(const uint4*)(g2 + 512); pv0 = *(const uint4*)(g2 + 1024);
      pk1 = *(const uint4*)(g2 + (size_t)32 * 1536 + 512); pv1 = *(const uint4*)(g2 + (size_t)32 * 1536 + 1024);
    }
    bf16x8 pf[2][2];
#pragma unroll
    for (int m = 0; m < 2; ++m) {
      f32x4 s[4];
      const float nm = -mrun[m];
#pragma unroll
      for (int kt = 0; kt < 4; ++kt) s[kt] = (f32x4){nm, nm, nm, nm};
#pragma unroll
      for (int ks = 0; ks < 2; ++ks)
#pragma unroll
        for (int kt = 0; kt < 4; ++kt) {
          bf16x8 a = *(const bf16x8*)(Ks + (kt * 16 + l15) * 136 + m * 64 + ks * 32 + lg * 8);
          s[kt] = __builtin_amdgcn_mfma_f32_16x16x32_bf16(a, qf[m][ks], s[kt], 0, 0, 0);
        }
      float mx = fmaxf(fmaxf(s[0][0], s[0][1]), fmaxf(s[0][2], s[0][3]));
#pragma unroll
      for (int kt = 1; kt < 4; ++kt) mx = fmaxf(mx, fmaxf(fmaxf(s[kt][0], s[kt][1]), fmaxf(s[kt][2], s[kt][3])));
      if (k0 == 0 || __any(mx > 11.f)) {
        mx = fmaxf(mx, __shfl_xor(mx, 16));
        mx = fmaxf(mx, __shfl_xor(mx, 32));
        const float d = (k0 == 0) ? mx : fmaxf(mx, 0.f);
        const float alpha = (k0 == 0) ? 1.f : __builtin_amdgcn_exp2f(-d);
        mrun[m] += d;
        lrun[m] *= alpha;
        float al[4];
#pragma unroll
        for (int r = 0; r < 4; ++r) al[r] = __shfl(alpha, lg * 4 + r);
#pragma unroll
        for (int n = 0; n < 8; ++n)
#pragma unroll
          for (int r = 0; r < 4; ++r) oacc[m][n][r] *= al[r];
#pragma unroll
        for (int kt = 0; kt < 4; ++kt)
#pragma unroll
          for (int r = 0; r < 4; ++r) s[kt][r] -= d;
      }
      float ps = 0.f;
#pragma unroll
      for (int kt = 0; kt < 4; ++kt)
#pragma unroll
        for (int r = 0; r < 4; ++r) {
          float e = __builtin_amdgcn_exp2f(s[kt][r]);
          s[kt][r] = e;
          ps += e;
        }
      lrun[m] += ps;
#pragma unroll
      for (int si = 0; si < 2; ++si) {
        i32x4 t;
        t[0] = (int)pack2(s[2 * si][0], s[2 * si][1]);
        t[1] = (int)pack2(s[2 * si][2], s[2 * si][3]);
        t[2] = (int)pack2(s[2 * si + 1][0], s[2 * si + 1][1]);
        t[3] = (int)pack2(s[2 * si + 1][2], s[2 * si + 1][3]);
        pf[m][si] = __builtin_bit_cast(bf16x8, t);
      }
    }
#pragma unroll
    for (int si = 0; si < 2; ++si)
#pragma unroll
      for (int nq = 0; nq < 2; ++nq) {
        bf16x8 bv[4];
        tr_quad<32, 16 * 144 * 2>(Vs + (si * 32 + vrow) * 144 + nq * 64 + vcol, bv[0], bv[1], bv[2], bv[3]);
#pragma unroll
        for (int n4 = 0; n4 < 4; ++n4) {
          oacc[0][nq * 4 + n4] = __builtin_amdgcn_mfma_f32_16x16x32_bf16(pf[0][si], bv[n4], oacc[0][nq * 4 + n4], 0, 0, 0);
          oacc[1][nq * 4 + n4] = __builtin_amdgcn_mfma_f32_16x16x32_bf16(pf[1][si], bv[n4], oacc[1][nq * 4 + n4], 0, 0, 0);
        }
      }
  }
  float inv[2];
#pragma unroll
  for (int m = 0; m < 2; ++m) {
    float l = lrun[m];
    l += __shfl_xor(l, 16);
    l += __shfl_xor(l, 32);
    inv[m] = 1.f / l;
  }
  float i1[4], i2[4];
#pragma unroll
  for (int r = 0; r < 4; ++r) { i1[r] = __shfl(inv[0], lg * 4 + r); i2[r] = __shfl(inv[1], lg * 4 + r); }
  float ss[4] = {0.f, 0.f, 0.f, 0.f};
#pragma unroll
  for (int n = 0; n < 8; ++n)
#pragma unroll
    for (int r = 0; r < 4; ++r) {
      float o = oacc[0][n][r] * i1[r] - lam * (oacc[1][n][r] * i2[r]);
      oacc[0][n][r] = o;
      ss[r] += o * o;
    }
  const float* subln = p.in[16];
  bf* O = (bf*)(p.ws + OFF_HO);
#pragma unroll
  for (int r = 0; r < 4; ++r) {
    float t = red16(ss[r]);
    float scl = rsqrtf(t * (1.f / 128.f) + 1e-5f) * 0.8f;
    size_t Ro = rowbase + qa0 + wave * 16 + lg * 4 + r;
#pragma unroll
    for (int n = 0; n < 8; ++n) O[Ro * 1024 + h * 128 + n * 16 + l15] = f2bf(oacc[0][n][r] * scl * subln[n * 16 + l15]);
  }
}

__device__ __forceinline__ void rwkv_chain2(const P& p, int chain, char* smem);
__device__ __forceinline__ void ph_mix0(const P& p, char* smem) {
  volatile int* s_unitp = (volatile int*)(smem + 131072);
  for (int u = blockIdx.x; u < 128; u += gridDim.x) rwkv_chain2(p, u, smem);
#ifdef PROBE_RWKV
  __syncthreads();
  for (int u = blockIdx.x; u < 256; u += gridDim.x) rwkv_chain(p, u & 127, u >> 7, smem);
#endif
  float d1 = 0.f, d2 = 0.f;
  for (int i = 0; i < 64; ++i) { d1 += p.in[12][i] * p.in[13][i]; d2 += p.in[14][i] * p.in[15][i]; }
  float lam = expf(d1) - expf(d2) + 0.2f;
  int* cnt = (int*)(p.ws + OFF_CNT);
  while (true) {
    __syncthreads();
    if (tidx() == 0) *s_unitp = atomicAdd(cnt, 1);
    __syncthreads();
    int u = *s_unitp;
    if (u >= 1088) break;
    attn_unit(p, u, smem, lam);
  }
#ifdef PROBE_ATTN
  while (true) {
    __syncthreads();
    if (tidx() == 0) *s_unitp = atomicAdd(cnt + 1, 1);
    __syncthreads();
    int u = *s_unitp;
    if (u >= 1088) break;
    attn_unit(p, u, smem, lam);
  }
#endif
}

__device__ __forceinline__ void ph_rwkv_post(const P& p) {
  const int tid = tidx(), wave = tid >> 6;
  const bf* YF = (const bf*)p.out;
  const bf* YB = YF + (size_t)RT * 512;
  const bf* PV = (const bf*)(p.ws + OFF_PREP) + (size_t)2 * RT * 512;
  const bf* G = (const bf*)(p.ws + OFF_G);
  const float* BON = (const float*)(p.ws + OFF_BONUS);
  bf* O = (bf*)(p.ws + OFF_HO);
  const float lw = p.in[28][tid], lb = p.in[29][tid];
  for (int R0 = blockIdx.x * 4; R0 < RT; R0 += gridDim.x * 4) {
    float yf[4], yb4[4], pv[4], gg[4], bn[4];
#pragma unroll
    for (int i = 0; i < 4; ++i) {
      size_t o = (size_t)(R0 + i) * 512 + tid;
      yf[i] = bf2f(YF[o]); yb4[i] = bf2f(YB[o]); pv[i] = bf2f(PV[o]); gg[i] = bf2f(G[o]); bn[i] = BON[(size_t)(R0 + i) * 8 + wave];
    }
#pragma unroll
    for (int i = 0; i < 4; ++i) {
      float y = yf[i] + yb4[i];
      float mean = wave_sum(y) * (1.f / 64.f);
      float d = y - mean;
      float var = wave_sum(d * d) * (1.f / 64.f);
      float yn = d * rsqrtf(var + 64e-5f) * lw + lb;
      float outv = (yn + bn[i] * pv[i]) * gg[i];
      O[(size_t)(R0 + i) * 1024 + 512 + tid] = f2bf(outv);
    }
  }
}

__device__ __forceinline__ void ph_gla_gates(const P& p, char* smem) {
  float* up = (float*)smem;
  float* gbv = up + 2 * 16 * 256;
  const int tid = tidx();
  __syncthreads();
  for (int i = tid; i < 2 * 16 * 256; i += NT) up[i] = p.in[i < 4096 ? 46 : 48][i & 4095];
  for (int i = tid; i < 512; i += NT) gbv[i] = p.in[i < 256 ? 47 : 49][i & 255];
  __syncthreads();
  const bf* P1 = (const bf*)(p.ws + OFF_P1C);
  bf* LG = (bf*)(p.ws + OFF_HO);
  for (int it = blockIdx.x * NT + tid; it < RT * 32; it += gridDim.x * NT) {
    const int R = it >> 5, c8 = (it & 31) * 8;
    const uint4 g0 = *(const uint4*)(P1 + (size_t)R * 2080 + 2064), g1 = *(const uint4*)(P1 + (size_t)R * 2080 + 2072);
    float gd[16];
    gd[0] = bflo(g0.x); gd[1] = bfhi(g0.x); gd[2] = bflo(g0.y); gd[3] = bfhi(g0.y); gd[4] = bflo(g0.z); gd[5] = bfhi(g0.z); gd[6] = bflo(g0.w); gd[7] = bfhi(g0.w);
    gd[8] = bflo(g1.x); gd[9] = bfhi(g1.x); gd[10] = bflo(g1.y); gd[11] = bfhi(g1.y); gd[12] = bflo(g1.z); gd[13] = bfhi(g1.z); gd[14] = bflo(g1.w); gd[15] = bfhi(g1.w);
#pragma unroll
    for (int d = 0; d < 2; ++d) {
      float z[8];
#pragma unroll
      for (int e = 0; e < 8; ++e) z[e] = gbv[d * 256 + c8 + e];
#pragma unroll
      for (int r = 0; r < 16; ++r) {
        const float4 u0 = *(const float4*)(up + (d * 16 + r) * 256 + c8), u1 = *(const float4*)(up + (d * 16 + r) * 256 + c8 + 4);
        z[0] += gd[r] * u0.x; z[1] += gd[r] * u0.y; z[2] += gd[r] * u0.z; z[3] += gd[r] * u0.w;
        z[4] += gd[r] * u1.x; z[5] += gd[r] * u1.y; z[6] += gd[r] * u1.z; z[7] += gd[r] * u1.w;
      }
      uint4 o;
      o.x = pack2(-softplusf_(-z[0]) * (1.f / 16.f), -softplusf_(-z[1]) * (1.f / 16.f));
      o.y = pack2(-softplusf_(-z[2]) * (1.f / 16.f), -softplusf_(-z[3]) * (1.f / 16.f));
      o.z = pack2(-softplusf_(-z[4]) * (1.f / 16.f), -softplusf_(-z[5]) * (1.f / 16.f));
      o.w = pack2(-softplusf_(-z[6]) * (1.f / 16.f), -softplusf_(-z[7]) * (1.f / 16.f));
      *(uint4*)(LG + ((size_t)d * RT + R) * 256 + c8) = o;
    }
  }
}

__device__ __forceinline__ void ph_conv(const P& p) {
  const bf* XR = (const bf*)(p.ws + OFF_XRAW);
  bf* XO = (bf*)(p.ws + OFF_XBC);
  const float* cw = p.in[38];
  const float* cb = p.in[39];
  for (size_t it = (size_t)blockIdx.x * NT + tidx(); it < (size_t)RT * 128; it += (size_t)gridDim.x * NT) {
    int R = (int)(it >> 7), c8 = (int)(it & 127) * 8;
    int b = R / TA, a = R - b * TA;
    int lo = a < CTX ? 0 : CTX, hi = a < CTX ? CTX : TA;
    float acc[8];
#pragma unroll
    for (int e = 0; e < 8; ++e) acc[e] = cb[c8 + e];
#pragma unroll
    for (int j = 0; j < 5; ++j) {
      int aj = a + j - 2;
      if (aj >= lo && aj < hi) {
        uint4 v = *(const uint4*)(XR + (size_t)(R + j - 2) * 1024 + c8);
        const float* w = cw + j * 1024 + c8;
        acc[0] += w[0] * bflo(v.x); acc[1] += w[1] * bfhi(v.x);
        acc[2] += w[2] * bflo(v.y); acc[3] += w[3] * bfhi(v.y);
        acc[4] += w[4] * bflo(v.z); acc[5] += w[5] * bfhi(v.z);
        acc[6] += w[6] * bflo(v.w); acc[7] += w[7] * bfhi(v.w);
      }
    }
    uint4 o;
    o.x = pack2(siluf_(acc[0]), siluf_(acc[1]));
    o.y = pack2(siluf_(acc[2]), siluf_(acc[3]));
    o.z = pack2(siluf_(acc[4]), siluf_(acc[5]));
    o.w = pack2(siluf_(acc[6]), siluf_(acc[7]));
    *(uint4*)(XO + (size_t)R * 1024 + c8) = o;
  }
}

__device__ __forceinline__ void ssd_chain(const P& p, int chain, char* smem) {
  const int dir = chain & 1, hh = (chain >> 1) & 7, b = chain >> 4;
  const int grp = hh >> 2;
  float* cB = (float*)smem;
  float* cC = cB + 4096;
  float* cX = cC + 4096;
  float* cDA = cX + 2048;
  float* yb = cDA + 32;
  const int tid = tidx(), lane = tid & 63, wave = tid >> 6;
  const int l15 = lane & 15, lg = lane >> 4;
  const bf* XBC = (const bf*)(p.ws + OFF_XBC);
  const float* DTR = (const float*)(p.ws + OFF_DTRAW);
  bf* Y = (bf*)(p.ws + OFF_XRAW) + (size_t)dir * RT * 512;
  const float dtb = p.in[dir ? 42 : 40][hh];
  const float Aneg = -expf(p.in[dir ? 43 : 41][hh]);
  const int st = tid >> 4, q = tid & 15;
  const int r0 = wave * 8 + lg * 2;
  float s0[8], s1[8];
#pragma unroll
  for (int j = 0; j < 8; ++j) { s0[j] = 0.f; s1[j] = 0.f; }
  uint4 gB, gC;
  uint2 gX;
  float gD;
  {
    size_t R = (size_t)scan_row(b, dir, st);
    gB = *(const uint4*)(XBC + R * 1024 + 512 + grp * 128 + q * 8);
    gC = *(const uint4*)(XBC + R * 1024 + 768 + grp * 128 + q * 8);
    gX = *(const uint2*)(XBC + R * 1024 + hh * 64 + q * 4);
    gD = DTR[R * 16 + dir * 8 + hh];
  }
  const int NCH = TA / 32;
  for (int ch = 0; ch <= NCH; ++ch) {
    __syncthreads();
    if (ch > 0) {
      float4 y4 = *(const float4*)(yb + st * 64 + q * 4);
      uint2 o2;
      o2.x = pack2(y4.x, y4.y);
      o2.y = pack2(y4.z, y4.w);
      *(uint2*)(Y + (size_t)scan_row(b, dir, (ch - 1) * 32 + st) * 512 + hh * 64 + q * 4) = o2;
    }
    if (ch == NCH) break;
    {
      float dt = softplusf_(gD + dtb);
      float dA = expf(dt * Aneg);
      float* d = cB + st * 128 + q * 8;
      *(float4*)d = make_float4(bflo(gB.x), bfhi(gB.x), bflo(gB.y), bfhi(gB.y));
      *(float4*)(d + 4) = make_float4(bflo(gB.z), bfhi(gB.z), bflo(gB.w), bfhi(gB.w));
      d = cC + st * 128 + q * 8;
      *(float4*)d = make_float4(bflo(gC.x), bfhi(gC.x), bflo(gC.y), bfhi(gC.y));
      *(float4*)(d + 4) = make_float4(bflo(gC.z), bfhi(gC.z), bflo(gC.w), bfhi(gC.w));
      *(float4*)(cX + st * 64 + q * 4) = make_float4(bflo(gX.x) * dt, bfhi(gX.x) * dt, bflo(gX.y) * dt, bfhi(gX.y) * dt);
      if (q == 0) cDA[st] = dA;
    }
    __syncthreads();
    if (ch + 1 < NCH) {
      size_t R = (size_t)scan_row(b, dir, (ch + 1) * 32 + st);
      gB = *(const uint4*)(XBC + R * 1024 + 512 + grp * 128 + q * 8);
      gC = *(const uint4*)(XBC + R * 1024 + 768 + grp * 128 + q * 8);
      gX = *(const uint2*)(XBC + R * 1024 + hh * 64 + q * 4);
      gD = DTR[R * 16 + dir * 8 + hh];
    }
#pragma unroll 4
    for (int t = 0; t < 32; ++t) {
      float4 b0 = *(const float4*)(cB + t * 128 + l15 * 8);
      float4 b1 = *(const float4*)(cB + t * 128 + l15 * 8 + 4);
      float4 c0 = *(const float4*)(cC + t * 128 + l15 * 8);
      float4 c1 = *(const float4*)(cC + t * 128 + l15 * 8 + 4);
      float2 x2 = *(const float2*)(cX + t * 64 + r0);
      float dA = cDA[t];
      s0[0] = s0[0] * dA + x2.x * b0.x; s0[1] = s0[1] * dA + x2.x * b0.y; s0[2] = s0[2] * dA + x2.x * b0.z; s0[3] = s0[3] * dA + x2.x * b0.w;
      s0[4] = s0[4] * dA + x2.x * b1.x; s0[5] = s0[5] * dA + x2.x * b1.y; s0[6] = s0[6] * dA + x2.x * b1.z; s0[7] = s0[7] * dA + x2.x * b1.w;
      s1[0] = s1[0] * dA + x2.y * b0.x; s1[1] = s1[1] * dA + x2.y * b0.y; s1[2] = s1[2] * dA + x2.y * b0.z; s1[3] = s1[3] * dA + x2.y * b0.w;
      s1[4] = s1[4] * dA + x2.y * b1.x; s1[5] = s1[5] * dA + x2.y * b1.y; s1[6] = s1[6] * dA + x2.y * b1.z; s1[7] = s1[7] * dA + x2.y * b1.w;
      float y0 = s0[0] * c0.x + s0[1] * c0.y + s0[2] * c0.z + s0[3] * c0.w + s0[4] * c1.x + s0[5] * c1.y + s0[6] * c1.z + s0[7] * c1.w;
      float y1 = s1[0] * c0.x + s1[1] * c0.y + s1[2] * c0.z + s1[3] * c0.w + s1[4] * c1.x + s1[5] * c1.y + s1[6] * c1.z + s1[7] * c1.w;
      y0 = red16(y0);
      y1 = red16(y1);
      if (l15 == 0) *(float2*)(yb + t * 64 + r0) = make_float2(y0, y1);
    }
  }
}

__device__ __forceinline__ void gla_chain(const P& p, int chain, char* smem) {
  const int dir = chain & 1, h = (chain >> 1) & 3, b = chain >> 3;
  float* cQ = (float*)smem;
  float* cK = cQ + 2048;
  float* cD = cK + 2048;
  float* cV = cD + 2048;
  float* yb = cV + 4096;
  float* up = yb + 4096;
  float* gbias = up + 1024;
  const int tid = tidx(), lane = tid & 63, wave = tid >> 6;
  const int l15 = lane & 15, lg = lane >> 4;
  const bf* P1 = (const bf*)(p.ws + OFF_P1C);
  bf* Y = (bf*)(p.ws + OFF_GY) + (size_t)dir * RT * 512;
  const float* gup = p.in[dir ? 48 : 46];
  const float* gb = p.in[dir ? 49 : 47];
  __syncthreads();
  for (int i = tid; i < 1024; i += NT) up[i] = gup[(i >> 6) * 256 + h * 64 + (i & 63)];
  if (tid < 64) gbias[tid] = gb[h * 64 + tid];
  const int st = tid >> 4, q = tid & 15;
  const int r0 = wave * 16 + lg * 4;
  float s[4][4];
#pragma unroll
  for (int r = 0; r < 4; ++r)
#pragma unroll
    for (int j = 0; j < 4; ++j) s[r][j] = 0.f;
  uint2 gQ, gK;
  uint4 gV, gG0, gG1;
  {
    const bf* row = P1 + (size_t)scan_row(b, dir, st) * 2080;
    gQ = *(const uint2*)(row + 528 + h * 64 + q * 4);
    gK = *(const uint2*)(row + 784 + h * 64 + q * 4);
    gV = *(const uint4*)(row + 1040 + h * 128 + q * 8);
    gG0 = *(const uint4*)(row + 2064);
    gG1 = *(const uint4*)(row + 2072);
  }
  const int NCH = TA / 32;
  for (int ch = 0; ch <= NCH; ++ch) {
    __syncthreads();
    if (ch > 0) {
      float4 ya = *(const float4*)(yb + st * 128 + q * 8);
      float4 yc = *(const float4*)(yb + st * 128 + q * 8 + 4);
      uint4 o4;
      o4.x = pack2(ya.x, ya.y); o4.y = pack2(ya.z, ya.w); o4.z = pack2(yc.x, yc.y); o4.w = pack2(yc.z, yc.w);
      *(uint4*)(Y + (size_t)scan_row(b, dir, (ch - 1) * 32 + st) * 512 + h * 128 + q * 8) = o4;
    }
    if (ch == NCH) break;
    {
      float gd[16];
      gd[0] = bflo(gG0.x); gd[1] = bfhi(gG0.x); gd[2] = bflo(gG0.y); gd[3] = bfhi(gG0.y);
      gd[4] = bflo(gG0.z); gd[5] = bfhi(gG0.z); gd[6] = bflo(gG0.w); gd[7] = bfhi(gG0.w);
      gd[8] = bflo(gG1.x); gd[9] = bfhi(gG1.x); gd[10] = bflo(gG1.y); gd[11] = bfhi(gG1.y);
      gd[12] = bflo(gG1.z); gd[13] = bfhi(gG1.z); gd[14] = bflo(gG1.w); gd[15] = bfhi(gG1.w);
      float4 z = *(const float4*)(gbias + q * 4);
#pragma unroll
      for (int i = 0; i < 16; ++i) {
        float4 u4 = *(const float4*)(up + i * 64 + q * 4);
        z.x += gd[i] * u4.x; z.y += gd[i] * u4.y; z.z += gd[i] * u4.z; z.w += gd[i] * u4.w;
      }
      float4 dd;
      dd.x = expf(-softplusf_(-z.x) * (1.f / 16.f));
      dd.y = expf(-softplusf_(-z.y) * (1.f / 16.f));
      dd.z = expf(-softplusf_(-z.z) * (1.f / 16.f));
      dd.w = expf(-softplusf_(-z.w) * (1.f / 16.f));
      *(float4*)(cD + st * 64 + q * 4) = dd;
      *(float4*)(cQ + st * 64 + q * 4) = make_float4(bflo(gQ.x) * 0.125f, bfhi(gQ.x) * 0.125f, bflo(gQ.y) * 0.125f, bfhi(gQ.y) * 0.125f);
      *(float4*)(cK + st * 64 + q * 4) = make_float4(bflo(gK.x), bfhi(gK.x), bflo(gK.y), bfhi(gK.y));
      float* d = cV + st * 128 + q * 8;
      *(float4*)d = make_float4(bflo(gV.x), bfhi(gV.x), bflo(gV.y), bfhi(gV.y));
      *(float4*)(d + 4) = make_float4(bflo(gV.z), bfhi(gV.z), bflo(gV.w), bfhi(gV.w));
    }
    __syncthreads();
    if (ch + 1 < NCH) {
      const bf* row = P1 + (size_t)scan_row(b, dir, (ch + 1) * 32 + st) * 2080;
      gQ = *(const uint2*)(row + 528 + h * 64 + q * 4);
      gK = *(const uint2*)(row + 784 + h * 64 + q * 4);
      gV = *(const uint4*)(row + 1040 + h * 128 + q * 8);
      gG0 = *(const uint4*)(row + 2064);
      gG1 = *(const uint4*)(row + 2072);
    }
#pragma unroll 4
    for (int t = 0; t < 32; ++t) {
      float4 q4 = *(const float4*)(cQ + t * 64 + l15 * 4);
      float4 k4 = *(const float4*)(cK + t * 64 + l15 * 4);
      float4 d4 = *(const float4*)(cD + t * 64 + l15 * 4);
      float4 v4 = *(const float4*)(cV + t * 128 + r0);
      float vv[4] = {v4.x, v4.y, v4.z, v4.w};
      float yy[4];
#pragma unroll
      for (int r = 0; r < 4; ++r) {
        s[r][0] = s[r][0] * d4.x + k4.x * vv[r];
        s[r][1] = s[r][1] * d4.y + k4.y * vv[r];
        s[r][2] = s[r][2] * d4.z + k4.z * vv[r];
        s[r][3] = s[r][3] * d4.w + k4.w * vv[r];
        yy[r] = red16(s[r][0] * q4.x + s[r][1] * q4.y + s[r][2] * q4.z + s[r][3] * q4.w);
      }
      if (l15 == 0) *(float4*)(yb + t * 128 + r0) = make_float4(yy[0], yy[1], yy[2], yy[3]);
    }
  }
}

typedef __attribute__((address_space(3))) s16x4* lds_s16x4p;
template <int LD>
__device__ __forceinline__ bf16x8 trfrag_t(const bf* img, int r0, int c0, int lane) {
  const bf* pp = img + (r0 + ((lane & 15) >> 2)) * LD + c0 + (lane & 3) * 4;
  return tr_pair<4 * LD * 2>(pp);
}
#define trfrag(img, ld, r0, c0, lane) trfrag_t<ld>(img, r0, c0, lane)
__device__ __forceinline__ bf16x8 pack8(f32x4 a, f32x4 b) {
  i32x4 t;
  t[0] = (int)pack2(a[0], a[1]); t[1] = (int)pack2(a[2], a[3]); t[2] = (int)pack2(b[0], b[1]); t[3] = (int)pack2(b[2], b[3]);
  return __builtin_bit_cast(bf16x8, t);
}
__device__ __forceinline__ bf16x8 ld2x64(const bf* p0, const bf* p1) {
  uint2 a = *(const uint2*)p0, b2 = *(const uint2*)p1;
  i32x4 t;
  t[0] = (int)a.x; t[1] = (int)a.y; t[2] = (int)b2.x; t[3] = (int)b2.y;
  return __builtin_bit_cast(bf16x8, t);
}

__device__ __forceinline__ void gla_chain2(const P& p, int chain, int half, char* smem) {
  const int dir = chain & 1, h = (chain >> 1) & 3, b = chain >> 3;
  bf* Qs = (bf*)smem;
  bf* Ks = Qs + 64 * 72;
  bf* Vs = Ks + 64 * 72;
  bf* Ps = Vs + 64 * 144;
  bf* LGs = Ps + 64 * 72;
  float* segtot = (float*)(LGs + 64 * 72);
  float* dS = segtot + 512;
  const int tid = tidx(), lane = tid & 63, wave = tid >> 6;
  const int l15 = lane & 15, g = lane >> 4;
  const int ih = wave >> 2, vcol0 = (half * 4 + (wave & 3)) * 16;
  const bf* P1 = (const bf*)(p.ws + OFF_P1C);
  bf* Y = (bf*)(p.ws + OFF_GY) + (size_t)dir * RT * 512;
  const bf* LG = (const bf*)(p.ws + OFF_HO) + (size_t)dir * RT * 256;
  const int kc = tid & 63, seg = tid >> 6;
  const int stok = tid >> 3, sc8 = (tid & 7) * 8;
  f32x4 S[4];
#pragma unroll
  for (int kt = 0; kt < 4; ++kt) S[kt] = (f32x4){0.f, 0.f, 0.f, 0.f};
  uint4 rq, rk, rv0, rv1, rg;
  {
    const bf* row = P1 + (size_t)scan_row(b, dir, stok) * 2080;
    rq = *(const uint4*)(row + 528 + h * 64 + sc8);
    rk = *(const uint4*)(row + 784 + h * 64 + sc8);
    rv0 = *(const uint4*)(row + 1040 + h * 128 + sc8 * 2);
    rv1 = *(const uint4*)(row + 1040 + h * 128 + sc8 * 2 + 8);
    rg = *(const uint4*)(LG + (size_t)scan_row(b, dir, stok) * 256 + h * 64 + sc8);
  }
  const int NCH = TA / 64;
  for (int c = 0; c < NCH; ++c) {
    __syncthreads();
    *(uint4*)(Qs + stok * 72 + sc8) = rq;
    *(uint4*)(Ks + stok * 72 + sc8) = rk;
    *(uint4*)(Vs + stok * 144 + sc8 * 2) = rv0;
    *(uint4*)(Vs + stok * 144 + sc8 * 2 + 8) = rv1;
    *(uint4*)(LGs + stok * 72 + sc8) = rg;
    __syncthreads();
    if (c + 1 < NCH) {
      const bf* row = P1 + (size_t)scan_row(b, dir, (c + 1) * 64 + stok) * 2080;
      rq = *(const uint4*)(row + 528 + h * 64 + sc8);
      rk = *(const uint4*)(row + 784 + h * 64 + sc8);
      rv0 = *(const uint4*)(row + 1040 + h * 128 + sc8 * 2);
      rv1 = *(const uint4*)(row + 1040 + h * 128 + sc8 * 2 + 8);
      rg = *(const uint4*)(LG + (size_t)scan_row(b, dir, (c + 1) * 64 + stok) * 256 + h * 64 + sc8);
    }
    float lc[8];
    {
      float run = 0.f;
#pragma unroll
      for (int ii = 0; ii < 8; ++ii) {
        run += bf2f(LGs[(seg * 8 + ii) * 72 + kc]);
        lc[ii] = run;
      }
      segtot[seg * 64 + kc] = run;
    }
    __syncthreads();
    {
      float off = 0.f, tot = 0.f;
#pragma unroll
      for (int s2 = 0; s2 < 8; ++s2) {
        float t = segtot[s2 * 64 + kc];
        tot += t;
        off += (s2 < seg) ? t : 0.f;
      }
#pragma unroll
      for (int ii = 0; ii < 8; ++ii) {
        int i = seg * 8 + ii;
        float cum = off + lc[ii];
        float qv = bf2f(Qs[i * 72 + kc]), kv = bf2f(Ks[i * 72 + kc]);
        float eq = __expf(cum - tot);
        Qs[i * 72 + kc] = f2bf(qv * 0.125f * eq);
        Ks[i * 72 + kc] = f2bf(kv * __builtin_amdgcn_rcpf(eq));
      }
      if (seg == 0) dS[kc] = __expf(tot);
    }
    __syncthreads();
#pragma unroll
    for (int kt = 0; kt < 4; ++kt) {
      float4 d4 = *(const float4*)(dS + kt * 16 + g * 4);
      S[kt][0] *= d4.x; S[kt][1] *= d4.y; S[kt][2] *= d4.z; S[kt][3] *= d4.w;
    }
#pragma unroll
    for (int tt = 0; tt < 2; ++tt) {
      int idx = wave * 2 + tt, jt = idx >> 2, it = idx & 3;
      f32x4 acc = (f32x4){0.f, 0.f, 0.f, 0.f};
      if (jt <= it) {
#pragma unroll
        for (int ks = 0; ks < 2; ++ks) {
          bf16x8 a = *(const bf16x8*)(Ks + (jt * 16 + l15) * 72 + ks * 32 + g * 8);
          bf16x8 bq = *(const bf16x8*)(Qs + (it * 16 + l15) * 72 + ks * 32 + g * 8);
          acc = __builtin_amdgcn_mfma_f32_16x16x32_bf16(a, bq, acc, 0, 0, 0);
        }
        int i = it * 16 + l15;
#pragma unroll
        for (int r = 0; r < 4; ++r) { int j = jt * 16 + g * 4 + r; acc[r] = (j <= i) ? acc[r] : 0.f; }
      }
      uint2 o;
      o.x = pack2(acc[0], acc[1]);
      o.y = pack2(acc[2], acc[3]);
      *(uint2*)(Ps + (it * 16 + l15) * 72 + jt * 16 + g * 4) = o;
    }
    __syncthreads();
    f32x4 y[2];
    y[0] = (f32x4){0.f, 0.f, 0.f, 0.f};
    y[1] = (f32x4){0.f, 0.f, 0.f, 0.f};
#pragma unroll
    for (int s2 = 0; s2 < 2; ++s2) {
      bf16x8 sf = pack8(S[2 * s2], S[2 * s2 + 1]);
#pragma unroll
      for (int ii = 0; ii < 2; ++ii) {
        const bf* qr = Qs + ((ih * 2 + ii) * 16 + l15) * 72 + g * 4;
        bf16x8 aq = ld2x64(qr + (2 * s2) * 16, qr + (2 * s2 + 1) * 16);
        y[ii] = __builtin_amdgcn_mfma_f32_16x16x32_bf16(aq, sf, y[ii], 0, 0, 0);
      }
    }
    {
      bf16x8 vfs[2];
      tr_dual<32 * 144 * 2, 4 * 144 * 2>(trbase(Vs, 144, g * 8, vcol0, lane), vfs[0], vfs[1]);
#pragma unroll
      for (int s2 = 0; s2 < 2; ++s2) {
#pragma unroll
        for (int ii = 0; ii < 2; ++ii) {
          bf16x8 ap = *(const bf16x8*)(Ps + ((ih * 2 + ii) * 16 + l15) * 72 + s2 * 32 + g * 8);
          y[ii] = __builtin_amdgcn_mfma_f32_16x16x32_bf16(ap, vfs[s2], y[ii], 0, 0, 0);
        }
        bf16x8 ak[4];
        tr_quad<32, 4 * 72 * 2>(trbase(Ks, 72, s2 * 32 + g * 8, 0, lane), ak[0], ak[1], ak[2], ak[3]);
#pragma unroll
        for (int kt = 0; kt < 4; ++kt) S[kt] = __builtin_amdgcn_mfma_f32_16x16x32_bf16(ak[kt], vfs[s2], S[kt], 0, 0, 0);
      }
    }
#pragma unroll
    for (int ii = 0; ii < 2; ++ii)
#pragma unroll
      for (int r = 0; r < 4; ++r) {
        int i = (ih * 2 + ii) * 16 + g * 4 + r;
        Y[(size_t)scan_row(b, dir, c * 64 + i) * 512 + h * 128 + vcol0 + l15] = f2bf(y[ii][r]);
      }
  }
}

__device__ __forceinline__ void ssd_chain2(const P& p, int chain, char* smem) {
  const int dir = chain & 1, hh = (chain >> 1) & 7, b = chain >> 4;
  const int grp = hh >> 2;
  bf* Cs = (bf*)smem;
  bf* Bs = Cs + 64 * 136;
  bf* Xs = Bs + 64 * 136;
  bf* Xw = Xs + 64 * 72;
  bf* Ps = Xw + 64 * 72;
  float* dtS = (float*)(Ps + 64 * 72);
  float* cumS = dtS + 64;
  float* ecS = cumS + 64;
  float* totS = ecS + 64;
  const int tid = tidx(), lane = tid & 63, wave = tid >> 6;
  const int l15 = lane & 15, g = lane >> 4;
  const int vt = wave & 3, ih = wave >> 2;
  const bf* XBC = (const bf*)(p.ws + OFF_XBC);
  const float* DTR = (const float*)(p.ws + OFF_DTRAW);
  bf* Y = (bf*)(p.ws + OFF_XRAW) + (size_t)dir * RT * 512;
  const float dtb = p.in[dir ? 42 : 40][hh];
  const float Aneg = -expf(p.in[dir ? 43 : 41][hh]);
  const int stok = tid >> 3, sc = tid & 7;
  f32x4 S[8];
#pragma unroll
  for (int nt = 0; nt < 8; ++nt) S[nt] = (f32x4){0.f, 0.f, 0.f, 0.f};
  uint4 rc0, rc1, rb0, rb1, rx;
  float rdt = 0.f;
  {
    const bf* row = XBC + (size_t)scan_row(b, dir, stok) * 1024;
    rb0 = *(const uint4*)(row + 512 + grp * 128 + sc * 16);
    rb1 = *(const uint4*)(row + 512 + grp * 128 + sc * 16 + 8);
    rc0 = *(const uint4*)(row + 768 + grp * 128 + sc * 16);
    rc1 = *(const uint4*)(row + 768 + grp * 128 + sc * 16 + 8);
    rx = *(const uint4*)(row + hh * 64 + sc * 8);
    if (tid < 64) rdt = DTR[(size_t)scan_row(b, dir, tid) * 16 + dir * 8 + hh];
  }
  const int NCH = TA / 64;
  for (int c = 0; c < NCH; ++c) {
    __syncthreads();
    *(uint4*)(Cs + stok * 136 + sc * 16) = rc0;
    *(uint4*)(Cs + stok * 136 + sc * 16 + 8) = rc1;
    *(uint4*)(Bs + stok * 136 + sc * 16) = rb0;
    *(uint4*)(Bs + stok * 136 + sc * 16 + 8) = rb1;
    if (tid < 64) {
      float dt = softplusf_(rdt + dtb);
      float cum = dt * Aneg;
#pragma unroll
      for (int o = 1; o < 64; o <<= 1) {
        float t = __shfl_up(cum, o);
        if (lane >= o) cum += t;
      }
      float tot = __shfl(cum, 63);
      dtS[lane] = dt;
      cumS[lane] = cum;
      ecS[lane] = __expf(cum);
      if (lane == 0) totS[0] = tot;
    }
    __syncthreads();
    const uint4 cx = rx;
    if (c + 1 < NCH) {
      const bf* row = XBC + (size_t)scan_row(b, dir, (c + 1) * 64 + stok) * 1024;
      rb0 = *(const uint4*)(row + 512 + grp * 128 + sc * 16);
      rb1 = *(const uint4*)(row + 512 + grp * 128 + sc * 16 + 8);
      rc0 = *(const uint4*)(row + 768 + grp * 128 + sc * 16);
      rc1 = *(const uint4*)(row + 768 + grp * 128 + sc * 16 + 8);
      rx = *(const uint4*)(row + hh * 64 + sc * 8);
      if (tid < 64) rdt = DTR[(size_t)scan_row(b, dir, (c + 1) * 64 + tid) * 16 + dir * 8 + hh];
    }
    const float tot = totS[0];
    {
      float dt = dtS[stok];
      float w = dt * __expf(tot - cumS[stok]);
      float x0 = bflo(cx.x), x1 = bfhi(cx.x), x2 = bflo(cx.y), x3 = bfhi(cx.y), x4 = bflo(cx.z), x5 = bfhi(cx.z), x6 = bflo(cx.w), x7 = bfhi(cx.w);
      uint4 o;
      o.x = pack2(x0 * dt, x1 * dt); o.y = pack2(x2 * dt, x3 * dt); o.z = pack2(x4 * dt, x5 * dt); o.w = pack2(x6 * dt, x7 * dt);
      *(uint4*)(Xs + stok * 72 + sc * 8) = o;
      o.x = pack2(x0 * w, x1 * w); o.y = pack2(x2 * w, x3 * w); o.z = pack2(x4 * w, x5 * w); o.w = pack2(x6 * w, x7 * w);
      *(uint4*)(Xw + stok * 72 + sc * 8) = o;
    }
#pragma unroll
    for (int tt = 0; tt < 2; ++tt) {
      int idx = wave * 2 + tt, jt = idx >> 2, it = idx & 3;
      f32x4 acc = (f32x4){0.f, 0.f, 0.f, 0.f};
      if (jt <= it) {
#pragma unroll
        for (int ks = 0; ks < 4; ++ks) {
          bf16x8 a = *(const bf16x8*)(Bs + (jt * 16 + l15) * 136 + ks * 32 + g * 8);
          bf16x8 bq = *(const bf16x8*)(Cs + (it * 16 + l15) * 136 + ks * 32 + g * 8);
          acc = __builtin_amdgcn_mfma_f32_16x16x32_bf16(a, bq, acc, 0, 0, 0);
        }
        int i = it * 16 + l15;
        float ci = cumS[i];
        float4 cj = *(const float4*)(cumS + jt * 16 + g * 4);
        int j0 = jt * 16 + g * 4;
        acc[0] = (j0 + 0 <= i) ? acc[0] * __expf(ci - cj.x) : 0.f;
        acc[1] = (j0 + 1 <= i) ? acc[1] * __expf(ci - cj.y) : 0.f;
        acc[2] = (j0 + 2 <= i) ? acc[2] * __expf(ci - cj.z) : 0.f;
        acc[3] = (j0 + 3 <= i) ? acc[3] * __expf(ci - cj.w) : 0.f;
      }
      uint2 o;
      o.x = pack2(acc[0], acc[1]);
      o.y = pack2(acc[2], acc[3]);
      *(uint2*)(Ps + (it * 16 + l15) * 72 + jt * 16 + g * 4) = o;
    }
    __syncthreads();
    f32x4 y[2];
    y[0] = (f32x4){0.f, 0.f, 0.f, 0.f};
    y[1] = (f32x4){0.f, 0.f, 0.f, 0.f};
#pragma unroll
    for (int s2 = 0; s2 < 4; ++s2) {
      bf16x8 sf = pack8(S[2 * s2], S[2 * s2 + 1]);
#pragma unroll
      for (int ii = 0; ii < 2; ++ii) {
        const bf* qr = Cs + ((ih * 2 + ii) * 16 + l15) * 136 + g * 4;
        bf16x8 aq = ld2x64(qr + (2 * s2) * 16, qr + (2 * s2 + 1) * 16);
        y[ii] = __builtin_amdgcn_mfma_f32_16x16x32_bf16(aq, sf, y[ii], 0, 0, 0);
      }
    }
    {
      float et = __expf(tot);
#pragma unroll
      for (int nt = 0; nt < 8; ++nt) { S[nt][0] *= et; S[nt][1] *= et; S[nt][2] *= et; S[nt][3] *= et; }
    }
#pragma unroll
    for (int ii = 0; ii < 2; ++ii) {
      float4 e4 = *(const float4*)(ecS + (ih * 2 + ii) * 16 + g * 4);
      y[ii][0] *= e4.x; y[ii][1] *= e4.y; y[ii][2] *= e4.z; y[ii][3] *= e4.w;
    }
    {
      bf16x8 xfs[2], xws[2];
      tr_dual<32 * 72 * 2, 4 * 72 * 2>(trbase(Xs, 72, g * 8, vt * 16, lane), xfs[0], xfs[1]);
      tr_dual<32 * 72 * 2, 4 * 72 * 2>(trbase(Xw, 72, g * 8, vt * 16, lane), xws[0], xws[1]);
#pragma unroll
      for (int s2 = 0; s2 < 2; ++s2) {
#pragma unroll
        for (int ii = 0; ii < 2; ++ii) {
          bf16x8 ap = *(const bf16x8*)(Ps + ((ih * 2 + ii) * 16 + l15) * 72 + s2 * 32 + g * 8);
          y[ii] = __builtin_amdgcn_mfma_f32_16x16x32_bf16(ap, xfs[s2], y[ii], 0, 0, 0);
        }
#pragma unroll
        for (int nq = 0; nq < 2; ++nq) {
          bf16x8 ab[4];
          tr_quad<32, 4 * 136 * 2>(trbase(Bs, 136, s2 * 32 + g * 8, nq * 64, lane), ab[0], ab[1], ab[2], ab[3]);
#pragma unroll
          for (int n4 = 0; n4 < 4; ++n4) S[nq * 4 + n4] = __builtin_amdgcn_mfma_f32_16x16x32_bf16(ab[n4], xws[s2], S[nq * 4 + n4], 0, 0, 0);
        }
      }
    }
#pragma unroll
    for (int ii = 0; ii < 2; ++ii)
#pragma unroll
      for (int r = 0; r < 4; ++r) {
        int i = (ih * 2 + ii) * 16 + g * 4 + r;
        Y[(size_t)scan_row(b, dir, c * 64 + i) * 512 + hh * 64 + vt * 16 + l15] = f2bf(y[ii][r]);
      }
  }
}

__device__ __forceinline__ void rwkv_chain2(const P& p, int chain, char* smem) {
  const int dir = chain & 1, h = (chain >> 1) & 7, b = chain >> 4;
  bf* KT = (bf*)smem;
  bf* RTi = KT + 4608;
  bf* KH = RTi + 4608;
  bf* BH = KH + 4608;
  bf* VV = BH + 4608;
  bf* MAkk = VV + 4608;
  bf* MBrk = MAkk + 4608;
  bf* MBrb = MBrk + 4608;
  bf* UN = MBrb + 4608;
  bf* LWs = UN + 4608;
  float* AKB = (float*)(LWs + 4608);
  float* RH = AKB + 64 * 68;
  float* segtot = RH + 64 * 68;
  float* dS = segtot + 512;
  const int tid = tidx(), lane = tid & 63, wave = tid >> 6;
  const int l15 = lane & 15, g = lane >> 4;
  const int vt = wave & 3, ih = wave >> 2;
  const bf* PR = (const bf*)(p.ws + OFF_PREP);
  const bf* PK = PR + (size_t)RT * 512;
  const bf* PV = PK + (size_t)RT * 512;
  const bf* PKK = PV + (size_t)RT * 512;
  const bf* PKA = PKK + (size_t)RT * 512;
  const bf* PLW = PKA + (size_t)RT * 512 + (size_t)dir * RT * 512;
  bf* Y = (bf*)p.out + (size_t)dir * RT * 512;
  const int kc = tid & 63, seg = tid >> 6;
  const int stok = tid >> 3, sc8 = (tid & 7) * 8;
  f32x4 T[4];
#pragma unroll
  for (int kt = 0; kt < 4; ++kt) T[kt] = (f32x4){0.f, 0.f, 0.f, 0.f};
  uint4 gR, gK, gV, gKK, gKA, gW;
  {
    size_t o = (size_t)scan_row(b, dir, stok) * 512 + h * 64 + sc8;
    gR = *(const uint4*)(PR + o); gK = *(const uint4*)(PK + o); gV = *(const uint4*)(PV + o);
    gKK = *(const uint4*)(PKK + o); gKA = *(const uint4*)(PKA + o); gW = *(const uint4*)(PLW + o);
  }
  const int NCH = TA / 64;
  for (int c = 0; c < NCH; ++c) {
    __syncthreads();
    *(uint4*)(RTi + stok * 72 + sc8) = gR;
    *(uint4*)(KH + stok * 72 + sc8) = gK;
    *(uint4*)(VV + stok * 72 + sc8) = gV;
    *(uint4*)(KT + stok * 72 + sc8) = gKK;
    *(uint4*)(BH + stok * 72 + sc8) = gKA;
    *(uint4*)(LWs + stok * 72 + sc8) = gW;
    __syncthreads();
    if (c + 1 < NCH) {
      size_t o = (size_t)scan_row(b, dir, (c + 1) * 64 + stok) * 512 + h * 64 + sc8;
      gR = *(const uint4*)(PR + o); gK = *(const uint4*)(PK + o); gV = *(const uint4*)(PV + o);
      gKK = *(const uint4*)(PKK + o); gKA = *(const uint4*)(PKA + o); gW = *(const uint4*)(PLW + o);
    }
    float lc[8];
    {
      float run = 0.f;
#pragma unroll
      for (int ii = 0; ii < 8; ++ii) {
        run += bf2f(LWs[(seg * 8 + ii) * 72 + kc]);
        lc[ii] = run;
      }
      segtot[seg * 64 + kc] = run;
    }
    __syncthreads();
    {
      float off = 0.f, tot = 0.f;
#pragma unroll
      for (int s2 = 0; s2 < 8; ++s2) {
        float t = segtot[s2 * 64 + kc];
        tot += t;
        off += (s2 < seg) ? t : 0.f;
      }
#pragma unroll
      for (int ii = 0; ii < 8; ++ii) {
        const int i = seg * 8 + ii;
        const float cum = off + lc[ii];
        const float cumx = off + (ii > 0 ? lc[ii > 0 ? ii - 1 : 0] : 0.f);
        const float eR = __expf(cum - tot);
        const float eK = __builtin_amdgcn_rcpf(eR);
        const float eX = __expf(cumx - tot);
        const int o = i * 72 + kc;
        RTi[o] = f2bf(bf2f(RTi[o]) * eR);
        KH[o] = f2bf(bf2f(KH[o]) * eK);
        BH[o] = f2bf(bf2f(BH[o]) * eK);
        KT[o] = f2bf(bf2f(KT[o]) * eX);
      }
      if (seg == 0) dS[kc] = __expf(tot);
    }
    __syncthreads();
#pragma unroll
    for (int kt = 0; kt < 4; ++kt) {
      float4 d4 = *(const float4*)(dS + kt * 16 + g * 4);
      T[kt][0] *= d4.x; T[kt][1] *= d4.y; T[kt][2] *= d4.z; T[kt][3] *= d4.w;
    }
#pragma unroll
    for (int tt = 0; tt < 2; ++tt) {
      const int idx = wave * 2 + tt, jt = idx >> 2, it = idx & 3;
      f32x4 akb = (f32x4){0.f, 0.f, 0.f, 0.f}, akk = akb, brk = akb, brb = akb;
      if (jt <= it) {
#pragma unroll
        for (int ks = 0; ks < 2; ++ks) {
          bf16x8 aKH = *(const bf16x8*)(KH + (jt * 16 + l15) * 72 + ks * 32 + g * 8);
          bf16x8 aBH = *(const bf16x8*)(BH + (jt * 16 + l15) * 72 + ks * 32 + g * 8);
          bf16x8 bKT = *(const bf16x8*)(KT + (it * 16 + l15) * 72 + ks * 32 + g * 8);
          bf16x8 bRT = *(const bf16x8*)(RTi + (it * 16 + l15) * 72 + ks * 32 + g * 8);
          akb = __builtin_amdgcn_mfma_f32_16x16x32_bf16(aBH, bKT, akb, 0, 0, 0);
          akk = __builtin_amdgcn_mfma_f32_16x16x32_bf16(aKH, bKT, akk, 0, 0, 0);
          brk = __builtin_amdgcn_mfma_f32_16x16x32_bf16(aKH, bRT, brk, 0, 0, 0);
          brb = __builtin_amdgcn_mfma_f32_16x16x32_bf16(aBH, bRT, brb, 0, 0, 0);
        }
        const int i = it * 16 + l15;
#pragma unroll
        for (int r = 0; r < 4; ++r) {
          const int j = jt * 16 + g * 4 + r;
          akb[r] = (j < i) ? akb[r] : 0.f;
          akk[r] = (j < i) ? akk[r] : 0.f;
          brk[r] = (j <= i) ? brk[r] : 0.f;
          brb[r] = (j <= i) ? brb[r] : 0.f;
        }
      }
      const int orow = (it * 16 + l15), ocol = jt * 16 + g * 4;
      uint2 o;
      o.x = pack2(akk[0], akk[1]); o.y = pack2(akk[2], akk[3]);
      *(uint2*)(MAkk + orow * 72 + ocol) = o;
      o.x = pack2(brk[0], brk[1]); o.y = pack2(brk[2], brk[3]);
      *(uint2*)(MBrk + orow * 72 + ocol) = o;
      o.x = pack2(brb[0], brb[1]); o.y = pack2(brb[2], brb[3]);
      *(uint2*)(MBrb + orow * 72 + ocol) = o;
      *(float4*)(AKB + orow * 68 + ocol) = make_float4(akb[0], akb[1], akb[2], akb[3]);
    }
    __syncthreads();
    bf16x8 tf0 = pack8(T[0], T[1]), tf1 = pack8(T[2], T[3]);
    f32x4 yv[2];
    {
      bf16x8 vf0, vf1;
      tr_dual<32 * 72 * 2, 4 * 72 * 2>(trbase(VV, 72, g * 8, vt * 16, lane), vf0, vf1);
#pragma unroll
      for (int ii = 0; ii < 2; ++ii) {
        const int it = ih * 2 + ii;
        f32x4 acc = (f32x4){0.f, 0.f, 0.f, 0.f};
        const bf* qr = KT + (it * 16 + l15) * 72 + g * 4;
        acc = __builtin_amdgcn_mfma_f32_16x16x32_bf16(ld2x64(qr, qr + 16), tf0, acc, 0, 0, 0);
        acc = __builtin_amdgcn_mfma_f32_16x16x32_bf16(ld2x64(qr + 32, qr + 48), tf1, acc, 0, 0, 0);
        const bf* ar = MAkk + (it * 16 + l15) * 72 + g * 8;
        acc = __builtin_amdgcn_mfma_f32_16x16x32_bf16(*(const bf16x8*)ar, vf0, acc, 0, 0, 0);
        acc = __builtin_amdgcn_mfma_f32_16x16x32_bf16(*(const bf16x8*)(ar + 32), vf1, acc, 0, 0, 0);
#pragma unroll
        for (int r = 0; r < 4; ++r) RH[(it * 16 + g * 4 + r) * 68 + vt * 16 + l15] = acc[r];
        f32x4 ya = (f32x4){0.f, 0.f, 0.f, 0.f};
        const bf* rr = RTi + (it * 16 + l15) * 72 + g * 4;
        ya = __builtin_amdgcn_mfma_f32_16x16x32_bf16(ld2x64(rr, rr + 16), tf0, ya, 0, 0, 0);
        ya = __builtin_amdgcn_mfma_f32_16x16x32_bf16(ld2x64(rr + 32, rr + 48), tf1, ya, 0, 0, 0);
        const bf* br = MBrk + (it * 16 + l15) * 72 + g * 8;
        ya = __builtin_amdgcn_mfma_f32_16x16x32_bf16(*(const bf16x8*)br, vf0, ya, 0, 0, 0);
        ya = __builtin_amdgcn_mfma_f32_16x16x32_bf16(*(const bf16x8*)(br + 32), vf1, ya, 0, 0, 0);
        yv[ii] = ya;
      }
      {
        bf16x8 k0[4], k1[4];
        tr_quad<32, 4 * 72 * 2>(trbase(KH, 72, g * 8, 0, lane), k0[0], k0[1], k0[2], k0[3]);
        tr_quad<32, 4 * 72 * 2>(trbase(KH, 72, 32 + g * 8, 0, lane), k1[0], k1[1], k1[2], k1[3]);
#pragma unroll
        for (int kt = 0; kt < 4; ++kt) {
          T[kt] = __builtin_amdgcn_mfma_f32_16x16x32_bf16(k0[kt], vf0, T[kt], 0, 0, 0);
          T[kt] = __builtin_amdgcn_mfma_f32_16x16x32_bf16(k1[kt], vf1, T[kt], 0, 0, 0);
        }
      }
    }
    __syncthreads();
    for (int rb = 0; rb < 8; ++rb) {
      if (wave == 0) {
        float acc[8];
#pragma unroll
        for (int q = 0; q < 8; ++q) acc[q] = RH[(rb * 8 + q) * 68 + lane];
#pragma unroll
        for (int q = 1; q < 8; ++q) {
          const float4 d0 = *(const float4*)(AKB + (rb * 8 + q) * 68 + rb * 8);
          const float4 d1 = *(const float4*)(AKB + (rb * 8 + q) * 68 + rb * 8 + 4);
          const float dd[8] = {d0.x, d0.y, d0.z, d0.w, d1.x, d1.y, d1.z, d1.w};
#pragma unroll
          for (int cc = 0; cc < q; ++cc) acc[q] -= dd[cc] * acc[cc];
        }
#pragma unroll
        for (int q = 0; q < 8; ++q) {
          RH[(rb * 8 + q) * 68 + lane] = acc[q];
          UN[(rb * 8 + q) * 72 + lane] = f2bf(-acc[q]);
        }
      }
      __syncthreads();
      if (rb < 7) {
        float uq[8];
#pragma unroll
        for (int q = 0; q < 8; ++q) uq[q] = RH[(rb * 8 + q) * 68 + lane];
        for (int r = (rb + 1) * 8 + wave; r < 64; r += 8) {
          const float4 a0 = *(const float4*)(AKB + r * 68 + rb * 8);
          const float4 a1 = *(const float4*)(AKB + r * 68 + rb * 8 + 4);
          float Rv = RH[r * 68 + lane];
          Rv -= ((a0.x * uq[0] + a0.y * uq[1]) + (a0.z * uq[2] + a0.w * uq[3])) + ((a1.x * uq[4] + a1.y * uq[5]) + (a1.z * uq[6] + a1.w * uq[7]));
          RH[r * 68 + lane] = Rv;
        }
        __syncthreads();
      }
    }
    __syncthreads();
    {
      bf16x8 uf0, uf1;
      tr_dual<32 * 72 * 2, 4 * 72 * 2>(trbase(UN, 72, g * 8, vt * 16, lane), uf0, uf1);
#pragma unroll
      for (int ii = 0; ii < 2; ++ii) {
        const int it = ih * 2 + ii;
        const bf* br = MBrb + (it * 16 + l15) * 72 + g * 8;
        yv[ii] = __builtin_amdgcn_mfma_f32_16x16x32_bf16(*(const bf16x8*)br, uf0, yv[ii], 0, 0, 0);
        yv[ii] = __builtin_amdgcn_mfma_f32_16x16x32_bf16(*(const bf16x8*)(br + 32), uf1, yv[ii], 0, 0, 0);
      }
      {
        bf16x8 b0[4], b1[4];
        tr_quad<32, 4 * 72 * 2>(trbase(BH, 72, g * 8, 0, lane), b0[0], b0[1], b0[2], b0[3]);
        tr_quad<32, 4 * 72 * 2>(trbase(BH, 72, 32 + g * 8, 0, lane), b1[0], b1[1], b1[2], b1[3]);
#pragma unroll
        for (int kt = 0; kt < 4; ++kt) {
          T[kt] = __builtin_amdgcn_mfma_f32_16x16x32_bf16(b0[kt], uf0, T[kt], 0, 0, 0);
          T[kt] = __builtin_amdgcn_mfma_f32_16x16x32_bf16(b1[kt], uf1, T[kt], 0, 0, 0);
        }
      }
    }
#pragma unroll
    for (int ii = 0; ii < 2; ++ii)
#pragma unroll
      for (int r = 0; r < 4; ++r) {
        const int i = (ih * 2 + ii) * 16 + g * 4 + r;
        Y[(size_t)scan_row(b, dir, c * 64 + i) * 512 + h * 64 + vt * 16 + l15] = f2bf(yv[ii][r]);
      }
  }
}

__device__ __forceinline__ void ph_mix1(const P& p, char* smem) {
  for (int u = blockIdx.x; u < 256; u += gridDim.x) {
    if (u < 128) ssd_chain2(p, u, smem);
    else gla_chain2(p, (u - 128) >> 1, (u - 128) & 1, smem);
  }
}

__device__ __forceinline__ void ph_post1(const P& p, char* smem) {
  float* ws1 = (float*)smem;
  float* ws2 = ws1 + 32;
  const int tid = tidx(), lane = tid & 63, wave = tid >> 6;
  const bf* SYF = (const bf*)(p.ws + OFF_XRAW);
  const bf* SYB = SYF + (size_t)RT * 512;
  const bf* GYF = (const bf*)(p.ws + OFF_GY);
  const bf* GYB = GYF + (size_t)RT * 512;
  const bf* XBC = (const bf*)(p.ws + OFF_XBC);
  const bf* P1 = (const bf*)(p.ws + OFF_P1C);
  bf* O = (bf*)(p.ws + OFF_HO);
  const float dsk = p.in[44][tid >> 6];
  const float sn = p.in[45][tid];
  const float gn = p.in[50][tid & 127];
  for (int rr0 = blockIdx.x * 4; rr0 < NBAT * SEQ; rr0 += gridDim.x * 4) {
    float y[4], y2[4], zg[4], gg[4];
    int Rr[4];
#pragma unroll
    for (int i = 0; i < 4; ++i) {
      int rr = rr0 + i;
      int R = (rr >> 12) * TA + CTX + (rr & 4095);
      Rr[i] = R;
      size_t o = (size_t)R * 512 + tid;
      y[i] = bf2f(SYF[o]) + bf2f(SYB[o]) + bf2f(XBC[(size_t)R * 1024 + tid]) * dsk;
      zg[i] = bf2f(P1[(size_t)R * 2080 + tid]);
      y2[i] = bf2f(GYF[o]) + bf2f(GYB[o]);
      gg[i] = bf2f(P1[(size_t)R * 2080 + 1552 + tid]);
    }
    __syncthreads();
#pragma unroll
    for (int i = 0; i < 4; ++i) {
      y[i] *= siluf_(zg[i]);
      float s1 = wave_sum(y[i] * y[i]);
      float s2 = wave_sum(y2[i] * y2[i]);
      if (lane == 0) { ws1[i * 8 + wave] = s1; ws2[i * 8 + wave] = s2; }
    }
    __syncthreads();
#pragma unroll
    for (int i = 0; i < 4; ++i) {
      int g4 = i * 8 + (wave >> 2) * 4;
      float t1 = ws1[g4] + ws1[g4 + 1] + ws1[g4 + 2] + ws1[g4 + 3];
      int g2 = i * 8 + (wave >> 1) * 2;
      float t2 = ws2[g2] + ws2[g2 + 1];
      float o1 = y[i] * rsqrtf(t1 * (1.f / 256.f) + 1e-6f) * sn;
      float o2 = y2[i] * rsqrtf(t2 * (1.f / 128.f) + 1e-6f) * gn * siluf_(gg[i]);
      O[(size_t)Rr[i] * 1024 + tid] = f2bf(o1);
      O[(size_t)Rr[i] * 1024 + 512 + tid] = f2bf(o2);
    }
  }
}

__device__ __forceinline__ void ph_final(const P& p) {
  const int lane = tidx() & 63, wave = tidx() >> 6;
  const float* g = p.in[51];
  for (int r = blockIdx.x * 8 + wave; r < NBAT * SEQ; r += gridDim.x * 8) {
    float* row = p.out + (size_t)r * 1024;
    float4 v[4];
    float ss = 0.f;
#pragma unroll
    for (int i = 0; i < 4; ++i) {
      v[i] = *(const float4*)(row + i * 256 + lane * 4);
      ss += v[i].x * v[i].x + v[i].y * v[i].y + v[i].z * v[i].z + v[i].w * v[i].w;
    }
    ss = wave_sum(ss);
    float rs = rsqrtf(ss * (1.f / 1024.f) + 1e-6f);
#pragma unroll
    for (int i = 0; i < 4; ++i) {
      float4 gg = *(const float4*)(g + i * 256 + lane * 4);
      float4 o = make_float4(v[i].x * rs * gg.x, v[i].y * rs * gg.y, v[i].z * rs * gg.z, v[i].w * rs * gg.w);
      *(float4*)(row + i * 256 + lane * 4) = o;
    }
  }
}

#define XB_TMO      128
#define XB_XCNT(j)  (256  + 64 * (j))
#define XB_XSUB(j)  (1280 + 64 * (j))
#define XB_XGEN(j)  (2304 + 64 * (j))
#define XB_TOP      3328
#define XB_TOPGEN   3392
#define XCD_BAR_WORDS 3456
#define XB_SPIN_CAP (1u << 18)
#define LAS __attribute__((address_space(3)))
__device__ __forceinline__ unsigned xb_ld(unsigned* q)              { return __hip_atomic_load(q, __ATOMIC_RELAXED, __HIP_MEMORY_SCOPE_AGENT); }
__device__ __forceinline__ unsigned xb_add(unsigned* q, unsigned v) { return __hip_atomic_fetch_add(q, v, __ATOMIC_RELAXED, __HIP_MEMORY_SCOPE_AGENT); }
__device__ __forceinline__ unsigned xb_xcc_id() { return (unsigned)__builtin_amdgcn_s_getreg((3 << 11) | 20) & 0xFu; }
#define XB_SPIN(cond, bar) do { unsigned _sp = 0; while (cond) { __builtin_amdgcn_s_sleep(1); \
    if ((++_sp & 255u) == 0u) { if (xb_ld(&(bar)[XB_TMO])) break; if (_sp > XB_SPIN_CAP) { atomicAdd(&(bar)[XB_TMO], 1u); break; } } } } while (0)
struct XcdBarrier { unsigned* bar; unsigned x; volatile LAS unsigned* st; };
__device__ __forceinline__ XcdBarrier xcd_barrier_post(unsigned* bar, volatile LAS unsigned* st) {
  XcdBarrier b; b.bar = bar; b.x = xb_xcc_id(); b.st = st;
  if (threadIdx.x == 0) (void)xb_add(&bar[XB_XCNT(b.x)], 1u);
  return b;
}
__device__ __forceinline__ void xcd_barrier_complete(unsigned* bar, unsigned x, unsigned& nloc, unsigned& nx) {
  const unsigned G = gridDim.x * gridDim.y * gridDim.z;
  unsigned sum, cnt, mine, sp = 0u;
  for (;;) {
    sum = 0u; cnt = 0u; mine = 0u;
#pragma unroll
    for (unsigned j = 0; j < 16; ++j) { const unsigned c = xb_ld(&bar[XB_XCNT(j)]); sum += c; cnt += (c > 0u) ? 1u : 0u; mine = (j == x) ? c : mine; }
    if (sum == G) break;
    __builtin_amdgcn_s_sleep(1);
    if ((++sp & 255u) == 0u) { if (xb_ld(&bar[XB_TMO])) break; if (sp > XB_SPIN_CAP) { atomicAdd(&bar[XB_TMO], 1u); break; } }
  }
  nloc = mine > 0u ? mine : 1u; nx = cnt > 0u ? cnt : 1u;
}
__device__ __forceinline__ void xcd_barrier(const XcdBarrier& b) {
  asm volatile("s_waitcnt vmcnt(0)" ::: "memory");
  __syncthreads();
  if (threadIdx.x == 0) {
    unsigned* bar = b.bar;
    __builtin_amdgcn_s_waitcnt(0);
    unsigned nloc = b.st[0], nx = b.st[1];
    if (nloc == 0u) { xcd_barrier_complete(bar, b.x, nloc, nx); b.st[0] = nloc; b.st[1] = nx; }
    const unsigned old = xb_add(&bar[XB_XSUB(b.x)], 1u);
    const unsigned gen = old / nloc;
    if (old + 1u == (gen + 1u) * nloc) {
      __builtin_amdgcn_fence(__ATOMIC_RELEASE, "agent");
      asm volatile("s_waitcnt vmcnt(0)" ::: "memory");
      const unsigned og = xb_add(&bar[XB_TOP], 1u);
      const unsigned tg = og / nx;
      if (og + 1u == (tg + 1u) * nx) xb_add(&bar[XB_TOPGEN], 1u);
      else XB_SPIN(xb_ld(&bar[XB_TOPGEN]) == tg, bar);
      __builtin_amdgcn_fence(__ATOMIC_ACQUIRE, "agent");
      xb_add(&bar[XB_XGEN(b.x)], 1u);
      asm volatile("s_waitcnt vmcnt(0)" ::: "memory");
    } else {
      XB_SPIN(xb_ld(&bar[XB_XGEN(b.x)]) == gen, bar);
      __builtin_amdgcn_fence(__ATOMIC_ACQUIRE, "agent");
      asm volatile("s_waitcnt vmcnt(0)" ::: "memory");
    }
  }
  __syncthreads();
}

constexpr int NPH = 20;
template <int PH>
__device__ __forceinline__ void run_phase(const P& p, char* smem) {
  const bf* WT = (const bf*)(p.ws + OFF_WT);
  const bf* WT1 = (const bf*)(p.ws + OFF_WT1);
  const bf* HO = (const bf*)(p.ws + OFF_HO);
  const bf* HID = (const bf*)(p.ws + OFF_HID);
  if constexpr (PH == 0) {
    if (blockIdx.x == 0 && tidx() == 0) { *(int*)(p.ws + OFF_CNT) = 0; *((int*)(p.ws + OFF_CNT) + 1) = 0; }
    ph_mod(p, smem);
    ph_lw(p);
    ph_wt(p, 0, smem, blockIdx.x, gridDim.x);
  } else if constexpr (PH == 1) ph_ada(p, 0, 0, 1, 0);
  else if constexpr (PH == 2) ph_gemm<0>(p, HO, WT + WT_IN, 1024, 13, 0, 0, smem);
  else if constexpr (PH == 3) {
    ph_rope(p, smem);
    ph_rwkv_prep(p, smem);
#ifdef PROBE_PREP
    __syncthreads();
    ph_rwkv_prep(p, smem);
#endif
  }
  else if constexpr (PH == 4) ph_mix0(p, smem);
  else if constexpr (PH == 5) ph_rwkv_post(p);
  else if constexpr (PH == 6) ph_gemm<2>(p, HO, WT + WT_OUT, 1024, 4, 0, 0, smem);
  else if constexpr (PH == 7) ph_ada(p, 0, 1, 0, 0);
  else if constexpr (PH == 8) ph_gemm<3>(p, HO, WT + WT_W1, 1024, 16, 0, 0, smem);
  else if constexpr (PH == 9) {
    ph_gemm<4>(p, HID, WT + WT_W2, 4096, 4, 0, 0, smem);
    const int extra = 544 % (int)gridDim.x;
    if ((int)gridDim.x - extra >= 32) { if ((int)blockIdx.x >= extra) ph_wt(p, 1, smem, blockIdx.x - extra, gridDim.x - extra); }
    else ph_wt(p, 1, smem, blockIdx.x, gridDim.x);
  }
  else if constexpr (PH == 10) ph_ada(p, 1, 0, 0, 0);
  else if constexpr (PH == 11) ph_gemm<1>(p, HO, WT1 + WT_IN, 1024, 13, 1, 0, smem);
  else if constexpr (PH == 12) { ph_conv(p); ph_gla_gates(p, smem); }
  else if constexpr (PH == 13) ph_mix1(p, smem);
  else if constexpr (PH == 14) ph_post1(p, smem);
  else if constexpr (PH == 15) ph_gemm<2>(p, HO, WT1 + WT_OUT, 1024, 4, 1, 1, smem);
  else if constexpr (PH == 16) ph_ada(p, 1, 1, 0, 1);
  else if constexpr (PH == 17) ph_gemm<3>(p, HO, WT1 + WT_W1, 1024, 16, 1, 1, smem);
  else if constexpr (PH == 18) ph_gemm<4>(p, HID, WT1 + WT_W2, 4096, 4, 1, 1, smem);
  else ph_final(p);
}

constexpr int LDS_BYTES = 131072 + 64;
template <int PH>
__device__ __forceinline__ void run_all(const P& p, char* smem, const XcdBarrier& xb) {
  run_phase<PH>(p, smem);
#ifdef PROBE_MASK
  if constexpr (((PROBE_MASK) >> PH) & 1) {
    xcd_barrier(xb);
    if constexpr (PH == 4) {
      if (blockIdx.x == 0 && tidx() == 0) *(int*)(p.ws + OFF_CNT) = 0;
      xcd_barrier(xb);
    }
    run_phase<PH>(p, smem);
  }
#endif
  if constexpr (PH + 1 < NPH) {
    if constexpr (PH == 0) cg::this_grid().sync();
    else xcd_barrier(xb);
    run_all<PH + 1>(p, smem, xb);
  }
}
__global__ void __launch_bounds__(NT) mega(P p) {
  extern __shared__ __attribute__((aligned(16))) char smem[];
  volatile LAS unsigned* st = (volatile LAS unsigned*)(smem + 131072 + 16);
  if (threadIdx.x == 0) { st[0] = 0u; st[1] = 0u; }
  __syncthreads();
  const XcdBarrier xb = xcd_barrier_post((unsigned*)(p.ws + OFF_BAR), st);
  run_all<0>(p, smem, xb);
}

extern "C" void kernel_launch(void* const* d_in, const int* in_sizes, int n_in, void* d_out, int out_size, void* d_ws,
                              size_t ws_size, hipStream_t stream) {
  P p{};
  for (int i = 0; i < 52; ++i) p.in[i] = (const float*)d_in[i];
  p.out = (float*)d_out;
  p.ws = (char*)d_ws;
  static int grid_blocks = 0;
  if (!grid_blocks) {
    int dev = 0, cus = 0, per_cu = 0;
    (void)hipGetDevice(&dev);
    (void)hipDeviceGetAttribute(&cus, hipDeviceAttributeMultiprocessorCount, dev);
    (void)hipFuncSetAttribute((const void*)mega, hipFuncAttributeMaxDynamicSharedMemorySize, LDS_BYTES);
    (void)hipOccupancyMaxActiveBlocksPerMultiprocessor(&per_cu, mega, NT, LDS_BYTES);
    if (per_cu < 1) per_cu = 1;
    if (per_cu > 1) per_cu = 1;
    grid_blocks = cus * per_cu;
  }
  (void)hipMemsetAsync((char*)d_ws + OFF_BAR, 0, XCD_BAR_WORDS * sizeof(unsigned), stream);
  void* args[] = {&p};
  hipError_t e = hipLaunchCooperativeKernel((void*)mega, dim3(grid_blocks), dim3(NT), args, LDS_BYTES, stream);
  if (e != hipSuccess) fprintf(stderr, "cooperative launch failed: %s (grid %d)\n", hipGetErrorString(e), grid_blocks);
}
```

```cpp
#include <hip/hip_runtime.h>
#include <hip/hip_cooperative_groups.h>
#include <cstdio>
namespace cg = cooperative_groups;

#ifndef MODE_COOP
#define MODE_COOP 1
#endif

typedef unsigned short bf;
typedef __attribute__((ext_vector_type(8))) short bf16x8;
typedef __attribute__((ext_vector_type(4))) float f32x4;
typedef __attribute__((ext_vector_type(4))) int i32x4;

constexpr int NT = 512;
constexpr int Dm = 1024, NBAT = 8, SEQ = 4096, CTX = 256, TA = 4352, RT = NBAT * TA;

constexpr size_t OFF_MOD = 0;
constexpr size_t OFF_CNT = 450000;
constexpr size_t OFF_BAR = 458752;
constexpr size_t OFF_WT = 524288;
constexpr size_t WT_IN = 0, WT_OUT = (size_t)3328 * 1024, WT_W1 = WT_OUT + (size_t)1024 * 1024, WT_W2 = WT_W1 + (size_t)4096 * 1024;
constexpr size_t OFF_CTXX = OFF_WT + (size_t)12544 * 1024 * 2;
constexpr size_t OFF_HO = OFF_CTXX + (size_t)2048 * 1024 * 4;
constexpr size_t OFF_BIG = OFF_HO + (size_t)RT * 1024 * 2;
constexpr size_t SZ512 = (size_t)RT * 512 * 2;
constexpr size_t OFF_QKV = OFF_BIG;
constexpr size_t OFF_PREP = OFF_QKV + (size_t)RT * 1536 * 2;
constexpr size_t OFF_G = OFF_PREP + 7 * SZ512;
constexpr size_t OFF_BONUS = OFF_G + SZ512;
constexpr size_t OFF_LW = OFF_BONUS + (size_t)RT * 8 * 4;
constexpr size_t OFF_WT1 = 500170752;
constexpr size_t OFF_HID = OFF_BIG;
constexpr size_t OFF_P1C = OFF_BIG;
constexpr size_t OFF_XRAW = OFF_P1C + (size_t)RT * 2080 * 2;
constexpr size_t OFF_DTRAW = OFF_XRAW + (size_t)RT * 1024 * 2;
constexpr size_t OFF_XBC = OFF_DTRAW + (size_t)RT * 16 * 4;
constexpr size_t OFF_GY = OFF_XBC + (size_t)RT * 1024 * 2;

struct P {
  const float* in[52];
  float* out;
  char* ws;
};

__device__ __forceinline__ int tidx() { int t = threadIdx.x; asm volatile("" : "+v"(t)); return t; }
__device__ __forceinline__ bf f2bf(float f) { __bf16 r = (__bf16)f; return __builtin_bit_cast(bf, r); }
__device__ __forceinline__ float bf2f(bf h) { return __uint_as_float(((unsigned)h) << 16); }
__device__ __forceinline__ float bflo(unsigned u) { return __uint_as_float(u << 16); }
__device__ __forceinline__ float bfhi(unsigned u) { return __uint_as_float(u & 0xffff0000u); }
typedef __bf16 bf16x2_t __attribute__((ext_vector_type(2)));
typedef float f32x2_t __attribute__((ext_vector_type(2)));
__device__ __forceinline__ unsigned pack2(float a, float b) { f32x2_t v = {a, b}; bf16x2_t r = __builtin_convertvector(v, bf16x2_t); return __builtin_bit_cast(unsigned, r); }
__device__ __forceinline__ float sigmoidf_(float x) { return __builtin_amdgcn_rcpf(1.f + __expf(-x)); }
__device__ __forceinline__ float softplusf_(float x) { return x > 15.f ? x : __logf(1.f + __expf(x)); }
__device__ __forceinline__ float siluf_(float x) { return x * __builtin_amdgcn_rcpf(1.f + __expf(-x)); }
__device__ __forceinline__ float wave_sum(float v) {
#pragma unroll
  for (int o = 32; o >= 1; o >>= 1) v += __shfl_xor(v, o);
  return v;
}
template <int C>
__device__ __forceinline__ float dppf(float x) {
  return __builtin_bit_cast(float, __builtin_amdgcn_update_dpp(0, __builtin_bit_cast(int, x), C, 0xF, 0xF, true));
}
__device__ __forceinline__ float red16(float x) {
  x += dppf<0xB1>(x);
  x += dppf<0x4E>(x);
  x += dppf<0x141>(x);
  x += dppf<0x128>(x);
  return x;
}
__device__ __forceinline__ float* xrow(const P& p, int R) {
  int b = R / TA, a = R - b * TA;
  if (a < CTX) return (float*)(p.ws + OFF_CTXX) + (size_t)(b * CTX + a) * Dm;
  return p.out + (size_t)(b * SEQ + a - CTX) * Dm;
}
__device__ __forceinline__ const float* inrow(const P& p, int R) {
  int b = R / TA, a = R - b * TA;
  if (a < CTX) return p.in[2] + (size_t)(b * CTX + a) * Dm;
  return p.in[0] + (size_t)(b * SEQ + a - CTX) * Dm;
}
__device__ __forceinline__ int mrow(int R) {
  int b = R / TA, a = R - b * TA;
  return a < CTX ? 8 : b;
}

__device__ __forceinline__ void ph_mod(const P& p, char* smem) {
  float* sc = (float*)smem;
  float* red = sc + 9 * 1024;
  const int tid = tidx();
  bool loaded = false;
  for (int unit = blockIdx.x; unit < 2 * 192; unit += gridDim.x) {
    int layer = unit / 192, cch = unit - layer * 192;
    const float* W = p.in[layer ? 30 : 4];
    const float* bias = p.in[layer ? 31 : 5];
    __syncthreads();
    if (!loaded) {
      for (int i = tid; i < 9 * 1024; i += NT) {
        int r = i >> 10, k = i & 1023;
        float v = (r < 8) ? p.in[1][r * 1024 + k] : p.in[3][k];
        sc[i] = siluf_(v);
      }
      loaded = true;
      __syncthreads();
    }
    int cl = tid & 31, kg = tid >> 5;
    int col = cch * 32 + cl;
    float acc[9];
#pragma unroll
    for (int r = 0; r < 9; ++r) acc[r] = 0.f;
    for (int k = kg * 64; k < kg * 64 + 64; ++k) {
      float w = W[(size_t)k * 6144 + col];
#pragma unroll
      for (int r = 0; r < 9; ++r) acc[r] += sc[r * 1024 + k] * w;
    }
#pragma unroll
    for (int r = 0; r < 9; ++r) red[(kg * 9 + r) * 32 + cl] = acc[r];
    __syncthreads();
    if (tid < 288) {
      int r = tid >> 5, c = tid & 31;
      float s = 0.f;
#pragma unroll
      for (int g = 0; g < 16; ++g) s += red[(g * 9 + r) * 32 + c];
      ((float*)(p.ws + OFF_MOD))[(size_t)(layer * 9 + r) * 6144 + cch * 32 + c] = s + bias[cch * 32 + c];
    }
  }
}

__device__ __forceinline__ void transpose_one(const float* W, bf* Wt, int K, int N, int Npad, int vb, int nvb, char* smem) {
  float* tile = (float*)smem;
  const int tid = tidx();
  int ntn = Npad / 64, ntk = K / 64;
  for (int t = vb; t < ntn * ntk; t += nvb) {
    int tn = t / ntk, tk = t - tn * ntk;
    int n0 = tn * 64, k0 = tk * 64;
    __syncthreads();
#pragma unroll
    for (int i = 0; i < 8; ++i) {
      int kk = (tid >> 6) + 8 * i, nn = tid & 63;
      float v = (n0 + nn < N) ? W[(size_t)(k0 + kk) * N + n0 + nn] : 0.f;
      tile[kk * 65 + nn] = v;
    }
    __syncthreads();
#pragma unroll
    for (int i = 0; i < 8; ++i) {
      int nn = (tid >> 6) + 8 * i, kk = tid & 63;
      Wt[(size_t)(n0 + nn) * K + k0 + kk] = f2bf(tile[kk * 65 + nn]);
    }
  }
}
__device__ __forceinline__ void ph_wt(const P& p, int layer, char* smem, int b, int nb) {
  bf* WT = (bf*)(p.ws + (layer ? OFF_WT1 : OFF_WT));
  int base = layer ? 34 : 8;
  int nin = layer ? 3104 : 3328, ninp = 3328;
  for (int mtx = 0; mtx < 4; ++mtx) {
    const float* W = p.in[base + mtx];
    bf* dst = WT + (mtx == 0 ? WT_IN : mtx == 1 ? WT_OUT : mtx == 2 ? WT_W1 : WT_W2);
    int K = mtx == 3 ? 4096 : 1024;
    int N = mtx == 0 ? nin : mtx == 2 ? 4096 : 1024;
    int Np = mtx == 0 ? ninp : N;
    transpose_one(W, dst, K, N, Np, (b + (nb / 4) * mtx) % nb, nb, smem);
  }
}

__device__ __forceinline__ void ph_ada(const P& p, int layer, int which, int useInput, int latonly) {
  const int lane = tidx() & 63, wave = tidx() >> 6;
  const float* ng = p.in[(layer ? 32 : 6) + which];
  const float* mod = (const float*)(p.ws + OFF_MOD);
  bf* H = (bf*)(p.ws + OFF_HO);
  for (int R = blockIdx.x * 8 + wave; R < RT; R += gridDim.x * 8) {
    int b = R / TA, a = R - b * TA;
    if (latonly && a < CTX) continue;
    const float* src = useInput ? inrow(p, R) : xrow(p, R);
    float4 v[4];
    float ss = 0.f;
#pragma unroll
    for (int i = 0; i < 4; ++i) {
      v[i] = *(const float4*)(src + i * 256 + lane * 4);
      ss += v[i].x * v[i].x + v[i].y * v[i].y + v[i].z * v[i].z + v[i].w * v[i].w;
    }
    ss = wave_sum(ss);
    float rs = rsqrtf(ss * (1.f / 1024.f) + 1e-6f);
    int mr = a < CTX ? 8 : b;
    const float* sh = mod + (size_t)(layer * 9 + mr) * 6144 + (which * 3 + 0) * 1024;
    const float* scl = mod + (size_t)(layer * 9 + mr) * 6144 + (which * 3 + 1) * 1024;
#pragma unroll
    for (int i = 0; i < 4; ++i) {
      int k = i * 256 + lane * 4;
      float4 g = *(const float4*)(ng + k);
      float4 s4 = *(const float4*)(sh + k);
      float4 c4 = *(const float4*)(scl + k);
      float o0 = v[i].x * rs * g.x * (1.f + c4.x) + s4.x;
      float o1 = v[i].y * rs * g.y * (1.f + c4.y) + s4.y;
      float o2 = v[i].z * rs * g.z * (1.f + c4.z) + s4.z;
      float o3 = v[i].w * rs * g.w * (1.f + c4.w) + s4.w;
      uint2 o;
      o.x = pack2(o0, o1);
      o.y = pack2(o2, o3);
      *(uint2*)(H + (size_t)R * 1024 + k) = o;
    }
  }
}

namespace pg8 {
#define PG8_LAS __attribute__((address_space(3)))
typedef float f32x2 __attribute__((ext_vector_type(2)));
typedef unsigned u32x4 __attribute__((ext_vector_type(4)));
constexpr int BM = 256, BK = 64, HALF = 128, HTB = HALF * BK * 2, STAGE_BYTES = 8 * HTB, NXCD = 8, WGM = 8;
__device__ __forceinline__ int lds_byte(int r, int c) { const int st = (r >> 4) * 2 + (c >> 5), rr = r & 15, cc = c & 31, ob = rr * 64 + cc * 2; return st * 1024 + (ob ^ (((ob >> 9) & 1) << 5)); }
__device__ __forceinline__ void stage_rc(int b, int& R, int& C) { const int st = b / 1024, sb = b % 1024, swz = sb ^ (((sb >> 9) & 1) << 5); R = (st >> 1) * 16 + swz / 64; C = (st & 1) * 32 + (swz % 64) / 2; }
__device__ __forceinline__ int perm32(int rho) { const int n = rho >> 4, i = rho & 15; return 8 * (i >> 2) + 4 * n + (i & 3); }
struct Unit { int pm, pn; };
struct Gemm { const bf* A; const bf* Bt; int K; };
struct Order {
  int nM, nN, nwg, G, c, latonly;
  __device__ void init(int nM_, int nN_, int G_, int c_, int lat) { nM = nM_; nN = nN_; nwg = nM * nN; G = G_; c = c_; latonly = lat; }
  __device__ bool next(int i, Unit& u) const {
    const long L = (long)i * G + c;
    if (L >= nwg) return false;
    int wgid = (int)L;
    { const int q = nwg / NXCD, r = nwg % NXCD, xcd = wgid % NXCD, off = wgid / NXCD; wgid = (xcd < r ? xcd * (q + 1) : r * (q + 1) + (xcd - r) * q) + off; }
    const int nig = WGM * nN, gid = wgid / nig, fm = gid * WGM, gsz = (nM - fm) < WGM ? (nM - fm) : WGM;
    int pm = fm + ((wgid % nig) % gsz);
    u.pn = (wgid % nig) / gsz;
    u.pm = latonly ? ((pm >> 4) * 17 + 1 + (pm & 15)) : pm;
    return true;
  }
};
__device__ __forceinline__ unsigned cvt_pk_bf16(float lo, float hi) { return pack2(lo, hi); }

template <int EPI>
struct Epi {
  static constexpr bool PERM = (EPI == 0 || EPI == 1 || EPI == 3);
  P p;
  int layer;
  __device__ __forceinline__ void operator()(const f32x4 (&acc)[2][2][4][2], const Unit& u, int wr, int wc, int fr, int fq) const {
#pragma unroll
    for (int ai = 0; ai < 2; ++ai)
#pragma unroll
      for (int m = 0; m < 4; ++m) {
        const int row = u.pm * BM + ai * HALF + wr * 64 + m * 16 + fr;
        if constexpr (PERM) {
#pragma unroll
          for (int bj = 0; bj < 2; ++bj) {
            const int c0 = u.pn * BM + bj * HALF + wc * 32 + 8 * fq;
            f32x4 v0 = acc[ai][bj][m][0], v1 = acc[ai][bj][m][1];
            if constexpr (EPI == 3) {
#pragma unroll
              for (int j = 0; j < 4; ++j) { float a = v0[j] > 0.f ? v0[j] : 0.f; v0[j] = a * a; float b2 = v1[j] > 0.f ? v1[j] : 0.f; v1[j] = b2 * b2; }
            }
            u32x4 w;
            w.x = cvt_pk_bf16(v0[0], v0[1]); w.y = cvt_pk_bf16(v0[2], v0[3]); w.z = cvt_pk_bf16(v1[0], v1[1]); w.w = cvt_pk_bf16(v1[2], v1[3]);
            if constexpr (EPI == 0) {
              bf* dst = c0 < 1536 ? (bf*)(p.ws + OFF_QKV) + (size_t)row * 1536 + c0 : (bf*)p.out + (size_t)row * 1792 + (c0 - 1536);
              *(u32x4*)dst = w;
            } else if constexpr (EPI == 1) {
              if (c0 < 512) *(u32x4*)((bf*)(p.ws + OFF_P1C) + (size_t)row * 2080 + c0) = w;
              else if (c0 < 1536) *(u32x4*)((bf*)(p.ws + OFF_XRAW) + (size_t)row * 1024 + (c0 - 512)) = w;
              else if (c0 < 1552) { float* d = (float*)(p.ws + OFF_DTRAW) + (size_t)row * 16 + (c0 - 1536); *(f32x4*)d = v0; *(f32x4*)(d + 4) = v1; }
              else if (c0 < 3104) *(u32x4*)((bf*)(p.ws + OFF_P1C) + (size_t)row * 2080 + (c0 - 1024)) = w;
            } else {
              *(u32x4*)((bf*)(p.ws + OFF_HID) + (size_t)row * 4096 + c0) = w;
            }
          }
        } else {
          const float* gate = (const float*)(p.ws + OFF_MOD) + (size_t)(layer * 9 + mrow(row)) * 6144 + (EPI == 2 ? 2 : 5) * 1024;
          float* xr = xrow(p, row);
          const float* br = (EPI == 2 && layer == 0) ? inrow(p, row) : xr;
#pragma unroll
          for (int bj = 0; bj < 2; ++bj)
#pragma unroll
            for (int n = 0; n < 2; ++n) {
              const int c = u.pn * BM + bj * HALF + wc * 32 + 16 * n + 4 * fq;
              f32x4 gt = *(const f32x4*)(gate + c);
              f32x4 bs = *(const f32x4*)(br + c);
              *(f32x4*)(xr + c) = bs + gt * acc[ai][bj][m][n];
            }
        }
      }
  }
};

template <class EpiT>
__device__ __forceinline__ void gemm_phase(PG8_LAS unsigned char* lds, const Gemm g, const Order& S, const EpiT& E) {
  const int tid = tidx(), wid = __builtin_amdgcn_readfirstlane(tid >> 6), lane = tid & 63, wr = wid >> 2, wc = wid & 3, fr = lane & 15, fq = lane >> 4;
  const int K = g.K, nt = K / BK;
  unsigned voffA[2], voffB[2];
#pragma unroll
  for (int i = 0; i < 2; ++i) { int R, C; stage_rc(tid * 16 + i * 8192, R, C); const int Rb = EpiT::PERM ? ((R & ~31) + perm32(R & 31)) : R;
    voffA[i] = (unsigned)(R * K + C) * 2u; voffB[i] = (unsigned)(Rb * K + C) * 2u; }
  const size_t kstep = (size_t)(BK * 2);
  const size_t hstep = (size_t)HALF * K * 2;
  const size_t tstep = 2 * hstep;
  const unsigned ldsw = (unsigned)wid * 1024u;
  const int aoff = lds_byte(wr * 64 + fr, fq * 8), boff = lds_byte(wc * 32 + fr, fq * 8);
#define PG8_SA(b, h) (((b) * 2 + (h)) * HTB)
#define PG8_SB(b, h) ((4 + (b) * 2 + (h)) * HTB)
#define PG8_STAGE(bufoff, gbase, voff) do { _Pragma("unroll") for (int _i = 0; _i < 2; ++_i) \
        __builtin_amdgcn_global_load_lds((const unsigned*)((const char*)(gbase) + (voff)[_i]), (PG8_LAS unsigned*)(lds + (bufoff) + ldsw + _i * 8192), 16, 0, 0); } while (0)
#define PG8_LDA(dst, b, h) do { _Pragma("unroll") for (int m = 0; m < 4; ++m) _Pragma("unroll") for (int k = 0; k < 2; ++k) dst[m][k] = *(const PG8_LAS bf16x8*)(lds + PG8_SA(b, h) + aoff + m * 2048 + k * 1024); } while (0)
#define PG8_LDB(dst, b, h) do { _Pragma("unroll") for (int n = 0; n < 2; ++n) _Pragma("unroll") for (int k = 0; k < 2; ++k) dst[n][k] = *(const PG8_LAS bf16x8*)(lds + PG8_SB(b, h) + boff + n * 2048 + k * 1024); } while (0)
#define PG8_MMA(ai, bj, At, Bt) do { __builtin_amdgcn_s_setprio(1); _Pragma("unroll") for (int m = 0; m < 4; ++m) _Pragma("unroll") for (int n = 0; n < 2; ++n) _Pragma("unroll") for (int k = 0; k < 2; ++k) \
        acc[ai][bj][m][n] = __builtin_amdgcn_mfma_f32_16x16x32_bf16(Bt[n][k], At[m][k], acc[ai][bj][m][n], 0, 0, 0); __builtin_amdgcn_s_setprio(0); } while (0)
#define PG8_WAIT_V(n) asm volatile("s_waitcnt vmcnt(" #n ")" ::: "memory")
#define PG8_WAIT_L(n) asm volatile("s_waitcnt lgkmcnt(" #n ")" ::: "memory")
#define PG8_BAR __builtin_amdgcn_s_barrier()
#define PG8_SCHED __builtin_amdgcn_sched_barrier(0)
  Unit cur, nxt; int ui = 0;
  if (!S.next(0, cur)) return;
  f32x4 acc[2][2][4][2];
#pragma unroll
  for (int a = 0; a < 2; ++a)
#pragma unroll
    for (int b = 0; b < 2; ++b)
#pragma unroll
      for (int m = 0; m < 4; ++m)
#pragma unroll
        for (int n = 0; n < 2; ++n) acc[a][b][m][n] = (f32x4){0.f, 0.f, 0.f, 0.f};
  bf16x8 At[4][2], B0[2][2], B1[2][2];
  const char* cA = (const char*)g.A + (size_t)cur.pm * tstep; const char* cB = (const char*)g.Bt + (size_t)cur.pn * tstep;
  PG8_STAGE(PG8_SB(0, 0), cB, voffB); PG8_STAGE(PG8_SA(0, 0), cA, voffA); PG8_STAGE(PG8_SB(0, 1), cB + hstep, voffB); PG8_STAGE(PG8_SA(0, 1), cA + hstep, voffA);
  if (wr == 1) PG8_BAR;
  PG8_WAIT_V(4); PG8_BAR;
  PG8_STAGE(PG8_SB(1, 0), cB + kstep, voffB); PG8_STAGE(PG8_SA(1, 0), cA + kstep, voffA); PG8_STAGE(PG8_SB(1, 1), cB + hstep + kstep, voffB);
  PG8_WAIT_V(6); PG8_BAR;
  for (;;) {
    const bool has_next = S.next(ui + 1, nxt);
    const char* nA = has_next ? (const char*)g.A + (size_t)nxt.pm * tstep : cA; const char* nB = has_next ? (const char*)g.Bt + (size_t)nxt.pn * tstep : cB;
    for (int t = 0; t < nt; t += 2) {
      const bool last = (t == nt - 2);
      const char* a1 = cA + (size_t)(t + 1) * kstep;
      const char* a2 = last ? nA : cA + (size_t)(t + 2) * kstep; const char* b2 = last ? nB : cB + (size_t)(t + 2) * kstep;
      const char* a3 = a2 + kstep; const char* b3 = b2 + kstep;
      PG8_LDB(B0, 0, 0); PG8_SCHED; PG8_LDA(At, 0, 0); PG8_STAGE(PG8_SA(1, 1), a1 + hstep, voffA);
      PG8_WAIT_L(8); PG8_BAR; PG8_WAIT_L(0); PG8_MMA(0, 0, At, B0); PG8_BAR; PG8_SCHED;
      PG8_LDB(B1, 0, 1); PG8_STAGE(PG8_SB(0, 0), b2, voffB);
      PG8_BAR; PG8_WAIT_L(0); PG8_MMA(0, 1, At, B1); PG8_BAR;
      PG8_LDA(At, 0, 1); PG8_STAGE(PG8_SA(0, 0), a2, voffA);
      PG8_BAR; PG8_WAIT_L(0); PG8_MMA(1, 0, At, B0); PG8_BAR; PG8_SCHED;
      PG8_STAGE(PG8_SB(0, 1), b2 + hstep, voffB);
      PG8_WAIT_V(6); PG8_BAR; PG8_MMA(1, 1, At, B1); PG8_BAR;
      PG8_LDB(B0, 1, 0); PG8_SCHED; PG8_LDA(At, 1, 0); PG8_STAGE(PG8_SA(0, 1), a2 + hstep, voffA);
      PG8_WAIT_L(8); PG8_BAR; PG8_WAIT_L(0); PG8_MMA(0, 0, At, B0); PG8_BAR; PG8_SCHED;
      PG8_LDB(B1, 1, 1); PG8_STAGE(PG8_SB(1, 0), b3, voffB);
      PG8_BAR; PG8_WAIT_L(0); PG8_MMA(0, 1, At, B1); PG8_BAR;
      PG8_LDA(At, 1, 1); PG8_STAGE(PG8_SA(1, 0), a3, voffA);
      PG8_BAR; PG8_WAIT_L(0); PG8_MMA(1, 0, At, B0); PG8_BAR; PG8_SCHED;
      PG8_STAGE(PG8_SB(1, 1), b3 + hstep, voffB);
      PG8_WAIT_V(6); PG8_BAR; PG8_MMA(1, 1, At, B1); PG8_BAR;
    }
    E(acc, cur, wr, wc, fr, fq);
    if (!has_next) break;
#pragma unroll
    for (int a = 0; a < 2; ++a)
#pragma unroll
      for (int b = 0; b < 2; ++b)
#pragma unroll
        for (int m = 0; m < 4; ++m)
#pragma unroll
          for (int n = 0; n < 2; ++n) acc[a][b][m][n] = (f32x4){0.f, 0.f, 0.f, 0.f};
    cur = nxt; cA = nA; cB = nB; ++ui;
  }
  PG8_WAIT_V(0);
  if (wr == 0) PG8_BAR;
  PG8_BAR;
#undef PG8_SA
#undef PG8_SB
#undef PG8_STAGE
#undef PG8_LDA
#undef PG8_LDB
#undef PG8_MMA
#undef PG8_WAIT_V
#undef PG8_WAIT_L
#undef PG8_BAR
#undef PG8_SCHED
}
}

template <int EPI>
__device__ __forceinline__ void ph_gemm(const P& p, const bf* A, const bf* Bt, int K, int nN, int layer, int latonly, char* smem) {
  pg8::Order S;
  S.init(latonly ? 128 : 136, nN, gridDim.x, blockIdx.x, latonly);
  pg8::Epi<EPI> E{p, layer};
  pg8::Gemm g{A, Bt, K};
  __syncthreads();
  pg8::gemm_phase(( __attribute__((address_space(3))) unsigned char*)smem, g, S, E);
  __syncthreads();
}

__device__ __forceinline__ void ph_rope(const P& p, char* smem) {
  float* tcos = (float*)smem;
  float* tsin = tcos + 1024;
  const int tid = tidx();
  __syncthreads();
  for (int i = tid; i < 1024; i += NT) {
    int c = i >> 4, f = i & 15;
    float inv = powf(10000.f, -(float)f / 16.f);
    float ang = (float)c * inv;
    float sn, cs;
    sincosf(ang, &sn, &cs);
    tcos[i] = cs;
    tsin[i] = sn;
  }
  __syncthreads();
  bf* QKV = (bf*)(p.ws + OFF_QKV);
  for (int it = blockIdx.x * NT + tid; it < RT * 32; it += gridDim.x * NT) {
    int R = it >> 5;
    int vec = (it >> 1) & 15, half = it & 1;
    int b = R / TA, a = R - b * TA;
    bool isq = vec < 8;
    if (!isq && a < CTX) continue;
    bf* ptr = QKV + (size_t)R * 1536 + vec * 64 + half * 32;
    uint4 a0 = *(const uint4*)ptr, a1 = *(const uint4*)(ptr + 8), b0 = *(const uint4*)(ptr + 16), b1 = *(const uint4*)(ptr + 24);
    float x1[16], x2[16];
    x1[0] = bflo(a0.x); x1[1] = bfhi(a0.x); x1[2] = bflo(a0.y); x1[3] = bfhi(a0.y); x1[4] = bflo(a0.z); x1[5] = bfhi(a0.z); x1[6] = bflo(a0.w); x1[7] = bfhi(a0.w);
    x1[8] = bflo(a1.x); x1[9] = bfhi(a1.x); x1[10] = bflo(a1.y); x1[11] = bfhi(a1.y); x1[12] = bflo(a1.z); x1[13] = bfhi(a1.z); x1[14] = bflo(a1.w); x1[15] = bfhi(a1.w);
    x2[0] = bflo(b0.x); x2[1] = bfhi(b0.x); x2[2] = bflo(b0.y); x2[3] = bfhi(b0.y); x2[4] = bflo(b0.z); x2[5] = bfhi(b0.z); x2[6] = bflo(b0.w); x2[7] = bfhi(b0.w);
    x2[8] = bflo(b1.x); x2[9] = bfhi(b1.x); x2[10] = bflo(b1.y); x2[11] = bfhi(b1.y); x2[12] = bflo(b1.z); x2[13] = bfhi(b1.z); x2[14] = bflo(b1.w); x2[15] = bfhi(b1.w);
    const float qs = isq ? 0.125f * 1.4426950408889634f : 1.f;
    if (a >= CTX) {
      int pos = a - CTX;
      int cidx = half == 0 ? (pos >> 6) : (pos & 63);
#pragma unroll
      for (int f = 0; f < 16; ++f) {
        float cs = tcos[cidx * 16 + f], sn = tsin[cidx * 16 + f];
        float y1 = x1[f] * cs - x2[f] * sn, y2 = x2[f] * cs + x1[f] * sn;
        x1[f] = y1 * qs;
        x2[f] = y2 * qs;
      }
    } else {
#pragma unroll
      for (int f = 0; f < 16; ++f) { x1[f] *= qs; x2[f] *= qs; }
    }
    uint4 o;
    o.x = pack2(x1[0], x1[1]); o.y = pack2(x1[2], x1[3]); o.z = pack2(x1[4], x1[5]); o.w = pack2(x1[6], x1[7]); *(uint4*)ptr = o;
    o.x = pack2(x1[8], x1[9]); o.y = pack2(x1[10], x1[11]); o.z = pack2(x1[12], x1[13]); o.w = pack2(x1[14], x1[15]); *(uint4*)(ptr + 8) = o;
    o.x = pack2(x2[0], x2[1]); o.y = pack2(x2[2], x2[3]); o.z = pack2(x2[4], x2[5]); o.w = pack2(x2[6], x2[7]); *(uint4*)(ptr + 16) = o;
    o.x = pack2(x2[8], x2[9]); o.y = pack2(x2[10], x2[11]); o.z = pack2(x2[12], x2[13]); o.w = pack2(x2[14], x2[15]); *(uint4*)(ptr + 24) = o;
  }
}

__device__ __forceinline__ float shiftmix(const bf* PB, const float* mu, int R, int a, int col) {
  int lo = a < CTX ? 0 : CTX, hi = a < CTX ? CTX : TA;
  float t = bf2f(PB[(size_t)R * 1792 + col]);
  float pv = a > lo ? bf2f(PB[(size_t)(R - 1) * 1792 + col]) : 0.f;
  float nx = a + 1 < hi ? bf2f(PB[(size_t)(R + 1) * 1792 + col]) : 0.f;
  return t + (0.5f * (pv + nx) - t) * mu[col];
}
__device__ __forceinline__ void ph_lw(const P& p) {
  bf* LW = (bf*)(p.ws + OFF_LW);
  const float *w2f = p.in[19], *w2b = p.in[21], *a2 = p.in[23], *g2 = p.in[24];
  for (int i = blockIdx.x * NT + tidx(); i < 512 * 320; i += gridDim.x * NT) {
    int n = i / 320, kk = i - n * 320;
    float v = kk < 64 ? w2f[kk * 512 + n] : kk < 128 ? w2b[(kk - 64) * 512 + n] : kk < 192 ? a2[(kk - 128) * 512 + n] : g2[(kk - 192) * 512 + n];
    LW[i] = f2bf(v);
  }
}
__device__ __forceinline__ float shiftmix_l(const bf* PBs, const float muc, int t, int a, int col) {
  const int lo = a < CTX ? 0 : CTX, hi = a < CTX ? CTX : TA;
  const float x = bf2f(PBs[(t + 1) * 1792 + col]);
  const float pv = a > lo ? bf2f(PBs[t * 1792 + col]) : 0.f;
  const float nx = a + 1 < hi ? bf2f(PBs[(t + 2) * 1792 + col]) : 0.f;
  return x + (0.5f * (pv + nx) - x) * muc;
}
__device__ __forceinline__ void ph_rwkv_prep(const P& p, char* smem) {
  bf* linA = (bf*)smem;
  bf* PBs = linA + 16 * 264;
  const int tid = tidx(), lane = tid & 63, wave = tid >> 6;
  const int l15 = lane & 15, g = lane >> 4;
  const bf* PB = (const bf*)p.out;
  const bf* LW = (const bf*)(p.ws + OFF_LW);
  const float* mu = p.in[17];
  bf* PR = (bf*)(p.ws + OFF_PREP);
  bf* PK = PR + (size_t)RT * 512;
  bf* PV = PK + (size_t)RT * 512;
  bf* PKK = PV + (size_t)RT * 512;
  bf* PKA = PKK + (size_t)RT * 512;
  bf* PLF = PKA + (size_t)RT * 512;
  bf* PLB = PLF + (size_t)RT * 512;
  bf* G = (bf*)(p.ws + OFF_G);
  float* BON = (float*)(p.ws + OFF_BONUS);
  float cw0f[4], cw0b[4], ca0[4], ckk[4], cka[4], crk[4], cmr[4], cmk[4], cmv[4];
#pragma unroll
  for (int nt = 0; nt < 4; ++nt) {
    int c = wave * 64 + nt * 16 + l15;
    cw0f[nt] = p.in[18][c]; cw0b[nt] = p.in[20][c]; ca0[nt] = p.in[22][c]; ckk[nt] = p.in[25][c]; cka[nt] = p.in[26][c]; crk[nt] = p.in[27][c];
    cmr[nt] = mu[c]; cmk[nt] = mu[512 + c]; cmv[nt] = mu[1024 + c];
  }
  for (int unit = blockIdx.x; unit < RT / 16; unit += gridDim.x) {
    const int R0 = unit * 16;
    const int b = R0 / TA, a00 = R0 - b * TA;
    __syncthreads();
    for (int ch = tid; ch < 18 * 224; ch += NT) {
      const int rr = ch / 224, cc = ch - rr * 224;
      const int Rg = R0 - 1 + rr;
      uint4 v = make_uint4(0, 0, 0, 0);
      if (Rg >= 0 && Rg < RT) v = *(const uint4*)(PB + (size_t)Rg * 1792 + cc * 8);
      *(uint4*)(PBs + rr * 1792 + cc * 8) = v;
    }
    __syncthreads();
#pragma unroll
    for (int i = 0; i < 8; ++i) {
      int idx = tid + NT * i;
      int tok = idx >> 8, j = idx & 255;
      float f = shiftmix_l(PBs, mu[1536 + j], tok, a00 + tok, 1536 + j);
      float val = j < 64 ? tanhf(f) : (j < 128 ? f : sigmoidf_(f));
      linA[tok * 264 + j] = f2bf(val);
    }
    __syncthreads();
    f32x4 wf[4], wb[4], aa[4], gg[4];
#pragma unroll
    for (int nt = 0; nt < 4; ++nt) {
      wf[nt] = (f32x4){0.f, 0.f, 0.f, 0.f}; wb[nt] = wf[nt]; aa[nt] = wf[nt]; gg[nt] = wf[nt];
    }
#pragma unroll
    for (int nt = 0; nt < 4; ++nt) {
      const bf* lw = LW + (size_t)(wave * 64 + nt * 16 + l15) * 320 + g * 8;
#pragma unroll
      for (int ks = 0; ks < 2; ++ks) {
        bf16x8 aw = *(const bf16x8*)(linA + l15 * 264 + ks * 32 + g * 8);
        wf[nt] = __builtin_amdgcn_mfma_f32_16x16x32_bf16(aw, *(const bf16x8*)(lw + ks * 32), wf[nt], 0, 0, 0);
        wb[nt] = __builtin_amdgcn_mfma_f32_16x16x32_bf16(aw, *(const bf16x8*)(lw + 64 + ks * 32), wb[nt], 0, 0, 0);
        bf16x8 a_a = *(const bf16x8*)(linA + l15 * 264 + 64 + ks * 32 + g * 8);
        aa[nt] = __builtin_amdgcn_mfma_f32_16x16x32_bf16(a_a, *(const bf16x8*)(lw + 128 + ks * 32), aa[nt], 0, 0, 0);
      }
#pragma unroll
      for (int ks = 0; ks < 4; ++ks) {
        bf16x8 ag = *(const bf16x8*)(linA + l15 * 264 + 128 + ks * 32 + g * 8);
        gg[nt] = __builtin_amdgcn_mfma_f32_16x16x32_bf16(ag, *(const bf16x8*)(lw + 192 + ks * 32), gg[nt], 0, 0, 0);
      }
    }
#pragma unroll
    for (int r = 0; r < 4; ++r) {
      const int t = g * 4 + r;
      const int R = R0 + t, a = a00 + t;
      float fr[4], fv[4], kkv[4], km[4], av[4];
      float n2 = 0.f, bon = 0.f;
#pragma unroll
      for (int nt = 0; nt < 4; ++nt) {
        int c = wave * 64 + nt * 16 + l15;
        fr[nt] = shiftmix_l(PBs, cmr[nt], t, a, c);
        float fk = shiftmix_l(PBs, cmk[nt], t, a, 512 + c);
        fv[nt] = shiftmix_l(PBs, cmv[nt], t, a, 1024 + c);
        av[nt] = sigmoidf_(ca0[nt] + aa[nt][r]);
        kkv[nt] = fk * ckk[nt];
        n2 += kkv[nt] * kkv[nt];
        km[nt] = fk * (1.f + (av[nt] - 1.f) * cka[nt]);
        bon += fr[nt] * km[nt] * crk[nt];
      }
      n2 = red16(n2);
      bon = red16(bon);
      float rn = 1.f / fmaxf(sqrtf(n2), 1e-12f);
#pragma unroll
      for (int nt = 0; nt < 4; ++nt) {
        int c = wave * 64 + nt * 16 + l15;
        size_t o = (size_t)R * 512 + c;
        float lwf = -__expf(-softplusf_(-(cw0f[nt] + wf[nt][r])) - 0.5f);
        float lwb = -__expf(-softplusf_(-(cw0b[nt] + wb[nt][r])) - 0.5f);
        float kk = kkv[nt] * rn;
        PR[o] = f2bf(fr[nt]);
        PK[o] = f2bf(km[nt]);
        PV[o] = f2bf(fv[nt]);
        PKK[o] = f2bf(kk);
        PKA[o] = f2bf(kk * av[nt]);
        PLF[o] = f2bf(lwf);
        PLB[o] = f2bf(lwb);
        G[o] = f2bf(gg[nt][r]);
      }
      if (l15 == 0) BON[(size_t)R * 8 + wave] = bon;
    }
  }
}

__device__ __forceinline__ int scan_row(int b, int dir, int s) {
  int a = dir ? (s < CTX ? CTX - 1 - s : TA + CTX - 1 - s) : s;
  return b * TA + a;
}

__device__ __forceinline__ void rwkv_chain(const P& p, int chain, int half, char* smem) {
  const int dir = chain & 1, h = (chain >> 1) & 7, b = chain >> 4;
  float* cR = (float*)smem;
  float* cW = cR + 2048;
  float* cK = cW + 2048;
  float* cKK = cK + 2048;
  float* cKA = cKK + 2048;
  float* cV = cKA + 2048;
  float* yb = cV + 2048;
  const int tid = tidx(), lane = tid & 63, wave = tid >> 6;
  const int l15 = lane & 15, lg = lane >> 4;
  const bf* PR = (const bf*)(p.ws + OFF_PREP);
  const bf* PK = PR + (size_t)RT * 512;
  const bf* PV = PK + (size_t)RT * 512;
  const bf* PKK = PV + (size_t)RT * 512;
  const bf* PKA = PKK + (size_t)RT * 512;
  const bf* PLW = PKA + (size_t)RT * 512 + (size_t)dir * RT * 512;
  bf* Y = (bf*)p.out + (size_t)dir * RT * 512;
  const int st = tid >> 4, c4 = (tid & 15) * 4;
  const int r0 = half < 0 ? wave * 8 + lg * 2 : half * 32 + (wave & 3) * 8 + lg * 2;
  const bool active = half < 0 || wave < 4;
  const bool ywr = half < 0 || ((c4 >> 5) == half);
  float s0[4], s1[4];
#pragma unroll
  for (int j = 0; j < 4; ++j) { s0[j] = 0.f; s1[j] = 0.f; }
  uint2 gR, gW, gK, gV, gKK, gKA;
  {
    size_t o = (size_t)scan_row(b, dir, st) * 512 + h * 64 + c4;
    gR = *(const uint2*)(PR + o); gW = *(const uint2*)(PLW + o); gK = *(const uint2*)(PK + o);
    gV = *(const uint2*)(PV + o); gKK = *(const uint2*)(PKK + o); gKA = *(const uint2*)(PKA + o);
  }
  const int NCH = TA / 32;
  for (int ch = 0; ch <= NCH; ++ch) {
    __syncthreads();
    if (ch > 0 && ywr) {
      float4 y4 = *(const float4*)(yb + st * 64 + c4);
      uint2 o2;
      o2.x = pack2(y4.x, y4.y);
      o2.y = pack2(y4.z, y4.w);
      *(uint2*)(Y + (size_t)scan_row(b, dir, (ch - 1) * 32 + st) * 512 + h * 64 + c4) = o2;
    }
    if (ch == NCH) break;
    {
      int o = st * 64 + c4;
      *(float4*)(cR + o) = make_float4(bflo(gR.x), bfhi(gR.x), bflo(gR.y), bfhi(gR.y));
      *(float4*)(cW + o) = make_float4(__expf(bflo(gW.x)), __expf(bfhi(gW.x)), __expf(bflo(gW.y)), __expf(bfhi(gW.y)));
      *(float4*)(cK + o) = make_float4(bflo(gK.x), bfhi(gK.x), bflo(gK.y), bfhi(gK.y));
      *(float4*)(cV + o) = make_float4(bflo(gV.x), bfhi(gV.x), bflo(gV.y), bfhi(gV.y));
      *(float4*)(cKK + o) = make_float4(bflo(gKK.x), bfhi(gKK.x), bflo(gKK.y), bfhi(gKK.y));
      *(float4*)(cKA + o) = make_float4(bflo(gKA.x), bfhi(gKA.x), bflo(gKA.y), bfhi(gKA.y));
    }
    __syncthreads();
    if (ch + 1 < NCH) {
      size_t o = (size_t)scan_row(b, dir, (ch + 1) * 32 + st) * 512 + h * 64 + c4;
      gR = *(const uint2*)(PR + o); gW = *(const uint2*)(PLW + o); gK = *(const uint2*)(PK + o);
      gV = *(const uint2*)(PV + o); gKK = *(const uint2*)(PKK + o); gKA = *(const uint2*)(PKA + o);
    }
    if (active) {
      float4 kk4 = *(const float4*)(cKK + l15 * 4);
      float4 w4 = *(const float4*)(cW + l15 * 4);
      float4 k4 = *(const float4*)(cK + l15 * 4);
      float4 ka4 = *(const float4*)(cKA + l15 * 4);
      float4 r4 = *(const float4*)(cR + l15 * 4);
      float2 v2 = *(const float2*)(cV + r0);
#pragma unroll 2
      for (int t = 0; t < 32; ++t) {
        const int tn = (t + 1) & 31;
        float4 nkk4 = *(const float4*)(cKK + tn * 64 + l15 * 4);
        float4 nw4 = *(const float4*)(cW + tn * 64 + l15 * 4);
        float4 nk4 = *(const float4*)(cK + tn * 64 + l15 * 4);
        float4 nka4 = *(const float4*)(cKA + tn * 64 + l15 * 4);
        float4 nr4 = *(const float4*)(cR + tn * 64 + l15 * 4);
        float2 nv2 = *(const float2*)(cV + tn * 64 + r0);
        float sa0 = (s0[0] * kk4.x + s0[1] * kk4.y) + (s0[2] * kk4.z + s0[3] * kk4.w);
        float sa1 = (s1[0] * kk4.x + s1[1] * kk4.y) + (s1[2] * kk4.z + s1[3] * kk4.w);
        float p00 = s0[0] * w4.x + v2.x * k4.x, p01 = s0[1] * w4.y + v2.x * k4.y, p02 = s0[2] * w4.z + v2.x * k4.z, p03 = s0[3] * w4.w + v2.x * k4.w;
        float p10 = s1[0] * w4.x + v2.y * k4.x, p11 = s1[1] * w4.y + v2.y * k4.y, p12 = s1[2] * w4.z + v2.y * k4.z, p13 = s1[3] * w4.w + v2.y * k4.w;
        sa0 = red16(sa0);
        sa1 = red16(sa1);
        s0[0] = p00 - sa0 * ka4.x; s0[1] = p01 - sa0 * ka4.y; s0[2] = p02 - sa0 * ka4.z; s0[3] = p03 - sa0 * ka4.w;
        s1[0] = p10 - sa1 * ka4.x; s1[1] = p11 - sa1 * ka4.y; s1[2] = p12 - sa1 * ka4.z; s1[3] = p13 - sa1 * ka4.w;
        float y0 = (s0[0] * r4.x + s0[1] * r4.y) + (s0[2] * r4.z + s0[3] * r4.w);
        float y1 = (s1[0] * r4.x + s1[1] * r4.y) + (s1[2] * r4.z + s1[3] * r4.w);
        y0 = red16(y0);
        y1 = red16(y1);
        if (l15 == 0) *(float2*)(yb + t * 64 + r0) = make_float2(y0, y1);
        kk4 = nkk4; w4 = nw4; k4 = nk4; ka4 = nka4; r4 = nr4; v2 = nv2;
      }
    }
  }
}


typedef short s16x4_g __attribute__((ext_vector_type(4)));
template <int OFFB>
__device__ __forceinline__ bf16x8 tr_pair(const bf* pp) {
  typedef short s16x4_ __attribute__((ext_vector_type(4)));
  s16x4_ v0, v1;
  unsigned addr = (unsigned)(size_t)(__attribute__((address_space(3))) const void*)pp;
  asm volatile("s_waitcnt lgkmcnt(0)\n\tds_read_b64_tr_b16 %0, %2\n\tds_read_b64_tr_b16 %1, %2 offset:%3\n\ts_waitcnt lgkmcnt(0)" : "=&v"(v0), "=&v"(v1) : "v"(addr), "n"(OFFB) : "memory");
  return __builtin_shufflevector(v0, v1, 0, 1, 2, 3, 4, 5, 6, 7);
}
template <int STRB, int OFF2B>
__device__ __forceinline__ void tr_quad(const bf* pp, bf16x8& f0, bf16x8& f1, bf16x8& f2, bf16x8& f3) {
  typedef short s16x4_ __attribute__((ext_vector_type(4)));
  s16x4_ a0, b0, a1, b1, a2, b2, a3, b3;
  unsigned addr = (unsigned)(size_t)(__attribute__((address_space(3))) const void*)pp;
  asm volatile(
      "s_waitcnt lgkmcnt(0)\n\t"
      "ds_read_b64_tr_b16 %0, %8\n\t"
      "ds_read_b64_tr_b16 %1, %8 offset:%9\n\t"
      "ds_read_b64_tr_b16 %2, %8 offset:%10\n\t"
      "ds_read_b64_tr_b16 %3, %8 offset:%11\n\t"
      "ds_read_b64_tr_b16 %4, %8 offset:%12\n\t"
      "ds_read_b64_tr_b16 %5, %8 offset:%13\n\t"
      "ds_read_b64_tr_b16 %6, %8 offset:%14\n\t"
      "ds_read_b64_tr_b16 %7, %8 offset:%15\n\t"
      "s_waitcnt lgkmcnt(0)"
      : "=&v"(a0), "=&v"(b0), "=&v"(a1), "=&v"(b1), "=&v"(a2), "=&v"(b2), "=&v"(a3), "=&v"(b3)
      : "v"(addr), "n"(OFF2B), "n"(STRB), "n"(STRB + OFF2B), "n"(2 * STRB), "n"(2 * STRB + OFF2B), "n"(3 * STRB), "n"(3 * STRB + OFF2B)
      : "memory");
  f0 = __builtin_shufflevector(a0, b0, 0, 1, 2, 3, 4, 5, 6, 7);
  f1 = __builtin_shufflevector(a1, b1, 0, 1, 2, 3, 4, 5, 6, 7);
  f2 = __builtin_shufflevector(a2, b2, 0, 1, 2, 3, 4, 5, 6, 7);
  f3 = __builtin_shufflevector(a3, b3, 0, 1, 2, 3, 4, 5, 6, 7);
}
struct TrQ { s16x4_g a0, b0, a1, b1, a2, b2, a3, b3; };
template <int STRB, int OFF2B>
__device__ __forceinline__ void tr8_issue(const bf* pp, TrQ& q) {
  unsigned addr = (unsigned)(size_t)(__attribute__((address_space(3))) const void*)pp;
  asm volatile(
      "ds_read_b64_tr_b16 %0, %8\n\t"
      "ds_read_b64_tr_b16 %1, %8 offset:%9\n\t"
      "ds_read_b64_tr_b16 %2, %8 offset:%10\n\t"
      "ds_read_b64_tr_b16 %3, %8 offset:%11\n\t"
      "ds_read_b64_tr_b16 %4, %8 offset:%12\n\t"
      "ds_read_b64_tr_b16 %5, %8 offset:%13\n\t"
      "ds_read_b64_tr_b16 %6, %8 offset:%14\n\t"
      "ds_read_b64_tr_b16 %7, %8 offset:%15"
      : "=&v"(q.a0), "=&v"(q.b0), "=&v"(q.a1), "=&v"(q.b1), "=&v"(q.a2), "=&v"(q.b2), "=&v"(q.a3), "=&v"(q.b3)
      : "v"(addr), "n"(OFF2B), "n"(STRB), "n"(STRB + OFF2B), "n"(2 * STRB), "n"(2 * STRB + OFF2B), "n"(3 * STRB), "n"(3 * STRB + OFF2B)
      : "memory");
}
__device__ __forceinline__ void tr8_wait(TrQ& q, bf16x8& f0, bf16x8& f1, bf16x8& f2, bf16x8& f3) {
  asm volatile("s_waitcnt lgkmcnt(0)"
               : "+v"(q.a0), "+v"(q.b0), "+v"(q.a1), "+v"(q.b1), "+v"(q.a2), "+v"(q.b2), "+v"(q.a3), "+v"(q.b3)
               :
               : "memory");
  f0 = __builtin_shufflevector(q.a0, q.b0, 0, 1, 2, 3, 4, 5, 6, 7);
  f1 = __builtin_shufflevector(q.a1, q.b1, 0, 1, 2, 3, 4, 5, 6, 7);
  f2 = __builtin_shufflevector(q.a2, q.b2, 0, 1, 2, 3, 4, 5, 6, 7);
  f3 = __builtin_shufflevector(q.a3, q.b3, 0, 1, 2, 3, 4, 5, 6, 7);
}
template <int STRB, int OFF2B>
__device__ __forceinline__ void tr_dual(const bf* pp, bf16x8& f0, bf16x8& f1) {
  typedef short s16x4_ __attribute__((ext_vector_type(4)));
  s16x4_ a0, b0, a1, b1;
  unsigned addr = (unsigned)(size_t)(__attribute__((address_space(3))) const void*)pp;
  asm volatile(
      "s_waitcnt lgkmcnt(0)\n\t"
      "ds_read_b64_tr_b16 %0, %4\n\t"
      "ds_read_b64_tr_b16 %1, %4 offset:%5\n\t"
      "ds_read_b64_tr_b16 %2, %4 offset:%6\n\t"
      "ds_read_b64_tr_b16 %3, %4 offset:%7\n\t"
      "s_waitcnt lgkmcnt(0)"
      : "=&v"(a0), "=&v"(b0), "=&v"(a1), "=&v"(b1)
      : "v"(addr), "n"(OFF2B), "n"(STRB), "n"(STRB + OFF2B)
      : "memory");
  f0 = __builtin_shufflevector(a0, b0, 0, 1, 2, 3, 4, 5, 6, 7);
  f1 = __builtin_shufflevector(a1, b1, 0, 1, 2, 3, 4, 5, 6, 7);
}
__device__ __forceinline__ const bf* trbase(const bf* img, int ld, int r0, int c0, int lane) { return img + (r0 + ((lane & 15) >> 2)) * ld + c0 + (lane & 3) * 4; }
typedef short s16x4 __attribute__((ext_vector_type(4)));
__device__ __forceinline__ void attn_unit(const P& p, int u, char* smem, float lam) {
  bf* Ks = (bf*)smem;
  bf* Vs = Ks + 64 * 136;
  int b, h, nkeys, qa0;
  if (u < 1024) { b = u >> 7; h = (u >> 5) & 3; nkeys = TA; qa0 = CTX + (u & 31) * 128; }
  else { int v = u - 1024; b = v >> 3; h = (v >> 1) & 3; nkeys = CTX; qa0 = (v & 1) * 128; }
  const bf* QKV = (const bf*)(p.ws + OFF_QKV);
  const int tid = tidx(), lane = tid & 63, wave = tid >> 6;
  const int l15 = lane & 15, lg = lane >> 4;
  const size_t rowbase = (size_t)b * TA;
  bf16x8 qf[2][2];
  {
    size_t Rq = rowbase + qa0 + wave * 16 + l15;
#pragma unroll
    for (int m = 0; m < 2; ++m)
#pragma unroll
      for (int ks = 0; ks < 2; ++ks) qf[m][ks] = *(const bf16x8*)(QKV + Rq * 1536 + h * 128 + m * 64 + ks * 32 + lg * 8);
  }
  f32x4 oacc[2][8];
#pragma unroll
  for (int m = 0; m < 2; ++m)
#pragma unroll
    for (int n = 0; n < 8; ++n) oacc[m][n] = (f32x4){0.f, 0.f, 0.f, 0.f};
  float mrun[2] = {0.f, 0.f}, lrun[2] = {0.f, 0.f};
  const int sr = tid >> 4, scc = tid & 15;
  const bf* gsrc = QKV + (rowbase + sr) * 1536 + h * 128 + scc * 8;
  uint4 pk0 = *(const uint4*)(gsrc + 512), pv0 = *(const uint4*)(gsrc + 1024);
  uint4 pk1 = *(const uint4*)(gsrc + (size_t)32 * 1536 + 512), pv1 = *(const uint4*)(gsrc + (size_t)32 * 1536 + 1024);
  const int vrow = lg * 4 + (l15 >> 2), vcol = (lane & 3) * 4;
  for (int k0 = 0; k0 < nkeys; k0 += 64) {
    __syncthreads();
    *(uint4*)(Ks + sr * 136 + scc * 8) = pk0;
    *(uint4*)(Ks + (sr + 32) * 136 + scc * 8) = pk1;
    *(uint4*)(Vs + sr * 144 + scc * 8) = pv0;
    *(uint4*)(Vs + (sr + 32) * 144 + scc * 8) = pv1;
    __syncthreads();
    if (k0 + 64 < nkeys) {
      const bf* g2 = gsrc + (size_t)(k0 + 64) * 1536;
      pk0 = *(const uint4*)(g2 + 512); pv0 = *(const uint4*)(g2 + 1024);
      pk1 = *(const uint4*)(g2 + (size_t)32 * 1536 + 512); pv1 = *(const uint4*)(g2 + (size_t)32 * 1536 + 1024);
    }
    bf16x8 pf[2][2];
#pragma unroll
    for (int m = 0; m < 2; ++m) {
      f32x4 s[4];
      const float nm = -mrun[m];
#pragma unroll
      for (int kt = 0; kt < 4; ++kt) s[kt] = (f32x4){nm, nm, nm, nm};
#pragma unroll
      for (int ks = 0; ks < 2; ++ks)
#pragma unroll
        for (int kt = 0; kt < 4; ++kt) {
          bf16x8 a = *(const bf16x8*)(Ks + (kt * 16 + l15) * 136 + m * 64 + ks * 32 + lg * 8);
          s[kt] = __builtin_amdgcn_mfma_f32_16x16x32_bf16(a, qf[m][ks], s[kt], 0, 0, 0);
        }
      float mx = fmaxf(fmaxf(s[0][0], s[0][1]), fmaxf(s[0][2], s[0][3]));
#pragma unroll
      for (int kt = 1; kt < 4; ++kt) mx = fmaxf(mx, fmaxf(fmaxf(s[kt][0], s[kt][1]), fmaxf(s[kt][2], s[kt][3])));
      if (k0 == 0 || __any(mx > 11.f)) {
        mx = fmaxf(mx, __shfl_xor(mx, 16));
        mx = fmaxf(mx, __shfl_xor(mx, 32));
        const float d = (k0 == 0) ? mx : fmaxf(mx, 0.f);
        const float alpha = (k0 == 0) ? 1.f : __builtin_amdgcn_exp2f(-d);
        mrun[m] += d;
        lrun[m] *= alpha;
        float al[4];
#pragma unroll
        for (int r = 0; r < 4; ++r) al[r] = __shfl(alpha, lg * 4 + r);
#pragma unroll
        for (int n = 0; n < 8; ++n)
#pragma unroll
          for (int r = 0; r < 4; ++r) oacc[m][n][r] *= al[r];
#pragma unroll
        for (int kt = 0; kt < 4; ++kt)
#pragma unroll
          for (int r = 0; r < 4; ++r) s[kt][r] -= d;
      }
      float ps = 0.f;
#pragma unroll
      for (int kt = 0; kt < 4; ++kt)
#pragma unroll
        for (int r = 0; r < 4; ++r) {
          float e = __builtin_amdgcn_exp2f(s[kt][r]);
          s[kt][r] = e;
          ps += e;
        }
      lrun[m] += ps;
#pragma unroll
      for (int si = 0; si < 2; ++si) {
        i32x4 t;
        t[0] = (int)pack2(s[2 * si][0], s[2 * si][1]);
        t[1] = (int)pack2(s[2 * si][2], s[2 * si][3]);
        t[2] = (int)pack2(s[2 * si + 1][0], s[2 * si + 1][1]);
        t[3] = (int)pack2(s[2 * si + 1][2], s[2 * si + 1][3]);
        pf[m][si] = __builtin_bit_cast(bf16x8, t);
      }
    }
    {
      TrQ qa, qb;
      bf16x8 bv[4];
      tr8_issue<32, 16 * 144 * 2>(Vs + (0 * 32 + vrow) * 144 + 0 * 64 + vcol, qa);
      tr8_wait(qa, bv[0], bv[1], bv[2], bv[3]);
      tr8_issue<32, 16 * 144 * 2>(Vs + (0 * 32 + vrow) * 144 + 1 * 64 + vcol, qb);
      __builtin_amdgcn_s_setprio(1);
#pragma unroll
      for (int n4 = 0; n4 < 4; ++n4) {
        oacc[0][n4] = __builtin_amdgcn_mfma_f32_16x16x32_bf16(pf[0][0], bv[n4], oacc[0][n4], 0, 0, 0);
        oacc[1][n4] = __builtin_amdgcn_mfma_f32_16x16x32_bf16(pf[1][0], bv[n4], oacc[1][n4], 0, 0, 0);
      }
      __builtin_amdgcn_s_setprio(0);
      tr8_wait(qb, bv[0], bv[1], bv[2], bv[3]);
      tr8_issue<32, 16 * 144 * 2>(Vs + (1 * 32 + vrow) * 144 + 0 * 64 + vcol, qa);
      __builtin_amdgcn_s_setprio(1);
#pragma unroll
      for (int n4 = 0; n4 < 4; ++n4) {
        oacc[0][4 + n4] = __builtin_amdgcn_mfma_f32_16x16x32_bf16(pf[0][0], bv[n4], oacc[0][4 + n4], 0, 0, 0);
        oacc[1][4 + n4] = __builtin_amdgcn_mfma_f32_16x16x32_bf16(pf[1][0], bv[n4], oacc[1][4 + n4], 0, 0, 0);
      }
      __builtin_amdgcn_s_setprio(0);
      tr8_wait(qa, bv[0], bv[1], bv[2], bv[3]);
      tr8_issue<32, 16 * 144 * 2>(Vs + (1 * 32 + vrow) * 144 + 1 * 64 + vcol, qb);
      __builtin_amdgcn_s_setprio(1);
#pragma unroll
      for (int n4 = 0; n4 < 4; ++n4) {
        oacc[0][n4] = __builtin_amdgcn_mfma_f32_16x16x32_bf16(pf[0][1], bv[n4], oacc[0][n4], 0, 0, 0);
        oacc[1][n4] = __builtin_amdgcn_mfma_f32_16x16x32_bf16(pf[1][1], bv[n4], oacc[1][n4], 0, 0, 0);
      }
      __builtin_amdgcn_s_setprio(0);
      tr8_wait(qb, bv[0], bv[1], bv[2], bv[3]);
      __builtin_amdgcn_s_setprio(1);
#pragma unroll
      for (int n4 = 0; n4 < 4; ++n4) {
        oacc[0][4 + n4] = __builtin_amdgcn_mfma_f32_16x16x32_bf16(pf[0][1], bv[n4], oacc[0][4 + n4], 0, 0, 0);
        oacc[1][4 + n4] = __builtin_amdgcn_mfma_f32_16x16x32_bf16(pf[1][1], bv[n4], oacc[1][4 + n4], 0, 0, 0);
      }
      __builtin_amdgcn_s_setprio(0);
    }
  }
  float inv[2];
#pragma unroll
  for (int m = 0; m < 2; ++m) {
    float l = lrun[m];
    l += __shfl_xor(l, 16);
    l += __shfl_xor(l, 32);
    inv[m] = 1.f / l;
  }
  float i1[4], i2[4];
#pragma unroll
  for (int r = 0; r < 4; ++r) { i1[r] = __shfl(inv[0], lg * 4 + r); i2[r] = __shfl(inv[1], lg * 4 + r); }
  float ss[4] = {0.f, 0.f, 0.f, 0.f};
#pragma unroll
  for (int n = 0; n < 8; ++n)
#pragma unroll
    for (int r = 0; r < 4; ++r) {
      float o = oacc[0][n][r] * i1[r] - lam * (oacc[1][n][r] * i2[r]);
      oacc[0][n][r] = o;
      ss[r] += o * o;
    }
  const float* subln = p.in[16];
  bf* O = (bf*)(p.ws + OFF_HO);
#pragma unroll
  for (int r = 0; r < 4; ++r) {
    float t = red16(ss[r]);
    float scl = rsqrtf(t * (1.f / 128.f) + 1e-5f) * 0.8f;
    size_t Ro = rowbase + qa0 + wave * 16 + lg * 4 + r;
#pragma unroll
    for (int n = 0; n < 8; ++n) O[Ro * 1024 + h * 128 + n * 16 + l15] = f2bf(oacc[0][n][r] * scl * subln[n * 16 + l15]);
  }
}

__device__ __forceinline__ void rwkv_chain2(const P& p, int chain, char* smem);
__device__ __forceinline__ void ph_mix0(const P& p, char* smem) {
  volatile int* s_unitp = (volatile int*)(smem + 131072);
  for (int u = blockIdx.x; u < 128; u += gridDim.x) rwkv_chain2(p, u, smem);
#ifdef PROBE_RWKV
  __syncthreads();
  for (int u = blockIdx.x; u < 256; u += gridDim.x) rwkv_chain(p, u & 127, u >> 7, smem);
#endif
  float d1 = 0.f, d2 = 0.f;
  for (int i = 0; i < 64; ++i) { d1 += p.in[12][i] * p.in[13][i]; d2 += p.in[14][i] * p.in[15][i]; }
  float lam = expf(d1) - expf(d2) + 0.2f;
  int* cnt = (int*)(p.ws + OFF_CNT);
  while (true) {
    __syncthreads();
    if (tidx() == 0) *s_unitp = atomicAdd(cnt, 1);
    __syncthreads();
    int u = *s_unitp;
    if (u >= 1088) break;
    attn_unit(p, u, smem, lam);
  }
#ifdef PROBE_ATTN
  while (true) {
    __syncthreads();
    if (tidx() == 0) *s_unitp = atomicAdd(cnt + 1, 1);
    __syncthreads();
    int u = *s_unitp;
    if (u >= 1088) break;
    attn_unit(p, u, smem, lam);
  }
#endif
}

__device__ __forceinline__ void ph_rwkv_post(const P& p) {
  const int tid = tidx(), wave = tid >> 6;
  const bf* YF = (const bf*)p.out;
  const bf* YB = YF + (size_t)RT * 512;
  const bf* PV = (const bf*)(p.ws + OFF_PREP) + (size_t)2 * RT * 512;
  const bf* G = (const bf*)(p.ws + OFF_G);
  const float* BON = (const float*)(p.ws + OFF_BONUS);
  bf* O = (bf*)(p.ws + OFF_HO);
  const float lw = p.in[28][tid], lb = p.in[29][tid];
  for (int R0 = blockIdx.x * 4; R0 < RT; R0 += gridDim.x * 4) {
    float yf[4], yb4[4], pv[4], gg[4], bn[4];
#pragma unroll
    for (int i = 0; i < 4; ++i) {
      size_t o = (size_t)(R0 + i) * 512 + tid;
      yf[i] = bf2f(YF[o]); yb4[i] = bf2f(YB[o]); pv[i] = bf2f(PV[o]); gg[i] = bf2f(G[o]); bn[i] = BON[(size_t)(R0 + i) * 8 + wave];
    }
#pragma unroll
    for (int i = 0; i < 4; ++i) {
      float y = yf[i] + yb4[i];
      float mean = wave_sum(y) * (1.f / 64.f);
      float d = y - mean;
      float var = wave_sum(d * d) * (1.f / 64.f);
      float yn = d * rsqrtf(var + 64e-5f) * lw + lb;
      float outv = (yn + bn[i] * pv[i]) * gg[i];
      O[(size_t)(R0 + i) * 1024 + 512 + tid] = f2bf(outv);
    }
  }
}

__device__ __forceinline__ void ph_gla_gates(const P& p, char* smem) {
  float* up = (float*)smem;
  float* gbv = up + 2 * 16 * 256;
  const int tid = tidx();
  __syncthreads();
  for (int i = tid; i < 2 * 16 * 256; i += NT) up[i] = p.in[i < 4096 ? 46 : 48][i & 4095];
  for (int i = tid; i < 512; i += NT) gbv[i] = p.in[i < 256 ? 47 : 49][i & 255];
  __syncthreads();
  const bf* P1 = (const bf*)(p.ws + OFF_P1C);
  bf* LG = (bf*)(p.ws + OFF_HO);
  for (int it = blockIdx.x * NT + tid; it < RT * 32; it += gridDim.x * NT) {
    const int R = it >> 5, c8 = (it & 31) * 8;
    const uint4 g0 = *(const uint4*)(P1 + (size_t)R * 2080 + 2064), g1 = *(const uint4*)(P1 + (size_t)R * 2080 + 2072);
    float gd[16];
    gd[0] = bflo(g0.x); gd[1] = bfhi(g0.x); gd[2] = bflo(g0.y); gd[3] = bfhi(g0.y); gd[4] = bflo(g0.z); gd[5] = bfhi(g0.z); gd[6] = bflo(g0.w); gd[7] = bfhi(g0.w);
    gd[8] = bflo(g1.x); gd[9] = bfhi(g1.x); gd[10] = bflo(g1.y); gd[11] = bfhi(g1.y); gd[12] = bflo(g1.z); gd[13] = bfhi(g1.z); gd[14] = bflo(g1.w); gd[15] = bfhi(g1.w);
#pragma unroll
    for (int d = 0; d < 2; ++d) {
      float z[8];
#pragma unroll
      for (int e = 0; e < 8; ++e) z[e] = gbv[d * 256 + c8 + e];
#pragma unroll
      for (int r = 0; r < 16; ++r) {
        const float4 u0 = *(const float4*)(up + (d * 16 + r) * 256 + c8), u1 = *(const float4*)(up + (d * 16 + r) * 256 + c8 + 4);
        z[0] += gd[r] * u0.x; z[1] += gd[r] * u0.y; z[2] += gd[r] * u0.z; z[3] += gd[r] * u0.w;
        z[4] += gd[r] * u1.x; z[5] += gd[r] * u1.y; z[6] += gd[r] * u1.z; z[7] += gd[r] * u1.w;
      }
      uint4 o;
      o.x = pack2(-softplusf_(-z[0]) * (1.f / 16.f), -softplusf_(-z[1]) * (1.f / 16.f));
      o.y = pack2(-softplusf_(-z[2]) * (1.f / 16.f), -softplusf_(-z[3]) * (1.f / 16.f));
      o.z = pack2(-softplusf_(-z[4]) * (1.f / 16.f), -softplusf_(-z[5]) * (1.f / 16.f));
      o.w = pack2(-softplusf_(-z[6]) * (1.f / 16.f), -softplusf_(-z[7]) * (1.f / 16.f));
      *(uint4*)(LG + ((size_t)d * RT + R) * 256 + c8) = o;
    }
  }
}

__device__ __forceinline__ void ph_conv(const P& p) {
  const bf* XR = (const bf*)(p.ws + OFF_XRAW);
  bf* XO = (bf*)(p.ws + OFF_XBC);
  const float* cw = p.in[38];
  const float* cb = p.in[39];
  for (size_t it = (size_t)blockIdx.x * NT + tidx(); it < (size_t)RT * 128; it += (size_t)gridDim.x * NT) {
    int R = (int)(it >> 7), c8 = (int)(it & 127) * 8;
    int b = R / TA, a = R - b * TA;
    int lo = a < CTX ? 0 : CTX, hi = a < CTX ? CTX : TA;
    float acc[8];
#pragma unroll
    for (int e = 0; e < 8; ++e) acc[e] = cb[c8 + e];
#pragma unroll
    for (int j = 0; j < 5; ++j) {
      int aj = a + j - 2;
      if (aj >= lo && aj < hi) {
        uint4 v = *(const uint4*)(XR + (size_t)(R + j - 2) * 1024 + c8);
        const float* w = cw + j * 1024 + c8;
        acc[0] += w[0] * bflo(v.x); acc[1] += w[1] * bfhi(v.x);
        acc[2] += w[2] * bflo(v.y); acc[3] += w[3] * bfhi(v.y);
        acc[4] += w[4] * bflo(v.z); acc[5] += w[5] * bfhi(v.z);
        acc[6] += w[6] * bflo(v.w); acc[7] += w[7] * bfhi(v.w);
      }
    }
    uint4 o;
    o.x = pack2(siluf_(acc[0]), siluf_(acc[1]));
    o.y = pack2(siluf_(acc[2]), siluf_(acc[3]));
    o.z = pack2(siluf_(acc[4]), siluf_(acc[5]));
    o.w = pack2(siluf_(acc[6]), siluf_(acc[7]));
    *(uint4*)(XO + (size_t)R * 1024 + c8) = o;
  }
}

__device__ __forceinline__ void ssd_chain(const P& p, int chain, char* smem) {
  const int dir = chain & 1, hh = (chain >> 1) & 7, b = chain >> 4;
  const int grp = hh >> 2;
  float* cB = (float*)smem;
  float* cC = cB + 4096;
  float* cX = cC + 4096;
  float* cDA = cX + 2048;
  float* yb = cDA + 32;
  const int tid = tidx(), lane = tid & 63, wave = tid >> 6;
  const int l15 = lane & 15, lg = lane >> 4;
  const bf* XBC = (const bf*)(p.ws + OFF_XBC);
  const float* DTR = (const float*)(p.ws + OFF_DTRAW);
  bf* Y = (bf*)(p.ws + OFF_XRAW) + (size_t)dir * RT * 512;
  const float dtb = p.in[dir ? 42 : 40][hh];
  const float Aneg = -expf(p.in[dir ? 43 : 41][hh]);
  const int st = tid >> 4, q = tid & 15;
  const int r0 = wave * 8 + lg * 2;
  float s0[8], s1[8];
#pragma unroll
  for (int j = 0; j < 8; ++j) { s0[j] = 0.f; s1[j] = 0.f; }
  uint4 gB, gC;
  uint2 gX;
  float gD;
  {
    size_t R = (size_t)scan_row(b, dir, st);
    gB = *(const uint4*)(XBC + R * 1024 + 512 + grp * 128 + q * 8);
    gC = *(const uint4*)(XBC + R * 1024 + 768 + grp * 128 + q * 8);
    gX = *(const uint2*)(XBC + R * 1024 + hh * 64 + q * 4);
    gD = DTR[R * 16 + dir * 8 + hh];
  }
  const int NCH = TA / 32;
  for (int ch = 0; ch <= NCH; ++ch) {
    __syncthreads();
    if (ch > 0) {
      float4 y4 = *(const float4*)(yb + st * 64 + q * 4);
      uint2 o2;
      o2.x = pack2(y4.x, y4.y);
      o2.y = pack2(y4.z, y4.w);
      *(uint2*)(Y + (size_t)scan_row(b, dir, (ch - 1) * 32 + st) * 512 + hh * 64 + q * 4) = o2;
    }
    if (ch == NCH) break;
    {
      float dt = softplusf_(gD + dtb);
      float dA = expf(dt * Aneg);
      float* d = cB + st * 128 + q * 8;
      *(float4*)d = make_float4(bflo(gB.x), bfhi(gB.x), bflo(gB.y), bfhi(gB.y));
      *(float4*)(d + 4) = make_float4(bflo(gB.z), bfhi(gB.z), bflo(gB.w), bfhi(gB.w));
      d = cC + st * 128 + q * 8;
      *(float4*)d = make_float4(bflo(gC.x), bfhi(gC.x), bflo(gC.y), bfhi(gC.y));
      *(float4*)(d + 4) = make_float4(bflo(gC.z), bfhi(gC.z), bflo(gC.w), bfhi(gC.w));
      *(float4*)(cX + st * 64 + q * 4) = make_float4(bflo(gX.x) * dt, bfhi(gX.x) * dt, bflo(gX.y) * dt, bfhi(gX.y) * dt);
      if (q == 0) cDA[st] = dA;
    }
    __syncthreads();
    if (ch + 1 < NCH) {
      size_t R = (size_t)scan_row(b, dir, (ch + 1) * 32 + st);
      gB = *(const uint4*)(XBC + R * 1024 + 512 + grp * 128 + q * 8);
      gC = *(const uint4*)(XBC + R * 1024 + 768 + grp * 128 + q * 8);
      gX = *(const uint2*)(XBC + R * 1024 + hh * 64 + q * 4);
      gD = DTR[R * 16 + dir * 8 + hh];
    }
#pragma unroll 4
    for (int t = 0; t < 32; ++t) {
      float4 b0 = *(const float4*)(cB + t * 128 + l15 * 8);
      float4 b1 = *(const float4*)(cB + t * 128 + l15 * 8 + 4);
      float4 c0 = *(const float4*)(cC + t * 128 + l15 * 8);
      float4 c1 = *(const float4*)(cC + t * 128 + l15 * 8 + 4);
      float2 x2 = *(const float2*)(cX + t * 64 + r0);
      float dA = cDA[t];
      s0[0] = s0[0] * dA + x2.x * b0.x; s0[1] = s0[1] * dA + x2.x * b0.y; s0[2] = s0[2] * dA + x2.x * b0.z; s0[3] = s0[3] * dA + x2.x * b0.w;
      s0[4] = s0[4] * dA + x2.x * b1.x; s0[5] = s0[5] * dA + x2.x * b1.y; s0[6] = s0[6] * dA + x2.x * b1.z; s0[7] = s0[7] * dA + x2.x * b1.w;
      s1[0] = s1[0] * dA + x2.y * b0.x; s1[1] = s1[1] * dA + x2.y * b0.y; s1[2] = s1[2] * dA + x2.y * b0.z; s1[3] = s1[3] * dA + x2.y * b0.w;
      s1[4] = s1[4] * dA + x2.y * b1.x; s1[5] = s1[5] * dA + x2.y * b1.y; s1[6] = s1[6] * dA + x2.y * b1.z; s1[7] = s1[7] * dA + x2.y * b1.w;
      float y0 = s0[0] * c0.x + s0[1] * c0.y + s0[2] * c0.z + s0[3] * c0.w + s0[4] * c1.x + s0[5] * c1.y + s0[6] * c1.z + s0[7] * c1.w;
      float y1 = s1[0] * c0.x + s1[1] * c0.y + s1[2] * c0.z + s1[3] * c0.w + s1[4] * c1.x + s1[5] * c1.y + s1[6] * c1.z + s1[7] * c1.w;
      y0 = red16(y0);
      y1 = red16(y1);
      if (l15 == 0) *(float2*)(yb + t * 64 + r0) = make_float2(y0, y1);
    }
  }
}

__device__ __forceinline__ void gla_chain(const P& p, int chain, char* smem) {
  const int dir = chain & 1, h = (chain >> 1) & 3, b = chain >> 3;
  float* cQ = (float*)smem;
  float* cK = cQ + 2048;
  float* cD = cK + 2048;
  float* cV = cD + 2048;
  float* yb = cV + 4096;
  float* up = yb + 4096;
  float* gbias = up + 1024;
  const int tid = tidx(), lane = tid & 63, wave = tid >> 6;
  const int l15 = lane & 15, lg = lane >> 4;
  const bf* P1 = (const bf*)(p.ws + OFF_P1C);
  bf* Y = (bf*)(p.ws + OFF_GY) + (size_t)dir * RT * 512;
  const float* gup = p.in[dir ? 48 : 46];
  const float* gb = p.in[dir ? 49 : 47];
  __syncthreads();
  for (int i = tid; i < 1024; i += NT) up[i] = gup[(i >> 6) * 256 + h * 64 + (i & 63)];
  if (tid < 64) gbias[tid] = gb[h * 64 + tid];
  const int st = tid >> 4, q = tid & 15;
  const int r0 = wave * 16 + lg * 4;
  float s[4][4];
#pragma unroll
  for (int r = 0; r < 4; ++r)
#pragma unroll
    for (int j = 0; j < 4; ++j) s[r][j] = 0.f;
  uint2 gQ, gK;
  uint4 gV, gG0, gG1;
  {
    const bf* row = P1 + (size_t)scan_row(b, dir, st) * 2080;
    gQ = *(const uint2*)(row + 528 + h * 64 + q * 4);
    gK = *(const uint2*)(row + 784 + h * 64 + q * 4);
    gV = *(const uint4*)(row + 1040 + h * 128 + q * 8);
    gG0 = *(const uint4*)(row + 2064);
    gG1 = *(const uint4*)(row + 2072);
  }
  const int NCH = TA / 32;
  for (int ch = 0; ch <= NCH; ++ch) {
    __syncthreads();
    if (ch > 0) {
      float4 ya = *(const float4*)(yb + st * 128 + q * 8);
      float4 yc = *(const float4*)(yb + st * 128 + q * 8 + 4);
      uint4 o4;
      o4.x = pack2(ya.x, ya.y); o4.y = pack2(ya.z, ya.w); o4.z = pack2(yc.x, yc.y); o4.w = pack2(yc.z, yc.w);
      *(uint4*)(Y + (size_t)scan_row(b, dir, (ch - 1) * 32 + st) * 512 + h * 128 + q * 8) = o4;
    }
    if (ch == NCH) break;
    {
      float gd[16];
      gd[0] = bflo(gG0.x); gd[1] = bfhi(gG0.x); gd[2] = bflo(gG0.y); gd[3] = bfhi(gG0.y);
      gd[4] = bflo(gG0.z); gd[5] = bfhi(gG0.z); gd[6] = bflo(gG0.w); gd[7] = bfhi(gG0.w);
      gd[8] = bflo(gG1.x); gd[9] = bfhi(gG1.x); gd[10] = bflo(gG1.y); gd[11] = bfhi(gG1.y);
      gd[12] = bflo(gG1.z); gd[13] = bfhi(gG1.z); gd[14] = bflo(gG1.w); gd[15] = bfhi(gG1.w);
      float4 z = *(const float4*)(gbias + q * 4);
#pragma unroll
      for (int i = 0; i < 16; ++i) {
        float4 u4 = *(const float4*)(up + i * 64 + q * 4);
        z.x += gd[i] * u4.x; z.y += gd[i] * u4.y; z.z += gd[i] * u4.z; z.w += gd[i] * u4.w;
      }
      float4 dd;
      dd.x = expf(-softplusf_(-z.x) * (1.f / 16.f));
      dd.y = expf(-softplusf_(-z.y) * (1.f / 16.f));
      dd.z = expf(-softplusf_(-z.z) * (1.f / 16.f));
      dd.w = expf(-softplusf_(-z.w) * (1.f / 16.f));
      *(float4*)(cD + st * 64 + q * 4) = dd;
      *(float4*)(cQ + st * 64 + q * 4) = make_float4(bflo(gQ.x) * 0.125f, bfhi(gQ.x) * 0.125f, bflo(gQ.y) * 0.125f, bfhi(gQ.y) * 0.125f);
      *(float4*)(cK + st * 64 + q * 4) = make_float4(bflo(gK.x), bfhi(gK.x), bflo(gK.y), bfhi(gK.y));
      float* d = cV + st * 128 + q * 8;
      *(float4*)d = make_float4(bflo(gV.x), bfhi(gV.x), bflo(gV.y), bfhi(gV.y));
      *(float4*)(d + 4) = make_float4(bflo(gV.z), bfhi(gV.z), bflo(gV.w), bfhi(gV.w));
    }
    __syncthreads();
    if (ch + 1 < NCH) {
      const bf* row = P1 + (size_t)scan_row(b, dir, (ch + 1) * 32 + st) * 2080;
      gQ = *(const uint2*)(row + 528 + h * 64 + q * 4);
      gK = *(const uint2*)(row + 784 + h * 64 + q * 4);
      gV = *(const uint4*)(row + 1040 + h * 128 + q * 8);
      gG0 = *(const uint4*)(row + 2064);
      gG1 = *(const uint4*)(row + 2072);
    }
#pragma unroll 4
    for (int t = 0; t < 32; ++t) {
      float4 q4 = *(const float4*)(cQ + t * 64 + l15 * 4);
      float4 k4 = *(const float4*)(cK + t * 64 + l15 * 4);
      float4 d4 = *(const float4*)(cD + t * 64 + l15 * 4);
      float4 v4 = *(const float4*)(cV + t * 128 + r0);
      float vv[4] = {v4.x, v4.y, v4.z, v4.w};
      float yy[4];
#pragma unroll
      for (int r = 0; r < 4; ++r) {
        s[r][0] = s[r][0] * d4.x + k4.x * vv[r];
        s[r][1] = s[r][1] * d4.y + k4.y * vv[r];
        s[r][2] = s[r][2] * d4.z + k4.z * vv[r];
        s[r][3] = s[r][3] * d4.w + k4.w * vv[r];
        yy[r] = red16(s[r][0] * q4.x + s[r][1] * q4.y + s[r][2] * q4.z + s[r][3] * q4.w);
      }
      if (l15 == 0) *(float4*)(yb + t * 128 + r0) = make_float4(yy[0], yy[1], yy[2], yy[3]);
    }
  }
}

typedef __attribute__((address_space(3))) s16x4* lds_s16x4p;
template <int LD>
__device__ __forceinline__ bf16x8 trfrag_t(const bf* img, int r0, int c0, int lane) {
  const bf* pp = img + (r0 + ((lane & 15) >> 2)) * LD + c0 + (lane & 3) * 4;
  return tr_pair<4 * LD * 2>(pp);
}
#define trfrag(img, ld, r0, c0, lane) trfrag_t<ld>(img, r0, c0, lane)
__device__ __forceinline__ bf16x8 pack8(f32x4 a, f32x4 b) {
  i32x4 t;
  t[0] = (int)pack2(a[0], a[1]); t[1] = (int)pack2(a[2], a[3]); t[2] = (int)pack2(b[0], b[1]); t[3] = (int)pack2(b[2], b[3]);
  return __builtin_bit_cast(bf16x8, t);
}
__device__ __forceinline__ bf16x8 ld2x64(const bf* p0, const bf* p1) {
  uint2 a = *(const uint2*)p0, b2 = *(const uint2*)p1;
  i32x4 t;
  t[0] = (int)a.x; t[1] = (int)a.y; t[2] = (int)b2.x; t[3] = (int)b2.y;
  return __builtin_bit_cast(bf16x8, t);
}

__device__ __forceinline__ void gla_chain2(const P& p, int chain, int half, char* smem) {
  const int dir = chain & 1, h = (chain >> 1) & 3, b = chain >> 3;
  bf* Qs = (bf*)smem;
  bf* Ks = Qs + 64 * 72;
  bf* Vs = Ks + 64 * 72;
  bf* Ps = Vs + 64 * 144;
  bf* LGs = Ps + 64 * 72;
  float* segtot = (float*)(LGs + 64 * 72);
  float* dS = segtot + 512;
  const int tid = tidx(), lane = tid & 63, wave = tid >> 6;
  const int l15 = lane & 15, g = lane >> 4;
  const int ih = wave >> 2, vcol0 = (half * 4 + (wave & 3)) * 16;
  const bf* P1 = (const bf*)(p.ws + OFF_P1C);
  bf* Y = (bf*)(p.ws + OFF_GY) + (size_t)dir * RT * 512;
  const bf* LG = (const bf*)(p.ws + OFF_HO) + (size_t)dir * RT * 256;
  const int kc = tid & 63, seg = tid >> 6;
  const int stok = tid >> 3, sc8 = (tid & 7) * 8;
  f32x4 S[4];
#pragma unroll
  for (int kt = 0; kt < 4; ++kt) S[kt] = (f32x4){0.f, 0.f, 0.f, 0.f};
  uint4 rq, rk, rv0, rv1, rg;
  {
    const bf* row = P1 + (size_t)scan_row(b, dir, stok) * 2080;
    rq = *(const uint4*)(row + 528 + h * 64 + sc8);
    rk = *(const uint4*)(row + 784 + h * 64 + sc8);
    rv0 = *(const uint4*)(row + 1040 + h * 128 + sc8 * 2);
    rv1 = *(const uint4*)(row + 1040 + h * 128 + sc8 * 2 + 8);
    rg = *(const uint4*)(LG + (size_t)scan_row(b, dir, stok) * 256 + h * 64 + sc8);
  }
  const int NCH = TA / 64;
  for (int c = 0; c < NCH; ++c) {
    __syncthreads();
    *(uint4*)(Qs + stok * 72 + sc8) = rq;
    *(uint4*)(Ks + stok * 72 + sc8) = rk;
    *(uint4*)(Vs + stok * 144 + sc8 * 2) = rv0;
    *(uint4*)(Vs + stok * 144 + sc8 * 2 + 8) = rv1;
    *(uint4*)(LGs + stok * 72 + sc8) = rg;
    __syncthreads();
    if (c + 1 < NCH) {
      const bf* row = P1 + (size_t)scan_row(b, dir, (c + 1) * 64 + stok) * 2080;
      rq = *(const uint4*)(row + 528 + h * 64 + sc8);
      rk = *(const uint4*)(row + 784 + h * 64 + sc8);
      rv0 = *(const uint4*)(row + 1040 + h * 128 + sc8 * 2);
      rv1 = *(const uint4*)(row + 1040 + h * 128 + sc8 * 2 + 8);
      rg = *(const uint4*)(LG + (size_t)scan_row(b, dir, (c + 1) * 64 + stok) * 256 + h * 64 + sc8);
    }
    float lc[8];
    {
      float run = 0.f;
#pragma unroll
      for (int ii = 0; ii < 8; ++ii) {
        run += bf2f(LGs[(seg * 8 + ii) * 72 + kc]);
        lc[ii] = run;
      }
      segtot[seg * 64 + kc] = run;
    }
    __syncthreads();
    {
      float off = 0.f, tot = 0.f;
#pragma unroll
      for (int s2 = 0; s2 < 8; ++s2) {
        float t = segtot[s2 * 64 + kc];
        tot += t;
        off += (s2 < seg) ? t : 0.f;
      }
#pragma unroll
      for (int ii = 0; ii < 8; ++ii) {
        int i = seg * 8 + ii;
        float cum = off + lc[ii];
        float qv = bf2f(Qs[i * 72 + kc]), kv = bf2f(Ks[i * 72 + kc]);
        float eq = __expf(cum - tot);
        Qs[i * 72 + kc] = f2bf(qv * 0.125f * eq);
        Ks[i * 72 + kc] = f2bf(kv * __builtin_amdgcn_rcpf(eq));
      }
      if (seg == 0) dS[kc] = __expf(tot);
    }
    __syncthreads();
#pragma unroll
    for (int kt = 0; kt < 4; ++kt) {
      float4 d4 = *(const float4*)(dS + kt * 16 + g * 4);
      S[kt][0] *= d4.x; S[kt][1] *= d4.y; S[kt][2] *= d4.z; S[kt][3] *= d4.w;
    }
#pragma unroll
    for (int tt = 0; tt < 2; ++tt) {
      int idx = wave * 2 + tt, jt = idx >> 2, it = idx & 3;
      f32x4 acc = (f32x4){0.f, 0.f, 0.f, 0.f};
      if (jt <= it) {
#pragma unroll
        for (int ks = 0; ks < 2; ++ks) {
          bf16x8 a = *(const bf16x8*)(Ks + (jt * 16 + l15) * 72 + ks * 32 + g * 8);
          bf16x8 bq = *(const bf16x8*)(Qs + (it * 16 + l15) * 72 + ks * 32 + g * 8);
          acc = __builtin_amdgcn_mfma_f32_16x16x32_bf16(a, bq, acc, 0, 0, 0);
        }
        int i = it * 16 + l15;
#pragma unroll
        for (int r = 0; r < 4; ++r) { int j = jt * 16 + g * 4 + r; acc[r] = (j <= i) ? acc[r] : 0.f; }
      }
      uint2 o;
      o.x = pack2(acc[0], acc[1]);
      o.y = pack2(acc[2], acc[3]);
      *(uint2*)(Ps + (it * 16 + l15) * 72 + jt * 16 + g * 4) = o;
    }
    __syncthreads();
    f32x4 y[2];
    y[0] = (f32x4){0.f, 0.f, 0.f, 0.f};
    y[1] = (f32x4){0.f, 0.f, 0.f, 0.f};
#pragma unroll
    for (int s2 = 0; s2 < 2; ++s2) {
      bf16x8 sf = pack8(S[2 * s2], S[2 * s2 + 1]);
#pragma unroll
      for (int ii = 0; ii < 2; ++ii) {
        const bf* qr = Qs + ((ih * 2 + ii) * 16 + l15) * 72 + g * 4;
        bf16x8 aq = ld2x64(qr + (2 * s2) * 16, qr + (2 * s2 + 1) * 16);
        y[ii] = __builtin_amdgcn_mfma_f32_16x16x32_bf16(aq, sf, y[ii], 0, 0, 0);
      }
    }
    {
      bf16x8 vfs[2];
      tr_dual<32 * 144 * 2, 4 * 144 * 2>(trbase(Vs, 144, g * 8, vcol0, lane), vfs[0], vfs[1]);
#pragma unroll
      for (int s2 = 0; s2 < 2; ++s2) {
#pragma unroll
        for (int ii = 0; ii < 2; ++ii) {
          bf16x8 ap = *(const bf16x8*)(Ps + ((ih * 2 + ii) * 16 + l15) * 72 + s2 * 32 + g * 8);
          y[ii] = __builtin_amdgcn_mfma_f32_16x16x32_bf16(ap, vfs[s2], y[ii], 0, 0, 0);
        }
        bf16x8 ak[4];
        tr_quad<32, 4 * 72 * 2>(trbase(Ks, 72, s2 * 32 + g * 8, 0, lane), ak[0], ak[1], ak[2], ak[3]);
#pragma unroll
        for (int kt = 0; kt < 4; ++kt) S[kt] = __builtin_amdgcn_mfma_f32_16x16x32_bf16(ak[kt], vfs[s2], S[kt], 0, 0, 0);
      }
    }
#pragma unroll
    for (int ii = 0; ii < 2; ++ii)
#pragma unroll
      for (int r = 0; r < 4; ++r) {
        int i = (ih * 2 + ii) * 16 + g * 4 + r;
        Y[(size_t)scan_row(b, dir, c * 64 + i) * 512 + h * 128 + vcol0 + l15] = f2bf(y[ii][r]);
      }
  }
}

__device__ __forceinline__ void ssd_chain2(const P& p, int chain, char* smem) {
  const int dir = chain & 1, hh = (chain >> 1) & 7, b = chain >> 4;
  const int grp = hh >> 2;
  bf* Cs = (bf*)smem;
  bf* Bs = Cs + 64 * 136;
  bf* Xs = Bs + 64 * 136;
  bf* Xw = Xs + 64 * 72;
  bf* Ps = Xw + 64 * 72;
  float* dtS = (float*)(Ps + 64 * 72);
  float* cumS = dtS + 64;
  float* ecS = cumS + 64;
  float* totS = ecS + 64;
  const int tid = tidx(), lane = tid & 63, wave = tid >> 6;
  const int l15 = lane & 15, g = lane >> 4;
  const int vt = wave & 3, ih = wave >> 2;
  const bf* XBC = (const bf*)(p.ws + OFF_XBC);
  const float* DTR = (const float*)(p.ws + OFF_DTRAW);
  bf* Y = (bf*)(p.ws + OFF_XRAW) + (size_t)dir * RT * 512;
  const float dtb = p.in[dir ? 42 : 40][hh];
  const float Aneg = -expf(p.in[dir ? 43 : 41][hh]);
  const int stok = tid >> 3, sc = tid & 7;
  f32x4 S[8];
#pragma unroll
  for (int nt = 0; nt < 8; ++nt) S[nt] = (f32x4){0.f, 0.f, 0.f, 0.f};
  uint4 rc0, rc1, rb0, rb1, rx;
  float rdt = 0.f;
  {
    const bf* row = XBC + (size_t)scan_row(b, dir, stok) * 1024;
    rb0 = *(const uint4*)(row + 512 + grp * 128 + sc * 16);
    rb1 = *(const uint4*)(row + 512 + grp * 128 + sc * 16 + 8);
    rc0 = *(const uint4*)(row + 768 + grp * 128 + sc * 16);
    rc1 = *(const uint4*)(row + 768 + grp * 128 + sc * 16 + 8);
    rx = *(const uint4*)(row + hh * 64 + sc * 8);
    if (tid < 64) rdt = DTR[(size_t)scan_row(b, dir, tid) * 16 + dir * 8 + hh];
  }
  const int NCH = TA / 64;
  for (int c = 0; c < NCH; ++c) {
    __syncthreads();
    *(uint4*)(Cs + stok * 136 + sc * 16) = rc0;
    *(uint4*)(Cs + stok * 136 + sc * 16 + 8) = rc1;
    *(uint4*)(Bs + stok * 136 + sc * 16) = rb0;
    *(uint4*)(Bs + stok * 136 + sc * 16 + 8) = rb1;
    if (tid < 64) {
      float dt = softplusf_(rdt + dtb);
      float cum = dt * Aneg;
#pragma unroll
      for (int o = 1; o < 64; o <<= 1) {
        float t = __shfl_up(cum, o);
        if (lane >= o) cum += t;
      }
      float tot = __shfl(cum, 63);
      dtS[lane] = dt;
      cumS[lane] = cum;
      ecS[lane] = __expf(cum);
      if (lane == 0) totS[0] = tot;
    }
    __syncthreads();
    const uint4 cx = rx;
    if (c + 1 < NCH) {
      const bf* row = XBC + (size_t)scan_row(b, dir, (c + 1) * 64 + stok) * 1024;
      rb0 = *(const uint4*)(row + 512 + grp * 128 + sc * 16);
      rb1 = *(const uint4*)(row + 512 + grp * 128 + sc * 16 + 8);
      rc0 = *(const uint4*)(row + 768 + grp * 128 + sc * 16);
      rc1 = *(const uint4*)(row + 768 + grp * 128 + sc * 16 + 8);
      rx = *(const uint4*)(row + hh * 64 + sc * 8);
      if (tid < 64) rdt = DTR[(size_t)scan_row(b, dir, (c + 1) * 64 + tid) * 16 + dir * 8 + hh];
    }
    const float tot = totS[0];
    {
      float dt = dtS[stok];
      float w = dt * __expf(tot - cumS[stok]);
      float x0 = bflo(cx.x), x1 = bfhi(cx.x), x2 = bflo(cx.y), x3 = bfhi(cx.y), x4 = bflo(cx.z), x5 = bfhi(cx.z), x6 = bflo(cx.w), x7 = bfhi(cx.w);
      uint4 o;
      o.x = pack2(x0 * dt, x1 * dt); o.y = pack2(x2 * dt, x3 * dt); o.z = pack2(x4 * dt, x5 * dt); o.w = pack2(x6 * dt, x7 * dt);
      *(uint4*)(Xs + stok * 72 + sc * 8) = o;
      o.x = pack2(x0 * w, x1 * w); o.y = pack2(x2 * w, x3 * w); o.z = pack2(x4 * w, x5 * w); o.w = pack2(x6 * w, x7 * w);
      *(uint4*)(Xw + stok * 72 + sc * 8) = o;
    }
#pragma unroll
    for (int tt = 0; tt < 2; ++tt) {
      int idx = wave * 2 + tt, jt = idx >> 2, it = idx & 3;
      f32x4 acc = (f32x4){0.f, 0.f, 0.f, 0.f};
      if (jt <= it) {
#pragma unroll
        for (int ks = 0; ks < 4; ++ks) {
          bf16x8 a = *(const bf16x8*)(Bs + (jt * 16 + l15) * 136 + ks * 32 + g * 8);
          bf16x8 bq = *(const bf16x8*)(Cs + (it * 16 + l15) * 136 + ks * 32 + g * 8);
          acc = __builtin_amdgcn_mfma_f32_16x16x32_bf16(a, bq, acc, 0, 0, 0);
        }
        int i = it * 16 + l15;
        float ci = cumS[i];
        float4 cj = *(const float4*)(cumS + jt * 16 + g * 4);
        int j0 = jt * 16 + g * 4;
        acc[0] = (j0 + 0 <= i) ? acc[0] * __expf(ci - cj.x) : 0.f;
        acc[1] = (j0 + 1 <= i) ? acc[1] * __expf(ci - cj.y) : 0.f;
        acc[2] = (j0 + 2 <= i) ? acc[2] * __expf(ci - cj.z) : 0.f;
        acc[3] = (j0 + 3 <= i) ? acc[3] * __expf(ci - cj.w) : 0.f;
      }
      uint2 o;
      o.x = pack2(acc[0], acc[1]);
      o.y = pack2(acc[2], acc[3]);
      *(uint2*)(Ps + (it * 16 + l15) * 72 + jt * 16 + g * 4) = o;
    }
    __syncthreads();
    f32x4 y[2];
    y[0] = (f32x4){0.f, 0.f, 0.f, 0.f};
    y[1] = (f32x4){0.f, 0.f, 0.f, 0.f};
#pragma unroll
    for (int s2 = 0; s2 < 4; ++s2) {
      bf16x8 sf = pack8(S[2 * s2], S[2 * s2 + 1]);
#pragma unroll
      for (int ii = 0; ii < 2; ++ii) {
        const bf* qr = Cs + ((ih * 2 + ii) * 16 + l15) * 136 + g * 4;
        bf16x8 aq = ld2x64(qr + (2 * s2) * 16, qr + (2 * s2 + 1) * 16);
        y[ii] = __builtin_amdgcn_mfma_f32_16x16x32_bf16(aq, sf, y[ii], 0, 0, 0);
      }
    }
    {
      float et = __expf(tot);
#pragma unroll
      for (int nt = 0; nt < 8; ++nt) { S[nt][0] *= et; S[nt][1] *= et; S[nt][2] *= et; S[nt][3] *= et; }
    }
#pragma unroll
    for (int ii = 0; ii < 2; ++ii) {
      float4 e4 = *(const float4*)(ecS + (ih * 2 + ii) * 16 + g * 4);
      y[ii][0] *= e4.x; y[ii][1] *= e4.y; y[ii][2] *= e4.z; y[ii][3] *= e4.w;
    }
    {
      bf16x8 xfs[2], xws[2];
      tr_dual<32 * 72 * 2, 4 * 72 * 2>(trbase(Xs, 72, g * 8, vt * 16, lane), xfs[0], xfs[1]);
      tr_dual<32 * 72 * 2, 4 * 72 * 2>(trbase(Xw, 72, g * 8, vt * 16, lane), xws[0], xws[1]);
#pragma unroll
      for (int s2 = 0; s2 < 2; ++s2) {
#pragma unroll
        for (int ii = 0; ii < 2; ++ii) {
          bf16x8 ap = *(const bf16x8*)(Ps + ((ih * 2 + ii) * 16 + l15) * 72 + s2 * 32 + g * 8);
          y[ii] = __builtin_amdgcn_mfma_f32_16x16x32_bf16(ap, xfs[s2], y[ii], 0, 0, 0);
        }
#pragma unroll
        for (int nq = 0; nq < 2; ++nq) {
          bf16x8 ab[4];
          tr_quad<32, 4 * 136 * 2>(trbase(Bs, 136, s2 * 32 + g * 8, nq * 64, lane), ab[0], ab[1], ab[2], ab[3]);
#pragma unroll
          for (int n4 = 0; n4 < 4; ++n4) S[nq * 4 + n4] = __builtin_amdgcn_mfma_f32_16x16x32_bf16(ab[n4], xws[s2], S[nq * 4 + n4], 0, 0, 0);
        }
      }
    }
#pragma unroll
    for (int ii = 0; ii < 2; ++ii)
#pragma unroll
      for (int r = 0; r < 4; ++r) {
        int i = (ih * 2 + ii) * 16 + g * 4 + r;
        Y[(size_t)scan_row(b, dir, c * 64 + i) * 512 + hh * 64 + vt * 16 + l15] = f2bf(y[ii][r]);
      }
  }
}

__device__ __forceinline__ void rwkv_chain2(const P& p, int chain, char* smem) {
  const int dir = chain & 1, h = (chain >> 1) & 7, b = chain >> 4;
  bf* KT = (bf*)smem;
  bf* RTi = KT + 4608;
  bf* KH = RTi + 4608;
  bf* BH = KH + 4608;
  bf* VV = BH + 4608;
  bf* MAkk = VV + 4608;
  bf* MBrk = MAkk + 4608;
  bf* MBrb = MBrk + 4608;
  bf* UN = MBrb + 4608;
  bf* LWs = UN + 4608;
  float* AKB = (float*)(LWs + 4608);
  float* RH = AKB + 64 * 68;
  float* segtot = RH + 64 * 68;
  float* dS = segtot + 512;
  const int tid = tidx(), lane = tid & 63, wave = tid >> 6;
  const int l15 = lane & 15, g = lane >> 4;
  const int vt = wave & 3, ih = wave >> 2;
  const bf* PR = (const bf*)(p.ws + OFF_PREP);
  const bf* PK = PR + (size_t)RT * 512;
  const bf* PV = PK + (size_t)RT * 512;
  const bf* PKK = PV + (size_t)RT * 512;
  const bf* PKA = PKK + (size_t)RT * 512;
  const bf* PLW = PKA + (size_t)RT * 512 + (size_t)dir * RT * 512;
  bf* Y = (bf*)p.out + (size_t)dir * RT * 512;
  const int kc = tid & 63, seg = tid >> 6;
  const int stok = tid >> 3, sc8 = (tid & 7) * 8;
  f32x4 T[4];
#pragma unroll
  for (int kt = 0; kt < 4; ++kt) T[kt] = (f32x4){0.f, 0.f, 0.f, 0.f};
  uint4 gR, gK, gV, gKK, gKA, gW;
  {
    size_t o = (size_t)scan_row(b, dir, stok) * 512 + h * 64 + sc8;
    gR = *(const uint4*)(PR + o); gK = *(const uint4*)(PK + o); gV = *(const uint4*)(PV + o);
    gKK = *(const uint4*)(PKK + o); gKA = *(const uint4*)(PKA + o); gW = *(const uint4*)(PLW + o);
  }
  const int NCH = TA / 64;
  for (int c = 0; c < NCH; ++c) {
    __syncthreads();
    *(uint4*)(RTi + stok * 72 + sc8) = gR;
    *(uint4*)(KH + stok * 72 + sc8) = gK;
    *(uint4*)(VV + stok * 72 + sc8) = gV;
    *(uint4*)(KT + stok * 72 + sc8) = gKK;
    *(uint4*)(BH + stok * 72 + sc8) = gKA;
    *(uint4*)(LWs + stok * 72 + sc8) = gW;
    __syncthreads();
    if (c + 1 < NCH) {
      size_t o = (size_t)scan_row(b, dir, (c + 1) * 64 + stok) * 512 + h * 64 + sc8;
      gR = *(const uint4*)(PR + o); gK = *(const uint4*)(PK + o); gV = *(const uint4*)(PV + o);
      gKK = *(const uint4*)(PKK + o); gKA = *(const uint4*)(PKA + o); gW = *(const uint4*)(PLW + o);
    }
    float lc[8];
    {
      float run = 0.f;
#pragma unroll
      for (int ii = 0; ii < 8; ++ii) {
        run += bf2f(LWs[(seg * 8 + ii) * 72 + kc]);
        lc[ii] = run;
      }
      segtot[seg * 64 + kc] = run;
    }
    __syncthreads();
    {
      float off = 0.f, tot = 0.f;
#pragma unroll
      for (int s2 = 0; s2 < 8; ++s2) {
        float t = segtot[s2 * 64 + kc];
        tot += t;
        off += (s2 < seg) ? t : 0.f;
      }
#pragma unroll
      for (int ii = 0; ii < 8; ++ii) {
        const int i = seg * 8 + ii;
        const float cum = off + lc[ii];
        const float cumx = off + (ii > 0 ? lc[ii > 0 ? ii - 1 : 0] : 0.f);
        const float eR = __expf(cum - tot);
        const float eK = __builtin_amdgcn_rcpf(eR);
        const float eX = __expf(cumx - tot);
        const int o = i * 72 + kc;
        RTi[o] = f2bf(bf2f(RTi[o]) * eR);
        KH[o] = f2bf(bf2f(KH[o]) * eK);
        BH[o] = f2bf(bf2f(BH[o]) * eK);
        KT[o] = f2bf(bf2f(KT[o]) * eX);
      }
      if (seg == 0) dS[kc] = __expf(tot);
    }
    __syncthreads();
#pragma unroll
    for (int kt = 0; kt < 4; ++kt) {
      float4 d4 = *(const float4*)(dS + kt * 16 + g * 4);
      T[kt][0] *= d4.x; T[kt][1] *= d4.y; T[kt][2] *= d4.z; T[kt][3] *= d4.w;
    }
#pragma unroll
    for (int tt = 0; tt < 2; ++tt) {
      const int idx = wave * 2 + tt, jt = idx >> 2, it = idx & 3;
      f32x4 akb = (f32x4){0.f, 0.f, 0.f, 0.f}, akk = akb, brk = akb, brb = akb;
      if (jt <= it) {
#pragma unroll
        for (int ks = 0; ks < 2; ++ks) {
          bf16x8 aKH = *(const bf16x8*)(KH + (jt * 16 + l15) * 72 + ks * 32 + g * 8);
          bf16x8 aBH = *(const bf16x8*)(BH + (jt * 16 + l15) * 72 + ks * 32 + g * 8);
          bf16x8 bKT = *(const bf16x8*)(KT + (it * 16 + l15) * 72 + ks * 32 + g * 8);
          bf16x8 bRT = *(const bf16x8*)(RTi + (it * 16 + l15) * 72 + ks * 32 + g * 8);
          akb = __builtin_amdgcn_mfma_f32_16x16x32_bf16(aBH, bKT, akb, 0, 0, 0);
          akk = __builtin_amdgcn_mfma_f32_16x16x32_bf16(aKH, bKT, akk, 0, 0, 0);
          brk = __builtin_amdgcn_mfma_f32_16x16x32_bf16(aKH, bRT, brk, 0, 0, 0);
          brb = __builtin_amdgcn_mfma_f32_16x16x32_bf16(aBH, bRT, brb, 0, 0, 0);
        }
        const int i = it * 16 + l15;
#pragma unroll
        for (int r = 0; r < 4; ++r) {
          const int j = jt * 16 + g * 4 + r;
          akb[r] = (j < i) ? akb[r] : 0.f;
          akk[r] = (j < i) ? akk[r] : 0.f;
          brk[r] = (j <= i) ? brk[r] : 0.f;
          brb[r] = (j <= i) ? brb[r] : 0.f;
        }
      }
      const int orow = (it * 16 + l15), ocol = jt * 16 + g * 4;
      uint2 o;
      o.x = pack2(akk[0], akk[1]); o.y = pack2(akk[2], akk[3]);
      *(uint2*)(MAkk + orow * 72 + ocol) = o;
      o.x = pack2(brk[0], brk[1]); o.y = pack2(brk[2], brk[3]);
      *(uint2*)(MBrk + orow * 72 + ocol) = o;
      o.x = pack2(brb[0], brb[1]); o.y = pack2(brb[2], brb[3]);
      *(uint2*)(MBrb + orow * 72 + ocol) = o;
      *(float4*)(AKB + orow * 68 + ocol) = make_float4(akb[0], akb[1], akb[2], akb[3]);
    }
    __syncthreads();
    bf16x8 tf0 = pack8(T[0], T[1]), tf1 = pack8(T[2], T[3]);
    f32x4 yv[2];
    {
      bf16x8 vf0, vf1;
      tr_dual<32 * 72 * 2, 4 * 72 * 2>(trbase(VV, 72, g * 8, vt * 16, lane), vf0, vf1);
#pragma unroll
      for (int ii = 0; ii < 2; ++ii) {
        const int it = ih * 2 + ii;
        f32x4 acc = (f32x4){0.f, 0.f, 0.f, 0.f};
        const bf* qr = KT + (it * 16 + l15) * 72 + g * 4;
        acc = __builtin_amdgcn_mfma_f32_16x16x32_bf16(ld2x64(qr, qr + 16), tf0, acc, 0, 0, 0);
        acc = __builtin_amdgcn_mfma_f32_16x16x32_bf16(ld2x64(qr + 32, qr + 48), tf1, acc, 0, 0, 0);
        const bf* ar = MAkk + (it * 16 + l15) * 72 + g * 8;
        acc = __builtin_amdgcn_mfma_f32_16x16x32_bf16(*(const bf16x8*)ar, vf0, acc, 0, 0, 0);
        acc = __builtin_amdgcn_mfma_f32_16x16x32_bf16(*(const bf16x8*)(ar + 32), vf1, acc, 0, 0, 0);
#pragma unroll
        for (int r = 0; r < 4; ++r) RH[(it * 16 + g * 4 + r) * 68 + vt * 16 + l15] = acc[r];
        f32x4 ya = (f32x4){0.f, 0.f, 0.f, 0.f};
        const bf* rr = RTi + (it * 16 + l15) * 72 + g * 4;
        ya = __builtin_amdgcn_mfma_f32_16x16x32_bf16(ld2x64(rr, rr + 16), tf0, ya, 0, 0, 0);
        ya = __builtin_amdgcn_mfma_f32_16x16x32_bf16(ld2x64(rr + 32, rr + 48), tf1, ya, 0, 0, 0);
        const bf* br = MBrk + (it * 16 + l15) * 72 + g * 8;
        ya = __builtin_amdgcn_mfma_f32_16x16x32_bf16(*(const bf16x8*)br, vf0, ya, 0, 0, 0);
        ya = __builtin_amdgcn_mfma_f32_16x16x32_bf16(*(const bf16x8*)(br + 32), vf1, ya, 0, 0, 0);
        yv[ii] = ya;
      }
      {
        bf16x8 k0[4], k1[4];
        tr_quad<32, 4 * 72 * 2>(trbase(KH, 72, g * 8, 0, lane), k0[0], k0[1], k0[2], k0[3]);
        tr_quad<32, 4 * 72 * 2>(trbase(KH, 72, 32 + g * 8, 0, lane), k1[0], k1[1], k1[2], k1[3]);
#pragma unroll
        for (int kt = 0; kt < 4; ++kt) {
          T[kt] = __builtin_amdgcn_mfma_f32_16x16x32_bf16(k0[kt], vf0, T[kt], 0, 0, 0);
          T[kt] = __builtin_amdgcn_mfma_f32_16x16x32_bf16(k1[kt], vf1, T[kt], 0, 0, 0);
        }
      }
    }
    __syncthreads();
    for (int rb = 0; rb < 8; ++rb) {
      if (wave == 0) {
        float acc[8];
#pragma unroll
        for (int q = 0; q < 8; ++q) acc[q] = RH[(rb * 8 + q) * 68 + lane];
#pragma unroll
        for (int q = 1; q < 8; ++q) {
          const float4 d0 = *(const float4*)(AKB + (rb * 8 + q) * 68 + rb * 8);
          const float4 d1 = *(const float4*)(AKB + (rb * 8 + q) * 68 + rb * 8 + 4);
          const float dd[8] = {d0.x, d0.y, d0.z, d0.w, d1.x, d1.y, d1.z, d1.w};
#pragma unroll
          for (int cc = 0; cc < q; ++cc) acc[q] -= dd[cc] * acc[cc];
        }
#pragma unroll
        for (int q = 0; q < 8; ++q) {
          RH[(rb * 8 + q) * 68 + lane] = acc[q];
          UN[(rb * 8 + q) * 72 + lane] = f2bf(-acc[q]);
        }
      }
      __syncthreads();
      if (rb < 7) {
        float uq[8];
#pragma unroll
        for (int q = 0; q < 8; ++q) uq[q] = RH[(rb * 8 + q) * 68 + lane];
        for (int r = (rb + 1) * 8 + wave; r < 64; r += 8) {
          const float4 a0 = *(const float4*)(AKB + r * 68 + rb * 8);
          const float4 a1 = *(const float4*)(AKB + r * 68 + rb * 8 + 4);
          float Rv = RH[r * 68 + lane];
          Rv -= ((a0.x * uq[0] + a0.y * uq[1]) + (a0.z * uq[2] + a0.w * uq[3])) + ((a1.x * uq[4] + a1.y * uq[5]) + (a1.z * uq[6] + a1.w * uq[7]));
          RH[r * 68 + lane] = Rv;
        }
        __syncthreads();
      }
    }
    __syncthreads();
    {
      bf16x8 uf0, uf1;
      tr_dual<32 * 72 * 2, 4 * 72 * 2>(trbase(UN, 72, g * 8, vt * 16, lane), uf0, uf1);
#pragma unroll
      for (int ii = 0; ii < 2; ++ii) {
        const int it = ih * 2 + ii;
        const bf* br = MBrb + (it * 16 + l15) * 72 + g * 8;
        yv[ii] = __builtin_amdgcn_mfma_f32_16x16x32_bf16(*(const bf16x8*)br, uf0, yv[ii], 0, 0, 0);
        yv[ii] = __builtin_amdgcn_mfma_f32_16x16x32_bf16(*(const bf16x8*)(br + 32), uf1, yv[ii], 0, 0, 0);
      }
      {
        bf16x8 b0[4], b1[4];
        tr_quad<32, 4 * 72 * 2>(trbase(BH, 72, g * 8, 0, lane), b0[0], b0[1], b0[2], b0[3]);
        tr_quad<32, 4 * 72 * 2>(trbase(BH, 72, 32 + g * 8, 0, lane), b1[0], b1[1], b1[2], b1[3]);
#pragma unroll
        for (int kt = 0; kt < 4; ++kt) {
          T[kt] = __builtin_amdgcn_mfma_f32_16x16x32_bf16(b0[kt], uf0, T[kt], 0, 0, 0);
          T[kt] = __builtin_amdgcn_mfma_f32_16x16x32_bf16(b1[kt], uf1, T[kt], 0, 0, 0);
        }
      }
    }
#pragma unroll
    for (int ii = 0; ii < 2; ++ii)
#pragma unroll
      for (int r = 0; r < 4; ++r) {
        const int i = (ih * 2 + ii) * 16 + g * 4 + r;
        Y[(size_t)scan_row(b, dir, c * 64 + i) * 512 + h * 64 + vt * 16 + l15] = f2bf(yv[ii][r]);
      }
  }
}

__device__ __forceinline__ void ph_mix1(const P& p, char* smem) {
  for (int u = blockIdx.x; u < 256; u += gridDim.x) {
    if (u < 128) ssd_chain2(p, u, smem);
    else gla_chain2(p, (u - 128) >> 1, (u - 128) & 1, smem);
  }
}

__device__ __forceinline__ void ph_post1(const P& p, char* smem) {
  float* ws1 = (float*)smem;
  float* ws2 = ws1 + 32;
  const int tid = tidx(), lane = tid & 63, wave = tid >> 6;
  const bf* SYF = (const bf*)(p.ws + OFF_XRAW);
  const bf* SYB = SYF + (size_t)RT * 512;
  const bf* GYF = (const bf*)(p.ws + OFF_GY);
  const bf* GYB = GYF + (size_t)RT * 512;
  const bf* XBC = (const bf*)(p.ws + OFF_XBC);
  const bf* P1 = (const bf*)(p.ws + OFF_P1C);
  bf* O = (bf*)(p.ws + OFF_HO);
  const float dsk = p.in[44][tid >> 6];
  const float sn = p.in[45][tid];
  const float gn = p.in[50][tid & 127];
  for (int rr0 = blockIdx.x * 4; rr0 < NBAT * SEQ; rr0 += gridDim.x * 4) {
    float y[4], y2[4], zg[4], gg[4];
    int Rr[4];
#pragma unroll
    for (int i = 0; i < 4; ++i) {
      int rr = rr0 + i;
      int R = (rr >> 12) * TA + CTX + (rr & 4095);
      Rr[i] = R;
      size_t o = (size_t)R * 512 + tid;
      y[i] = bf2f(SYF[o]) + bf2f(SYB[o]) + bf2f(XBC[(size_t)R * 1024 + tid]) * dsk;
      zg[i] = bf2f(P1[(size_t)R * 2080 + tid]);
      y2[i] = bf2f(GYF[o]) + bf2f(GYB[o]);
      gg[i] = bf2f(P1[(size_t)R * 2080 + 1552 + tid]);
    }
    __syncthreads();
#pragma unroll
    for (int i = 0; i < 4; ++i) {
      y[i] *= siluf_(zg[i]);
      float s1 = wave_sum(y[i] * y[i]);
      float s2 = wave_sum(y2[i] * y2[i]);
      if (lane == 0) { ws1[i * 8 + wave] = s1; ws2[i * 8 + wave] = s2; }
    }
    __syncthreads();
#pragma unroll
    for (int i = 0; i < 4; ++i) {
      int g4 = i * 8 + (wave >> 2) * 4;
      float t1 = ws1[g4] + ws1[g4 + 1] + ws1[g4 + 2] + ws1[g4 + 3];
      int g2 = i * 8 + (wave >> 1) * 2;
      float t2 = ws2[g2] + ws2[g2 + 1];
      float o1 = y[i] * rsqrtf(t1 * (1.f / 256.f) + 1e-6f) * sn;
      float o2 = y2[i] * rsqrtf(t2 * (1.f / 128.f) + 1e-6f) * gn * siluf_(gg[i]);
      O[(size_t)Rr[i] * 1024 + tid] = f2bf(o1);
      O[(size_t)Rr[i] * 1024 + 512 + tid] = f2bf(o2);
    }
  }
}

__device__ __forceinline__ void ph_final(const P& p) {
  const int lane = tidx() & 63, wave = tidx() >> 6;
  const float* g = p.in[51];
  for (int r = blockIdx.x * 8 + wave; r < NBAT * SEQ; r += gridDim.x * 8) {
    float* row = p.out + (size_t)r * 1024;
    float4 v[4];
    float ss = 0.f;
#pragma unroll
    for (int i = 0; i < 4; ++i) {
      v[i] = *(const float4*)(row + i * 256 + lane * 4);
      ss += v[i].x * v[i].x + v[i].y * v[i].y + v[i].z * v[i].z + v[i].w * v[i].w;
    }
    ss = wave_sum(ss);
    float rs = rsqrtf(ss * (1.f / 1024.f) + 1e-6f);
#pragma unroll
    for (int i = 0; i < 4; ++i) {
      float4 gg = *(const float4*)(g + i * 256 + lane * 4);
      float4 o = make_float4(v[i].x * rs * gg.x, v[i].y * rs * gg.y, v[i].z * rs * gg.z, v[i].w * rs * gg.w);
      *(float4*)(row + i * 256 + lane * 4) = o;
    }
  }
}

#define XB_TMO      128
#define XB_XCNT(j)  (256  + 64 * (j))
#define XB_XSUB(j)  (1280 + 64 * (j))
#define XB_XGEN(j)  (2304 + 64 * (j))
#define XB_TOP      3328
#define XB_TOPGEN   3392
#define XCD_BAR_WORDS 3456
#define XB_SPIN_CAP (1u << 18)
#define LAS __attribute__((address_space(3)))
__device__ __forceinline__ unsigned xb_ld(unsigned* q)              { return __hip_atomic_load(q, __ATOMIC_RELAXED, __HIP_MEMORY_SCOPE_AGENT); }
__device__ __forceinline__ unsigned xb_add(unsigned* q, unsigned v) { return __hip_atomic_fetch_add(q, v, __ATOMIC_RELAXED, __HIP_MEMORY_SCOPE_AGENT); }
__device__ __forceinline__ unsigned xb_xcc_id() { return (unsigned)__builtin_amdgcn_s_getreg((3 << 11) | 20) & 0xFu; }
#define XB_SPIN(cond, bar) do { unsigned _sp = 0; while (cond) { __builtin_amdgcn_s_sleep(1); \
    if ((++_sp & 255u) == 0u) { if (xb_ld(&(bar)[XB_TMO])) break; if (_sp > XB_SPIN_CAP) { atomicAdd(&(bar)[XB_TMO], 1u); break; } } } } while (0)
struct XcdBarrier { unsigned* bar; unsigned x; volatile LAS unsigned* st; };
__device__ __forceinline__ XcdBarrier xcd_barrier_post(unsigned* bar, volatile LAS unsigned* st) {
  XcdBarrier b; b.bar = bar; b.x = xb_xcc_id(); b.st = st;
  if (threadIdx.x == 0) (void)xb_add(&bar[XB_XCNT(b.x)], 1u);
  return b;
}
__device__ __forceinline__ void xcd_barrier_complete(unsigned* bar, unsigned x, unsigned& nloc, unsigned& nx) {
  const unsigned G = gridDim.x * gridDim.y * gridDim.z;
  unsigned sum, cnt, mine, sp = 0u;
  for (;;) {
    sum = 0u; cnt = 0u; mine = 0u;
#pragma unroll
    for (unsigned j = 0; j < 16; ++j) { const unsigned c = xb_ld(&bar[XB_XCNT(j)]); sum += c; cnt += (c > 0u) ? 1u : 0u; mine = (j == x) ? c : mine; }
    if (sum == G) break;
    __builtin_amdgcn_s_sleep(1);
    if ((++sp & 255u) == 0u) { if (xb_ld(&bar[XB_TMO])) break; if (sp > XB_SPIN_CAP) { atomicAdd(&bar[XB_TMO], 1u); break; } }
  }
  nloc = mine > 0u ? mine : 1u; nx = cnt > 0u ? cnt : 1u;
}
__device__ __forceinline__ void xcd_barrier(const XcdBarrier& b) {
  asm volatile("s_waitcnt vmcnt(0)" ::: "memory");
  __syncthreads();
  if (threadIdx.x == 0) {
    unsigned* bar = b.bar;
    __builtin_amdgcn_s_waitcnt(0);
    unsigned nloc = b.st[0], nx = b.st[1];
    if (nloc == 0u) { xcd_barrier_complete(bar, b.x, nloc, nx); b.st[0] = nloc; b.st[1] = nx; }
    const unsigned old = xb_add(&bar[XB_XSUB(b.x)], 1u);
    const unsigned gen = old / nloc;
    if (old + 1u == (gen + 1u) * nloc) {
      __builtin_amdgcn_fence(__ATOMIC_RELEASE, "agent");
      asm volatile("s_waitcnt vmcnt(0)" ::: "memory");
      const unsigned og = xb_add(&bar[XB_TOP], 1u);
      const unsigned tg = og / nx;
      if (og + 1u == (tg + 1u) * nx) xb_add(&bar[XB_TOPGEN], 1u);
      else XB_SPIN(xb_ld(&bar[XB_TOPGEN]) == tg, bar);
      __builtin_amdgcn_fence(__ATOMIC_ACQUIRE, "agent");
      xb_add(&bar[XB_XGEN(b.x)], 1u);
      asm volatile("s_waitcnt vmcnt(0)" ::: "memory");
    } else {
      XB_SPIN(xb_ld(&bar[XB_XGEN(b.x)]) == gen, bar);
      __builtin_amdgcn_fence(__ATOMIC_ACQUIRE, "agent");
      asm volatile("s_waitcnt vmcnt(0)" ::: "memory");
    }
  }
  __syncthreads();
}

constexpr int NPH = 20;
template <int PH>
__device__ __forceinline__ void run_phase(const P& p, char* smem) {
  const bf* WT = (const bf*)(p.ws + OFF_WT);
  const bf* WT1 = (const bf*)(p.ws + OFF_WT1);
  const bf* HO = (const bf*)(p.ws + OFF_HO);
  const bf* HID = (const bf*)(p.ws + OFF_HID);
  if constexpr (PH == 0) {
    if (blockIdx.x == 0 && tidx() == 0) { *(int*)(p.ws + OFF_CNT) = 0; *((int*)(p.ws + OFF_CNT) + 1) = 0; }
    ph_mod(p, smem);
    ph_lw(p);
    ph_wt(p, 0, smem, blockIdx.x, gridDim.x);
  } else if constexpr (PH == 1) ph_ada(p, 0, 0, 1, 0);
  else if constexpr (PH == 2) ph_gemm<0>(p, HO, WT + WT_IN, 1024, 13, 0, 0, smem);
  else if constexpr (PH == 3) {
    ph_rope(p, smem);
    ph_rwkv_prep(p, smem);
#ifdef PROBE_PREP
    __syncthreads();
    ph_rwkv_prep(p, smem);
#endif
  }
  else if constexpr (PH == 4) ph_mix0(p, smem);
  else if constexpr (PH == 5) ph_rwkv_post(p);
  else if constexpr (PH == 6) ph_gemm<2>(p, HO, WT + WT_OUT, 1024, 4, 0, 0, smem);
  else if constexpr (PH == 7) ph_ada(p, 0, 1, 0, 0);
  else if constexpr (PH == 8) ph_gemm<3>(p, HO, WT + WT_W1, 1024, 16, 0, 0, smem);
  else if constexpr (PH == 9) {
    ph_gemm<4>(p, HID, WT + WT_W2, 4096, 4, 0, 0, smem);
    const int extra = 544 % (int)gridDim.x;
    if ((int)gridDim.x - extra >= 32) { if ((int)blockIdx.x >= extra) ph_wt(p, 1, smem, blockIdx.x - extra, gridDim.x - extra); }
    else ph_wt(p, 1, smem, blockIdx.x, gridDim.x);
  }
  else if constexpr (PH == 10) ph_ada(p, 1, 0, 0, 0);
  else if constexpr (PH == 11) ph_gemm<1>(p, HO, WT1 + WT_IN, 1024, 13, 1, 0, smem);
  else if constexpr (PH == 12) { ph_conv(p); ph_gla_gates(p, smem); }
  else if constexpr (PH == 13) ph_mix1(p, smem);
  else if constexpr (PH == 14) ph_post1(p, smem);
  else if constexpr (PH == 15) ph_gemm<2>(p, HO, WT1 + WT_OUT, 1024, 4, 1, 1, smem);
  else if constexpr (PH == 16) ph_ada(p, 1, 1, 0, 1);
  else if constexpr (PH == 17) ph_gemm<3>(p, HO, WT1 + WT_W1, 1024, 16, 1, 1, smem);
  else if constexpr (PH == 18) ph_gemm<4>(p, HID, WT1 + WT_W2, 4096, 4, 1, 1, smem);
  else ph_final(p);
}

constexpr int LDS_BYTES = 131072 + 64;
template <int PH>
__device__ __forceinline__ void run_all(const P& p, char* smem, const XcdBarrier& xb) {
  run_phase<PH>(p, smem);
#ifdef PROBE_MASK
  if constexpr (((PROBE_MASK) >> PH) & 1) {
    xcd_barrier(xb);
    if constexpr (PH == 4) {
      if (blockIdx.x == 0 && tidx() == 0) *(int*)(p.ws + OFF_CNT) = 0;
      xcd_barrier(xb);
    }
    run_phase<PH>(p, smem);
  }
#endif
  if constexpr (PH + 1 < NPH) {
    if constexpr (PH == 0) cg::this_grid().sync();
    else xcd_barrier(xb);
    run_all<PH + 1>(p, smem, xb);
  }
}
__global__ void __launch_bounds__(NT) mega(P p) {
  extern __shared__ __attribute__((aligned(16))) char smem[];
  volatile LAS unsigned* st = (volatile LAS unsigned*)(smem + 131072 + 16);
  if (threadIdx.x == 0) { st[0] = 0u; st[1] = 0u; }
  __syncthreads();
  const XcdBarrier xb = xcd_barrier_post((unsigned*)(p.ws + OFF_BAR), st);
  run_all<0>(p, smem, xb);
}

extern "C" void kernel_launch(void* const* d_in, const int* in_sizes, int n_in, void* d_out, int out_size, void* d_ws,
                              size_t ws_size, hipStream_t stream) {
  P p{};
  for (int i = 0; i < 52; ++i) p.in[i] = (const float*)d_in[i];
  p.out = (float*)d_out;
  p.ws = (char*)d_ws;
  static int grid_blocks = 0;
  if (!grid_blocks) {
    int dev = 0, cus = 0, per_cu = 0;
    (void)hipGetDevice(&dev);
    (void)hipDeviceGetAttribute(&cus, hipDeviceAttributeMultiprocessorCount, dev);
    (void)hipFuncSetAttribute((const void*)mega, hipFuncAttributeMaxDynamicSharedMemorySize, LDS_BYTES);
    (void)hipOccupancyMaxActiveBlocksPerMultiprocessor(&per_cu, mega, NT, LDS_BYTES);
    if (per_cu < 1) per_cu = 1;
    if (per_cu > 1) per_cu = 1;
    grid_blocks = cus * per_cu;
  }
  (void)hipMemsetAsync((char*)d_ws + OFF_BAR, 0, XCD_BAR_WORDS * sizeof(unsigned), stream);
  void* args[] = {&p};
  hipError_t e = hipLaunchCooperativeKernel((void*)mega, dim3(grid_blocks), dim3(NT), args, LDS_BYTES, stream);
  if (e != hipSuccess) fprintf(stderr, "cooperative launch failed: %s (grid %d)\n", hipGetErrorString(e), grid_blocks);
}
```
